# Optimizing an MI355X kernel written in HIP

```python
import math
import jax
import jax.numpy as jnp
from jax import lax
import numpy as np

D_MODEL = 1024
BATCH = 2
SEQ = 8192
DEPTH = 4

HEAD_DIM = 64
A_HEADS = 8
A_WIDTH = A_HEADS * HEAD_DIM
DECAY_LORA = 64
ICLR_LORA = 64
VRES_LORA = 32
GATE_LORA = 128
GN_EPS = 64e-5
B_HEADS = 8
B_WIDTH = B_HEADS * HEAD_DIM
KV_RANK = 128
IDX_HEADS = 8
IDX_DIM = 64
IDX_TOPK_MAX = 256
C_HEADS = 16
C_WIDTH = C_HEADS * HEAD_DIM
N_GROUPS = 4
EXPERTS_PER_GROUP = 8
N_EXPERTS = N_GROUPS * EXPERTS_PER_GROUP
EXPERT_FF = 512
TOP_K_EXPERTS = 2
MOE_BLOCK = 128
Q_BLOCK = 128
RMS_EPS = 1e-6
N_EVEN = (DEPTH + 1) // 2
N_ODD = DEPTH // 2
EVEN_SPLIT_SIZES = (A_WIDTH, A_WIDTH, A_WIDTH, B_WIDTH, KV_RANK, IDX_HEADS * IDX_DIM, IDX_DIM, IDX_HEADS)
IN_EVEN = sum(EVEN_SPLIT_SIZES)

kernel_name = "hybrid_rwkv7_dsa_stickbreak_hmoe"


def rmsnorm(x, g):
    xf = x.astype(jnp.float32)
    y = xf * lax.rsqrt(jnp.mean(xf * xf, axis=-1, keepdims=True) + RMS_EPS)
    return (y * g.astype(jnp.float32)).astype(x.dtype)


def token_shift(z):
    return jnp.concatenate([jnp.zeros_like(z[:, :1]), z[:, :-1]], axis=1)


def rwkv7_scan(r, w, k, v, kk, a):
    b, t, h, n = r.shape

    def step(state, inp):
        r_t, w_t, k_t, v_t, kk_t, a_t = inp
        s_kk = jnp.einsum('bhvk,bhk->bhv', state, kk_t)
        state = (state * w_t[:, :, None, :]
                 - s_kk[..., None] * (kk_t * a_t)[:, :, None, :]
                 + v_t[..., None] * k_t[:, :, None, :])
        return state, jnp.einsum('bhvk,bhk->bhv', state, r_t)

    xs = tuple(jnp.moveaxis(z, 1, 0) for z in (r, w, k, v, kk, a))
    _, ys = lax.scan(step, jnp.zeros((b, h, n, n), jnp.float32), xs)
    return jnp.moveaxis(ys, 0, 1)


def rwkv7_time_mix(h, r, k, v, mu_rkv, mu_lora, w0, w1, w2, a0, a1, a2, g1, g2,
                   k_k, k_a, r_k, ln_g, ln_b, vres):
    f32 = jnp.float32
    b, t, _ = h.shape
    rkv = jnp.stack([r, k, v], axis=2)
    rkv = rkv + (token_shift(rkv) - rkv) * mu_rkv
    r, k, v = rkv[:, :, 0], rkv[:, :, 1], rkv[:, :, 2]
    dh = token_shift(h) - h
    xw = h + dh * mu_lora[0]
    xa = h + dh * mu_lora[1]
    xg = h + dh * mu_lora[2]
    decay = jnp.exp(-math.exp(-0.5) * jax.nn.sigmoid((w0 + jnp.tanh(xw @ w1) @ w2).astype(f32)))
    iclr = jax.nn.sigmoid((a0 + (xa @ a1) @ a2).astype(f32))
    gate = jax.nn.sigmoid(xg @ g1) @ g2
    if vres is not None:
        v_first, mu_v, v0, v1, v2 = vres
        xv = h + dh * mu_v
        v = v + (v_first - v) * jax.nn.sigmoid(v0 + (xv @ v1) @ v2)

    def heads(z):
        return z.astype(f32).reshape(b, t, A_HEADS, HEAD_DIM)

    kk = heads(k * k_k)
    kk = kk * lax.rsqrt(jnp.maximum(jnp.sum(kk * kk, axis=-1, keepdims=True), 1e-12))
    k_mod = k.astype(f32) * (1.0 + (iclr - 1.0) * k_a)
    r_h, k_h, v_h = heads(r), heads(k_mod), heads(v)
    y = rwkv7_scan(r_h, heads(decay), k_h, v_h, kk, heads(iclr))
    yc = y - jnp.mean(y, axis=-1, keepdims=True)
    y = yc * lax.rsqrt(jnp.mean(yc * yc, axis=-1, keepdims=True) + GN_EPS)
    bonus = jnp.sum(r_h * k_h * r_k, axis=-1, keepdims=True) * v_h
    y = y.reshape(b, t, A_WIDTH) * ln_g + ln_b + bonus.reshape(b, t, A_WIDTH)
    return (y * gate).astype(h.dtype), v


def dsa_sparse_attention(q, c_kv, q_idx, k_idx, w_idx, kv_norm, w_kv_up, idx_k_norm):
    b, t = q.shape[0], q.shape[1]
    n_blk = t // Q_BLOCK
    topk = min(IDX_TOPK_MAX, t // 4)
    kv = (rmsnorm(c_kv, kv_norm) @ w_kv_up).reshape(b, t, 2, B_HEADS, HEAD_DIM)
    k_i = rmsnorm(k_idx, idx_k_norm)
    q_blk = q.reshape(b, n_blk, Q_BLOCK, B_HEADS, HEAD_DIM).swapaxes(0, 1)
    qi_blk = q_idx.reshape(b, n_blk, Q_BLOCK, IDX_HEADS, IDX_DIM).swapaxes(0, 1)
    wi_blk = w_idx.reshape(b, n_blk, Q_BLOCK, IDX_HEADS).swapaxes(0, 1)
    key_pos = jnp.arange(t)

    def one_block(args):
        blk, qb, qib, wib = args
        q_pos = blk * Q_BLOCK + jnp.arange(Q_BLOCK)
        dots = jnp.einsum('bqhd,bsd->bqhs', qib, k_i).astype(jnp.float32) * IDX_DIM ** -0.5
        score = jnp.einsum('bqhs,bqh->bqs', jax.nn.relu(dots), wib.astype(jnp.float32)) * IDX_HEADS ** -0.5
        causal = key_pos[None, :] <= q_pos[:, None]
        score = jnp.where(causal[None], score, -jnp.inf)
        _, sel = lax.top_k(score, topk)
        valid = sel <= q_pos[None, :, None]
        kv_sel = jax.vmap(lambda kv_b, sel_b: kv_b[sel_b])(kv, sel)
        logits = jnp.einsum('bqhd,bqkhd->bhqk', qb, kv_sel[:, :, :, 0]).astype(jnp.float32) * HEAD_DIM ** -0.5
        logits = jnp.where(valid[:, None], logits, -jnp.inf)
        p = jax.nn.softmax(logits, axis=-1).astype(kv.dtype)
        return jnp.einsum('bhqk,bqkhd->bqhd', p, kv_sel[:, :, :, 1])

    o = lax.map(one_block, (jnp.arange(n_blk), q_blk, qi_blk, wi_blk))
    return o.swapaxes(0, 1).reshape(b, t, B_WIDTH)


def stick_breaking_attention(q, k, v):
    b, t, _, _ = q.shape
    n_blk = t // Q_BLOCK
    q_blk = q.reshape(b, n_blk, Q_BLOCK, C_HEADS, HEAD_DIM).swapaxes(0, 1)
    key_pos = jnp.arange(t)

    def one_block(args):
        blk, qb = args
        q_pos = blk * Q_BLOCK + jnp.arange(Q_BLOCK)
        z = jnp.einsum('bqhd,bshd->bhqs', qb, k).astype(jnp.float32) * HEAD_DIM ** -0.5
        before = key_pos[None, :] < q_pos[:, None]
        log_keep = jnp.where(before, jax.nn.log_sigmoid(-z), 0.0)
        log_tail = lax.cumsum(log_keep, axis=3, reverse=True) - log_keep
        weight = jnp.where(before, jnp.exp(jax.nn.log_sigmoid(z) + log_tail), 0.0)
        return jnp.einsum('bhqs,bshd->bqhd', weight.astype(v.dtype), v)

    o = lax.map(one_block, (jnp.arange(n_blk), q_blk))
    return o.swapaxes(0, 1).reshape(b, t, C_WIDTH)


def routed_experts(xf, expert_idx, gates, w1, w3, w2):
    n_tok, d = xf.shape
    n_asg = n_tok * TOP_K_EXPERTS
    flat_e = expert_idx.reshape(n_asg)
    order = jnp.argsort(flat_e)
    sorted_e = flat_e[order]
    counts = jnp.zeros((N_EXPERTS,), jnp.int32).at[flat_e].add(1)
    padded = (counts + MOE_BLOCK - 1) // MOE_BLOCK * MOE_BLOCK
    seg_start = jnp.cumsum(counts) - counts
    pad_end = jnp.cumsum(padded)
    pad_start = pad_end - padded
    dest = pad_start[sorted_e] + (jnp.arange(n_asg) - seg_start[sorted_e])
    n_blocks = (n_asg + MOE_BLOCK - 1) // MOE_BLOCK + N_EXPERTS
    n_rows = n_blocks * MOE_BLOCK
    x_rows = jnp.zeros((n_rows, d), xf.dtype).at[dest].set(xf[order // TOP_K_EXPERTS])
    blk_expert = jnp.minimum(jnp.searchsorted(pad_end, jnp.arange(n_blocks) * MOE_BLOCK, side='right'), N_EXPERTS - 1)

    def expert_block(args):
        xb, e = args
        return (jax.nn.silu(xb @ w1[e]) * (xb @ w3[e])) @ w2[e]

    y_rows = lax.map(expert_block, (x_rows.reshape(n_blocks, MOE_BLOCK, d), blk_expert)).reshape(n_rows, d)
    y_asg = jnp.zeros((n_asg, d), y_rows.dtype).at[order].set(y_rows[dest])
    y = jnp.sum(y_asg.reshape(n_tok, TOP_K_EXPERTS, d).astype(jnp.float32) * gates[..., None], axis=1)
    return y.astype(xf.dtype)


def hierarchical_moe(h, router_group, router_expert, w1, w3, w2):
    b, t, d = h.shape
    xf = h.reshape(b * t, d)
    g_logits = (xf @ router_group).astype(jnp.float32)
    g_prob = jax.nn.softmax(g_logits, axis=-1)
    g_sel = jnp.argmax(g_logits, axis=-1)
    g_gate = jnp.take_along_axis(g_prob, g_sel[:, None], axis=1)
    e_logits = jnp.einsum('nd,gde->nge', xf, router_expert).astype(jnp.float32)
    e_logits = jnp.take_along_axis(e_logits, g_sel[:, None, None], axis=1)[:, 0]
    top_p, top_i = lax.top_k(jax.nn.softmax(e_logits, axis=-1), TOP_K_EXPERTS)
    gates = g_gate * top_p / jnp.sum(top_p, axis=-1, keepdims=True)
    expert_idx = g_sel[:, None].astype(jnp.int32) * EXPERTS_PER_GROUP + top_i.astype(jnp.int32)
    return routed_experts(xf, expert_idx, gates, w1, w3, w2).reshape(b, t, d)


def setup_inputs(seed: int = 0) -> dict:
    key = jax.random.key(seed)
    ks = iter(jax.random.split(key, 48))
    D = D_MODEL
    NE, NO = N_EVEN, N_ODD
    res_scale = (2.0 * DEPTH) ** -0.5

    def nrm(shape, scale):
        return jax.random.normal(next(ks), shape, jnp.float32) * scale

    def gain(shape):
        return 1.0 + nrm(shape, 0.02)

    def unif(shape):
        return jax.random.uniform(next(ks), shape, jnp.float32, 0.0, 1.0)

    return {
        'x': nrm((BATCH, SEQ, D), 1.0),
        'ev_norm': gain((NE, D)),
        'ev_w_in': nrm((NE, D, IN_EVEN), D ** -0.5),
        'ev_w_out': nrm((NE, A_WIDTH + B_WIDTH, D), (A_WIDTH + B_WIDTH) ** -0.5 * res_scale),
        'a_mu_rkv': unif((NE, 3, A_WIDTH)),
        'a_mu_lora': unif((NE, 3, D)),
        'a_w0': nrm((NE, A_WIDTH), 0.5),
        'a_w1': nrm((NE, D, DECAY_LORA), D ** -0.5),
        'a_w2': nrm((NE, DECAY_LORA, A_WIDTH), 0.5 * DECAY_LORA ** -0.5),
        'a_a0': nrm((NE, A_WIDTH), 0.1),
        'a_a1': nrm((NE, D, ICLR_LORA), D ** -0.5),
        'a_a2': nrm((NE, ICLR_LORA, A_WIDTH), 0.5 * ICLR_LORA ** -0.5),
        'a_g1': nrm((NE, D, GATE_LORA), D ** -0.5),
        'a_g2': nrm((NE, GATE_LORA, A_WIDTH), GATE_LORA ** -0.5),
        'a_k_k': 0.85 + nrm((NE, A_WIDTH), 0.02),
        'a_k_a': 1.0 + nrm((NE, A_WIDTH), 0.02),
        'a_r_k': nrm((NE, A_HEADS, HEAD_DIM), 0.1),
        'a_ln_g': gain((NE, A_WIDTH)),
        'a_ln_b': nrm((NE, A_WIDTH), 0.02),
        'a_mu_vres': unif((NE - 1, D)),
        'a_v0': nrm((NE - 1, A_WIDTH), 0.5),
        'a_v1': nrm((NE - 1, D, VRES_LORA), D ** -0.5),
        'a_v2': nrm((NE - 1, VRES_LORA, A_WIDTH), 0.5 * VRES_LORA ** -0.5),
        'b_kv_norm': gain((NE, KV_RANK)),
        'b_w_kv_up': nrm((NE, KV_RANK, 2 * B_WIDTH), KV_RANK ** -0.5),
        'b_idx_k_norm': gain((NE, IDX_DIM)),
        'od_norm': gain((NO, D)),
        'od_w_qkv': nrm((NO, D, 3 * C_WIDTH), D ** -0.5),
        'od_w_out': nrm((NO, C_WIDTH, D), C_WIDTH ** -0.5 * res_scale),
        'moe_norm': gain((DEPTH, D)),
        'moe_router_group': nrm((DEPTH, D, N_GROUPS), D ** -0.5),
        'moe_router_expert': nrm((DEPTH, N_GROUPS, D, EXPERTS_PER_GROUP), D ** -0.5),
        'moe_w1': nrm((DEPTH, N_EXPERTS, D, EXPERT_FF), D ** -0.5),
        'moe_w3': nrm((DEPTH, N_EXPERTS, D, EXPERT_FF), D ** -0.5),
        'moe_w2': nrm((DEPTH, N_EXPERTS, EXPERT_FF, D), EXPERT_FF ** -0.5 * res_scale),
        'final_norm': gain((D,)),
    }


def reference(x, ev_norm, ev_w_in, ev_w_out, a_mu_rkv, a_mu_lora, a_w0, a_w1, a_w2,
              a_a0, a_a1, a_a2, a_g1, a_g2, a_k_k, a_k_a, a_r_k, a_ln_g, a_ln_b,
              a_mu_vres, a_v0, a_v1, a_v2, b_kv_norm, b_w_kv_up, b_idx_k_norm,
              od_norm, od_w_qkv, od_w_out, moe_norm, moe_router_group, moe_router_expert,
              moe_w1, moe_w3, moe_w2, final_norm):
    b, t, _ = x.shape
    split_points = [int(s) for s in np.cumsum(EVEN_SPLIT_SIZES)[:-1]]
    v_first = None
    for i in range(DEPTH):
        if i % 2 == 0:
            e = i // 2
            h = rmsnorm(x, ev_norm[e])
            r, k, v, q_b, c_kv, q_idx, k_idx, w_idx = jnp.split(h @ ev_w_in[e], split_points, axis=-1)
            vres = None if e == 0 else (v_first, a_mu_vres[e - 1], a_v0[e - 1], a_v1[e - 1], a_v2[e - 1])
            y_a, v_used = rwkv7_time_mix(h, r, k, v, a_mu_rkv[e], a_mu_lora[e], a_w0[e], a_w1[e], a_w2[e],
                                         a_a0[e], a_a1[e], a_a2[e], a_g1[e], a_g2[e], a_k_k[e], a_k_a[e],
                                         a_r_k[e], a_ln_g[e], a_ln_b[e], vres)
            if e == 0:
                v_first = v_used
            y_b = dsa_sparse_attention(q_b.reshape(b, t, B_HEADS, HEAD_DIM), c_kv,
                                       q_idx.reshape(b, t, IDX_HEADS, IDX_DIM), k_idx, w_idx,
                                       b_kv_norm[e], b_w_kv_up[e], b_idx_k_norm[e])
            x = x + jnp.concatenate([y_a, y_b], axis=-1) @ ev_w_out[e]
        else:
            o = i // 2
            h = rmsnorm(x, od_norm[o])
            q, k, v = jnp.split((h @ od_w_qkv[o]).reshape(b, t, 3, C_HEADS, HEAD_DIM), 3, axis=2)
            y_c = stick_breaking_attention(q[:, :, 0], k[:, :, 0], v[:, :, 0])
            x = x + y_c @ od_w_out[o]
        x = x + hierarchical_moe(rmsnorm(x, moe_norm[i]), moe_router_group[i], moe_router_expert[i],
                                 moe_w1[i], moe_w3[i], moe_w2[i])
    return rmsnorm(x, final_norm)
```

```cpp
#include <hip/hip_runtime.h>
#include <cstdio>
#include <cstdint>

#ifndef ONE_LAUNCH
#define ONE_LAUNCH 0
#endif

#define GAS __attribute__((address_space(1)))
#define LAS __attribute__((address_space(3)))
typedef unsigned short bf16_t;
typedef short bf16x8 __attribute__((ext_vector_type(8)));
typedef float f32x4 __attribute__((ext_vector_type(4)));
typedef float f32x2 __attribute__((ext_vector_type(2)));
typedef float f32x16 __attribute__((ext_vector_type(16)));
typedef unsigned u32x4 __attribute__((ext_vector_type(4)));
typedef unsigned u32x2 __attribute__((ext_vector_type(2)));

constexpr int NT = 16384, TT = 8192, DM = 1024, NB = 2;
constexpr int NCOL = 3584;
constexpr int C_R = 0, C_K = 512, C_V = 1024, C_QB = 1536, C_CKV = 2048, C_QI = 2176, C_KI = 2688, C_WI = 2752;
constexpr int C_PW = 2816, C_QW = 2880, C_PA = 2944, C_QA = 3008, C_PG = 3072, C_QG = 3200, C_PV = 3328, C_QV = 3360;
constexpr int NWAVES = 8, NTHR = 512;
constexpr float RMS_EPS = 1e-6f, GN_EPS = 64e-5f;
constexpr float LOG2E = 1.4426950408889634f;

constexpr size_t MiB = 1u << 20;
constexpr size_t WS_CTL = 0, CTL_ZERO_BYTES = 1 * MiB;
constexpr size_t WS_SMALL = 1 * MiB;
constexpr size_t SM_EIDX = WS_SMALL, SM_GATE = WS_SMALL + 128 * 1024, SM_SLOT = WS_SMALL + 256 * 1024, SM_BONUS = WS_SMALL + 512 * 1024, SM_SGN = WS_SMALL + 1024 * 1024;
constexpr size_t WS_W = 5 * MiB;
constexpr size_t W_WIN = WS_W, W_WOUTE = WS_W + 14 * MiB, W_WQKV = WS_W + 18 * MiB, W_WOUTO = WS_W + 30 * MiB, W_WKB = WS_W + 34 * MiB, W_WVT = W_WKB + 256 * 1024;
constexpr size_t WS_X = 45 * MiB, WS_XB = 109 * MiB, WS_PROJ = 141 * MiB, WS_SIN = 253 * MiB, WS_VF = 445 * MiB, WS_Y = 477 * MiB, WS_GATE = 509 * MiB, WS_YCAT = 541 * MiB;
constexpr size_t WS_CN = 573 * MiB, WS_KI = 577 * MiB, WS_QI = 579 * MiB, WS_QA = 595 * MiB, WS_SEL = 627 * MiB;
constexpr size_t WS_BIG = 645 * MiB;
constexpr size_t WS_SCORE = WS_BIG;
constexpr size_t WS_W13T = WS_BIG, WS_W2T = WS_BIG + 64 * MiB, WS_AMOE = WS_BIG + 96 * MiB, WS_H = WS_BIG + 176 * MiB, WS_YM = WS_BIG + 216 * MiB;
constexpr size_t WS_END = 941 * MiB;
constexpr size_t SCORE_PER_BATCH = (size_t)16384 * 2080;
static_assert(WS_SCORE + 2 * SCORE_PER_BATCH * 4 <= WS_END, "score map");
static_assert(WS_YM + (size_t)40960 * 1024 * 2 <= WS_END, "moe map");
constexpr int CW_BAR = 4096;
constexpr int CW_CNT = 16384;

constexpr int LDS_BYTES = 147456;
constexpr int LDS_WSCR = 16384;
constexpr int LDS_MISC = 131072;

__device__ __forceinline__ float bf2f(bf16_t b) { return __uint_as_float(((unsigned)b) << 16); }
__device__ __forceinline__ unsigned f2bf(float f) { unsigned u = __float_as_uint(f); return (u + 0x7fffu + ((u >> 16) & 1u)) >> 16; }
__device__ __forceinline__ unsigned pk2(float lo, float hi) { return f2bf(lo) | (f2bf(hi) << 16); }
__device__ __forceinline__ float wave_sum(float v) {
#pragma unroll
    for (int o = 1; o < 64; o <<= 1) v += __shfl_xor(v, o);
    return v;
}
__device__ __forceinline__ float wave_max(float v) {
#pragma unroll
    for (int o = 1; o < 64; o <<= 1) v = fmaxf(v, __shfl_xor(v, o));
    return v;
}
__device__ __forceinline__ float sigmoidf_(float x) { return 1.0f / (1.0f + __expf(-x)); }
#define LDS_WAIT() asm volatile("s_waitcnt lgkmcnt(0)" ::: "memory")

#define XB_TMO      128
#define XB_XCNT(j)  (256  + 64 * (j))
#define XB_XSUB(j)  (1280 + 64 * (j))
#define XB_XGEN(j)  (2304 + 64 * (j))
#define XB_TOP      3328
#define XB_TOPGEN   3392
#define XCD_BAR_WORDS 3456
#define XB_SPIN_CAP (1u << 18)
__device__ __forceinline__ unsigned xb_ld(unsigned* p)              { return __hip_atomic_load(p, __ATOMIC_RELAXED, __HIP_MEMORY_SCOPE_AGENT); }
__device__ __forceinline__ unsigned xb_add(unsigned* p, unsigned v) { return __hip_atomic_fetch_add(p, v, __ATOMIC_RELAXED, __HIP_MEMORY_SCOPE_AGENT); }
__device__ __forceinline__ unsigned xb_xcc_id() { return (unsigned)__builtin_amdgcn_s_getreg((3 << 11) | 20) & 0xFu; }
#define XB_SPIN(cond, bar) do { unsigned _sp = 0; while (cond) { __builtin_amdgcn_s_sleep(1); \
    if ((++_sp & 255u) == 0u) { if (xb_ld(&(bar)[XB_TMO])) break; if (_sp > XB_SPIN_CAP) { atomicAdd(&(bar)[XB_TMO], 1u); break; } } } } while (0)
struct XcdBarrier { unsigned* bar; unsigned x; volatile LAS unsigned* st; };
__device__ __forceinline__ XcdBarrier xcd_barrier_post(unsigned* bar, volatile LAS unsigned* st) {
    XcdBarrier b; b.bar = bar; b.x = xb_xcc_id(); b.st = st;
    if (threadIdx.x == 0) (void)xb_add(&bar[XB_XCNT(b.x)], 1u);
    return b;
}
__device__ __forceinline__ void xcd_barrier_complete(unsigned* bar, unsigned x, unsigned& nloc, unsigned& nx) {
    const unsigned G = gridDim.x * gridDim.y * gridDim.z;
    unsigned sum, cnt, mine, sp = 0u;
    for (;;) {
        sum = 0u; cnt = 0u; mine = 0u;
#pragma unroll
        for (unsigned j = 0; j < 16; ++j) { const unsigned c = xb_ld(&bar[XB_XCNT(j)]); sum += c; cnt += (c > 0u) ? 1u : 0u; mine = (j == x) ? c : mine; }
        if (sum == G) break;
        __builtin_amdgcn_s_sleep(1);
        if ((++sp & 255u) == 0u) { if (xb_ld(&bar[XB_TMO])) break; if (sp > XB_SPIN_CAP) { atomicAdd(&bar[XB_TMO], 1u); break; } }
    }
    nloc = mine > 0u ? mine : 1u; nx = cnt > 0u ? cnt : 1u;
}
__device__ __forceinline__ void xcd_barrier(const XcdBarrier& b) {
    asm volatile("s_waitcnt vmcnt(0)" ::: "memory");
    __syncthreads();
    if (threadIdx.x == 0) {
        unsigned* bar = b.bar;
        __builtin_amdgcn_s_waitcnt(0);
        unsigned nloc = b.st[0], nx = b.st[1];
        if (nloc == 0u) { xcd_barrier_complete(bar, b.x, nloc, nx); b.st[0] = nloc; b.st[1] = nx; }
        const unsigned old = xb_add(&bar[XB_XSUB(b.x)], 1u);
        const unsigned gen = old / nloc;
        if (old + 1u == (gen + 1u) * nloc) {
            __builtin_amdgcn_fence(__ATOMIC_RELEASE, "agent");
            asm volatile("s_waitcnt vmcnt(0)" ::: "memory");
            const unsigned og = xb_add(&bar[XB_TOP], 1u);
            const unsigned tg = og / nx;
            if (og + 1u == (tg + 1u) * nx) xb_add(&bar[XB_TOPGEN], 1u);
            else XB_SPIN(xb_ld(&bar[XB_TOPGEN]) == tg, bar);
            __builtin_amdgcn_fence(__ATOMIC_ACQUIRE, "agent");
            xb_add(&bar[XB_XGEN(b.x)], 1u);
            asm volatile("s_waitcnt vmcnt(0)" ::: "memory");
        } else {
            XB_SPIN(xb_ld(&bar[XB_XGEN(b.x)]) == gen, bar);
            __builtin_amdgcn_fence(__ATOMIC_ACQUIRE, "agent");
            asm volatile("s_waitcnt vmcnt(0)" ::: "memory");
        }
    }
    __syncthreads();
}

struct Args { const float* in[36]; float* out; unsigned char* ws; int ph_lo, ph_hi; };
struct Frame {
    LAS unsigned char* lds; int tid, lane, wave, gw, ngw;
    float* out; unsigned char* ws;
};

#define PHASE_PIN(F) do { unsigned long long _z64; int _z32; asm volatile("s_mov_b64 %0, 0\n\ts_mov_b32 %1, 0" : "=s"(_z64), "=s"(_z32)); \
    asm volatile("" : "+v"((F).tid), "+v"((F).lane)); (F).ws += _z64; (F).out += _z64; (F).gw += _z32; (F).ngw += _z32; (F).wave += _z32; } while (0)
struct TrJob { const float* W; int K, ldw, col_off, ncols; bf16_t* WT; int ldt, row_off; const float* g; const float* mu; int mode; float cs; };
__device__ __forceinline__ void tr_item(const TrJob& J, int item, LAS float* scr, int lane) {
    const int nblk = (J.ncols + 31) / 32, kb = item / nblk, nb = item % nblk, k0 = 64 * kb, n0 = 32 * nb;
#pragma unroll 8
    for (int i = 0; i < 32; ++i) {
        const int kk = 2 * i + (lane >> 5), n = lane & 31, k = k0 + kk;
        float v = 0.f;
        if (k < J.K && n0 + n < J.ncols) {
            float s = J.cs;
            if (J.g) s *= J.g[k];
            if (J.mode == 1) s *= (1.0f - J.mu[k]); else if (J.mode == 2) s *= J.mu[k];
            v = J.W[(size_t)k * J.ldw + J.col_off + n0 + n] * s;
        }
        scr[kk * 33 + n] = v;
    }
    LDS_WAIT(); asm volatile("" ::: "memory");
    const int c = lane & 7;
#pragma unroll
    for (int j = 0; j < 4; ++j) {
        const int n = (lane >> 3) + 8 * j; const LAS float* s = scr + (8 * c) * 33 + n;
        u32x4 o; o.x = pk2(s[0 * 33], s[1 * 33]); o.y = pk2(s[2 * 33], s[3 * 33]); o.z = pk2(s[4 * 33], s[5 * 33]); o.w = pk2(s[6 * 33], s[7 * 33]);
        if (n0 + n < J.ncols && k0 + 8 * c < J.K) *(u32x4*)(J.WT + (size_t)(J.row_off + n0 + n) * J.ldt + k0 + 8 * c) = o;
    }
    LDS_WAIT(); asm volatile("" ::: "memory");
}
__device__ __forceinline__ void tr_job(Frame& F, const TrJob& J, int rot) {
    LAS float* scr = (LAS float*)(F.lds + F.wave * LDS_WSCR);
    const int nitems = ((J.K + 63) / 64) * ((J.ncols + 31) / 32);
    int start = F.gw - (rot % F.ngw); if (start < 0) start += F.ngw;
    for (int it = start; it < nitems; it += F.ngw) tr_item(J, it, scr, F.lane);
}
__device__ __forceinline__ void zero_rows(Frame& F, bf16_t* WT, int ld, int r0, int r1) {
    const size_t n16 = (size_t)(r1 - r0) * ld / 8; u32x4* p = (u32x4*)(WT + (size_t)r0 * ld);
    for (size_t i = (size_t)F.gw * 64 + F.lane; i < n16; i += (size_t)F.ngw * 64) p[i] = (u32x4){0u, 0u, 0u, 0u};
}
__device__ __forceinline__ void row_norm_to_bf16(const float* xrow, bf16_t* orow, int lane) {
    const f32x4* xr = (const f32x4*)xrow + lane; f32x4 v[4]; float s = 0.f;
#pragma unroll
    for (int j = 0; j < 4; ++j) { v[j] = xr[64 * j]; s += (v[j].x * v[j].x + v[j].y * v[j].y) + (v[j].z * v[j].z + v[j].w * v[j].w); }
    const float rstd = rsqrtf(wave_sum(s) * (1.f / DM) + RMS_EPS);
    u32x2* o8 = (u32x2*)orow + lane;
#pragma unroll
    for (int j = 0; j < 4; ++j) { u32x2 w; w.x = pk2(v[j].x * rstd, v[j].y * rstd); w.y = pk2(v[j].z * rstd, v[j].w * rstd); o8[64 * j] = w; }
}

__device__ __forceinline__ void ph_prologue(Frame& F, const Args& A) {
    PHASE_PIN(F);
    unsigned char* ws = F.ws; int rot = 0;
    for (int e = 0; e < 2; ++e) {
        bf16_t* WT = (bf16_t*)(ws + W_WIN) + (size_t)e * NCOL * DM;
        const float* g = A.in[1] + e * DM; const float* mul = A.in[5] + (size_t)e * 3 * DM;
        TrJob J{A.in[2] + (size_t)e * DM * 2760, DM, 2760, 0, 2760, WT, DM, 0, g, nullptr, 0, 1.0f}; tr_job(F, J, rot); rot += 1392;
        zero_rows(F, WT, DM, 2760, C_PW);
        TrJob Jw1{A.in[7] + (size_t)e * DM * 64, DM, 64, 0, 64, WT, DM, C_PW, g, mul, 1, 1.0f}; tr_job(F, Jw1, rot); rot += 32;
        TrJob Jw2{A.in[7] + (size_t)e * DM * 64, DM, 64, 0, 64, WT, DM, C_QW, g, mul, 2, 1.0f}; tr_job(F, Jw2, rot); rot += 32;
        TrJob Ja1{A.in[10] + (size_t)e * DM * 64, DM, 64, 0, 64, WT, DM, C_PA, g, mul + DM, 1, 1.0f}; tr_job(F, Ja1, rot); rot += 32;
        TrJob Ja2{A.in[10] + (size_t)e * DM * 64, DM, 64, 0, 64, WT, DM, C_QA, g, mul + DM, 2, 1.0f}; tr_job(F, Ja2, rot); rot += 32;
        TrJob Jg1{A.in[12] + (size_t)e * DM * 128, DM, 128, 0, 128, WT, DM, C_PG, g, mul + 2 * DM, 1, 1.0f}; tr_job(F, Jg1, rot); rot += 64;
        TrJob Jg2{A.in[12] + (size_t)e * DM * 128, DM, 128, 0, 128, WT, DM, C_QG, g, mul + 2 * DM, 2, 1.0f}; tr_job(F, Jg2, rot); rot += 64;
        if (e == 1) {
            TrJob Jv1{A.in[21], DM, 32, 0, 32, WT, DM, C_PV, g, A.in[19], 1, 1.0f}; tr_job(F, Jv1, rot); rot += 16;
            TrJob Jv2{A.in[21], DM, 32, 0, 32, WT, DM, C_QV, g, A.in[19], 2, 1.0f}; tr_job(F, Jv2, rot); rot += 16;
            zero_rows(F, WT, DM, C_QV + 32, NCOL);
        } else zero_rows(F, WT, DM, C_PV, NCOL);
        TrJob Jo{A.in[3] + (size_t)e * DM * DM, DM, DM, 0, DM, (bf16_t*)(ws + W_WOUTE) + (size_t)e * DM * DM, DM, 0, nullptr, nullptr, 0, 1.0f}; tr_job(F, Jo, rot); rot += 512;
        { const float* Wkv = A.in[24] + (size_t)e * 128 * 1024; bf16_t* WkB = (bf16_t*)(ws + W_WKB) + (size_t)e * 8 * 128 * 64;
          for (int i = F.gw * 64 + F.lane; i < 8 * 128 * 64; i += F.ngw * 64) { const int d = i & 63, r = (i >> 6) & 127, h = i >> 13; WkB[i] = (bf16_t)f2bf(Wkv[(size_t)r * 1024 + h * 64 + d]); } }
        TrJob Jv{A.in[24] + (size_t)e * 128 * 1024, 128, 1024, 512, 512, (bf16_t*)(ws + W_WVT) + (size_t)e * 512 * 128, 128, 0, nullptr, nullptr, 0, 1.0f}; tr_job(F, Jv, rot); rot += 32;
    }
    for (int o = 0; o < 2; ++o) {
        const float* g = A.in[26] + o * DM; bf16_t* WT = (bf16_t*)(ws + W_WQKV) + (size_t)o * 3072 * DM;
        TrJob Jq{A.in[27] + (size_t)o * DM * 3072, DM, 3072, 0, 1024, WT, DM, 0, g, nullptr, 0, LOG2E * 0.125f}; tr_job(F, Jq, rot); rot += 512;
        TrJob Jk{A.in[27] + (size_t)o * DM * 3072, DM, 3072, 1024, 2048, WT, DM, 1024, g, nullptr, 0, 1.0f}; tr_job(F, Jk, rot); rot += 1024;
        TrJob Jo{A.in[28] + (size_t)o * DM * DM, DM, DM, 0, DM, (bf16_t*)(ws + W_WOUTO) + (size_t)o * DM * DM, DM, 0, nullptr, nullptr, 0, 1.0f}; tr_job(F, Jo, rot); rot += 512;
    }
    for (int m = F.gw; m < NT; m += F.ngw) row_norm_to_bf16(A.in[0] + (size_t)m * DM, (bf16_t*)(ws + WS_XB) + (size_t)m * DM, F.lane);
}

__device__ __forceinline__ void moe_weight_prep(Frame& F, const Args& A, int l) {
    PHASE_PIN(F);
    LAS float* scr = (LAS float*)(F.lds + F.wave * LDS_WSCR);
    const float* g = A.in[29] + l * DM;
    const float* w1 = A.in[32] + (size_t)l * 32 * DM * 512; const float* w3 = A.in[33] + (size_t)l * 32 * DM * 512; const float* w2 = A.in[34] + (size_t)l * 32 * 512 * DM;
    bf16_t* W13T = (bf16_t*)(F.ws + WS_W13T); bf16_t* W2T = (bf16_t*)(F.ws + WS_W2T);
    for (int it = F.gw; it < 16384; it += F.ngw) {
        const int job = it >> 6, item = it & 63, which = job & 1, j = (job >> 1) & 3, e = job >> 3;
        TrJob J{(which ? w3 : w1) + (size_t)e * DM * 512, DM, 512, 128 * j, 128, W13T, DM, e * 1024 + 256 * j + 128 * which, g, nullptr, 0, 1.0f};
        tr_item(J, item, scr, F.lane);
    }
    for (int it = F.gw; it < 8192; it += F.ngw) {
        const int e = it >> 8, item = it & 255;
        TrJob J{w2 + (size_t)e * 512 * DM, 512, DM, 0, DM, W2T, 512, e * 1024, nullptr, nullptr, 0, 1.0f};
        tr_item(J, item, scr, F.lane);
    }
}

#define MFMA32(a, b, c) __builtin_amdgcn_mfma_f32_32x32x16_bf16((a), (b), (c), 0, 0, 0)
template <class Epi>
__device__ __forceinline__ void sg_tile(const bf16_t* A, int lda, const bf16_t* B0, const bf16_t* B1, int ldb, int K, int m0, const Epi& epi, int lane) {
    const int r = lane & 31, h = lane >> 5;
    const bf16_t* a0 = A + (size_t)(m0 + r) * lda + 8 * h; const bf16_t* a1 = a0 + (size_t)32 * lda;
    const bf16_t* b0 = B0 + (size_t)r * ldb + 8 * h; const bf16_t* b1 = B1 + (size_t)r * ldb + 8 * h;
    f32x16 c00, c01, c10, c11;
#pragma unroll
    for (int i = 0; i < 16; ++i) { c00[i] = 0.f; c01[i] = 0.f; c10[i] = 0.f; c11[i] = 0.f; }
#pragma unroll 4
    for (int k = 0; k < K; k += 16) {
        const bf16x8 fa0 = *(const bf16x8*)(a0 + k), fa1 = *(const bf16x8*)(a1 + k), fb0 = *(const bf16x8*)(b0 + k), fb1 = *(const bf16x8*)(b1 + k);
        c00 = MFMA32(fb0, fa0, c00); c01 = MFMA32(fb1, fa0, c01); c10 = MFMA32(fb0, fa1, c10); c11 = MFMA32(fb1, fa1, c11);
    }
#pragma unroll
    for (int g = 0; g < 4; ++g) {
        const int j = 8 * g + 4 * h;
        epi.pair(m0 + r, j, (f32x4){c00[4 * g], c00[4 * g + 1], c00[4 * g + 2], c00[4 * g + 3]}, (f32x4){c01[4 * g], c01[4 * g + 1], c01[4 * g + 2], c01[4 * g + 3]});
        epi.pair(m0 + 32 + r, j, (f32x4){c10[4 * g], c10[4 * g + 1], c10[4 * g + 2], c10[4 * g + 3]}, (f32x4){c11[4 * g], c11[4 * g + 1], c11[4 * g + 2], c11[4 * g + 3]});
    }
}
struct EpiStoreBf16 {
    bf16_t* O; int ldo, n0, n1;
    __device__ __forceinline__ void pair(int row, int j, f32x4 v0, f32x4 v1) const {
        u32x2 w; w.x = pk2(v0.x, v0.y); w.y = pk2(v0.z, v0.w); *(u32x2*)(O + (size_t)row * ldo + n0 + j) = w;
        w.x = pk2(v1.x, v1.y); w.y = pk2(v1.z, v1.w); *(u32x2*)(O + (size_t)row * ldo + n1 + j) = w;
    }
};
struct EpiResidF32 {
    const float* S; float* X; int n0, n1;
    __device__ __forceinline__ void pair(int row, int j, f32x4 v0, f32x4 v1) const {
        const size_t o0 = (size_t)row * DM + n0 + j, o1 = (size_t)row * DM + n1 + j;
        *(f32x4*)(X + o0) = *(const f32x4*)(S + o0) + v0; *(f32x4*)(X + o1) = *(const f32x4*)(S + o1) + v1;
    }
};
struct EpiGated {
    bf16_t* H; int hc;
    __device__ __forceinline__ void pair(int row, int j, f32x4 a, f32x4 b) const {
        f32x4 o;
#pragma unroll
        for (int i = 0; i < 4; ++i) o[i] = a[i] * sigmoidf_(a[i]) * b[i];
        u32x2 w; w.x = pk2(o.x, o.y); w.y = pk2(o.z, o.w); *(u32x2*)(H + (size_t)row * 512 + hc + j) = w;
    }
};
__device__ __forceinline__ void sg_dense_bf16(Frame& F, const bf16_t* A, int lda, const bf16_t* Bt, int K, int M, int N, bf16_t* O, int ldo) {
    PHASE_PIN(F);
    const int nN = N / 64, ntile = (M / 64) * nN;
    for (int t = F.gw; t < ntile; t += F.ngw) {
        const int mt = t / nN, nt = t % nN; EpiStoreBf16 E{O, ldo, nt * 64, nt * 64 + 32};
        sg_tile(A, lda, Bt + (size_t)(nt * 64) * K, Bt + (size_t)(nt * 64 + 32) * K, K, K, mt * 64, E, F.lane);
    }
}
__device__ __forceinline__ void sg_dense_resid(Frame& F, const bf16_t* A, const bf16_t* Bt, const float* S, float* X) {
    PHASE_PIN(F);
    const int nN = DM / 64, ntile = (NT / 64) * nN;
    for (int t = F.gw; t < ntile; t += F.ngw) {
        const int mt = t / nN, nt = t % nN; EpiResidF32 E{S, X, nt * 64, nt * 64 + 32};
        sg_tile(A, DM, Bt + (size_t)(nt * 64) * DM, Bt + (size_t)(nt * 64 + 32) * DM, DM, DM, mt * 64, E, F.lane);
    }
}

__device__ __forceinline__ void ph_prep(Frame& F, const Args& A, int e) {
    PHASE_PIN(F);
    LAS float* sc = (LAS float*)(F.lds + F.wave * LDS_WSCR);
    unsigned char* ws = F.ws; const int lane = F.lane;
    const bf16_t* proj = (const bf16_t*)(ws + WS_PROJ);
    const float* mu_rkv = A.in[4] + (size_t)e * 3 * 512;
    const float* w0 = A.in[6] + e * 512; const float* w2 = A.in[8] + (size_t)e * 64 * 512;
    const float* a0 = A.in[9] + e * 512; const float* a2 = A.in[11] + (size_t)e * 64 * 512;
    const float* g2 = A.in[13] + (size_t)e * 128 * 512;
    const float* k_k = A.in[14] + e * 512; const float* k_a = A.in[15] + e * 512; const float* r_k = A.in[16] + e * 512;
    const float* v0 = A.in[20]; const float* v2 = A.in[22];
    const float* kvn = A.in[23] + e * 128; const float* ikn = A.in[25] + e * 64;
    float* SIN = (float*)(ws + WS_SIN); float* VF = (float*)(ws + WS_VF); float* GATE = (float*)(ws + WS_GATE); float* BON = (float*)(ws + SM_BONUS);
    unsigned* SGN = (unsigned*)(ws + SM_SGN);
    bf16_t* CN = (bf16_t*)(ws + WS_CN); bf16_t* KI = (bf16_t*)(ws + WS_KI); bf16_t* QI = (bf16_t*)(ws + WS_QI);
    for (int m = F.gw; m < NT; m += F.ngw) {
        const int t = m & (TT - 1), b = m >> 13; const bool hp = t > 0;
        const bf16_t* pr = proj + (size_t)m * NCOL; const bf16_t* pp = pr - NCOL;
        { const float lw = bf2f(pr[C_PW + lane]) + (hp ? bf2f(pp[C_QW + lane]) : 0.f);
          const float la = bf2f(pr[C_PA + lane]) + (hp ? bf2f(pp[C_QA + lane]) : 0.f);
          const float lg0 = bf2f(pr[C_PG + lane]) + (hp ? bf2f(pp[C_QG + lane]) : 0.f);
          const float lg1 = bf2f(pr[C_PG + 64 + lane]) + (hp ? bf2f(pp[C_QG + 64 + lane]) : 0.f);
          sc[lane] = tanhf(lw); sc[64 + lane] = la; sc[128 + lane] = sigmoidf_(lg0); sc[192 + lane] = sigmoidf_(lg1);
          if (lane < 32) sc[256 + lane] = bf2f(pr[C_PV + lane]) + (hp ? bf2f(pp[C_QV + lane]) : 0.f); }
        { const float c0 = bf2f(pr[C_CKV + lane]), c1 = bf2f(pr[C_CKV + 64 + lane]);
          const float rs = rsqrtf(wave_sum(c0 * c0 + c1 * c1) * (1.f / 128.f) + RMS_EPS);
          CN[(size_t)m * 128 + lane] = (bf16_t)f2bf(c0 * rs * kvn[lane]); CN[(size_t)m * 128 + 64 + lane] = (bf16_t)f2bf(c1 * rs * kvn[64 + lane]);
          const float ki = bf2f(pr[C_KI + lane]); const float rs2 = rsqrtf(wave_sum(ki * ki) * (1.f / 64.f) + RMS_EPS);
          KI[(size_t)m * 64 + lane] = (bf16_t)f2bf(ki * rs2 * ikn[lane]);
          unsigned sg = 0;
#pragma unroll
          for (int hh = 0; hh < 8; ++hh) { const float w = bf2f(pr[C_WI + hh]); if (w < 0.f) sg |= 1u << hh;
              QI[(size_t)m * 512 + hh * 64 + lane] = (bf16_t)f2bf(fabsf(w) * bf2f(pr[C_QI + hh * 64 + lane])); }
          if (lane == 0) SGN[m] = sg; }
        LDS_WAIT(); asm volatile("" ::: "memory");
#pragma unroll 1
        for (int hh = 0; hh < 8; ++hh) {
            const int ch = hh * 64 + lane;
            float dw = w0[ch], da = a0[ch], dg = 0.f, dv = 0.f;
#pragma unroll 4
            for (int j = 0; j < 64; j += 4) {
                const f32x4 tw = *(const LAS f32x4*)(sc + j), ta = *(const LAS f32x4*)(sc + 64 + j);
                dw += tw.x * w2[(size_t)(j + 0) * 512 + ch] + tw.y * w2[(size_t)(j + 1) * 512 + ch] + tw.z * w2[(size_t)(j + 2) * 512 + ch] + tw.w * w2[(size_t)(j + 3) * 512 + ch];
                da += ta.x * a2[(size_t)(j + 0) * 512 + ch] + ta.y * a2[(size_t)(j + 1) * 512 + ch] + ta.z * a2[(size_t)(j + 2) * 512 + ch] + ta.w * a2[(size_t)(j + 3) * 512 + ch];
            }
#pragma unroll 4
            for (int j = 0; j < 128; j += 4) {
                const f32x4 tg = *(const LAS f32x4*)(sc + 128 + j);
                dg += tg.x * g2[(size_t)(j + 0) * 512 + ch] + tg.y * g2[(size_t)(j + 1) * 512 + ch] + tg.z * g2[(size_t)(j + 2) * 512 + ch] + tg.w * g2[(size_t)(j + 3) * 512 + ch];
            }
            const float rr = bf2f(pr[C_R + ch]), kk0 = bf2f(pr[C_K + ch]), vv = bf2f(pr[C_V + ch]);
            const float rp = hp ? bf2f(pp[C_R + ch]) : 0.f, kp = hp ? bf2f(pp[C_K + ch]) : 0.f, vp = hp ? bf2f(pp[C_V + ch]) : 0.f;
            const float r1 = rr + (rp - rr) * mu_rkv[ch], k1 = kk0 + (kp - kk0) * mu_rkv[512 + ch]; float v1 = vv + (vp - vv) * mu_rkv[1024 + ch];
            if (e == 1) {
                dv = v0[ch];
#pragma unroll 4
                for (int j = 0; j < 32; j += 4) {
                    const f32x4 tv = *(const LAS f32x4*)(sc + 256 + j);
                    dv += tv.x * v2[(size_t)(j + 0) * 512 + ch] + tv.y * v2[(size_t)(j + 1) * 512 + ch] + tv.z * v2[(size_t)(j + 2) * 512 + ch] + tv.w * v2[(size_t)(j + 3) * 512 + ch];
                }
                const float vf = VF[(size_t)m * 512 + ch]; v1 = v1 + (vf - v1) * sigmoidf_(dv);
            } else VF[(size_t)m * 512 + ch] = v1;
            const float decay = __expf(-0.6065306597126334f * sigmoidf_(dw));
            const float ic = sigmoidf_(da);
            float kkv = k1 * k_k[ch]; const float ss = wave_sum(kkv * kkv); kkv *= rsqrtf(fmaxf(ss, 1e-12f));
            const float kmod = k1 * (1.0f + (ic - 1.0f) * k_a[ch]);
            const float bon = wave_sum(r1 * kmod * r_k[ch]);
            float* so = SIN + ((size_t)(b * 8 + hh) * TT + t) * 384;
            so[lane] = r1; so[64 + lane] = decay; so[128 + lane] = kmod; so[192 + lane] = kkv; so[256 + lane] = ic * kkv; so[320 + lane] = v1;
            GATE[(size_t)m * 512 + ch] = dg;
            if (lane == 0) BON[m * 8 + hh] = bon;
        }
        LDS_WAIT(); asm volatile("" ::: "memory");
    }
    { bf16_t* QA = (bf16_t*)(ws + WS_QA); const bf16_t* WkB = (const bf16_t*)(ws + W_WKB) + (size_t)e * 8 * 128 * 64;
      const int ntile = (NT / 64) * 2 * 8;
      for (int tI = F.gw; tI < ntile; tI += F.ngw) {
          const int hh = tI & 7, nt = (tI >> 3) & 1, mt = tI >> 4;
          EpiStoreBf16 E{QA + hh * 128, 1024, nt * 64, nt * 64 + 32};
          sg_tile(proj + C_QB + hh * 64, NCOL, WkB + (size_t)hh * 128 * 64 + (size_t)(nt * 64) * 64, WkB + (size_t)hh * 128 * 64 + (size_t)(nt * 64 + 32) * 64, 64, 64, mt * 64, E, F.lane);
      } }
}

__device__ __forceinline__ float allred16(float x) {
    x += __builtin_bit_cast(float, __builtin_amdgcn_update_dpp(0, __builtin_bit_cast(int, x), 0x128, 0xf, 0xf, false));
    x += __builtin_bit_cast(float, __builtin_amdgcn_update_dpp(0, __builtin_bit_cast(int, x), 0x124, 0xf, 0xf, false));
    x += __builtin_bit_cast(float, __builtin_amdgcn_update_dpp(0, __builtin_bit_cast(int, x), 0x122, 0xf, 0xf, false));
    x += __builtin_bit_cast(float, __builtin_amdgcn_update_dpp(0, __builtin_bit_cast(int, x), 0x121, 0xf, 0xf, false));
    return x;
}
__device__ __forceinline__ void ph_scan(Frame& F) {
    PHASE_PIN(F);
    if (F.wave != 0) return;
    const int lane = F.lane, i = lane >> 4, kq = lane & 15;
    for (int task = blockIdx.x; task < 256; task += gridDim.x) {
        const int bh = task >> 4, rg = task & 15, row = 4 * rg + i, b = bh >> 3, hh = bh & 7;
        const float* sin = (const float*)(F.ws + WS_SIN) + (size_t)bh * TT * 384;
        float* Y = (float*)(F.ws + WS_Y) + (size_t)b * TT * 512 + hh * 64 + row;
        f32x4 R[8], W[8], K[8], KK[8], B[8]; float V[8];
#pragma unroll
        for (int j = 0; j < 8; ++j) { const float* p = sin + (size_t)j * 384; R[j] = *(const f32x4*)(p + 4 * kq); W[j] = *(const f32x4*)(p + 64 + 4 * kq); K[j] = *(const f32x4*)(p + 128 + 4 * kq);
            KK[j] = *(const f32x4*)(p + 192 + 4 * kq); B[j] = *(const f32x4*)(p + 256 + 4 * kq); V[j] = p[320 + row]; }
        float s0 = 0.f, s1 = 0.f, s2 = 0.f, s3 = 0.f;
        for (int t0 = 0; t0 < TT; t0 += 8) {
#pragma unroll
            for (int j = 0; j < 8; ++j) {
                float p = s0 * KK[j].x + s1 * KK[j].y + s2 * KK[j].z + s3 * KK[j].w; p = allred16(p);
                s0 = s0 * W[j].x - p * B[j].x + V[j] * K[j].x; s1 = s1 * W[j].y - p * B[j].y + V[j] * K[j].y;
                s2 = s2 * W[j].z - p * B[j].z + V[j] * K[j].z; s3 = s3 * W[j].w - p * B[j].w + V[j] * K[j].w;
                float y = s0 * R[j].x + s1 * R[j].y + s2 * R[j].z + s3 * R[j].w; y = allred16(y);
                if (kq == 0) Y[(size_t)(t0 + j) * 512] = y;
                if (t0 + j + 8 < TT) { const float* p2 = sin + (size_t)(t0 + j + 8) * 384; R[j] = *(const f32x4*)(p2 + 4 * kq); W[j] = *(const f32x4*)(p2 + 64 + 4 * kq); K[j] = *(const f32x4*)(p2 + 128 + 4 * kq);
                    KK[j] = *(const f32x4*)(p2 + 192 + 4 * kq); B[j] = *(const f32x4*)(p2 + 256 + 4 * kq); V[j] = p2[320 + row]; }
            }
        }
    }
}

__device__ __forceinline__ size_t score_row_off(int b, int t) { const int j = t >> 7; return (size_t)b * SCORE_PER_BATCH + (size_t)16384 * (j * (j + 1) / 2) + (size_t)(t & 127) * (128 * (j + 1)); }
__device__ __forceinline__ void ph_idx_score(Frame& F) {
    PHASE_PIN(F);
    const int lane = F.lane, r = lane & 31, h = lane >> 5;
    const bf16_t* QI = (const bf16_t*)(F.ws + WS_QI); const bf16_t* KI = (const bf16_t*)(F.ws + WS_KI); const unsigned* SGN = (const unsigned*)(F.ws + SM_SGN);
    float* SC = (float*)(F.ws + WS_SCORE);
    for (int it = F.gw; it < 4352; it += F.ngw) {
        const int b = it / 2176; int i = it - b * 2176; i = 2175 - i;
        int a = 1; while (8 * a * (a + 1) <= i) ++a;
        const int rem = i - 8 * a * (a - 1), qt = 16 * (a - 1) + rem / a, g = rem % a;
        const int mq = b * TT + qt * 32 + r;
        bf16x8 qf[8][4];
#pragma unroll
        for (int hh = 0; hh < 8; ++hh)
#pragma unroll
            for (int ks = 0; ks < 4; ++ks) qf[hh][ks] = *(const bf16x8*)(QI + (size_t)mq * 512 + hh * 64 + ks * 16 + 8 * h);
        const unsigned sg = SGN[mq];
        float* srow = SC + score_row_off(b, qt * 32 + r);
        const int kt_end = (16 * g + 15 < qt) ? 16 * g + 15 : qt;
        for (int kt = 16 * g; kt <= kt_end; ++kt) {
            const bf16_t* kp = KI + (size_t)(b * TT + kt * 32 + r) * 64 + 8 * h;
            const bf16x8 kf0 = *(const bf16x8*)(kp), kf1 = *(const bf16x8*)(kp + 16), kf2 = *(const bf16x8*)(kp + 32), kf3 = *(const bf16x8*)(kp + 48);
            float sc[16];
#pragma unroll
            for (int q = 0; q < 16; ++q) sc[q] = 0.f;
#pragma unroll
            for (int hh = 0; hh < 8; ++hh) {
                f32x16 acc;
#pragma unroll
                for (int q = 0; q < 16; ++q) acc[q] = 0.f;
                acc = MFMA32(kf0, qf[hh][0], acc); acc = MFMA32(kf1, qf[hh][1], acc); acc = MFMA32(kf2, qf[hh][2], acc); acc = MFMA32(kf3, qf[hh][3], acc);
                const bool neg = (sg >> hh) & 1u;
#pragma unroll
                for (int q = 0; q < 16; ++q) { const float v = fmaxf(acc[q], 0.f); sc[q] = neg ? sc[q] - v : sc[q] + v; }
            }
#pragma unroll
            for (int g4 = 0; g4 < 4; ++g4) *(f32x4*)(srow + kt * 32 + 8 * g4 + 4 * h) = (f32x4){sc[4 * g4], sc[4 * g4 + 1], sc[4 * g4 + 2], sc[4 * g4 + 3]};
        }
    }
}
__device__ __forceinline__ unsigned block_excl_scan(unsigned v, LAS unsigned* scr, int tid, unsigned* total) {
    const int lane = tid & 63, w = tid >> 6; unsigned x = v;
#pragma unroll
    for (int o = 1; o < 64; o <<= 1) { const unsigned y = __shfl_up(x, o); if (lane >= o) x += y; }
    __syncthreads();
    if (lane == 63) scr[w] = x;
    __syncthreads();
    unsigned base = 0, tot = 0;
#pragma unroll
    for (int j = 0; j < 8; ++j) { const unsigned c = scr[j]; if (j < w) base += c; tot += c; }
    *total = tot;
    return base + x - v;
}
__device__ __forceinline__ void ph_idx_select(Frame& F) {
    PHASE_PIN(F);
    const int tid = F.tid; LAS unsigned* hist = (LAS unsigned*)F.lds; LAS unsigned* misc = hist + 256;
    const float* SC = (const float*)(F.ws + WS_SCORE); int* SEL = (int*)(F.ws + WS_SEL);
    for (int m = blockIdx.x; m < NT; m += gridDim.x) {
        const int t = m & (TT - 1), b = m >> 13, n = t + 1; int* sel = SEL + (size_t)m * 256;
        if (n <= 256) { if (tid < 256) sel[tid] = tid < n ? tid : -1; continue; }
        const float* srow = SC + score_row_off(b, t);
        unsigned key[16];
#pragma unroll
        for (int j = 0; j < 4; ++j) {
            const int idx0 = 4 * (tid + 512 * j);
            if (idx0 < n) { const f32x4 v = *(const f32x4*)(srow + idx0);
#pragma unroll
                for (int i = 0; i < 4; ++i) { const unsigned u = __float_as_uint(v[i]); key[4 * j + i] = (idx0 + i < n) ? ((u & 0x80000000u) ? ~u : (u | 0x80000000u)) : 0u; } }
            else {
#pragma unroll
                for (int i = 0; i < 4; ++i) key[4 * j + i] = 0u; }
        }
        unsigned prefix = 0, mask = 0, need = 256;
#pragma unroll 1
        for (int pass = 0; pass < 4; ++pass) {
            const int shift = 24 - 8 * pass;
            __syncthreads();
            if (tid < 256) hist[tid] = 0;
            __syncthreads();
#pragma unroll
            for (int q = 0; q < 16; ++q) { const int idx = 4 * (tid + 512 * (q >> 2)) + (q & 3); if (idx < n && (key[q] & mask) == prefix) __hip_atomic_fetch_add(&hist[(key[q] >> shift) & 255u], 1u, __ATOMIC_RELAXED, __HIP_MEMORY_SCOPE_WORKGROUP); }
            __syncthreads();
            if (tid < 64) {
                unsigned hv[4], L = 0;
#pragma unroll
                for (int i = 0; i < 4; ++i) { hv[i] = hist[255 - 4 * tid - i]; L += hv[i]; }
                unsigned x = L;
#pragma unroll
                for (int o = 1; o < 64; o <<= 1) { const unsigned y = __shfl_up(x, o); if (tid >= o) x += y; }
                unsigned run = x - L;
#pragma unroll
                for (int i = 0; i < 4; ++i) { if (run < need && need <= run + hv[i]) { misc[16] = 255 - 4 * tid - i; misc[17] = need - run; } run += hv[i]; }
            }
            __syncthreads();
            prefix |= misc[16] << shift; mask |= 255u << shift; need = misc[17];
        }
        unsigned basegt = 0, baseeq = 0; const unsigned ngt = 256 - need;
#pragma unroll
        for (int j = 0; j < 4; ++j) {
            unsigned cg = 0, ce = 0;
#pragma unroll
            for (int i = 0; i < 4; ++i) { const int idx = 4 * (tid + 512 * j) + i; if (idx < n) { cg += key[4 * j + i] > prefix; ce += key[4 * j + i] == prefix; } }
            unsigned tot; const unsigned ex = block_excl_scan(cg | (ce << 16), misc, tid, &tot);
            unsigned pg = basegt + (ex & 0xffffu), pe = baseeq + (ex >> 16);
#pragma unroll
            for (int i = 0; i < 4; ++i) { const int idx = 4 * (tid + 512 * j) + i; if (idx < n) {
                if (key[4 * j + i] > prefix) { sel[pg] = idx; ++pg; }
                else if (key[4 * j + i] == prefix) { if (pe < need) sel[ngt + pe] = idx; ++pe; } } }
            basegt += tot & 0xffffu; baseeq += tot >> 16;
        }
    }
    __syncthreads();
}

__device__ __forceinline__ void ph_sparse(Frame& F, const Args& A, int e) {
    PHASE_PIN(F);
    const int lane = F.lane; unsigned char* ws = F.ws;
    LAS float* qs = (LAS float*)(F.lds + F.wave * LDS_WSCR);
    LAS float* ps = qs + 1024;
    LAS float* cs = ps + 2048;
    const bf16_t* QA = (const bf16_t*)(ws + WS_QA); const bf16_t* CN = (const bf16_t*)(ws + WS_CN); const int* SEL = (const int*)(ws + WS_SEL);
    const float* Wkv = A.in[24] + (size_t)e * 128 * 1024;
    bf16_t* YC = (bf16_t*)(ws + WS_YCAT);
    const float* ln_g = A.in[17] + e * 512; const float* ln_b = A.in[18] + e * 512;
    const float* Yr = (const float*)(ws + WS_Y); const float* GATE = (const float*)(ws + WS_GATE); const float* BON = (const float*)(ws + SM_BONUS); const float* SIN = (const float*)(ws + WS_SIN);
    for (int m = F.gw; m < NT; m += F.ngw) {
        const int t = m & (TT - 1), b = m >> 13;
#pragma unroll 1
        for (int hh = 0; hh < 8; ++hh) {
            const int ch = hh * 64 + lane; const float y = Yr[(size_t)m * 512 + ch];
            const float mean = wave_sum(y) * (1.f / 64.f); const float yc = y - mean; const float var = wave_sum(yc * yc) * (1.f / 64.f);
            const float v1 = SIN[((size_t)(b * 8 + hh) * TT + t) * 384 + 320 + lane];
            const float o = (yc * rsqrtf(var + GN_EPS) * ln_g[ch] + ln_b[ch] + BON[m * 8 + hh] * v1) * GATE[(size_t)m * 512 + ch];
            YC[(size_t)m * 1024 + ch] = (bf16_t)f2bf(o);
        }
        const bf16_t* qa = QA + (size_t)m * 1024;
#pragma unroll
        for (int i = 0; i < 16; ++i) qs[lane + 64 * i] = bf2f(qa[lane + 64 * i]);
        int sj[4]; float lg[4][8];
#pragma unroll
        for (int i = 0; i < 4; ++i) sj[i] = SEL[(size_t)m * 256 + lane + 64 * i];
        LDS_WAIT(); asm volatile("" ::: "memory");
#pragma unroll
        for (int i = 0; i < 4; ++i) {
            const int s = sj[i] < 0 ? 0 : sj[i];
            const bf16_t* crow = CN + (size_t)(b * TT + s) * 128;
            float acc[8];
#pragma unroll
            for (int hh = 0; hh < 8; ++hh) acc[hh] = 0.f;
#pragma unroll 2
            for (int r8 = 0; r8 < 128; r8 += 8) {
                const u32x4 cw = *(const u32x4*)(crow + r8);
                float cf[8]; cf[0] = __uint_as_float(cw.x << 16); cf[1] = __uint_as_float(cw.x & 0xffff0000u); cf[2] = __uint_as_float(cw.y << 16); cf[3] = __uint_as_float(cw.y & 0xffff0000u);
                cf[4] = __uint_as_float(cw.z << 16); cf[5] = __uint_as_float(cw.z & 0xffff0000u); cf[6] = __uint_as_float(cw.w << 16); cf[7] = __uint_as_float(cw.w & 0xffff0000u);
#pragma unroll
                for (int hh = 0; hh < 8; ++hh) { const f32x4 q0 = *(const LAS f32x4*)(qs + hh * 128 + r8), q1 = *(const LAS f32x4*)(qs + hh * 128 + r8 + 4);
                    acc[hh] += cf[0] * q0.x + cf[1] * q0.y + cf[2] * q0.z + cf[3] * q0.w + cf[4] * q1.x + cf[5] * q1.y + cf[6] * q1.z + cf[7] * q1.w; }
            }
#pragma unroll
            for (int hh = 0; hh < 8; ++hh) lg[i][hh] = sj[i] < 0 ? -INFINITY : acc[hh] * 0.125f;
        }
#pragma unroll
        for (int hh = 0; hh < 8; ++hh) {
            float mx = fmaxf(fmaxf(lg[0][hh], lg[1][hh]), fmaxf(lg[2][hh], lg[3][hh])); mx = wave_max(mx);
            float p0 = __expf(lg[0][hh] - mx), p1 = __expf(lg[1][hh] - mx), p2 = __expf(lg[2][hh] - mx), p3 = __expf(lg[3][hh] - mx);
            const float inv = 1.0f / wave_sum(p0 + p1 + p2 + p3);
            ps[(lane) * 8 + hh] = p0 * inv; ps[(lane + 64) * 8 + hh] = p1 * inv; ps[(lane + 128) * 8 + hh] = p2 * inv; ps[(lane + 192) * 8 + hh] = p3 * inv;
        }
        LDS_WAIT(); asm volatile("" ::: "memory");
        float c0[8], c1[8];
#pragma unroll
        for (int hh = 0; hh < 8; ++hh) { c0[hh] = 0.f; c1[hh] = 0.f; }
#pragma unroll
        for (int i = 0; i < 4; ++i) {
#pragma unroll 1
        for (int jj = 0; jj < 64; ++jj) {
            const int j = i * 64 + jj;
            int s = __shfl(sj[i], jj); if (s < 0) s = 0;
            const bf16_t* crow = CN + (size_t)(b * TT + s) * 128;
            const float x0 = bf2f(crow[lane]), x1 = bf2f(crow[64 + lane]);
            const f32x4 pa = *(const LAS f32x4*)(ps + j * 8), pb = *(const LAS f32x4*)(ps + j * 8 + 4);
            c0[0] += pa.x * x0; c0[1] += pa.y * x0; c0[2] += pa.z * x0; c0[3] += pa.w * x0; c0[4] += pb.x * x0; c0[5] += pb.y * x0; c0[6] += pb.z * x0; c0[7] += pb.w * x0;
            c1[0] += pa.x * x1; c1[1] += pa.y * x1; c1[2] += pa.z * x1; c1[3] += pa.w * x1; c1[4] += pb.x * x1; c1[5] += pb.y * x1; c1[6] += pb.z * x1; c1[7] += pb.w * x1;
        } }
#pragma unroll
        for (int hh = 0; hh < 8; ++hh) { cs[hh * 128 + lane] = c0[hh]; cs[hh * 128 + 64 + lane] = c1[hh]; }
        LDS_WAIT(); asm volatile("" ::: "memory");
#pragma unroll 1
        for (int hh = 0; hh < 8; ++hh) {
            float o = 0.f; const float* wv = Wkv + 512 + hh * 64 + lane;
#pragma unroll 4
            for (int r4 = 0; r4 < 128; r4 += 4) { const f32x4 cx = *(const LAS f32x4*)(cs + hh * 128 + r4);
                o += cx.x * wv[(size_t)(r4 + 0) * 1024] + cx.y * wv[(size_t)(r4 + 1) * 1024] + cx.z * wv[(size_t)(r4 + 2) * 1024] + cx.w * wv[(size_t)(r4 + 3) * 1024]; }
            YC[(size_t)m * 1024 + 512 + hh * 64 + lane] = (bf16_t)f2bf(o);
        }
        LDS_WAIT(); asm volatile("" ::: "memory");
    }
}

__device__ __forceinline__ void ph_stickbreak(Frame& F) {
    PHASE_PIN(F);
    const int lane = F.lane; unsigned char* ws = F.ws;
    LAS float* qs = (LAS float*)(F.lds + F.wave * LDS_WSCR);
    LAS float* wsd = qs + 64;
    const bf16_t* Q = (const bf16_t*)(ws + WS_PROJ); const bf16_t* Kb = Q + (size_t)NT * 1024; const bf16_t* Vb = Kb + (size_t)NT * 1024;
    bf16_t* YC = (bf16_t*)(ws + WS_YCAT);
    for (int it = F.gw; it < NT * 16; it += F.ngw) {
        const int hh = it & 15, m = it >> 4, t = m & (TT - 1), b = m >> 13;
        qs[lane] = bf2f(Q[(size_t)m * 1024 + hh * 64 + lane]);
        LDS_WAIT(); asm volatile("" ::: "memory");
        float o = 0.f, P = 1.0f;
        for (int c0 = t - 1; c0 >= 0; c0 -= 64) {
            const int s = c0 - lane; const bool valid = s >= 0;
            float z = 0.f;
            if (valid) { const bf16_t* kr = Kb + (size_t)(b * TT + s) * 1024 + hh * 64;
#pragma unroll
                for (int d8 = 0; d8 < 64; d8 += 8) { const u32x4 kw = *(const u32x4*)(kr + d8); const f32x4 q0 = *(const LAS f32x4*)(qs + d8), q1 = *(const LAS f32x4*)(qs + d8 + 4);
                    z += __uint_as_float(kw.x << 16) * q0.x + __uint_as_float(kw.x & 0xffff0000u) * q0.y + __uint_as_float(kw.y << 16) * q0.z + __uint_as_float(kw.y & 0xffff0000u) * q0.w
                       + __uint_as_float(kw.z << 16) * q1.x + __uint_as_float(kw.z & 0xffff0000u) * q1.y + __uint_as_float(kw.w << 16) * q1.z + __uint_as_float(kw.w & 0xffff0000u) * q1.w; } }
            const float ez = exp2f(z); const float keep = valid ? 1.0f / (1.0f + ez) : 1.0f; const float beta = valid ? 1.0f - keep : 0.f;
            float x = keep;
#pragma unroll
            for (int of = 1; of < 64; of <<= 1) { const float y = __shfl_up(x, of); if (lane >= of) x *= y; }
            float ex = __shfl_up(x, 1); if (lane == 0) ex = 1.0f;
            wsd[lane] = beta * ex * P;
            P *= __shfl(x, 63);
            LDS_WAIT(); asm volatile("" ::: "memory");
            const int nk = (c0 + 1 < 64) ? c0 + 1 : 64;
            for (int j = 0; j < nk; ++j) o += wsd[j] * bf2f(Vb[(size_t)(b * TT + c0 - j) * 1024 + hh * 64 + lane]);
            LDS_WAIT(); asm volatile("" ::: "memory");
            if (P < 1e-30f) break;
        }
        YC[(size_t)m * 1024 + hh * 64 + lane] = (bf16_t)f2bf(o);
    }
}

__device__ __forceinline__ void ph_moe_route(Frame& F, const Args& A, int l) {
    PHASE_PIN(F);
    const int lane = F.lane; unsigned char* ws = F.ws;
    const float* X = (const float*)(ws + WS_X); bf16_t* XB = (bf16_t*)(ws + WS_XB);
    const float* g = A.in[29] + l * DM; const float* Wg = A.in[30] + (size_t)l * DM * 4; const float* We = A.in[31] + (size_t)l * 4 * DM * 8;
    int* EIDX = (int*)(ws + SM_EIDX); float* GATEV = (float*)(ws + SM_GATE); int* SLOT = (int*)(ws + SM_SLOT);
    unsigned* cnt = (unsigned*)(ws + WS_CTL) + CW_CNT + 64 * l;
    for (int m = F.gw; m < NT; m += F.ngw) {
        const f32x4* xr = (const f32x4*)(X + (size_t)m * DM) + lane; f32x4 v[4]; float s = 0.f;
#pragma unroll
        for (int j = 0; j < 4; ++j) { v[j] = xr[64 * j]; s += (v[j].x * v[j].x + v[j].y * v[j].y) + (v[j].z * v[j].z + v[j].w * v[j].w); }
        const float rstd = rsqrtf(wave_sum(s) * (1.f / DM) + RMS_EPS);
        u32x2* o8 = (u32x2*)(XB + (size_t)m * DM) + lane;
#pragma unroll
        for (int j = 0; j < 4; ++j) { u32x2 w; w.x = pk2(v[j].x * rstd, v[j].y * rstd); w.y = pk2(v[j].z * rstd, v[j].w * rstd); o8[64 * j] = w; }
#pragma unroll
        for (int j = 0; j < 4; ++j) { const f32x4 gg = *((const f32x4*)g + lane + 64 * j); v[j] = v[j] * gg * rstd; }
        float gl[4] = {0.f, 0.f, 0.f, 0.f};
#pragma unroll
        for (int j = 0; j < 4; ++j)
#pragma unroll
            for (int i = 0; i < 4; ++i) { const int k = 4 * (lane + 64 * j) + i; const f32x4 w = *(const f32x4*)(Wg + (size_t)k * 4); const float xv = v[j][i];
                gl[0] += xv * w.x; gl[1] += xv * w.y; gl[2] += xv * w.z; gl[3] += xv * w.w; }
#pragma unroll
        for (int q = 0; q < 4; ++q) gl[q] = wave_sum(gl[q]);
        int gs = 0; float gm = gl[0];
#pragma unroll
        for (int q = 1; q < 4; ++q) if (gl[q] > gm) { gm = gl[q]; gs = q; }
        float gden = 0.f;
#pragma unroll
        for (int q = 0; q < 4; ++q) gden += __expf(gl[q] - gm);
        const float g_gate = 1.0f / gden;
        const float* Wes = We + (size_t)gs * DM * 8;
        float el[8];
#pragma unroll
        for (int q = 0; q < 8; ++q) el[q] = 0.f;
#pragma unroll
        for (int j = 0; j < 4; ++j)
#pragma unroll
            for (int i = 0; i < 4; ++i) { const int k = 4 * (lane + 64 * j) + i; const f32x4 w0 = *(const f32x4*)(Wes + (size_t)k * 8), w1 = *(const f32x4*)(Wes + (size_t)k * 8 + 4); const float xv = v[j][i];
                el[0] += xv * w0.x; el[1] += xv * w0.y; el[2] += xv * w0.z; el[3] += xv * w0.w; el[4] += xv * w1.x; el[5] += xv * w1.y; el[6] += xv * w1.z; el[7] += xv * w1.w; }
#pragma unroll
        for (int q = 0; q < 8; ++q) el[q] = wave_sum(el[q]);
        int i1 = 0; float m1 = el[0];
#pragma unroll
        for (int q = 1; q < 8; ++q) if (el[q] > m1) { m1 = el[q]; i1 = q; }
        int i2 = -1; float m2 = -INFINITY;
#pragma unroll
        for (int q = 0; q < 8; ++q) if (q != i1 && el[q] > m2) { m2 = el[q]; i2 = q; }
        const float e2 = __expf(m2 - m1); const float ga = g_gate / (1.0f + e2), gb = g_gate * e2 / (1.0f + e2);
        if (lane == 0) {
            const int ea = gs * 8 + i1, eb = gs * 8 + i2;
            const unsigned sa = atomicAdd(&cnt[ea], 1u), sb = atomicAdd(&cnt[eb], 1u);
            EIDX[2 * m] = ea; EIDX[2 * m + 1] = eb; GATEV[2 * m] = ga; GATEV[2 * m + 1] = gb; SLOT[2 * m] = (int)sa; SLOT[2 * m + 1] = (int)sb;
        }
    }
}
__device__ __forceinline__ int moe_offsets(const unsigned* cnt, int lane, int* total, int* mycnt_pad) {
    const unsigned c = lane < 32 ? __hip_atomic_load(cnt + (lane & 31), __ATOMIC_RELAXED, __HIP_MEMORY_SCOPE_AGENT) : 0u; const int p = (int)((c + 255u) & ~255u);
    int x = p;
#pragma unroll
    for (int o = 1; o < 64; o <<= 1) { const int y = __shfl_up(x, o); if (lane >= o) x += y; }
    *total = __shfl(x, 63); *mycnt_pad = p;
    return x - p;
}
__device__ __forceinline__ void ph_moe_gather(Frame& F, int l) {
    PHASE_PIN(F);
    const int lane = F.lane; unsigned char* ws = F.ws;
    const unsigned* cnt = (const unsigned*)(ws + WS_CTL) + CW_CNT + 64 * l; int total, pad; const int off = moe_offsets(cnt, lane, &total, &pad);
    const int* EIDX = (const int*)(ws + SM_EIDX); const int* SLOT = (const int*)(ws + SM_SLOT);
    const bf16_t* XB = (const bf16_t*)(ws + WS_XB); bf16_t* AM = (bf16_t*)(ws + WS_AMOE);
    for (int a = F.gw; a < NT * 2; a += F.ngw) {
        const int m = a >> 1, e = EIDX[a], row = __shfl(off, e) + SLOT[a];
        const u32x4* src = (const u32x4*)(XB + (size_t)m * DM); u32x4* dst = (u32x4*)(AM + (size_t)row * DM);
        dst[lane] = src[lane]; dst[lane + 64] = src[lane + 64];
    }
}
__device__ __forceinline__ void ph_moe_gemm1(Frame& F, int l) {
    PHASE_PIN(F);
    const int lane = F.lane; unsigned char* ws = F.ws;
    const unsigned* cnt = (const unsigned*)(ws + WS_CTL) + CW_CNT + 64 * l; int total, pad; const int off = moe_offsets(cnt, lane, &total, &pad);
    const int endo = off + pad;
    const bf16_t* AM = (const bf16_t*)(ws + WS_AMOE); const bf16_t* W13T = (const bf16_t*)(ws + WS_W13T); bf16_t* H = (bf16_t*)(ws + WS_H);
    const int ntile = (total / 64) * 16;
    for (int tI = F.gw; tI < ntile; tI += F.ngw) {
        const int nt = tI & 15, rt = tI >> 4, row0 = rt * 64;
        const int e = __popcll(__ballot(lane < 32 && endo <= row0));
        const int j = nt >> 2, i = nt & 3, n0 = 256 * j + 32 * i;
        EpiGated E{H, 128 * j + 32 * i};
        sg_tile(AM, DM, W13T + (size_t)(e * 1024 + n0) * DM, W13T + (size_t)(e * 1024 + n0 + 128) * DM, DM, DM, row0, E, lane);
    }
}
__device__ __forceinline__ void ph_moe_gemm2(Frame& F, int l) {
    PHASE_PIN(F);
    const int lane = F.lane; unsigned char* ws = F.ws;
    const unsigned* cnt = (const unsigned*)(ws + WS_CTL) + CW_CNT + 64 * l; int total, pad; const int off = moe_offsets(cnt, lane, &total, &pad);
    const int endo = off + pad;
    const bf16_t* H = (const bf16_t*)(ws + WS_H); const bf16_t* W2T = (const bf16_t*)(ws + WS_W2T); bf16_t* YM = (bf16_t*)(ws + WS_YM);
    const int ntile = (total / 64) * 16;
    for (int tI = F.gw; tI < ntile; tI += F.ngw) {
        const int nt = tI & 15, rt = tI >> 4, row0 = rt * 64;
        const int e = __popcll(__ballot(lane < 32 && endo <= row0));
        EpiStoreBf16 E{YM, DM, nt * 64, nt * 64 + 32};
        sg_tile(H, 512, W2T + (size_t)(e * 1024 + nt * 64) * 512, W2T + (size_t)(e * 1024 + nt * 64 + 32) * 512, 512, 512, row0, E, lane);
    }
}
__device__ __forceinline__ void ph_moe_combine(Frame& F, const Args& A, int l) {
    PHASE_PIN(F);
    const int lane = F.lane; unsigned char* ws = F.ws;
    const unsigned* cnt = (const unsigned*)(ws + WS_CTL) + CW_CNT + 64 * l; int total, pad; const int off = moe_offsets(cnt, lane, &total, &pad);
    const int* EIDX = (const int*)(ws + SM_EIDX); const int* SLOT = (const int*)(ws + SM_SLOT); const float* GATEV = (const float*)(ws + SM_GATE);
    float* X = (float*)(ws + WS_X); bf16_t* XB = (bf16_t*)(ws + WS_XB); const bf16_t* YM = (const bf16_t*)(ws + WS_YM);
    const float* fg = A.in[35];
    for (int m = F.gw; m < NT; m += F.ngw) {
        const int ea = EIDX[2 * m], eb = EIDX[2 * m + 1]; const float ga = GATEV[2 * m], gb = GATEV[2 * m + 1];
        const int ra = __shfl(off, ea) + SLOT[2 * m], rb = __shfl(off, eb) + SLOT[2 * m + 1];
        f32x4* xr = (f32x4*)(X + (size_t)m * DM) + lane; const u32x2* ya = (const u32x2*)(YM + (size_t)ra * DM) + lane; const u32x2* yb = (const u32x2*)(YM + (size_t)rb * DM) + lane;
        f32x4 v[4]; float s = 0.f;
#pragma unroll
        for (int j = 0; j < 4; ++j) { v[j] = xr[64 * j]; const u32x2 a = ya[64 * j], bq = yb[64 * j];
            v[j].x += ga * __uint_as_float(a.x << 16) + gb * __uint_as_float(bq.x << 16); v[j].y += ga * __uint_as_float(a.x & 0xffff0000u) + gb * __uint_as_float(bq.x & 0xffff0000u);
            v[j].z += ga * __uint_as_float(a.y << 16) + gb * __uint_as_float(bq.y << 16); v[j].w += ga * __uint_as_float(a.y & 0xffff0000u) + gb * __uint_as_float(bq.y & 0xffff0000u);
            s += (v[j].x * v[j].x + v[j].y * v[j].y) + (v[j].z * v[j].z + v[j].w * v[j].w); }
        const float rstd = rsqrtf(wave_sum(s) * (1.f / DM) + RMS_EPS);
        if (l < 3) {
            u32x2* o8 = (u32x2*)(XB + (size_t)m * DM) + lane;
#pragma unroll
            for (int j = 0; j < 4; ++j) { xr[64 * j] = v[j]; u32x2 w; w.x = pk2(v[j].x * rstd, v[j].y * rstd); w.y = pk2(v[j].z * rstd, v[j].w * rstd); o8[64 * j] = w; }
        } else {
            f32x4* orow = (f32x4*)(F.out + (size_t)m * DM) + lane;
#pragma unroll
            for (int j = 0; j < 4; ++j) { const f32x4 gg = *((const f32x4*)fg + lane + 64 * j); orow[64 * j] = v[j] * gg * rstd; }
        }
    }
}

__global__ void __launch_bounds__(NTHR, 2) fwd_kernel(Args args) {
    extern __shared__ __attribute__((aligned(16))) unsigned char lds_raw[];
    Frame F; F.lds = (LAS unsigned char*)lds_raw; F.tid = threadIdx.x; F.lane = F.tid & 63; F.wave = __builtin_amdgcn_readfirstlane(F.tid >> 6);
    F.gw = blockIdx.x * NWAVES + F.wave; F.ngw = gridDim.x * NWAVES; F.out = args.out; F.ws = args.ws;
    volatile LAS unsigned* MISC = (volatile LAS unsigned*)(F.lds + LDS_MISC);
    if (F.tid < 64) MISC[F.tid] = 0u;
    __syncthreads();
    const int lo = args.ph_lo, hi = args.ph_hi;
    XcdBarrier bar; bar.bar = (unsigned*)(F.ws + WS_CTL) + CW_BAR; bar.x = 0; bar.st = MISC;
    if (hi - lo > 1) bar = xcd_barrier_post((unsigned*)(F.ws + WS_CTL) + CW_BAR, MISC);
#define IN(k) (lo <= (k) && (k) < hi)
#define SEAM(k) do { if ((k) + 1 < hi) xcd_barrier(bar); } while (0)
    unsigned char* ws = F.ws;
    if (IN(0)) { ph_prologue(F, args); SEAM(0); }
    for (int l = 0; l < 4; ++l) {
        const int pb = 1 + 16 * l, e = l >> 1;
        const float* xsrc = (l == 0) ? args.in[0] : (const float*)(ws + WS_X);
        if ((l & 1) == 0) {
            if (IN(pb + 0)) { sg_dense_bf16(F, (const bf16_t*)(ws + WS_XB), DM, (const bf16_t*)(ws + W_WIN) + (size_t)e * NCOL * DM, DM, NT, NCOL, (bf16_t*)(ws + WS_PROJ), NCOL); SEAM(pb + 0); }
            if (IN(pb + 1)) {
#ifndef NO_PREP
 ph_prep(F, args, e);
#endif
 SEAM(pb + 1); }
            if (IN(pb + 2)) {
#ifndef NO_SCAN
 ph_scan(F);
#endif
 SEAM(pb + 2); }
            if (IN(pb + 3)) {
#ifndef NO_SCORE
 ph_idx_score(F);
#endif
 SEAM(pb + 3); }
            if (IN(pb + 4)) {
#ifndef NO_SELECT
 ph_idx_select(F);
#endif
 SEAM(pb + 4); }
            if (IN(pb + 5)) {
#ifndef NO_SPARSE
 ph_sparse(F, args, e);
#endif
 SEAM(pb + 5); }
        } else {
            if (IN(pb + 0)) { sg_dense_bf16(F, (const bf16_t*)(ws + WS_XB), DM, (const bf16_t*)(ws + W_WQKV) + (size_t)e * 3072 * DM, DM, NT, 1024, (bf16_t*)(ws + WS_PROJ), 1024);
                              sg_dense_bf16(F, (const bf16_t*)(ws + WS_XB), DM, (const bf16_t*)(ws + W_WQKV) + (size_t)e * 3072 * DM + (size_t)1024 * DM, DM, NT, 1024, (bf16_t*)(ws + WS_PROJ) + (size_t)NT * 1024, 1024);
                              sg_dense_bf16(F, (const bf16_t*)(ws + WS_XB), DM, (const bf16_t*)(ws + W_WQKV) + (size_t)e * 3072 * DM + (size_t)2048 * DM, DM, NT, 1024, (bf16_t*)(ws + WS_PROJ) + (size_t)2 * NT * 1024, 1024);
                              SEAM(pb + 0); }
            if (IN(pb + 1)) {
#ifndef NO_SB
 ph_stickbreak(F);
#endif
 SEAM(pb + 1); }
        }
        if (IN(pb + 6)) { sg_dense_resid(F, (const bf16_t*)(ws + WS_YCAT), (const bf16_t*)(ws + ((l & 1) ? W_WOUTO : W_WOUTE)) + (size_t)e * DM * DM, xsrc, (float*)(ws + WS_X)); SEAM(pb + 6); }
        if (IN(pb + 7)) {
#ifndef NO_ROUTE
 ph_moe_route(F, args, l); moe_weight_prep(F, args, l);
#endif
 SEAM(pb + 7); }
        if (IN(pb + 8)) { ph_moe_gather(F, l); SEAM(pb + 8); }
        if (IN(pb + 9)) { ph_moe_gemm1(F, l); SEAM(pb + 9); }
        if (IN(pb + 10)) { ph_moe_gemm2(F, l); SEAM(pb + 10); }
        if (IN(pb + 11)) { ph_moe_combine(F, args, l); SEAM(pb + 11); }
    }
#undef IN
#undef SEAM
}

extern "C" void kernel_launch(void* const* d_in, const int* in_sizes, int n_in, void* d_out, int out_size, void* d_ws, size_t ws_size, hipStream_t stream) {
    static int grid = 0;
    if (grid == 0) {
        if (n_in != 36 || out_size != NT * DM || ws_size < WS_END) { fprintf(stderr, "kernel_launch: unexpected problem (n_in %d out %d ws %zu)\n", n_in, out_size, ws_size); grid = -1; return; }
        int dev = 0, cus = 0, per_cu = 0;
        if (hipGetDevice(&dev) != hipSuccess || hipDeviceGetAttribute(&cus, hipDeviceAttributeMultiprocessorCount, dev) != hipSuccess) { grid = -1; return; }
        if (hipFuncSetAttribute((const void*)fwd_kernel, hipFuncAttributeMaxDynamicSharedMemorySize, LDS_BYTES) != hipSuccess) { grid = -1; return; }
        if (hipOccupancyMaxActiveBlocksPerMultiprocessor(&per_cu, (const void*)fwd_kernel, NTHR, LDS_BYTES) != hipSuccess || per_cu < 1) { fprintf(stderr, "kernel_launch: occupancy query says %d\n", per_cu); }
        (void)hipGetLastError();
        grid = cus;
    }
    if (grid < 0) return;
    (void)hipMemsetAsync((char*)d_ws + WS_CTL, 0, CTL_ZERO_BYTES, stream);
    Args a{};
    for (int i = 0; i < 36; ++i) a.in[i] = (const float*)d_in[i];
    a.out = (float*)d_out; a.ws = (unsigned char*)d_ws;
#if ONE_LAUNCH
    a.ph_lo = 0; a.ph_hi = 65;
    hipLaunchKernelGGL(fwd_kernel, dim3(grid), dim3(NTHR), LDS_BYTES, stream, a);
#else
    for (int p = 0; p < 65; ++p) {
        const int l = (p - 1) >> 4, k = (p - 1) & 15;
        if (p > 0) { if (k > 11) continue; if ((l & 1) && k >= 2 && k <= 5) continue; }
        a.ph_lo = p; a.ph_hi = p + 1;
        hipLaunchKernelGGL(fwd_kernel, dim3(grid), dim3(NTHR), LDS_BYTES, stream, a);
    }
#endif
}
```

```cpp
#include <hip/hip_runtime.h>
#include <cstdio>
#include <cstdint>

#ifndef ONE_LAUNCH
#define ONE_LAUNCH 1
#endif

#define GAS __attribute__((address_space(1)))
#define LAS __attribute__((address_space(3)))
typedef unsigned short bf16_t;
typedef short bf16x8 __attribute__((ext_vector_type(8)));
typedef float f32x4 __attribute__((ext_vector_type(4)));
typedef float f32x2 __attribute__((ext_vector_type(2)));
typedef float f32x16 __attribute__((ext_vector_type(16)));
typedef unsigned u32x4 __attribute__((ext_vector_type(4)));
typedef unsigned u32x2 __attribute__((ext_vector_type(2)));

constexpr int NT = 16384, TT = 8192, DM = 1024, NB = 2;
constexpr int NCOL = 3584;
constexpr int C_R = 0, C_K = 512, C_V = 1024, C_QB = 1536, C_CKV = 2048, C_QI = 2176, C_KI = 2688, C_WI = 2752;
constexpr int C_PW = 2816, C_QW = 2880, C_PA = 2944, C_QA = 3008, C_PG = 3072, C_QG = 3200, C_PV = 3328, C_QV = 3360;
constexpr int NWAVES = 8, NTHR = 512;
constexpr float RMS_EPS = 1e-6f, GN_EPS = 64e-5f;
constexpr float LOG2E = 1.4426950408889634f;

constexpr size_t MiB = 1u << 20;
constexpr size_t WS_CTL = 0, CTL_ZERO_BYTES = 1 * MiB;
constexpr size_t WS_SMALL = 1 * MiB;
constexpr size_t SM_EIDX = WS_SMALL, SM_GATE = WS_SMALL + 128 * 1024, SM_SLOT = WS_SMALL + 256 * 1024, SM_BONUS = WS_SMALL + 512 * 1024, SM_SGN = WS_SMALL + 1024 * 1024;
constexpr size_t WS_W = 5 * MiB;
constexpr size_t W_WIN = WS_W, W_WOUTE = WS_W + 14 * MiB, W_WQKV = WS_W + 18 * MiB, W_WOUTO = WS_W + 30 * MiB, W_WKB = WS_W + 34 * MiB, W_WVT = W_WKB + 256 * 1024;
constexpr size_t WS_X = 45 * MiB, WS_XB = 109 * MiB, WS_PROJ = 141 * MiB, WS_SIN = 253 * MiB, WS_VF = 445 * MiB, WS_Y = 477 * MiB, WS_GATE = 509 * MiB, WS_YCAT = 541 * MiB;
constexpr size_t WS_CN = 573 * MiB, WS_KI = 577 * MiB, WS_QI = 579 * MiB, WS_QA = 595 * MiB, WS_SEL = 627 * MiB;
constexpr size_t WS_BIG = 645 * MiB;
constexpr size_t WS_SCORE = WS_BIG;
constexpr size_t WS_W13T = WS_BIG, WS_W2T = WS_BIG + 64 * MiB, WS_AMOE = WS_BIG + 96 * MiB, WS_H = WS_BIG + 176 * MiB, WS_YM = WS_BIG + 216 * MiB;
constexpr size_t WS_END = 941 * MiB;
constexpr size_t SCORE_PER_BATCH = (size_t)16384 * 2080;
static_assert(WS_SCORE + 2 * SCORE_PER_BATCH * 4 <= WS_END, "score map");
static_assert(WS_YM + (size_t)40960 * 1024 * 2 <= WS_END, "moe map");
constexpr int CW_BAR = 4096;
constexpr int CW_CNT = 16384;

constexpr int LDS_BYTES = 147456;
constexpr int LDS_WSCR = 16384;
constexpr int LDS_MISC = 131072;

__device__ __forceinline__ float bf2f(bf16_t b) { return __uint_as_float(((unsigned)b) << 16); }
__device__ __forceinline__ unsigned f2bf(float f) { unsigned u = __float_as_uint(f); return (u + 0x7fffu + ((u >> 16) & 1u)) >> 16; }
__device__ __forceinline__ unsigned pk2(float lo, float hi) { return f2bf(lo) | (f2bf(hi) << 16); }
__device__ __forceinline__ float wave_sum(float v) {
#pragma unroll
    for (int o = 1; o < 64; o <<= 1) v += __shfl_xor(v, o);
    return v;
}
__device__ __forceinline__ float wave_max(float v) {
#pragma unroll
    for (int o = 1; o < 64; o <<= 1) v = fmaxf(v, __shfl_xor(v, o));
    return v;
}
__device__ __forceinline__ float sigmoidf_(float x) { return 1.0f / (1.0f + __expf(-x)); }
#define LDS_WAIT() asm volatile("s_waitcnt lgkmcnt(0)" ::: "memory")

#define XB_TMO      128
#define XB_XCNT(j)  (256  + 64 * (j))
#define XB_XSUB(j)  (1280 + 64 * (j))
#define XB_XGEN(j)  (2304 + 64 * (j))
#define XB_TOP      3328
#define XB_TOPGEN   3392
#define XCD_BAR_WORDS 3456
#define XB_SPIN_CAP (1u << 18)
__device__ __forceinline__ unsigned xb_ld(unsigned* p)              { return __hip_atomic_load(p, __ATOMIC_RELAXED, __HIP_MEMORY_SCOPE_AGENT); }
__device__ __forceinline__ unsigned xb_add(unsigned* p, unsigned v) { return __hip_atomic_fetch_add(p, v, __ATOMIC_RELAXED, __HIP_MEMORY_SCOPE_AGENT); }
__device__ __forceinline__ unsigned xb_xcc_id() { return (unsigned)__builtin_amdgcn_s_getreg((3 << 11) | 20) & 0xFu; }
#define XB_SPIN(cond, bar) do { unsigned _sp = 0; while (cond) { __builtin_amdgcn_s_sleep(1); \
    if ((++_sp & 255u) == 0u) { if (xb_ld(&(bar)[XB_TMO])) break; if (_sp > XB_SPIN_CAP) { atomicAdd(&(bar)[XB_TMO], 1u); break; } } } } while (0)
struct XcdBarrier { unsigned* bar; unsigned x; volatile LAS unsigned* st; };
__device__ __forceinline__ XcdBarrier xcd_barrier_post(unsigned* bar, volatile LAS unsigned* st) {
    XcdBarrier b; b.bar = bar; b.x = xb_xcc_id(); b.st = st;
    if (threadIdx.x == 0) (void)xb_add(&bar[XB_XCNT(b.x)], 1u);
    return b;
}
__device__ __forceinline__ void xcd_barrier_complete(unsigned* bar, unsigned x, unsigned& nloc, unsigned& nx) {
    const unsigned G = gridDim.x * gridDim.y * gridDim.z;
    unsigned sum, cnt, mine, sp = 0u;
    for (;;) {
        sum = 0u; cnt = 0u; mine = 0u;
#pragma unroll
        for (unsigned j = 0; j < 16; ++j) { const unsigned c = xb_ld(&bar[XB_XCNT(j)]); sum += c; cnt += (c > 0u) ? 1u : 0u; mine = (j == x) ? c : mine; }
        if (sum == G) break;
        __builtin_amdgcn_s_sleep(1);
        if ((++sp & 255u) == 0u) { if (xb_ld(&bar[XB_TMO])) break; if (sp > XB_SPIN_CAP) { atomicAdd(&bar[XB_TMO], 1u); break; } }
    }
    nloc = mine > 0u ? mine : 1u; nx = cnt > 0u ? cnt : 1u;
}
__device__ __forceinline__ void xcd_barrier(const XcdBarrier& b) {
    asm volatile("s_waitcnt vmcnt(0)" ::: "memory");
    __syncthreads();
    if (threadIdx.x == 0) {
        unsigned* bar = b.bar;
        __builtin_amdgcn_s_waitcnt(0);
        unsigned nloc = b.st[0], nx = b.st[1];
        if (nloc == 0u) { xcd_barrier_complete(bar, b.x, nloc, nx); b.st[0] = nloc; b.st[1] = nx; }
        const unsigned old = xb_add(&bar[XB_XSUB(b.x)], 1u);
        const unsigned gen = old / nloc;
        if (old + 1u == (gen + 1u) * nloc) {
            __builtin_amdgcn_fence(__ATOMIC_RELEASE, "agent");
            asm volatile("s_waitcnt vmcnt(0)" ::: "memory");
            const unsigned og = xb_add(&bar[XB_TOP], 1u);
            const unsigned tg = og / nx;
            if (og + 1u == (tg + 1u) * nx) xb_add(&bar[XB_TOPGEN], 1u);
            else XB_SPIN(xb_ld(&bar[XB_TOPGEN]) == tg, bar);
            __builtin_amdgcn_fence(__ATOMIC_ACQUIRE, "agent");
            xb_add(&bar[XB_XGEN(b.x)], 1u);
            asm volatile("s_waitcnt vmcnt(0)" ::: "memory");
        } else {
            XB_SPIN(xb_ld(&bar[XB_XGEN(b.x)]) == gen, bar);
            __builtin_amdgcn_fence(__ATOMIC_ACQUIRE, "agent");
            asm volatile("s_waitcnt vmcnt(0)" ::: "memory");
        }
    }
    __syncthreads();
}

struct Args { const float* in[36]; float* out; unsigned char* ws; int ph_lo, ph_hi; };
struct Frame {
    LAS unsigned char* lds; int tid, lane, wave, gw, ngw;
    float* out; unsigned char* ws;
};

#define PHASE_PIN(F) do { unsigned long long _z64; int _z32; asm volatile("s_mov_b64 %0, 0\n\ts_mov_b32 %1, 0" : "=s"(_z64), "=s"(_z32)); \
    asm volatile("" : "+v"((F).tid), "+v"((F).lane)); (F).ws += _z64; (F).out += _z64; (F).gw += _z32; (F).ngw += _z32; (F).wave += _z32; } while (0)
struct TrJob { const float* W; int K, ldw, col_off, ncols; bf16_t* WT; int ldt, row_off; const float* g; const float* mu; int mode; float cs; };
__device__ __forceinline__ void tr_item(const TrJob& J, int item, LAS float* scr, int lane) {
    const int nblk = (J.ncols + 31) / 32, kb = item / nblk, nb = item % nblk, k0 = 64 * kb, n0 = 32 * nb;
#pragma unroll 8
    for (int i = 0; i < 32; ++i) {
        const int kk = 2 * i + (lane >> 5), n = lane & 31, k = k0 + kk;
        float v = 0.f;
        if (k < J.K && n0 + n < J.ncols) {
            float s = J.cs;
            if (J.g) s *= J.g[k];
            if (J.mode == 1) s *= (1.0f - J.mu[k]); else if (J.mode == 2) s *= J.mu[k];
            v = J.W[(size_t)k * J.ldw + J.col_off + n0 + n] * s;
        }
        scr[kk * 33 + n] = v;
    }
    LDS_WAIT(); asm volatile("" ::: "memory");
    const int c = lane & 7;
#pragma unroll
    for (int j = 0; j < 4; ++j) {
        const int n = (lane >> 3) + 8 * j; const LAS float* s = scr + (8 * c) * 33 + n;
        u32x4 o; o.x = pk2(s[0 * 33], s[1 * 33]); o.y = pk2(s[2 * 33], s[3 * 33]); o.z = pk2(s[4 * 33], s[5 * 33]); o.w = pk2(s[6 * 33], s[7 * 33]);
        if (n0 + n < J.ncols && k0 + 8 * c < J.K) *(u32x4*)(J.WT + (size_t)(J.row_off + n0 + n) * J.ldt + k0 + 8 * c) = o;
    }
    LDS_WAIT(); asm volatile("" ::: "memory");
}
__device__ __forceinline__ void tr_job(Frame& F, const TrJob& J, int rot) {
    LAS float* scr = (LAS float*)(F.lds + F.wave * LDS_WSCR);
    const int nitems = ((J.K + 63) / 64) * ((J.ncols + 31) / 32);
    int start = F.gw - (rot % F.ngw); if (start < 0) start += F.ngw;
    for (int it = start; it < nitems; it += F.ngw) tr_item(J, it, scr, F.lane);
}
__device__ __forceinline__ void zero_rows(Frame& F, bf16_t* WT, int ld, int r0, int r1) {
    const size_t n16 = (size_t)(r1 - r0) * ld / 8; u32x4* p = (u32x4*)(WT + (size_t)r0 * ld);
    for (size_t i = (size_t)F.gw * 64 + F.lane; i < n16; i += (size_t)F.ngw * 64) p[i] = (u32x4){0u, 0u, 0u, 0u};
}
__device__ __forceinline__ void row_norm_to_bf16(const float* xrow, bf16_t* orow, int lane) {
    const f32x4* xr = (const f32x4*)xrow + lane; f32x4 v[4]; float s = 0.f;
#pragma unroll
    for (int j = 0; j < 4; ++j) { v[j] = xr[64 * j]; s += (v[j].x * v[j].x + v[j].y * v[j].y) + (v[j].z * v[j].z + v[j].w * v[j].w); }
    const float rstd = rsqrtf(wave_sum(s) * (1.f / DM) + RMS_EPS);
    u32x2* o8 = (u32x2*)orow + lane;
#pragma unroll
    for (int j = 0; j < 4; ++j) { u32x2 w; w.x = pk2(v[j].x * rstd, v[j].y * rstd); w.y = pk2(v[j].z * rstd, v[j].w * rstd); o8[64 * j] = w; }
}

__device__ __forceinline__ void ph_prologue(Frame& F, const Args& A) {
    PHASE_PIN(F);
    unsigned char* ws = F.ws; int rot = 0;
    for (int e = 0; e < 2; ++e) {
        bf16_t* WT = (bf16_t*)(ws + W_WIN) + (size_t)e * NCOL * DM;
        const float* g = A.in[1] + e * DM; const float* mul = A.in[5] + (size_t)e * 3 * DM;
        TrJob J{A.in[2] + (size_t)e * DM * 2760, DM, 2760, 0, 2760, WT, DM, 0, g, nullptr, 0, 1.0f}; tr_job(F, J, rot); rot += 1392;
        zero_rows(F, WT, DM, 2760, C_PW);
        TrJob Jw1{A.in[7] + (size_t)e * DM * 64, DM, 64, 0, 64, WT, DM, C_PW, g, mul, 1, 1.0f}; tr_job(F, Jw1, rot); rot += 32;
        TrJob Jw2{A.in[7] + (size_t)e * DM * 64, DM, 64, 0, 64, WT, DM, C_QW, g, mul, 2, 1.0f}; tr_job(F, Jw2, rot); rot += 32;
        TrJob Ja1{A.in[10] + (size_t)e * DM * 64, DM, 64, 0, 64, WT, DM, C_PA, g, mul + DM, 1, 1.0f}; tr_job(F, Ja1, rot); rot += 32;
        TrJob Ja2{A.in[10] + (size_t)e * DM * 64, DM, 64, 0, 64, WT, DM, C_QA, g, mul + DM, 2, 1.0f}; tr_job(F, Ja2, rot); rot += 32;
        TrJob Jg1{A.in[12] + (size_t)e * DM * 128, DM, 128, 0, 128, WT, DM, C_PG, g, mul + 2 * DM, 1, 1.0f}; tr_job(F, Jg1, rot); rot += 64;
        TrJob Jg2{A.in[12] + (size_t)e * DM * 128, DM, 128, 0, 128, WT, DM, C_QG, g, mul + 2 * DM, 2, 1.0f}; tr_job(F, Jg2, rot); rot += 64;
        if (e == 1) {
            TrJob Jv1{A.in[21], DM, 32, 0, 32, WT, DM, C_PV, g, A.in[19], 1, 1.0f}; tr_job(F, Jv1, rot); rot += 16;
            TrJob Jv2{A.in[21], DM, 32, 0, 32, WT, DM, C_QV, g, A.in[19], 2, 1.0f}; tr_job(F, Jv2, rot); rot += 16;
            zero_rows(F, WT, DM, C_QV + 32, NCOL);
        } else zero_rows(F, WT, DM, C_PV, NCOL);
        TrJob Jo{A.in[3] + (size_t)e * DM * DM, DM, DM, 0, DM, (bf16_t*)(ws + W_WOUTE) + (size_t)e * DM * DM, DM, 0, nullptr, nullptr, 0, 1.0f}; tr_job(F, Jo, rot); rot += 512;
        { const float* Wkv = A.in[24] + (size_t)e * 128 * 1024; bf16_t* WkB = (bf16_t*)(ws + W_WKB) + (size_t)e * 8 * 128 * 64;
          for (int i = F.gw * 64 + F.lane; i < 8 * 128 * 64; i += F.ngw * 64) { const int d = i & 63, r = (i >> 6) & 127, h = i >> 13; WkB[i] = (bf16_t)f2bf(Wkv[(size_t)r * 1024 + h * 64 + d]); } }
        TrJob Jv{A.in[24] + (size_t)e * 128 * 1024, 128, 1024, 512, 512, (bf16_t*)(ws + W_WVT) + (size_t)e * 512 * 128, 128, 0, nullptr, nullptr, 0, 1.0f}; tr_job(F, Jv, rot); rot += 32;
    }
    for (int o = 0; o < 2; ++o) {
        const float* g = A.in[26] + o * DM; bf16_t* WT = (bf16_t*)(ws + W_WQKV) + (size_t)o * 3072 * DM;
        TrJob Jq{A.in[27] + (size_t)o * DM * 3072, DM, 3072, 0, 1024, WT, DM, 0, g, nullptr, 0, LOG2E * 0.125f}; tr_job(F, Jq, rot); rot += 512;
        TrJob Jk{A.in[27] + (size_t)o * DM * 3072, DM, 3072, 1024, 2048, WT, DM, 1024, g, nullptr, 0, 1.0f}; tr_job(F, Jk, rot); rot += 1024;
        TrJob Jo{A.in[28] + (size_t)o * DM * DM, DM, DM, 0, DM, (bf16_t*)(ws + W_WOUTO) + (size_t)o * DM * DM, DM, 0, nullptr, nullptr, 0, 1.0f}; tr_job(F, Jo, rot); rot += 512;
    }
    for (int m = F.gw; m < NT; m += F.ngw) row_norm_to_bf16(A.in[0] + (size_t)m * DM, (bf16_t*)(ws + WS_XB) + (size_t)m * DM, F.lane);
}

__device__ __forceinline__ void moe_weight_prep(Frame& F, const Args& A, int l) {
    PHASE_PIN(F);
    LAS float* scr = (LAS float*)(F.lds + F.wave * LDS_WSCR);
    const float* g = A.in[29] + l * DM;
    const float* w1 = A.in[32] + (size_t)l * 32 * DM * 512; const float* w3 = A.in[33] + (size_t)l * 32 * DM * 512; const float* w2 = A.in[34] + (size_t)l * 32 * 512 * DM;
    bf16_t* W13T = (bf16_t*)(F.ws + WS_W13T); bf16_t* W2T = (bf16_t*)(F.ws + WS_W2T);
    for (int it = F.gw; it < 16384; it += F.ngw) {
        const int job = it >> 6, item = it & 63, which = job & 1, j = (job >> 1) & 3, e = job >> 3;
        TrJob J{(which ? w3 : w1) + (size_t)e * DM * 512, DM, 512, 128 * j, 128, W13T, DM, e * 1024 + 256 * j + 128 * which, g, nullptr, 0, 1.0f};
        tr_item(J, item, scr, F.lane);
    }
    for (int it = F.gw; it < 8192; it += F.ngw) {
        const int e = it >> 8, item = it & 255;
        TrJob J{w2 + (size_t)e * 512 * DM, 512, DM, 0, DM, W2T, 512, e * 1024, nullptr, nullptr, 0, 1.0f};
        tr_item(J, item, scr, F.lane);
    }
}

#define MFMA32(a, b, c) __builtin_amdgcn_mfma_f32_32x32x16_bf16((a), (b), (c), 0, 0, 0)
template <class Epi>
__device__ __forceinline__ void sg_tile(const bf16_t* A, int lda, const bf16_t* B0, const bf16_t* B1, int ldb, int K, int m0, const Epi& epi, int lane) {
    const int r = lane & 31, h = lane >> 5;
    const bf16_t* a0 = A + (size_t)(m0 + r) * lda + 8 * h; const bf16_t* a1 = a0 + (size_t)32 * lda;
    const bf16_t* b0 = B0 + (size_t)r * ldb + 8 * h; const bf16_t* b1 = B1 + (size_t)r * ldb + 8 * h;
    f32x16 c00, c01, c10, c11;
#pragma unroll
    for (int i = 0; i < 16; ++i) { c00[i] = 0.f; c01[i] = 0.f; c10[i] = 0.f; c11[i] = 0.f; }
#pragma unroll 4
    for (int k = 0; k < K; k += 16) {
        const bf16x8 fa0 = *(const bf16x8*)(a0 + k), fa1 = *(const bf16x8*)(a1 + k), fb0 = *(const bf16x8*)(b0 + k), fb1 = *(const bf16x8*)(b1 + k);
        c00 = MFMA32(fb0, fa0, c00); c01 = MFMA32(fb1, fa0, c01); c10 = MFMA32(fb0, fa1, c10); c11 = MFMA32(fb1, fa1, c11);
    }
#pragma unroll
    for (int g = 0; g < 4; ++g) {
        const int j = 8 * g + 4 * h;
        epi.pair(m0 + r, j, (f32x4){c00[4 * g], c00[4 * g + 1], c00[4 * g + 2], c00[4 * g + 3]}, (f32x4){c01[4 * g], c01[4 * g + 1], c01[4 * g + 2], c01[4 * g + 3]});
        epi.pair(m0 + 32 + r, j, (f32x4){c10[4 * g], c10[4 * g + 1], c10[4 * g + 2], c10[4 * g + 3]}, (f32x4){c11[4 * g], c11[4 * g + 1], c11[4 * g + 2], c11[4 * g + 3]});
    }
}
struct EpiStoreBf16 {
    bf16_t* O; int ldo, n0, n1;
    __device__ __forceinline__ void pair(int row, int j, f32x4 v0, f32x4 v1) const {
        u32x2 w; w.x = pk2(v0.x, v0.y); w.y = pk2(v0.z, v0.w); *(u32x2*)(O + (size_t)row * ldo + n0 + j) = w;
        w.x = pk2(v1.x, v1.y); w.y = pk2(v1.z, v1.w); *(u32x2*)(O + (size_t)row * ldo + n1 + j) = w;
    }
};
struct EpiResidF32 {
    const float* S; float* X; int n0, n1;
    __device__ __forceinline__ void pair(int row, int j, f32x4 v0, f32x4 v1) const {
        const size_t o0 = (size_t)row * DM + n0 + j, o1 = (size_t)row * DM + n1 + j;
        *(f32x4*)(X + o0) = *(const f32x4*)(S + o0) + v0; *(f32x4*)(X + o1) = *(const f32x4*)(S + o1) + v1;
    }
};
struct EpiGated {
    bf16_t* H; int hc;
    __device__ __forceinline__ void pair(int row, int j, f32x4 a, f32x4 b) const {
        f32x4 o;
#pragma unroll
        for (int i = 0; i < 4; ++i) o[i] = a[i] * sigmoidf_(a[i]) * b[i];
        u32x2 w; w.x = pk2(o.x, o.y); w.y = pk2(o.z, o.w); *(u32x2*)(H + (size_t)row * 512 + hc + j) = w;
    }
};
__device__ __forceinline__ void sg_dense_bf16(Frame& F, const bf16_t* A, int lda, const bf16_t* Bt, int K, int M, int N, bf16_t* O, int ldo) {
    PHASE_PIN(F);
    const int nN = N / 64, ntile = (M / 64) * nN;
    for (int t = F.gw; t < ntile; t += F.ngw) {
        const int mt = t / nN, nt = t % nN; EpiStoreBf16 E{O, ldo, nt * 64, nt * 64 + 32};
        sg_tile(A, lda, Bt + (size_t)(nt * 64) * K, Bt + (size_t)(nt * 64 + 32) * K, K, K, mt * 64, E, F.lane);
    }
}
__device__ __forceinline__ void sg_dense_resid(Frame& F, const bf16_t* A, const bf16_t* Bt, const float* S, float* X) {
    PHASE_PIN(F);
    const int nN = DM / 64, ntile = (NT / 64) * nN;
    for (int t = F.gw; t < ntile; t += F.ngw) {
        const int mt = t / nN, nt = t % nN; EpiResidF32 E{S, X, nt * 64, nt * 64 + 32};
        sg_tile(A, DM, Bt + (size_t)(nt * 64) * DM, Bt + (size_t)(nt * 64 + 32) * DM, DM, DM, mt * 64, E, F.lane);
    }
}

__device__ __forceinline__ void ph_prep(Frame& F, const Args& A, int e) {
    PHASE_PIN(F);
    LAS float* sc = (LAS float*)(F.lds + F.wave * LDS_WSCR);
    unsigned char* ws = F.ws; const int lane = F.lane;
    const bf16_t* proj = (const bf16_t*)(ws + WS_PROJ);
    const float* mu_rkv = A.in[4] + (size_t)e * 3 * 512;
    const float* w0 = A.in[6] + e * 512; const float* w2 = A.in[8] + (size_t)e * 64 * 512;
    const float* a0 = A.in[9] + e * 512; const float* a2 = A.in[11] + (size_t)e * 64 * 512;
    const float* g2 = A.in[13] + (size_t)e * 128 * 512;
    const float* k_k = A.in[14] + e * 512; const float* k_a = A.in[15] + e * 512; const float* r_k = A.in[16] + e * 512;
    const float* v0 = A.in[20]; const float* v2 = A.in[22];
    const float* kvn = A.in[23] + e * 128; const float* ikn = A.in[25] + e * 64;
    float* SIN = (float*)(ws + WS_SIN); float* VF = (float*)(ws + WS_VF); float* GATE = (float*)(ws + WS_GATE); float* BON = (float*)(ws + SM_BONUS);
    unsigned* SGN = (unsigned*)(ws + SM_SGN);
    bf16_t* CN = (bf16_t*)(ws + WS_CN); bf16_t* KI = (bf16_t*)(ws + WS_KI); bf16_t* QI = (bf16_t*)(ws + WS_QI);
    for (int m = F.gw; m < NT; m += F.ngw) {
        const int t = m & (TT - 1), b = m >> 13; const bool hp = t > 0;
        const bf16_t* pr = proj + (size_t)m * NCOL; const bf16_t* pp = pr - NCOL;
        { const float lw = bf2f(pr[C_PW + lane]) + (hp ? bf2f(pp[C_QW + lane]) : 0.f);
          const float la = bf2f(pr[C_PA + lane]) + (hp ? bf2f(pp[C_QA + lane]) : 0.f);
          const float lg0 = bf2f(pr[C_PG + lane]) + (hp ? bf2f(pp[C_QG + lane]) : 0.f);
          const float lg1 = bf2f(pr[C_PG + 64 + lane]) + (hp ? bf2f(pp[C_QG + 64 + lane]) : 0.f);
          sc[lane] = tanhf(lw); sc[64 + lane] = la; sc[128 + lane] = sigmoidf_(lg0); sc[192 + lane] = sigmoidf_(lg1);
          if (lane < 32) sc[256 + lane] = bf2f(pr[C_PV + lane]) + (hp ? bf2f(pp[C_QV + lane]) : 0.f); }
        { const float c0 = bf2f(pr[C_CKV + lane]), c1 = bf2f(pr[C_CKV + 64 + lane]);
          const float rs = rsqrtf(wave_sum(c0 * c0 + c1 * c1) * (1.f / 128.f) + RMS_EPS);
          CN[(size_t)m * 128 + lane] = (bf16_t)f2bf(c0 * rs * kvn[lane]); CN[(size_t)m * 128 + 64 + lane] = (bf16_t)f2bf(c1 * rs * kvn[64 + lane]);
          const float ki = bf2f(pr[C_KI + lane]); const float rs2 = rsqrtf(wave_sum(ki * ki) * (1.f / 64.f) + RMS_EPS);
          KI[(size_t)m * 64 + lane] = (bf16_t)f2bf(ki * rs2 * ikn[lane]);
          unsigned sg = 0;
#pragma unroll
          for (int hh = 0; hh < 8; ++hh) { const float w = bf2f(pr[C_WI + hh]); if (w < 0.f) sg |= 1u << hh;
              QI[(size_t)m * 512 + hh * 64 + lane] = (bf16_t)f2bf(fabsf(w) * bf2f(pr[C_QI + hh * 64 + lane])); }
          if (lane == 0) SGN[m] = sg; }
        LDS_WAIT(); asm volatile("" ::: "memory");
#pragma unroll 1
        for (int hh = 0; hh < 8; ++hh) {
            const int ch = hh * 64 + lane;
            float dw = w0[ch], da = a0[ch], dg = 0.f, dv = 0.f;
#pragma unroll 4
            for (int j = 0; j < 64; j += 4) {
                const f32x4 tw = *(const LAS f32x4*)(sc + j), ta = *(const LAS f32x4*)(sc + 64 + j);
                dw += tw.x * w2[(size_t)(j + 0) * 512 + ch] + tw.y * w2[(size_t)(j + 1) * 512 + ch] + tw.z * w2[(size_t)(j + 2) * 512 + ch] + tw.w * w2[(size_t)(j + 3) * 512 + ch];
                da += ta.x * a2[(size_t)(j + 0) * 512 + ch] + ta.y * a2[(size_t)(j + 1) * 512 + ch] + ta.z * a2[(size_t)(j + 2) * 512 + ch] + ta.w * a2[(size_t)(j + 3) * 512 + ch];
            }
#pragma unroll 4
            for (int j = 0; j < 128; j += 4) {
                const f32x4 tg = *(const LAS f32x4*)(sc + 128 + j);
                dg += tg.x * g2[(size_t)(j + 0) * 512 + ch] + tg.y * g2[(size_t)(j + 1) * 512 + ch] + tg.z * g2[(size_t)(j + 2) * 512 + ch] + tg.w * g2[(size_t)(j + 3) * 512 + ch];
            }
            const float rr = bf2f(pr[C_R + ch]), kk0 = bf2f(pr[C_K + ch]), vv = bf2f(pr[C_V + ch]);
            const float rp = hp ? bf2f(pp[C_R + ch]) : 0.f, kp = hp ? bf2f(pp[C_K + ch]) : 0.f, vp = hp ? bf2f(pp[C_V + ch]) : 0.f;
            const float r1 = rr + (rp - rr) * mu_rkv[ch], k1 = kk0 + (kp - kk0) * mu_rkv[512 + ch]; float v1 = vv + (vp - vv) * mu_rkv[1024 + ch];
            if (e == 1) {
                dv = v0[ch];
#pragma unroll 4
                for (int j = 0; j < 32; j += 4) {
                    const f32x4 tv = *(const LAS f32x4*)(sc + 256 + j);
                    dv += tv.x * v2[(size_t)(j + 0) * 512 + ch] + tv.y * v2[(size_t)(j + 1) * 512 + ch] + tv.z * v2[(size_t)(j + 2) * 512 + ch] + tv.w * v2[(size_t)(j + 3) * 512 + ch];
                }
                const float vf = VF[(size_t)m * 512 + ch]; v1 = v1 + (vf - v1) * sigmoidf_(dv);
            } else VF[(size_t)m * 512 + ch] = v1;
            const float decay = __expf(-0.6065306597126334f * sigmoidf_(dw));
            const float ic = sigmoidf_(da);
            float kkv = k1 * k_k[ch]; const float ss = wave_sum(kkv * kkv); kkv *= rsqrtf(fmaxf(ss, 1e-12f));
            const float kmod = k1 * (1.0f + (ic - 1.0f) * k_a[ch]);
            const float bon = wave_sum(r1 * kmod * r_k[ch]);
            float* so = SIN + ((size_t)(b * 8 + hh) * TT + t) * 384;
            so[lane] = r1; so[64 + lane] = decay; so[128 + lane] = kmod; so[192 + lane] = kkv; so[256 + lane] = ic * kkv; so[320 + lane] = v1;
            GATE[(size_t)m * 512 + ch] = dg;
            if (lane == 0) BON[m * 8 + hh] = bon;
        }
        LDS_WAIT(); asm volatile("" ::: "memory");
    }
    { bf16_t* QA = (bf16_t*)(ws + WS_QA); const bf16_t* WkB = (const bf16_t*)(ws + W_WKB) + (size_t)e * 8 * 128 * 64;
      const int ntile = (NT / 64) * 2 * 8;
      for (int tI = F.gw; tI < ntile; tI += F.ngw) {
          const int hh = tI & 7, nt = (tI >> 3) & 1, mt = tI >> 4;
          EpiStoreBf16 E{QA + hh * 128, 1024, nt * 64, nt * 64 + 32};
          sg_tile(proj + C_QB + hh * 64, NCOL, WkB + (size_t)hh * 128 * 64 + (size_t)(nt * 64) * 64, WkB + (size_t)hh * 128 * 64 + (size_t)(nt * 64 + 32) * 64, 64, 64, mt * 64, E, F.lane);
      } }
}

__device__ __forceinline__ float allred16(float x) {
    x += __builtin_bit_cast(float, __builtin_amdgcn_update_dpp(0, __builtin_bit_cast(int, x), 0x128, 0xf, 0xf, false));
    x += __builtin_bit_cast(float, __builtin_amdgcn_update_dpp(0, __builtin_bit_cast(int, x), 0x124, 0xf, 0xf, false));
    x += __builtin_bit_cast(float, __builtin_amdgcn_update_dpp(0, __builtin_bit_cast(int, x), 0x122, 0xf, 0xf, false));
    x += __builtin_bit_cast(float, __builtin_amdgcn_update_dpp(0, __builtin_bit_cast(int, x), 0x121, 0xf, 0xf, false));
    return x;
}
__device__ __forceinline__ void ph_scan(Frame& F) {
    PHASE_PIN(F);
    if (F.wave != 0) return;
    const int lane = F.lane, i = lane >> 4, kq = lane & 15;
    for (int task = blockIdx.x; task < 256; task += gridDim.x) {
        const int bh = task >> 4, rg = task & 15, row = 4 * rg + i, b = bh >> 3, hh = bh & 7;
        const float* sin = (const float*)(F.ws + WS_SIN) + (size_t)bh * TT * 384;
        float* Y = (float*)(F.ws + WS_Y) + (size_t)b * TT * 512 + hh * 64 + row;
        f32x4 R[8], W[8], K[8], KK[8], B[8]; float V[8];
#pragma unroll
        for (int j = 0; j < 8; ++j) { const float* p = sin + (size_t)j * 384; R[j] = *(const f32x4*)(p + 4 * kq); W[j] = *(const f32x4*)(p + 64 + 4 * kq); K[j] = *(const f32x4*)(p + 128 + 4 * kq);
            KK[j] = *(const f32x4*)(p + 192 + 4 * kq); B[j] = *(const f32x4*)(p + 256 + 4 * kq); V[j] = p[320 + row]; }
        float s0 = 0.f, s1 = 0.f, s2 = 0.f, s3 = 0.f;
        for (int t0 = 0; t0 < TT; t0 += 8) {
#pragma unroll
            for (int j = 0; j < 8; ++j) {
                float p = s0 * KK[j].x + s1 * KK[j].y + s2 * KK[j].z + s3 * KK[j].w; p = allred16(p);
                s0 = s0 * W[j].x - p * B[j].x + V[j] * K[j].x; s1 = s1 * W[j].y - p * B[j].y + V[j] * K[j].y;
                s2 = s2 * W[j].z - p * B[j].z + V[j] * K[j].z; s3 = s3 * W[j].w - p * B[j].w + V[j] * K[j].w;
                float y = s0 * R[j].x + s1 * R[j].y + s2 * R[j].z + s3 * R[j].w; y = allred16(y);
                if (kq == 0) Y[(size_t)(t0 + j) * 512] = y;
                if (t0 + j + 8 < TT) { const float* p2 = sin + (size_t)(t0 + j + 8) * 384; R[j] = *(const f32x4*)(p2 + 4 * kq); W[j] = *(const f32x4*)(p2 + 64 + 4 * kq); K[j] = *(const f32x4*)(p2 + 128 + 4 * kq);
                    KK[j] = *(const f32x4*)(p2 + 192 + 4 * kq); B[j] = *(const f32x4*)(p2 + 256 + 4 * kq); V[j] = p2[320 + row]; }
            }
        }
    }
}

__device__ __forceinline__ size_t score_row_off(int b, int t) { const int j = t >> 7; return (size_t)b * SCORE_PER_BATCH + (size_t)16384 * (j * (j + 1) / 2) + (size_t)(t & 127) * (128 * (j + 1)); }
__device__ __forceinline__ void ph_idx_score(Frame& F) {
    PHASE_PIN(F);
    const int lane = F.lane, r = lane & 31, h = lane >> 5;
    const bf16_t* QI = (const bf16_t*)(F.ws + WS_QI); const bf16_t* KI = (const bf16_t*)(F.ws + WS_KI); const unsigned* SGN = (const unsigned*)(F.ws + SM_SGN);
    float* SC = (float*)(F.ws + WS_SCORE);
    for (int it = F.gw; it < 4352; it += F.ngw) {
        const int b = it / 2176; int i = it - b * 2176; i = 2175 - i;
        int a = 1; while (8 * a * (a + 1) <= i) ++a;
        const int rem = i - 8 * a * (a - 1), qt = 16 * (a - 1) + rem / a, g = rem % a;
        const int mq = b * TT + qt * 32 + r;
        bf16x8 qf[8][4];
#pragma unroll
        for (int hh = 0; hh < 8; ++hh)
#pragma unroll
            for (int ks = 0; ks < 4; ++ks) qf[hh][ks] = *(const bf16x8*)(QI + (size_t)mq * 512 + hh * 64 + ks * 16 + 8 * h);
        const unsigned sg = SGN[mq];
        float* srow = SC + score_row_off(b, qt * 32 + r);
        const int kt_end = (16 * g + 15 < qt) ? 16 * g + 15 : qt;
        for (int kt = 16 * g; kt <= kt_end; ++kt) {
            const bf16_t* kp = KI + (size_t)(b * TT + kt * 32 + r) * 64 + 8 * h;
            const bf16x8 kf0 = *(const bf16x8*)(kp), kf1 = *(const bf16x8*)(kp + 16), kf2 = *(const bf16x8*)(kp + 32), kf3 = *(const bf16x8*)(kp + 48);
            float sc[16];
#pragma unroll
            for (int q = 0; q < 16; ++q) sc[q] = 0.f;
#pragma unroll
            for (int hh = 0; hh < 8; ++hh) {
                f32x16 acc;
#pragma unroll
                for (int q = 0; q < 16; ++q) acc[q] = 0.f;
                acc = MFMA32(kf0, qf[hh][0], acc); acc = MFMA32(kf1, qf[hh][1], acc); acc = MFMA32(kf2, qf[hh][2], acc); acc = MFMA32(kf3, qf[hh][3], acc);
                const bool neg = (sg >> hh) & 1u;
#pragma unroll
                for (int q = 0; q < 16; ++q) { const float v = fmaxf(acc[q], 0.f); sc[q] = neg ? sc[q] - v : sc[q] + v; }
            }
#pragma unroll
            for (int g4 = 0; g4 < 4; ++g4) *(f32x4*)(srow + kt * 32 + 8 * g4 + 4 * h) = (f32x4){sc[4 * g4], sc[4 * g4 + 1], sc[4 * g4 + 2], sc[4 * g4 + 3]};
        }
    }
}
__device__ __forceinline__ unsigned block_excl_scan(unsigned v, LAS unsigned* scr, int tid, unsigned* total) {
    const int lane = tid & 63, w = tid >> 6; unsigned x = v;
#pragma unroll
    for (int o = 1; o < 64; o <<= 1) { const unsigned y = __shfl_up(x, o); if (lane >= o) x += y; }
    __syncthreads();
    if (lane == 63) scr[w] = x;
    __syncthreads();
    unsigned base = 0, tot = 0;
#pragma unroll
    for (int j = 0; j < 8; ++j) { const unsigned c = scr[j]; if (j < w) base += c; tot += c; }
    *total = tot;
    return base + x - v;
}
__device__ __forceinline__ void ph_idx_select(Frame& F) {
    PHASE_PIN(F);
    const int tid = F.tid; LAS unsigned* hist = (LAS unsigned*)F.lds; LAS unsigned* misc = hist + 256;
    const float* SC = (const float*)(F.ws + WS_SCORE); int* SEL = (int*)(F.ws + WS_SEL);
    for (int m = blockIdx.x; m < NT; m += gridDim.x) {
        const int t = m & (TT - 1), b = m >> 13, n = t + 1; int* sel = SEL + (size_t)m * 256;
        if (n <= 256) { if (tid < 256) sel[tid] = tid < n ? tid : -1; continue; }
        const float* srow = SC + score_row_off(b, t);
        unsigned key[16];
#pragma unroll
        for (int j = 0; j < 4; ++j) {
            const int idx0 = 4 * (tid + 512 * j);
            if (idx0 < n) { const f32x4 v = *(const f32x4*)(srow + idx0);
#pragma unroll
                for (int i = 0; i < 4; ++i) { const unsigned u = __float_as_uint(v[i]); key[4 * j + i] = (idx0 + i < n) ? ((u & 0x80000000u) ? ~u : (u | 0x80000000u)) : 0u; } }
            else {
#pragma unroll
                for (int i = 0; i < 4; ++i) key[4 * j + i] = 0u; }
        }
        unsigned prefix = 0, mask = 0, need = 256;
#pragma unroll 1
        for (int pass = 0; pass < 4; ++pass) {
            const int shift = 24 - 8 * pass;
            __syncthreads();
            if (tid < 256) hist[tid] = 0;
            __syncthreads();
#pragma unroll
            for (int q = 0; q < 16; ++q) { const int idx = 4 * (tid + 512 * (q >> 2)) + (q & 3); if (idx < n && (key[q] & mask) == prefix) __hip_atomic_fetch_add(&hist[(key[q] >> shift) & 255u], 1u, __ATOMIC_RELAXED, __HIP_MEMORY_SCOPE_WORKGROUP); }
            __syncthreads();
            if (tid < 64) {
                unsigned hv[4], L = 0;
#pragma unroll
                for (int i = 0; i < 4; ++i) { hv[i] = hist[255 - 4 * tid - i]; L += hv[i]; }
                unsigned x = L;
#pragma unroll
                for (int o = 1; o < 64; o <<= 1) { const unsigned y = __shfl_up(x, o); if (tid >= o) x += y; }
                unsigned run = x - L;
#pragma unroll
                for (int i = 0; i < 4; ++i) { if (run < need && need <= run + hv[i]) { misc[16] = 255 - 4 * tid - i; misc[17] = need - run; } run += hv[i]; }
            }
            __syncthreads();
            prefix |= misc[16] << shift; mask |= 255u << shift; need = misc[17];
        }
        unsigned basegt = 0, baseeq = 0; const unsigned ngt = 256 - need;
#pragma unroll
        for (int j = 0; j < 4; ++j) {
            unsigned cg = 0, ce = 0;
#pragma unroll
            for (int i = 0; i < 4; ++i) { const int idx = 4 * (tid + 512 * j) + i; if (idx < n) { cg += key[4 * j + i] > prefix; ce += key[4 * j + i] == prefix; } }
            unsigned tot; const unsigned ex = block_excl_scan(cg | (ce << 16), misc, tid, &tot);
            unsigned pg = basegt + (ex & 0xffffu), pe = baseeq + (ex >> 16);
#pragma unroll
            for (int i = 0; i < 4; ++i) { const int idx = 4 * (tid + 512 * j) + i; if (idx < n) {
                if (key[4 * j + i] > prefix) { sel[pg] = idx; ++pg; }
                else if (key[4 * j + i] == prefix) { if (pe < need) sel[ngt + pe] = idx; ++pe; } } }
            basegt += tot & 0xffffu; baseeq += tot >> 16;
        }
    }
    __syncthreads();
}

__device__ __forceinline__ void ph_sparse(Frame& F, const Args& A, int e) {
    PHASE_PIN(F);
    const int lane = F.lane; unsigned char* ws = F.ws;
    LAS float* qs = (LAS float*)(F.lds + F.wave * LDS_WSCR);
    LAS float* ps = qs + 1024;
    LAS float* cs = ps + 2048;
    const bf16_t* QA = (const bf16_t*)(ws + WS_QA); const bf16_t* CN = (const bf16_t*)(ws + WS_CN); const int* SEL = (const int*)(ws + WS_SEL);
    const float* Wkv = A.in[24] + (size_t)e * 128 * 1024;
    bf16_t* YC = (bf16_t*)(ws + WS_YCAT);
    const float* ln_g = A.in[17] + e * 512; const float* ln_b = A.in[18] + e * 512;
    const float* Yr = (const float*)(ws + WS_Y); const float* GATE = (const float*)(ws + WS_GATE); const float* BON = (const float*)(ws + SM_BONUS); const float* SIN = (const float*)(ws + WS_SIN);
    for (int m = F.gw; m < NT; m += F.ngw) {
        const int t = m & (TT - 1), b = m >> 13;
#pragma unroll 1
        for (int hh = 0; hh < 8; ++hh) {
            const int ch = hh * 64 + lane; const float y = Yr[(size_t)m * 512 + ch];
            const float mean = wave_sum(y) * (1.f / 64.f); const float yc = y - mean; const float var = wave_sum(yc * yc) * (1.f / 64.f);
            const float v1 = SIN[((size_t)(b * 8 + hh) * TT + t) * 384 + 320 + lane];
            const float o = (yc * rsqrtf(var + GN_EPS) * ln_g[ch] + ln_b[ch] + BON[m * 8 + hh] * v1) * GATE[(size_t)m * 512 + ch];
            YC[(size_t)m * 1024 + ch] = (bf16_t)f2bf(o);
        }
        const bf16_t* qa = QA + (size_t)m * 1024;
#pragma unroll
        for (int i = 0; i < 16; ++i) qs[lane + 64 * i] = bf2f(qa[lane + 64 * i]);
        int sj[4]; float lg[4][8];
#pragma unroll
        for (int i = 0; i < 4; ++i) sj[i] = SEL[(size_t)m * 256 + lane + 64 * i];
        LDS_WAIT(); asm volatile("" ::: "memory");
#pragma unroll
        for (int i = 0; i < 4; ++i) {
            const int s = sj[i] < 0 ? 0 : sj[i];
            const bf16_t* crow = CN + (size_t)(b * TT + s) * 128;
            float acc[8];
#pragma unroll
            for (int hh = 0; hh < 8; ++hh) acc[hh] = 0.f;
#pragma unroll 2
            for (int r8 = 0; r8 < 128; r8 += 8) {
                const u32x4 cw = *(const u32x4*)(crow + r8);
                float cf[8]; cf[0] = __uint_as_float(cw.x << 16); cf[1] = __uint_as_float(cw.x & 0xffff0000u); cf[2] = __uint_as_float(cw.y << 16); cf[3] = __uint_as_float(cw.y & 0xffff0000u);
                cf[4] = __uint_as_float(cw.z << 16); cf[5] = __uint_as_float(cw.z & 0xffff0000u); cf[6] = __uint_as_float(cw.w << 16); cf[7] = __uint_as_float(cw.w & 0xffff0000u);
#pragma unroll
                for (int hh = 0; hh < 8; ++hh) { const f32x4 q0 = *(const LAS f32x4*)(qs + hh * 128 + r8), q1 = *(const LAS f32x4*)(qs + hh * 128 + r8 + 4);
                    acc[hh] += cf[0] * q0.x + cf[1] * q0.y + cf[2] * q0.z + cf[3] * q0.w + cf[4] * q1.x + cf[5] * q1.y + cf[6] * q1.z + cf[7] * q1.w; }
            }
#pragma unroll
            for (int hh = 0; hh < 8; ++hh) lg[i][hh] = sj[i] < 0 ? -INFINITY : acc[hh] * 0.125f;
        }
#pragma unroll
        for (int hh = 0; hh < 8; ++hh) {
            float mx = fmaxf(fmaxf(lg[0][hh], lg[1][hh]), fmaxf(lg[2][hh], lg[3][hh])); mx = wave_max(mx);
            float p0 = __expf(lg[0][hh] - mx), p1 = __expf(lg[1][hh] - mx), p2 = __expf(lg[2][hh] - mx), p3 = __expf(lg[3][hh] - mx);
            const float inv = 1.0f / wave_sum(p0 + p1 + p2 + p3);
            ps[(lane) * 8 + hh] = p0 * inv; ps[(lane + 64) * 8 + hh] = p1 * inv; ps[(lane + 128) * 8 + hh] = p2 * inv; ps[(lane + 192) * 8 + hh] = p3 * inv;
        }
        LDS_WAIT(); asm volatile("" ::: "memory");
        float c0[8], c1[8];
#pragma unroll
        for (int hh = 0; hh < 8; ++hh) { c0[hh] = 0.f; c1[hh] = 0.f; }
#pragma unroll
        for (int i = 0; i < 4; ++i) {
#pragma unroll 1
        for (int jj = 0; jj < 64; ++jj) {
            const int j = i * 64 + jj;
            int s = __shfl(sj[i], jj); if (s < 0) s = 0;
            const bf16_t* crow = CN + (size_t)(b * TT + s) * 128;
            const float x0 = bf2f(crow[lane]), x1 = bf2f(crow[64 + lane]);
            const f32x4 pa = *(const LAS f32x4*)(ps + j * 8), pb = *(const LAS f32x4*)(ps + j * 8 + 4);
            c0[0] += pa.x * x0; c0[1] += pa.y * x0; c0[2] += pa.z * x0; c0[3] += pa.w * x0; c0[4] += pb.x * x0; c0[5] += pb.y * x0; c0[6] += pb.z * x0; c0[7] += pb.w * x0;
            c1[0] += pa.x * x1; c1[1] += pa.y * x1; c1[2] += pa.z * x1; c1[3] += pa.w * x1; c1[4] += pb.x * x1; c1[5] += pb.y * x1; c1[6] += pb.z * x1; c1[7] += pb.w * x1;
        } }
#pragma unroll
        for (int hh = 0; hh < 8; ++hh) { cs[hh * 128 + lane] = c0[hh]; cs[hh * 128 + 64 + lane] = c1[hh]; }
        LDS_WAIT(); asm volatile("" ::: "memory");
#pragma unroll 1
        for (int hh = 0; hh < 8; ++hh) {
            float o = 0.f; const float* wv = Wkv + 512 + hh * 64 + lane;
#pragma unroll 4
            for (int r4 = 0; r4 < 128; r4 += 4) { const f32x4 cx = *(const LAS f32x4*)(cs + hh * 128 + r4);
                o += cx.x * wv[(size_t)(r4 + 0) * 1024] + cx.y * wv[(size_t)(r4 + 1) * 1024] + cx.z * wv[(size_t)(r4 + 2) * 1024] + cx.w * wv[(size_t)(r4 + 3) * 1024]; }
            YC[(size_t)m * 1024 + 512 + hh * 64 + lane] = (bf16_t)f2bf(o);
        }
        LDS_WAIT(); asm volatile("" ::: "memory");
    }
}

__device__ __forceinline__ void ph_stickbreak(Frame& F) {
    PHASE_PIN(F);
    const int lane = F.lane; unsigned char* ws = F.ws;
    LAS float* qs = (LAS float*)(F.lds + F.wave * LDS_WSCR);
    LAS float* wsd = qs + 64;
    const bf16_t* Q = (const bf16_t*)(ws + WS_PROJ); const bf16_t* Kb = Q + (size_t)NT * 1024; const bf16_t* Vb = Kb + (size_t)NT * 1024;
    bf16_t* YC = (bf16_t*)(ws + WS_YCAT);
    for (int it = F.gw; it < NT * 16; it += F.ngw) {
        const int hh = it & 15, m = it >> 4, t = m & (TT - 1), b = m >> 13;
        qs[lane] = bf2f(Q[(size_t)m * 1024 + hh * 64 + lane]);
        LDS_WAIT(); asm volatile("" ::: "memory");
        float o = 0.f, P = 1.0f;
        for (int c0 = t - 1; c0 >= 0; c0 -= 64) {
            const int s = c0 - lane; const bool valid = s >= 0;
            float z = 0.f;
            if (valid) { const bf16_t* kr = Kb + (size_t)(b * TT + s) * 1024 + hh * 64;
#pragma unroll
                for (int d8 = 0; d8 < 64; d8 += 8) { const u32x4 kw = *(const u32x4*)(kr + d8); const f32x4 q0 = *(const LAS f32x4*)(qs + d8), q1 = *(const LAS f32x4*)(qs + d8 + 4);
                    z += __uint_as_float(kw.x << 16) * q0.x + __uint_as_float(kw.x & 0xffff0000u) * q0.y + __uint_as_float(kw.y << 16) * q0.z + __uint_as_float(kw.y & 0xffff0000u) * q0.w
                       + __uint_as_float(kw.z << 16) * q1.x + __uint_as_float(kw.z & 0xffff0000u) * q1.y + __uint_as_float(kw.w << 16) * q1.z + __uint_as_float(kw.w & 0xffff0000u) * q1.w; } }
            const float ez = exp2f(z); const float keep = valid ? 1.0f / (1.0f + ez) : 1.0f; const float beta = valid ? 1.0f - keep : 0.f;
            float x = keep;
#pragma unroll
            for (int of = 1; of < 64; of <<= 1) { const float y = __shfl_up(x, of); if (lane >= of) x *= y; }
            float ex = __shfl_up(x, 1); if (lane == 0) ex = 1.0f;
            wsd[lane] = beta * ex * P;
            P *= __shfl(x, 63);
            LDS_WAIT(); asm volatile("" ::: "memory");
            const int nk = (c0 + 1 < 64) ? c0 + 1 : 64;
            for (int j = 0; j < nk; ++j) o += wsd[j] * bf2f(Vb[(size_t)(b * TT + c0 - j) * 1024 + hh * 64 + lane]);
            LDS_WAIT(); asm volatile("" ::: "memory");
            if (P < 1e-30f) break;
        }
        YC[(size_t)m * 1024 + hh * 64 + lane] = (bf16_t)f2bf(o);
    }
}

__device__ __forceinline__ void ph_moe_route(Frame& F, const Args& A, int l) {
    PHASE_PIN(F);
    const int lane = F.lane; unsigned char* ws = F.ws;
    const float* X = (const float*)(ws + WS_X); bf16_t* XB = (bf16_t*)(ws + WS_XB);
    const float* g = A.in[29] + l * DM; const float* Wg = A.in[30] + (size_t)l * DM * 4; const float* We = A.in[31] + (size_t)l * 4 * DM * 8;
    int* EIDX = (int*)(ws + SM_EIDX); float* GATEV = (float*)(ws + SM_GATE); int* SLOT = (int*)(ws + SM_SLOT);
    unsigned* cnt = (unsigned*)(ws + WS_CTL) + CW_CNT + 64 * l;
    for (int m = F.gw; m < NT; m += F.ngw) {
        const f32x4* xr = (const f32x4*)(X + (size_t)m * DM) + lane; f32x4 v[4]; float s = 0.f;
#pragma unroll
        for (int j = 0; j < 4; ++j) { v[j] = xr[64 * j]; s += (v[j].x * v[j].x + v[j].y * v[j].y) + (v[j].z * v[j].z + v[j].w * v[j].w); }
        const float rstd = rsqrtf(wave_sum(s) * (1.f / DM) + RMS_EPS);
        u32x2* o8 = (u32x2*)(XB + (size_t)m * DM) + lane;
#pragma unroll
        for (int j = 0; j < 4; ++j) { u32x2 w; w.x = pk2(v[j].x * rstd, v[j].y * rstd); w.y = pk2(v[j].z * rstd, v[j].w * rstd); o8[64 * j] = w; }
#pragma unroll
        for (int j = 0; j < 4; ++j) { const f32x4 gg = *((const f32x4*)g + lane + 64 * j); v[j] = v[j] * gg * rstd; }
        float gl[4] = {0.f, 0.f, 0.f, 0.f};
#pragma unroll
        for (int j = 0; j < 4; ++j)
#pragma unroll
            for (int i = 0; i < 4; ++i) { const int k = 4 * (lane + 64 * j) + i; const f32x4 w = *(const f32x4*)(Wg + (size_t)k * 4); const float xv = v[j][i];
                gl[0] += xv * w.x; gl[1] += xv * w.y; gl[2] += xv * w.z; gl[3] += xv * w.w; }
#pragma unroll
        for (int q = 0; q < 4; ++q) gl[q] = wave_sum(gl[q]);
        int gs = 0; float gm = gl[0];
#pragma unroll
        for (int q = 1; q < 4; ++q) if (gl[q] > gm) { gm = gl[q]; gs = q; }
        float gden = 0.f;
#pragma unroll
        for (int q = 0; q < 4; ++q) gden += __expf(gl[q] - gm);
        const float g_gate = 1.0f / gden;
        const float* Wes = We + (size_t)gs * DM * 8;
        float el[8];
#pragma unroll
        for (int q = 0; q < 8; ++q) el[q] = 0.f;
#pragma unroll
        for (int j = 0; j < 4; ++j)
#pragma unroll
            for (int i = 0; i < 4; ++i) { const int k = 4 * (lane + 64 * j) + i; const f32x4 w0 = *(const f32x4*)(Wes + (size_t)k * 8), w1 = *(const f32x4*)(Wes + (size_t)k * 8 + 4); const float xv = v[j][i];
                el[0] += xv * w0.x; el[1] += xv * w0.y; el[2] += xv * w0.z; el[3] += xv * w0.w; el[4] += xv * w1.x; el[5] += xv * w1.y; el[6] += xv * w1.z; el[7] += xv * w1.w; }
#pragma unroll
        for (int q = 0; q < 8; ++q) el[q] = wave_sum(el[q]);
        int i1 = 0; float m1 = el[0];
#pragma unroll
        for (int q = 1; q < 8; ++q) if (el[q] > m1) { m1 = el[q]; i1 = q; }
        int i2 = -1; float m2 = -INFINITY;
#pragma unroll
        for (int q = 0; q < 8; ++q) if (q != i1 && el[q] > m2) { m2 = el[q]; i2 = q; }
        const float e2 = __expf(m2 - m1); const float ga = g_gate / (1.0f + e2), gb = g_gate * e2 / (1.0f + e2);
        if (lane == 0) {
            const int ea = gs * 8 + i1, eb = gs * 8 + i2;
            const unsigned sa = atomicAdd(&cnt[ea], 1u), sb = atomicAdd(&cnt[eb], 1u);
            EIDX[2 * m] = ea; EIDX[2 * m + 1] = eb; GATEV[2 * m] = ga; GATEV[2 * m + 1] = gb; SLOT[2 * m] = (int)sa; SLOT[2 * m + 1] = (int)sb;
        }
    }
}
__device__ __forceinline__ int moe_offsets(const unsigned* cnt, int lane, int* total, int* mycnt_pad) {
    const unsigned c = lane < 32 ? __hip_atomic_load(cnt + (lane & 31), __ATOMIC_RELAXED, __HIP_MEMORY_SCOPE_AGENT) : 0u; const int p = (int)((c + 255u) & ~255u);
    int x = p;
#pragma unroll
    for (int o = 1; o < 64; o <<= 1) { const int y = __shfl_up(x, o); if (lane >= o) x += y; }
    *total = __shfl(x, 63); *mycnt_pad = p;
    return x - p;
}
__device__ __forceinline__ void ph_moe_gather(Frame& F, int l) {
    PHASE_PIN(F);
    const int lane = F.lane; unsigned char* ws = F.ws;
    const unsigned* cnt = (const unsigned*)(ws + WS_CTL) + CW_CNT + 64 * l; int total, pad; const int off = moe_offsets(cnt, lane, &total, &pad);
    const int* EIDX = (const int*)(ws + SM_EIDX); const int* SLOT = (const int*)(ws + SM_SLOT);
    const bf16_t* XB = (const bf16_t*)(ws + WS_XB); bf16_t* AM = (bf16_t*)(ws + WS_AMOE);
    for (int a = F.gw; a < NT * 2; a += F.ngw) {
        const int m = a >> 1, e = EIDX[a], row = __shfl(off, e) + SLOT[a];
        const u32x4* src = (const u32x4*)(XB + (size_t)m * DM); u32x4* dst = (u32x4*)(AM + (size_t)row * DM);
        dst[lane] = src[lane]; dst[lane + 64] = src[lane + 64];
    }
}
__device__ __forceinline__ void ph_moe_gemm1(Frame& F, int l) {
    PHASE_PIN(F);
    const int lane = F.lane; unsigned char* ws = F.ws;
    const unsigned* cnt = (const unsigned*)(ws + WS_CTL) + CW_CNT + 64 * l; int total, pad; const int off = moe_offsets(cnt, lane, &total, &pad);
    const int endo = off + pad;
    const bf16_t* AM = (const bf16_t*)(ws + WS_AMOE); const bf16_t* W13T = (const bf16_t*)(ws + WS_W13T); bf16_t* H = (bf16_t*)(ws + WS_H);
    const int ntile = (total / 64) * 16;
    for (int tI = F.gw; tI < ntile; tI += F.ngw) {
        const int nt = tI & 15, rt = tI >> 4, row0 = rt * 64;
        const int e = __popcll(__ballot(lane < 32 && endo <= row0));
        const int j = nt >> 2, i = nt & 3, n0 = 256 * j + 32 * i;
        EpiGated E{H, 128 * j + 32 * i};
        sg_tile(AM, DM, W13T + (size_t)(e * 1024 + n0) * DM, W13T + (size_t)(e * 1024 + n0 + 128) * DM, DM, DM, row0, E, lane);
    }
}
__device__ __forceinline__ void ph_moe_gemm2(Frame& F, int l) {
    PHASE_PIN(F);
    const int lane = F.lane; unsigned char* ws = F.ws;
    const unsigned* cnt = (const unsigned*)(ws + WS_CTL) + CW_CNT + 64 * l; int total, pad; const int off = moe_offsets(cnt, lane, &total, &pad);
    const int endo = off + pad;
    const bf16_t* H = (const bf16_t*)(ws + WS_H); const bf16_t* W2T = (const bf16_t*)(ws + WS_W2T); bf16_t* YM = (bf16_t*)(ws + WS_YM);
    const int ntile = (total / 64) * 16;
    for (int tI = F.gw; tI < ntile; tI += F.ngw) {
        const int nt = tI & 15, rt = tI >> 4, row0 = rt * 64;
        const int e = __popcll(__ballot(lane < 32 && endo <= row0));
        EpiStoreBf16 E{YM, DM, nt * 64, nt * 64 + 32};
        sg_tile(H, 512, W2T + (size_t)(e * 1024 + nt * 64) * 512, W2T + (size_t)(e * 1024 + nt * 64 + 32) * 512, 512, 512, row0, E, lane);
    }
}
__device__ __forceinline__ void ph_moe_combine(Frame& F, const Args& A, int l) {
    PHASE_PIN(F);
    const int lane = F.lane; unsigned char* ws = F.ws;
    const unsigned* cnt = (const unsigned*)(ws + WS_CTL) + CW_CNT + 64 * l; int total, pad; const int off = moe_offsets(cnt, lane, &total, &pad);
    const int* EIDX = (const int*)(ws + SM_EIDX); const int* SLOT = (const int*)(ws + SM_SLOT); const float* GATEV = (const float*)(ws + SM_GATE);
    float* X = (float*)(ws + WS_X); bf16_t* XB = (bf16_t*)(ws + WS_XB); const bf16_t* YM = (const bf16_t*)(ws + WS_YM);
    const float* fg = A.in[35];
    for (int m = F.gw; m < NT; m += F.ngw) {
        const int ea = EIDX[2 * m], eb = EIDX[2 * m + 1]; const float ga = GATEV[2 * m], gb = GATEV[2 * m + 1];
        const int ra = __shfl(off, ea) + SLOT[2 * m], rb = __shfl(off, eb) + SLOT[2 * m + 1];
        f32x4* xr = (f32x4*)(X + (size_t)m * DM) + lane; const u32x2* ya = (const u32x2*)(YM + (size_t)ra * DM) + lane; const u32x2* yb = (const u32x2*)(YM + (size_t)rb * DM) + lane;
        f32x4 v[4]; float s = 0.f;
#pragma unroll
        for (int j = 0; j < 4; ++j) { v[j] = xr[64 * j]; const u32x2 a = ya[64 * j], bq = yb[64 * j];
            v[j].x += ga * __uint_as_float(a.x << 16) + gb * __uint_as_float(bq.x << 16); v[j].y += ga * __uint_as_float(a.x & 0xffff0000u) + gb * __uint_as_float(bq.x & 0xffff0000u);
            v[j].z += ga * __uint_as_float(a.y << 16) + gb * __uint_as_float(bq.y << 16); v[j].w += ga * __uint_as_float(a.y & 0xffff0000u) + gb * __uint_as_float(bq.y & 0xffff0000u);
            s += (v[j].x * v[j].x + v[j].y * v[j].y) + (v[j].z * v[j].z + v[j].w * v[j].w); }
        const float rstd = rsqrtf(wave_sum(s) * (1.f / DM) + RMS_EPS);
        if (l < 3) {
            u32x2* o8 = (u32x2*)(XB + (size_t)m * DM) + lane;
#pragma unroll
            for (int j = 0; j < 4; ++j) { xr[64 * j] = v[j]; u32x2 w; w.x = pk2(v[j].x * rstd, v[j].y * rstd); w.y = pk2(v[j].z * rstd, v[j].w * rstd); o8[64 * j] = w; }
        } else {
            f32x4* orow = (f32x4*)(F.out + (size_t)m * DM) + lane;
#pragma unroll
            for (int j = 0; j < 4; ++j) { const f32x4 gg = *((const f32x4*)fg + lane + 64 * j); orow[64 * j] = v[j] * gg * rstd; }
        }
    }
}

__global__ void __launch_bounds__(NTHR, 2) fwd_kernel(Args args) {
    extern __shared__ __attribute__((aligned(16))) unsigned char lds_raw[];
    Frame F; F.lds = (LAS unsigned char*)lds_raw; F.tid = threadIdx.x; F.lane = F.tid & 63; F.wave = __builtin_amdgcn_readfirstlane(F.tid >> 6);
    F.gw = blockIdx.x * NWAVES + F.wave; F.ngw = gridDim.x * NWAVES; F.out = args.out; F.ws = args.ws;
    volatile LAS unsigned* MISC = (volatile LAS unsigned*)(F.lds + LDS_MISC);
    if (F.tid < 64) MISC[F.tid] = 0u;
    __syncthreads();
    const int lo = args.ph_lo, hi = args.ph_hi;
    XcdBarrier bar; bar.bar = (unsigned*)(F.ws + WS_CTL) + CW_BAR; bar.x = 0; bar.st = MISC;
    if (hi - lo > 1) bar = xcd_barrier_post((unsigned*)(F.ws + WS_CTL) + CW_BAR, MISC);
#define IN(k) (lo <= (k) && (k) < hi)
#define SEAM(k) do { if ((k) + 1 < hi) xcd_barrier(bar); } while (0)
    unsigned char* ws = F.ws;
    if (IN(0)) { ph_prologue(F, args); SEAM(0); }
    for (int l = 0; l < 4; ++l) {
        const int pb = 1 + 16 * l, e = l >> 1;
        const float* xsrc = (l == 0) ? args.in[0] : (const float*)(ws + WS_X);
        if ((l & 1) == 0) {
            if (IN(pb + 0)) { sg_dense_bf16(F, (const bf16_t*)(ws + WS_XB), DM, (const bf16_t*)(ws + W_WIN) + (size_t)e * NCOL * DM, DM, NT, NCOL, (bf16_t*)(ws + WS_PROJ), NCOL); SEAM(pb + 0); }
            if (IN(pb + 1)) {
#ifndef NO_PREP
 ph_prep(F, args, e);
#endif
 SEAM(pb + 1); }
            if (IN(pb + 2)) {
#ifndef NO_SCAN
 ph_scan(F);
#endif
 SEAM(pb + 2); }
            if (IN(pb + 3)) {
#ifndef NO_SCORE
 ph_idx_score(F);
#endif
 SEAM(pb + 3); }
            if (IN(pb + 4)) {
#ifndef NO_SELECT
 ph_idx_select(F);
#endif
 SEAM(pb + 4); }
            if (IN(pb + 5)) {
#ifndef NO_SPARSE
 ph_sparse(F, args, e);
#endif
 SEAM(pb + 5); }
        } else {
            if (IN(pb + 0)) { sg_dense_bf16(F, (const bf16_t*)(ws + WS_XB), DM, (const bf16_t*)(ws + W_WQKV) + (size_t)e * 3072 * DM, DM, NT, 1024, (bf16_t*)(ws + WS_PROJ), 1024);
                              sg_dense_bf16(F, (const bf16_t*)(ws + WS_XB), DM, (const bf16_t*)(ws + W_WQKV) + (size_t)e * 3072 * DM + (size_t)1024 * DM, DM, NT, 1024, (bf16_t*)(ws + WS_PROJ) + (size_t)NT * 1024, 1024);
                              sg_dense_bf16(F, (const bf16_t*)(ws + WS_XB), DM, (const bf16_t*)(ws + W_WQKV) + (size_t)e * 3072 * DM + (size_t)2048 * DM, DM, NT, 1024, (bf16_t*)(ws + WS_PROJ) + (size_t)2 * NT * 1024, 1024);
                              SEAM(pb + 0); }
            if (IN(pb + 1)) {
#ifndef NO_SB
 ph_stickbreak(F);
#endif
 SEAM(pb + 1); }
        }
        if (IN(pb + 6)) { sg_dense_resid(F, (const bf16_t*)(ws + WS_YCAT), (const bf16_t*)(ws + ((l & 1) ? W_WOUTO : W_WOUTE)) + (size_t)e * DM * DM, xsrc, (float*)(ws + WS_X)); SEAM(pb + 6); }
        if (IN(pb + 7)) {
#ifndef NO_ROUTE
 ph_moe_route(F, args, l); moe_weight_prep(F, args, l);
#endif
 SEAM(pb + 7); }
        if (IN(pb + 8)) { ph_moe_gather(F, l); SEAM(pb + 8); }
        if (IN(pb + 9)) { ph_moe_gemm1(F, l); SEAM(pb + 9); }
        if (IN(pb + 10)) { ph_moe_gemm2(F, l); SEAM(pb + 10); }
        if (IN(pb + 11)) { ph_moe_combine(F, args, l); SEAM(pb + 11); }
    }
#undef IN
#undef SEAM
}

extern "C" void kernel_launch(void* const* d_in, const int* in_sizes, int n_in, void* d_out, int out_size, void* d_ws, size_t ws_size, hipStream_t stream) {
    static int grid = 0;
    if (grid == 0) {
        if (n_in != 36 || out_size != NT * DM || ws_size < WS_END) { fprintf(stderr, "kernel_launch: unexpected problem (n_in %d out %d ws %zu)\n", n_in, out_size, ws_size); grid = -1; return; }
        int dev = 0, cus = 0, per_cu = 0;
        if (hipGetDevice(&dev) != hipSuccess || hipDeviceGetAttribute(&cus, hipDeviceAttributeMultiprocessorCount, dev) != hipSuccess) { grid = -1; return; }
        if (hipFuncSetAttribute((const void*)fwd_kernel, hipFuncAttributeMaxDynamicSharedMemorySize, LDS_BYTES) != hipSuccess) { grid = -1; return; }
        if (hipOccupancyMaxActiveBlocksPerMultiprocessor(&per_cu, (const void*)fwd_kernel, NTHR, LDS_BYTES) != hipSuccess || per_cu < 1) { fprintf(stderr, "kernel_launch: occupancy query says %d\n", per_cu); }
        (void)hipGetLastError();
        grid = cus;
    }
    if (grid < 0) return;
    (void)hipMemsetAsync((char*)d_ws + WS_CTL, 0, CTL_ZERO_BYTES, stream);
    Args a{};
    for (int i = 0; i < 36; ++i) a.in[i] = (const float*)d_in[i];
    a.out = (float*)d_out; a.ws = (unsigned char*)d_ws;
#if ONE_LAUNCH
    a.ph_lo = 0; a.ph_hi = 65;
    hipLaunchKernelGGL(fwd_kernel, dim3(grid), dim3(NTHR), LDS_BYTES, stream, a);
#else
    for (int p = 0; p < 65; ++p) {
        const int l = (p - 1) >> 4, k = (p - 1) & 15;
        if (p > 0) { if (k > 11) continue; if ((l & 1) && k >= 2 && k <= 5) continue; }
        a.ph_lo = p; a.ph_hi = p + 1;
        hipLaunchKernelGGL(fwd_kernel, dim3(grid), dim3(NTHR), LDS_BYTES, stream, a);
    }
#endif
}
```

```cpp
#include <hip/hip_runtime.h>
#include <cstdio>
#include <cstdint>

#ifndef ONE_LAUNCH
#define ONE_LAUNCH 1
#endif

#define GAS __attribute__((address_space(1)))
#define LAS __attribute__((address_space(3)))
typedef unsigned short bf16_t;
typedef short bf16x8 __attribute__((ext_vector_type(8)));
typedef float f32x4 __attribute__((ext_vector_type(4)));
typedef float f32x2 __attribute__((ext_vector_type(2)));
typedef float f32x16 __attribute__((ext_vector_type(16)));
typedef unsigned u32x4 __attribute__((ext_vector_type(4)));
typedef unsigned u32x2 __attribute__((ext_vector_type(2)));

constexpr int NT = 16384, TT = 8192, DM = 1024, NB = 2;
constexpr int NCOL = 3584;
constexpr int C_R = 0, C_K = 512, C_V = 1024, C_QB = 1536, C_CKV = 2048, C_QI = 2176, C_KI = 2688, C_WI = 2752;
constexpr int C_PW = 2816, C_QW = 2880, C_PA = 2944, C_QA = 3008, C_PG = 3072, C_QG = 3200, C_PV = 3328, C_QV = 3360;
constexpr int NWAVES = 8, NTHR = 512;
constexpr float RMS_EPS = 1e-6f, GN_EPS = 64e-5f;
constexpr float LOG2E = 1.4426950408889634f;

constexpr size_t MiB = 1u << 20;
constexpr size_t WS_CTL = 0, CTL_ZERO_BYTES = 1 * MiB;
constexpr size_t WS_SMALL = 1 * MiB;
constexpr size_t SM_EIDX = WS_SMALL, SM_GATE = WS_SMALL + 128 * 1024, SM_SLOT = WS_SMALL + 256 * 1024, SM_BONUS = WS_SMALL + 512 * 1024, SM_SGN = WS_SMALL + 1024 * 1024;
constexpr size_t WS_W = 5 * MiB;
constexpr size_t W_WIN = WS_W, W_WOUTE = WS_W + 14 * MiB, W_WQKV = WS_W + 18 * MiB, W_WOUTO = WS_W + 30 * MiB, W_WKB = WS_W + 34 * MiB, W_WVT = W_WKB + 256 * 1024;
constexpr size_t WS_X = 45 * MiB, WS_XB = 109 * MiB, WS_PROJ = 141 * MiB, WS_SIN = 253 * MiB, WS_VF = 445 * MiB, WS_Y = 477 * MiB, WS_GATE = 509 * MiB, WS_YCAT = 541 * MiB;
constexpr size_t WS_CN = 573 * MiB, WS_KI = 577 * MiB, WS_QI = 579 * MiB, WS_QA = 595 * MiB, WS_SEL = 627 * MiB;
constexpr size_t WS_BIG = 645 * MiB;
constexpr size_t WS_SCORE = WS_BIG;
constexpr size_t WS_W13T = WS_BIG, WS_W2T = WS_BIG + 64 * MiB, WS_AMOE = WS_BIG + 96 * MiB, WS_H = WS_BIG + 176 * MiB, WS_YM = WS_BIG + 216 * MiB;
constexpr size_t WS_END = 941 * MiB;
constexpr size_t SCORE_PER_BATCH = (size_t)16384 * 2080;
static_assert(WS_SCORE + 2 * SCORE_PER_BATCH * 4 <= WS_END, "score map");
static_assert(WS_YM + (size_t)40960 * 1024 * 2 <= WS_END, "moe map");
constexpr int CW_BAR = 4096;
constexpr int CW_CNT = 16384;

constexpr int LDS_BYTES = 147456;
constexpr int LDS_WSCR = 16384;
constexpr int LDS_MISC = 131072;

__device__ __forceinline__ float bf2f(bf16_t b) { return __uint_as_float(((unsigned)b) << 16); }
__device__ __forceinline__ unsigned f2bf(float f) { unsigned u = __float_as_uint(f); return (u + 0x7fffu + ((u >> 16) & 1u)) >> 16; }
__device__ __forceinline__ unsigned pk2(float lo, float hi) { return f2bf(lo) | (f2bf(hi) << 16); }
__device__ __forceinline__ float wave_sum(float v) {
#pragma unroll
    for (int o = 1; o < 64; o <<= 1) v += __shfl_xor(v, o);
    return v;
}
__device__ __forceinline__ float wave_max(float v) {
#pragma unroll
    for (int o = 1; o < 64; o <<= 1) v = fmaxf(v, __shfl_xor(v, o));
    return v;
}
__device__ __forceinline__ float sigmoidf_(float x) { return 1.0f / (1.0f + __expf(-x)); }
#define LDS_WAIT() asm volatile("s_waitcnt lgkmcnt(0)" ::: "memory")

#define XB_TMO      128
#define XB_XCNT(j)  (256  + 64 * (j))
#define XB_XSUB(j)  (1280 + 64 * (j))
#define XB_XGEN(j)  (2304 + 64 * (j))
#define XB_TOP      3328
#define XB_TOPGEN   3392
#define XCD_BAR_WORDS 3456
#define XB_SPIN_CAP (1u << 18)
__device__ __forceinline__ unsigned xb_ld(unsigned* p)              { return __hip_atomic_load(p, __ATOMIC_RELAXED, __HIP_MEMORY_SCOPE_AGENT); }
__device__ __forceinline__ unsigned xb_add(unsigned* p, unsigned v) { return __hip_atomic_fetch_add(p, v, __ATOMIC_RELAXED, __HIP_MEMORY_SCOPE_AGENT); }
__device__ __forceinline__ unsigned xb_xcc_id() { return (unsigned)__builtin_amdgcn_s_getreg((3 << 11) | 20) & 0xFu; }
#define XB_SPIN(cond, bar) do { unsigned _sp = 0; while (cond) { __builtin_amdgcn_s_sleep(1); \
    if ((++_sp & 255u) == 0u) { if (xb_ld(&(bar)[XB_TMO])) break; if (_sp > XB_SPIN_CAP) { atomicAdd(&(bar)[XB_TMO], 1u); break; } } } } while (0)
struct XcdBarrier { unsigned* bar; unsigned x; volatile LAS unsigned* st; };
__device__ __forceinline__ XcdBarrier xcd_barrier_post(unsigned* bar, volatile LAS unsigned* st) {
    XcdBarrier b; b.bar = bar; b.x = xb_xcc_id(); b.st = st;
    if (threadIdx.x == 0) (void)xb_add(&bar[XB_XCNT(b.x)], 1u);
    return b;
}
__device__ __forceinline__ void xcd_barrier_complete(unsigned* bar, unsigned x, unsigned& nloc, unsigned& nx) {
    const unsigned G = gridDim.x * gridDim.y * gridDim.z;
    unsigned sum, cnt, mine, sp = 0u;
    for (;;) {
        sum = 0u; cnt = 0u; mine = 0u;
#pragma unroll
        for (unsigned j = 0; j < 16; ++j) { const unsigned c = xb_ld(&bar[XB_XCNT(j)]); sum += c; cnt += (c > 0u) ? 1u : 0u; mine = (j == x) ? c : mine; }
        if (sum == G) break;
        __builtin_amdgcn_s_sleep(1);
        if ((++sp & 255u) == 0u) { if (xb_ld(&bar[XB_TMO])) break; if (sp > XB_SPIN_CAP) { atomicAdd(&bar[XB_TMO], 1u); break; } }
    }
    nloc = mine > 0u ? mine : 1u; nx = cnt > 0u ? cnt : 1u;
}
__device__ __forceinline__ void xcd_barrier(const XcdBarrier& b) {
    asm volatile("s_waitcnt vmcnt(0)" ::: "memory");
    __syncthreads();
    if (threadIdx.x == 0) {
        unsigned* bar = b.bar;
        __builtin_amdgcn_s_waitcnt(0);
        unsigned nloc = b.st[0], nx = b.st[1];
        if (nloc == 0u) { xcd_barrier_complete(bar, b.x, nloc, nx); b.st[0] = nloc; b.st[1] = nx; }
        const unsigned old = xb_add(&bar[XB_XSUB(b.x)], 1u);
        const unsigned gen = old / nloc;
        if (old + 1u == (gen + 1u) * nloc) {
            __builtin_amdgcn_fence(__ATOMIC_RELEASE, "agent");
            asm volatile("s_waitcnt vmcnt(0)" ::: "memory");
            const unsigned og = xb_add(&bar[XB_TOP], 1u);
            const unsigned tg = og / nx;
            if (og + 1u == (tg + 1u) * nx) xb_add(&bar[XB_TOPGEN], 1u);
            else XB_SPIN(xb_ld(&bar[XB_TOPGEN]) == tg, bar);
            __builtin_amdgcn_fence(__ATOMIC_ACQUIRE, "agent");
            xb_add(&bar[XB_XGEN(b.x)], 1u);
            asm volatile("s_waitcnt vmcnt(0)" ::: "memory");
        } else {
            XB_SPIN(xb_ld(&bar[XB_XGEN(b.x)]) == gen, bar);
            __builtin_amdgcn_fence(__ATOMIC_ACQUIRE, "agent");
            asm volatile("s_waitcnt vmcnt(0)" ::: "memory");
        }
    }
    __syncthreads();
}

struct Args { const float* in[36]; float* out; unsigned char* ws; int ph_lo, ph_hi; };
struct Frame {
    LAS unsigned char* lds; int tid, lane, wave, gw, ngw;
    float* out; unsigned char* ws;
};

#define PHASE_PIN(F) do { unsigned long long _z64; int _z32; asm volatile("s_mov_b64 %0, 0\n\ts_mov_b32 %1, 0" : "=s"(_z64), "=s"(_z32)); \
    asm volatile("" : "+v"((F).tid), "+v"((F).lane)); (F).ws += _z64; (F).out += _z64; (F).gw += _z32; (F).ngw += _z32; (F).wave += _z32; } while (0)
struct TrJob { const float* W; int K, ldw, col_off, ncols; bf16_t* WT; int ldt, row_off; const float* g; const float* mu; int mode; float cs; };
__device__ __forceinline__ void tr_item(const TrJob& J, int item, LAS float* scr, int lane) {
    const int nblk = (J.ncols + 31) / 32, kb = item / nblk, nb = item % nblk, k0 = 64 * kb, n0 = 32 * nb;
#pragma unroll 8
    for (int i = 0; i < 32; ++i) {
        const int kk = 2 * i + (lane >> 5), n = lane & 31, k = k0 + kk;
        float v = 0.f;
        if (k < J.K && n0 + n < J.ncols) {
            float s = J.cs;
            if (J.g) s *= J.g[k];
            if (J.mode == 1) s *= (1.0f - J.mu[k]); else if (J.mode == 2) s *= J.mu[k];
            v = J.W[(size_t)k * J.ldw + J.col_off + n0 + n] * s;
        }
        scr[kk * 33 + n] = v;
    }
    LDS_WAIT(); asm volatile("" ::: "memory");
    const int c = lane & 7;
#pragma unroll
    for (int j = 0; j < 4; ++j) {
        const int n = (lane >> 3) + 8 * j; const LAS float* s = scr + (8 * c) * 33 + n;
        u32x4 o; o.x = pk2(s[0 * 33], s[1 * 33]); o.y = pk2(s[2 * 33], s[3 * 33]); o.z = pk2(s[4 * 33], s[5 * 33]); o.w = pk2(s[6 * 33], s[7 * 33]);
        if (n0 + n < J.ncols && k0 + 8 * c < J.K) *(u32x4*)(J.WT + (size_t)(J.row_off + n0 + n) * J.ldt + k0 + 8 * c) = o;
    }
    LDS_WAIT(); asm volatile("" ::: "memory");
}
__device__ __forceinline__ void tr_job(Frame& F, const TrJob& J, int rot) {
    LAS float* scr = (LAS float*)(F.lds + F.wave * LDS_WSCR);
    const int nitems = ((J.K + 63) / 64) * ((J.ncols + 31) / 32);
    int start = F.gw - (rot % F.ngw); if (start < 0) start += F.ngw;
    for (int it = start; it < nitems; it += F.ngw) tr_item(J, it, scr, F.lane);
}
__device__ __forceinline__ void zero_rows(Frame& F, bf16_t* WT, int ld, int r0, int r1) {
    const size_t n16 = (size_t)(r1 - r0) * ld / 8; u32x4* p = (u32x4*)(WT + (size_t)r0 * ld);
    for (size_t i = (size_t)F.gw * 64 + F.lane; i < n16; i += (size_t)F.ngw * 64) p[i] = (u32x4){0u, 0u, 0u, 0u};
}
__device__ __forceinline__ void row_norm_to_bf16(const float* xrow, bf16_t* orow, int lane) {
    const f32x4* xr = (const f32x4*)xrow + lane; f32x4 v[4]; float s = 0.f;
#pragma unroll
    for (int j = 0; j < 4; ++j) { v[j] = xr[64 * j]; s += (v[j].x * v[j].x + v[j].y * v[j].y) + (v[j].z * v[j].z + v[j].w * v[j].w); }
    const float rstd = rsqrtf(wave_sum(s) * (1.f / DM) + RMS_EPS);
    u32x2* o8 = (u32x2*)orow + lane;
#pragma unroll
    for (int j = 0; j < 4; ++j) { u32x2 w; w.x = pk2(v[j].x * rstd, v[j].y * rstd); w.y = pk2(v[j].z * rstd, v[j].w * rstd); o8[64 * j] = w; }
}

__device__ __forceinline__ void ph_prologue(Frame& F, const Args& A) {
    PHASE_PIN(F);
    unsigned char* ws = F.ws; int rot = 0;
    for (int e = 0; e < 2; ++e) {
        bf16_t* WT = (bf16_t*)(ws + W_WIN) + (size_t)e * NCOL * DM;
        const float* g = A.in[1] + e * DM; const float* mul = A.in[5] + (size_t)e * 3 * DM;
        TrJob J{A.in[2] + (size_t)e * DM * 2760, DM, 2760, 0, 2760, WT, DM, 0, g, nullptr, 0, 1.0f}; tr_job(F, J, rot); rot += 1392;
        zero_rows(F, WT, DM, 2760, C_PW);
        TrJob Jw1{A.in[7] + (size_t)e * DM * 64, DM, 64, 0, 64, WT, DM, C_PW, g, mul, 1, 1.0f}; tr_job(F, Jw1, rot); rot += 32;
        TrJob Jw2{A.in[7] + (size_t)e * DM * 64, DM, 64, 0, 64, WT, DM, C_QW, g, mul, 2, 1.0f}; tr_job(F, Jw2, rot); rot += 32;
        TrJob Ja1{A.in[10] + (size_t)e * DM * 64, DM, 64, 0, 64, WT, DM, C_PA, g, mul + DM, 1, 1.0f}; tr_job(F, Ja1, rot); rot += 32;
        TrJob Ja2{A.in[10] + (size_t)e * DM * 64, DM, 64, 0, 64, WT, DM, C_QA, g, mul + DM, 2, 1.0f}; tr_job(F, Ja2, rot); rot += 32;
        TrJob Jg1{A.in[12] + (size_t)e * DM * 128, DM, 128, 0, 128, WT, DM, C_PG, g, mul + 2 * DM, 1, 1.0f}; tr_job(F, Jg1, rot); rot += 64;
        TrJob Jg2{A.in[12] + (size_t)e * DM * 128, DM, 128, 0, 128, WT, DM, C_QG, g, mul + 2 * DM, 2, 1.0f}; tr_job(F, Jg2, rot); rot += 64;
        if (e == 1) {
            TrJob Jv1{A.in[21], DM, 32, 0, 32, WT, DM, C_PV, g, A.in[19], 1, 1.0f}; tr_job(F, Jv1, rot); rot += 16;
            TrJob Jv2{A.in[21], DM, 32, 0, 32, WT, DM, C_QV, g, A.in[19], 2, 1.0f}; tr_job(F, Jv2, rot); rot += 16;
            zero_rows(F, WT, DM, C_QV + 32, NCOL);
        } else zero_rows(F, WT, DM, C_PV, NCOL);
        TrJob Jo{A.in[3] + (size_t)e * DM * DM, DM, DM, 0, DM, (bf16_t*)(ws + W_WOUTE) + (size_t)e * DM * DM, DM, 0, nullptr, nullptr, 0, 1.0f}; tr_job(F, Jo, rot); rot += 512;
        { const float* Wkv = A.in[24] + (size_t)e * 128 * 1024; bf16_t* WkB = (bf16_t*)(ws + W_WKB) + (size_t)e * 8 * 128 * 64;
          for (int i = F.gw * 64 + F.lane; i < 8 * 128 * 64; i += F.ngw * 64) { const int d = i & 63, r = (i >> 6) & 127, h = i >> 13; WkB[i] = (bf16_t)f2bf(Wkv[(size_t)r * 1024 + h * 64 + d]); } }
        TrJob Jv{A.in[24] + (size_t)e * 128 * 1024, 128, 1024, 512, 512, (bf16_t*)(ws + W_WVT) + (size_t)e * 512 * 128, 128, 0, nullptr, nullptr, 0, 1.0f}; tr_job(F, Jv, rot); rot += 32;
    }
    for (int o = 0; o < 2; ++o) {
        const float* g = A.in[26] + o * DM; bf16_t* WT = (bf16_t*)(ws + W_WQKV) + (size_t)o * 3072 * DM;
        TrJob Jq{A.in[27] + (size_t)o * DM * 3072, DM, 3072, 0, 1024, WT, DM, 0, g, nullptr, 0, LOG2E * 0.125f}; tr_job(F, Jq, rot); rot += 512;
        TrJob Jk{A.in[27] + (size_t)o * DM * 3072, DM, 3072, 1024, 2048, WT, DM, 1024, g, nullptr, 0, 1.0f}; tr_job(F, Jk, rot); rot += 1024;
        TrJob Jo{A.in[28] + (size_t)o * DM * DM, DM, DM, 0, DM, (bf16_t*)(ws + W_WOUTO) + (size_t)o * DM * DM, DM, 0, nullptr, nullptr, 0, 1.0f}; tr_job(F, Jo, rot); rot += 512;
    }
    for (int m = F.gw; m < NT; m += F.ngw) row_norm_to_bf16(A.in[0] + (size_t)m * DM, (bf16_t*)(ws + WS_XB) + (size_t)m * DM, F.lane);
}

__device__ __forceinline__ void moe_weight_prep(Frame& F, const Args& A, int l) {
    PHASE_PIN(F);
    LAS float* scr = (LAS float*)(F.lds + F.wave * LDS_WSCR);
    const float* g = A.in[29] + l * DM;
    const float* w1 = A.in[32] + (size_t)l * 32 * DM * 512; const float* w3 = A.in[33] + (size_t)l * 32 * DM * 512; const float* w2 = A.in[34] + (size_t)l * 32 * 512 * DM;
    bf16_t* W13T = (bf16_t*)(F.ws + WS_W13T); bf16_t* W2T = (bf16_t*)(F.ws + WS_W2T);
    for (int it = F.gw; it < 16384; it += F.ngw) {
        const int job = it >> 6, item = it & 63, which = job & 1, j = (job >> 1) & 3, e = job >> 3;
        TrJob J{(which ? w3 : w1) + (size_t)e * DM * 512, DM, 512, 128 * j, 128, W13T, DM, e * 1024 + 256 * j + 128 * which, g, nullptr, 0, 1.0f};
        tr_item(J, item, scr, F.lane);
    }
    for (int it = F.gw; it < 8192; it += F.ngw) {
        const int e = it >> 8, item = it & 255;
        TrJob J{w2 + (size_t)e * 512 * DM, 512, DM, 0, DM, W2T, 512, e * 1024, nullptr, nullptr, 0, 1.0f};
        tr_item(J, item, scr, F.lane);
    }
}

#define MFMA32(a, b, c) __builtin_amdgcn_mfma_f32_32x32x16_bf16((a), (b), (c), 0, 0, 0)
template <class Epi>
__device__ __forceinline__ void sg_tile(const bf16_t* A, int lda, const bf16_t* B0, const bf16_t* B1, int ldb, int K, int m0, const Epi& epi, int lane) {
    const int r = lane & 31, h = lane >> 5;
    const bf16_t* a0 = A + (size_t)(m0 + r) * lda + 8 * h; const bf16_t* a1 = a0 + (size_t)32 * lda;
    const bf16_t* b0 = B0 + (size_t)r * ldb + 8 * h; const bf16_t* b1 = B1 + (size_t)r * ldb + 8 * h;
    f32x16 c00, c01, c10, c11;
#pragma unroll
    for (int i = 0; i < 16; ++i) { c00[i] = 0.f; c01[i] = 0.f; c10[i] = 0.f; c11[i] = 0.f; }
#pragma unroll 4
    for (int k = 0; k < K; k += 16) {
        const bf16x8 fa0 = *(const bf16x8*)(a0 + k), fa1 = *(const bf16x8*)(a1 + k), fb0 = *(const bf16x8*)(b0 + k), fb1 = *(const bf16x8*)(b1 + k);
        c00 = MFMA32(fb0, fa0, c00); c01 = MFMA32(fb1, fa0, c01); c10 = MFMA32(fb0, fa1, c10); c11 = MFMA32(fb1, fa1, c11);
    }
#pragma unroll
    for (int g = 0; g < 4; ++g) {
        const int j = 8 * g + 4 * h;
        epi.pair(m0 + r, j, (f32x4){c00[4 * g], c00[4 * g + 1], c00[4 * g + 2], c00[4 * g + 3]}, (f32x4){c01[4 * g], c01[4 * g + 1], c01[4 * g + 2], c01[4 * g + 3]});
        epi.pair(m0 + 32 + r, j, (f32x4){c10[4 * g], c10[4 * g + 1], c10[4 * g + 2], c10[4 * g + 3]}, (f32x4){c11[4 * g], c11[4 * g + 1], c11[4 * g + 2], c11[4 * g + 3]});
    }
}
struct EpiStoreBf16 {
    bf16_t* O; int ldo, n0, n1;
    __device__ __forceinline__ void pair(int row, int j, f32x4 v0, f32x4 v1) const {
        u32x2 w; w.x = pk2(v0.x, v0.y); w.y = pk2(v0.z, v0.w); *(u32x2*)(O + (size_t)row * ldo + n0 + j) = w;
        w.x = pk2(v1.x, v1.y); w.y = pk2(v1.z, v1.w); *(u32x2*)(O + (size_t)row * ldo + n1 + j) = w;
    }
};
struct EpiResidF32 {
    const float* S; float* X; int n0, n1;
    __device__ __forceinline__ void pair(int row, int j, f32x4 v0, f32x4 v1) const {
        const size_t o0 = (size_t)row * DM + n0 + j, o1 = (size_t)row * DM + n1 + j;
        *(f32x4*)(X + o0) = *(const f32x4*)(S + o0) + v0; *(f32x4*)(X + o1) = *(const f32x4*)(S + o1) + v1;
    }
};
struct EpiGated {
    bf16_t* H; int hc;
    __device__ __forceinline__ void pair(int row, int j, f32x4 a, f32x4 b) const {
        f32x4 o;
#pragma unroll
        for (int i = 0; i < 4; ++i) o[i] = a[i] * sigmoidf_(a[i]) * b[i];
        u32x2 w; w.x = pk2(o.x, o.y); w.y = pk2(o.z, o.w); *(u32x2*)(H + (size_t)row * 512 + hc + j) = w;
    }
};
__device__ __forceinline__ void sg_dense_bf16(Frame& F, const bf16_t* A, int lda, const bf16_t* Bt, int K, int M, int N, bf16_t* O, int ldo) {
    PHASE_PIN(F);
    const int nN = N / 64, ntile = (M / 64) * nN;
    for (int t = F.gw; t < ntile; t += F.ngw) {
        const int mt = t / nN, nt = t % nN; EpiStoreBf16 E{O, ldo, nt * 64, nt * 64 + 32};
        sg_tile(A, lda, Bt + (size_t)(nt * 64) * K, Bt + (size_t)(nt * 64 + 32) * K, K, K, mt * 64, E, F.lane);
    }
}
__device__ __forceinline__ void sg_dense_resid(Frame& F, const bf16_t* A, const bf16_t* Bt, const float* S, float* X) {
    PHASE_PIN(F);
    const int nN = DM / 64, ntile = (NT / 64) * nN;
    for (int t = F.gw; t < ntile; t += F.ngw) {
        const int mt = t / nN, nt = t % nN; EpiResidF32 E{S, X, nt * 64, nt * 64 + 32};
        sg_tile(A, DM, Bt + (size_t)(nt * 64) * DM, Bt + (size_t)(nt * 64 + 32) * DM, DM, DM, mt * 64, E, F.lane);
    }
}

namespace pg8 {
#define PG8_LAS __attribute__((address_space(3)))
typedef unsigned short bf16_t;
typedef short bf16x8 __attribute__((ext_vector_type(8)));
typedef float f32x4 __attribute__((ext_vector_type(4)));
typedef unsigned u32x4 __attribute__((ext_vector_type(4)));
constexpr int BM = 256, BK = 64, HALF = 128, HTB = HALF * BK * 2  , STAGE_BYTES = 8 * HTB, NXCD = 8, WGM = 8;

__host__ __device__ __forceinline__ int lds_byte(int r, int c) { const int st = (r >> 4) * 2 + (c >> 5), rr = r & 15, cc = c & 31, ob = rr * 64 + cc * 2; return st * 1024 + (ob ^ (((ob >> 9) & 1) << 5)); }
__host__ __device__ __forceinline__ void stage_rc(int b, int& R, int& C) { const int st = b / 1024, sb = b % 1024, swz = sb ^ (((sb >> 9) & 1) << 5); R = (st >> 1) * 16 + swz / 64; C = (st & 1) * 32 + (swz % 64) / 2; }
__host__ __device__ __forceinline__ int perm32(int rho) { const int n = rho >> 4, i = rho & 15; return 8 * (i >> 2) + 4 * n + (i & 3); }

struct Unit { int pm, pn; };
struct Gemm { const bf16_t* A; const bf16_t* Bt; int M, N, K; };

struct StaticOrder {
    int nM, nN, nwg, G, c;
    __host__ __device__ void init(int M, int N, int G_, int c_) { nM = M / BM; nN = N / BM; nwg = nM * nN; G = G_; c = c_; }
    __host__ __device__ bool next(int i, Unit& u) const {
        const long L = (long)i * G + c; if (L >= nwg) return false;
        int wgid = (int)L; { const int q = nwg / NXCD, r = nwg % NXCD, xcd = wgid % NXCD, off = wgid / NXCD; wgid = (xcd < r ? xcd * (q + 1) : r * (q + 1) + (xcd - r) * q) + off; }
        const int nig = WGM * nN, gid = wgid / nig, fm = gid * WGM, gsz = (nM - fm) < WGM ? (nM - fm) : WGM;
        u.pm = fm + ((wgid % nig) % gsz); u.pn = (wgid % nig) / gsz; return true;
    }
    __device__ __forceinline__ void a_ready(const Unit&) const {}
    __device__ __forceinline__ void done(const Unit&) const {}
};

__device__ __forceinline__ unsigned cvt_pk_bf16(float lo, float hi) { unsigned r; asm volatile("v_cvt_pk_bf16_f32 %0, %1, %2" : "=v"(r) : "v"(lo), "v"(hi)); return r; }
struct EpiBf16S {
    static constexpr bool PERM = true, AFTER_DRAIN = false;
    bf16_t* O; int ldc; int split_cols; size_t split_stride;
    __device__ __forceinline__ void operator()(const f32x4 (&acc)[2][2][4][2], const Unit& u, int wr, int wc, int fr, int fq) const {
        const int row0 = u.pm * BM + wr * 64 + fr; int colt = u.pn * BM; bf16_t* base = O;
        if (split_cols) { const int t = colt / split_cols; base += (size_t)t * split_stride; colt -= t * split_cols; }
        const int col0 = colt + wc * 32 + 8 * fq;
#pragma unroll
        for (int ai = 0; ai < 2; ++ai)
#pragma unroll
            for (int m = 0; m < 4; ++m) { bf16_t* rowp = base + (size_t)(row0 + ai * HALF + m * 16) * ldc + col0;
#pragma unroll
                for (int bj = 0; bj < 2; ++bj) { const f32x4 v0 = acc[ai][bj][m][0], v1 = acc[ai][bj][m][1];
                    u32x4 w; w.x = cvt_pk_bf16(v0[0], v0[1]); w.y = cvt_pk_bf16(v0[2], v0[3]); w.z = cvt_pk_bf16(v1[0], v1[1]); w.w = cvt_pk_bf16(v1[2], v1[3]);
                    *(u32x4*)(rowp + bj * HALF) = w; } }
    }
};
struct EpiResid {
    static constexpr bool PERM = false, AFTER_DRAIN = false;
    const float* S; float* X;
    __device__ __forceinline__ void operator()(const f32x4 (&acc)[2][2][4][2], const Unit& u, int wr, int wc, int fr, int fq) const {
        const int row0 = u.pm * BM + wr * 64 + fr, col0 = u.pn * BM + wc * 32 + 4 * fq;
#pragma unroll
        for (int ai = 0; ai < 2; ++ai)
#pragma unroll
            for (int m = 0; m < 4; ++m) { const size_t off = (size_t)(row0 + ai * HALF + m * 16) * 1024 + col0;
#pragma unroll
                for (int bj = 0; bj < 2; ++bj)
#pragma unroll
                    for (int n = 0; n < 2; ++n) *(f32x4*)(X + off + bj * HALF + n * 16) = *(const f32x4*)(S + off + bj * HALF + n * 16) + acc[ai][bj][m][n]; }
    }
};
struct EpiGate {
    static constexpr bool PERM = true, AFTER_DRAIN = false;
    bf16_t* H;
    __device__ __forceinline__ void operator()(const f32x4 (&acc)[2][2][4][2], const Unit& u, int wr, int wc, int fr, int fq) const {
        const int row0 = u.pm * BM + wr * 64 + fr, col0 = (u.pn & 3) * 128 + wc * 32 + 8 * fq;
#pragma unroll
        for (int ai = 0; ai < 2; ++ai)
#pragma unroll
            for (int m = 0; m < 4; ++m) { float o[8];
#pragma unroll
                for (int n = 0; n < 2; ++n)
#pragma unroll
                    for (int i = 0; i < 4; ++i) { const float a = acc[ai][0][m][n][i], b = acc[ai][1][m][n][i]; o[4 * n + i] = a * b * __builtin_amdgcn_rcpf(1.0f + __builtin_amdgcn_exp2f(-1.4426950408889634f * a)); }
                u32x4 w; w.x = cvt_pk_bf16(o[0], o[1]); w.y = cvt_pk_bf16(o[2], o[3]); w.z = cvt_pk_bf16(o[4], o[5]); w.w = cvt_pk_bf16(o[6], o[7]);
                *(u32x4*)(H + (size_t)(row0 + ai * HALF + m * 16) * 512 + col0) = w; }
    }
};
struct EpiMoeDown {
    static constexpr bool PERM = true, AFTER_DRAIN = false;
    bf16_t* Y;
    __device__ __forceinline__ void operator()(const f32x4 (&acc)[2][2][4][2], const Unit& u, int wr, int wc, int fr, int fq) const {
        const int row0 = u.pm * BM + wr * 64 + fr, col0 = (u.pn & 3) * BM + wc * 32 + 8 * fq;
#pragma unroll
        for (int ai = 0; ai < 2; ++ai)
#pragma unroll
            for (int m = 0; m < 4; ++m) { bf16_t* rowp = Y + (size_t)(row0 + ai * HALF + m * 16) * 1024 + col0;
#pragma unroll
                for (int bj = 0; bj < 2; ++bj) { const f32x4 v0 = acc[ai][bj][m][0], v1 = acc[ai][bj][m][1];
                    u32x4 w; w.x = cvt_pk_bf16(v0[0], v0[1]); w.y = cvt_pk_bf16(v0[2], v0[3]); w.z = cvt_pk_bf16(v1[0], v1[1]); w.w = cvt_pk_bf16(v1[2], v1[3]);
                    *(u32x4*)(rowp + bj * HALF) = w; } }
    }
};
struct MoeOrder {
    int nunits, G, c; const PG8_LAS int* tab;
    __device__ __forceinline__ bool next(int i, Unit& u) const {
        const int L = i * G + c; if (L >= nunits) return false;
        const int rt = L >> 2; u.pm = rt; u.pn = __builtin_amdgcn_readfirstlane(tab[rt]) * 4 + (L & 3); return true;
    }
    __device__ __forceinline__ void a_ready(const Unit&) const {}
    __device__ __forceinline__ void done(const Unit&) const {}
};
template <class Epi, class Sched, bool STAMP = false>
__device__ __forceinline__ void gemm_phase(PG8_LAS unsigned char* lds, const Gemm g, const Sched& S, const Epi& E, unsigned long long* stamps) {
    int tid_ = threadIdx.x; asm volatile("" : "+v"(tid_)); const int tid = tid_, wid = __builtin_amdgcn_readfirstlane(tid >> 6), lane = tid & 63, wr = wid >> 2, wc = wid & 3, fr = lane & 15, fq = lane >> 4;
    const int K = g.K, nt = K / BK;
    int ts_lo = 0, ts_hi = 0, nts = 0; const unsigned long long rt_entry = STAMP ? (unsigned long long)wall_clock64() : 0ull;
#define PG8_STAMP() do { if (STAMP && wid == 0 && nts < 64) { const unsigned long long _c = (unsigned long long)clock64(); \
        ts_lo = (lane == nts) ? (int)(unsigned)_c : ts_lo; ts_hi = (lane == nts) ? (int)(unsigned)(_c >> 32) : ts_hi; ++nts; } } while (0)
    PG8_STAMP();
    unsigned voffA[2], voffB[2];
#pragma unroll
    for (int i = 0; i < 2; ++i) { int R, C; stage_rc(tid * 16 + i * 8192, R, C); const int Rb = Epi::PERM ? ((R & ~31) + perm32(R & 31)) : R;
        voffA[i] = (unsigned)(R * K + C) * 2u; voffB[i] = (unsigned)(Rb * K + C) * 2u; }
    const size_t kstep = (size_t)(BK * 2);
    const size_t hstep = (size_t)HALF * K * 2;
    const size_t tstep = 2 * hstep;
    const unsigned ldsw = (unsigned)wid * 1024u;
    const int aoff = lds_byte(wr * 64 + fr, fq * 8), boff = lds_byte(wc * 32 + fr, fq * 8);
#define PG8_SA(b, h) (((b) * 2 + (h)) * HTB)
#define PG8_SB(b, h) ((4 + (b) * 2 + (h)) * HTB)
#define PG8_STAGE(bufoff, gbase, voff) do { _Pragma("unroll") for (int _i = 0; _i < 2; ++_i) \
        __builtin_amdgcn_global_load_lds((const unsigned*)((const char*)(gbase) + (voff)[_i]), (PG8_LAS unsigned*)(lds + (bufoff) + ldsw + _i * 8192), 16, 0, 0); } while (0)
#define PG8_LDA(dst, b, h) do { _Pragma("unroll") for (int m = 0; m < 4; ++m) _Pragma("unroll") for (int k = 0; k < 2; ++k) dst[m][k] = *(const PG8_LAS bf16x8*)(lds + PG8_SA(b, h) + aoff + m * 2048 + k * 1024); } while (0)
#define PG8_LDB(dst, b, h) do { _Pragma("unroll") for (int n = 0; n < 2; ++n) _Pragma("unroll") for (int k = 0; k < 2; ++k) dst[n][k] = *(const PG8_LAS bf16x8*)(lds + PG8_SB(b, h) + boff + n * 2048 + k * 1024); } while (0)
#define PG8_MMA(ai, bj, At, Bt) do { __builtin_amdgcn_s_setprio(1); _Pragma("unroll") for (int m = 0; m < 4; ++m) _Pragma("unroll") for (int n = 0; n < 2; ++n) _Pragma("unroll") for (int k = 0; k < 2; ++k) \
        acc[ai][bj][m][n] = __builtin_amdgcn_mfma_f32_16x16x32_bf16(Bt[n][k], At[m][k], acc[ai][bj][m][n], 0, 0, 0); __builtin_amdgcn_s_setprio(0); } while (0)
#define PG8_WAIT_V(n) asm volatile("s_waitcnt vmcnt(" #n ")" ::: "memory")
#define PG8_WAIT_L(n) asm volatile("s_waitcnt lgkmcnt(" #n ")" ::: "memory")
#define PG8_BAR __builtin_amdgcn_s_barrier()
#define PG8_SCHED __builtin_amdgcn_sched_barrier(0)
    Unit cur, nxt; int ui = 0;
    if (!S.next(0, cur)) return;
    f32x4 acc[2][2][4][2];
#pragma unroll
    for (int a = 0; a < 2; ++a)
#pragma unroll
        for (int b = 0; b < 2; ++b)
#pragma unroll
            for (int m = 0; m < 4; ++m)
#pragma unroll
                for (int n = 0; n < 2; ++n) acc[a][b][m][n] = (f32x4){0.f, 0.f, 0.f, 0.f};
    bf16x8 At[4][2], B0[2][2], B1[2][2];
    const char* cA = (const char*)g.A + (size_t)cur.pm * tstep; const char* cB = (const char*)g.Bt + (size_t)cur.pn * tstep;
    S.a_ready(cur);
    PG8_STAGE(PG8_SB(0, 0), cB, voffB); PG8_STAGE(PG8_SA(0, 0), cA, voffA); PG8_STAGE(PG8_SB(0, 1), cB + hstep, voffB); PG8_STAGE(PG8_SA(0, 1), cA + hstep, voffA);
    if (wr == 1) PG8_BAR;
    PG8_WAIT_V(4); PG8_BAR;
    PG8_STAGE(PG8_SB(1, 0), cB + kstep, voffB); PG8_STAGE(PG8_SA(1, 0), cA + kstep, voffA); PG8_STAGE(PG8_SB(1, 1), cB + hstep + kstep, voffB);
    PG8_WAIT_V(6); PG8_BAR;
    PG8_STAMP();
    for (;;) {
        const bool has_next = S.next(ui + 1, nxt);
        const char* nA = has_next ? (const char*)g.A + (size_t)nxt.pm * tstep : cA; const char* nB = has_next ? (const char*)g.Bt + (size_t)nxt.pn * tstep : cB;
        for (int t = 0; t < nt; t += 2) {
            const bool last = (t == nt - 2);
            const char* a1 = cA + (size_t)(t + 1) * kstep;
            const char* a2 = last ? nA : cA + (size_t)(t + 2) * kstep; const char* b2 = last ? nB : cB + (size_t)(t + 2) * kstep;
            const char* a3 = a2 + kstep; const char* b3 = b2 + kstep;
            if (last && has_next) S.a_ready(nxt);
            PG8_LDB(B0, 0, 0); PG8_SCHED; PG8_LDA(At, 0, 0); PG8_STAGE(PG8_SA(1, 1), a1 + hstep, voffA);
            PG8_WAIT_L(8); PG8_BAR; PG8_WAIT_L(0); PG8_MMA(0, 0, At, B0); PG8_BAR; PG8_SCHED;
            PG8_LDB(B1, 0, 1); PG8_STAGE(PG8_SB(0, 0), b2, voffB);
            PG8_BAR; PG8_WAIT_L(0); PG8_MMA(0, 1, At, B1); PG8_BAR;
            PG8_LDA(At, 0, 1); PG8_STAGE(PG8_SA(0, 0), a2, voffA);
            PG8_BAR; PG8_WAIT_L(0); PG8_MMA(1, 0, At, B0); PG8_BAR; PG8_SCHED;
            PG8_STAGE(PG8_SB(0, 1), b2 + hstep, voffB);
            PG8_WAIT_V(6); PG8_BAR; PG8_MMA(1, 1, At, B1); PG8_BAR;
            PG8_LDB(B0, 1, 0); PG8_SCHED; PG8_LDA(At, 1, 0); PG8_STAGE(PG8_SA(0, 1), a2 + hstep, voffA);
            PG8_WAIT_L(8); PG8_BAR; PG8_WAIT_L(0); PG8_MMA(0, 0, At, B0); PG8_BAR; PG8_SCHED;
            PG8_LDB(B1, 1, 1); PG8_STAGE(PG8_SB(1, 0), b3, voffB);
            PG8_BAR; PG8_WAIT_L(0); PG8_MMA(0, 1, At, B1); PG8_BAR;
            PG8_LDA(At, 1, 1); PG8_STAGE(PG8_SA(1, 0), a3, voffA);
            PG8_BAR; PG8_WAIT_L(0); PG8_MMA(1, 0, At, B0); PG8_BAR; PG8_SCHED;
            PG8_STAGE(PG8_SB(1, 1), b3 + hstep, voffB);
            PG8_WAIT_V(6); PG8_BAR; PG8_MMA(1, 1, At, B1); PG8_BAR;
        }
        PG8_STAMP();
        if constexpr (!Epi::AFTER_DRAIN) { E(acc, cur, wr, wc, fr, fq); S.done(cur); }
        PG8_STAMP();
        if (!has_next) break;
#pragma unroll
        for (int a = 0; a < 2; ++a)
#pragma unroll
            for (int b = 0; b < 2; ++b)
#pragma unroll
                for (int m = 0; m < 4; ++m)
#pragma unroll
                    for (int n = 0; n < 2; ++n) acc[a][b][m][n] = (f32x4){0.f, 0.f, 0.f, 0.f};
        cur = nxt; cA = nA; cB = nB; ++ui;
    }
    PG8_WAIT_V(0);
    if (wr == 0) PG8_BAR;
    PG8_BAR;
    if constexpr (Epi::AFTER_DRAIN) { E.fused(acc, cur, wr, wc, fr, fq, lds, wid, lane); S.done(cur); }
    PG8_STAMP();
    if (STAMP && wid == 0) { stamps[lane] = lane < nts ? (((unsigned long long)(unsigned)ts_hi << 32) | (unsigned)ts_lo) : 0ull;
        if (lane == 62) stamps[62] = rt_entry; if (lane == 63) stamps[63] = (unsigned long long)wall_clock64(); }
#undef PG8_STAMP
#undef PG8_SA
#undef PG8_SB
#undef PG8_STAGE
#undef PG8_LDA
#undef PG8_LDB
#undef PG8_MMA
#undef PG8_WAIT_V
#undef PG8_WAIT_L
#undef PG8_BAR
#undef PG8_SCHED
}
}

__device__ __forceinline__ void ph_prep(Frame& F, const Args& A, int e) {
    PHASE_PIN(F);
    LAS float* sc = (LAS float*)(F.lds + F.wave * LDS_WSCR);
    unsigned char* ws = F.ws; const int lane = F.lane;
    const bf16_t* proj = (const bf16_t*)(ws + WS_PROJ);
    const float* mu_rkv = A.in[4] + (size_t)e * 3 * 512;
    const float* w0 = A.in[6] + e * 512; const float* w2 = A.in[8] + (size_t)e * 64 * 512;
    const float* a0 = A.in[9] + e * 512; const float* a2 = A.in[11] + (size_t)e * 64 * 512;
    const float* g2 = A.in[13] + (size_t)e * 128 * 512;
    const float* k_k = A.in[14] + e * 512; const float* k_a = A.in[15] + e * 512; const float* r_k = A.in[16] + e * 512;
    const float* v0 = A.in[20]; const float* v2 = A.in[22];
    const float* kvn = A.in[23] + e * 128; const float* ikn = A.in[25] + e * 64;
    float* SIN = (float*)(ws + WS_SIN); float* VF = (float*)(ws + WS_VF); float* GATE = (float*)(ws + WS_GATE); float* BON = (float*)(ws + SM_BONUS);
    unsigned* SGN = (unsigned*)(ws + SM_SGN);
    bf16_t* CN = (bf16_t*)(ws + WS_CN); bf16_t* KI = (bf16_t*)(ws + WS_KI); bf16_t* QI = (bf16_t*)(ws + WS_QI);
    for (int m = F.gw; m < NT; m += F.ngw) {
        const int t = m & (TT - 1), b = m >> 13; const bool hp = t > 0;
        const bf16_t* pr = proj + (size_t)m * NCOL; const bf16_t* pp = pr - NCOL;
        { const float lw = bf2f(pr[C_PW + lane]) + (hp ? bf2f(pp[C_QW + lane]) : 0.f);
          const float la = bf2f(pr[C_PA + lane]) + (hp ? bf2f(pp[C_QA + lane]) : 0.f);
          const float lg0 = bf2f(pr[C_PG + lane]) + (hp ? bf2f(pp[C_QG + lane]) : 0.f);
          const float lg1 = bf2f(pr[C_PG + 64 + lane]) + (hp ? bf2f(pp[C_QG + 64 + lane]) : 0.f);
          sc[lane] = tanhf(lw); sc[64 + lane] = la; sc[128 + lane] = sigmoidf_(lg0); sc[192 + lane] = sigmoidf_(lg1);
          if (lane < 32) sc[256 + lane] = bf2f(pr[C_PV + lane]) + (hp ? bf2f(pp[C_QV + lane]) : 0.f); }
        { const float c0 = bf2f(pr[C_CKV + lane]), c1 = bf2f(pr[C_CKV + 64 + lane]);
          const float rs = rsqrtf(wave_sum(c0 * c0 + c1 * c1) * (1.f / 128.f) + RMS_EPS);
          CN[(size_t)m * 128 + lane] = (bf16_t)f2bf(c0 * rs * kvn[lane]); CN[(size_t)m * 128 + 64 + lane] = (bf16_t)f2bf(c1 * rs * kvn[64 + lane]);
          const float ki = bf2f(pr[C_KI + lane]); const float rs2 = rsqrtf(wave_sum(ki * ki) * (1.f / 64.f) + RMS_EPS);
          KI[(size_t)m * 64 + lane] = (bf16_t)f2bf(ki * rs2 * ikn[lane]);
          unsigned sg = 0;
#pragma unroll
          for (int hh = 0; hh < 8; ++hh) { const float w = bf2f(pr[C_WI + hh]); if (w < 0.f) sg |= 1u << hh;
              QI[(size_t)m * 512 + hh * 64 + lane] = (bf16_t)f2bf(fabsf(w) * bf2f(pr[C_QI + hh * 64 + lane])); }
          if (lane == 0) SGN[m] = sg; }
        LDS_WAIT(); asm volatile("" ::: "memory");
#pragma unroll 1
        for (int hh = 0; hh < 8; ++hh) {
            const int ch = hh * 64 + lane;
            float dw = w0[ch], da = a0[ch], dg = 0.f, dv = 0.f;
#pragma unroll 4
            for (int j = 0; j < 64; j += 4) {
                const f32x4 tw = *(const LAS f32x4*)(sc + j), ta = *(const LAS f32x4*)(sc + 64 + j);
                dw += tw.x * w2[(size_t)(j + 0) * 512 + ch] + tw.y * w2[(size_t)(j + 1) * 512 + ch] + tw.z * w2[(size_t)(j + 2) * 512 + ch] + tw.w * w2[(size_t)(j + 3) * 512 + ch];
                da += ta.x * a2[(size_t)(j + 0) * 512 + ch] + ta.y * a2[(size_t)(j + 1) * 512 + ch] + ta.z * a2[(size_t)(j + 2) * 512 + ch] + ta.w * a2[(size_t)(j + 3) * 512 + ch];
            }
#pragma unroll 4
            for (int j = 0; j < 128; j += 4) {
                const f32x4 tg = *(const LAS f32x4*)(sc + 128 + j);
                dg += tg.x * g2[(size_t)(j + 0) * 512 + ch] + tg.y * g2[(size_t)(j + 1) * 512 + ch] + tg.z * g2[(size_t)(j + 2) * 512 + ch] + tg.w * g2[(size_t)(j + 3) * 512 + ch];
            }
            const float rr = bf2f(pr[C_R + ch]), kk0 = bf2f(pr[C_K + ch]), vv = bf2f(pr[C_V + ch]);
            const float rp = hp ? bf2f(pp[C_R + ch]) : 0.f, kp = hp ? bf2f(pp[C_K + ch]) : 0.f, vp = hp ? bf2f(pp[C_V + ch]) : 0.f;
            const float r1 = rr + (rp - rr) * mu_rkv[ch], k1 = kk0 + (kp - kk0) * mu_rkv[512 + ch]; float v1 = vv + (vp - vv) * mu_rkv[1024 + ch];
            if (e == 1) {
                dv = v0[ch];
#pragma unroll 4
                for (int j = 0; j < 32; j += 4) {
                    const f32x4 tv = *(const LAS f32x4*)(sc + 256 + j);
                    dv += tv.x * v2[(size_t)(j + 0) * 512 + ch] + tv.y * v2[(size_t)(j + 1) * 512 + ch] + tv.z * v2[(size_t)(j + 2) * 512 + ch] + tv.w * v2[(size_t)(j + 3) * 512 + ch];
                }
                const float vf = VF[(size_t)m * 512 + ch]; v1 = v1 + (vf - v1) * sigmoidf_(dv);
            } else VF[(size_t)m * 512 + ch] = v1;
            const float decay = __expf(-0.6065306597126334f * sigmoidf_(dw));
            const float ic = sigmoidf_(da);
            float kkv = k1 * k_k[ch]; const float ss = wave_sum(kkv * kkv); kkv *= rsqrtf(fmaxf(ss, 1e-12f));
            const float kmod = k1 * (1.0f + (ic - 1.0f) * k_a[ch]);
            const float bon = wave_sum(r1 * kmod * r_k[ch]);
            float* so = SIN + ((size_t)(b * 8 + hh) * TT + t) * 384;
            so[lane] = r1; so[64 + lane] = decay; so[128 + lane] = kmod; so[192 + lane] = kkv; so[256 + lane] = ic * kkv; so[320 + lane] = v1;
            GATE[(size_t)m * 512 + ch] = dg;
            if (lane == 0) BON[m * 8 + hh] = bon;
        }
        LDS_WAIT(); asm volatile("" ::: "memory");
    }
    { bf16_t* QA = (bf16_t*)(ws + WS_QA); const bf16_t* WkB = (const bf16_t*)(ws + W_WKB) + (size_t)e * 8 * 128 * 64;
      const int ntile = (NT / 64) * 2 * 8;
      for (int tI = F.gw; tI < ntile; tI += F.ngw) {
          const int hh = tI & 7, nt = (tI >> 3) & 1, mt = tI >> 4;
          EpiStoreBf16 E{QA + hh * 128, 1024, nt * 64, nt * 64 + 32};
          sg_tile(proj + C_QB + hh * 64, NCOL, WkB + (size_t)hh * 128 * 64 + (size_t)(nt * 64) * 64, WkB + (size_t)hh * 128 * 64 + (size_t)(nt * 64 + 32) * 64, 64, 64, mt * 64, E, F.lane);
      } }
}

__device__ __forceinline__ float allred16(float x) {
    x += __builtin_bit_cast(float, __builtin_amdgcn_update_dpp(0, __builtin_bit_cast(int, x), 0x128, 0xf, 0xf, false));
    x += __builtin_bit_cast(float, __builtin_amdgcn_update_dpp(0, __builtin_bit_cast(int, x), 0x124, 0xf, 0xf, false));
    x += __builtin_bit_cast(float, __builtin_amdgcn_update_dpp(0, __builtin_bit_cast(int, x), 0x122, 0xf, 0xf, false));
    x += __builtin_bit_cast(float, __builtin_amdgcn_update_dpp(0, __builtin_bit_cast(int, x), 0x121, 0xf, 0xf, false));
    return x;
}
__device__ __forceinline__ void ph_scan(Frame& F) {
    PHASE_PIN(F);
    if (F.wave != 0) return;
    const int lane = F.lane, i = lane >> 4, kq = lane & 15;
    for (int task = blockIdx.x; task < 256; task += gridDim.x) {
        const int bh = task >> 4, rg = task & 15, row = 4 * rg + i, b = bh >> 3, hh = bh & 7;
        const float* sin = (const float*)(F.ws + WS_SIN) + (size_t)bh * TT * 384;
        float* Y = (float*)(F.ws + WS_Y) + (size_t)b * TT * 512 + hh * 64 + row;
        f32x4 R[8], W[8], K[8], KK[8], B[8]; float V[8];
#pragma unroll
        for (int j = 0; j < 8; ++j) { const float* p = sin + (size_t)j * 384; R[j] = *(const f32x4*)(p + 4 * kq); W[j] = *(const f32x4*)(p + 64 + 4 * kq); K[j] = *(const f32x4*)(p + 128 + 4 * kq);
            KK[j] = *(const f32x4*)(p + 192 + 4 * kq); B[j] = *(const f32x4*)(p + 256 + 4 * kq); V[j] = p[320 + row]; }
        float s0 = 0.f, s1 = 0.f, s2 = 0.f, s3 = 0.f;
        for (int t0 = 0; t0 < TT; t0 += 8) {
#pragma unroll
            for (int j = 0; j < 8; ++j) {
                float p = s0 * KK[j].x + s1 * KK[j].y + s2 * KK[j].z + s3 * KK[j].w; p = allred16(p);
                s0 = s0 * W[j].x - p * B[j].x + V[j] * K[j].x; s1 = s1 * W[j].y - p * B[j].y + V[j] * K[j].y;
                s2 = s2 * W[j].z - p * B[j].z + V[j] * K[j].z; s3 = s3 * W[j].w - p * B[j].w + V[j] * K[j].w;
                float y = s0 * R[j].x + s1 * R[j].y + s2 * R[j].z + s3 * R[j].w; y = allred16(y);
                if (kq == 0) Y[(size_t)(t0 + j) * 512] = y;
                if (t0 + j + 8 < TT) { const float* p2 = sin + (size_t)(t0 + j + 8) * 384; R[j] = *(const f32x4*)(p2 + 4 * kq); W[j] = *(const f32x4*)(p2 + 64 + 4 * kq); K[j] = *(const f32x4*)(p2 + 128 + 4 * kq);
                    KK[j] = *(const f32x4*)(p2 + 192 + 4 * kq); B[j] = *(const f32x4*)(p2 + 256 + 4 * kq); V[j] = p2[320 + row]; }
            }
        }
    }
}

__device__ __forceinline__ size_t score_row_off(int b, int t) { const int j = t >> 7; return (size_t)b * SCORE_PER_BATCH + (size_t)16384 * (j * (j + 1) / 2) + (size_t)(t & 127) * (128 * (j + 1)); }
__device__ __forceinline__ void ph_idx_score(Frame& F) {
    PHASE_PIN(F);
    const int lane = F.lane, r = lane & 31, h = lane >> 5;
    const bf16_t* QI = (const bf16_t*)(F.ws + WS_QI); const bf16_t* KI = (const bf16_t*)(F.ws + WS_KI); const unsigned* SGN = (const unsigned*)(F.ws + SM_SGN);
    float* SC = (float*)(F.ws + WS_SCORE);
    for (int it = F.gw; it < 4352; it += F.ngw) {
        const int b = it / 2176; int i = it - b * 2176; i = 2175 - i;
        int a = 1; while (8 * a * (a + 1) <= i) ++a;
        const int rem = i - 8 * a * (a - 1), qt = 16 * (a - 1) + rem / a, g = rem % a;
        const int mq = b * TT + qt * 32 + r;
        bf16x8 qf[8][4];
#pragma unroll
        for (int hh = 0; hh < 8; ++hh)
#pragma unroll
            for (int ks = 0; ks < 4; ++ks) qf[hh][ks] = *(const bf16x8*)(QI + (size_t)mq * 512 + hh * 64 + ks * 16 + 8 * h);
        const unsigned sg = SGN[mq];
        float* srow = SC + score_row_off(b, qt * 32 + r);
        const int kt_end = (16 * g + 15 < qt) ? 16 * g + 15 : qt;
        for (int kt = 16 * g; kt <= kt_end; ++kt) {
            const bf16_t* kp = KI + (size_t)(b * TT + kt * 32 + r) * 64 + 8 * h;
            const bf16x8 kf0 = *(const bf16x8*)(kp), kf1 = *(const bf16x8*)(kp + 16), kf2 = *(const bf16x8*)(kp + 32), kf3 = *(const bf16x8*)(kp + 48);
            float sc[16];
#pragma unroll
            for (int q = 0; q < 16; ++q) sc[q] = 0.f;
#pragma unroll
            for (int hh = 0; hh < 8; ++hh) {
                f32x16 acc;
#pragma unroll
                for (int q = 0; q < 16; ++q) acc[q] = 0.f;
                acc = MFMA32(kf0, qf[hh][0], acc); acc = MFMA32(kf1, qf[hh][1], acc); acc = MFMA32(kf2, qf[hh][2], acc); acc = MFMA32(kf3, qf[hh][3], acc);
                const bool neg = (sg >> hh) & 1u;
#pragma unroll
                for (int q = 0; q < 16; ++q) { const float v = fmaxf(acc[q], 0.f); sc[q] = neg ? sc[q] - v : sc[q] + v; }
            }
#pragma unroll
            for (int g4 = 0; g4 < 4; ++g4) *(f32x4*)(srow + kt * 32 + 8 * g4 + 4 * h) = (f32x4){sc[4 * g4], sc[4 * g4 + 1], sc[4 * g4 + 2], sc[4 * g4 + 3]};
        }
    }
}
__device__ __forceinline__ unsigned block_excl_scan(unsigned v, LAS unsigned* scr, int tid, unsigned* total) {
    const int lane = tid & 63, w = tid >> 6; unsigned x = v;
#pragma unroll
    for (int o = 1; o < 64; o <<= 1) { const unsigned y = __shfl_up(x, o); if (lane >= o) x += y; }
    __syncthreads();
    if (lane == 63) scr[w] = x;
    __syncthreads();
    unsigned base = 0, tot = 0;
#pragma unroll
    for (int j = 0; j < 8; ++j) { const unsigned c = scr[j]; if (j < w) base += c; tot += c; }
    *total = tot;
    return base + x - v;
}
__device__ __forceinline__ void ph_idx_select(Frame& F) {
    PHASE_PIN(F);
    const int tid = F.tid; LAS unsigned* hist = (LAS unsigned*)F.lds; LAS unsigned* misc = hist + 256;
    const float* SC = (const float*)(F.ws + WS_SCORE); int* SEL = (int*)(F.ws + WS_SEL);
    for (int m = blockIdx.x; m < NT; m += gridDim.x) {
        const int t = m & (TT - 1), b = m >> 13, n = t + 1; int* sel = SEL + (size_t)m * 256;
        if (n <= 256) { if (tid < 256) sel[tid] = tid < n ? tid : -1; continue; }
        const float* srow = SC + score_row_off(b, t);
        unsigned key[16];
#pragma unroll
        for (int j = 0; j < 4; ++j) {
            const int idx0 = 4 * (tid + 512 * j);
            if (idx0 < n) { const f32x4 v = *(const f32x4*)(srow + idx0);
#pragma unroll
                for (int i = 0; i < 4; ++i) { const unsigned u = __float_as_uint(v[i]); key[4 * j + i] = (idx0 + i < n) ? ((u & 0x80000000u) ? ~u : (u | 0x80000000u)) : 0u; } }
            else {
#pragma unroll
                for (int i = 0; i < 4; ++i) key[4 * j + i] = 0u; }
        }
        unsigned prefix = 0, mask = 0, need = 256;
#pragma unroll 1
        for (int pass = 0; pass < 4; ++pass) {
            const int shift = 24 - 8 * pass;
            __syncthreads();
            if (tid < 256) hist[tid] = 0;
            __syncthreads();
#pragma unroll
            for (int q = 0; q < 16; ++q) { const int idx = 4 * (tid + 512 * (q >> 2)) + (q & 3); if (idx < n && (key[q] & mask) == prefix) __hip_atomic_fetch_add(&hist[(key[q] >> shift) & 255u], 1u, __ATOMIC_RELAXED, __HIP_MEMORY_SCOPE_WORKGROUP); }
            __syncthreads();
            if (tid < 64) {
                unsigned hv[4], L = 0;
#pragma unroll
                for (int i = 0; i < 4; ++i) { hv[i] = hist[255 - 4 * tid - i]; L += hv[i]; }
                unsigned x = L;
#pragma unroll
                for (int o = 1; o < 64; o <<= 1) { const unsigned y = __shfl_up(x, o); if (tid >= o) x += y; }
                unsigned run = x - L;
#pragma unroll
                for (int i = 0; i < 4; ++i) { if (run < need && need <= run + hv[i]) { misc[16] = 255 - 4 * tid - i; misc[17] = need - run; } run += hv[i]; }
            }
            __syncthreads();
            prefix |= misc[16] << shift; mask |= 255u << shift; need = misc[17];
        }
        unsigned basegt = 0, baseeq = 0; const unsigned ngt = 256 - need;
#pragma unroll
        for (int j = 0; j < 4; ++j) {
            unsigned cg = 0, ce = 0;
#pragma unroll
            for (int i = 0; i < 4; ++i) { const int idx = 4 * (tid + 512 * j) + i; if (idx < n) { cg += key[4 * j + i] > prefix; ce += key[4 * j + i] == prefix; } }
            unsigned tot; const unsigned ex = block_excl_scan(cg | (ce << 16), misc, tid, &tot);
            unsigned pg = basegt + (ex & 0xffffu), pe = baseeq + (ex >> 16);
#pragma unroll
            for (int i = 0; i < 4; ++i) { const int idx = 4 * (tid + 512 * j) + i; if (idx < n) {
                if (key[4 * j + i] > prefix) { sel[pg] = idx; ++pg; }
                else if (key[4 * j + i] == prefix) { if (pe < need) sel[ngt + pe] = idx; ++pe; } } }
            basegt += tot & 0xffffu; baseeq += tot >> 16;
        }
    }
    __syncthreads();
}

__device__ __forceinline__ void ph_sparse(Frame& F, const Args& A, int e) {
    PHASE_PIN(F);
    const int lane = F.lane; unsigned char* ws = F.ws;
    LAS float* qs = (LAS float*)(F.lds + F.wave * LDS_WSCR);
    LAS float* ps = qs + 1024;
    LAS float* cs = ps + 2048;
    const bf16_t* QA = (const bf16_t*)(ws + WS_QA); const bf16_t* CN = (const bf16_t*)(ws + WS_CN); const int* SEL = (const int*)(ws + WS_SEL);
    const float* Wkv = A.in[24] + (size_t)e * 128 * 1024;
    bf16_t* YC = (bf16_t*)(ws + WS_YCAT);
    const float* ln_g = A.in[17] + e * 512; const float* ln_b = A.in[18] + e * 512;
    const float* Yr = (const float*)(ws + WS_Y); const float* GATE = (const float*)(ws + WS_GATE); const float* BON = (const float*)(ws + SM_BONUS); const float* SIN = (const float*)(ws + WS_SIN);
    for (int m = F.gw; m < NT; m += F.ngw) {
        const int t = m & (TT - 1), b = m >> 13;
#pragma unroll 1
        for (int hh = 0; hh < 8; ++hh) {
            const int ch = hh * 64 + lane; const float y = Yr[(size_t)m * 512 + ch];
            const float mean = wave_sum(y) * (1.f / 64.f); const float yc = y - mean; const float var = wave_sum(yc * yc) * (1.f / 64.f);
            const float v1 = SIN[((size_t)(b * 8 + hh) * TT + t) * 384 + 320 + lane];
            const float o = (yc * rsqrtf(var + GN_EPS) * ln_g[ch] + ln_b[ch] + BON[m * 8 + hh] * v1) * GATE[(size_t)m * 512 + ch];
            YC[(size_t)m * 1024 + ch] = (bf16_t)f2bf(o);
        }
        const bf16_t* qa = QA + (size_t)m * 1024;
#pragma unroll
        for (int i = 0; i < 16; ++i) qs[lane + 64 * i] = bf2f(qa[lane + 64 * i]);
        int sj[4]; float lg[4][8];
#pragma unroll
        for (int i = 0; i < 4; ++i) sj[i] = SEL[(size_t)m * 256 + lane + 64 * i];
        LDS_WAIT(); asm volatile("" ::: "memory");
#pragma unroll
        for (int i = 0; i < 4; ++i) {
            const int s = sj[i] < 0 ? 0 : sj[i];
            const bf16_t* crow = CN + (size_t)(b * TT + s) * 128;
            float acc[8];
#pragma unroll
            for (int hh = 0; hh < 8; ++hh) acc[hh] = 0.f;
#pragma unroll 2
            for (int r8 = 0; r8 < 128; r8 += 8) {
                const u32x4 cw = *(const u32x4*)(crow + r8);
                float cf[8]; cf[0] = __uint_as_float(cw.x << 16); cf[1] = __uint_as_float(cw.x & 0xffff0000u); cf[2] = __uint_as_float(cw.y << 16); cf[3] = __uint_as_float(cw.y & 0xffff0000u);
                cf[4] = __uint_as_float(cw.z << 16); cf[5] = __uint_as_float(cw.z & 0xffff0000u); cf[6] = __uint_as_float(cw.w << 16); cf[7] = __uint_as_float(cw.w & 0xffff0000u);
#pragma unroll
                for (int hh = 0; hh < 8; ++hh) { const f32x4 q0 = *(const LAS f32x4*)(qs + hh * 128 + r8), q1 = *(const LAS f32x4*)(qs + hh * 128 + r8 + 4);
                    acc[hh] += cf[0] * q0.x + cf[1] * q0.y + cf[2] * q0.z + cf[3] * q0.w + cf[4] * q1.x + cf[5] * q1.y + cf[6] * q1.z + cf[7] * q1.w; }
            }
#pragma unroll
            for (int hh = 0; hh < 8; ++hh) lg[i][hh] = sj[i] < 0 ? -INFINITY : acc[hh] * 0.125f;
        }
#pragma unroll
        for (int hh = 0; hh < 8; ++hh) {
            float mx = fmaxf(fmaxf(lg[0][hh], lg[1][hh]), fmaxf(lg[2][hh], lg[3][hh])); mx = wave_max(mx);
            float p0 = __expf(lg[0][hh] - mx), p1 = __expf(lg[1][hh] - mx), p2 = __expf(lg[2][hh] - mx), p3 = __expf(lg[3][hh] - mx);
            const float inv = 1.0f / wave_sum(p0 + p1 + p2 + p3);
            ps[(lane) * 8 + hh] = p0 * inv; ps[(lane + 64) * 8 + hh] = p1 * inv; ps[(lane + 128) * 8 + hh] = p2 * inv; ps[(lane + 192) * 8 + hh] = p3 * inv;
        }
        LDS_WAIT(); asm volatile("" ::: "memory");
        float c0[8], c1[8];
#pragma unroll
        for (int hh = 0; hh < 8; ++hh) { c0[hh] = 0.f; c1[hh] = 0.f; }
#pragma unroll
        for (int i = 0; i < 4; ++i) {
#pragma unroll 1
        for (int jj = 0; jj < 64; ++jj) {
            const int j = i * 64 + jj;
            int s = __shfl(sj[i], jj); if (s < 0) s = 0;
            const bf16_t* crow = CN + (size_t)(b * TT + s) * 128;
            const float x0 = bf2f(crow[lane]), x1 = bf2f(crow[64 + lane]);
            const f32x4 pa = *(const LAS f32x4*)(ps + j * 8), pb = *(const LAS f32x4*)(ps + j * 8 + 4);
            c0[0] += pa.x * x0; c0[1] += pa.y * x0; c0[2] += pa.z * x0; c0[3] += pa.w * x0; c0[4] += pb.x * x0; c0[5] += pb.y * x0; c0[6] += pb.z * x0; c0[7] += pb.w * x0;
            c1[0] += pa.x * x1; c1[1] += pa.y * x1; c1[2] += pa.z * x1; c1[3] += pa.w * x1; c1[4] += pb.x * x1; c1[5] += pb.y * x1; c1[6] += pb.z * x1; c1[7] += pb.w * x1;
        } }
#pragma unroll
        for (int hh = 0; hh < 8; ++hh) { cs[hh * 128 + lane] = c0[hh]; cs[hh * 128 + 64 + lane] = c1[hh]; }
        LDS_WAIT(); asm volatile("" ::: "memory");
#pragma unroll 1
        for (int hh = 0; hh < 8; ++hh) {
            float o = 0.f; const float* wv = Wkv + 512 + hh * 64 + lane;
#pragma unroll 4
            for (int r4 = 0; r4 < 128; r4 += 4) { const f32x4 cx = *(const LAS f32x4*)(cs + hh * 128 + r4);
                o += cx.x * wv[(size_t)(r4 + 0) * 1024] + cx.y * wv[(size_t)(r4 + 1) * 1024] + cx.z * wv[(size_t)(r4 + 2) * 1024] + cx.w * wv[(size_t)(r4 + 3) * 1024]; }
            YC[(size_t)m * 1024 + 512 + hh * 64 + lane] = (bf16_t)f2bf(o);
        }
        LDS_WAIT(); asm volatile("" ::: "memory");
    }
}

__device__ __forceinline__ void ph_stickbreak(Frame& F) {
    PHASE_PIN(F);
    const int lane = F.lane; unsigned char* ws = F.ws;
    LAS float* qs = (LAS float*)(F.lds + F.wave * LDS_WSCR);
    LAS float* wsd = qs + 64;
    const bf16_t* Q = (const bf16_t*)(ws + WS_PROJ); const bf16_t* Kb = Q + (size_t)NT * 1024; const bf16_t* Vb = Kb + (size_t)NT * 1024;
    bf16_t* YC = (bf16_t*)(ws + WS_YCAT);
    for (int it = F.gw; it < NT * 16; it += F.ngw) {
        const int hh = it & 15, m = it >> 4, t = m & (TT - 1), b = m >> 13;
        qs[lane] = bf2f(Q[(size_t)m * 1024 + hh * 64 + lane]);
        LDS_WAIT(); asm volatile("" ::: "memory");
        float o = 0.f, P = 1.0f;
        for (int c0 = t - 1; c0 >= 0; c0 -= 64) {
            const int s = c0 - lane; const bool valid = s >= 0;
            float z = 0.f;
            if (valid) { const bf16_t* kr = Kb + (size_t)(b * TT + s) * 1024 + hh * 64;
#pragma unroll
                for (int d8 = 0; d8 < 64; d8 += 8) { const u32x4 kw = *(const u32x4*)(kr + d8); const f32x4 q0 = *(const LAS f32x4*)(qs + d8), q1 = *(const LAS f32x4*)(qs + d8 + 4);
                    z += __uint_as_float(kw.x << 16) * q0.x + __uint_as_float(kw.x & 0xffff0000u) * q0.y + __uint_as_float(kw.y << 16) * q0.z + __uint_as_float(kw.y & 0xffff0000u) * q0.w
                       + __uint_as_float(kw.z << 16) * q1.x + __uint_as_float(kw.z & 0xffff0000u) * q1.y + __uint_as_float(kw.w << 16) * q1.z + __uint_as_float(kw.w & 0xffff0000u) * q1.w; } }
            const float ez = exp2f(z); const float keep = valid ? 1.0f / (1.0f + ez) : 1.0f; const float beta = valid ? 1.0f - keep : 0.f;
            float x = keep;
#pragma unroll
            for (int of = 1; of < 64; of <<= 1) { const float y = __shfl_up(x, of); if (lane >= of) x *= y; }
            float ex = __shfl_up(x, 1); if (lane == 0) ex = 1.0f;
            wsd[lane] = beta * ex * P;
            P *= __shfl(x, 63);
            LDS_WAIT(); asm volatile("" ::: "memory");
            const int nk = (c0 + 1 < 64) ? c0 + 1 : 64;
            for (int j = 0; j < nk; ++j) o += wsd[j] * bf2f(Vb[(size_t)(b * TT + c0 - j) * 1024 + hh * 64 + lane]);
            LDS_WAIT(); asm volatile("" ::: "memory");
            if (P < 1e-30f) break;
        }
        YC[(size_t)m * 1024 + hh * 64 + lane] = (bf16_t)f2bf(o);
    }
}

__device__ __forceinline__ void ph_moe_route(Frame& F, const Args& A, int l) {
    PHASE_PIN(F);
    const int lane = F.lane; unsigned char* ws = F.ws;
    const float* X = (const float*)(ws + WS_X); bf16_t* XB = (bf16_t*)(ws + WS_XB);
    const float* g = A.in[29] + l * DM; const float* Wg = A.in[30] + (size_t)l * DM * 4; const float* We = A.in[31] + (size_t)l * 4 * DM * 8;
    int* EIDX = (int*)(ws + SM_EIDX); float* GATEV = (float*)(ws + SM_GATE); int* SLOT = (int*)(ws + SM_SLOT);
    unsigned* cnt = (unsigned*)(ws + WS_CTL) + CW_CNT + 64 * l;
    for (int m = F.gw; m < NT; m += F.ngw) {
        const f32x4* xr = (const f32x4*)(X + (size_t)m * DM) + lane; f32x4 v[4]; float s = 0.f;
#pragma unroll
        for (int j = 0; j < 4; ++j) { v[j] = xr[64 * j]; s += (v[j].x * v[j].x + v[j].y * v[j].y) + (v[j].z * v[j].z + v[j].w * v[j].w); }
        const float rstd = rsqrtf(wave_sum(s) * (1.f / DM) + RMS_EPS);
        u32x2* o8 = (u32x2*)(XB + (size_t)m * DM) + lane;
#pragma unroll
        for (int j = 0; j < 4; ++j) { u32x2 w; w.x = pk2(v[j].x * rstd, v[j].y * rstd); w.y = pk2(v[j].z * rstd, v[j].w * rstd); o8[64 * j] = w; }
#pragma unroll
        for (int j = 0; j < 4; ++j) { const f32x4 gg = *((const f32x4*)g + lane + 64 * j); v[j] = v[j] * gg * rstd; }
        float gl[4] = {0.f, 0.f, 0.f, 0.f};
#pragma unroll
        for (int j = 0; j < 4; ++j)
#pragma unroll
            for (int i = 0; i < 4; ++i) { const int k = 4 * (lane + 64 * j) + i; const f32x4 w = *(const f32x4*)(Wg + (size_t)k * 4); const float xv = v[j][i];
                gl[0] += xv * w.x; gl[1] += xv * w.y; gl[2] += xv * w.z; gl[3] += xv * w.w; }
#pragma unroll
        for (int q = 0; q < 4; ++q) gl[q] = wave_sum(gl[q]);
        int gs = 0; float gm = gl[0];
#pragma unroll
        for (int q = 1; q < 4; ++q) if (gl[q] > gm) { gm = gl[q]; gs = q; }
        float gden = 0.f;
#pragma unroll
        for (int q = 0; q < 4; ++q) gden += __expf(gl[q] - gm);
        const float g_gate = 1.0f / gden;
        const float* Wes = We + (size_t)gs * DM * 8;
        float el[8];
#pragma unroll
        for (int q = 0; q < 8; ++q) el[q] = 0.f;
#pragma unroll
        for (int j = 0; j < 4; ++j)
#pragma unroll
            for (int i = 0; i < 4; ++i) { const int k = 4 * (lane + 64 * j) + i; const f32x4 w0 = *(const f32x4*)(Wes + (size_t)k * 8), w1 = *(const f32x4*)(Wes + (size_t)k * 8 + 4); const float xv = v[j][i];
                el[0] += xv * w0.x; el[1] += xv * w0.y; el[2] += xv * w0.z; el[3] += xv * w0.w; el[4] += xv * w1.x; el[5] += xv * w1.y; el[6] += xv * w1.z; el[7] += xv * w1.w; }
#pragma unroll
        for (int q = 0; q < 8; ++q) el[q] = wave_sum(el[q]);
        int i1 = 0; float m1 = el[0];
#pragma unroll
        for (int q = 1; q < 8; ++q) if (el[q] > m1) { m1 = el[q]; i1 = q; }
        int i2 = -1; float m2 = -INFINITY;
#pragma unroll
        for (int q = 0; q < 8; ++q) if (q != i1 && el[q] > m2) { m2 = el[q]; i2 = q; }
        const float e2 = __expf(m2 - m1); const float ga = g_gate / (1.0f + e2), gb = g_gate * e2 / (1.0f + e2);
        if (lane == 0) {
            const int ea = gs * 8 + i1, eb = gs * 8 + i2;
            const unsigned sa = atomicAdd(&cnt[ea], 1u), sb = atomicAdd(&cnt[eb], 1u);
            EIDX[2 * m] = ea; EIDX[2 * m + 1] = eb; GATEV[2 * m] = ga; GATEV[2 * m + 1] = gb; SLOT[2 * m] = (int)sa; SLOT[2 * m + 1] = (int)sb;
        }
    }
}
__device__ __forceinline__ int moe_offsets(const unsigned* cnt, int lane, int* total, int* mycnt_pad) {
    const unsigned c = lane < 32 ? __hip_atomic_load(cnt + (lane & 31), __ATOMIC_RELAXED, __HIP_MEMORY_SCOPE_AGENT) : 0u; const int p = (int)((c + 255u) & ~255u);
    int x = p;
#pragma unroll
    for (int o = 1; o < 64; o <<= 1) { const int y = __shfl_up(x, o); if (lane >= o) x += y; }
    *total = __shfl(x, 63); *mycnt_pad = p;
    return x - p;
}
__device__ __forceinline__ void ph_moe_gather(Frame& F, int l) {
    PHASE_PIN(F);
    const int lane = F.lane; unsigned char* ws = F.ws;
    const unsigned* cnt = (const unsigned*)(ws + WS_CTL) + CW_CNT + 64 * l; int total, pad; const int off = moe_offsets(cnt, lane, &total, &pad);
    const int* EIDX = (const int*)(ws + SM_EIDX); const int* SLOT = (const int*)(ws + SM_SLOT);
    const bf16_t* XB = (const bf16_t*)(ws + WS_XB); bf16_t* AM = (bf16_t*)(ws + WS_AMOE);
    for (int a = F.gw; a < NT * 2; a += F.ngw) {
        const int m = a >> 1, e = EIDX[a], row = __shfl(off, e) + SLOT[a];
        const u32x4* src = (const u32x4*)(XB + (size_t)m * DM); u32x4* dst = (u32x4*)(AM + (size_t)row * DM);
        dst[lane] = src[lane]; dst[lane + 64] = src[lane + 64];
    }
}
__device__ __forceinline__ int moe_build_tab(Frame& F, int l) {
    LAS int* tab = (LAS int*)(F.lds + LDS_MISC + 256); LAS int* ends = (LAS int*)(F.lds + LDS_MISC + 1024);
    const unsigned* cnt = (const unsigned*)(F.ws + WS_CTL) + CW_CNT + 64 * l; int total, pad; const int off = moe_offsets(cnt, F.lane, &total, &pad);
    __syncthreads();
    if (F.tid < 32) ends[F.tid] = off + pad;
    __syncthreads();
    for (int rt = F.tid; rt < total / 256; rt += NTHR) { int e = 0; for (int q = 0; q < 32; ++q) e += (ends[q] <= rt * 256) ? 1 : 0; tab[rt] = e; }
    __syncthreads();
    return total;
}
__device__ __forceinline__ void ph_moe_gemm1(Frame& F, int l) {
    PHASE_PIN(F);
    const int total = moe_build_tab(F, l);
    pg8::Gemm g{(const pg8::bf16_t*)(F.ws + WS_AMOE), (const pg8::bf16_t*)(F.ws + WS_W13T), total, 32 * 1024, DM};
    pg8::MoeOrder S{(total / 256) * 4, (int)gridDim.x, (int)blockIdx.x, (const LAS int*)(F.lds + LDS_MISC + 256)};
    pg8::EpiGate E{(pg8::bf16_t*)(F.ws + WS_H)};
    pg8::gemm_phase<pg8::EpiGate, pg8::MoeOrder>(F.lds, g, S, E, nullptr);
}
__device__ __forceinline__ void ph_moe_gemm2(Frame& F, int l) {
    PHASE_PIN(F);
    const int total = moe_build_tab(F, l);
    pg8::Gemm g{(const pg8::bf16_t*)(F.ws + WS_H), (const pg8::bf16_t*)(F.ws + WS_W2T), total, 32 * 1024, 512};
    pg8::MoeOrder S{(total / 256) * 4, (int)gridDim.x, (int)blockIdx.x, (const LAS int*)(F.lds + LDS_MISC + 256)};
    pg8::EpiMoeDown E{(pg8::bf16_t*)(F.ws + WS_YM)};
    pg8::gemm_phase<pg8::EpiMoeDown, pg8::MoeOrder>(F.lds, g, S, E, nullptr);
}
__device__ __forceinline__ void ph_moe_combine(Frame& F, const Args& A, int l) {
    PHASE_PIN(F);
    const int lane = F.lane; unsigned char* ws = F.ws;
    const unsigned* cnt = (const unsigned*)(ws + WS_CTL) + CW_CNT + 64 * l; int total, pad; const int off = moe_offsets(cnt, lane, &total, &pad);
    const int* EIDX = (const int*)(ws + SM_EIDX); const int* SLOT = (const int*)(ws + SM_SLOT); const float* GATEV = (const float*)(ws + SM_GATE);
    float* X = (float*)(ws + WS_X); bf16_t* XB = (bf16_t*)(ws + WS_XB); const bf16_t* YM = (const bf16_t*)(ws + WS_YM);
    const float* fg = A.in[35];
    for (int m = F.gw; m < NT; m += F.ngw) {
        const int ea = EIDX[2 * m], eb = EIDX[2 * m + 1]; const float ga = GATEV[2 * m], gb = GATEV[2 * m + 1];
        const int ra = __shfl(off, ea) + SLOT[2 * m], rb = __shfl(off, eb) + SLOT[2 * m + 1];
        f32x4* xr = (f32x4*)(X + (size_t)m * DM) + lane; const u32x2* ya = (const u32x2*)(YM + (size_t)ra * DM) + lane; const u32x2* yb = (const u32x2*)(YM + (size_t)rb * DM) + lane;
        f32x4 v[4]; float s = 0.f;
#pragma unroll
        for (int j = 0; j < 4; ++j) { v[j] = xr[64 * j]; const u32x2 a = ya[64 * j], bq = yb[64 * j];
            v[j].x += ga * __uint_as_float(a.x << 16) + gb * __uint_as_float(bq.x << 16); v[j].y += ga * __uint_as_float(a.x & 0xffff0000u) + gb * __uint_as_float(bq.x & 0xffff0000u);
            v[j].z += ga * __uint_as_float(a.y << 16) + gb * __uint_as_float(bq.y << 16); v[j].w += ga * __uint_as_float(a.y & 0xffff0000u) + gb * __uint_as_float(bq.y & 0xffff0000u);
            s += (v[j].x * v[j].x + v[j].y * v[j].y) + (v[j].z * v[j].z + v[j].w * v[j].w); }
        const float rstd = rsqrtf(wave_sum(s) * (1.f / DM) + RMS_EPS);
        if (l < 3) {
            u32x2* o8 = (u32x2*)(XB + (size_t)m * DM) + lane;
#pragma unroll
            for (int j = 0; j < 4; ++j) { xr[64 * j] = v[j]; u32x2 w; w.x = pk2(v[j].x * rstd, v[j].y * rstd); w.y = pk2(v[j].z * rstd, v[j].w * rstd); o8[64 * j] = w; }
        } else {
            f32x4* orow = (f32x4*)(F.out + (size_t)m * DM) + lane;
#pragma unroll
            for (int j = 0; j < 4; ++j) { const f32x4 gg = *((const f32x4*)fg + lane + 64 * j); orow[64 * j] = v[j] * gg * rstd; }
        }
    }
}

__global__ void __launch_bounds__(NTHR, 2) fwd_kernel(Args args) {
    extern __shared__ __attribute__((aligned(16))) unsigned char lds_raw[];
    Frame F; F.lds = (LAS unsigned char*)lds_raw; F.tid = threadIdx.x; F.lane = F.tid & 63; F.wave = __builtin_amdgcn_readfirstlane(F.tid >> 6);
    F.gw = blockIdx.x * NWAVES + F.wave; F.ngw = gridDim.x * NWAVES; F.out = args.out; F.ws = args.ws;
    volatile LAS unsigned* MISC = (volatile LAS unsigned*)(F.lds + LDS_MISC);
    if (F.tid < 64) MISC[F.tid] = 0u;
    __syncthreads();
    const int lo = args.ph_lo, hi = args.ph_hi;
    XcdBarrier bar; bar.bar = (unsigned*)(F.ws + WS_CTL) + CW_BAR; bar.x = 0; bar.st = MISC;
    if (hi - lo > 1) bar = xcd_barrier_post((unsigned*)(F.ws + WS_CTL) + CW_BAR, MISC);
#define IN(k) (lo <= (k) && (k) < hi)
#define SEAM(k) do { if ((k) + 1 < hi) xcd_barrier(bar); } while (0)
    unsigned char* ws = F.ws;
    if (IN(0)) { ph_prologue(F, args); SEAM(0); }
    for (int l = 0; l < 4; ++l) {
        const int pb = 1 + 16 * l, e = l >> 1;
        const float* xsrc = (l == 0) ? args.in[0] : (const float*)(ws + WS_X);
        if ((l & 1) == 0) {
            if (IN(pb + 0)) { PHASE_PIN(F);
                pg8::Gemm g{(const pg8::bf16_t*)(F.ws + WS_XB), (const pg8::bf16_t*)(F.ws + W_WIN) + (size_t)e * NCOL * DM, NT, NCOL, DM}; pg8::StaticOrder S; S.init(NT, NCOL, (int)gridDim.x, (int)blockIdx.x);
                pg8::EpiBf16S E{(pg8::bf16_t*)(F.ws + WS_PROJ), NCOL, 0, 0};
                pg8::gemm_phase<pg8::EpiBf16S, pg8::StaticOrder>(F.lds, g, S, E, nullptr);
                SEAM(pb + 0); }
            if (IN(pb + 1)) {
#ifndef NO_PREP
 ph_prep(F, args, e);
#endif
 SEAM(pb + 1); }
            if (IN(pb + 2)) {
#ifndef NO_SCAN
 ph_scan(F);
#endif
 SEAM(pb + 2); }
            if (IN(pb + 3)) {
#ifndef NO_SCORE
 ph_idx_score(F);
#endif
 SEAM(pb + 3); }
            if (IN(pb + 4)) {
#ifndef NO_SELECT
 ph_idx_select(F);
#endif
 SEAM(pb + 4); }
            if (IN(pb + 5)) {
#ifndef NO_SPARSE
 ph_sparse(F, args, e);
#endif
 SEAM(pb + 5); }
        } else {
            if (IN(pb + 0)) { PHASE_PIN(F);
                pg8::Gemm g{(const pg8::bf16_t*)(F.ws + WS_XB), (const pg8::bf16_t*)(F.ws + W_WQKV) + (size_t)e * 3072 * DM, NT, 3072, DM}; pg8::StaticOrder S; S.init(NT, 3072, (int)gridDim.x, (int)blockIdx.x);
                pg8::EpiBf16S E{(pg8::bf16_t*)(F.ws + WS_PROJ), 1024, 1024, (size_t)NT * 1024};
                pg8::gemm_phase<pg8::EpiBf16S, pg8::StaticOrder>(F.lds, g, S, E, nullptr);
                SEAM(pb + 0); }
            if (IN(pb + 1)) {
#ifndef NO_SB
 ph_stickbreak(F);
#endif
 SEAM(pb + 1); }
        }
        if (IN(pb + 6)) { PHASE_PIN(F);
            pg8::Gemm g{(const pg8::bf16_t*)(F.ws + WS_YCAT), (const pg8::bf16_t*)(F.ws + ((l & 1) ? W_WOUTO : W_WOUTE)) + (size_t)e * DM * DM, NT, DM, DM}; pg8::StaticOrder S; S.init(NT, DM, (int)gridDim.x, (int)blockIdx.x);
            pg8::EpiResid E{xsrc, (float*)(F.ws + WS_X)};
            pg8::gemm_phase<pg8::EpiResid, pg8::StaticOrder>(F.lds, g, S, E, nullptr);
            SEAM(pb + 6); }
        if (IN(pb + 7)) {
#ifndef NO_ROUTE
 ph_moe_route(F, args, l); moe_weight_prep(F, args, l);
#endif
 SEAM(pb + 7); }
        if (IN(pb + 8)) { ph_moe_gather(F, l); SEAM(pb + 8); }
        if (IN(pb + 9)) { ph_moe_gemm1(F, l); SEAM(pb + 9); }
        if (IN(pb + 10)) { ph_moe_gemm2(F, l); SEAM(pb + 10); }
        if (IN(pb + 11)) { ph_moe_combine(F, args, l); SEAM(pb + 11); }
    }
#undef IN
#undef SEAM
}

extern "C" void kernel_launch(void* const* d_in, const int* in_sizes, int n_in, void* d_out, int out_size, void* d_ws, size_t ws_size, hipStream_t stream) {
    static int grid = 0;
    if (grid == 0) {
        if (n_in != 36 || out_size != NT * DM || ws_size < WS_END) { fprintf(stderr, "kernel_launch: unexpected problem (n_in %d out %d ws %zu)\n", n_in, out_size, ws_size); grid = -1; return; }
        int dev = 0, cus = 0, per_cu = 0;
        if (hipGetDevice(&dev) != hipSuccess || hipDeviceGetAttribute(&cus, hipDeviceAttributeMultiprocessorCount, dev) != hipSuccess) { grid = -1; return; }
        if (hipFuncSetAttribute((const void*)fwd_kernel, hipFuncAttributeMaxDynamicSharedMemorySize, LDS_BYTES) != hipSuccess) { grid = -1; return; }
        if (hipOccupancyMaxActiveBlocksPerMultiprocessor(&per_cu, (const void*)fwd_kernel, NTHR, LDS_BYTES) != hipSuccess || per_cu < 1) { fprintf(stderr, "kernel_launch: occupancy query says %d\n", per_cu); }
        (void)hipGetLastError();
        grid = cus;
    }
    if (grid < 0) return;
    (void)hipMemsetAsync((char*)d_ws + WS_CTL, 0, CTL_ZERO_BYTES, stream);
    Args a{};
    for (int i = 0; i < 36; ++i) a.in[i] = (const float*)d_in[i];
    a.out = (float*)d_out; a.ws = (unsigned char*)d_ws;
#if ONE_LAUNCH
    a.ph_lo = 0; a.ph_hi = 65;
    hipLaunchKernelGGL(fwd_kernel, dim3(grid), dim3(NTHR), LDS_BYTES, stream, a);
#else
    for (int p = 0; p < 65; ++p) {
        const int l = (p - 1) >> 4, k = (p - 1) & 15;
        if (p > 0) { if (k > 11) continue; if ((l & 1) && k >= 2 && k <= 5) continue; }
        a.ph_lo = p; a.ph_hi = p + 1;
        hipLaunchKernelGGL(fwd_kernel, dim3(grid), dim3(NTHR), LDS_BYTES, stream, a);
    }
#endif
}
```

```cpp
#include <hip/hip_runtime.h>
#include <cstdio>
#include <cstdint>

#ifndef DUP_PHASE
#define DUP_PHASE -1
#endif
#ifndef ONE_LAUNCH
#define ONE_LAUNCH 1
#endif

#define GAS __attribute__((address_space(1)))
#define LAS __attribute__((address_space(3)))
typedef unsigned short bf16_t;
typedef short bf16x8 __attribute__((ext_vector_type(8)));
typedef float f32x4 __attribute__((ext_vector_type(4)));
typedef float f32x2 __attribute__((ext_vector_type(2)));
typedef float f32x16 __attribute__((ext_vector_type(16)));
typedef unsigned u32x4 __attribute__((ext_vector_type(4)));
typedef unsigned u32x2 __attribute__((ext_vector_type(2)));

constexpr int NT = 16384, TT = 8192, DM = 1024, NB = 2;
constexpr int NCOL = 3584;
constexpr int C_R = 0, C_K = 512, C_V = 1024, C_QB = 1536, C_CKV = 2048, C_QI = 2176, C_KI = 2688, C_WI = 2752;
constexpr int C_PW = 2816, C_QW = 2880, C_PA = 2944, C_QA = 3008, C_PG = 3072, C_QG = 3200, C_PV = 3328, C_QV = 3360;
constexpr int NWAVES = 8, NTHR = 512;
constexpr float RMS_EPS = 1e-6f, GN_EPS = 64e-5f;
constexpr float LOG2E = 1.4426950408889634f;

constexpr size_t MiB = 1u << 20;
constexpr size_t WS_CTL = 0, CTL_ZERO_BYTES = 1 * MiB;
constexpr size_t WS_SMALL = 1 * MiB;
constexpr size_t SM_EIDX = WS_SMALL, SM_GATE = WS_SMALL + 128 * 1024, SM_SLOT = WS_SMALL + 256 * 1024, SM_BONUS = WS_SMALL + 512 * 1024, SM_SGN = WS_SMALL + 1024 * 1024;
constexpr size_t WS_W = 5 * MiB;
constexpr size_t W_WIN = WS_W, W_WOUTE = WS_W + 14 * MiB, W_WQKV = WS_W + 18 * MiB, W_WOUTO = WS_W + 30 * MiB, W_WKB = WS_W + 34 * MiB, W_WVT = W_WKB + 256 * 1024, W_L2 = W_WKB + 512 * 1024;
constexpr size_t WS_X = 45 * MiB, WS_XB = 109 * MiB, WS_PROJ = 141 * MiB, WS_SIN = 253 * MiB, WS_VF = 445 * MiB, WS_Y = 477 * MiB, WS_GATE = 509 * MiB, WS_YCAT = 541 * MiB;
constexpr size_t WS_CN = 573 * MiB, WS_KI = 577 * MiB, WS_QI = 579 * MiB, WS_QA = 595 * MiB, WS_SEL = 627 * MiB;
constexpr size_t WS_BIG = 645 * MiB;
constexpr size_t WS_SCORE = WS_BIG;
constexpr size_t WS_W13T = WS_BIG, WS_W2T = WS_BIG + 64 * MiB, WS_AMOE = WS_BIG + 96 * MiB, WS_H = WS_BIG + 176 * MiB, WS_YM = WS_BIG + 216 * MiB;
constexpr size_t WS_END = 941 * MiB;
constexpr size_t SCORE_PER_BATCH = (size_t)16384 * 2080;
static_assert(WS_SCORE + 2 * SCORE_PER_BATCH * 4 <= WS_END, "score map");
static_assert(WS_YM + (size_t)40960 * 1024 * 2 <= WS_END, "moe map");
constexpr int CW_BAR = 4096;
constexpr int CW_CNT = 16384;

constexpr int LDS_BYTES = 147456;
constexpr int LDS_WSCR = 16384;
constexpr int LDS_MISC = 131072;

__device__ __forceinline__ float bf2f(bf16_t b) { return __uint_as_float(((unsigned)b) << 16); }
__device__ __forceinline__ unsigned f2bf(float f) { unsigned u = __float_as_uint(f); return (u + 0x7fffu + ((u >> 16) & 1u)) >> 16; }
__device__ __forceinline__ unsigned pk2(float lo, float hi) { return f2bf(lo) | (f2bf(hi) << 16); }
__device__ __forceinline__ float wave_sum(float v) {
#pragma unroll
    for (int o = 1; o < 64; o <<= 1) v += __shfl_xor(v, o);
    return v;
}
__device__ __forceinline__ float wave_max(float v) {
#pragma unroll
    for (int o = 1; o < 64; o <<= 1) v = fmaxf(v, __shfl_xor(v, o));
    return v;
}
__device__ __forceinline__ float sigmoidf_(float x) { return 1.0f / (1.0f + __expf(-x)); }
#define LDS_WAIT() asm volatile("s_waitcnt lgkmcnt(0)" ::: "memory")

#define XB_TMO      128
#define XB_XCNT(j)  (256  + 64 * (j))
#define XB_XSUB(j)  (1280 + 64 * (j))
#define XB_XGEN(j)  (2304 + 64 * (j))
#define XB_TOP      3328
#define XB_TOPGEN   3392
#define XCD_BAR_WORDS 3456
#define XB_SPIN_CAP (1u << 18)
__device__ __forceinline__ unsigned xb_ld(unsigned* p)              { return __hip_atomic_load(p, __ATOMIC_RELAXED, __HIP_MEMORY_SCOPE_AGENT); }
__device__ __forceinline__ unsigned xb_add(unsigned* p, unsigned v) { return __hip_atomic_fetch_add(p, v, __ATOMIC_RELAXED, __HIP_MEMORY_SCOPE_AGENT); }
__device__ __forceinline__ unsigned xb_xcc_id() { return (unsigned)__builtin_amdgcn_s_getreg((3 << 11) | 20) & 0xFu; }
#define XB_SPIN(cond, bar) do { unsigned _sp = 0; while (cond) { __builtin_amdgcn_s_sleep(1); \
    if ((++_sp & 255u) == 0u) { if (xb_ld(&(bar)[XB_TMO])) break; if (_sp > XB_SPIN_CAP) { atomicAdd(&(bar)[XB_TMO], 1u); break; } } } } while (0)
struct XcdBarrier { unsigned* bar; unsigned x; volatile LAS unsigned* st; };
__device__ __forceinline__ XcdBarrier xcd_barrier_post(unsigned* bar, volatile LAS unsigned* st, bool t0) {
    XcdBarrier b; b.bar = bar; b.x = xb_xcc_id(); b.st = st;
    if (t0) (void)xb_add(&bar[XB_XCNT(b.x)], 1u);
    return b;
}
__device__ __forceinline__ void xcd_barrier_complete(unsigned* bar, unsigned x, unsigned& nloc, unsigned& nx) {
    const unsigned G = gridDim.x * gridDim.y * gridDim.z;
    unsigned sum, cnt, mine, sp = 0u;
    for (;;) {
        sum = 0u; cnt = 0u; mine = 0u;
#pragma unroll
        for (unsigned j = 0; j < 16; ++j) { const unsigned c = xb_ld(&bar[XB_XCNT(j)]); sum += c; cnt += (c > 0u) ? 1u : 0u; mine = (j == x) ? c : mine; }
        if (sum == G) break;
        __builtin_amdgcn_s_sleep(1);
        if ((++sp & 255u) == 0u) { if (xb_ld(&bar[XB_TMO])) break; if (sp > XB_SPIN_CAP) { atomicAdd(&bar[XB_TMO], 1u); break; } }
    }
    nloc = mine > 0u ? mine : 1u; nx = cnt > 0u ? cnt : 1u;
}
__device__ __forceinline__ void xcd_barrier(const XcdBarrier& b, bool t0) {
    asm volatile("s_waitcnt vmcnt(0)" ::: "memory");
    __syncthreads();
    if (t0) {
        unsigned* bar = b.bar;
        __builtin_amdgcn_s_waitcnt(0);
        unsigned nloc = b.st[0], nx = b.st[1];
        if (nloc == 0u) { xcd_barrier_complete(bar, b.x, nloc, nx); b.st[0] = nloc; b.st[1] = nx; }
        const unsigned old = xb_add(&bar[XB_XSUB(b.x)], 1u);
        const unsigned gen = old / nloc;
        if (old + 1u == (gen + 1u) * nloc) {
            __builtin_amdgcn_fence(__ATOMIC_RELEASE, "agent");
            asm volatile("s_waitcnt vmcnt(0)" ::: "memory");
            const unsigned og = xb_add(&bar[XB_TOP], 1u);
            const unsigned tg = og / nx;
            if (og + 1u == (tg + 1u) * nx) xb_add(&bar[XB_TOPGEN], 1u);
            else XB_SPIN(xb_ld(&bar[XB_TOPGEN]) == tg, bar);
            __builtin_amdgcn_fence(__ATOMIC_ACQUIRE, "agent");
            xb_add(&bar[XB_XGEN(b.x)], 1u);
            asm volatile("s_waitcnt vmcnt(0)" ::: "memory");
        } else {
            XB_SPIN(xb_ld(&bar[XB_XGEN(b.x)]) == gen, bar);
            __builtin_amdgcn_fence(__ATOMIC_ACQUIRE, "agent");
            asm volatile("s_waitcnt vmcnt(0)" ::: "memory");
        }
    }
    __syncthreads();
}

struct Args { const float* in[36]; float* out; unsigned char* ws; int ph_lo, ph_hi; };
struct Frame {
    LAS unsigned char* lds; int tid, lane, wave, gw, ngw;
    float* out; unsigned char* ws;
    const __attribute__((address_space(4))) Args* ka;
};

#define PHASE_PIN(F) do { unsigned long long _z64; int _z32; asm volatile("s_mov_b64 %0, 0\n\ts_mov_b32 %1, 0" : "=s"(_z64), "=s"(_z32)); asm volatile("" : "+v"((F).lane)); \
    (F).ws += _z64; (F).out += _z64; (F).ka = (const __attribute__((address_space(4))) Args*)((const __attribute__((address_space(4))) char*)(F).ka + _z64); \
    (F).gw += _z32; (F).ngw += _z32; (F).wave += _z32; (F).tid = (F).wave * 64 + (F).lane; } while (0)
struct TrJob { const float* W; int K, ldw, col_off, ncols; bf16_t* WT; int ldt, row_off; const float* g; const float* mu; int mode; float cs; };
__device__ __forceinline__ void tr_item(const TrJob& J, int item, LAS float* scr, int lane) {
    const int nblk = (J.ncols + 31) / 32, kb = item / nblk, nb = item % nblk, k0 = 64 * kb, n0 = 32 * nb;
#pragma unroll 8
    for (int i = 0; i < 32; ++i) {
        const int kk = 2 * i + (lane >> 5), n = lane & 31, k = k0 + kk;
        float v = 0.f;
        if (k < J.K && n0 + n < J.ncols) {
            float s = J.cs;
            if (J.g) s *= J.g[k];
            if (J.mode == 1) s *= (1.0f - J.mu[k]); else if (J.mode == 2) s *= J.mu[k];
            v = J.W[(size_t)k * J.ldw + J.col_off + n0 + n] * s;
        }
        scr[kk * 33 + n] = v;
    }
    LDS_WAIT(); asm volatile("" ::: "memory");
    const int c = lane & 7;
#pragma unroll
    for (int j = 0; j < 4; ++j) {
        const int n = (lane >> 3) + 8 * j; const LAS float* s = scr + (8 * c) * 33 + n;
        u32x4 o; o.x = pk2(s[0 * 33], s[1 * 33]); o.y = pk2(s[2 * 33], s[3 * 33]); o.z = pk2(s[4 * 33], s[5 * 33]); o.w = pk2(s[6 * 33], s[7 * 33]);
        if (n0 + n < J.ncols && k0 + 8 * c < J.K) *(u32x4*)(J.WT + (size_t)(J.row_off + n0 + n) * J.ldt + k0 + 8 * c) = o;
    }
    LDS_WAIT(); asm volatile("" ::: "memory");
}
__device__ __forceinline__ void tr_job(Frame& F, const TrJob& J, int rot) {
    LAS float* scr = (LAS float*)(F.lds + F.wave * LDS_WSCR);
    const int nitems = ((J.K + 63) / 64) * ((J.ncols + 31) / 32);
    int start = F.gw - (rot % F.ngw); if (start < 0) start += F.ngw;
    for (int it = start; it < nitems; it += F.ngw) tr_item(J, it, scr, F.lane);
}
__device__ __forceinline__ void zero_rows(Frame& F, bf16_t* WT, int ld, int r0, int r1) {
    const size_t n16 = (size_t)(r1 - r0) * ld / 8; u32x4* p = (u32x4*)(WT + (size_t)r0 * ld);
    for (size_t i = (size_t)F.gw * 64 + F.lane; i < n16; i += (size_t)F.ngw * 64) p[i] = (u32x4){0u, 0u, 0u, 0u};
}
__device__ __forceinline__ void row_norm_to_bf16(const float* xrow, bf16_t* orow, int lane) {
    const f32x4* xr = (const f32x4*)xrow + lane; f32x4 v[4]; float s = 0.f;
#pragma unroll
    for (int j = 0; j < 4; ++j) { v[j] = xr[64 * j]; s += (v[j].x * v[j].x + v[j].y * v[j].y) + (v[j].z * v[j].z + v[j].w * v[j].w); }
    const float rstd = rsqrtf(wave_sum(s) * (1.f / DM) + RMS_EPS);
    u32x2* o8 = (u32x2*)orow + lane;
#pragma unroll
    for (int j = 0; j < 4; ++j) { u32x2 w; w.x = pk2(v[j].x * rstd, v[j].y * rstd); w.y = pk2(v[j].z * rstd, v[j].w * rstd); o8[64 * j] = w; }
}

__device__ __forceinline__ void ph_prologue(Frame& F, const Args& A) {
    PHASE_PIN(F);
    unsigned char* ws = F.ws; int rot = 0;
    for (int e = 0; e < 2; ++e) {
        bf16_t* WT = (bf16_t*)(ws + W_WIN) + (size_t)e * NCOL * DM;
        const float* g = F.ka->in[1] + e * DM; const float* mul = F.ka->in[5] + (size_t)e * 3 * DM;
        TrJob J{F.ka->in[2] + (size_t)e * DM * 2760, DM, 2760, 0, 2760, WT, DM, 0, g, nullptr, 0, 1.0f}; tr_job(F, J, rot); rot += 1392;
        zero_rows(F, WT, DM, 2760, C_PW);
        TrJob Jw1{F.ka->in[7] + (size_t)e * DM * 64, DM, 64, 0, 64, WT, DM, C_PW, g, mul, 1, 1.0f}; tr_job(F, Jw1, rot); rot += 32;
        TrJob Jw2{F.ka->in[7] + (size_t)e * DM * 64, DM, 64, 0, 64, WT, DM, C_QW, g, mul, 2, 1.0f}; tr_job(F, Jw2, rot); rot += 32;
        TrJob Ja1{F.ka->in[10] + (size_t)e * DM * 64, DM, 64, 0, 64, WT, DM, C_PA, g, mul + DM, 1, 1.0f}; tr_job(F, Ja1, rot); rot += 32;
        TrJob Ja2{F.ka->in[10] + (size_t)e * DM * 64, DM, 64, 0, 64, WT, DM, C_QA, g, mul + DM, 2, 1.0f}; tr_job(F, Ja2, rot); rot += 32;
        TrJob Jg1{F.ka->in[12] + (size_t)e * DM * 128, DM, 128, 0, 128, WT, DM, C_PG, g, mul + 2 * DM, 1, 1.0f}; tr_job(F, Jg1, rot); rot += 64;
        TrJob Jg2{F.ka->in[12] + (size_t)e * DM * 128, DM, 128, 0, 128, WT, DM, C_QG, g, mul + 2 * DM, 2, 1.0f}; tr_job(F, Jg2, rot); rot += 64;
        if (e == 1) {
            TrJob Jv1{F.ka->in[21], DM, 32, 0, 32, WT, DM, C_PV, g, F.ka->in[19], 1, 1.0f}; tr_job(F, Jv1, rot); rot += 16;
            TrJob Jv2{F.ka->in[21], DM, 32, 0, 32, WT, DM, C_QV, g, F.ka->in[19], 2, 1.0f}; tr_job(F, Jv2, rot); rot += 16;
            zero_rows(F, WT, DM, C_QV + 32, NCOL);
        } else zero_rows(F, WT, DM, C_PV, NCOL);
        TrJob Jo{F.ka->in[3] + (size_t)e * DM * DM, DM, DM, 0, DM, (bf16_t*)(ws + W_WOUTE) + (size_t)e * DM * DM, DM, 0, nullptr, nullptr, 0, 1.0f}; tr_job(F, Jo, rot); rot += 512;
        { bf16_t* L2W = (bf16_t*)(ws + W_L2) + (size_t)e * (288 * 512);
          TrJob Jl1{F.ka->in[8] + (size_t)e * 64 * 512, 64, 512, 0, 512, L2W, 64, 0, nullptr, nullptr, 0, 1.0f}; tr_job(F, Jl1, rot); rot += 16;
          TrJob Jl2{F.ka->in[11] + (size_t)e * 64 * 512, 64, 512, 0, 512, L2W + 64 * 512, 64, 0, nullptr, nullptr, 0, 1.0f}; tr_job(F, Jl2, rot); rot += 16;
          TrJob Jl3{F.ka->in[13] + (size_t)e * 128 * 512, 128, 512, 0, 512, L2W + 128 * 512, 128, 0, nullptr, nullptr, 0, 1.0f}; tr_job(F, Jl3, rot); rot += 32;
          if (e == 1) { TrJob Jl4{F.ka->in[22], 32, 512, 0, 512, L2W + 256 * 512, 32, 0, nullptr, nullptr, 0, 1.0f}; tr_job(F, Jl4, rot); rot += 16; } }
        { const float* Wkv = F.ka->in[24] + (size_t)e * 128 * 1024; bf16_t* WkB = (bf16_t*)(ws + W_WKB) + (size_t)e * 8 * 128 * 64;
          for (int i = F.gw * 64 + F.lane; i < 8 * 128 * 64; i += F.ngw * 64) { const int d = i & 63, r = (i >> 6) & 127, h = i >> 13; WkB[i] = (bf16_t)f2bf(Wkv[(size_t)r * 1024 + h * 64 + d]); } }
        TrJob Jv{F.ka->in[24] + (size_t)e * 128 * 1024, 128, 1024, 512, 512, (bf16_t*)(ws + W_WVT) + (size_t)e * 512 * 128, 128, 0, nullptr, nullptr, 0, 1.0f}; tr_job(F, Jv, rot); rot += 32;
    }
    for (int o = 0; o < 2; ++o) {
        const float* g = F.ka->in[26] + o * DM; bf16_t* WT = (bf16_t*)(ws + W_WQKV) + (size_t)o * 3072 * DM;
        TrJob Jq{F.ka->in[27] + (size_t)o * DM * 3072, DM, 3072, 0, 1024, WT, DM, 0, g, nullptr, 0, LOG2E * 0.125f}; tr_job(F, Jq, rot); rot += 512;
        TrJob Jk{F.ka->in[27] + (size_t)o * DM * 3072, DM, 3072, 1024, 2048, WT, DM, 1024, g, nullptr, 0, 1.0f}; tr_job(F, Jk, rot); rot += 1024;
        TrJob Jo{F.ka->in[28] + (size_t)o * DM * DM, DM, DM, 0, DM, (bf16_t*)(ws + W_WOUTO) + (size_t)o * DM * DM, DM, 0, nullptr, nullptr, 0, 1.0f}; tr_job(F, Jo, rot); rot += 512;
    }
    for (int m = F.gw; m < NT; m += F.ngw) row_norm_to_bf16(F.ka->in[0] + (size_t)m * DM, (bf16_t*)(ws + WS_XB) + (size_t)m * DM, F.lane);
}

__device__ __forceinline__ void moe_weight_prep(Frame& F, const Args& A, int l) {
    PHASE_PIN(F);
    LAS float* scr = (LAS float*)(F.lds + F.wave * LDS_WSCR);
    const float* g = F.ka->in[29] + l * DM;
    const float* w1 = F.ka->in[32] + (size_t)l * 32 * DM * 512; const float* w3 = F.ka->in[33] + (size_t)l * 32 * DM * 512; const float* w2 = F.ka->in[34] + (size_t)l * 32 * 512 * DM;
    bf16_t* W13T = (bf16_t*)(F.ws + WS_W13T); bf16_t* W2T = (bf16_t*)(F.ws + WS_W2T);
    for (int it = F.gw; it < 16384; it += F.ngw) {
        const int job = it >> 6, item = it & 63, which = job & 1, j = (job >> 1) & 3, e = job >> 3;
        TrJob J{(which ? w3 : w1) + (size_t)e * DM * 512, DM, 512, 128 * j, 128, W13T, DM, e * 1024 + 256 * j + 128 * which, g, nullptr, 0, 1.0f};
        tr_item(J, item, scr, F.lane);
    }
    for (int it = F.gw; it < 8192; it += F.ngw) {
        const int e = it >> 8, item = it & 255;
        TrJob J{w2 + (size_t)e * 512 * DM, 512, DM, 0, DM, W2T, 512, e * 1024, nullptr, nullptr, 0, 1.0f};
        tr_item(J, item, scr, F.lane);
    }
}

#define MFMA32(a, b, c) __builtin_amdgcn_mfma_f32_32x32x16_bf16((a), (b), (c), 0, 0, 0)
template <class Epi>
__device__ __forceinline__ void sg_tile(const bf16_t* A, int lda, const bf16_t* B0, const bf16_t* B1, int ldb, int K, int m0, const Epi& epi, int lane) {
    const int r = lane & 31, h = lane >> 5;
    const bf16_t* a0 = A + (size_t)(m0 + r) * lda + 8 * h; const bf16_t* a1 = a0 + (size_t)32 * lda;
    const bf16_t* b0 = B0 + (size_t)r * ldb + 8 * h; const bf16_t* b1 = B1 + (size_t)r * ldb + 8 * h;
    f32x16 c00, c01, c10, c11;
#pragma unroll
    for (int i = 0; i < 16; ++i) { c00[i] = 0.f; c01[i] = 0.f; c10[i] = 0.f; c11[i] = 0.f; }
#pragma unroll 4
    for (int k = 0; k < K; k += 16) {
        const bf16x8 fa0 = *(const bf16x8*)(a0 + k), fa1 = *(const bf16x8*)(a1 + k), fb0 = *(const bf16x8*)(b0 + k), fb1 = *(const bf16x8*)(b1 + k);
        c00 = MFMA32(fb0, fa0, c00); c01 = MFMA32(fb1, fa0, c01); c10 = MFMA32(fb0, fa1, c10); c11 = MFMA32(fb1, fa1, c11);
    }
#pragma unroll
    for (int g = 0; g < 4; ++g) {
        const int j = 8 * g + 4 * h;
        epi.pair(m0 + r, j, (f32x4){c00[4 * g], c00[4 * g + 1], c00[4 * g + 2], c00[4 * g + 3]}, (f32x4){c01[4 * g], c01[4 * g + 1], c01[4 * g + 2], c01[4 * g + 3]});
        epi.pair(m0 + 32 + r, j, (f32x4){c10[4 * g], c10[4 * g + 1], c10[4 * g + 2], c10[4 * g + 3]}, (f32x4){c11[4 * g], c11[4 * g + 1], c11[4 * g + 2], c11[4 * g + 3]});
    }
}
struct EpiStoreBf16 {
    bf16_t* O; int ldo, n0, n1;
    __device__ __forceinline__ void pair(int row, int j, f32x4 v0, f32x4 v1) const {
        u32x2 w; w.x = pk2(v0.x, v0.y); w.y = pk2(v0.z, v0.w); *(u32x2*)(O + (size_t)row * ldo + n0 + j) = w;
        w.x = pk2(v1.x, v1.y); w.y = pk2(v1.z, v1.w); *(u32x2*)(O + (size_t)row * ldo + n1 + j) = w;
    }
};
struct EpiResidF32 {
    const float* S; float* X; int n0, n1;
    __device__ __forceinline__ void pair(int row, int j, f32x4 v0, f32x4 v1) const {
        const size_t o0 = (size_t)row * DM + n0 + j, o1 = (size_t)row * DM + n1 + j;
        *(f32x4*)(X + o0) = *(const f32x4*)(S + o0) + v0; *(f32x4*)(X + o1) = *(const f32x4*)(S + o1) + v1;
    }
};
struct EpiGated {
    bf16_t* H; int hc;
    __device__ __forceinline__ void pair(int row, int j, f32x4 a, f32x4 b) const {
        f32x4 o;
#pragma unroll
        for (int i = 0; i < 4; ++i) o[i] = a[i] * sigmoidf_(a[i]) * b[i];
        u32x2 w; w.x = pk2(o.x, o.y); w.y = pk2(o.z, o.w); *(u32x2*)(H + (size_t)row * 512 + hc + j) = w;
    }
};
__device__ __forceinline__ void sg_dense_bf16(Frame& F, const bf16_t* A, int lda, const bf16_t* Bt, int K, int M, int N, bf16_t* O, int ldo) {
    PHASE_PIN(F);
    const int nN = N / 64, ntile = (M / 64) * nN;
    for (int t = F.gw; t < ntile; t += F.ngw) {
        const int mt = t / nN, nt = t % nN; EpiStoreBf16 E{O, ldo, nt * 64, nt * 64 + 32};
        sg_tile(A, lda, Bt + (size_t)(nt * 64) * K, Bt + (size_t)(nt * 64 + 32) * K, K, K, mt * 64, E, F.lane);
    }
}
__device__ __forceinline__ void sg_dense_resid(Frame& F, const bf16_t* A, const bf16_t* Bt, const float* S, float* X) {
    PHASE_PIN(F);
    const int nN = DM / 64, ntile = (NT / 64) * nN;
    for (int t = F.gw; t < ntile; t += F.ngw) {
        const int mt = t / nN, nt = t % nN; EpiResidF32 E{S, X, nt * 64, nt * 64 + 32};
        sg_tile(A, DM, Bt + (size_t)(nt * 64) * DM, Bt + (size_t)(nt * 64 + 32) * DM, DM, DM, mt * 64, E, F.lane);
    }
}

namespace pg8 {
#define PG8_LAS __attribute__((address_space(3)))
typedef unsigned short bf16_t;
typedef short bf16x8 __attribute__((ext_vector_type(8)));
typedef float f32x4 __attribute__((ext_vector_type(4)));
typedef unsigned u32x4 __attribute__((ext_vector_type(4)));
constexpr int BM = 256, BK = 64, HALF = 128, HTB = HALF * BK * 2  , STAGE_BYTES = 8 * HTB, NXCD = 8, WGM = 8;

__host__ __device__ __forceinline__ int lds_byte(int r, int c) { const int st = (r >> 4) * 2 + (c >> 5), rr = r & 15, cc = c & 31, ob = rr * 64 + cc * 2; return st * 1024 + (ob ^ (((ob >> 9) & 1) << 5)); }
__host__ __device__ __forceinline__ void stage_rc(int b, int& R, int& C) { const int st = b / 1024, sb = b % 1024, swz = sb ^ (((sb >> 9) & 1) << 5); R = (st >> 1) * 16 + swz / 64; C = (st & 1) * 32 + (swz % 64) / 2; }
__host__ __device__ __forceinline__ int perm32(int rho) { const int n = rho >> 4, i = rho & 15; return 8 * (i >> 2) + 4 * n + (i & 3); }

struct Unit { int pm, pn; };
struct Gemm { const bf16_t* A; const bf16_t* Bt; int M, N, K; };

struct StaticOrder {
    int nM, nN, nwg, G, c;
    __host__ __device__ void init(int M, int N, int G_, int c_) { nM = M / BM; nN = N / BM; nwg = nM * nN; G = G_; c = c_; }
    __host__ __device__ bool next(int i, Unit& u) const {
        const long L = (long)i * G + c; if (L >= nwg) return false;
        int wgid = (int)L; { const int q = nwg / NXCD, r = nwg % NXCD, xcd = wgid % NXCD, off = wgid / NXCD; wgid = (xcd < r ? xcd * (q + 1) : r * (q + 1) + (xcd - r) * q) + off; }
        const int nig = WGM * nN, gid = wgid / nig, fm = gid * WGM, gsz = (nM - fm) < WGM ? (nM - fm) : WGM;
        u.pm = fm + ((wgid % nig) % gsz); u.pn = (wgid % nig) / gsz; return true;
    }
    __device__ __forceinline__ void a_ready(const Unit&) const {}
    __device__ __forceinline__ void done(const Unit&) const {}
};

__device__ __forceinline__ unsigned cvt_pk_bf16(float lo, float hi) { unsigned r; asm volatile("v_cvt_pk_bf16_f32 %0, %1, %2" : "=v"(r) : "v"(lo), "v"(hi)); return r; }
struct EpiBf16S {
    static constexpr bool PERM = true, AFTER_DRAIN = false;
    bf16_t* O; int ldc; int split_cols; size_t split_stride;
    __device__ __forceinline__ void operator()(const f32x4 (&acc)[2][2][4][2], const Unit& u, int wr, int wc, int fr, int fq) const {
        const int row0 = u.pm * BM + wr * 64 + fr; int colt = u.pn * BM; bf16_t* base = O;
        if (split_cols) { const int t = colt / split_cols; base += (size_t)t * split_stride; colt -= t * split_cols; }
        const int col0 = colt + wc * 32 + 8 * fq;
#pragma unroll
        for (int ai = 0; ai < 2; ++ai)
#pragma unroll
            for (int m = 0; m < 4; ++m) { bf16_t* rowp = base + (size_t)(row0 + ai * HALF + m * 16) * ldc + col0;
#pragma unroll
                for (int bj = 0; bj < 2; ++bj) { const f32x4 v0 = acc[ai][bj][m][0], v1 = acc[ai][bj][m][1];
                    u32x4 w; w.x = cvt_pk_bf16(v0[0], v0[1]); w.y = cvt_pk_bf16(v0[2], v0[3]); w.z = cvt_pk_bf16(v1[0], v1[1]); w.w = cvt_pk_bf16(v1[2], v1[3]);
                    *(u32x4*)(rowp + bj * HALF) = w; } }
    }
};
struct EpiResid {
    static constexpr bool PERM = false, AFTER_DRAIN = false;
    const float* S; float* X;
    __device__ __forceinline__ void operator()(const f32x4 (&acc)[2][2][4][2], const Unit& u, int wr, int wc, int fr, int fq) const {
        const int row0 = u.pm * BM + wr * 64 + fr, col0 = u.pn * BM + wc * 32 + 4 * fq;
#pragma unroll
        for (int ai = 0; ai < 2; ++ai)
#pragma unroll
            for (int m = 0; m < 4; ++m) { const size_t off = (size_t)(row0 + ai * HALF + m * 16) * 1024 + col0;
#pragma unroll
                for (int bj = 0; bj < 2; ++bj)
#pragma unroll
                    for (int n = 0; n < 2; ++n) *(f32x4*)(X + off + bj * HALF + n * 16) = *(const f32x4*)(S + off + bj * HALF + n * 16) + acc[ai][bj][m][n]; }
    }
};
struct EpiGate {
    static constexpr bool PERM = true, AFTER_DRAIN = false;
    bf16_t* H;
    __device__ __forceinline__ void operator()(const f32x4 (&acc)[2][2][4][2], const Unit& u, int wr, int wc, int fr, int fq) const {
        const int row0 = u.pm * BM + wr * 64 + fr, col0 = (u.pn & 3) * 128 + wc * 32 + 8 * fq;
#pragma unroll
        for (int ai = 0; ai < 2; ++ai)
#pragma unroll
            for (int m = 0; m < 4; ++m) { float o[8];
#pragma unroll
                for (int n = 0; n < 2; ++n)
#pragma unroll
                    for (int i = 0; i < 4; ++i) { const float a = acc[ai][0][m][n][i], b = acc[ai][1][m][n][i]; o[4 * n + i] = a * b * __builtin_amdgcn_rcpf(1.0f + __builtin_amdgcn_exp2f(-1.4426950408889634f * a)); }
                u32x4 w; w.x = cvt_pk_bf16(o[0], o[1]); w.y = cvt_pk_bf16(o[2], o[3]); w.z = cvt_pk_bf16(o[4], o[5]); w.w = cvt_pk_bf16(o[6], o[7]);
                *(u32x4*)(H + (size_t)(row0 + ai * HALF + m * 16) * 512 + col0) = w; }
    }
};
struct EpiMoeDown {
    static constexpr bool PERM = true, AFTER_DRAIN = false;
    bf16_t* Y;
    __device__ __forceinline__ void operator()(const f32x4 (&acc)[2][2][4][2], const Unit& u, int wr, int wc, int fr, int fq) const {
        const int row0 = u.pm * BM + wr * 64 + fr, col0 = (u.pn & 3) * BM + wc * 32 + 8 * fq;
#pragma unroll
        for (int ai = 0; ai < 2; ++ai)
#pragma unroll
            for (int m = 0; m < 4; ++m) { bf16_t* rowp = Y + (size_t)(row0 + ai * HALF + m * 16) * 1024 + col0;
#pragma unroll
                for (int bj = 0; bj < 2; ++bj) { const f32x4 v0 = acc[ai][bj][m][0], v1 = acc[ai][bj][m][1];
                    u32x4 w; w.x = cvt_pk_bf16(v0[0], v0[1]); w.y = cvt_pk_bf16(v0[2], v0[3]); w.z = cvt_pk_bf16(v1[0], v1[1]); w.w = cvt_pk_bf16(v1[2], v1[3]);
                    *(u32x4*)(rowp + bj * HALF) = w; } }
    }
};
struct MoeOrder {
    int nunits, G, c; const PG8_LAS int* tab;
    __device__ __forceinline__ bool next(int i, Unit& u) const {
        const int L = i * G + c; if (L >= nunits) return false;
        const int rt = L >> 2; u.pm = rt; u.pn = __builtin_amdgcn_readfirstlane(tab[rt]) * 4 + (L & 3); return true;
    }
    __device__ __forceinline__ void a_ready(const Unit&) const {}
    __device__ __forceinline__ void done(const Unit&) const {}
};
template <class Epi, class Sched, bool STAMP = false>
__device__ __forceinline__ void gemm_phase(PG8_LAS unsigned char* lds, const Gemm g, const Sched& S, const Epi& E, unsigned long long* stamps, const int wid_in) {
    int ln_; asm volatile("v_mbcnt_lo_u32_b32 %0, -1, 0\n\tv_mbcnt_hi_u32_b32 %0, -1, %0" : "=v"(ln_)); const int tid = wid_in * 64 + ln_, wid = wid_in, lane = tid & 63, wr = wid >> 2, wc = wid & 3, fr = lane & 15, fq = lane >> 4;
    const int K = g.K, nt = K / BK;
    int ts_lo = 0, ts_hi = 0, nts = 0; const unsigned long long rt_entry = STAMP ? (unsigned long long)wall_clock64() : 0ull;
#define PG8_STAMP() do { if (STAMP && wid == 0 && nts < 64) { const unsigned long long _c = (unsigned long long)clock64(); \
        ts_lo = (lane == nts) ? (int)(unsigned)_c : ts_lo; ts_hi = (lane == nts) ? (int)(unsigned)(_c >> 32) : ts_hi; ++nts; } } while (0)
    PG8_STAMP();
    unsigned voffA[2], voffB[2];
#pragma unroll
    for (int i = 0; i < 2; ++i) { int R, C; stage_rc(tid * 16 + i * 8192, R, C); const int Rb = Epi::PERM ? ((R & ~31) + perm32(R & 31)) : R;
        voffA[i] = (unsigned)(R * K + C) * 2u; voffB[i] = (unsigned)(Rb * K + C) * 2u; }
    const size_t kstep = (size_t)(BK * 2);
    const size_t hstep = (size_t)HALF * K * 2;
    const size_t tstep = 2 * hstep;
    const unsigned ldsw = (unsigned)wid * 1024u;
    const int aoff = lds_byte(wr * 64 + fr, fq * 8), boff = lds_byte(wc * 32 + fr, fq * 8);
#define PG8_SA(b, h) (((b) * 2 + (h)) * HTB)
#define PG8_SB(b, h) ((4 + (b) * 2 + (h)) * HTB)
#define PG8_STAGE(bufoff, gbase, voff) do { _Pragma("unroll") for (int _i = 0; _i < 2; ++_i) \
        __builtin_amdgcn_global_load_lds((const unsigned*)((const char*)(gbase) + (voff)[_i]), (PG8_LAS unsigned*)(lds + (bufoff) + ldsw + _i * 8192), 16, 0, 0); } while (0)
#define PG8_LDA(dst, b, h) do { _Pragma("unroll") for (int m = 0; m < 4; ++m) _Pragma("unroll") for (int k = 0; k < 2; ++k) dst[m][k] = *(const PG8_LAS bf16x8*)(lds + PG8_SA(b, h) + aoff + m * 2048 + k * 1024); } while (0)
#define PG8_LDB(dst, b, h) do { _Pragma("unroll") for (int n = 0; n < 2; ++n) _Pragma("unroll") for (int k = 0; k < 2; ++k) dst[n][k] = *(const PG8_LAS bf16x8*)(lds + PG8_SB(b, h) + boff + n * 2048 + k * 1024); } while (0)
#define PG8_MMA(ai, bj, At, Bt) do { __builtin_amdgcn_s_setprio(1); _Pragma("unroll") for (int m = 0; m < 4; ++m) _Pragma("unroll") for (int n = 0; n < 2; ++n) _Pragma("unroll") for (int k = 0; k < 2; ++k) \
        acc[ai][bj][m][n] = __builtin_amdgcn_mfma_f32_16x16x32_bf16(Bt[n][k], At[m][k], acc[ai][bj][m][n], 0, 0, 0); __builtin_amdgcn_s_setprio(0); } while (0)
#define PG8_WAIT_V(n) asm volatile("s_waitcnt vmcnt(" #n ")" ::: "memory")
#define PG8_WAIT_L(n) asm volatile("s_waitcnt lgkmcnt(" #n ")" ::: "memory")
#define PG8_BAR __builtin_amdgcn_s_barrier()
#define PG8_SCHED __builtin_amdgcn_sched_barrier(0)
    Unit cur, nxt; int ui = 0;
    if (!S.next(0, cur)) return;
    f32x4 acc[2][2][4][2];
#pragma unroll
    for (int a = 0; a < 2; ++a)
#pragma unroll
        for (int b = 0; b < 2; ++b)
#pragma unroll
            for (int m = 0; m < 4; ++m)
#pragma unroll
                for (int n = 0; n < 2; ++n) acc[a][b][m][n] = (f32x4){0.f, 0.f, 0.f, 0.f};
    bf16x8 At[4][2], B0[2][2], B1[2][2];
    const char* cA = (const char*)g.A + (size_t)cur.pm * tstep; const char* cB = (const char*)g.Bt + (size_t)cur.pn * tstep;
    S.a_ready(cur);
    PG8_STAGE(PG8_SB(0, 0), cB, voffB); PG8_STAGE(PG8_SA(0, 0), cA, voffA); PG8_STAGE(PG8_SB(0, 1), cB + hstep, voffB); PG8_STAGE(PG8_SA(0, 1), cA + hstep, voffA);
    if (wr == 1) PG8_BAR;
    PG8_WAIT_V(4); PG8_BAR;
    PG8_STAGE(PG8_SB(1, 0), cB + kstep, voffB); PG8_STAGE(PG8_SA(1, 0), cA + kstep, voffA); PG8_STAGE(PG8_SB(1, 1), cB + hstep + kstep, voffB);
    PG8_WAIT_V(6); PG8_BAR;
    PG8_STAMP();
    for (;;) {
        const bool has_next = S.next(ui + 1, nxt);
        const char* nA = has_next ? (const char*)g.A + (size_t)nxt.pm * tstep : cA; const char* nB = has_next ? (const char*)g.Bt + (size_t)nxt.pn * tstep : cB;
        for (int t = 0; t < nt; t += 2) {
            const bool last = (t == nt - 2);
            const char* a1 = cA + (size_t)(t + 1) * kstep;
            const char* a2 = last ? nA : cA + (size_t)(t + 2) * kstep; const char* b2 = last ? nB : cB + (size_t)(t + 2) * kstep;
            const char* a3 = a2 + kstep; const char* b3 = b2 + kstep;
            if (last && has_next) S.a_ready(nxt);
            PG8_LDB(B0, 0, 0); PG8_SCHED; PG8_LDA(At, 0, 0); PG8_STAGE(PG8_SA(1, 1), a1 + hstep, voffA);
            PG8_WAIT_L(8); PG8_BAR; PG8_WAIT_L(0); PG8_MMA(0, 0, At, B0); PG8_BAR; PG8_SCHED;
            PG8_LDB(B1, 0, 1); PG8_STAGE(PG8_SB(0, 0), b2, voffB);
            PG8_BAR; PG8_WAIT_L(0); PG8_MMA(0, 1, At, B1); PG8_BAR;
            PG8_LDA(At, 0, 1); PG8_STAGE(PG8_SA(0, 0), a2, voffA);
            PG8_BAR; PG8_WAIT_L(0); PG8_MMA(1, 0, At, B0); PG8_BAR; PG8_SCHED;
            PG8_STAGE(PG8_SB(0, 1), b2 + hstep, voffB);
            PG8_WAIT_V(6); PG8_BAR; PG8_MMA(1, 1, At, B1); PG8_BAR;
            PG8_LDB(B0, 1, 0); PG8_SCHED; PG8_LDA(At, 1, 0); PG8_STAGE(PG8_SA(0, 1), a2 + hstep, voffA);
            PG8_WAIT_L(8); PG8_BAR; PG8_WAIT_L(0); PG8_MMA(0, 0, At, B0); PG8_BAR; PG8_SCHED;
            PG8_LDB(B1, 1, 1); PG8_STAGE(PG8_SB(1, 0), b3, voffB);
            PG8_BAR; PG8_WAIT_L(0); PG8_MMA(0, 1, At, B1); PG8_BAR;
            PG8_LDA(At, 1, 1); PG8_STAGE(PG8_SA(1, 0), a3, voffA);
            PG8_BAR; PG8_WAIT_L(0); PG8_MMA(1, 0, At, B0); PG8_BAR; PG8_SCHED;
            PG8_STAGE(PG8_SB(1, 1), b3 + hstep, voffB);
            PG8_WAIT_V(6); PG8_BAR; PG8_MMA(1, 1, At, B1); PG8_BAR;
        }
        PG8_STAMP();
        if constexpr (!Epi::AFTER_DRAIN) { E(acc, cur, wr, wc, fr, fq); S.done(cur); }
        PG8_STAMP();
        if (!has_next) break;
#pragma unroll
        for (int a = 0; a < 2; ++a)
#pragma unroll
            for (int b = 0; b < 2; ++b)
#pragma unroll
                for (int m = 0; m < 4; ++m)
#pragma unroll
                    for (int n = 0; n < 2; ++n) acc[a][b][m][n] = (f32x4){0.f, 0.f, 0.f, 0.f};
        cur = nxt; cA = nA; cB = nB; ++ui;
    }
    PG8_WAIT_V(0);
    if (wr == 0) PG8_BAR;
    PG8_BAR;
    if constexpr (Epi::AFTER_DRAIN) { E.fused(acc, cur, wr, wc, fr, fq, lds, wid, lane); S.done(cur); }
    PG8_STAMP();
    if (STAMP && wid == 0) { stamps[lane] = lane < nts ? (((unsigned long long)(unsigned)ts_hi << 32) | (unsigned)ts_lo) : 0ull;
        if (lane == 62) stamps[62] = rt_entry; if (lane == 63) stamps[63] = (unsigned long long)wall_clock64(); }
#undef PG8_STAMP
#undef PG8_SA
#undef PG8_SB
#undef PG8_STAGE
#undef PG8_LDA
#undef PG8_LDB
#undef PG8_MMA
#undef PG8_WAIT_V
#undef PG8_WAIT_L
#undef PG8_BAR
#undef PG8_SCHED
}
}

__device__ __forceinline__ f32x4 ld_bf4(const bf16_t* p) { const u32x2 w = *(const u32x2*)p; return (f32x4){__uint_as_float(w.x << 16), __uint_as_float(w.x & 0xffff0000u), __uint_as_float(w.y << 16), __uint_as_float(w.y & 0xffff0000u)}; }
__device__ __forceinline__ float fast_sigmoid(float x) { return __builtin_amdgcn_rcpf(1.0f + __builtin_amdgcn_exp2f(-LOG2E * x)); }
__device__ __forceinline__ float fast_tanh(float x) { return 1.0f - 2.0f * __builtin_amdgcn_rcpf(1.0f + __builtin_amdgcn_exp2f(2.0f * LOG2E * x)); }
__device__ __forceinline__ void ld_pq8(const bf16_t* p, const bf16_t* q, bool hp, float (&o)[8]) {
    const u32x4 a = *(const u32x4*)p; u32x4 b = (u32x4){0u, 0u, 0u, 0u}; if (hp) b = *(const u32x4*)q;
    o[0] = __uint_as_float(a.x << 16) + __uint_as_float(b.x << 16); o[1] = __uint_as_float(a.x & 0xffff0000u) + __uint_as_float(b.x & 0xffff0000u);
    o[2] = __uint_as_float(a.y << 16) + __uint_as_float(b.y << 16); o[3] = __uint_as_float(a.y & 0xffff0000u) + __uint_as_float(b.y & 0xffff0000u);
    o[4] = __uint_as_float(a.z << 16) + __uint_as_float(b.z << 16); o[5] = __uint_as_float(a.z & 0xffff0000u) + __uint_as_float(b.z & 0xffff0000u);
    o[6] = __uint_as_float(a.w << 16) + __uint_as_float(b.w << 16); o[7] = __uint_as_float(a.w & 0xffff0000u) + __uint_as_float(b.w & 0xffff0000u);
}
__device__ __forceinline__ bf16x8 pack8(const float (&o)[8]) { u32x4 w; w.x = pk2(o[0], o[1]); w.y = pk2(o[2], o[3]); w.z = pk2(o[4], o[5]); w.w = pk2(o[6], o[7]); return __builtin_bit_cast(bf16x8, w); }
__device__ __forceinline__ void ph_prep(Frame& F, const Args& A, int e) {
    PHASE_PIN(F);
    unsigned char* ws = F.ws; const int lane = F.lane;
    const bf16_t* proj = (const bf16_t*)(ws + WS_PROJ);
    const float* mu_rkv = F.ka->in[4] + (size_t)e * 3 * 512;
    const float* w0 = F.ka->in[6] + e * 512; const float* a0 = F.ka->in[9] + e * 512;
    const float* k_k = F.ka->in[14] + e * 512; const float* k_a = F.ka->in[15] + e * 512; const float* r_k = F.ka->in[16] + e * 512;
    const float* v0 = F.ka->in[20];
    const float* kvn = F.ka->in[23] + e * 128; const float* ikn = F.ka->in[25] + e * 64;
    float* SIN = (float*)(ws + WS_SIN); float* VF = (float*)(ws + WS_VF); float* GATE = (float*)(ws + WS_GATE); float* BON = (float*)(ws + SM_BONUS);
    unsigned* SGN = (unsigned*)(ws + SM_SGN);
    bf16_t* CN = (bf16_t*)(ws + WS_CN); bf16_t* KI = (bf16_t*)(ws + WS_KI); bf16_t* QI = (bf16_t*)(ws + WS_QI);
    for (int m = F.gw; m < NT; m += F.ngw) {
        const bf16_t* pr = proj + (size_t)m * NCOL;
        const float c0 = bf2f(pr[C_CKV + lane]), c1 = bf2f(pr[C_CKV + 64 + lane]);
        const float rs = rsqrtf(wave_sum(c0 * c0 + c1 * c1) * (1.f / 128.f) + RMS_EPS);
        CN[(size_t)m * 128 + lane] = (bf16_t)f2bf(c0 * rs * kvn[lane]); CN[(size_t)m * 128 + 64 + lane] = (bf16_t)f2bf(c1 * rs * kvn[64 + lane]);
        const float ki = bf2f(pr[C_KI + lane]); const float rs2 = rsqrtf(wave_sum(ki * ki) * (1.f / 64.f) + RMS_EPS);
        KI[(size_t)m * 64 + lane] = (bf16_t)f2bf(ki * rs2 * ikn[lane]);
        unsigned sg = 0;
#pragma unroll
        for (int hh = 0; hh < 8; ++hh) { const float w = bf2f(pr[C_WI + hh]); if (w < 0.f) sg |= 1u << hh;
            QI[(size_t)m * 512 + hh * 64 + lane] = (bf16_t)f2bf(fabsf(w) * bf2f(pr[C_QI + hh * 64 + lane])); }
        if (lane == 0) SGN[m] = sg;
    }
    { const int r = lane & 31, hf = lane >> 5;
      const bf16_t* L2W = (const bf16_t*)(ws + W_L2) + (size_t)e * (288 * 512);
      const bf16_t* w2T = L2W; const bf16_t* a2T = L2W + 64 * 512; const bf16_t* g2T = L2W + 128 * 512; const bf16_t* v2T = L2W + 256 * 512;
      for (int it = F.gw; it < 512 * 8; it += F.ngw) {
        const int hh = it & 7, tile = it >> 3, m = tile * 32 + r, t = m & (TT - 1), b = m >> 13; const bool hp = t > 0;
        const bf16_t* pr = proj + (size_t)m * NCOL; const bf16_t* pp = pr - NCOL;
        float ss = 0.f, bon = 0.f;
        float* so = SIN + ((size_t)(b * 8 + hh) * TT + t) * 384;
#pragma unroll
        for (int sub = 0; sub < 2; ++sub)
#pragma unroll
            for (int g = 0; g < 4; ++g) { const int ch4 = hh * 64 + sub * 32 + 8 * g + 4 * hf;
                const f32x4 kk0 = ld_bf4(pr + C_K + ch4); f32x4 kp = (f32x4){0.f, 0.f, 0.f, 0.f}; if (hp) kp = ld_bf4(pp + C_K + ch4);
                const f32x4 mk = *(const f32x4*)(mu_rkv + 512 + ch4), kk4 = *(const f32x4*)(k_k + ch4);
#pragma unroll
                for (int j = 0; j < 4; ++j) { const float kx = (kk0[j] + (kp[j] - kk0[j]) * mk[j]) * kk4[j]; ss += kx * kx; } }
        ss += __shfl_xor(ss, 32);
        const float rn = rsqrtf(fmaxf(ss, 1e-12f));
#pragma unroll 1
        for (int sub = 0; sub < 2; ++sub) {
            const int cb = hh * 64 + sub * 32;
            f32x16 acc;
#pragma unroll
            for (int i = 0; i < 16; ++i) acc[i] = 0.f;
#pragma unroll
            for (int ks = 0; ks < 4; ++ks) { float o[8]; ld_pq8(pr + C_PW + 16 * ks + 8 * hf, pp + C_QW + 16 * ks + 8 * hf, hp, o);
#pragma unroll
                for (int j = 0; j < 8; ++j) o[j] = fast_tanh(o[j]);
                acc = MFMA32(*(const bf16x8*)(w2T + (size_t)(cb + r) * 64 + 16 * ks + 8 * hf), pack8(o), acc); }
#pragma unroll
            for (int g = 0; g < 4; ++g) { const int ch4 = cb + 8 * g + 4 * hf; const f32x4 b0 = *(const f32x4*)(w0 + ch4); f32x4 d;
#pragma unroll
                for (int j = 0; j < 4; ++j) d[j] = __builtin_amdgcn_exp2f(-0.6065306597126334f * LOG2E * fast_sigmoid(b0[j] + acc[4 * g + j]));
                *(f32x4*)(so + 64 + sub * 32 + 8 * g + 4 * hf) = d; }
            float icv[16];
#pragma unroll
            for (int i = 0; i < 16; ++i) acc[i] = 0.f;
#pragma unroll
            for (int ks = 0; ks < 4; ++ks) { float o[8]; ld_pq8(pr + C_PA + 16 * ks + 8 * hf, pp + C_QA + 16 * ks + 8 * hf, hp, o);
                acc = MFMA32(*(const bf16x8*)(a2T + (size_t)(cb + r) * 64 + 16 * ks + 8 * hf), pack8(o), acc); }
#pragma unroll
            for (int g = 0; g < 4; ++g) { const int ch4 = cb + 8 * g + 4 * hf; const f32x4 b0 = *(const f32x4*)(a0 + ch4);
#pragma unroll
                for (int j = 0; j < 4; ++j) icv[4 * g + j] = fast_sigmoid(b0[j] + acc[4 * g + j]); }
#pragma unroll
            for (int i = 0; i < 16; ++i) acc[i] = 0.f;
#pragma unroll
            for (int ks = 0; ks < 8; ++ks) { float o[8]; ld_pq8(pr + C_PG + 16 * ks + 8 * hf, pp + C_QG + 16 * ks + 8 * hf, hp, o);
#pragma unroll
                for (int j = 0; j < 8; ++j) o[j] = fast_sigmoid(o[j]);
                acc = MFMA32(*(const bf16x8*)(g2T + (size_t)(cb + r) * 128 + 16 * ks + 8 * hf), pack8(o), acc); }
#pragma unroll
            for (int g = 0; g < 4; ++g) *(f32x4*)(GATE + (size_t)m * 512 + cb + 8 * g + 4 * hf) = (f32x4){acc[4 * g], acc[4 * g + 1], acc[4 * g + 2], acc[4 * g + 3]};
            if (e == 1) {
#pragma unroll
                for (int i = 0; i < 16; ++i) acc[i] = 0.f;
#pragma unroll
                for (int ks = 0; ks < 2; ++ks) { float o[8]; ld_pq8(pr + C_PV + 16 * ks + 8 * hf, pp + C_QV + 16 * ks + 8 * hf, hp, o);
                    acc = MFMA32(*(const bf16x8*)(v2T + (size_t)(cb + r) * 32 + 16 * ks + 8 * hf), pack8(o), acc); }
            }
#pragma unroll
            for (int g = 0; g < 4; ++g) {
                const int ch4 = cb + 8 * g + 4 * hf;
                const f32x4 rr = ld_bf4(pr + C_R + ch4), kk0 = ld_bf4(pr + C_K + ch4), vv = ld_bf4(pr + C_V + ch4);
                f32x4 rp = (f32x4){0.f, 0.f, 0.f, 0.f}, kp = rp, vp = rp;
                if (hp) { rp = ld_bf4(pp + C_R + ch4); kp = ld_bf4(pp + C_K + ch4); vp = ld_bf4(pp + C_V + ch4); }
                const f32x4 mr = *(const f32x4*)(mu_rkv + ch4), mk = *(const f32x4*)(mu_rkv + 512 + ch4), mv = *(const f32x4*)(mu_rkv + 1024 + ch4);
                const f32x4 kk4 = *(const f32x4*)(k_k + ch4), ka4 = *(const f32x4*)(k_a + ch4), rk4 = *(const f32x4*)(r_k + ch4);
                const f32x4 r1 = rr + (rp - rr) * mr, k1 = kk0 + (kp - kk0) * mk; f32x4 v1 = vv + (vp - vv) * mv;
                if (e == 1) { const f32x4 vb = *(const f32x4*)(v0 + ch4), vf = *(const f32x4*)(VF + (size_t)m * 512 + ch4);
#pragma unroll
                    for (int j = 0; j < 4; ++j) v1[j] = v1[j] + (vf[j] - v1[j]) * fast_sigmoid(vb[j] + acc[4 * g + j]); }
                else *(f32x4*)(VF + (size_t)m * 512 + ch4) = v1;
                f32x4 km, kn, bb;
#pragma unroll
                for (int j = 0; j < 4; ++j) { kn[j] = k1[j] * kk4[j] * rn; bb[j] = icv[4 * g + j] * kn[j];
                    km[j] = k1[j] * (1.0f + (icv[4 * g + j] - 1.0f) * ka4[j]); bon += r1[j] * km[j] * rk4[j]; }
                *(f32x4*)(so + sub * 32 + 8 * g + 4 * hf) = r1; *(f32x4*)(so + 128 + sub * 32 + 8 * g + 4 * hf) = km; *(f32x4*)(so + 320 + sub * 32 + 8 * g + 4 * hf) = v1;
                *(f32x4*)(so + 192 + sub * 32 + 8 * g + 4 * hf) = kn; *(f32x4*)(so + 256 + sub * 32 + 8 * g + 4 * hf) = bb;
                asm volatile("" ::: "memory");
            }
        }
        bon += __shfl_xor(bon, 32);
        if (hf == 0) BON[m * 8 + hh] = bon;
      } }
    { bf16_t* QA = (bf16_t*)(ws + WS_QA); const bf16_t* WkB = (const bf16_t*)(ws + W_WKB) + (size_t)e * 8 * 128 * 64;
      const int ntile = (NT / 64) * 2 * 8;
      for (int tI = F.gw; tI < ntile; tI += F.ngw) {
          const int hh = tI & 7, nt = (tI >> 3) & 1, mt = tI >> 4;
          EpiStoreBf16 E{QA + hh * 128, 1024, nt * 64, nt * 64 + 32};
          sg_tile(proj + C_QB + hh * 64, NCOL, WkB + (size_t)hh * 128 * 64 + (size_t)(nt * 64) * 64, WkB + (size_t)hh * 128 * 64 + (size_t)(nt * 64 + 32) * 64, 64, 64, mt * 64, E, F.lane);
      } }
}

__device__ __forceinline__ float allred16(float x) {
    x += __builtin_bit_cast(float, __builtin_amdgcn_update_dpp(0, __builtin_bit_cast(int, x), 0x128, 0xf, 0xf, false));
    x += __builtin_bit_cast(float, __builtin_amdgcn_update_dpp(0, __builtin_bit_cast(int, x), 0x124, 0xf, 0xf, false));
    x += __builtin_bit_cast(float, __builtin_amdgcn_update_dpp(0, __builtin_bit_cast(int, x), 0x122, 0xf, 0xf, false));
    x += __builtin_bit_cast(float, __builtin_amdgcn_update_dpp(0, __builtin_bit_cast(int, x), 0x121, 0xf, 0xf, false));
    return x;
}
__device__ __forceinline__ void ph_scan(Frame& F) {
    PHASE_PIN(F);
    if (F.wave != 0) return;
    const int lane = F.lane, i = lane >> 4, kq = lane & 15;
    for (int task = blockIdx.x; task < 256; task += gridDim.x) {
        const int bh = task >> 4, rg = task & 15, row = 4 * rg + i, b = bh >> 3, hh = bh & 7;
        const float* sin = (const float*)(F.ws + WS_SIN) + (size_t)bh * TT * 384;
        float* Y = (float*)(F.ws + WS_Y) + (size_t)b * TT * 512 + hh * 64 + row;
        f32x4 R[8], W[8], K[8], KK[8], B[8]; float V[8];
#pragma unroll
        for (int j = 0; j < 8; ++j) { const float* p = sin + (size_t)j * 384; R[j] = *(const f32x4*)(p + 4 * kq); W[j] = *(const f32x4*)(p + 64 + 4 * kq); K[j] = *(const f32x4*)(p + 128 + 4 * kq);
            KK[j] = *(const f32x4*)(p + 192 + 4 * kq); B[j] = *(const f32x4*)(p + 256 + 4 * kq); V[j] = p[320 + row]; }
        float s0 = 0.f, s1 = 0.f, s2 = 0.f, s3 = 0.f;
        for (int t0 = 0; t0 < TT; t0 += 8) {
#pragma unroll
            for (int j = 0; j < 8; ++j) {
                float p = s0 * KK[j].x + s1 * KK[j].y + s2 * KK[j].z + s3 * KK[j].w; p = allred16(p);
                s0 = s0 * W[j].x - p * B[j].x + V[j] * K[j].x; s1 = s1 * W[j].y - p * B[j].y + V[j] * K[j].y;
                s2 = s2 * W[j].z - p * B[j].z + V[j] * K[j].z; s3 = s3 * W[j].w - p * B[j].w + V[j] * K[j].w;
                float y = s0 * R[j].x + s1 * R[j].y + s2 * R[j].z + s3 * R[j].w; y = allred16(y);
                if (kq == 0) Y[(size_t)(t0 + j) * 512] = y;
                if (t0 + j + 8 < TT) { const float* p2 = sin + (size_t)(t0 + j + 8) * 384; R[j] = *(const f32x4*)(p2 + 4 * kq); W[j] = *(const f32x4*)(p2 + 64 + 4 * kq); K[j] = *(const f32x4*)(p2 + 128 + 4 * kq);
                    KK[j] = *(const f32x4*)(p2 + 192 + 4 * kq); B[j] = *(const f32x4*)(p2 + 256 + 4 * kq); V[j] = p2[320 + row]; }
            }
        }
    }
}

__device__ __forceinline__ size_t score_row_off(int b, int t) { const int j = t >> 7; return (size_t)b * SCORE_PER_BATCH + (size_t)16384 * (j * (j + 1) / 2) + (size_t)(t & 127) * (128 * (j + 1)); }
__device__ __forceinline__ void ph_idx_score(Frame& F) {
    PHASE_PIN(F);
    const int lane = F.lane, r = lane & 31, h = lane >> 5;
    const bf16_t* QI = (const bf16_t*)(F.ws + WS_QI); const bf16_t* KI = (const bf16_t*)(F.ws + WS_KI); const unsigned* SGN = (const unsigned*)(F.ws + SM_SGN);
    float* SC = (float*)(F.ws + WS_SCORE);
    for (int it = F.gw; it < 4352; it += F.ngw) {
        const int b = it / 2176; int i = it - b * 2176; i = 2175 - i;
        int a = 1; while (8 * a * (a + 1) <= i) ++a;
        const int rem = i - 8 * a * (a - 1), qt = 16 * (a - 1) + rem / a, g = rem % a;
        const int mq = b * TT + qt * 32 + r;
        bf16x8 qf[8][4];
#pragma unroll
        for (int hh = 0; hh < 8; ++hh)
#pragma unroll
            for (int ks = 0; ks < 4; ++ks) qf[hh][ks] = *(const bf16x8*)(QI + (size_t)mq * 512 + hh * 64 + ks * 16 + 8 * h);
        const unsigned sg = SGN[mq];
        float* srow = SC + score_row_off(b, qt * 32 + r);
        const int kt_end = (16 * g + 15 < qt) ? 16 * g + 15 : qt;
        for (int kt = 16 * g; kt <= kt_end; ++kt) {
            const bf16_t* kp = KI + (size_t)(b * TT + kt * 32 + r) * 64 + 8 * h;
            const bf16x8 kf0 = *(const bf16x8*)(kp), kf1 = *(const bf16x8*)(kp + 16), kf2 = *(const bf16x8*)(kp + 32), kf3 = *(const bf16x8*)(kp + 48);
            float sc[16];
#pragma unroll
            for (int q = 0; q < 16; ++q) sc[q] = 0.f;
#pragma unroll
            for (int hh = 0; hh < 8; ++hh) {
                f32x16 acc;
#pragma unroll
                for (int q = 0; q < 16; ++q) acc[q] = 0.f;
                acc = MFMA32(kf0, qf[hh][0], acc); acc = MFMA32(kf1, qf[hh][1], acc); acc = MFMA32(kf2, qf[hh][2], acc); acc = MFMA32(kf3, qf[hh][3], acc);
                const bool neg = (sg >> hh) & 1u;
#pragma unroll
                for (int q = 0; q < 16; ++q) { const float v = fmaxf(acc[q], 0.f); sc[q] = neg ? sc[q] - v : sc[q] + v; }
            }
#pragma unroll
            for (int g4 = 0; g4 < 4; ++g4) *(f32x4*)(srow + kt * 32 + 8 * g4 + 4 * h) = (f32x4){sc[4 * g4], sc[4 * g4 + 1], sc[4 * g4 + 2], sc[4 * g4 + 3]};
        }
    }
}
__device__ __forceinline__ unsigned block_excl_scan(unsigned v, LAS unsigned* scr, int tid, unsigned* total) {
    const int lane = tid & 63, w = tid >> 6; unsigned x = v;
#pragma unroll
    for (int o = 1; o < 64; o <<= 1) { const unsigned y = __shfl_up(x, o); if (lane >= o) x += y; }
    __syncthreads();
    if (lane == 63) scr[w] = x;
    __syncthreads();
    unsigned base = 0, tot = 0;
#pragma unroll
    for (int j = 0; j < 8; ++j) { const unsigned c = scr[j]; if (j < w) base += c; tot += c; }
    *total = tot;
    return base + x - v;
}
__device__ __forceinline__ void ph_idx_select(Frame& F) {
    PHASE_PIN(F);
    const int tid = F.tid; LAS unsigned* hist = (LAS unsigned*)F.lds; LAS unsigned* misc = hist + 256;
    const float* SC = (const float*)(F.ws + WS_SCORE); int* SEL = (int*)(F.ws + WS_SEL);
    for (int m = blockIdx.x; m < NT; m += gridDim.x) {
        const int t = m & (TT - 1), b = m >> 13, n = t + 1; int* sel = SEL + (size_t)m * 256;
        if (n <= 256) { if (tid < 256) sel[tid] = tid < n ? tid : -1; continue; }
        const float* srow = SC + score_row_off(b, t);
        unsigned key[16];
#pragma unroll
        for (int j = 0; j < 4; ++j) {
            const int idx0 = 4 * (tid + 512 * j);
            if (idx0 < n) { const f32x4 v = *(const f32x4*)(srow + idx0);
#pragma unroll
                for (int i = 0; i < 4; ++i) { const unsigned u = __float_as_uint(v[i]); key[4 * j + i] = (idx0 + i < n) ? ((u & 0x80000000u) ? ~u : (u | 0x80000000u)) : 0u; } }
            else {
#pragma unroll
                for (int i = 0; i < 4; ++i) key[4 * j + i] = 0u; }
        }
        unsigned prefix = 0, mask = 0, need = 256;
#pragma unroll 1
        for (int pass = 0; pass < 4; ++pass) {
            const int shift = 24 - 8 * pass;
            __syncthreads();
            if (tid < 256) hist[tid] = 0;
            __syncthreads();
#pragma unroll
            for (int q = 0; q < 16; ++q) { const int idx = 4 * (tid + 512 * (q >> 2)) + (q & 3); if (idx < n && (key[q] & mask) == prefix) __hip_atomic_fetch_add(&hist[(key[q] >> shift) & 255u], 1u, __ATOMIC_RELAXED, __HIP_MEMORY_SCOPE_WORKGROUP); }
            __syncthreads();
            if (tid < 64) {
                unsigned hv[4], L = 0;
#pragma unroll
                for (int i = 0; i < 4; ++i) { hv[i] = hist[255 - 4 * tid - i]; L += hv[i]; }
                unsigned x = L;
#pragma unroll
                for (int o = 1; o < 64; o <<= 1) { const unsigned y = __shfl_up(x, o); if (tid >= o) x += y; }
                unsigned run = x - L;
#pragma unroll
                for (int i = 0; i < 4; ++i) { if (run < need && need <= run + hv[i]) { misc[16] = 255 - 4 * tid - i; misc[17] = need - run; } run += hv[i]; }
            }
            __syncthreads();
            prefix |= misc[16] << shift; mask |= 255u << shift; need = misc[17];
        }
        unsigned basegt = 0, baseeq = 0; const unsigned ngt = 256 - need;
#pragma unroll
        for (int j = 0; j < 4; ++j) {
            unsigned cg = 0, ce = 0;
#pragma unroll
            for (int i = 0; i < 4; ++i) { const int idx = 4 * (tid + 512 * j) + i; if (idx < n) { cg += key[4 * j + i] > prefix; ce += key[4 * j + i] == prefix; } }
            unsigned tot; const unsigned ex = block_excl_scan(cg | (ce << 16), misc, tid, &tot);
            unsigned pg = basegt + (ex & 0xffffu), pe = baseeq + (ex >> 16);
#pragma unroll
            for (int i = 0; i < 4; ++i) { const int idx = 4 * (tid + 512 * j) + i; if (idx < n) {
                if (key[4 * j + i] > prefix) { sel[pg] = idx; ++pg; }
                else if (key[4 * j + i] == prefix) { if (pe < need) sel[ngt + pe] = idx; ++pe; } } }
            basegt += tot & 0xffffu; baseeq += tot >> 16;
        }
    }
    __syncthreads();
}

#define MFMA16(a, b, c) __builtin_amdgcn_mfma_f32_16x16x32_bf16((a), (b), (c), 0, 0, 0)
__device__ __forceinline__ void ph_sparse(Frame& F, int e) {
    PHASE_PIN(F);
    const int lane = F.lane, hd = lane & 15, gq = lane >> 4; unsigned char* ws = F.ws;
    LAS unsigned char* Tl = F.lds + F.wave * LDS_WSCR;
    bf16_t* QA = (bf16_t*)(ws + WS_QA); const bf16_t* CN = (const bf16_t*)(ws + WS_CN); const int* SEL = (const int*)(ws + WS_SEL);
    for (int m = F.gw; m < NT; m += F.ngw) {
        const int t = m & (TT - 1), b = m >> 13; const int nvalid = (t + 1 < 256) ? t + 1 : 256;
        bf16x8 qf[4];
#pragma unroll
        for (int ks = 0; ks < 4; ++ks) { u32x4 z = (u32x4){0u, 0u, 0u, 0u}; if (hd < 8) z = *(const u32x4*)(QA + (size_t)m * 1024 + hd * 128 + 32 * ks + 8 * gq); qf[ks] = __builtin_bit_cast(bf16x8, z); }
        f32x4 ctx[8];
#pragma unroll
        for (int i = 0; i < 8; ++i) ctx[i] = (f32x4){0.f, 0.f, 0.f, 0.f};
        float mrun = -INFINITY, lsum = 0.f;
        const bf16_t* cbase = CN + (size_t)b * TT * 128;
#pragma unroll 1
        for (int c = 0; c < 4; ++c) {
            if (64 * c >= nvalid) break;
            int sjc = SEL[(size_t)m * 256 + 64 * c + lane]; if (sjc < 0) sjc = 0;
            bf16x8 pc[4][4];
#pragma unroll
            for (int kt = 0; kt < 4; ++kt) { const int s = __shfl(sjc, 16 * kt + hd); const bf16_t* row = cbase + (size_t)s * 128 + 8 * gq;
#pragma unroll
                for (int ks = 0; ks < 4; ++ks) pc[kt][ks] = *(const bf16x8*)(row + 32 * ks); }
            f32x4 d[4];
#pragma unroll
            for (int kt = 0; kt < 4; ++kt) { f32x4 a = (f32x4){0.f, 0.f, 0.f, 0.f};
#pragma unroll
                for (int ks = 0; ks < 4; ++ks) a = MFMA16(pc[kt][ks], qf[ks], a);
#pragma unroll
                for (int q = 0; q < 4; ++q) { const int kidx = 64 * c + 16 * kt + 4 * gq + q; d[kt][q] = (kidx < nvalid) ? a[q] * (0.125f * LOG2E) : -INFINITY; } }
            { LAS unsigned char* wb = Tl + (hd >> 2) * 1024 + (hd & 3) * 2 + gq * 64;
#pragma unroll
              for (int kt = 0; kt < 4; ++kt)
#pragma unroll
                for (int ks = 0; ks < 4; ++ks)
#pragma unroll
                    for (int el = 0; el < 8; ++el) *(LAS bf16_t*)(wb + 4 * kt * 1024 + (32 * ks + el) * 8) = (bf16_t)pc[kt][ks][el]; }
            float mx = fmaxf(fmaxf(fmaxf(d[0][0], d[0][1]), fmaxf(d[0][2], d[0][3])), fmaxf(fmaxf(d[1][0], d[1][1]), fmaxf(d[1][2], d[1][3])));
            mx = fmaxf(mx, fmaxf(fmaxf(fmaxf(d[2][0], d[2][1]), fmaxf(d[2][2], d[2][3])), fmaxf(fmaxf(d[3][0], d[3][1]), fmaxf(d[3][2], d[3][3]))));
            mx = fmaxf(mx, __shfl_xor(mx, 16)); mx = fmaxf(mx, __shfl_xor(mx, 32));
            const float mnew = fmaxf(mrun, mx); const float scale = __builtin_amdgcn_exp2f(mrun - mnew); mrun = mnew;
            float psum = 0.f;
#pragma unroll
            for (int kt = 0; kt < 4; ++kt)
#pragma unroll
                for (int q = 0; q < 4; ++q) { d[kt][q] = __builtin_amdgcn_exp2f(d[kt][q] - mnew); psum += d[kt][q]; }
            lsum = lsum * scale + psum;
#pragma unroll
            for (int i = 0; i < 8; ++i) ctx[i] *= scale;
#pragma unroll
            for (int u = 0; u < 2; ++u) {
                u32x4 pw; pw.x = pk2(d[2 * u][0], d[2 * u][1]); pw.y = pk2(d[2 * u][2], d[2 * u][3]); pw.z = pk2(d[2 * u + 1][0], d[2 * u + 1][1]); pw.w = pk2(d[2 * u + 1][2], d[2 * u + 1][3]);
                const bf16x8 pf = __builtin_bit_cast(bf16x8, pw);
#pragma unroll
                for (int mt = 0; mt < 8; ++mt) { const LAS unsigned char* rb = Tl + gq * 1024 + hd * 8;
                    const u32x2 lo = *(const LAS u32x2*)(rb + (8 * u) * 1024 + 16 * mt * 8);
                    const u32x2 hi = *(const LAS u32x2*)(rb + (8 * u + 4) * 1024 + 16 * mt * 8);
                    u32x4 aw; aw.x = lo.x; aw.y = lo.y; aw.z = hi.x; aw.w = hi.y;
                    ctx[mt] = MFMA16(__builtin_bit_cast(bf16x8, aw), pf, ctx[mt]); }
            }
        }
        lsum += __shfl_xor(lsum, 16); lsum += __shfl_xor(lsum, 32);
        const float inv = 1.0f / lsum;
        if (hd < 8) {
#pragma unroll
            for (int mt = 0; mt < 8; ++mt) { u32x2 w; w.x = pk2(ctx[mt][0] * inv, ctx[mt][1] * inv); w.y = pk2(ctx[mt][2] * inv, ctx[mt][3] * inv);
                *(u32x2*)(QA + (size_t)m * 1024 + hd * 128 + 16 * mt + 4 * gq) = w; }
        }
    }
}
__device__ __forceinline__ void ph_mix_finish(Frame& F, int e) {
    PHASE_PIN(F);
    const int lane = F.lane; unsigned char* ws = F.ws;
    bf16_t* YC = (bf16_t*)(ws + WS_YCAT);
    const float* ln_g = F.ka->in[17] + e * 512; const float* ln_b = F.ka->in[18] + e * 512;
    const float* Yr = (const float*)(ws + WS_Y); const float* GATE = (const float*)(ws + WS_GATE); const float* BON = (const float*)(ws + SM_BONUS); const float* SIN = (const float*)(ws + WS_SIN);
    for (int m = F.gw; m < NT; m += F.ngw) {
        const int t = m & (TT - 1), b = m >> 13;
#pragma unroll 1
        for (int hh = 0; hh < 8; ++hh) {
            const int ch = hh * 64 + lane; const float y = Yr[(size_t)m * 512 + ch];
            const float mean = wave_sum(y) * (1.f / 64.f); const float yc = y - mean; const float var = wave_sum(yc * yc) * (1.f / 64.f);
            const float v1 = SIN[((size_t)(b * 8 + hh) * TT + t) * 384 + 320 + lane];
            const float o = (yc * rsqrtf(var + GN_EPS) * ln_g[ch] + ln_b[ch] + BON[m * 8 + hh] * v1) * GATE[(size_t)m * 512 + ch];
            YC[(size_t)m * 1024 + ch] = (bf16_t)f2bf(o);
        }
    }
    { const bf16_t* CTX = (const bf16_t*)(ws + WS_QA); const bf16_t* WvT = (const bf16_t*)(ws + W_WVT) + (size_t)e * 512 * 128;
      for (int tI = F.gw; tI < (NT / 64) * 8; tI += F.ngw) {
          const int hh = tI & 7, mt = tI >> 3;
          EpiStoreBf16 E{YC + 512 + hh * 64, 1024, 0, 32};
          sg_tile(CTX + hh * 128, 1024, WvT + (size_t)(hh * 64) * 128, WvT + (size_t)(hh * 64 + 32) * 128, 128, 128, mt * 64, E, F.lane);
      } }
}

__device__ __forceinline__ void ph_stickbreak(Frame& F) {
    PHASE_PIN(F);
    const int lane = F.lane, r = lane & 31, hf = lane >> 5; unsigned char* ws = F.ws;
    const bf16_t* Q = (const bf16_t*)(ws + WS_PROJ); const bf16_t* Kb = Q + (size_t)NT * 1024; const bf16_t* Vb = Kb + (size_t)NT * 1024;
    bf16_t* YC = (bf16_t*)(ws + WS_YCAT);
    for (int it = F.gw; it < NB * 16 * 256; it += F.ngw) {
        const int qt = it & 255, hh = (it >> 8) & 15, b = it >> 12;
        const int mq = b * TT + qt * 32 + r;
        bf16x8 qf[4];
#pragma unroll
        for (int ks = 0; ks < 4; ++ks) qf[ks] = *(const bf16x8*)(Q + (size_t)mq * 1024 + hh * 64 + ks * 16 + 8 * hf);
        f32x16 o0, o1;
#pragma unroll
        for (int i = 0; i < 16; ++i) { o0[i] = 0.f; o1[i] = 0.f; }
        float P = 1.0f;
        for (int kt = qt; kt >= 0; --kt) {
            const bf16_t* kp = Kb + (size_t)(b * TT + kt * 32 + r) * 1024 + hh * 64 + 8 * hf;
            const bf16x8 kf0 = *(const bf16x8*)(kp), kf1 = *(const bf16x8*)(kp + 16), kf2 = *(const bf16x8*)(kp + 32), kf3 = *(const bf16x8*)(kp + 48);
            const bf16_t* vp = Vb + (size_t)(b * TT + kt * 32 + 4 * hf) * 1024 + hh * 64 + r;
            bf16x8 vf[2][2];
#pragma unroll
            for (int s2 = 0; s2 < 2; ++s2)
#pragma unroll
                for (int j = 0; j < 8; ++j) { const size_t ko = (size_t)(16 * s2 + 8 * (j >> 2) + (j & 3)) * 1024; vf[0][s2][j] = (short)vp[ko]; vf[1][s2][j] = (short)vp[ko + 32]; }
            f32x16 acc;
#pragma unroll
            for (int i = 0; i < 16; ++i) acc[i] = 0.f;
            acc = MFMA32(kf0, qf[0], acc); acc = MFMA32(kf1, qf[1], acc); acc = MFMA32(kf2, qf[2], acc); acc = MFMA32(kf3, qf[3], acc);
            float kp_[16], be[16];
            const bool diag = (kt == qt);
#pragma unroll
            for (int q = 0; q < 16; ++q) {
                const int key = 8 * (q >> 2) + 4 * hf + (q & 3);
                const float e = __builtin_amdgcn_exp2f(acc[q]); float keep = __builtin_amdgcn_rcpf(1.0f + e);
                if (diag && key >= r) keep = 1.0f;
                kp_[q] = keep; be[q] = 1.0f - keep;
            }
            float ls[16], tot[4], oth[4];
#pragma unroll
            for (int g = 0; g < 4; ++g) { ls[4 * g + 3] = 1.0f; ls[4 * g + 2] = kp_[4 * g + 3]; ls[4 * g + 1] = ls[4 * g + 2] * kp_[4 * g + 2]; ls[4 * g] = ls[4 * g + 1] * kp_[4 * g + 1]; tot[g] = ls[4 * g] * kp_[4 * g]; }
#pragma unroll
            for (int g = 0; g < 4; ++g) oth[g] = __shfl_xor(tot[g], 32);
            const float G0 = tot[0] * oth[0], G1 = tot[1] * oth[1], G2 = tot[2] * oth[2], G3 = tot[3] * oth[3];
            float E[4]; E[3] = 1.0f; E[2] = G3; E[1] = G3 * G2; E[0] = E[1] * G1;
            float w[16];
#pragma unroll
            for (int g = 0; g < 4; ++g) { const float mg = E[g] * (hf == 0 ? oth[g] : 1.0f) * P;
#pragma unroll
                for (int j = 0; j < 4; ++j) w[4 * g + j] = be[4 * g + j] * ls[4 * g + j] * mg; }
            P *= E[0] * G0;
            u32x4 w0, w1;
            w0.x = pk2(w[0], w[1]); w0.y = pk2(w[2], w[3]); w0.z = pk2(w[4], w[5]); w0.w = pk2(w[6], w[7]);
            w1.x = pk2(w[8], w[9]); w1.y = pk2(w[10], w[11]); w1.z = pk2(w[12], w[13]); w1.w = pk2(w[14], w[15]);
            const bf16x8 wf0 = __builtin_bit_cast(bf16x8, w0), wf1 = __builtin_bit_cast(bf16x8, w1);
            o0 = MFMA32(vf[0][0], wf0, o0); o0 = MFMA32(vf[0][1], wf1, o0);
            o1 = MFMA32(vf[1][0], wf0, o1); o1 = MFMA32(vf[1][1], wf1, o1);
            if (__ballot(P > 1e-30f) == 0ull) break;
        }
        bf16_t* op = YC + (size_t)mq * 1024 + hh * 64 + 4 * hf;
#pragma unroll
        for (int g = 0; g < 4; ++g) {
            u32x2 a; a.x = pk2(o0[4 * g], o0[4 * g + 1]); a.y = pk2(o0[4 * g + 2], o0[4 * g + 3]); *(u32x2*)(op + 8 * g) = a;
            u32x2 c; c.x = pk2(o1[4 * g], o1[4 * g + 1]); c.y = pk2(o1[4 * g + 2], o1[4 * g + 3]); *(u32x2*)(op + 32 + 8 * g) = c;
        }
    }
}

__device__ __forceinline__ void ph_moe_route(Frame& F, const Args& A, int l) {
    PHASE_PIN(F);
    const int lane = F.lane; unsigned char* ws = F.ws;
    const float* X = (const float*)(ws + WS_X); bf16_t* XB = (bf16_t*)(ws + WS_XB);
    const float* g = F.ka->in[29] + l * DM; const float* Wg = F.ka->in[30] + (size_t)l * DM * 4; const float* We = F.ka->in[31] + (size_t)l * 4 * DM * 8;
    int* EIDX = (int*)(ws + SM_EIDX); float* GATEV = (float*)(ws + SM_GATE); int* SLOT = (int*)(ws + SM_SLOT);
    unsigned* cnt = (unsigned*)(ws + WS_CTL) + CW_CNT + 64 * l;
    for (int m = F.gw; m < NT; m += F.ngw) {
        const f32x4* xr = (const f32x4*)(X + (size_t)m * DM) + lane; f32x4 v[4]; float s = 0.f;
#pragma unroll
        for (int j = 0; j < 4; ++j) { v[j] = xr[64 * j]; s += (v[j].x * v[j].x + v[j].y * v[j].y) + (v[j].z * v[j].z + v[j].w * v[j].w); }
        const float rstd = rsqrtf(wave_sum(s) * (1.f / DM) + RMS_EPS);
        u32x2* o8 = (u32x2*)(XB + (size_t)m * DM) + lane;
#pragma unroll
        for (int j = 0; j < 4; ++j) { u32x2 w; w.x = pk2(v[j].x * rstd, v[j].y * rstd); w.y = pk2(v[j].z * rstd, v[j].w * rstd); o8[64 * j] = w; }
#pragma unroll
        for (int j = 0; j < 4; ++j) { const f32x4 gg = *((const f32x4*)g + lane + 64 * j); v[j] = v[j] * gg * rstd; }
        float gl[4] = {0.f, 0.f, 0.f, 0.f};
#pragma unroll
        for (int j = 0; j < 4; ++j)
#pragma unroll
            for (int i = 0; i < 4; ++i) { const int k = 4 * (lane + 64 * j) + i; const f32x4 w = *(const f32x4*)(Wg + (size_t)k * 4); const float xv = v[j][i];
                gl[0] += xv * w.x; gl[1] += xv * w.y; gl[2] += xv * w.z; gl[3] += xv * w.w; }
#pragma unroll
        for (int q = 0; q < 4; ++q) gl[q] = wave_sum(gl[q]);
        int gs = 0; float gm = gl[0];
#pragma unroll
        for (int q = 1; q < 4; ++q) if (gl[q] > gm) { gm = gl[q]; gs = q; }
        float gden = 0.f;
#pragma unroll
        for (int q = 0; q < 4; ++q) gden += __expf(gl[q] - gm);
        const float g_gate = 1.0f / gden;
        const float* Wes = We + (size_t)gs * DM * 8;
        float el[8];
#pragma unroll
        for (int q = 0; q < 8; ++q) el[q] = 0.f;
#pragma unroll
        for (int j = 0; j < 4; ++j)
#pragma unroll
            for (int i = 0; i < 4; ++i) { const int k = 4 * (lane + 64 * j) + i; const f32x4 w0 = *(const f32x4*)(Wes + (size_t)k * 8), w1 = *(const f32x4*)(Wes + (size_t)k * 8 + 4); const float xv = v[j][i];
                el[0] += xv * w0.x; el[1] += xv * w0.y; el[2] += xv * w0.z; el[3] += xv * w0.w; el[4] += xv * w1.x; el[5] += xv * w1.y; el[6] += xv * w1.z; el[7] += xv * w1.w; }
#pragma unroll
        for (int q = 0; q < 8; ++q) el[q] = wave_sum(el[q]);
        int i1 = 0; float m1 = el[0];
#pragma unroll
        for (int q = 1; q < 8; ++q) if (el[q] > m1) { m1 = el[q]; i1 = q; }
        int i2 = -1; float m2 = -INFINITY;
#pragma unroll
        for (int q = 0; q < 8; ++q) if (q != i1 && el[q] > m2) { m2 = el[q]; i2 = q; }
        const float e2 = __expf(m2 - m1); const float ga = g_gate / (1.0f + e2), gb = g_gate * e2 / (1.0f + e2);
        if (lane == 0) {
            const int ea = gs * 8 + i1, eb = gs * 8 + i2;
            const unsigned sa = atomicAdd(&cnt[ea], 1u), sb = atomicAdd(&cnt[eb], 1u);
            EIDX[2 * m] = ea; EIDX[2 * m + 1] = eb; GATEV[2 * m] = ga; GATEV[2 * m + 1] = gb; SLOT[2 * m] = (int)sa; SLOT[2 * m + 1] = (int)sb;
        }
    }
}
__device__ __forceinline__ int moe_offsets(const unsigned* cnt, int lane, int* total, int* mycnt_pad) {
    const unsigned c = lane < 32 ? __hip_atomic_load(cnt + (lane & 31), __ATOMIC_RELAXED, __HIP_MEMORY_SCOPE_AGENT) : 0u; const int p = (int)((c + 255u) & ~255u);
    int x = p;
#pragma unroll
    for (int o = 1; o < 64; o <<= 1) { const int y = __shfl_up(x, o); if (lane >= o) x += y; }
    *total = __shfl(x, 63); *mycnt_pad = p;
    return x - p;
}
__device__ __forceinline__ void ph_moe_gather(Frame& F, int l) {
    PHASE_PIN(F);
    const int lane = F.lane; unsigned char* ws = F.ws;
    const unsigned* cnt = (const unsigned*)(ws + WS_CTL) + CW_CNT + 64 * l; int total, pad; const int off = moe_offsets(cnt, lane, &total, &pad);
    const int* EIDX = (const int*)(ws + SM_EIDX); const int* SLOT = (const int*)(ws + SM_SLOT);
    const bf16_t* XB = (const bf16_t*)(ws + WS_XB); bf16_t* AM = (bf16_t*)(ws + WS_AMOE);
    for (int a = F.gw; a < NT * 2; a += F.ngw) {
        const int m = a >> 1, e = EIDX[a], row = __shfl(off, e) + SLOT[a];
        const u32x4* src = (const u32x4*)(XB + (size_t)m * DM); u32x4* dst = (u32x4*)(AM + (size_t)row * DM);
        dst[lane] = src[lane]; dst[lane + 64] = src[lane + 64];
    }
}
__device__ __forceinline__ int moe_build_tab(Frame& F, int l) {
    LAS int* tab = (LAS int*)(F.lds + LDS_MISC + 256); LAS int* ends = (LAS int*)(F.lds + LDS_MISC + 1024);
    const unsigned* cnt = (const unsigned*)(F.ws + WS_CTL) + CW_CNT + 64 * l; int total, pad; const int off = moe_offsets(cnt, F.lane, &total, &pad);
    __syncthreads();
    if (F.tid < 32) ends[F.tid] = off + pad;
    __syncthreads();
    for (int rt = F.tid; rt < total / 256; rt += NTHR) { int e = 0; for (int q = 0; q < 32; ++q) e += (ends[q] <= rt * 256) ? 1 : 0; tab[rt] = e; }
    __syncthreads();
    return total;
}
__device__ __forceinline__ void ph_moe_gemm1(Frame& F, int l) {
    PHASE_PIN(F);
    const int total = moe_build_tab(F, l);
    pg8::Gemm g{(const pg8::bf16_t*)(F.ws + WS_AMOE), (const pg8::bf16_t*)(F.ws + WS_W13T), total, 32 * 1024, DM};
    pg8::MoeOrder S{(total / 256) * 4, (int)gridDim.x, (int)blockIdx.x, (const LAS int*)(F.lds + LDS_MISC + 256)};
    pg8::EpiGate E{(pg8::bf16_t*)(F.ws + WS_H)};
    pg8::gemm_phase<pg8::EpiGate, pg8::MoeOrder>(F.lds, g, S, E, nullptr, F.wave);
}
__device__ __forceinline__ void ph_moe_gemm2(Frame& F, int l) {
    PHASE_PIN(F);
    const int total = moe_build_tab(F, l);
    pg8::Gemm g{(const pg8::bf16_t*)(F.ws + WS_H), (const pg8::bf16_t*)(F.ws + WS_W2T), total, 32 * 1024, 512};
    pg8::MoeOrder S{(total / 256) * 4, (int)gridDim.x, (int)blockIdx.x, (const LAS int*)(F.lds + LDS_MISC + 256)};
    pg8::EpiMoeDown E{(pg8::bf16_t*)(F.ws + WS_YM)};
    pg8::gemm_phase<pg8::EpiMoeDown, pg8::MoeOrder>(F.lds, g, S, E, nullptr, F.wave);
}
__device__ __forceinline__ void ph_moe_combine(Frame& F, const Args& A, int l) {
    PHASE_PIN(F);
    const int lane = F.lane; unsigned char* ws = F.ws;
    const unsigned* cnt = (const unsigned*)(ws + WS_CTL) + CW_CNT + 64 * l; int total, pad; const int off = moe_offsets(cnt, lane, &total, &pad);
    const int* EIDX = (const int*)(ws + SM_EIDX); const int* SLOT = (const int*)(ws + SM_SLOT); const float* GATEV = (const float*)(ws + SM_GATE);
    float* X = (float*)(ws + WS_X); bf16_t* XB = (bf16_t*)(ws + WS_XB); const bf16_t* YM = (const bf16_t*)(ws + WS_YM);
    const float* fg = F.ka->in[35];
    for (int m = F.gw; m < NT; m += F.ngw) {
        const int ea = EIDX[2 * m], eb = EIDX[2 * m + 1]; const float ga = GATEV[2 * m], gb = GATEV[2 * m + 1];
        const int ra = __shfl(off, ea) + SLOT[2 * m], rb = __shfl(off, eb) + SLOT[2 * m + 1];
        f32x4* xr = (f32x4*)(X + (size_t)m * DM) + lane; const u32x2* ya = (const u32x2*)(YM + (size_t)ra * DM) + lane; const u32x2* yb = (const u32x2*)(YM + (size_t)rb * DM) + lane;
        f32x4 v[4]; float s = 0.f;
#pragma unroll
        for (int j = 0; j < 4; ++j) { v[j] = xr[64 * j]; const u32x2 a = ya[64 * j], bq = yb[64 * j];
            v[j].x += ga * __uint_as_float(a.x << 16) + gb * __uint_as_float(bq.x << 16); v[j].y += ga * __uint_as_float(a.x & 0xffff0000u) + gb * __uint_as_float(bq.x & 0xffff0000u);
            v[j].z += ga * __uint_as_float(a.y << 16) + gb * __uint_as_float(bq.y << 16); v[j].w += ga * __uint_as_float(a.y & 0xffff0000u) + gb * __uint_as_float(bq.y & 0xffff0000u);
            s += (v[j].x * v[j].x + v[j].y * v[j].y) + (v[j].z * v[j].z + v[j].w * v[j].w); }
        const float rstd = rsqrtf(wave_sum(s) * (1.f / DM) + RMS_EPS);
        if (l < 3) {
            u32x2* o8 = (u32x2*)(XB + (size_t)m * DM) + lane;
#pragma unroll
            for (int j = 0; j < 4; ++j) { xr[64 * j] = v[j]; u32x2 w; w.x = pk2(v[j].x * rstd, v[j].y * rstd); w.y = pk2(v[j].z * rstd, v[j].w * rstd); o8[64 * j] = w; }
        } else {
            f32x4* orow = (f32x4*)(F.out + (size_t)m * DM) + lane;
#pragma unroll
            for (int j = 0; j < 4; ++j) { const f32x4 gg = *((const f32x4*)fg + lane + 64 * j); orow[64 * j] = v[j] * gg * rstd; }
        }
    }
}

__global__ void __launch_bounds__(NTHR, 2) fwd_kernel(Args args) {
    extern __shared__ __attribute__((aligned(16))) unsigned char lds_raw[];
    Frame F; F.lds = (LAS unsigned char*)lds_raw; F.tid = threadIdx.x; F.lane = F.tid & 63; F.wave = __builtin_amdgcn_readfirstlane(F.tid >> 6);
    F.gw = blockIdx.x * NWAVES + F.wave; F.ngw = gridDim.x * NWAVES; F.out = args.out; F.ws = args.ws; F.ka = (const __attribute__((address_space(4))) Args*)__builtin_amdgcn_kernarg_segment_ptr();
    volatile LAS unsigned* MISC = (volatile LAS unsigned*)(F.lds + LDS_MISC);
    if (F.tid < 64) MISC[F.tid] = 0u;
    __syncthreads();
    const int lo = args.ph_lo, hi = args.ph_hi;
    XcdBarrier bar; bar.bar = (unsigned*)(F.ws + WS_CTL) + CW_BAR; bar.x = 0; bar.st = MISC;
    if (hi - lo > 1) bar = xcd_barrier_post((unsigned*)(F.ws + WS_CTL) + CW_BAR, MISC, F.tid == 0);
#define IN(k) (lo <= (k) && (k) < hi)
#define DUP(k) for (int _rep = 0; _rep < ((DUP_PHASE == (k)) ? 2 : 1); ++_rep)
#define SEAM(k) do { if ((k) + 1 < hi) { PHASE_PIN(F); xcd_barrier(bar, F.tid == 0); } } while (0)
    unsigned char* ws = F.ws;
    if (IN(0)) { DUP(0) ph_prologue(F, args); SEAM(0); }
    for (int l = 0; l < 4; ++l) {
        const int pb = 1 + 16 * l, e = l >> 1;
        const float* xsrc = (l == 0) ? args.in[0] : (const float*)(ws + WS_X);
        if ((l & 1) == 0) {
            if (IN(pb + 0)) { PHASE_PIN(F);
                pg8::Gemm g{(const pg8::bf16_t*)(F.ws + WS_XB), (const pg8::bf16_t*)(F.ws + W_WIN) + (size_t)e * NCOL * DM, NT, NCOL, DM}; pg8::StaticOrder S; S.init(NT, NCOL, (int)gridDim.x, (int)blockIdx.x);
                pg8::EpiBf16S E{(pg8::bf16_t*)(F.ws + WS_PROJ), NCOL, 0, 0};
                pg8::gemm_phase<pg8::EpiBf16S, pg8::StaticOrder>(F.lds, g, S, E, nullptr, F.wave);
                SEAM(pb + 0); }
            if (IN(pb + 1)) {
#ifndef NO_PREP
 DUP(1) ph_prep(F, args, e);
#endif
 SEAM(pb + 1); }
            if (IN(pb + 2)) {
#ifndef NO_SCAN
 DUP(2) ph_scan(F);
#endif
 SEAM(pb + 2); }
            if (IN(pb + 3)) {
#ifndef NO_SCORE
 DUP(3) ph_idx_score(F);
#endif
 SEAM(pb + 3); }
            if (IN(pb + 4)) {
#ifndef NO_SELECT
 DUP(4) ph_idx_select(F);
#endif
 SEAM(pb + 4); }
            if (IN(pb + 5)) {
#ifndef NO_SPARSE
 DUP(5) ph_sparse(F, e);
#endif
 SEAM(pb + 5); }
            if (IN(pb + 6)) { ph_mix_finish(F, e); SEAM(pb + 6); }
        } else {
            if (IN(pb + 0)) { PHASE_PIN(F);
                pg8::Gemm g{(const pg8::bf16_t*)(F.ws + WS_XB), (const pg8::bf16_t*)(F.ws + W_WQKV) + (size_t)e * 3072 * DM, NT, 3072, DM}; pg8::StaticOrder S; S.init(NT, 3072, (int)gridDim.x, (int)blockIdx.x);
                pg8::EpiBf16S E{(pg8::bf16_t*)(F.ws + WS_PROJ), 1024, 1024, (size_t)NT * 1024};
                pg8::gemm_phase<pg8::EpiBf16S, pg8::StaticOrder>(F.lds, g, S, E, nullptr, F.wave);
                SEAM(pb + 0); }
            if (IN(pb + 1)) {
#ifndef NO_SB
 DUP(6) ph_stickbreak(F);
#endif
 SEAM(pb + 1); }
        }
        if (IN(pb + 7)) { PHASE_PIN(F);
            pg8::Gemm g{(const pg8::bf16_t*)(F.ws + WS_YCAT), (const pg8::bf16_t*)(F.ws + ((l & 1) ? W_WOUTO : W_WOUTE)) + (size_t)e * DM * DM, NT, DM, DM}; pg8::StaticOrder S; S.init(NT, DM, (int)gridDim.x, (int)blockIdx.x);
            pg8::EpiResid E{xsrc, (float*)(F.ws + WS_X)};
            pg8::gemm_phase<pg8::EpiResid, pg8::StaticOrder>(F.lds, g, S, E, nullptr, F.wave);
            SEAM(pb + 7); }
        if (IN(pb + 8)) {
#ifndef NO_ROUTE
 ph_moe_route(F, args, l); DUP(7) moe_weight_prep(F, args, l);
#endif
 SEAM(pb + 8); }
        if (IN(pb + 9)) { DUP(8) ph_moe_gather(F, l); SEAM(pb + 9); }
        if (IN(pb + 10)) { DUP(9) ph_moe_gemm1(F, l); SEAM(pb + 10); }
        if (IN(pb + 11)) { DUP(10) ph_moe_gemm2(F, l); SEAM(pb + 11); }
        if (IN(pb + 12)) { ph_moe_combine(F, args, l); SEAM(pb + 12); }
    }
#undef IN
#undef SEAM
}

extern "C" void kernel_launch(void* const* d_in, const int* in_sizes, int n_in, void* d_out, int out_size, void* d_ws, size_t ws_size, hipStream_t stream) {
    static int grid = 0;
    if (grid == 0) {
        if (n_in != 36 || out_size != NT * DM || ws_size < WS_END) { fprintf(stderr, "kernel_launch: unexpected problem (n_in %d out %d ws %zu)\n", n_in, out_size, ws_size); grid = -1; return; }
        int dev = 0, cus = 0, per_cu = 0;
        if (hipGetDevice(&dev) != hipSuccess || hipDeviceGetAttribute(&cus, hipDeviceAttributeMultiprocessorCount, dev) != hipSuccess) { grid = -1; return; }
        if (hipFuncSetAttribute((const void*)fwd_kernel, hipFuncAttributeMaxDynamicSharedMemorySize, LDS_BYTES) != hipSuccess) { grid = -1; return; }
        if (hipOccupancyMaxActiveBlocksPerMultiprocessor(&per_cu, (const void*)fwd_kernel, NTHR, LDS_BYTES) != hipSuccess || per_cu < 1) { fprintf(stderr, "kernel_launch: occupancy query says %d\n", per_cu); }
        (void)hipGetLastError();
        grid = cus;
    }
    if (grid < 0) return;
    (void)hipMemsetAsync((char*)d_ws + WS_CTL, 0, CTL_ZERO_BYTES, stream);
    Args a{};
    for (int i = 0; i < 36; ++i) a.in[i] = (const float*)d_in[i];
    a.out = (float*)d_out; a.ws = (unsigned char*)d_ws;
#if ONE_LAUNCH
    a.ph_lo = 0; a.ph_hi = 65;
    hipLaunchKernelGGL(fwd_kernel, dim3(grid), dim3(NTHR), LDS_BYTES, stream, a);
#else
    for (int p = 0; p < 65; ++p) {
        const int l = (p - 1) >> 4, k = (p - 1) & 15;
        if (p > 0) { if (k > 12) continue; if ((l & 1) && k >= 2 && k <= 6) continue; }
        a.ph_lo = p; a.ph_hi = p + 1;
        hipLaunchKernelGGL(fwd_kernel, dim3(grid), dim3(NTHR), LDS_BYTES, stream, a);
    }
#endif
}
```

```cpp
#include <hip/hip_runtime.h>
#include <cstdio>
#include <cstdint>

#ifndef DUP_PHASE
#define DUP_PHASE -1
#endif
#ifndef CHUNKED
#define CHUNKED 1
#endif
#ifndef ONE_LAUNCH
#define ONE_LAUNCH 1
#endif

#define GAS __attribute__((address_space(1)))
#define LAS __attribute__((address_space(3)))
typedef unsigned short bf16_t;
typedef short bf16x8 __attribute__((ext_vector_type(8)));
typedef float f32x4 __attribute__((ext_vector_type(4)));
typedef float f32x2 __attribute__((ext_vector_type(2)));
typedef float f32x16 __attribute__((ext_vector_type(16)));
typedef unsigned u32x4 __attribute__((ext_vector_type(4)));
typedef unsigned u32x2 __attribute__((ext_vector_type(2)));

constexpr int NT = 16384, TT = 8192, DM = 1024, NB = 2;
constexpr int NCOL = 3584;
constexpr int C_R = 0, C_K = 512, C_V = 1024, C_QB = 1536, C_CKV = 2048, C_QI = 2176, C_KI = 2688, C_WI = 2752;
constexpr int C_PW = 2816, C_QW = 2880, C_PA = 2944, C_QA = 3008, C_PG = 3072, C_QG = 3200, C_PV = 3328, C_QV = 3360;
constexpr int NWAVES = 8, NTHR = 512;
constexpr float RMS_EPS = 1e-6f, GN_EPS = 64e-5f;
constexpr float LOG2E = 1.4426950408889634f;

constexpr size_t MiB = 1u << 20;
constexpr size_t WS_CTL = 0, CTL_ZERO_BYTES = 1 * MiB;
constexpr size_t WS_SMALL = 1 * MiB;
constexpr size_t SM_EIDX = WS_SMALL, SM_GATE = WS_SMALL + 128 * 1024, SM_SLOT = WS_SMALL + 256 * 1024, SM_BONUS = WS_SMALL + 512 * 1024, SM_SGN = WS_SMALL + 1024 * 1024;
constexpr size_t WS_W = 5 * MiB;
constexpr size_t W_WIN = WS_W, W_WOUTE = WS_W + 14 * MiB, W_WQKV = WS_W + 18 * MiB, W_WOUTO = WS_W + 30 * MiB, W_WKB = WS_W + 34 * MiB, W_WVT = W_WKB + 256 * 1024, W_L2 = W_WKB + 512 * 1024;
constexpr size_t WS_X = 45 * MiB, WS_XB = 109 * MiB, WS_PROJ = 141 * MiB, WS_SIN = 253 * MiB, WS_VF = 445 * MiB, WS_Y = 477 * MiB, WS_GATE = 509 * MiB, WS_YCAT = 541 * MiB;
constexpr size_t WS_CN = 573 * MiB, WS_KI = 577 * MiB, WS_QI = 579 * MiB, WS_QA = 595 * MiB, WS_SEL = 627 * MiB;
constexpr size_t WS_BIG = 645 * MiB;
constexpr size_t WS_SCORE = WS_BIG;
constexpr size_t WS_W13T = WS_BIG, WS_W2T = WS_BIG + 64 * MiB, WS_AMOE = WS_BIG + 96 * MiB, WS_H = WS_BIG + 176 * MiB, WS_YM = WS_BIG + 216 * MiB;
constexpr size_t WS_END = 941 * MiB;
constexpr size_t SCORE_PER_BATCH = (size_t)16384 * 2080;
static_assert(WS_SCORE + 2 * SCORE_PER_BATCH * 4 <= WS_END, "score map");
static_assert(WS_YM + (size_t)40960 * 1024 * 2 <= WS_END, "moe map");
constexpr int CW_BAR = 4096;
constexpr int CW_CNT = 16384;

constexpr int LDS_BYTES = 147456;
constexpr int LDS_WSCR = 16384;
constexpr int LDS_MISC = 131072;

__device__ __forceinline__ float bf2f(bf16_t b) { return __uint_as_float(((unsigned)b) << 16); }
__device__ __forceinline__ unsigned f2bf(float f) { unsigned u = __float_as_uint(f); return (u + 0x7fffu + ((u >> 16) & 1u)) >> 16; }
__device__ __forceinline__ unsigned pk2(float lo, float hi) { return f2bf(lo) | (f2bf(hi) << 16); }
__device__ __forceinline__ float wave_sum(float v) {
#pragma unroll
    for (int o = 1; o < 64; o <<= 1) v += __shfl_xor(v, o);
    return v;
}
__device__ __forceinline__ float wave_max(float v) {
#pragma unroll
    for (int o = 1; o < 64; o <<= 1) v = fmaxf(v, __shfl_xor(v, o));
    return v;
}
__device__ __forceinline__ float sigmoidf_(float x) { return 1.0f / (1.0f + __expf(-x)); }
#define LDS_WAIT() asm volatile("s_waitcnt lgkmcnt(0)" ::: "memory")

#define XB_TMO      128
#define XB_XCNT(j)  (256  + 64 * (j))
#define XB_XSUB(j)  (1280 + 64 * (j))
#define XB_XGEN(j)  (2304 + 64 * (j))
#define XB_TOP      3328
#define XB_TOPGEN   3392
#define XCD_BAR_WORDS 3456
#define XB_SPIN_CAP (1u << 18)
__device__ __forceinline__ unsigned xb_ld(unsigned* p)              { return __hip_atomic_load(p, __ATOMIC_RELAXED, __HIP_MEMORY_SCOPE_AGENT); }
__device__ __forceinline__ unsigned xb_add(unsigned* p, unsigned v) { return __hip_atomic_fetch_add(p, v, __ATOMIC_RELAXED, __HIP_MEMORY_SCOPE_AGENT); }
__device__ __forceinline__ unsigned xb_xcc_id() { return (unsigned)__builtin_amdgcn_s_getreg((3 << 11) | 20) & 0xFu; }
#define XB_SPIN(cond, bar) do { unsigned _sp = 0; while (cond) { __builtin_amdgcn_s_sleep(1); \
    if ((++_sp & 255u) == 0u) { if (xb_ld(&(bar)[XB_TMO])) break; if (_sp > XB_SPIN_CAP) { atomicAdd(&(bar)[XB_TMO], 1u); break; } } } } while (0)
struct XcdBarrier { unsigned* bar; unsigned x; volatile LAS unsigned* st; };
__device__ __forceinline__ XcdBarrier xcd_barrier_post(unsigned* bar, volatile LAS unsigned* st, bool t0) {
    XcdBarrier b; b.bar = bar; b.x = xb_xcc_id(); b.st = st;
    if (t0) (void)xb_add(&bar[XB_XCNT(b.x)], 1u);
    return b;
}
__device__ __forceinline__ void xcd_barrier_complete(unsigned* bar, unsigned x, unsigned& nloc, unsigned& nx) {
    const unsigned G = gridDim.x * gridDim.y * gridDim.z;
    unsigned sum, cnt, mine, sp = 0u;
    for (;;) {
        sum = 0u; cnt = 0u; mine = 0u;
#pragma unroll
        for (unsigned j = 0; j < 16; ++j) { const unsigned c = xb_ld(&bar[XB_XCNT(j)]); sum += c; cnt += (c > 0u) ? 1u : 0u; mine = (j == x) ? c : mine; }
        if (sum == G) break;
        __builtin_amdgcn_s_sleep(1);
        if ((++sp & 255u) == 0u) { if (xb_ld(&bar[XB_TMO])) break; if (sp > XB_SPIN_CAP) { atomicAdd(&bar[XB_TMO], 1u); break; } }
    }
    nloc = mine > 0u ? mine : 1u; nx = cnt > 0u ? cnt : 1u;
}
__device__ __forceinline__ void xcd_barrier(const XcdBarrier& b, bool t0) {
    asm volatile("s_waitcnt vmcnt(0)" ::: "memory");
    __syncthreads();
    if (t0) {
        unsigned* bar = b.bar;
        __builtin_amdgcn_s_waitcnt(0);
        unsigned nloc = b.st[0], nx = b.st[1];
        if (nloc == 0u) { xcd_barrier_complete(bar, b.x, nloc, nx); b.st[0] = nloc; b.st[1] = nx; }
        const unsigned old = xb_add(&bar[XB_XSUB(b.x)], 1u);
        const unsigned gen = old / nloc;
        if (old + 1u == (gen + 1u) * nloc) {
            __builtin_amdgcn_fence(__ATOMIC_RELEASE, "agent");
            asm volatile("s_waitcnt vmcnt(0)" ::: "memory");
            const unsigned og = xb_add(&bar[XB_TOP], 1u);
            const unsigned tg = og / nx;
            if (og + 1u == (tg + 1u) * nx) xb_add(&bar[XB_TOPGEN], 1u);
            else XB_SPIN(xb_ld(&bar[XB_TOPGEN]) == tg, bar);
            __builtin_amdgcn_fence(__ATOMIC_ACQUIRE, "agent");
            xb_add(&bar[XB_XGEN(b.x)], 1u);
            asm volatile("s_waitcnt vmcnt(0)" ::: "memory");
        } else {
            XB_SPIN(xb_ld(&bar[XB_XGEN(b.x)]) == gen, bar);
            __builtin_amdgcn_fence(__ATOMIC_ACQUIRE, "agent");
            asm volatile("s_waitcnt vmcnt(0)" ::: "memory");
        }
    }
    __syncthreads();
}

struct Args { const float* in[36]; float* out; unsigned char* ws; int ph_lo, ph_hi; };
struct Frame {
    LAS unsigned char* lds; int tid, lane, wave, gw, ngw;
    float* out; unsigned char* ws;
    const __attribute__((address_space(4))) Args* ka;
};

#define PHASE_PIN(F) do { unsigned long long _z64; int _z32; asm volatile("s_mov_b64 %0, 0\n\ts_mov_b32 %1, 0" : "=s"(_z64), "=s"(_z32)); asm volatile("" : "+v"((F).lane)); \
    (F).ws += _z64; (F).out += _z64; (F).ka = (const __attribute__((address_space(4))) Args*)((const __attribute__((address_space(4))) char*)(F).ka + _z64); \
    (F).gw += _z32; (F).ngw += _z32; (F).wave += _z32; (F).tid = (F).wave * 64 + (F).lane; } while (0)
struct TrJob { const float* W; int K, ldw, col_off, ncols; bf16_t* WT; int ldt, row_off; const float* g; const float* mu; int mode; float cs; };
__device__ __forceinline__ void tr_item(const TrJob& J, int item, LAS float* scr, int lane) {
    const int nblk = (J.ncols + 31) / 32, kb = item / nblk, nb = item % nblk, k0 = 64 * kb, n0 = 32 * nb;
#pragma unroll 8
    for (int i = 0; i < 32; ++i) {
        const int kk = 2 * i + (lane >> 5), n = lane & 31, k = k0 + kk;
        float v = 0.f;
        if (k < J.K && n0 + n < J.ncols) {
            float s = J.cs;
            if (J.g) s *= J.g[k];
            if (J.mode == 1) s *= (1.0f - J.mu[k]); else if (J.mode == 2) s *= J.mu[k];
            v = J.W[(size_t)k * J.ldw + J.col_off + n0 + n] * s;
        }
        scr[kk * 33 + n] = v;
    }
    LDS_WAIT(); asm volatile("" ::: "memory");
    const int c = lane & 7;
#pragma unroll
    for (int j = 0; j < 4; ++j) {
        const int n = (lane >> 3) + 8 * j; const LAS float* s = scr + (8 * c) * 33 + n;
        u32x4 o; o.x = pk2(s[0 * 33], s[1 * 33]); o.y = pk2(s[2 * 33], s[3 * 33]); o.z = pk2(s[4 * 33], s[5 * 33]); o.w = pk2(s[6 * 33], s[7 * 33]);
        if (n0 + n < J.ncols && k0 + 8 * c < J.K) *(u32x4*)(J.WT + (size_t)(J.row_off + n0 + n) * J.ldt + k0 + 8 * c) = o;
    }
    LDS_WAIT(); asm volatile("" ::: "memory");
}
__device__ __forceinline__ void tr_job(Frame& F, const TrJob& J, int rot) {
    LAS float* scr = (LAS float*)(F.lds + F.wave * LDS_WSCR);
    const int nitems = ((J.K + 63) / 64) * ((J.ncols + 31) / 32);
    int start = F.gw - (rot % F.ngw); if (start < 0) start += F.ngw;
    for (int it = start; it < nitems; it += F.ngw) tr_item(J, it, scr, F.lane);
}
__device__ __forceinline__ void zero_rows(Frame& F, bf16_t* WT, int ld, int r0, int r1) {
    const size_t n16 = (size_t)(r1 - r0) * ld / 8; u32x4* p = (u32x4*)(WT + (size_t)r0 * ld);
    for (size_t i = (size_t)F.gw * 64 + F.lane; i < n16; i += (size_t)F.ngw * 64) p[i] = (u32x4){0u, 0u, 0u, 0u};
}
__device__ __forceinline__ void row_norm_to_bf16(const float* xrow, bf16_t* orow, int lane) {
    const f32x4* xr = (const f32x4*)xrow + lane; f32x4 v[4]; float s = 0.f;
#pragma unroll
    for (int j = 0; j < 4; ++j) { v[j] = xr[64 * j]; s += (v[j].x * v[j].x + v[j].y * v[j].y) + (v[j].z * v[j].z + v[j].w * v[j].w); }
    const float rstd = rsqrtf(wave_sum(s) * (1.f / DM) + RMS_EPS);
    u32x2* o8 = (u32x2*)orow + lane;
#pragma unroll
    for (int j = 0; j < 4; ++j) { u32x2 w; w.x = pk2(v[j].x * rstd, v[j].y * rstd); w.y = pk2(v[j].z * rstd, v[j].w * rstd); o8[64 * j] = w; }
}

__device__ __forceinline__ void ph_prologue(Frame& F, const Args& A) {
    PHASE_PIN(F);
    unsigned char* ws = F.ws; int rot = 0;
    for (int e = 0; e < 2; ++e) {
        bf16_t* WT = (bf16_t*)(ws + W_WIN) + (size_t)e * NCOL * DM;
        const float* g = F.ka->in[1] + e * DM; const float* mul = F.ka->in[5] + (size_t)e * 3 * DM;
        TrJob J{F.ka->in[2] + (size_t)e * DM * 2760, DM, 2760, 0, 2760, WT, DM, 0, g, nullptr, 0, 1.0f}; tr_job(F, J, rot); rot += 1392;
        zero_rows(F, WT, DM, 2760, C_PW);
        TrJob Jw1{F.ka->in[7] + (size_t)e * DM * 64, DM, 64, 0, 64, WT, DM, C_PW, g, mul, 1, 1.0f}; tr_job(F, Jw1, rot); rot += 32;
        TrJob Jw2{F.ka->in[7] + (size_t)e * DM * 64, DM, 64, 0, 64, WT, DM, C_QW, g, mul, 2, 1.0f}; tr_job(F, Jw2, rot); rot += 32;
        TrJob Ja1{F.ka->in[10] + (size_t)e * DM * 64, DM, 64, 0, 64, WT, DM, C_PA, g, mul + DM, 1, 1.0f}; tr_job(F, Ja1, rot); rot += 32;
        TrJob Ja2{F.ka->in[10] + (size_t)e * DM * 64, DM, 64, 0, 64, WT, DM, C_QA, g, mul + DM, 2, 1.0f}; tr_job(F, Ja2, rot); rot += 32;
        TrJob Jg1{F.ka->in[12] + (size_t)e * DM * 128, DM, 128, 0, 128, WT, DM, C_PG, g, mul + 2 * DM, 1, 1.0f}; tr_job(F, Jg1, rot); rot += 64;
        TrJob Jg2{F.ka->in[12] + (size_t)e * DM * 128, DM, 128, 0, 128, WT, DM, C_QG, g, mul + 2 * DM, 2, 1.0f}; tr_job(F, Jg2, rot); rot += 64;
        if (e == 1) {
            TrJob Jv1{F.ka->in[21], DM, 32, 0, 32, WT, DM, C_PV, g, F.ka->in[19], 1, 1.0f}; tr_job(F, Jv1, rot); rot += 16;
            TrJob Jv2{F.ka->in[21], DM, 32, 0, 32, WT, DM, C_QV, g, F.ka->in[19], 2, 1.0f}; tr_job(F, Jv2, rot); rot += 16;
            zero_rows(F, WT, DM, C_QV + 32, NCOL);
        } else zero_rows(F, WT, DM, C_PV, NCOL);
        TrJob Jo{F.ka->in[3] + (size_t)e * DM * DM, DM, DM, 0, DM, (bf16_t*)(ws + W_WOUTE) + (size_t)e * DM * DM, DM, 0, nullptr, nullptr, 0, 1.0f}; tr_job(F, Jo, rot); rot += 512;
        { bf16_t* L2W = (bf16_t*)(ws + W_L2) + (size_t)e * (288 * 512);
          TrJob Jl1{F.ka->in[8] + (size_t)e * 64 * 512, 64, 512, 0, 512, L2W, 64, 0, nullptr, nullptr, 0, 1.0f}; tr_job(F, Jl1, rot); rot += 16;
          TrJob Jl2{F.ka->in[11] + (size_t)e * 64 * 512, 64, 512, 0, 512, L2W + 64 * 512, 64, 0, nullptr, nullptr, 0, 1.0f}; tr_job(F, Jl2, rot); rot += 16;
          TrJob Jl3{F.ka->in[13] + (size_t)e * 128 * 512, 128, 512, 0, 512, L2W + 128 * 512, 128, 0, nullptr, nullptr, 0, 1.0f}; tr_job(F, Jl3, rot); rot += 32;
          if (e == 1) { TrJob Jl4{F.ka->in[22], 32, 512, 0, 512, L2W + 256 * 512, 32, 0, nullptr, nullptr, 0, 1.0f}; tr_job(F, Jl4, rot); rot += 16; } }
        { const float* Wkv = F.ka->in[24] + (size_t)e * 128 * 1024; bf16_t* WkB = (bf16_t*)(ws + W_WKB) + (size_t)e * 8 * 128 * 64;
          for (int i = F.gw * 64 + F.lane; i < 8 * 128 * 64; i += F.ngw * 64) { const int d = i & 63, r = (i >> 6) & 127, h = i >> 13; WkB[i] = (bf16_t)f2bf(Wkv[(size_t)r * 1024 + h * 64 + d]); } }
        TrJob Jv{F.ka->in[24] + (size_t)e * 128 * 1024, 128, 1024, 512, 512, (bf16_t*)(ws + W_WVT) + (size_t)e * 512 * 128, 128, 0, nullptr, nullptr, 0, 1.0f}; tr_job(F, Jv, rot); rot += 32;
    }
    for (int o = 0; o < 2; ++o) {
        const float* g = F.ka->in[26] + o * DM; bf16_t* WT = (bf16_t*)(ws + W_WQKV) + (size_t)o * 3072 * DM;
        TrJob Jq{F.ka->in[27] + (size_t)o * DM * 3072, DM, 3072, 0, 1024, WT, DM, 0, g, nullptr, 0, LOG2E * 0.125f}; tr_job(F, Jq, rot); rot += 512;
        TrJob Jk{F.ka->in[27] + (size_t)o * DM * 3072, DM, 3072, 1024, 2048, WT, DM, 1024, g, nullptr, 0, 1.0f}; tr_job(F, Jk, rot); rot += 1024;
        TrJob Jo{F.ka->in[28] + (size_t)o * DM * DM, DM, DM, 0, DM, (bf16_t*)(ws + W_WOUTO) + (size_t)o * DM * DM, DM, 0, nullptr, nullptr, 0, 1.0f}; tr_job(F, Jo, rot); rot += 512;
    }
    for (int m = F.gw; m < NT; m += F.ngw) row_norm_to_bf16(F.ka->in[0] + (size_t)m * DM, (bf16_t*)(ws + WS_XB) + (size_t)m * DM, F.lane);
}

__device__ __forceinline__ void moe_weight_prep(Frame& F, const Args& A, int l) {
    PHASE_PIN(F);
    LAS float* scr = (LAS float*)(F.lds + F.wave * LDS_WSCR);
    const float* g = F.ka->in[29] + l * DM;
    const float* w1 = F.ka->in[32] + (size_t)l * 32 * DM * 512; const float* w3 = F.ka->in[33] + (size_t)l * 32 * DM * 512; const float* w2 = F.ka->in[34] + (size_t)l * 32 * 512 * DM;
    bf16_t* W13T = (bf16_t*)(F.ws + WS_W13T); bf16_t* W2T = (bf16_t*)(F.ws + WS_W2T);
    for (int it = F.gw; it < 16384; it += F.ngw) {
        const int job = it >> 6, item = it & 63, which = job & 1, j = (job >> 1) & 3, e = job >> 3;
        TrJob J{(which ? w3 : w1) + (size_t)e * DM * 512, DM, 512, 128 * j, 128, W13T, DM, e * 1024 + 256 * j + 128 * which, g, nullptr, 0, 1.0f};
        tr_item(J, item, scr, F.lane);
    }
    for (int it = F.gw; it < 8192; it += F.ngw) {
        const int e = it >> 8, item = it & 255;
        TrJob J{w2 + (size_t)e * 512 * DM, 512, DM, 0, DM, W2T, 512, e * 1024, nullptr, nullptr, 0, 1.0f};
        tr_item(J, item, scr, F.lane);
    }
}

#define MFMA32(a, b, c) __builtin_amdgcn_mfma_f32_32x32x16_bf16((a), (b), (c), 0, 0, 0)
template <class Epi>
__device__ __forceinline__ void sg_tile(const bf16_t* A, int lda, const bf16_t* B0, const bf16_t* B1, int ldb, int K, int m0, const Epi& epi, int lane) {
    const int r = lane & 31, h = lane >> 5;
    const bf16_t* a0 = A + (size_t)(m0 + r) * lda + 8 * h; const bf16_t* a1 = a0 + (size_t)32 * lda;
    const bf16_t* b0 = B0 + (size_t)r * ldb + 8 * h; const bf16_t* b1 = B1 + (size_t)r * ldb + 8 * h;
    f32x16 c00, c01, c10, c11;
#pragma unroll
    for (int i = 0; i < 16; ++i) { c00[i] = 0.f; c01[i] = 0.f; c10[i] = 0.f; c11[i] = 0.f; }
#pragma unroll 4
    for (int k = 0; k < K; k += 16) {
        const bf16x8 fa0 = *(const bf16x8*)(a0 + k), fa1 = *(const bf16x8*)(a1 + k), fb0 = *(const bf16x8*)(b0 + k), fb1 = *(const bf16x8*)(b1 + k);
        c00 = MFMA32(fb0, fa0, c00); c01 = MFMA32(fb1, fa0, c01); c10 = MFMA32(fb0, fa1, c10); c11 = MFMA32(fb1, fa1, c11);
    }
#pragma unroll
    for (int g = 0; g < 4; ++g) {
        const int j = 8 * g + 4 * h;
        epi.pair(m0 + r, j, (f32x4){c00[4 * g], c00[4 * g + 1], c00[4 * g + 2], c00[4 * g + 3]}, (f32x4){c01[4 * g], c01[4 * g + 1], c01[4 * g + 2], c01[4 * g + 3]});
        epi.pair(m0 + 32 + r, j, (f32x4){c10[4 * g], c10[4 * g + 1], c10[4 * g + 2], c10[4 * g + 3]}, (f32x4){c11[4 * g], c11[4 * g + 1], c11[4 * g + 2], c11[4 * g + 3]});
    }
}
struct EpiStoreBf16 {
    bf16_t* O; int ldo, n0, n1;
    __device__ __forceinline__ void pair(int row, int j, f32x4 v0, f32x4 v1) const {
        u32x2 w; w.x = pk2(v0.x, v0.y); w.y = pk2(v0.z, v0.w); *(u32x2*)(O + (size_t)row * ldo + n0 + j) = w;
        w.x = pk2(v1.x, v1.y); w.y = pk2(v1.z, v1.w); *(u32x2*)(O + (size_t)row * ldo + n1 + j) = w;
    }
};
struct EpiResidF32 {
    const float* S; float* X; int n0, n1;
    __device__ __forceinline__ void pair(int row, int j, f32x4 v0, f32x4 v1) const {
        const size_t o0 = (size_t)row * DM + n0 + j, o1 = (size_t)row * DM + n1 + j;
        *(f32x4*)(X + o0) = *(const f32x4*)(S + o0) + v0; *(f32x4*)(X + o1) = *(const f32x4*)(S + o1) + v1;
    }
};
struct EpiGated {
    bf16_t* H; int hc;
    __device__ __forceinline__ void pair(int row, int j, f32x4 a, f32x4 b) const {
        f32x4 o;
#pragma unroll
        for (int i = 0; i < 4; ++i) o[i] = a[i] * sigmoidf_(a[i]) * b[i];
        u32x2 w; w.x = pk2(o.x, o.y); w.y = pk2(o.z, o.w); *(u32x2*)(H + (size_t)row * 512 + hc + j) = w;
    }
};
__device__ __forceinline__ void sg_dense_bf16(Frame& F, const bf16_t* A, int lda, const bf16_t* Bt, int K, int M, int N, bf16_t* O, int ldo) {
    PHASE_PIN(F);
    const int nN = N / 64, ntile = (M / 64) * nN;
    for (int t = F.gw; t < ntile; t += F.ngw) {
        const int mt = t / nN, nt = t % nN; EpiStoreBf16 E{O, ldo, nt * 64, nt * 64 + 32};
        sg_tile(A, lda, Bt + (size_t)(nt * 64) * K, Bt + (size_t)(nt * 64 + 32) * K, K, K, mt * 64, E, F.lane);
    }
}
__device__ __forceinline__ void sg_dense_resid(Frame& F, const bf16_t* A, const bf16_t* Bt, const float* S, float* X) {
    PHASE_PIN(F);
    const int nN = DM / 64, ntile = (NT / 64) * nN;
    for (int t = F.gw; t < ntile; t += F.ngw) {
        const int mt = t / nN, nt = t % nN; EpiResidF32 E{S, X, nt * 64, nt * 64 + 32};
        sg_tile(A, DM, Bt + (size_t)(nt * 64) * DM, Bt + (size_t)(nt * 64 + 32) * DM, DM, DM, mt * 64, E, F.lane);
    }
}

namespace pg8 {
#define PG8_LAS __attribute__((address_space(3)))
typedef unsigned short bf16_t;
typedef short bf16x8 __attribute__((ext_vector_type(8)));
typedef float f32x4 __attribute__((ext_vector_type(4)));
typedef unsigned u32x4 __attribute__((ext_vector_type(4)));
constexpr int BM = 256, BK = 64, HALF = 128, HTB = HALF * BK * 2  , STAGE_BYTES = 8 * HTB, NXCD = 8, WGM = 8;

__host__ __device__ __forceinline__ int lds_byte(int r, int c) { const int st = (r >> 4) * 2 + (c >> 5), rr = r & 15, cc = c & 31, ob = rr * 64 + cc * 2; return st * 1024 + (ob ^ (((ob >> 9) & 1) << 5)); }
__host__ __device__ __forceinline__ void stage_rc(int b, int& R, int& C) { const int st = b / 1024, sb = b % 1024, swz = sb ^ (((sb >> 9) & 1) << 5); R = (st >> 1) * 16 + swz / 64; C = (st & 1) * 32 + (swz % 64) / 2; }
__host__ __device__ __forceinline__ int perm32(int rho) { const int n = rho >> 4, i = rho & 15; return 8 * (i >> 2) + 4 * n + (i & 3); }

struct Unit { int pm, pn; };
struct Gemm { const bf16_t* A; const bf16_t* Bt; int M, N, K; };

struct StaticOrder {
    int nM, nN, nwg, G, c;
    __host__ __device__ void init(int M, int N, int G_, int c_) { nM = M / BM; nN = N / BM; nwg = nM * nN; G = G_; c = c_; }
    __host__ __device__ bool next(int i, Unit& u) const {
        const long L = (long)i * G + c; if (L >= nwg) return false;
        int wgid = (int)L; { const int q = nwg / NXCD, r = nwg % NXCD, xcd = wgid % NXCD, off = wgid / NXCD; wgid = (xcd < r ? xcd * (q + 1) : r * (q + 1) + (xcd - r) * q) + off; }
        const int nig = WGM * nN, gid = wgid / nig, fm = gid * WGM, gsz = (nM - fm) < WGM ? (nM - fm) : WGM;
        u.pm = fm + ((wgid % nig) % gsz); u.pn = (wgid % nig) / gsz; return true;
    }
    __device__ __forceinline__ void a_ready(const Unit&) const {}
    __device__ __forceinline__ void done(const Unit&) const {}
};

__device__ __forceinline__ unsigned cvt_pk_bf16(float lo, float hi) { unsigned r; asm volatile("v_cvt_pk_bf16_f32 %0, %1, %2" : "=v"(r) : "v"(lo), "v"(hi)); return r; }
struct EpiBf16S {
    static constexpr bool PERM = true, AFTER_DRAIN = false;
    bf16_t* O; int ldc; int split_cols; size_t split_stride;
    __device__ __forceinline__ void operator()(const f32x4 (&acc)[2][2][4][2], const Unit& u, int wr, int wc, int fr, int fq) const {
        const int row0 = u.pm * BM + wr * 64 + fr; int colt = u.pn * BM; bf16_t* base = O;
        if (split_cols) { const int t = colt / split_cols; base += (size_t)t * split_stride; colt -= t * split_cols; }
        const int col0 = colt + wc * 32 + 8 * fq;
#pragma unroll
        for (int ai = 0; ai < 2; ++ai)
#pragma unroll
            for (int m = 0; m < 4; ++m) { bf16_t* rowp = base + (size_t)(row0 + ai * HALF + m * 16) * ldc + col0;
#pragma unroll
                for (int bj = 0; bj < 2; ++bj) { const f32x4 v0 = acc[ai][bj][m][0], v1 = acc[ai][bj][m][1];
                    u32x4 w; w.x = cvt_pk_bf16(v0[0], v0[1]); w.y = cvt_pk_bf16(v0[2], v0[3]); w.z = cvt_pk_bf16(v1[0], v1[1]); w.w = cvt_pk_bf16(v1[2], v1[3]);
                    *(u32x4*)(rowp + bj * HALF) = w; } }
    }
};
struct EpiResid {
    static constexpr bool PERM = false, AFTER_DRAIN = false;
    const float* S; float* X;
    __device__ __forceinline__ void operator()(const f32x4 (&acc)[2][2][4][2], const Unit& u, int wr, int wc, int fr, int fq) const {
        const int row0 = u.pm * BM + wr * 64 + fr, col0 = u.pn * BM + wc * 32 + 4 * fq;
#pragma unroll
        for (int ai = 0; ai < 2; ++ai)
#pragma unroll
            for (int m = 0; m < 4; ++m) { const size_t off = (size_t)(row0 + ai * HALF + m * 16) * 1024 + col0;
#pragma unroll
                for (int bj = 0; bj < 2; ++bj)
#pragma unroll
                    for (int n = 0; n < 2; ++n) *(f32x4*)(X + off + bj * HALF + n * 16) = *(const f32x4*)(S + off + bj * HALF + n * 16) + acc[ai][bj][m][n]; }
    }
};
struct EpiGate {
    static constexpr bool PERM = true, AFTER_DRAIN = false;
    bf16_t* H;
    __device__ __forceinline__ void operator()(const f32x4 (&acc)[2][2][4][2], const Unit& u, int wr, int wc, int fr, int fq) const {
        const int row0 = u.pm * BM + wr * 64 + fr, col0 = (u.pn & 3) * 128 + wc * 32 + 8 * fq;
#pragma unroll
        for (int ai = 0; ai < 2; ++ai)
#pragma unroll
            for (int m = 0; m < 4; ++m) { float o[8];
#pragma unroll
                for (int n = 0; n < 2; ++n)
#pragma unroll
                    for (int i = 0; i < 4; ++i) { const float a = acc[ai][0][m][n][i], b = acc[ai][1][m][n][i]; o[4 * n + i] = a * b * __builtin_amdgcn_rcpf(1.0f + __builtin_amdgcn_exp2f(-1.4426950408889634f * a)); }
                u32x4 w; w.x = cvt_pk_bf16(o[0], o[1]); w.y = cvt_pk_bf16(o[2], o[3]); w.z = cvt_pk_bf16(o[4], o[5]); w.w = cvt_pk_bf16(o[6], o[7]);
                *(u32x4*)(H + (size_t)(row0 + ai * HALF + m * 16) * 512 + col0) = w; }
    }
};
struct EpiMoeDown {
    static constexpr bool PERM = true, AFTER_DRAIN = false;
    bf16_t* Y;
    __device__ __forceinline__ void operator()(const f32x4 (&acc)[2][2][4][2], const Unit& u, int wr, int wc, int fr, int fq) const {
        const int row0 = u.pm * BM + wr * 64 + fr, col0 = (u.pn & 3) * BM + wc * 32 + 8 * fq;
#pragma unroll
        for (int ai = 0; ai < 2; ++ai)
#pragma unroll
            for (int m = 0; m < 4; ++m) { bf16_t* rowp = Y + (size_t)(row0 + ai * HALF + m * 16) * 1024 + col0;
#pragma unroll
                for (int bj = 0; bj < 2; ++bj) { const f32x4 v0 = acc[ai][bj][m][0], v1 = acc[ai][bj][m][1];
                    u32x4 w; w.x = cvt_pk_bf16(v0[0], v0[1]); w.y = cvt_pk_bf16(v0[2], v0[3]); w.z = cvt_pk_bf16(v1[0], v1[1]); w.w = cvt_pk_bf16(v1[2], v1[3]);
                    *(u32x4*)(rowp + bj * HALF) = w; } }
    }
};
struct MoeOrder {
    int nunits, G, c; const PG8_LAS int* tab;
    __device__ __forceinline__ bool next(int i, Unit& u) const {
        const int L = i * G + c; if (L >= nunits) return false;
        const int rt = L >> 2; u.pm = rt; u.pn = __builtin_amdgcn_readfirstlane(tab[rt]) * 4 + (L & 3); return true;
    }
    __device__ __forceinline__ void a_ready(const Unit&) const {}
    __device__ __forceinline__ void done(const Unit&) const {}
};
template <class Epi, class Sched, bool STAMP = false>
__device__ __forceinline__ void gemm_phase(PG8_LAS unsigned char* lds, const Gemm g, const Sched& S, const Epi& E, unsigned long long* stamps, const int wid_in) {
    int ln_; asm volatile("v_mbcnt_lo_u32_b32 %0, -1, 0\n\tv_mbcnt_hi_u32_b32 %0, -1, %0" : "=v"(ln_)); const int tid = wid_in * 64 + ln_, wid = wid_in, lane = tid & 63, wr = wid >> 2, wc = wid & 3, fr = lane & 15, fq = lane >> 4;
    const int K = g.K, nt = K / BK;
    int ts_lo = 0, ts_hi = 0, nts = 0; const unsigned long long rt_entry = STAMP ? (unsigned long long)wall_clock64() : 0ull;
#define PG8_STAMP() do { if (STAMP && wid == 0 && nts < 64) { const unsigned long long _c = (unsigned long long)clock64(); \
        ts_lo = (lane == nts) ? (int)(unsigned)_c : ts_lo; ts_hi = (lane == nts) ? (int)(unsigned)(_c >> 32) : ts_hi; ++nts; } } while (0)
    PG8_STAMP();
    unsigned voffA[2], voffB[2];
#pragma unroll
    for (int i = 0; i < 2; ++i) { int R, C; stage_rc(tid * 16 + i * 8192, R, C); const int Rb = Epi::PERM ? ((R & ~31) + perm32(R & 31)) : R;
        voffA[i] = (unsigned)(R * K + C) * 2u; voffB[i] = (unsigned)(Rb * K + C) * 2u; }
    const size_t kstep = (size_t)(BK * 2);
    const size_t hstep = (size_t)HALF * K * 2;
    const size_t tstep = 2 * hstep;
    const unsigned ldsw = (unsigned)wid * 1024u;
    const int aoff = lds_byte(wr * 64 + fr, fq * 8), boff = lds_byte(wc * 32 + fr, fq * 8);
#define PG8_SA(b, h) (((b) * 2 + (h)) * HTB)
#define PG8_SB(b, h) ((4 + (b) * 2 + (h)) * HTB)
#define PG8_STAGE(bufoff, gbase, voff) do { _Pragma("unroll") for (int _i = 0; _i < 2; ++_i) \
        __builtin_amdgcn_global_load_lds((const unsigned*)((const char*)(gbase) + (voff)[_i]), (PG8_LAS unsigned*)(lds + (bufoff) + ldsw + _i * 8192), 16, 0, 0); } while (0)
#define PG8_LDA(dst, b, h) do { _Pragma("unroll") for (int m = 0; m < 4; ++m) _Pragma("unroll") for (int k = 0; k < 2; ++k) dst[m][k] = *(const PG8_LAS bf16x8*)(lds + PG8_SA(b, h) + aoff + m * 2048 + k * 1024); } while (0)
#define PG8_LDB(dst, b, h) do { _Pragma("unroll") for (int n = 0; n < 2; ++n) _Pragma("unroll") for (int k = 0; k < 2; ++k) dst[n][k] = *(const PG8_LAS bf16x8*)(lds + PG8_SB(b, h) + boff + n * 2048 + k * 1024); } while (0)
#define PG8_MMA(ai, bj, At, Bt) do { __builtin_amdgcn_s_setprio(1); _Pragma("unroll") for (int m = 0; m < 4; ++m) _Pragma("unroll") for (int n = 0; n < 2; ++n) _Pragma("unroll") for (int k = 0; k < 2; ++k) \
        acc[ai][bj][m][n] = __builtin_amdgcn_mfma_f32_16x16x32_bf16(Bt[n][k], At[m][k], acc[ai][bj][m][n], 0, 0, 0); __builtin_amdgcn_s_setprio(0); } while (0)
#define PG8_WAIT_V(n) asm volatile("s_waitcnt vmcnt(" #n ")" ::: "memory")
#define PG8_WAIT_L(n) asm volatile("s_waitcnt lgkmcnt(" #n ")" ::: "memory")
#define PG8_BAR __builtin_amdgcn_s_barrier()
#define PG8_SCHED __builtin_amdgcn_sched_barrier(0)
    Unit cur, nxt; int ui = 0;
    if (!S.next(0, cur)) return;
    f32x4 acc[2][2][4][2];
#pragma unroll
    for (int a = 0; a < 2; ++a)
#pragma unroll
        for (int b = 0; b < 2; ++b)
#pragma unroll
            for (int m = 0; m < 4; ++m)
#pragma unroll
                for (int n = 0; n < 2; ++n) acc[a][b][m][n] = (f32x4){0.f, 0.f, 0.f, 0.f};
    bf16x8 At[4][2], B0[2][2], B1[2][2];
    const char* cA = (const char*)g.A + (size_t)cur.pm * tstep; const char* cB = (const char*)g.Bt + (size_t)cur.pn * tstep;
    S.a_ready(cur);
    PG8_STAGE(PG8_SB(0, 0), cB, voffB); PG8_STAGE(PG8_SA(0, 0), cA, voffA); PG8_STAGE(PG8_SB(0, 1), cB + hstep, voffB); PG8_STAGE(PG8_SA(0, 1), cA + hstep, voffA);
    if (wr == 1) PG8_BAR;
    PG8_WAIT_V(4); PG8_BAR;
    PG8_STAGE(PG8_SB(1, 0), cB + kstep, voffB); PG8_STAGE(PG8_SA(1, 0), cA + kstep, voffA); PG8_STAGE(PG8_SB(1, 1), cB + hstep + kstep, voffB);
    PG8_WAIT_V(6); PG8_BAR;
    PG8_STAMP();
    for (;;) {
        const bool has_next = S.next(ui + 1, nxt);
        const char* nA = has_next ? (const char*)g.A + (size_t)nxt.pm * tstep : cA; const char* nB = has_next ? (const char*)g.Bt + (size_t)nxt.pn * tstep : cB;
        for (int t = 0; t < nt; t += 2) {
            const bool last = (t == nt - 2);
            const char* a1 = cA + (size_t)(t + 1) * kstep;
            const char* a2 = last ? nA : cA + (size_t)(t + 2) * kstep; const char* b2 = last ? nB : cB + (size_t)(t + 2) * kstep;
            const char* a3 = a2 + kstep; const char* b3 = b2 + kstep;
            if (last && has_next) S.a_ready(nxt);
            PG8_LDB(B0, 0, 0); PG8_SCHED; PG8_LDA(At, 0, 0); PG8_STAGE(PG8_SA(1, 1), a1 + hstep, voffA);
            PG8_WAIT_L(8); PG8_BAR; PG8_WAIT_L(0); PG8_MMA(0, 0, At, B0); PG8_BAR; PG8_SCHED;
            PG8_LDB(B1, 0, 1); PG8_STAGE(PG8_SB(0, 0), b2, voffB);
            PG8_BAR; PG8_WAIT_L(0); PG8_MMA(0, 1, At, B1); PG8_BAR;
            PG8_LDA(At, 0, 1); PG8_STAGE(PG8_SA(0, 0), a2, voffA);
            PG8_BAR; PG8_WAIT_L(0); PG8_MMA(1, 0, At, B0); PG8_BAR; PG8_SCHED;
            PG8_STAGE(PG8_SB(0, 1), b2 + hstep, voffB);
            PG8_WAIT_V(6); PG8_BAR; PG8_MMA(1, 1, At, B1); PG8_BAR;
            PG8_LDB(B0, 1, 0); PG8_SCHED; PG8_LDA(At, 1, 0); PG8_STAGE(PG8_SA(0, 1), a2 + hstep, voffA);
            PG8_WAIT_L(8); PG8_BAR; PG8_WAIT_L(0); PG8_MMA(0, 0, At, B0); PG8_BAR; PG8_SCHED;
            PG8_LDB(B1, 1, 1); PG8_STAGE(PG8_SB(1, 0), b3, voffB);
            PG8_BAR; PG8_WAIT_L(0); PG8_MMA(0, 1, At, B1); PG8_BAR;
            PG8_LDA(At, 1, 1); PG8_STAGE(PG8_SA(1, 0), a3, voffA);
            PG8_BAR; PG8_WAIT_L(0); PG8_MMA(1, 0, At, B0); PG8_BAR; PG8_SCHED;
            PG8_STAGE(PG8_SB(1, 1), b3 + hstep, voffB);
            PG8_WAIT_V(6); PG8_BAR; PG8_MMA(1, 1, At, B1); PG8_BAR;
        }
        PG8_STAMP();
        if constexpr (!Epi::AFTER_DRAIN) { E(acc, cur, wr, wc, fr, fq); S.done(cur); }
        PG8_STAMP();
        if (!has_next) break;
#pragma unroll
        for (int a = 0; a < 2; ++a)
#pragma unroll
            for (int b = 0; b < 2; ++b)
#pragma unroll
                for (int m = 0; m < 4; ++m)
#pragma unroll
                    for (int n = 0; n < 2; ++n) acc[a][b][m][n] = (f32x4){0.f, 0.f, 0.f, 0.f};
        cur = nxt; cA = nA; cB = nB; ++ui;
    }
    PG8_WAIT_V(0);
    if (wr == 0) PG8_BAR;
    PG8_BAR;
    if constexpr (Epi::AFTER_DRAIN) { E.fused(acc, cur, wr, wc, fr, fq, lds, wid, lane); S.done(cur); }
    PG8_STAMP();
    if (STAMP && wid == 0) { stamps[lane] = lane < nts ? (((unsigned long long)(unsigned)ts_hi << 32) | (unsigned)ts_lo) : 0ull;
        if (lane == 62) stamps[62] = rt_entry; if (lane == 63) stamps[63] = (unsigned long long)wall_clock64(); }
#undef PG8_STAMP
#undef PG8_SA
#undef PG8_SB
#undef PG8_STAGE
#undef PG8_LDA
#undef PG8_LDB
#undef PG8_MMA
#undef PG8_WAIT_V
#undef PG8_WAIT_L
#undef PG8_BAR
#undef PG8_SCHED
}
}

__device__ __forceinline__ f32x4 ld_bf4(const bf16_t* p) { const u32x2 w = *(const u32x2*)p; return (f32x4){__uint_as_float(w.x << 16), __uint_as_float(w.x & 0xffff0000u), __uint_as_float(w.y << 16), __uint_as_float(w.y & 0xffff0000u)}; }
__device__ __forceinline__ float fast_sigmoid(float x) { return __builtin_amdgcn_rcpf(1.0f + __builtin_amdgcn_exp2f(-LOG2E * x)); }
__device__ __forceinline__ float fast_tanh(float x) { return 1.0f - 2.0f * __builtin_amdgcn_rcpf(1.0f + __builtin_amdgcn_exp2f(2.0f * LOG2E * x)); }
__device__ __forceinline__ void ld_pq8(const bf16_t* p, const bf16_t* q, bool hp, float (&o)[8]) {
    const u32x4 a = *(const u32x4*)p; u32x4 b = (u32x4){0u, 0u, 0u, 0u}; if (hp) b = *(const u32x4*)q;
    o[0] = __uint_as_float(a.x << 16) + __uint_as_float(b.x << 16); o[1] = __uint_as_float(a.x & 0xffff0000u) + __uint_as_float(b.x & 0xffff0000u);
    o[2] = __uint_as_float(a.y << 16) + __uint_as_float(b.y << 16); o[3] = __uint_as_float(a.y & 0xffff0000u) + __uint_as_float(b.y & 0xffff0000u);
    o[4] = __uint_as_float(a.z << 16) + __uint_as_float(b.z << 16); o[5] = __uint_as_float(a.z & 0xffff0000u) + __uint_as_float(b.z & 0xffff0000u);
    o[6] = __uint_as_float(a.w << 16) + __uint_as_float(b.w << 16); o[7] = __uint_as_float(a.w & 0xffff0000u) + __uint_as_float(b.w & 0xffff0000u);
}
__device__ __forceinline__ bf16x8 pack8(const float (&o)[8]) { u32x4 w; w.x = pk2(o[0], o[1]); w.y = pk2(o[2], o[3]); w.z = pk2(o[4], o[5]); w.w = pk2(o[6], o[7]); return __builtin_bit_cast(bf16x8, w); }
__device__ __forceinline__ void ph_prep(Frame& F, const Args& A, int e) {
    PHASE_PIN(F);
    unsigned char* ws = F.ws; const int lane = F.lane;
    const bf16_t* proj = (const bf16_t*)(ws + WS_PROJ);
    const float* mu_rkv = F.ka->in[4] + (size_t)e * 3 * 512;
    const float* w0 = F.ka->in[6] + e * 512; const float* a0 = F.ka->in[9] + e * 512;
    const float* k_k = F.ka->in[14] + e * 512; const float* k_a = F.ka->in[15] + e * 512; const float* r_k = F.ka->in[16] + e * 512;
    const float* v0 = F.ka->in[20];
    const float* kvn = F.ka->in[23] + e * 128; const float* ikn = F.ka->in[25] + e * 64;
    float* SIN = (float*)(ws + WS_SIN); float* VF = (float*)(ws + WS_VF); float* GATE = (float*)(ws + WS_GATE); float* BON = (float*)(ws + SM_BONUS);
    unsigned* SGN = (unsigned*)(ws + SM_SGN);
    bf16_t* CN = (bf16_t*)(ws + WS_CN); bf16_t* KI = (bf16_t*)(ws + WS_KI); bf16_t* QI = (bf16_t*)(ws + WS_QI);
    for (int m = F.gw; m < NT; m += F.ngw) {
        const bf16_t* pr = proj + (size_t)m * NCOL;
        const float c0 = bf2f(pr[C_CKV + lane]), c1 = bf2f(pr[C_CKV + 64 + lane]);
        const float rs = rsqrtf(wave_sum(c0 * c0 + c1 * c1) * (1.f / 128.f) + RMS_EPS);
        CN[(size_t)m * 128 + lane] = (bf16_t)f2bf(c0 * rs * kvn[lane]); CN[(size_t)m * 128 + 64 + lane] = (bf16_t)f2bf(c1 * rs * kvn[64 + lane]);
        const float ki = bf2f(pr[C_KI + lane]); const float rs2 = rsqrtf(wave_sum(ki * ki) * (1.f / 64.f) + RMS_EPS);
        KI[(size_t)m * 64 + lane] = (bf16_t)f2bf(ki * rs2 * ikn[lane]);
        unsigned sg = 0;
#pragma unroll
        for (int hh = 0; hh < 8; ++hh) { const float w = bf2f(pr[C_WI + hh]); if (w < 0.f) sg |= 1u << hh;
            QI[(size_t)m * 512 + hh * 64 + lane] = (bf16_t)f2bf(fabsf(w) * bf2f(pr[C_QI + hh * 64 + lane])); }
        if (lane == 0) SGN[m] = sg;
    }
    { const int r = lane & 31, hf = lane >> 5;
      const bf16_t* L2W = (const bf16_t*)(ws + W_L2) + (size_t)e * (288 * 512);
      const bf16_t* w2T = L2W; const bf16_t* a2T = L2W + 64 * 512; const bf16_t* g2T = L2W + 128 * 512; const bf16_t* v2T = L2W + 256 * 512;
      for (int it = F.gw; it < 512 * 8; it += F.ngw) {
        const int hh = it & 7, tile = it >> 3, m = tile * 32 + r, t = m & (TT - 1), b = m >> 13; const bool hp = t > 0;
        const bf16_t* pr = proj + (size_t)m * NCOL; const bf16_t* pp = pr - NCOL;
        float ss = 0.f, bon = 0.f;
        float* so = SIN + ((size_t)(b * 8 + hh) * TT + t) * 384;
#pragma unroll
        for (int sub = 0; sub < 2; ++sub)
#pragma unroll
            for (int g = 0; g < 4; ++g) { const int ch4 = hh * 64 + sub * 32 + 8 * g + 4 * hf;
                const f32x4 kk0 = ld_bf4(pr + C_K + ch4); f32x4 kp = (f32x4){0.f, 0.f, 0.f, 0.f}; if (hp) kp = ld_bf4(pp + C_K + ch4);
                const f32x4 mk = *(const f32x4*)(mu_rkv + 512 + ch4), kk4 = *(const f32x4*)(k_k + ch4);
#pragma unroll
                for (int j = 0; j < 4; ++j) { const float kx = (kk0[j] + (kp[j] - kk0[j]) * mk[j]) * kk4[j]; ss += kx * kx; } }
        ss += __shfl_xor(ss, 32);
        const float rn = rsqrtf(fmaxf(ss, 1e-12f));
#pragma unroll 1
        for (int sub = 0; sub < 2; ++sub) {
            const int cb = hh * 64 + sub * 32;
            f32x16 acc;
#pragma unroll
            for (int i = 0; i < 16; ++i) acc[i] = 0.f;
#pragma unroll
            for (int ks = 0; ks < 4; ++ks) { float o[8]; ld_pq8(pr + C_PW + 16 * ks + 8 * hf, pp + C_QW + 16 * ks + 8 * hf, hp, o);
#pragma unroll
                for (int j = 0; j < 8; ++j) o[j] = fast_tanh(o[j]);
                acc = MFMA32(*(const bf16x8*)(w2T + (size_t)(cb + r) * 64 + 16 * ks + 8 * hf), pack8(o), acc); }
#pragma unroll
            for (int g = 0; g < 4; ++g) { const int ch4 = cb + 8 * g + 4 * hf; const f32x4 b0 = *(const f32x4*)(w0 + ch4); f32x4 d;
#pragma unroll
                for (int j = 0; j < 4; ++j) d[j] = __builtin_amdgcn_exp2f(-0.6065306597126334f * LOG2E * fast_sigmoid(b0[j] + acc[4 * g + j]));
                *(f32x4*)(so + 64 + sub * 32 + 8 * g + 4 * hf) = d; }
            float icv[16];
#pragma unroll
            for (int i = 0; i < 16; ++i) acc[i] = 0.f;
#pragma unroll
            for (int ks = 0; ks < 4; ++ks) { float o[8]; ld_pq8(pr + C_PA + 16 * ks + 8 * hf, pp + C_QA + 16 * ks + 8 * hf, hp, o);
                acc = MFMA32(*(const bf16x8*)(a2T + (size_t)(cb + r) * 64 + 16 * ks + 8 * hf), pack8(o), acc); }
#pragma unroll
            for (int g = 0; g < 4; ++g) { const int ch4 = cb + 8 * g + 4 * hf; const f32x4 b0 = *(const f32x4*)(a0 + ch4);
#pragma unroll
                for (int j = 0; j < 4; ++j) icv[4 * g + j] = fast_sigmoid(b0[j] + acc[4 * g + j]); }
#pragma unroll
            for (int i = 0; i < 16; ++i) acc[i] = 0.f;
#pragma unroll
            for (int ks = 0; ks < 8; ++ks) { float o[8]; ld_pq8(pr + C_PG + 16 * ks + 8 * hf, pp + C_QG + 16 * ks + 8 * hf, hp, o);
#pragma unroll
                for (int j = 0; j < 8; ++j) o[j] = fast_sigmoid(o[j]);
                acc = MFMA32(*(const bf16x8*)(g2T + (size_t)(cb + r) * 128 + 16 * ks + 8 * hf), pack8(o), acc); }
#pragma unroll
            for (int g = 0; g < 4; ++g) *(f32x4*)(GATE + (size_t)m * 512 + cb + 8 * g + 4 * hf) = (f32x4){acc[4 * g], acc[4 * g + 1], acc[4 * g + 2], acc[4 * g + 3]};
            if (e == 1) {
#pragma unroll
                for (int i = 0; i < 16; ++i) acc[i] = 0.f;
#pragma unroll
                for (int ks = 0; ks < 2; ++ks) { float o[8]; ld_pq8(pr + C_PV + 16 * ks + 8 * hf, pp + C_QV + 16 * ks + 8 * hf, hp, o);
                    acc = MFMA32(*(const bf16x8*)(v2T + (size_t)(cb + r) * 32 + 16 * ks + 8 * hf), pack8(o), acc); }
            }
#pragma unroll
            for (int g = 0; g < 4; ++g) {
                const int ch4 = cb + 8 * g + 4 * hf;
                const f32x4 rr = ld_bf4(pr + C_R + ch4), kk0 = ld_bf4(pr + C_K + ch4), vv = ld_bf4(pr + C_V + ch4);
                f32x4 rp = (f32x4){0.f, 0.f, 0.f, 0.f}, kp = rp, vp = rp;
                if (hp) { rp = ld_bf4(pp + C_R + ch4); kp = ld_bf4(pp + C_K + ch4); vp = ld_bf4(pp + C_V + ch4); }
                const f32x4 mr = *(const f32x4*)(mu_rkv + ch4), mk = *(const f32x4*)(mu_rkv + 512 + ch4), mv = *(const f32x4*)(mu_rkv + 1024 + ch4);
                const f32x4 kk4 = *(const f32x4*)(k_k + ch4), ka4 = *(const f32x4*)(k_a + ch4), rk4 = *(const f32x4*)(r_k + ch4);
                const f32x4 r1 = rr + (rp - rr) * mr, k1 = kk0 + (kp - kk0) * mk; f32x4 v1 = vv + (vp - vv) * mv;
                if (e == 1) { const f32x4 vb = *(const f32x4*)(v0 + ch4), vf = *(const f32x4*)(VF + (size_t)m * 512 + ch4);
#pragma unroll
                    for (int j = 0; j < 4; ++j) v1[j] = v1[j] + (vf[j] - v1[j]) * fast_sigmoid(vb[j] + acc[4 * g + j]); }
                else *(f32x4*)(VF + (size_t)m * 512 + ch4) = v1;
                f32x4 km, kn, bb;
#pragma unroll
                for (int j = 0; j < 4; ++j) { kn[j] = k1[j] * kk4[j] * rn; bb[j] = icv[4 * g + j] * kn[j];
                    km[j] = k1[j] * (1.0f + (icv[4 * g + j] - 1.0f) * ka4[j]); bon += r1[j] * km[j] * rk4[j]; }
                *(f32x4*)(so + sub * 32 + 8 * g + 4 * hf) = r1; *(f32x4*)(so + 128 + sub * 32 + 8 * g + 4 * hf) = km; *(f32x4*)(so + 320 + sub * 32 + 8 * g + 4 * hf) = v1;
                *(f32x4*)(so + 192 + sub * 32 + 8 * g + 4 * hf) = kn; *(f32x4*)(so + 256 + sub * 32 + 8 * g + 4 * hf) = bb;
                asm volatile("" ::: "memory");
            }
        }
        bon += __shfl_xor(bon, 32);
        if (hf == 0) BON[m * 8 + hh] = bon;
      } }
    { bf16_t* QA = (bf16_t*)(ws + WS_QA); const bf16_t* WkB = (const bf16_t*)(ws + W_WKB) + (size_t)e * 8 * 128 * 64;
      const int ntile = (NT / 64) * 2 * 8;
      for (int tI = F.gw; tI < ntile; tI += F.ngw) {
          const int hh = tI & 7, nt = (tI >> 3) & 1, mt = tI >> 4;
          EpiStoreBf16 E{QA + hh * 128, 1024, nt * 64, nt * 64 + 32};
          sg_tile(proj + C_QB + hh * 64, NCOL, WkB + (size_t)hh * 128 * 64 + (size_t)(nt * 64) * 64, WkB + (size_t)hh * 128 * 64 + (size_t)(nt * 64 + 32) * 64, 64, 64, mt * 64, E, F.lane);
      } }
}

__device__ __forceinline__ float allred16(float x) {
    x += __builtin_bit_cast(float, __builtin_amdgcn_update_dpp(0, __builtin_bit_cast(int, x), 0x128, 0xf, 0xf, false));
    x += __builtin_bit_cast(float, __builtin_amdgcn_update_dpp(0, __builtin_bit_cast(int, x), 0x124, 0xf, 0xf, false));
    x += __builtin_bit_cast(float, __builtin_amdgcn_update_dpp(0, __builtin_bit_cast(int, x), 0x122, 0xf, 0xf, false));
    x += __builtin_bit_cast(float, __builtin_amdgcn_update_dpp(0, __builtin_bit_cast(int, x), 0x121, 0xf, 0xf, false));
    return x;
}
__device__ __forceinline__ void ph_scan(Frame& F) {
    PHASE_PIN(F);
    if (F.wave != 0) return;
    const int lane = F.lane, i = lane >> 4, kq = lane & 15;
    for (int task = blockIdx.x; task < 256; task += gridDim.x) {
        const int bh = task >> 4, rg = task & 15, row = 4 * rg + i, b = bh >> 3, hh = bh & 7;
        const float* sin = (const float*)(F.ws + WS_SIN) + (size_t)bh * TT * 384;
        float* Y = (float*)(F.ws + WS_Y) + (size_t)b * TT * 512 + hh * 64 + row;
        f32x4 R[8], W[8], K[8], KK[8], B[8]; float V[8];
#pragma unroll
        for (int j = 0; j < 8; ++j) { const float* p = sin + (size_t)j * 384; R[j] = *(const f32x4*)(p + 4 * kq); W[j] = *(const f32x4*)(p + 64 + 4 * kq); K[j] = *(const f32x4*)(p + 128 + 4 * kq);
            KK[j] = *(const f32x4*)(p + 192 + 4 * kq); B[j] = *(const f32x4*)(p + 256 + 4 * kq); V[j] = p[320 + row]; }
        float s0 = 0.f, s1 = 0.f, s2 = 0.f, s3 = 0.f;
        for (int t0 = 0; t0 < TT; t0 += 8) {
#pragma unroll
            for (int j = 0; j < 8; ++j) {
                float p = s0 * KK[j].x + s1 * KK[j].y + s2 * KK[j].z + s3 * KK[j].w; p = allred16(p);
                s0 = s0 * W[j].x - p * B[j].x + V[j] * K[j].x; s1 = s1 * W[j].y - p * B[j].y + V[j] * K[j].y;
                s2 = s2 * W[j].z - p * B[j].z + V[j] * K[j].z; s3 = s3 * W[j].w - p * B[j].w + V[j] * K[j].w;
                float y = s0 * R[j].x + s1 * R[j].y + s2 * R[j].z + s3 * R[j].w; y = allred16(y);
                if (kq == 0) Y[(size_t)(t0 + j) * 512] = y;
                if (t0 + j + 8 < TT) { const float* p2 = sin + (size_t)(t0 + j + 8) * 384; R[j] = *(const f32x4*)(p2 + 4 * kq); W[j] = *(const f32x4*)(p2 + 64 + 4 * kq); K[j] = *(const f32x4*)(p2 + 128 + 4 * kq);
                    KK[j] = *(const f32x4*)(p2 + 192 + 4 * kq); B[j] = *(const f32x4*)(p2 + 256 + 4 * kq); V[j] = p2[320 + row]; }
            }
        }
    }
}

constexpr size_t S1_TMP_STRIDE = 131072, S1_OUT_STRIDE = 50176;
constexpr int T_TCK = 0, T_TCB = 8192, T_TCKT = 16384, T_TCR = 24576, T_CTB = 32768, T_CTK = 40960, T_CTV = 49152, T_MAK = 57344, T_AAB = 65536, T_AAK = 73728, T_CTKH = 81920, T_CTU = 90112, T_RHSF = 98304;
constexpr int O_PT = 0, O_RH = 8192, O_G = 16384, O_Y0 = 32768, O_GC = 49152;
static_assert(WS_PROJ + 2048 * S1_OUT_STRIDE <= WS_SIN && WS_BIG + 2048 * S1_TMP_STRIDE <= WS_END, "scan map");
#define STAGE_SYNC() asm volatile("s_waitcnt vmcnt(0) lgkmcnt(0)" ::: "memory")
template <bool TWO>
__device__ __forceinline__ void mm64_acc(const bf16_t* A1, const bf16_t* B1, const bf16_t* A2, const bf16_t* B2, f32x16& c00, f32x16& c01, f32x16& c10, f32x16& c11, int lane) {
    const int r = lane & 31, h = lane >> 5; const int o = r * 64 + 8 * h;
#pragma unroll
    for (int i = 0; i < 16; ++i) { c00[i] = 0.f; c01[i] = 0.f; c10[i] = 0.f; c11[i] = 0.f; }
#pragma unroll
    for (int k = 0; k < 64; k += 16) {
        const bf16x8 fa0 = *(const bf16x8*)(A1 + o + k), fa1 = *(const bf16x8*)(A1 + o + 2048 + k), fb0 = *(const bf16x8*)(B1 + o + k), fb1 = *(const bf16x8*)(B1 + o + 2048 + k);
        c00 = MFMA32(fb0, fa0, c00); c01 = MFMA32(fb1, fa0, c01); c10 = MFMA32(fb0, fa1, c10); c11 = MFMA32(fb1, fa1, c11);
    }
    if (TWO) {
#pragma unroll
        for (int k = 0; k < 64; k += 16) {
            const bf16x8 fa0 = *(const bf16x8*)(A2 + o + k), fa1 = *(const bf16x8*)(A2 + o + 2048 + k), fb0 = *(const bf16x8*)(B2 + o + k), fb1 = *(const bf16x8*)(B2 + o + 2048 + k);
            c00 = MFMA32(fb0, fa0, c00); c01 = MFMA32(fb1, fa0, c01); c10 = MFMA32(fb0, fa1, c10); c11 = MFMA32(fb1, fa1, c11);
        }
    }
}
template <class Epi>
__device__ __forceinline__ void mm64_epi(const Epi& epi, const f32x16& c00, const f32x16& c01, const f32x16& c10, const f32x16& c11, int lane) {
    const int r = lane & 31, h = lane >> 5;
#pragma unroll
    for (int g = 0; g < 4; ++g) { const int j = 8 * g + 4 * h;
        epi.pair(r, j, (f32x4){c00[4 * g], c00[4 * g + 1], c00[4 * g + 2], c00[4 * g + 3]}, (f32x4){c01[4 * g], c01[4 * g + 1], c01[4 * g + 2], c01[4 * g + 3]});
        epi.pair(32 + r, j, (f32x4){c10[4 * g], c10[4 * g + 1], c10[4 * g + 2], c10[4 * g + 3]}, (f32x4){c11[4 * g], c11[4 * g + 1], c11[4 * g + 2], c11[4 * g + 3]}); }
}
__device__ __forceinline__ u32x2 pk4(f32x4 v) { u32x2 w; w.x = pk2(v.x, v.y); w.y = pk2(v.z, v.w); return w; }
struct EpiMaskLds { LAS float* M; __device__ __forceinline__ void pair(int row, int j, f32x4 v0, f32x4 v1) const {
    f32x4 a, b;
#pragma unroll
    for (int q = 0; q < 4; ++q) { a[q] = (j + q < row) ? v0[q] : 0.f; b[q] = (32 + j + q < row) ? v1[q] : 0.f; }
    *(LAS f32x4*)(M + row * 64 + j) = a; *(LAS f32x4*)(M + row * 64 + 32 + j) = b; } };
template <int INCL> struct EpiMaskBf { bf16_t* O; __device__ __forceinline__ void pair(int row, int j, f32x4 v0, f32x4 v1) const {
    f32x4 a, b;
#pragma unroll
    for (int q = 0; q < 4; ++q) { a[q] = (j + q < row + INCL) ? v0[q] : 0.f; b[q] = (32 + j + q < row + INCL) ? v1[q] : 0.f; }
    *(u32x2*)(O + row * 64 + j) = pk4(a); *(u32x2*)(O + row * 64 + 32 + j) = pk4(b); } };
struct EpiF32 { float* O; __device__ __forceinline__ void pair(int row, int j, f32x4 v0, f32x4 v1) const { *(f32x4*)(O + row * 64 + j) = v0; *(f32x4*)(O + row * 64 + 32 + j) = v1; } };
struct EpiRhat { const bf16_t* R; bf16_t* O; __device__ __forceinline__ void pair(int row, int j, f32x4 v0, f32x4 v1) const {
    *(u32x2*)(O + row * 64 + j) = pk4(ld_bf4(R + row * 64 + j) - v0); *(u32x2*)(O + row * 64 + 32 + j) = pk4(ld_bf4(R + row * 64 + 32 + j) - v1); } };
struct EpiPT { const float* gC; bf16_t* O; __device__ __forceinline__ void pair(int row, int j, f32x4 v0, f32x4 v1) const {
    const float gr = gC[row]; f32x4 a, b;
#pragma unroll
    for (int q = 0; q < 4; ++q) { a[q] = gr * (((j + q == row) ? 1.f : 0.f) - v0[q]); b[q] = gr * (((32 + j + q == row) ? 1.f : 0.f) - v1[q]); }
    *(u32x2*)(O + row * 64 + j) = pk4(a); *(u32x2*)(O + row * 64 + 32 + j) = pk4(b); } };
struct EpiGsc { const float* gC; float* O; __device__ __forceinline__ void pair(int row, int j, f32x4 v0, f32x4 v1) const {
    *(f32x4*)(O + row * 64 + j) = v0 * *(const f32x4*)(gC + j); *(f32x4*)(O + row * 64 + 32 + j) = v1 * *(const f32x4*)(gC + 32 + j); } };

__device__ __forceinline__ void ph_scan_s1(Frame& F) {
    PHASE_PIN(F);
    if (F.wave >= 4) return;
    const int lane = F.lane; LAS float* Ml = (LAS float*)(F.lds + F.wave * 32768); LAS float* Xl = Ml + 4096;
    for (int item = blockIdx.x * 4 + F.wave; item < 2048; item += gridDim.x * 4) {
        const int bh = item >> 7, chunk = item & 127;
        unsigned char* tmp = F.ws + WS_BIG + (size_t)item * S1_TMP_STRIDE; unsigned char* outp = F.ws + WS_PROJ + (size_t)item * S1_OUT_STRIDE;
        bf16_t* TCk = (bf16_t*)(tmp + T_TCK); bf16_t* TCb = (bf16_t*)(tmp + T_TCB); bf16_t* TCkt = (bf16_t*)(tmp + T_TCKT); bf16_t* TCr = (bf16_t*)(tmp + T_TCR);
        bf16_t* CTb = (bf16_t*)(tmp + T_CTB); bf16_t* CTk = (bf16_t*)(tmp + T_CTK); bf16_t* CTv = (bf16_t*)(tmp + T_CTV);
        bf16_t* MAK = (bf16_t*)(tmp + T_MAK); bf16_t* AAB = (bf16_t*)(tmp + T_AAB); bf16_t* AAK = (bf16_t*)(tmp + T_AAK);
        bf16_t* CTKH = (bf16_t*)(tmp + T_CTKH); bf16_t* CTU = (bf16_t*)(tmp + T_CTU); float* RHSF = (float*)(tmp + T_RHSF);
        bf16_t* PT = (bf16_t*)(outp + O_PT); bf16_t* RH = (bf16_t*)(outp + O_RH); float* Gm = (float*)(outp + O_G); float* Y0 = (float*)(outp + O_Y0); float* gC = (float*)(outp + O_GC);
        const float* sin = (const float*)(F.ws + WS_SIN) + ((size_t)bh * TT + chunk * 64) * 384;
#ifndef S1_NO_CT
        { float g = 1.0f;
#pragma unroll 1
          for (int blk = 0; blk < 8; ++blk) {
            float bt8[8], kt8[8], v8[8];
#pragma unroll
            for (int el = 0; el < 8; ++el) { const int i = blk * 8 + el; const float* p = sin + (size_t)i * 384;
                const float rr = p[lane], ww = p[64 + lane], kk = p[128 + lane], ka = p[192 + lane], bb = p[256 + lane], vv = p[320 + lane];
                const float kap = g * ka; g *= ww; const float inv = 1.0f / g; const float bt = bb * inv, kt = kk * inv, rt = rr * g;
                TCk[i * 64 + lane] = (bf16_t)f2bf(kap); TCb[i * 64 + lane] = (bf16_t)f2bf(bt); TCkt[i * 64 + lane] = (bf16_t)f2bf(kt); TCr[i * 64 + lane] = (bf16_t)f2bf(rt);
                RHSF[i * 64 + lane] = kap; bt8[el] = bt; kt8[el] = kt; v8[el] = vv; }
            *(bf16x8*)(CTb + lane * 64 + blk * 8) = pack8(bt8); *(bf16x8*)(CTk + lane * 64 + blk * 8) = pack8(kt8); *(bf16x8*)(CTv + lane * 64 + blk * 8) = pack8(v8);
          }
          gC[lane] = g; }
#endif
        STAGE_SYNC();
        f32x16 c00, c01, c10, c11;
        mm64_acc<false>(TCk, TCb, nullptr, nullptr, c00, c01, c10, c11, lane); { EpiMaskLds E{Ml}; mm64_epi(E, c00, c01, c10, c11, lane); }
        mm64_acc<false>(TCk, TCkt, nullptr, nullptr, c00, c01, c10, c11, lane); { EpiMaskBf<0> E{MAK}; mm64_epi(E, c00, c01, c10, c11, lane); }
        STAGE_SYNC();
        mm64_acc<false>(MAK, CTv, nullptr, nullptr, c00, c01, c10, c11, lane); { EpiF32 E{RHSF + 4096}; mm64_epi(E, c00, c01, c10, c11, lane); }
        STAGE_SYNC();
#ifndef S1_NO_SOLVE
#pragma unroll 1
        for (int pass = 0; pass < 2; ++pass) {
#pragma unroll 8
            for (int i = 0; i < 64; ++i) Xl[i * 64 + lane] = RHSF[pass * 4096 + i * 64 + lane];
#pragma unroll 1
            for (int i = 1; i < 64; ++i) {
                float a = Xl[i * 64 + lane];
#pragma unroll 2
                for (int j4 = 0; j4 < i; j4 += 4) { const f32x4 mv = *(const LAS f32x4*)(Ml + i * 64 + j4);
                    a -= mv.x * Xl[j4 * 64 + lane]; a -= mv.y * Xl[(j4 + 1) * 64 + lane]; a -= mv.z * Xl[(j4 + 2) * 64 + lane]; a -= mv.w * Xl[(j4 + 3) * 64 + lane]; }
                Xl[i * 64 + lane] = a;
            }
            bf16_t* dst = pass ? CTU : CTKH; const float sgn = pass ? -1.0f : 1.0f;
#pragma unroll 1
            for (int blk = 0; blk < 8; ++blk) { float o8[8];
#pragma unroll
                for (int el = 0; el < 8; ++el) o8[el] = sgn * Xl[(blk * 8 + el) * 64 + lane];
                *(bf16x8*)(dst + lane * 64 + blk * 8) = pack8(o8); }
        }
#endif
        mm64_acc<false>(TCr, TCb, nullptr, nullptr, c00, c01, c10, c11, lane); { EpiMaskBf<1> E{AAB}; mm64_epi(E, c00, c01, c10, c11, lane); }
        mm64_acc<false>(TCr, TCkt, nullptr, nullptr, c00, c01, c10, c11, lane); { EpiMaskBf<1> E{AAK}; mm64_epi(E, c00, c01, c10, c11, lane); }
        STAGE_SYNC();
        mm64_acc<false>(AAB, CTKH, nullptr, nullptr, c00, c01, c10, c11, lane); { EpiRhat E{TCr, RH}; mm64_epi(E, c00, c01, c10, c11, lane); }
        mm64_acc<true>(AAB, CTU, AAK, CTv, c00, c01, c10, c11, lane); { EpiF32 E{Y0}; mm64_epi(E, c00, c01, c10, c11, lane); }
        mm64_acc<false>(CTb, CTKH, nullptr, nullptr, c00, c01, c10, c11, lane); { EpiPT E{gC, PT}; mm64_epi(E, c00, c01, c10, c11, lane); }
        mm64_acc<true>(CTU, CTb, CTv, CTk, c00, c01, c10, c11, lane); { EpiGsc E{gC, Gm}; mm64_epi(E, c00, c01, c10, c11, lane); }
        STAGE_SYNC();
    }
}
__device__ __forceinline__ void ph_scan_s2(Frame& F) {
    PHASE_PIN(F);
    if (F.wave != 0 || blockIdx.x >= 32) return;
    const int lane = F.lane, r = lane & 31, hf = lane >> 5; const int bh = blockIdx.x >> 1, vt = blockIdx.x & 1, v = 32 * vt + r;
    bf16_t* SS = (bf16_t*)(F.ws + WS_Y);
    f32x16 acc0, acc1;
#pragma unroll
    for (int i = 0; i < 16; ++i) { acc0[i] = 0.f; acc1[i] = 0.f; }
    u32x2 pt[2][2][4][2]; f32x4 gin[2][2][4];
#define S2_LOAD(buf, chunk) do { const unsigned char* op_ = F.ws + WS_PROJ + (size_t)(bh * 128 + (chunk)) * S1_OUT_STRIDE; const bf16_t* PT_ = (const bf16_t*)(op_ + O_PT); const float* G_ = (const float*)(op_ + O_G); \
        _Pragma("unroll") for (int ni = 0; ni < 2; ++ni) { _Pragma("unroll") for (int s2 = 0; s2 < 4; ++s2) { pt[buf][ni][s2][0] = *(const u32x2*)(PT_ + (32 * ni + r) * 64 + 16 * s2 + 4 * hf); pt[buf][ni][s2][1] = *(const u32x2*)(PT_ + (32 * ni + r) * 64 + 16 * s2 + 8 + 4 * hf); } \
            _Pragma("unroll") for (int g = 0; g < 4; ++g) gin[buf][ni][g] = *(const f32x4*)(G_ + v * 64 + 32 * ni + 8 * g + 4 * hf); } } while (0)
#define S2_STEP(buf, chunk) do { bf16_t* so_ = SS + ((size_t)(bh * 128 + (chunk)) * 64 + v) * 64 + 4 * hf; \
        _Pragma("unroll") for (int g = 0; g < 4; ++g) { *(u32x2*)(so_ + 8 * g) = pk4((f32x4){acc0[4 * g], acc0[4 * g + 1], acc0[4 * g + 2], acc0[4 * g + 3]}); *(u32x2*)(so_ + 32 + 8 * g) = pk4((f32x4){acc1[4 * g], acc1[4 * g + 1], acc1[4 * g + 2], acc1[4 * g + 3]}); } \
        bf16x8 sf[4]; { u32x4 w_; \
          w_.x = pk2(acc0[0], acc0[1]); w_.y = pk2(acc0[2], acc0[3]); w_.z = pk2(acc0[4], acc0[5]); w_.w = pk2(acc0[6], acc0[7]); sf[0] = __builtin_bit_cast(bf16x8, w_); \
          w_.x = pk2(acc0[8], acc0[9]); w_.y = pk2(acc0[10], acc0[11]); w_.z = pk2(acc0[12], acc0[13]); w_.w = pk2(acc0[14], acc0[15]); sf[1] = __builtin_bit_cast(bf16x8, w_); \
          w_.x = pk2(acc1[0], acc1[1]); w_.y = pk2(acc1[2], acc1[3]); w_.z = pk2(acc1[4], acc1[5]); w_.w = pk2(acc1[6], acc1[7]); sf[2] = __builtin_bit_cast(bf16x8, w_); \
          w_.x = pk2(acc1[8], acc1[9]); w_.y = pk2(acc1[10], acc1[11]); w_.z = pk2(acc1[12], acc1[13]); w_.w = pk2(acc1[14], acc1[15]); sf[3] = __builtin_bit_cast(bf16x8, w_); } \
        f32x16 n0_, n1_; \
        _Pragma("unroll") for (int g = 0; g < 4; ++g) { _Pragma("unroll") for (int q = 0; q < 4; ++q) { n0_[4 * g + q] = gin[buf][0][g][q]; n1_[4 * g + q] = gin[buf][1][g][q]; } } \
        _Pragma("unroll") for (int s2 = 0; s2 < 4; ++s2) { u32x4 a_; a_.x = pt[buf][0][s2][0].x; a_.y = pt[buf][0][s2][0].y; a_.z = pt[buf][0][s2][1].x; a_.w = pt[buf][0][s2][1].y; n0_ = MFMA32(__builtin_bit_cast(bf16x8, a_), sf[s2], n0_); \
            a_.x = pt[buf][1][s2][0].x; a_.y = pt[buf][1][s2][0].y; a_.z = pt[buf][1][s2][1].x; a_.w = pt[buf][1][s2][1].y; n1_ = MFMA32(__builtin_bit_cast(bf16x8, a_), sf[s2], n1_); } \
        acc0 = n0_; acc1 = n1_; } while (0)
    S2_LOAD(0, 0);
    for (int chunk = 0; chunk < 128; chunk += 2) {
        S2_LOAD(1, chunk + 1);
        S2_STEP(0, chunk);
        if (chunk + 2 < 128) S2_LOAD(0, chunk + 2);
        S2_STEP(1, chunk + 1);
    }
#undef S2_LOAD
#undef S2_STEP
}
__device__ __forceinline__ void ph_scan_s3(Frame& F, int e) {
    PHASE_PIN(F);
    const int lane = F.lane, r = lane & 31, hf = lane >> 5;
    const float* ln_g = F.ka->in[17] + e * 512; const float* ln_b = F.ka->in[18] + e * 512;
    const float* GATE = (const float*)(F.ws + WS_GATE); const float* BON = (const float*)(F.ws + SM_BONUS); const float* SIN = (const float*)(F.ws + WS_SIN);
    bf16_t* YC = (bf16_t*)(F.ws + WS_YCAT); const bf16_t* SS = (const bf16_t*)(F.ws + WS_Y);
    for (int item = F.gw; item < 2048; item += F.ngw) {
        const int bh = item >> 7, chunk = item & 127, b = bh >> 3, hh = bh & 7;
        const unsigned char* outp = F.ws + WS_PROJ + (size_t)item * S1_OUT_STRIDE;
        const bf16_t* RH = (const bf16_t*)(outp + O_RH); const float* Y0 = (const float*)(outp + O_Y0);
        f32x16 c[2][2];
        mm64_acc<false>(RH, SS + (size_t)item * 4096, nullptr, nullptr, c[0][0], c[0][1], c[1][0], c[1][1], lane);
#pragma unroll
        for (int mi = 0; mi < 2; ++mi) {
            const int i = 32 * mi + r, t = chunk * 64 + i, m = b * TT + t;
            float s1 = 0.f;
#pragma unroll
            for (int ni = 0; ni < 2; ++ni)
#pragma unroll
                for (int g = 0; g < 4; ++g) { const f32x4 y0 = *(const f32x4*)(Y0 + i * 64 + 32 * ni + 8 * g + 4 * hf);
#pragma unroll
                    for (int q = 0; q < 4; ++q) { c[mi][ni][4 * g + q] += y0[q]; s1 += c[mi][ni][4 * g + q]; } }
            s1 += __shfl_xor(s1, 32); const float mean = s1 * (1.f / 64.f); float s2 = 0.f;
#pragma unroll
            for (int ni = 0; ni < 2; ++ni)
#pragma unroll
                for (int q = 0; q < 16; ++q) { const float d = c[mi][ni][q] - mean; c[mi][ni][q] = d; s2 += d * d; }
            s2 += __shfl_xor(s2, 32); const float rstd = rsqrtf(s2 * (1.f / 64.f) + GN_EPS); const float bon = BON[m * 8 + hh];
            const float* vrow = SIN + ((size_t)bh * TT + t) * 384 + 320;
#pragma unroll
            for (int ni = 0; ni < 2; ++ni)
#pragma unroll
                for (int g = 0; g < 4; ++g) { const int vv = 32 * ni + 8 * g + 4 * hf, ch = hh * 64 + vv;
                    const f32x4 lg = *(const f32x4*)(ln_g + ch), lb = *(const f32x4*)(ln_b + ch), v1 = *(const f32x4*)(vrow + vv), gt = *(const f32x4*)(GATE + (size_t)m * 512 + ch); f32x4 o;
#pragma unroll
                    for (int q = 0; q < 4; ++q) o[q] = (c[mi][ni][4 * g + q] * rstd * lg[q] + lb[q] + bon * v1[q]) * gt[q];
                    *(u32x2*)(YC + (size_t)m * 1024 + ch) = pk4(o); }
        }
    }
}

__device__ __forceinline__ size_t score_row_off(int b, int t) { const int j = t >> 7; return (size_t)b * SCORE_PER_BATCH + (size_t)16384 * (j * (j + 1) / 2) + (size_t)(t & 127) * (128 * (j + 1)); }
__device__ __forceinline__ void ph_idx_score(Frame& F) {
    PHASE_PIN(F);
    const int lane = F.lane, r = lane & 31, h = lane >> 5;
    const bf16_t* QI = (const bf16_t*)(F.ws + WS_QI); const bf16_t* KI = (const bf16_t*)(F.ws + WS_KI); const unsigned* SGN = (const unsigned*)(F.ws + SM_SGN);
    float* SC = (float*)(F.ws + WS_SCORE);
    for (int it = F.gw; it < 4352; it += F.ngw) {
        const int b = it / 2176; int i = it - b * 2176; i = 2175 - i;
        int a = 1; while (8 * a * (a + 1) <= i) ++a;
        const int rem = i - 8 * a * (a - 1), qt = 16 * (a - 1) + rem / a, g = rem % a;
        const int mq = b * TT + qt * 32 + r;
        bf16x8 qf[8][4];
#pragma unroll
        for (int hh = 0; hh < 8; ++hh)
#pragma unroll
            for (int ks = 0; ks < 4; ++ks) qf[hh][ks] = *(const bf16x8*)(QI + (size_t)mq * 512 + hh * 64 + ks * 16 + 8 * h);
        const unsigned sg = SGN[mq];
        float* srow = SC + score_row_off(b, qt * 32 + r);
        const int kt_end = (16 * g + 15 < qt) ? 16 * g + 15 : qt;
        for (int kt = 16 * g; kt <= kt_end; ++kt) {
            const bf16_t* kp = KI + (size_t)(b * TT + kt * 32 + r) * 64 + 8 * h;
            const bf16x8 kf0 = *(const bf16x8*)(kp), kf1 = *(const bf16x8*)(kp + 16), kf2 = *(const bf16x8*)(kp + 32), kf3 = *(const bf16x8*)(kp + 48);
            float sc[16];
#pragma unroll
            for (int q = 0; q < 16; ++q) sc[q] = 0.f;
#pragma unroll
            for (int hh = 0; hh < 8; ++hh) {
                f32x16 acc;
#pragma unroll
                for (int q = 0; q < 16; ++q) acc[q] = 0.f;
                acc = MFMA32(kf0, qf[hh][0], acc); acc = MFMA32(kf1, qf[hh][1], acc); acc = MFMA32(kf2, qf[hh][2], acc); acc = MFMA32(kf3, qf[hh][3], acc);
                const bool neg = (sg >> hh) & 1u;
#pragma unroll
                for (int q = 0; q < 16; ++q) { const float v = fmaxf(acc[q], 0.f); sc[q] = neg ? sc[q] - v : sc[q] + v; }
            }
#pragma unroll
            for (int g4 = 0; g4 < 4; ++g4) *(f32x4*)(srow + kt * 32 + 8 * g4 + 4 * h) = (f32x4){sc[4 * g4], sc[4 * g4 + 1], sc[4 * g4 + 2], sc[4 * g4 + 3]};
        }
    }
}
__device__ __forceinline__ unsigned block_excl_scan(unsigned v, LAS unsigned* scr, int tid, unsigned* total) {
    const int lane = tid & 63, w = tid >> 6; unsigned x = v;
#pragma unroll
    for (int o = 1; o < 64; o <<= 1) { const unsigned y = __shfl_up(x, o); if (lane >= o) x += y; }
    __syncthreads();
    if (lane == 63) scr[w] = x;
    __syncthreads();
    unsigned base = 0, tot = 0;
#pragma unroll
    for (int j = 0; j < 8; ++j) { const unsigned c = scr[j]; if (j < w) base += c; tot += c; }
    *total = tot;
    return base + x - v;
}
__device__ __forceinline__ void ph_idx_select(Frame& F) {
    PHASE_PIN(F);
    const int lane = F.lane;
    LAS unsigned* hist = (LAS unsigned*)(F.lds + F.wave * LDS_WSCR);
    LAS float* cval = (LAS float*)(hist + 2048); LAS int* cidx = (LAS int*)(cval + 1024);
    const float* SC = (const float*)(F.ws + WS_SCORE); int* SEL = (int*)(F.ws + WS_SEL);
    const unsigned long long lt_mask = (1ull << lane) - 1ull;
    for (int m = F.gw; m < NT; m += F.ngw) {
        const int t = m & (TT - 1), b = m >> 13, n = t + 1; int* sel = SEL + (size_t)m * 256;
        if (n <= 256) {
#pragma unroll
            for (int i = 0; i < 4; ++i) sel[lane + 64 * i] = (lane + 64 * i < n) ? lane + 64 * i : -1;
            continue; }
        const float* srow = SC + score_row_off(b, t);
        const int nch = (n + 255) >> 8;
        float lo = INFINITY, hi = -INFINITY;
        for (int c = 0; c < nch; ++c) { const int idx0 = 256 * c + 4 * lane; if (idx0 < n) { const f32x4 v = *(const f32x4*)(srow + idx0);
#pragma unroll
            for (int i = 0; i < 4; ++i) if (idx0 + i < n) { lo = fminf(lo, v[i]); hi = fmaxf(hi, v[i]); } } }
#pragma unroll
        for (int o = 1; o < 64; o <<= 1) { lo = fminf(lo, __shfl_xor(lo, o)); hi = fmaxf(hi, __shfl_xor(hi, o)); }
        unsigned need = 256u, outpos = 0u;
        for (int level = 0; level < 8; ++level) {
            if (!(hi > lo)) {
                for (int c = 0; c < nch && need > 0u; ++c) { const int idx0 = 256 * c + 4 * lane; f32x4 v = (f32x4){0.f, 0.f, 0.f, 0.f}; if (idx0 < n) v = *(const f32x4*)(srow + idx0);
                    bool f[4]; unsigned before = 0, mine = 0;
#pragma unroll
                    for (int i = 0; i < 4; ++i) { f[i] = (idx0 + i < n) && v[i] == lo; before += __popcll(__ballot(f[i]) & lt_mask); }
                    unsigned total = 0;
#pragma unroll
                    for (int i = 0; i < 4; ++i) total += __popcll(__ballot(f[i]));
#pragma unroll
                    for (int i = 0; i < 4; ++i) { if (f[i]) { const unsigned p = before + mine; if (p < need) sel[outpos + p] = idx0 + i; ++mine; } }
                    const unsigned took = total < need ? total : need; outpos += took; need -= took; }
                break;
            }
            const float scale = 2047.0f / (hi - lo);
#pragma unroll
            for (int i = 0; i < 8; ++i) *(LAS u32x4*)(hist + 4 * (lane + 64 * i)) = (u32x4){0u, 0u, 0u, 0u};
            LDS_WAIT(); asm volatile("" ::: "memory");
            for (int c = 0; c < nch; ++c) { const int idx0 = 256 * c + 4 * lane; if (idx0 < n) { const f32x4 v = *(const f32x4*)(srow + idx0);
#pragma unroll
                for (int i = 0; i < 4; ++i) if (idx0 + i < n && v[i] >= lo && v[i] <= hi) { int bq = (int)((v[i] - lo) * scale); bq = bq > 2047 ? 2047 : bq;
                    __hip_atomic_fetch_add(&hist[bq], 1u, __ATOMIC_RELAXED, __HIP_MEMORY_SCOPE_WORKGROUP); } } }
            LDS_WAIT(); asm volatile("" ::: "memory");
            unsigned hv[32], L = 0;
#pragma unroll
            for (int i = 0; i < 8; ++i) { const u32x4 h4 = *(const LAS u32x4*)(hist + 2044 - 32 * lane - 4 * i); hv[4 * i] = h4.w; hv[4 * i + 1] = h4.z; hv[4 * i + 2] = h4.y; hv[4 * i + 3] = h4.x; L += h4.x + h4.y + h4.z + h4.w; }
            unsigned xs = L;
#pragma unroll
            for (int o = 1; o < 64; o <<= 1) { const unsigned y = __shfl_up(xs, o); if (lane >= o) xs += y; }
            unsigned run = xs - L; const bool finder = (run < need && need <= run + L);
            int fb = 0; unsigned fneed = 0, fcnt = 0;
#pragma unroll
            for (int i = 0; i < 32; ++i) { if (run < need && need <= run + hv[i]) { fb = 2047 - 32 * lane - i; fneed = need - run; fcnt = hv[i]; } run += hv[i]; }
            const int fl = __ffsll((long long)__ballot(finder)) - 1;
            const int bstar = __shfl(fb, fl); const unsigned need2 = __shfl(fneed, fl), cnum = __shfl(fcnt, fl);
            const bool listed = cnum <= 1024u;
            float lo2 = INFINITY, hi2 = -INFINITY; unsigned cpos = 0;
            for (int c = 0; c < nch; ++c) { const int idx0 = 256 * c + 4 * lane; f32x4 v = (f32x4){0.f, 0.f, 0.f, 0.f}; if (idx0 < n) v = *(const f32x4*)(srow + idx0);
                bool fg[4], fe[4]; unsigned bg = 0, be = 0, tg = 0, te = 0;
#pragma unroll
                for (int i = 0; i < 4; ++i) { const bool act = (idx0 + i < n) && v[i] >= lo && v[i] <= hi; int bq = (int)((v[i] - lo) * scale); bq = bq > 2047 ? 2047 : bq;
                    fg[i] = act && bq > bstar; fe[i] = act && bq == bstar;
                    const unsigned long long mg = __ballot(fg[i]), me = __ballot(fe[i]); bg += __popcll(mg & lt_mask); be += __popcll(me & lt_mask); tg += __popcll(mg); te += __popcll(me); }
                unsigned mg2 = 0, me2 = 0;
#pragma unroll
                for (int i = 0; i < 4; ++i) {
                    if (fg[i]) { sel[outpos + bg + mg2] = idx0 + i; ++mg2; }
                    if (fe[i]) { lo2 = fminf(lo2, v[i]); hi2 = fmaxf(hi2, v[i]); if (listed) { cval[cpos + be + me2] = v[i]; cidx[cpos + be + me2] = idx0 + i; } ++me2; } }
                outpos += tg; cpos += te; }
            need = need2;
            if (listed) {
                LDS_WAIT(); asm volatile("" ::: "memory");
                for (unsigned i = lane; i < cnum; i += 64) { const float vi = cval[i]; const int ii = cidx[i]; unsigned rank = 0;
                    for (unsigned j = 0; j < cnum; ++j) { const float vj = cval[j]; rank += (vj > vi || (vj == vi && cidx[j] < ii)) ? 1u : 0u; }
                    if (rank < need) sel[outpos + rank] = ii; }
                LDS_WAIT(); asm volatile("" ::: "memory");
                break;
            }
#pragma unroll
            for (int o = 1; o < 64; o <<= 1) { lo2 = fminf(lo2, __shfl_xor(lo2, o)); hi2 = fmaxf(hi2, __shfl_xor(hi2, o)); }
            lo = lo2; hi = hi2;
        }
    }
}

#define MFMA16(a, b, c) __builtin_amdgcn_mfma_f32_16x16x32_bf16((a), (b), (c), 0, 0, 0)
__device__ __forceinline__ void ph_sparse(Frame& F, int e) {
    PHASE_PIN(F);
    const int lane = F.lane, hd = lane & 15, gq = lane >> 4; unsigned char* ws = F.ws;
    LAS unsigned char* Tl = F.lds + F.wave * LDS_WSCR;
    bf16_t* QA = (bf16_t*)(ws + WS_QA); const bf16_t* CN = (const bf16_t*)(ws + WS_CN); const int* SEL = (const int*)(ws + WS_SEL);
    for (int m = F.gw; m < NT; m += F.ngw) {
        const int t = m & (TT - 1), b = m >> 13; const int nvalid = (t + 1 < 256) ? t + 1 : 256;
        bf16x8 qf[4];
#pragma unroll
        for (int ks = 0; ks < 4; ++ks) { u32x4 z = (u32x4){0u, 0u, 0u, 0u}; if (hd < 8) z = *(const u32x4*)(QA + (size_t)m * 1024 + hd * 128 + 32 * ks + 8 * gq); qf[ks] = __builtin_bit_cast(bf16x8, z); }
        f32x4 ctx[8];
#pragma unroll
        for (int i = 0; i < 8; ++i) ctx[i] = (f32x4){0.f, 0.f, 0.f, 0.f};
        float mrun = -INFINITY, lsum = 0.f;
        const bf16_t* cbase = CN + (size_t)b * TT * 128;
#pragma unroll 1
        for (int c = 0; c < 4; ++c) {
            if (64 * c >= nvalid) break;
            int sjc = SEL[(size_t)m * 256 + 64 * c + lane]; if (sjc < 0) sjc = 0;
            bf16x8 pc[4][4];
#pragma unroll
            for (int kt = 0; kt < 4; ++kt) { const int s = __shfl(sjc, 16 * kt + hd); const bf16_t* row = cbase + (size_t)s * 128 + 8 * gq;
#pragma unroll
                for (int ks = 0; ks < 4; ++ks) pc[kt][ks] = *(const bf16x8*)(row + 32 * ks); }
            f32x4 d[4];
#pragma unroll
            for (int kt = 0; kt < 4; ++kt) { f32x4 a = (f32x4){0.f, 0.f, 0.f, 0.f};
#pragma unroll
                for (int ks = 0; ks < 4; ++ks) a = MFMA16(pc[kt][ks], qf[ks], a);
#pragma unroll
                for (int q = 0; q < 4; ++q) { const int kidx = 64 * c + 16 * kt + 4 * gq + q; d[kt][q] = (kidx < nvalid) ? a[q] * (0.125f * LOG2E) : -INFINITY; } }
            { LAS unsigned char* wb = Tl + (hd >> 2) * 1024 + (hd & 3) * 2 + gq * 64;
#pragma unroll
              for (int kt = 0; kt < 4; ++kt)
#pragma unroll
                for (int ks = 0; ks < 4; ++ks)
#pragma unroll
                    for (int el = 0; el < 8; ++el) *(LAS bf16_t*)(wb + 4 * kt * 1024 + (32 * ks + el) * 8) = (bf16_t)pc[kt][ks][el]; }
            float mx = fmaxf(fmaxf(fmaxf(d[0][0], d[0][1]), fmaxf(d[0][2], d[0][3])), fmaxf(fmaxf(d[1][0], d[1][1]), fmaxf(d[1][2], d[1][3])));
            mx = fmaxf(mx, fmaxf(fmaxf(fmaxf(d[2][0], d[2][1]), fmaxf(d[2][2], d[2][3])), fmaxf(fmaxf(d[3][0], d[3][1]), fmaxf(d[3][2], d[3][3]))));
            mx = fmaxf(mx, __shfl_xor(mx, 16)); mx = fmaxf(mx, __shfl_xor(mx, 32));
            const float mnew = fmaxf(mrun, mx); const float scale = __builtin_amdgcn_exp2f(mrun - mnew); mrun = mnew;
            float psum = 0.f;
#pragma unroll
            for (int kt = 0; kt < 4; ++kt)
#pragma unroll
                for (int q = 0; q < 4; ++q) { d[kt][q] = __builtin_amdgcn_exp2f(d[kt][q] - mnew); psum += d[kt][q]; }
            lsum = lsum * scale + psum;
#pragma unroll
            for (int i = 0; i < 8; ++i) ctx[i] *= scale;
#pragma unroll
            for (int u = 0; u < 2; ++u) {
                u32x4 pw; pw.x = pk2(d[2 * u][0], d[2 * u][1]); pw.y = pk2(d[2 * u][2], d[2 * u][3]); pw.z = pk2(d[2 * u + 1][0], d[2 * u + 1][1]); pw.w = pk2(d[2 * u + 1][2], d[2 * u + 1][3]);
                const bf16x8 pf = __builtin_bit_cast(bf16x8, pw);
#pragma unroll
                for (int mt = 0; mt < 8; ++mt) { const LAS unsigned char* rb = Tl + gq * 1024 + hd * 8;
                    const u32x2 lo = *(const LAS u32x2*)(rb + (8 * u) * 1024 + 16 * mt * 8);
                    const u32x2 hi = *(const LAS u32x2*)(rb + (8 * u + 4) * 1024 + 16 * mt * 8);
                    u32x4 aw; aw.x = lo.x; aw.y = lo.y; aw.z = hi.x; aw.w = hi.y;
                    ctx[mt] = MFMA16(__builtin_bit_cast(bf16x8, aw), pf, ctx[mt]); }
            }
        }
        lsum += __shfl_xor(lsum, 16); lsum += __shfl_xor(lsum, 32);
        const float inv = 1.0f / lsum;
        if (hd < 8) {
#pragma unroll
            for (int mt = 0; mt < 8; ++mt) { u32x2 w; w.x = pk2(ctx[mt][0] * inv, ctx[mt][1] * inv); w.y = pk2(ctx[mt][2] * inv, ctx[mt][3] * inv);
                *(u32x2*)(QA + (size_t)m * 1024 + hd * 128 + 16 * mt + 4 * gq) = w; }
        }
    }
}
__device__ __forceinline__ void ph_mix_finish(Frame& F, int e) {
    PHASE_PIN(F);
    const int lane = F.lane; unsigned char* ws = F.ws;
    bf16_t* YC = (bf16_t*)(ws + WS_YCAT);
    const float* ln_g = F.ka->in[17] + e * 512; const float* ln_b = F.ka->in[18] + e * 512;
    const float* Yr = (const float*)(ws + WS_Y); const float* GATE = (const float*)(ws + WS_GATE); const float* BON = (const float*)(ws + SM_BONUS); const float* SIN = (const float*)(ws + WS_SIN);
#if !CHUNKED
    for (int m = F.gw; m < NT; m += F.ngw) {
        const int t = m & (TT - 1), b = m >> 13;
#pragma unroll 1
        for (int hh = 0; hh < 8; ++hh) {
            const int ch = hh * 64 + lane; const float y = Yr[(size_t)m * 512 + ch];
            const float mean = wave_sum(y) * (1.f / 64.f); const float yc = y - mean; const float var = wave_sum(yc * yc) * (1.f / 64.f);
            const float v1 = SIN[((size_t)(b * 8 + hh) * TT + t) * 384 + 320 + lane];
            const float o = (yc * rsqrtf(var + GN_EPS) * ln_g[ch] + ln_b[ch] + BON[m * 8 + hh] * v1) * GATE[(size_t)m * 512 + ch];
            YC[(size_t)m * 1024 + ch] = (bf16_t)f2bf(o);
        }
    }
#endif
    { const bf16_t* CTX = (const bf16_t*)(ws + WS_QA); const bf16_t* WvT = (const bf16_t*)(ws + W_WVT) + (size_t)e * 512 * 128;
      for (int tI = F.gw; tI < (NT / 64) * 8; tI += F.ngw) {
          const int hh = tI & 7, mt = tI >> 3;
          EpiStoreBf16 E{YC + 512 + hh * 64, 1024, 0, 32};
          sg_tile(CTX + hh * 128, 1024, WvT + (size_t)(hh * 64) * 128, WvT + (size_t)(hh * 64 + 32) * 128, 128, 128, mt * 64, E, F.lane);
      } }
}

__device__ __forceinline__ void ph_stickbreak(Frame& F) {
    PHASE_PIN(F);
    const int lane = F.lane, r = lane & 31, hf = lane >> 5; unsigned char* ws = F.ws;
    const bf16_t* Q = (const bf16_t*)(ws + WS_PROJ); const bf16_t* Kb = Q + (size_t)NT * 1024; const bf16_t* Vb = Kb + (size_t)NT * 1024;
    bf16_t* YC = (bf16_t*)(ws + WS_YCAT);
    for (int it = F.gw; it < NB * 16 * 256; it += F.ngw) {
        const int qt = it & 255, hh = (it >> 8) & 15, b = it >> 12;
        const int mq = b * TT + qt * 32 + r;
        bf16x8 qf[4];
#pragma unroll
        for (int ks = 0; ks < 4; ++ks) qf[ks] = *(const bf16x8*)(Q + (size_t)mq * 1024 + hh * 64 + ks * 16 + 8 * hf);
        f32x16 o0, o1;
#pragma unroll
        for (int i = 0; i < 16; ++i) { o0[i] = 0.f; o1[i] = 0.f; }
        float P = 1.0f;
        for (int kt = qt; kt >= 0; --kt) {
            const bf16_t* kp = Kb + (size_t)(b * TT + kt * 32 + r) * 1024 + hh * 64 + 8 * hf;
            const bf16x8 kf0 = *(const bf16x8*)(kp), kf1 = *(const bf16x8*)(kp + 16), kf2 = *(const bf16x8*)(kp + 32), kf3 = *(const bf16x8*)(kp + 48);
            const bf16_t* vp = Vb + (size_t)(b * TT + kt * 32 + 4 * hf) * 1024 + hh * 64 + r;
            bf16x8 vf[2][2];
#pragma unroll
            for (int s2 = 0; s2 < 2; ++s2)
#pragma unroll
                for (int j = 0; j < 8; ++j) { const size_t ko = (size_t)(16 * s2 + 8 * (j >> 2) + (j & 3)) * 1024; vf[0][s2][j] = (short)vp[ko]; vf[1][s2][j] = (short)vp[ko + 32]; }
            f32x16 acc;
#pragma unroll
            for (int i = 0; i < 16; ++i) acc[i] = 0.f;
            acc = MFMA32(kf0, qf[0], acc); acc = MFMA32(kf1, qf[1], acc); acc = MFMA32(kf2, qf[2], acc); acc = MFMA32(kf3, qf[3], acc);
            float kp_[16], be[16];
            const bool diag = (kt == qt);
#pragma unroll
            for (int q = 0; q < 16; ++q) {
                const int key = 8 * (q >> 2) + 4 * hf + (q & 3);
                const float e = __builtin_amdgcn_exp2f(acc[q]); float keep = __builtin_amdgcn_rcpf(1.0f + e);
                if (diag && key >= r) keep = 1.0f;
                kp_[q] = keep; be[q] = 1.0f - keep;
            }
            float ls[16], tot[4], oth[4];
#pragma unroll
            for (int g = 0; g < 4; ++g) { ls[4 * g + 3] = 1.0f; ls[4 * g + 2] = kp_[4 * g + 3]; ls[4 * g + 1] = ls[4 * g + 2] * kp_[4 * g + 2]; ls[4 * g] = ls[4 * g + 1] * kp_[4 * g + 1]; tot[g] = ls[4 * g] * kp_[4 * g]; }
#pragma unroll
            for (int g = 0; g < 4; ++g) oth[g] = __shfl_xor(tot[g], 32);
            const float G0 = tot[0] * oth[0], G1 = tot[1] * oth[1], G2 = tot[2] * oth[2], G3 = tot[3] * oth[3];
            float E[4]; E[3] = 1.0f; E[2] = G3; E[1] = G3 * G2; E[0] = E[1] * G1;
            float w[16];
#pragma unroll
            for (int g = 0; g < 4; ++g) { const float mg = E[g] * (hf == 0 ? oth[g] : 1.0f) * P;
#pragma unroll
                for (int j = 0; j < 4; ++j) w[4 * g + j] = be[4 * g + j] * ls[4 * g + j] * mg; }
            P *= E[0] * G0;
            u32x4 w0, w1;
            w0.x = pk2(w[0], w[1]); w0.y = pk2(w[2], w[3]); w0.z = pk2(w[4], w[5]); w0.w = pk2(w[6], w[7]);
            w1.x = pk2(w[8], w[9]); w1.y = pk2(w[10], w[11]); w1.z = pk2(w[12], w[13]); w1.w = pk2(w[14], w[15]);
            const bf16x8 wf0 = __builtin_bit_cast(bf16x8, w0), wf1 = __builtin_bit_cast(bf16x8, w1);
            o0 = MFMA32(vf[0][0], wf0, o0); o0 = MFMA32(vf[0][1], wf1, o0);
            o1 = MFMA32(vf[1][0], wf0, o1); o1 = MFMA32(vf[1][1], wf1, o1);
            if (__ballot(P > 1e-30f) == 0ull) break;
        }
        bf16_t* op = YC + (size_t)mq * 1024 + hh * 64 + 4 * hf;
#pragma unroll
        for (int g = 0; g < 4; ++g) {
            u32x2 a; a.x = pk2(o0[4 * g], o0[4 * g + 1]); a.y = pk2(o0[4 * g + 2], o0[4 * g + 3]); *(u32x2*)(op + 8 * g) = a;
            u32x2 c; c.x = pk2(o1[4 * g], o1[4 * g + 1]); c.y = pk2(o1[4 * g + 2], o1[4 * g + 3]); *(u32x2*)(op + 32 + 8 * g) = c;
        }
    }
}

__device__ __forceinline__ void ph_moe_route(Frame& F, const Args& A, int l) {
    PHASE_PIN(F);
    const int lane = F.lane; unsigned char* ws = F.ws;
    const float* X = (const float*)(ws + WS_X); bf16_t* XB = (bf16_t*)(ws + WS_XB);
    const float* g = F.ka->in[29] + l * DM; const float* Wg = F.ka->in[30] + (size_t)l * DM * 4; const float* We = F.ka->in[31] + (size_t)l * 4 * DM * 8;
    int* EIDX = (int*)(ws + SM_EIDX); float* GATEV = (float*)(ws + SM_GATE); int* SLOT = (int*)(ws + SM_SLOT);
    unsigned* cnt = (unsigned*)(ws + WS_CTL) + CW_CNT + 64 * l;
    for (int m = F.gw; m < NT; m += F.ngw) {
        const f32x4* xr = (const f32x4*)(X + (size_t)m * DM) + lane; f32x4 v[4]; float s = 0.f;
#pragma unroll
        for (int j = 0; j < 4; ++j) { v[j] = xr[64 * j]; s += (v[j].x * v[j].x + v[j].y * v[j].y) + (v[j].z * v[j].z + v[j].w * v[j].w); }
        const float rstd = rsqrtf(wave_sum(s) * (1.f / DM) + RMS_EPS);
        u32x2* o8 = (u32x2*)(XB + (size_t)m * DM) + lane;
#pragma unroll
        for (int j = 0; j < 4; ++j) { u32x2 w; w.x = pk2(v[j].x * rstd, v[j].y * rstd); w.y = pk2(v[j].z * rstd, v[j].w * rstd); o8[64 * j] = w; }
#pragma unroll
        for (int j = 0; j < 4; ++j) { const f32x4 gg = *((const f32x4*)g + lane + 64 * j); v[j] = v[j] * gg * rstd; }
        float gl[4] = {0.f, 0.f, 0.f, 0.f};
#pragma unroll
        for (int j = 0; j < 4; ++j)
#pragma unroll
            for (int i = 0; i < 4; ++i) { const int k = 4 * (lane + 64 * j) + i; const f32x4 w = *(const f32x4*)(Wg + (size_t)k * 4); const float xv = v[j][i];
                gl[0] += xv * w.x; gl[1] += xv * w.y; gl[2] += xv * w.z; gl[3] += xv * w.w; }
#pragma unroll
        for (int q = 0; q < 4; ++q) gl[q] = wave_sum(gl[q]);
        int gs = 0; float gm = gl[0];
#pragma unroll
        for (int q = 1; q < 4; ++q) if (gl[q] > gm) { gm = gl[q]; gs = q; }
        float gden = 0.f;
#pragma unroll
        for (int q = 0; q < 4; ++q) gden += __expf(gl[q] - gm);
        const float g_gate = 1.0f / gden;
        const float* Wes = We + (size_t)gs * DM * 8;
        float el[8];
#pragma unroll
        for (int q = 0; q < 8; ++q) el[q] = 0.f;
#pragma unroll
        for (int j = 0; j < 4; ++j)
#pragma unroll
            for (int i = 0; i < 4; ++i) { const int k = 4 * (lane + 64 * j) + i; const f32x4 w0 = *(const f32x4*)(Wes + (size_t)k * 8), w1 = *(const f32x4*)(Wes + (size_t)k * 8 + 4); const float xv = v[j][i];
                el[0] += xv * w0.x; el[1] += xv * w0.y; el[2] += xv * w0.z; el[3] += xv * w0.w; el[4] += xv * w1.x; el[5] += xv * w1.y; el[6] += xv * w1.z; el[7] += xv * w1.w; }
#pragma unroll
        for (int q = 0; q < 8; ++q) el[q] = wave_sum(el[q]);
        int i1 = 0; float m1 = el[0];
#pragma unroll
        for (int q = 1; q < 8; ++q) if (el[q] > m1) { m1 = el[q]; i1 = q; }
        int i2 = -1; float m2 = -INFINITY;
#pragma unroll
        for (int q = 0; q < 8; ++q) if (q != i1 && el[q] > m2) { m2 = el[q]; i2 = q; }
        const float e2 = __expf(m2 - m1); const float ga = g_gate / (1.0f + e2), gb = g_gate * e2 / (1.0f + e2);
        if (lane == 0) {
            const int ea = gs * 8 + i1, eb = gs * 8 + i2;
            const unsigned sa = atomicAdd(&cnt[ea], 1u), sb = atomicAdd(&cnt[eb], 1u);
            EIDX[2 * m] = ea; EIDX[2 * m + 1] = eb; GATEV[2 * m] = ga; GATEV[2 * m + 1] = gb; SLOT[2 * m] = (int)sa; SLOT[2 * m + 1] = (int)sb;
        }
    }
}
__device__ __forceinline__ int moe_offsets(const unsigned* cnt, int lane, int* total, int* mycnt_pad) {
    const unsigned c = lane < 32 ? __hip_atomic_load(cnt + (lane & 31), __ATOMIC_RELAXED, __HIP_MEMORY_SCOPE_AGENT) : 0u; const int p = (int)((c + 255u) & ~255u);
    int x = p;
#pragma unroll
    for (int o = 1; o < 64; o <<= 1) { const int y = __shfl_up(x, o); if (lane >= o) x += y; }
    *total = __shfl(x, 63); *mycnt_pad = p;
    return x - p;
}
__device__ __forceinline__ void ph_moe_gather(Frame& F, int l) {
    PHASE_PIN(F);
    const int lane = F.lane; unsigned char* ws = F.ws;
    const unsigned* cnt = (const unsigned*)(ws + WS_CTL) + CW_CNT + 64 * l; int total, pad; const int off = moe_offsets(cnt, lane, &total, &pad);
    const int* EIDX = (const int*)(ws + SM_EIDX); const int* SLOT = (const int*)(ws + SM_SLOT);
    const bf16_t* XB = (const bf16_t*)(ws + WS_XB); bf16_t* AM = (bf16_t*)(ws + WS_AMOE);
    for (int a = F.gw; a < NT * 2; a += F.ngw) {
        const int m = a >> 1, e = EIDX[a], row = __shfl(off, e) + SLOT[a];
        const u32x4* src = (const u32x4*)(XB + (size_t)m * DM); u32x4* dst = (u32x4*)(AM + (size_t)row * DM);
        dst[lane] = src[lane]; dst[lane + 64] = src[lane + 64];
    }
}
__device__ __forceinline__ int moe_build_tab(Frame& F, int l) {
    LAS int* tab = (LAS int*)(F.lds + LDS_MISC + 256); LAS int* ends = (LAS int*)(F.lds + LDS_MISC + 1024);
    const unsigned* cnt = (const unsigned*)(F.ws + WS_CTL) + CW_CNT + 64 * l; int total, pad; const int off = moe_offsets(cnt, F.lane, &total, &pad);
    __syncthreads();
    if (F.tid < 32) ends[F.tid] = off + pad;
    __syncthreads();
    for (int rt = F.tid; rt < total / 256; rt += NTHR) { int e = 0; for (int q = 0; q < 32; ++q) e += (ends[q] <= rt * 256) ? 1 : 0; tab[rt] = e; }
    __syncthreads();
    return total;
}
__device__ __forceinline__ void ph_moe_gemm1(Frame& F, int l) {
    PHASE_PIN(F);
    const int total = moe_build_tab(F, l);
    pg8::Gemm g{(const pg8::bf16_t*)(F.ws + WS_AMOE), (const pg8::bf16_t*)(F.ws + WS_W13T), total, 32 * 1024, DM};
    pg8::MoeOrder S{(total / 256) * 4, (int)gridDim.x, (int)blockIdx.x, (const LAS int*)(F.lds + LDS_MISC + 256)};
    pg8::EpiGate E{(pg8::bf16_t*)(F.ws + WS_H)};
    pg8::gemm_phase<pg8::EpiGate, pg8::MoeOrder>(F.lds, g, S, E, nullptr, F.wave);
}
__device__ __forceinline__ void ph_moe_gemm2(Frame& F, int l) {
    PHASE_PIN(F);
    const int total = moe_build_tab(F, l);
    pg8::Gemm g{(const pg8::bf16_t*)(F.ws + WS_H), (const pg8::bf16_t*)(F.ws + WS_W2T), total, 32 * 1024, 512};
    pg8::MoeOrder S{(total / 256) * 4, (int)gridDim.x, (int)blockIdx.x, (const LAS int*)(F.lds + LDS_MISC + 256)};
    pg8::EpiMoeDown E{(pg8::bf16_t*)(F.ws + WS_YM)};
    pg8::gemm_phase<pg8::EpiMoeDown, pg8::MoeOrder>(F.lds, g, S, E, nullptr, F.wave);
}
__device__ __forceinline__ void ph_moe_combine(Frame& F, const Args& A, int l) {
    PHASE_PIN(F);
    const int lane = F.lane; unsigned char* ws = F.ws;
    const unsigned* cnt = (const unsigned*)(ws + WS_CTL) + CW_CNT + 64 * l; int total, pad; const int off = moe_offsets(cnt, lane, &total, &pad);
    const int* EIDX = (const int*)(ws + SM_EIDX); const int* SLOT = (const int*)(ws + SM_SLOT); const float* GATEV = (const float*)(ws + SM_GATE);
    float* X = (float*)(ws + WS_X); bf16_t* XB = (bf16_t*)(ws + WS_XB); const bf16_t* YM = (const bf16_t*)(ws + WS_YM);
    const float* fg = F.ka->in[35];
    for (int m = F.gw; m < NT; m += F.ngw) {
        const int ea = EIDX[2 * m], eb = EIDX[2 * m + 1]; const float ga = GATEV[2 * m], gb = GATEV[2 * m + 1];
        const int ra = __shfl(off, ea) + SLOT[2 * m], rb = __shfl(off, eb) + SLOT[2 * m + 1];
        f32x4* xr = (f32x4*)(X + (size_t)m * DM) + lane; const u32x2* ya = (const u32x2*)(YM + (size_t)ra * DM) + lane; const u32x2* yb = (const u32x2*)(YM + (size_t)rb * DM) + lane;
        f32x4 v[4]; float s = 0.f;
#pragma unroll
        for (int j = 0; j < 4; ++j) { v[j] = xr[64 * j]; const u32x2 a = ya[64 * j], bq = yb[64 * j];
            v[j].x += ga * __uint_as_float(a.x << 16) + gb * __uint_as_float(bq.x << 16); v[j].y += ga * __uint_as_float(a.x & 0xffff0000u) + gb * __uint_as_float(bq.x & 0xffff0000u);
            v[j].z += ga * __uint_as_float(a.y << 16) + gb * __uint_as_float(bq.y << 16); v[j].w += ga * __uint_as_float(a.y & 0xffff0000u) + gb * __uint_as_float(bq.y & 0xffff0000u);
            s += (v[j].x * v[j].x + v[j].y * v[j].y) + (v[j].z * v[j].z + v[j].w * v[j].w); }
        const float rstd = rsqrtf(wave_sum(s) * (1.f / DM) + RMS_EPS);
        if (l < 3) {
            u32x2* o8 = (u32x2*)(XB + (size_t)m * DM) + lane;
#pragma unroll
            for (int j = 0; j < 4; ++j) { xr[64 * j] = v[j]; u32x2 w; w.x = pk2(v[j].x * rstd, v[j].y * rstd); w.y = pk2(v[j].z * rstd, v[j].w * rstd); o8[64 * j] = w; }
        } else {
            f32x4* orow = (f32x4*)(F.out + (size_t)m * DM) + lane;
#pragma unroll
            for (int j = 0; j < 4; ++j) { const f32x4 gg = *((const f32x4*)fg + lane + 64 * j); orow[64 * j] = v[j] * gg * rstd; }
        }
    }
}

__global__ void __launch_bounds__(NTHR, 2) fwd_kernel(Args args) {
    extern __shared__ __attribute__((aligned(16))) unsigned char lds_raw[];
    Frame F; F.lds = (LAS unsigned char*)lds_raw; F.tid = threadIdx.x; F.lane = F.tid & 63; F.wave = __builtin_amdgcn_readfirstlane(F.tid >> 6);
    F.gw = blockIdx.x * NWAVES + F.wave; F.ngw = gridDim.x * NWAVES; F.out = args.out; F.ws = args.ws; F.ka = (const __attribute__((address_space(4))) Args*)__builtin_amdgcn_kernarg_segment_ptr();
    volatile LAS unsigned* MISC = (volatile LAS unsigned*)(F.lds + LDS_MISC);
    if (F.tid < 64) MISC[F.tid] = 0u;
    __syncthreads();
    const int lo = args.ph_lo, hi = args.ph_hi;
    XcdBarrier bar; bar.bar = (unsigned*)(F.ws + WS_CTL) + CW_BAR; bar.x = 0; bar.st = MISC;
    if (hi - lo > 1) bar = xcd_barrier_post((unsigned*)(F.ws + WS_CTL) + CW_BAR, MISC, F.tid == 0);
#define IN(k) (lo <= (k) && (k) < hi)
#define DUP(k) for (int _rep = 0; _rep < ((DUP_PHASE == (k)) ? 2 : 1); ++_rep)
#define SEAM(k) do { if ((k) + 1 < hi) { PHASE_PIN(F); xcd_barrier(bar, F.tid == 0); } } while (0)
    unsigned char* ws = F.ws;
    if (IN(0)) { DUP(0) ph_prologue(F, args); SEAM(0); }
    for (int l = 0; l < 4; ++l) {
        const int pb = 1 + 16 * l, e = l >> 1;
        const float* xsrc = (l == 0) ? args.in[0] : (const float*)(ws + WS_X);
        if ((l & 1) == 0) {
            if (IN(pb + 0)) { PHASE_PIN(F);
                pg8::Gemm g{(const pg8::bf16_t*)(F.ws + WS_XB), (const pg8::bf16_t*)(F.ws + W_WIN) + (size_t)e * NCOL * DM, NT, NCOL, DM}; pg8::StaticOrder S; S.init(NT, NCOL, (int)gridDim.x, (int)blockIdx.x);
                pg8::EpiBf16S E{(pg8::bf16_t*)(F.ws + WS_PROJ), NCOL, 0, 0};
                DUP(11) pg8::gemm_phase<pg8::EpiBf16S, pg8::StaticOrder>(F.lds, g, S, E, nullptr, F.wave);
                SEAM(pb + 0); }
            if (IN(pb + 1)) {
#ifndef NO_PREP
 DUP(1) ph_prep(F, args, e);
#endif
 SEAM(pb + 1); }
            if (IN(pb + 2)) {
#ifndef NO_SCAN
#if CHUNKED
 DUP(2) ph_scan_s1(F);
#else
 DUP(2) ph_scan(F);
#endif
#endif
 SEAM(pb + 2); }
            if (IN(pb + 3)) {
#if CHUNKED
 ph_scan_s2(F);
#endif
#ifndef NO_SCORE
 DUP(3) ph_idx_score(F);
#endif
 SEAM(pb + 3); }
            if (IN(pb + 4)) {
#if CHUNKED
 ph_scan_s3(F, e);
#endif
#ifndef NO_SELECT
 DUP(4) ph_idx_select(F);
#endif
 SEAM(pb + 4); }
            if (IN(pb + 5)) {
#ifndef NO_SPARSE
 DUP(5) ph_sparse(F, e);
#endif
 SEAM(pb + 5); }
            if (IN(pb + 6)) { DUP(13) ph_mix_finish(F, e); SEAM(pb + 6); }
        } else {
            if (IN(pb + 0)) { PHASE_PIN(F);
                pg8::Gemm g{(const pg8::bf16_t*)(F.ws + WS_XB), (const pg8::bf16_t*)(F.ws + W_WQKV) + (size_t)e * 3072 * DM, NT, 3072, DM}; pg8::StaticOrder S; S.init(NT, 3072, (int)gridDim.x, (int)blockIdx.x);
                pg8::EpiBf16S E{(pg8::bf16_t*)(F.ws + WS_PROJ), 1024, 1024, (size_t)NT * 1024};
                DUP(12) pg8::gemm_phase<pg8::EpiBf16S, pg8::StaticOrder>(F.lds, g, S, E, nullptr, F.wave);
                SEAM(pb + 0); }
            if (IN(pb + 1)) {
#ifndef NO_SB
 DUP(6) ph_stickbreak(F);
#endif
 SEAM(pb + 1); }
        }
        if (IN(pb + 7)) { PHASE_PIN(F);
            pg8::Gemm g{(const pg8::bf16_t*)(F.ws + WS_YCAT), (const pg8::bf16_t*)(F.ws + ((l & 1) ? W_WOUTO : W_WOUTE)) + (size_t)e * DM * DM, NT, DM, DM}; pg8::StaticOrder S; S.init(NT, DM, (int)gridDim.x, (int)blockIdx.x);
            pg8::EpiResid E{xsrc, (float*)(F.ws + WS_X)};
            pg8::gemm_phase<pg8::EpiResid, pg8::StaticOrder>(F.lds, g, S, E, nullptr, F.wave);
            SEAM(pb + 7); }
        if (IN(pb + 8)) {
#ifndef NO_ROUTE
 ph_moe_route(F, args, l); DUP(7) moe_weight_prep(F, args, l);
#endif
 SEAM(pb + 8); }
        if (IN(pb + 9)) { DUP(8) ph_moe_gather(F, l); SEAM(pb + 9); }
        if (IN(pb + 10)) { DUP(9) ph_moe_gemm1(F, l); SEAM(pb + 10); }
        if (IN(pb + 11)) { DUP(10) ph_moe_gemm2(F, l); SEAM(pb + 11); }
        if (IN(pb + 12)) { ph_moe_combine(F, args, l); SEAM(pb + 12); }
    }
#undef IN
#undef SEAM
}

extern "C" void kernel_launch(void* const* d_in, const int* in_sizes, int n_in, void* d_out, int out_size, void* d_ws, size_t ws_size, hipStream_t stream) {
    static int grid = 0;
    if (grid == 0) {
        if (n_in != 36 || out_size != NT * DM || ws_size < WS_END) { fprintf(stderr, "kernel_launch: unexpected problem (n_in %d out %d ws %zu)\n", n_in, out_size, ws_size); grid = -1; return; }
        int dev = 0, cus = 0, per_cu = 0;
        if (hipGetDevice(&dev) != hipSuccess || hipDeviceGetAttribute(&cus, hipDeviceAttributeMultiprocessorCount, dev) != hipSuccess) { grid = -1; return; }
        if (hipFuncSetAttribute((const void*)fwd_kernel, hipFuncAttributeMaxDynamicSharedMemorySize, LDS_BYTES) != hipSuccess) { grid = -1; return; }
        if (hipOccupancyMaxActiveBlocksPerMultiprocessor(&per_cu, (const void*)fwd_kernel, NTHR, LDS_BYTES) != hipSuccess || per_cu < 1) { fprintf(stderr, "kernel_launch: occupancy query says %d\n", per_cu); }
        (void)hipGetLastError();
        grid = cus;
    }
    if (grid < 0) return;
    (void)hipMemsetAsync((char*)d_ws + WS_CTL, 0, CTL_ZERO_BYTES, stream);
    Args a{};
    for (int i = 0; i < 36; ++i) a.in[i] = (const float*)d_in[i];
    a.out = (float*)d_out; a.ws = (unsigned char*)d_ws;
#if ONE_LAUNCH
    a.ph_lo = 0; a.ph_hi = 65;
    hipLaunchKernelGGL(fwd_kernel, dim3(grid), dim3(NTHR), LDS_BYTES, stream, a);
#else
    for (int p = 0; p < 65; ++p) {
        const int l = (p - 1) >> 4, k = (p - 1) & 15;
        if (p > 0) { if (k > 12) continue; if ((l & 1) && k >= 2 && k <= 6) continue; }
        a.ph_lo = p; a.ph_hi = p + 1;
        hipLaunchKernelGGL(fwd_kernel, dim3(grid), dim3(NTHR), LDS_BYTES, stream, a);
    }
#endif
}
```

```cpp
#include <hip/hip_runtime.h>
#include <cstdio>
#include <cstdint>

#ifndef DUP_PHASE
#define DUP_PHASE -1
#endif
#ifndef CHUNKED
#define CHUNKED 1
#endif
#ifndef ONE_LAUNCH
#define ONE_LAUNCH 1
#endif

#define GAS __attribute__((address_space(1)))
#define LAS __attribute__((address_space(3)))
typedef unsigned short bf16_t;
typedef short bf16x8 __attribute__((ext_vector_type(8)));
typedef float f32x4 __attribute__((ext_vector_type(4)));
typedef float f32x2 __attribute__((ext_vector_type(2)));
typedef float f32x16 __attribute__((ext_vector_type(16)));
typedef unsigned u32x4 __attribute__((ext_vector_type(4)));
typedef unsigned u32x2 __attribute__((ext_vector_type(2)));

constexpr int NT = 16384, TT = 8192, DM = 1024, NB = 2;
constexpr int NCOL = 3584;
constexpr int C_R = 0, C_K = 512, C_V = 1024, C_QB = 1536, C_CKV = 2048, C_QI = 2176, C_KI = 2688, C_WI = 2752;
constexpr int C_PW = 2816, C_QW = 2880, C_PA = 2944, C_QA = 3008, C_PG = 3072, C_QG = 3200, C_PV = 3328, C_QV = 3360;
constexpr int NWAVES = 8, NTHR = 512;
constexpr float RMS_EPS = 1e-6f, GN_EPS = 64e-5f;
constexpr float LOG2E = 1.4426950408889634f;

constexpr size_t MiB = 1u << 20;
constexpr size_t WS_CTL = 0, CTL_ZERO_BYTES = 1 * MiB;
constexpr size_t WS_SMALL = 1 * MiB;
constexpr size_t SM_EIDX = WS_SMALL, SM_GATE = WS_SMALL + 128 * 1024, SM_SLOT = WS_SMALL + 256 * 1024, SM_BONUS = WS_SMALL + 512 * 1024, SM_SGN = WS_SMALL + 1024 * 1024;
constexpr size_t WS_W = 5 * MiB;
constexpr size_t W_WIN = WS_W, W_WOUTE = WS_W + 14 * MiB, W_WQKV = WS_W + 18 * MiB, W_WOUTO = WS_W + 30 * MiB, W_WKB = WS_W + 34 * MiB, W_WVT = W_WKB + 256 * 1024, W_L2 = W_WKB + 512 * 1024;
constexpr size_t WS_X = 45 * MiB, WS_XB = 109 * MiB, WS_PROJ = 141 * MiB, WS_SIN = 253 * MiB, WS_VF = 445 * MiB, WS_Y = 477 * MiB, WS_GATE = 509 * MiB, WS_YCAT = 541 * MiB;
constexpr size_t WS_CN = 573 * MiB, WS_KI = 577 * MiB, WS_QI = 579 * MiB, WS_QA = 595 * MiB, WS_SEL = 627 * MiB;
constexpr size_t WS_BIG = 645 * MiB;
constexpr size_t WS_SCORE = WS_BIG;
constexpr size_t WS_W13T = WS_BIG, WS_W2T = WS_BIG + 64 * MiB, WS_AMOE = WS_BIG + 96 * MiB, WS_H = WS_BIG + 176 * MiB, WS_YM = WS_BIG + 216 * MiB;
constexpr size_t WS_END = 941 * MiB;
constexpr size_t SCORE_PER_BATCH = (size_t)16384 * 2080;
static_assert(WS_SCORE + 2 * SCORE_PER_BATCH * 4 <= WS_END, "score map");
static_assert(WS_YM + (size_t)40960 * 1024 * 2 <= WS_END, "moe map");
constexpr int CW_BAR = 4096;
constexpr int CW_CNT = 16384;

constexpr int LDS_BYTES = 147456;
constexpr int LDS_WSCR = 16384;
constexpr int LDS_MISC = 131072;

__device__ __forceinline__ float bf2f(bf16_t b) { return __uint_as_float(((unsigned)b) << 16); }
typedef __bf16 bf16v2_t __attribute__((ext_vector_type(2)));
__device__ __forceinline__ unsigned pk2(float lo, float hi) { const f32x2 v = {lo, hi}; const bf16v2_t b = __builtin_convertvector(v, bf16v2_t); return __builtin_bit_cast(unsigned, b); }
__device__ __forceinline__ unsigned f2bf(float f) { return pk2(f, f) & 0xffffu; }
__device__ __forceinline__ float wave_sum(float v) {
#pragma unroll
    for (int o = 1; o < 64; o <<= 1) v += __shfl_xor(v, o);
    return v;
}
__device__ __forceinline__ float wave_max(float v) {
#pragma unroll
    for (int o = 1; o < 64; o <<= 1) v = fmaxf(v, __shfl_xor(v, o));
    return v;
}
__device__ __forceinline__ float sigmoidf_(float x) { return 1.0f / (1.0f + __expf(-x)); }
#define LDS_WAIT() asm volatile("s_waitcnt lgkmcnt(0)" ::: "memory")

#define XB_TMO      128
#define XB_XCNT(j)  (256  + 64 * (j))
#define XB_XSUB(j)  (1280 + 64 * (j))
#define XB_XGEN(j)  (2304 + 64 * (j))
#define XB_TOP      3328
#define XB_TOPGEN   3392
#define XCD_BAR_WORDS 3456
#define XB_SPIN_CAP (1u << 18)
__device__ __forceinline__ unsigned xb_ld(unsigned* p)              { return __hip_atomic_load(p, __ATOMIC_RELAXED, __HIP_MEMORY_SCOPE_AGENT); }
__device__ __forceinline__ unsigned xb_add(unsigned* p, unsigned v) { return __hip_atomic_fetch_add(p, v, __ATOMIC_RELAXED, __HIP_MEMORY_SCOPE_AGENT); }
__device__ __forceinline__ unsigned xb_xcc_id() { return (unsigned)__builtin_amdgcn_s_getreg((3 << 11) | 20) & 0xFu; }
#define XB_SPIN(cond, bar) do { unsigned _sp = 0; while (cond) { __builtin_amdgcn_s_sleep(1); \
    if ((++_sp & 255u) == 0u) { if (xb_ld(&(bar)[XB_TMO])) break; if (_sp > XB_SPIN_CAP) { atomicAdd(&(bar)[XB_TMO], 1u); break; } } } } while (0)
struct XcdBarrier { unsigned* bar; unsigned x; volatile LAS unsigned* st; };
__device__ __forceinline__ XcdBarrier xcd_barrier_post(unsigned* bar, volatile LAS unsigned* st, bool t0) {
    XcdBarrier b; b.bar = bar; b.x = xb_xcc_id(); b.st = st;
    if (t0) (void)xb_add(&bar[XB_XCNT(b.x)], 1u);
    return b;
}
__device__ __forceinline__ void xcd_barrier_complete(unsigned* bar, unsigned x, unsigned& nloc, unsigned& nx) {
    const unsigned G = gridDim.x * gridDim.y * gridDim.z;
    unsigned sum, cnt, mine, sp = 0u;
    for (;;) {
        sum = 0u; cnt = 0u; mine = 0u;
#pragma unroll
        for (unsigned j = 0; j < 16; ++j) { const unsigned c = xb_ld(&bar[XB_XCNT(j)]); sum += c; cnt += (c > 0u) ? 1u : 0u; mine = (j == x) ? c : mine; }
        if (sum == G) break;
        __builtin_amdgcn_s_sleep(1);
        if ((++sp & 255u) == 0u) { if (xb_ld(&bar[XB_TMO])) break; if (sp > XB_SPIN_CAP) { atomicAdd(&bar[XB_TMO], 1u); break; } }
    }
    nloc = mine > 0u ? mine : 1u; nx = cnt > 0u ? cnt : 1u;
}
__device__ __forceinline__ void xcd_barrier(const XcdBarrier& b, bool t0) {
    asm volatile("s_waitcnt vmcnt(0)" ::: "memory");
    __syncthreads();
    if (t0) {
        unsigned* bar = b.bar;
        __builtin_amdgcn_s_waitcnt(0);
        unsigned nloc = b.st[0], nx = b.st[1];
        if (nloc == 0u) { xcd_barrier_complete(bar, b.x, nloc, nx); b.st[0] = nloc; b.st[1] = nx; }
        const unsigned old = xb_add(&bar[XB_XSUB(b.x)], 1u);
        const unsigned gen = old / nloc;
        if (old + 1u == (gen + 1u) * nloc) {
            __builtin_amdgcn_fence(__ATOMIC_RELEASE, "agent");
            asm volatile("s_waitcnt vmcnt(0)" ::: "memory");
            const unsigned og = xb_add(&bar[XB_TOP], 1u);
            const unsigned tg = og / nx;
            if (og + 1u == (tg + 1u) * nx) xb_add(&bar[XB_TOPGEN], 1u);
            else XB_SPIN(xb_ld(&bar[XB_TOPGEN]) == tg, bar);
            __builtin_amdgcn_fence(__ATOMIC_ACQUIRE, "agent");
            xb_add(&bar[XB_XGEN(b.x)], 1u);
            asm volatile("s_waitcnt vmcnt(0)" ::: "memory");
        } else {
            XB_SPIN(xb_ld(&bar[XB_XGEN(b.x)]) == gen, bar);
            __builtin_amdgcn_fence(__ATOMIC_ACQUIRE, "agent");
            asm volatile("s_waitcnt vmcnt(0)" ::: "memory");
        }
    }
    __syncthreads();
}

struct Args { const float* in[36]; float* out; unsigned char* ws; int ph_lo, ph_hi; };
struct Frame {
    LAS unsigned char* lds; int tid, lane, wave, gw, ngw;
    float* out; unsigned char* ws;
    const __attribute__((address_space(4))) Args* ka;
};

#define PHASE_PIN(F) do { unsigned long long _z64; int _z32; asm volatile("s_mov_b64 %0, 0\n\ts_mov_b32 %1, 0" : "=s"(_z64), "=s"(_z32)); asm volatile("" : "+v"((F).lane)); \
    (F).ws += _z64; (F).out += _z64; (F).ka = (const __attribute__((address_space(4))) Args*)((const __attribute__((address_space(4))) char*)(F).ka + _z64); \
    (F).gw += _z32; (F).ngw += _z32; (F).wave += _z32; (F).tid = (F).wave * 64 + (F).lane; } while (0)
struct TrJob { const float* W; int K, ldw, col_off, ncols; bf16_t* WT; int ldt, row_off; const float* g; const float* mu; int mode; float cs; };
__device__ __forceinline__ void tr_item(const TrJob& J, int item, LAS float* scr, int lane) {
    const int nblk = (J.ncols + 31) / 32, kb = item / nblk, nb = item % nblk, k0 = 64 * kb, n0 = 32 * nb;
#pragma unroll 8
    for (int i = 0; i < 32; ++i) {
        const int kk = 2 * i + (lane >> 5), n = lane & 31, k = k0 + kk;
        float v = 0.f;
        if (k < J.K && n0 + n < J.ncols) {
            float s = J.cs;
            if (J.g) s *= J.g[k];
            if (J.mode == 1) s *= (1.0f - J.mu[k]); else if (J.mode == 2) s *= J.mu[k];
            v = J.W[(size_t)k * J.ldw + J.col_off + n0 + n] * s;
        }
        scr[kk * 33 + n] = v;
    }
    LDS_WAIT(); asm volatile("" ::: "memory");
    const int c = lane & 7;
#pragma unroll
    for (int j = 0; j < 4; ++j) {
        const int n = (lane >> 3) + 8 * j; const LAS float* s = scr + (8 * c) * 33 + n;
        u32x4 o; o.x = pk2(s[0 * 33], s[1 * 33]); o.y = pk2(s[2 * 33], s[3 * 33]); o.z = pk2(s[4 * 33], s[5 * 33]); o.w = pk2(s[6 * 33], s[7 * 33]);
        if (n0 + n < J.ncols && k0 + 8 * c < J.K) *(u32x4*)(J.WT + (size_t)(J.row_off + n0 + n) * J.ldt + k0 + 8 * c) = o;
    }
    LDS_WAIT(); asm volatile("" ::: "memory");
}
__device__ __forceinline__ void tr_job(Frame& F, const TrJob& J, int rot) {
    LAS float* scr = (LAS float*)(F.lds + F.wave * LDS_WSCR);
    const int nitems = ((J.K + 63) / 64) * ((J.ncols + 31) / 32);
    int start = F.gw - (rot % F.ngw); if (start < 0) start += F.ngw;
    for (int it = start; it < nitems; it += F.ngw) tr_item(J, it, scr, F.lane);
}
__device__ __forceinline__ void zero_rows(Frame& F, bf16_t* WT, int ld, int r0, int r1) {
    const size_t n16 = (size_t)(r1 - r0) * ld / 8; u32x4* p = (u32x4*)(WT + (size_t)r0 * ld);
    for (size_t i = (size_t)F.gw * 64 + F.lane; i < n16; i += (size_t)F.ngw * 64) p[i] = (u32x4){0u, 0u, 0u, 0u};
}
__device__ __forceinline__ void row_norm_to_bf16(const float* xrow, bf16_t* orow, int lane) {
    const f32x4* xr = (const f32x4*)xrow + lane; f32x4 v[4]; float s = 0.f;
#pragma unroll
    for (int j = 0; j < 4; ++j) { v[j] = xr[64 * j]; s += (v[j].x * v[j].x + v[j].y * v[j].y) + (v[j].z * v[j].z + v[j].w * v[j].w); }
    const float rstd = rsqrtf(wave_sum(s) * (1.f / DM) + RMS_EPS);
    u32x2* o8 = (u32x2*)orow + lane;
#pragma unroll
    for (int j = 0; j < 4; ++j) { u32x2 w; w.x = pk2(v[j].x * rstd, v[j].y * rstd); w.y = pk2(v[j].z * rstd, v[j].w * rstd); o8[64 * j] = w; }
}

__device__ __forceinline__ void ph_prologue(Frame& F, const Args& A) {
    PHASE_PIN(F);
    unsigned char* ws = F.ws; int rot = 0;
    for (int e = 0; e < 2; ++e) {
        bf16_t* WT = (bf16_t*)(ws + W_WIN) + (size_t)e * NCOL * DM;
        const float* g = F.ka->in[1] + e * DM; const float* mul = F.ka->in[5] + (size_t)e * 3 * DM;
        TrJob J{F.ka->in[2] + (size_t)e * DM * 2760, DM, 2760, 0, 2760, WT, DM, 0, g, nullptr, 0, 1.0f}; tr_job(F, J, rot); rot += 1392;
        zero_rows(F, WT, DM, 2760, C_PW);
        TrJob Jw1{F.ka->in[7] + (size_t)e * DM * 64, DM, 64, 0, 64, WT, DM, C_PW, g, mul, 1, 1.0f}; tr_job(F, Jw1, rot); rot += 32;
        TrJob Jw2{F.ka->in[7] + (size_t)e * DM * 64, DM, 64, 0, 64, WT, DM, C_QW, g, mul, 2, 1.0f}; tr_job(F, Jw2, rot); rot += 32;
        TrJob Ja1{F.ka->in[10] + (size_t)e * DM * 64, DM, 64, 0, 64, WT, DM, C_PA, g, mul + DM, 1, 1.0f}; tr_job(F, Ja1, rot); rot += 32;
        TrJob Ja2{F.ka->in[10] + (size_t)e * DM * 64, DM, 64, 0, 64, WT, DM, C_QA, g, mul + DM, 2, 1.0f}; tr_job(F, Ja2, rot); rot += 32;
        TrJob Jg1{F.ka->in[12] + (size_t)e * DM * 128, DM, 128, 0, 128, WT, DM, C_PG, g, mul + 2 * DM, 1, 1.0f}; tr_job(F, Jg1, rot); rot += 64;
        TrJob Jg2{F.ka->in[12] + (size_t)e * DM * 128, DM, 128, 0, 128, WT, DM, C_QG, g, mul + 2 * DM, 2, 1.0f}; tr_job(F, Jg2, rot); rot += 64;
        if (e == 1) {
            TrJob Jv1{F.ka->in[21], DM, 32, 0, 32, WT, DM, C_PV, g, F.ka->in[19], 1, 1.0f}; tr_job(F, Jv1, rot); rot += 16;
            TrJob Jv2{F.ka->in[21], DM, 32, 0, 32, WT, DM, C_QV, g, F.ka->in[19], 2, 1.0f}; tr_job(F, Jv2, rot); rot += 16;
            zero_rows(F, WT, DM, C_QV + 32, NCOL);
        } else zero_rows(F, WT, DM, C_PV, NCOL);
        TrJob Jo{F.ka->in[3] + (size_t)e * DM * DM, DM, DM, 0, DM, (bf16_t*)(ws + W_WOUTE) + (size_t)e * DM * DM, DM, 0, nullptr, nullptr, 0, 1.0f}; tr_job(F, Jo, rot); rot += 512;
        { bf16_t* L2W = (bf16_t*)(ws + W_L2) + (size_t)e * (288 * 512);
          TrJob Jl1{F.ka->in[8] + (size_t)e * 64 * 512, 64, 512, 0, 512, L2W, 64, 0, nullptr, nullptr, 0, 1.0f}; tr_job(F, Jl1, rot); rot += 16;
          TrJob Jl2{F.ka->in[11] + (size_t)e * 64 * 512, 64, 512, 0, 512, L2W + 64 * 512, 64, 0, nullptr, nullptr, 0, 1.0f}; tr_job(F, Jl2, rot); rot += 16;
          TrJob Jl3{F.ka->in[13] + (size_t)e * 128 * 512, 128, 512, 0, 512, L2W + 128 * 512, 128, 0, nullptr, nullptr, 0, 1.0f}; tr_job(F, Jl3, rot); rot += 32;
          if (e == 1) { TrJob Jl4{F.ka->in[22], 32, 512, 0, 512, L2W + 256 * 512, 32, 0, nullptr, nullptr, 0, 1.0f}; tr_job(F, Jl4, rot); rot += 16; } }
        { const float* Wkv = F.ka->in[24] + (size_t)e * 128 * 1024; bf16_t* WkB = (bf16_t*)(ws + W_WKB) + (size_t)e * 8 * 128 * 64;
          for (int i = F.gw * 64 + F.lane; i < 8 * 128 * 64; i += F.ngw * 64) { const int d = i & 63, r = (i >> 6) & 127, h = i >> 13; WkB[i] = (bf16_t)f2bf(Wkv[(size_t)r * 1024 + h * 64 + d]); } }
        TrJob Jv{F.ka->in[24] + (size_t)e * 128 * 1024, 128, 1024, 512, 512, (bf16_t*)(ws + W_WVT) + (size_t)e * 512 * 128, 128, 0, nullptr, nullptr, 0, 1.0f}; tr_job(F, Jv, rot); rot += 32;
    }
    for (int o = 0; o < 2; ++o) {
        const float* g = F.ka->in[26] + o * DM; bf16_t* WT = (bf16_t*)(ws + W_WQKV) + (size_t)o * 3072 * DM;
        TrJob Jq{F.ka->in[27] + (size_t)o * DM * 3072, DM, 3072, 0, 1024, WT, DM, 0, g, nullptr, 0, LOG2E * 0.125f}; tr_job(F, Jq, rot); rot += 512;
        TrJob Jk{F.ka->in[27] + (size_t)o * DM * 3072, DM, 3072, 1024, 2048, WT, DM, 1024, g, nullptr, 0, 1.0f}; tr_job(F, Jk, rot); rot += 1024;
        TrJob Jo{F.ka->in[28] + (size_t)o * DM * DM, DM, DM, 0, DM, (bf16_t*)(ws + W_WOUTO) + (size_t)o * DM * DM, DM, 0, nullptr, nullptr, 0, 1.0f}; tr_job(F, Jo, rot); rot += 512;
    }
    for (int m = F.gw; m < NT; m += F.ngw) row_norm_to_bf16(F.ka->in[0] + (size_t)m * DM, (bf16_t*)(ws + WS_XB) + (size_t)m * DM, F.lane);
}

struct MwJob { const float* src; const float* gk; bf16_t* dst; int ldw, ldt; };
__device__ __forceinline__ MwJob mw_job(int it, const float* w1, const float* w3, const float* w2, const float* g, bf16_t* W13T, bf16_t* W2T, int lane) {
    MwJob J;
    if (it < 16384) { const int job = it >> 6, item = it & 63, which = job & 1, j = (job >> 1) & 3, e = job >> 3, k0 = 64 * (item >> 2), n0 = 32 * (item & 3);
        J.src = (which ? w3 : w1) + (size_t)e * DM * 512 + (size_t)(k0 + (lane >> 5)) * 512 + 128 * j + n0 + (lane & 31); J.ldw = 512; J.gk = g + k0 + (lane >> 5);
        J.dst = W13T + (size_t)(e * 1024 + 256 * j + 128 * which + n0 + (lane >> 3)) * DM + k0 + 8 * (lane & 7); J.ldt = DM; }
    else { const int it2 = it - 16384, e = it2 >> 8, item = it2 & 255, k0 = 64 * (item >> 5), n0 = 32 * (item & 31);
        J.src = w2 + (size_t)e * 512 * DM + (size_t)(k0 + (lane >> 5)) * DM + n0 + (lane & 31); J.ldw = DM; J.gk = nullptr;
        J.dst = W2T + (size_t)(e * 1024 + n0 + (lane >> 3)) * 512 + k0 + 8 * (lane & 7); J.ldt = 512; }
    return J;
}
__device__ __forceinline__ void mw_load(const MwJob& J, float (&v)[32]) {
#pragma unroll
    for (int i = 0; i < 32; ++i) { float x = J.src[(size_t)(2 * i) * J.ldw]; if (J.gk) x *= J.gk[2 * i]; v[i] = x; }
}
__device__ __forceinline__ void mw_finish(const MwJob& J, const float (&v)[32], LAS float* scr, int lane) {
#pragma unroll
    for (int i = 0; i < 32; ++i) scr[(2 * i + (lane >> 5)) * 33 + (lane & 31)] = v[i];
    LDS_WAIT(); asm volatile("" ::: "memory");
    const int c = lane & 7;
#pragma unroll
    for (int j = 0; j < 4; ++j) { const LAS float* sp = scr + (8 * c) * 33 + (lane >> 3) + 8 * j;
        u32x4 o; o.x = pk2(sp[0 * 33], sp[1 * 33]); o.y = pk2(sp[2 * 33], sp[3 * 33]); o.z = pk2(sp[4 * 33], sp[5 * 33]); o.w = pk2(sp[6 * 33], sp[7 * 33]);
        *(u32x4*)(J.dst + (size_t)(8 * j) * J.ldt) = o; }
    LDS_WAIT(); asm volatile("" ::: "memory");
}
__device__ __forceinline__ void moe_weight_prep(Frame& F, const Args& A, int l) {
    PHASE_PIN(F);
    LAS float* scr = (LAS float*)(F.lds + F.wave * LDS_WSCR); const int lane = F.lane;
    const float* g = F.ka->in[29] + l * DM;
    const float* w1 = F.ka->in[32] + (size_t)l * 32 * DM * 512; const float* w3 = F.ka->in[33] + (size_t)l * 32 * DM * 512; const float* w2 = F.ka->in[34] + (size_t)l * 32 * 512 * DM;
    bf16_t* W13T = (bf16_t*)(F.ws + WS_W13T); bf16_t* W2T = (bf16_t*)(F.ws + WS_W2T);
    float va[32], vb[32];
    int it = F.gw;
    if (it >= 24576) return;
    MwJob Ja = mw_job(it, w1, w3, w2, g, W13T, W2T, lane), Jb = Ja; mw_load(Ja, va);
    for (;;) {
        const int itb = it + F.ngw; const bool hb = itb < 24576;
        if (hb) { Jb = mw_job(itb, w1, w3, w2, g, W13T, W2T, lane); mw_load(Jb, vb); }
        mw_finish(Ja, va, scr, lane);
        if (!hb) break;
        const int ita = itb + F.ngw; const bool ha = ita < 24576;
        if (ha) { Ja = mw_job(ita, w1, w3, w2, g, W13T, W2T, lane); mw_load(Ja, va); }
        mw_finish(Jb, vb, scr, lane);
        if (!ha) break;
        it = ita;
    }
}

#define MFMA32(a, b, c) __builtin_amdgcn_mfma_f32_32x32x16_bf16((a), (b), (c), 0, 0, 0)
template <class Epi>
__device__ __forceinline__ void sg_tile(const bf16_t* A, int lda, const bf16_t* B0, const bf16_t* B1, int ldb, int K, int m0, const Epi& epi, int lane) {
    const int r = lane & 31, h = lane >> 5;
    const bf16_t* a0 = A + (size_t)(m0 + r) * lda + 8 * h; const bf16_t* a1 = a0 + (size_t)32 * lda;
    const bf16_t* b0 = B0 + (size_t)r * ldb + 8 * h; const bf16_t* b1 = B1 + (size_t)r * ldb + 8 * h;
    f32x16 c00, c01, c10, c11;
#pragma unroll
    for (int i = 0; i < 16; ++i) { c00[i] = 0.f; c01[i] = 0.f; c10[i] = 0.f; c11[i] = 0.f; }
#pragma unroll 4
    for (int k = 0; k < K; k += 16) {
        const bf16x8 fa0 = *(const bf16x8*)(a0 + k), fa1 = *(const bf16x8*)(a1 + k), fb0 = *(const bf16x8*)(b0 + k), fb1 = *(const bf16x8*)(b1 + k);
        c00 = MFMA32(fb0, fa0, c00); c01 = MFMA32(fb1, fa0, c01); c10 = MFMA32(fb0, fa1, c10); c11 = MFMA32(fb1, fa1, c11);
    }
#pragma unroll
    for (int g = 0; g < 4; ++g) {
        const int j = 8 * g + 4 * h;
        epi.pair(m0 + r, j, (f32x4){c00[4 * g], c00[4 * g + 1], c00[4 * g + 2], c00[4 * g + 3]}, (f32x4){c01[4 * g], c01[4 * g + 1], c01[4 * g + 2], c01[4 * g + 3]});
        epi.pair(m0 + 32 + r, j, (f32x4){c10[4 * g], c10[4 * g + 1], c10[4 * g + 2], c10[4 * g + 3]}, (f32x4){c11[4 * g], c11[4 * g + 1], c11[4 * g + 2], c11[4 * g + 3]});
    }
}
struct EpiStoreBf16 {
    bf16_t* O; int ldo, n0, n1;
    __device__ __forceinline__ void pair(int row, int j, f32x4 v0, f32x4 v1) const {
        u32x2 w; w.x = pk2(v0.x, v0.y); w.y = pk2(v0.z, v0.w); *(u32x2*)(O + (size_t)row * ldo + n0 + j) = w;
        w.x = pk2(v1.x, v1.y); w.y = pk2(v1.z, v1.w); *(u32x2*)(O + (size_t)row * ldo + n1 + j) = w;
    }
};
struct EpiResidF32 {
    const float* S; float* X; int n0, n1;
    __device__ __forceinline__ void pair(int row, int j, f32x4 v0, f32x4 v1) const {
        const size_t o0 = (size_t)row * DM + n0 + j, o1 = (size_t)row * DM + n1 + j;
        *(f32x4*)(X + o0) = *(const f32x4*)(S + o0) + v0; *(f32x4*)(X + o1) = *(const f32x4*)(S + o1) + v1;
    }
};
struct EpiGated {
    bf16_t* H; int hc;
    __device__ __forceinline__ void pair(int row, int j, f32x4 a, f32x4 b) const {
        f32x4 o;
#pragma unroll
        for (int i = 0; i < 4; ++i) o[i] = a[i] * sigmoidf_(a[i]) * b[i];
        u32x2 w; w.x = pk2(o.x, o.y); w.y = pk2(o.z, o.w); *(u32x2*)(H + (size_t)row * 512 + hc + j) = w;
    }
};
__device__ __forceinline__ void sg_dense_bf16(Frame& F, const bf16_t* A, int lda, const bf16_t* Bt, int K, int M, int N, bf16_t* O, int ldo) {
    PHASE_PIN(F);
    const int nN = N / 64, ntile = (M / 64) * nN;
    for (int t = F.gw; t < ntile; t += F.ngw) {
        const int mt = t / nN, nt = t % nN; EpiStoreBf16 E{O, ldo, nt * 64, nt * 64 + 32};
        sg_tile(A, lda, Bt + (size_t)(nt * 64) * K, Bt + (size_t)(nt * 64 + 32) * K, K, K, mt * 64, E, F.lane);
    }
}
__device__ __forceinline__ void sg_dense_resid(Frame& F, const bf16_t* A, const bf16_t* Bt, const float* S, float* X) {
    PHASE_PIN(F);
    const int nN = DM / 64, ntile = (NT / 64) * nN;
    for (int t = F.gw; t < ntile; t += F.ngw) {
        const int mt = t / nN, nt = t % nN; EpiResidF32 E{S, X, nt * 64, nt * 64 + 32};
        sg_tile(A, DM, Bt + (size_t)(nt * 64) * DM, Bt + (size_t)(nt * 64 + 32) * DM, DM, DM, mt * 64, E, F.lane);
    }
}

namespace pg8 {
#define PG8_LAS __attribute__((address_space(3)))
typedef unsigned short bf16_t;
typedef short bf16x8 __attribute__((ext_vector_type(8)));
typedef float f32x4 __attribute__((ext_vector_type(4)));
typedef unsigned u32x4 __attribute__((ext_vector_type(4)));
constexpr int BM = 256, BK = 64, HALF = 128, HTB = HALF * BK * 2  , STAGE_BYTES = 8 * HTB, NXCD = 8, WGM = 8;

__host__ __device__ __forceinline__ int lds_byte(int r, int c) { const int st = (r >> 4) * 2 + (c >> 5), rr = r & 15, cc = c & 31, ob = rr * 64 + cc * 2; return st * 1024 + (ob ^ (((ob >> 9) & 1) << 5)); }
__host__ __device__ __forceinline__ void stage_rc(int b, int& R, int& C) { const int st = b / 1024, sb = b % 1024, swz = sb ^ (((sb >> 9) & 1) << 5); R = (st >> 1) * 16 + swz / 64; C = (st & 1) * 32 + (swz % 64) / 2; }
__host__ __device__ __forceinline__ int perm32(int rho) { const int n = rho >> 4, i = rho & 15; return 8 * (i >> 2) + 4 * n + (i & 3); }

struct Unit { int pm, pn; };
struct Gemm { const bf16_t* A; const bf16_t* Bt; int M, N, K; };

struct StaticOrder {
    int nM, nN, nwg, G, c;
    __host__ __device__ void init(int M, int N, int G_, int c_) { nM = M / BM; nN = N / BM; nwg = nM * nN; G = G_; c = c_; }
    __host__ __device__ bool next(int i, Unit& u) const {
        const long L = (long)i * G + c; if (L >= nwg) return false;
        int wgid = (int)L; { const int q = nwg / NXCD, r = nwg % NXCD, xcd = wgid % NXCD, off = wgid / NXCD; wgid = (xcd < r ? xcd * (q + 1) : r * (q + 1) + (xcd - r) * q) + off; }
        const int nig = WGM * nN, gid = wgid / nig, fm = gid * WGM, gsz = (nM - fm) < WGM ? (nM - fm) : WGM;
        u.pm = fm + ((wgid % nig) % gsz); u.pn = (wgid % nig) / gsz; return true;
    }
    __device__ __forceinline__ void a_ready(const Unit&) const {}
    __device__ __forceinline__ void done(const Unit&) const {}
};

__device__ __forceinline__ unsigned cvt_pk_bf16(float lo, float hi) { return ::pk2(lo, hi); }
struct EpiBf16S {
    static constexpr bool PERM = true, AFTER_DRAIN = false;
    bf16_t* O; int ldc; int split_cols; size_t split_stride;
    __device__ __forceinline__ void operator()(const f32x4 (&acc)[2][2][4][2], const Unit& u, int wr, int wc, int fr, int fq) const {
        const int row0 = u.pm * BM + wr * 64 + fr; int colt = u.pn * BM; bf16_t* base = O;
        if (split_cols) { const int t = colt / split_cols; base += (size_t)t * split_stride; colt -= t * split_cols; }
        const int col0 = colt + wc * 32 + 8 * fq;
#pragma unroll
        for (int ai = 0; ai < 2; ++ai)
#pragma unroll
            for (int m = 0; m < 4; ++m) { bf16_t* rowp = base + (size_t)(row0 + ai * HALF + m * 16) * ldc + col0;
#pragma unroll
                for (int bj = 0; bj < 2; ++bj) { const f32x4 v0 = acc[ai][bj][m][0], v1 = acc[ai][bj][m][1];
                    u32x4 w; w.x = cvt_pk_bf16(v0[0], v0[1]); w.y = cvt_pk_bf16(v0[2], v0[3]); w.z = cvt_pk_bf16(v1[0], v1[1]); w.w = cvt_pk_bf16(v1[2], v1[3]);
                    *(u32x4*)(rowp + bj * HALF) = w; } }
    }
};
struct EpiResid {
    static constexpr bool PERM = false, AFTER_DRAIN = false;
    const float* S; float* X;
    __device__ __forceinline__ void operator()(const f32x4 (&acc)[2][2][4][2], const Unit& u, int wr, int wc, int fr, int fq) const {
        const int row0 = u.pm * BM + wr * 64 + fr, col0 = u.pn * BM + wc * 32 + 4 * fq;
#pragma unroll
        for (int ai = 0; ai < 2; ++ai)
#pragma unroll
            for (int m = 0; m < 4; ++m) { const size_t off = (size_t)(row0 + ai * HALF + m * 16) * 1024 + col0;
#pragma unroll
                for (int bj = 0; bj < 2; ++bj)
#pragma unroll
                    for (int n = 0; n < 2; ++n) *(f32x4*)(X + off + bj * HALF + n * 16) = *(const f32x4*)(S + off + bj * HALF + n * 16) + acc[ai][bj][m][n]; }
    }
};
struct EpiGate {
    static constexpr bool PERM = true, AFTER_DRAIN = false;
    bf16_t* H;
    __device__ __forceinline__ void operator()(const f32x4 (&acc)[2][2][4][2], const Unit& u, int wr, int wc, int fr, int fq) const {
        const int row0 = u.pm * BM + wr * 64 + fr, col0 = (u.pn & 3) * 128 + wc * 32 + 8 * fq;
#pragma unroll
        for (int ai = 0; ai < 2; ++ai)
#pragma unroll
            for (int m = 0; m < 4; ++m) { float o[8];
#pragma unroll
                for (int n = 0; n < 2; ++n)
#pragma unroll
                    for (int i = 0; i < 4; ++i) { const float a = acc[ai][0][m][n][i], b = acc[ai][1][m][n][i]; o[4 * n + i] = a * b * __builtin_amdgcn_rcpf(1.0f + __builtin_amdgcn_exp2f(-1.4426950408889634f * a)); }
                u32x4 w; w.x = cvt_pk_bf16(o[0], o[1]); w.y = cvt_pk_bf16(o[2], o[3]); w.z = cvt_pk_bf16(o[4], o[5]); w.w = cvt_pk_bf16(o[6], o[7]);
                *(u32x4*)(H + (size_t)(row0 + ai * HALF + m * 16) * 512 + col0) = w; }
    }
};
struct EpiMoeDown {
    static constexpr bool PERM = true, AFTER_DRAIN = false;
    bf16_t* Y;
    __device__ __forceinline__ void operator()(const f32x4 (&acc)[2][2][4][2], const Unit& u, int wr, int wc, int fr, int fq) const {
        const int row0 = u.pm * BM + wr * 64 + fr, col0 = (u.pn & 3) * BM + wc * 32 + 8 * fq;
#pragma unroll
        for (int ai = 0; ai < 2; ++ai)
#pragma unroll
            for (int m = 0; m < 4; ++m) { bf16_t* rowp = Y + (size_t)(row0 + ai * HALF + m * 16) * 1024 + col0;
#pragma unroll
                for (int bj = 0; bj < 2; ++bj) { const f32x4 v0 = acc[ai][bj][m][0], v1 = acc[ai][bj][m][1];
                    u32x4 w; w.x = cvt_pk_bf16(v0[0], v0[1]); w.y = cvt_pk_bf16(v0[2], v0[3]); w.z = cvt_pk_bf16(v1[0], v1[1]); w.w = cvt_pk_bf16(v1[2], v1[3]);
                    *(u32x4*)(rowp + bj * HALF) = w; } }
    }
};
struct MoeOrder {
    int nunits, G, c; const PG8_LAS int* tab;
    __device__ __forceinline__ bool next(int i, Unit& u) const {
        const int L = i * G + c; if (L >= nunits) return false;
        const int rt = L >> 2; u.pm = rt; u.pn = __builtin_amdgcn_readfirstlane(tab[rt]) * 4 + (L & 3); return true;
    }
    __device__ __forceinline__ void a_ready(const Unit&) const {}
    __device__ __forceinline__ void done(const Unit&) const {}
};
template <class Epi, class Sched, bool STAMP = false>
__device__ __forceinline__ void gemm_phase(PG8_LAS unsigned char* lds, const Gemm g, const Sched& S, const Epi& E, unsigned long long* stamps, const int wid_in) {
    int ln_; asm volatile("v_mbcnt_lo_u32_b32 %0, -1, 0\n\tv_mbcnt_hi_u32_b32 %0, -1, %0" : "=v"(ln_)); const int tid = wid_in * 64 + ln_, wid = wid_in, lane = tid & 63, wr = wid >> 2, wc = wid & 3, fr = lane & 15, fq = lane >> 4;
    const int K = g.K, nt = K / BK;
    int ts_lo = 0, ts_hi = 0, nts = 0; const unsigned long long rt_entry = STAMP ? (unsigned long long)wall_clock64() : 0ull;
#define PG8_STAMP() do { if (STAMP && wid == 0 && nts < 64) { const unsigned long long _c = (unsigned long long)clock64(); \
        ts_lo = (lane == nts) ? (int)(unsigned)_c : ts_lo; ts_hi = (lane == nts) ? (int)(unsigned)(_c >> 32) : ts_hi; ++nts; } } while (0)
    PG8_STAMP();
    unsigned voffA[2], voffB[2];
#pragma unroll
    for (int i = 0; i < 2; ++i) { int R, C; stage_rc(tid * 16 + i * 8192, R, C); const int Rb = Epi::PERM ? ((R & ~31) + perm32(R & 31)) : R;
        voffA[i] = (unsigned)(R * K + C) * 2u; voffB[i] = (unsigned)(Rb * K + C) * 2u; }
    const size_t kstep = (size_t)(BK * 2);
    const size_t hstep = (size_t)HALF * K * 2;
    const size_t tstep = 2 * hstep;
    const unsigned ldsw = (unsigned)wid * 1024u;
    const int aoff = lds_byte(wr * 64 + fr, fq * 8), boff = lds_byte(wc * 32 + fr, fq * 8);
#define PG8_SA(b, h) (((b) * 2 + (h)) * HTB)
#define PG8_SB(b, h) ((4 + (b) * 2 + (h)) * HTB)
#define PG8_STAGE(bufoff, gbase, voff) do { _Pragma("unroll") for (int _i = 0; _i < 2; ++_i) \
        __builtin_amdgcn_global_load_lds((const unsigned*)((const char*)(gbase) + (voff)[_i]), (PG8_LAS unsigned*)(lds + (bufoff) + ldsw + _i * 8192), 16, 0, 0); } while (0)
#define PG8_LDA(dst, b, h) do { _Pragma("unroll") for (int m = 0; m < 4; ++m) _Pragma("unroll") for (int k = 0; k < 2; ++k) dst[m][k] = *(const PG8_LAS bf16x8*)(lds + PG8_SA(b, h) + aoff + m * 2048 + k * 1024); } while (0)
#define PG8_LDB(dst, b, h) do { _Pragma("unroll") for (int n = 0; n < 2; ++n) _Pragma("unroll") for (int k = 0; k < 2; ++k) dst[n][k] = *(const PG8_LAS bf16x8*)(lds + PG8_SB(b, h) + boff + n * 2048 + k * 1024); } while (0)
#define PG8_MMA(ai, bj, At, Bt) do { __builtin_amdgcn_s_setprio(1); _Pragma("unroll") for (int m = 0; m < 4; ++m) _Pragma("unroll") for (int n = 0; n < 2; ++n) _Pragma("unroll") for (int k = 0; k < 2; ++k) \
        acc[ai][bj][m][n] = __builtin_amdgcn_mfma_f32_16x16x32_bf16(Bt[n][k], At[m][k], acc[ai][bj][m][n], 0, 0, 0); __builtin_amdgcn_s_setprio(0); } while (0)
#define PG8_WAIT_V(n) asm volatile("s_waitcnt vmcnt(" #n ")" ::: "memory")
#define PG8_WAIT_L(n) asm volatile("s_waitcnt lgkmcnt(" #n ")" ::: "memory")
#define PG8_BAR __builtin_amdgcn_s_barrier()
#define PG8_SCHED __builtin_amdgcn_sched_barrier(0)
    Unit cur, nxt; int ui = 0;
    if (!S.next(0, cur)) return;
    f32x4 acc[2][2][4][2];
#pragma unroll
    for (int a = 0; a < 2; ++a)
#pragma unroll
        for (int b = 0; b < 2; ++b)
#pragma unroll
            for (int m = 0; m < 4; ++m)
#pragma unroll
                for (int n = 0; n < 2; ++n) acc[a][b][m][n] = (f32x4){0.f, 0.f, 0.f, 0.f};
    bf16x8 At[4][2], B0[2][2], B1[2][2];
    const char* cA = (const char*)g.A + (size_t)cur.pm * tstep; const char* cB = (const char*)g.Bt + (size_t)cur.pn * tstep;
    S.a_ready(cur);
    PG8_STAGE(PG8_SB(0, 0), cB, voffB); PG8_STAGE(PG8_SA(0, 0), cA, voffA); PG8_STAGE(PG8_SB(0, 1), cB + hstep, voffB); PG8_STAGE(PG8_SA(0, 1), cA + hstep, voffA);
    if (wr == 1) PG8_BAR;
    PG8_WAIT_V(4); PG8_BAR;
    PG8_STAGE(PG8_SB(1, 0), cB + kstep, voffB); PG8_STAGE(PG8_SA(1, 0), cA + kstep, voffA); PG8_STAGE(PG8_SB(1, 1), cB + hstep + kstep, voffB);
    PG8_WAIT_V(6); PG8_BAR;
    PG8_STAMP();
    for (;;) {
        const bool has_next = S.next(ui + 1, nxt);
        const char* nA = has_next ? (const char*)g.A + (size_t)nxt.pm * tstep : cA; const char* nB = has_next ? (const char*)g.Bt + (size_t)nxt.pn * tstep : cB;
        for (int t = 0; t < nt; t += 2) {
            const bool last = (t == nt - 2);
            const char* a1 = cA + (size_t)(t + 1) * kstep;
            const char* a2 = last ? nA : cA + (size_t)(t + 2) * kstep; const char* b2 = last ? nB : cB + (size_t)(t + 2) * kstep;
            const char* a3 = a2 + kstep; const char* b3 = b2 + kstep;
            if (last && has_next) S.a_ready(nxt);
            PG8_LDB(B0, 0, 0); PG8_SCHED; PG8_LDA(At, 0, 0); PG8_STAGE(PG8_SA(1, 1), a1 + hstep, voffA);
            PG8_WAIT_L(8); PG8_BAR; PG8_WAIT_L(0); PG8_MMA(0, 0, At, B0); PG8_BAR; PG8_SCHED;
            PG8_LDB(B1, 0, 1); PG8_STAGE(PG8_SB(0, 0), b2, voffB);
            PG8_BAR; PG8_WAIT_L(0); PG8_MMA(0, 1, At, B1); PG8_BAR;
            PG8_LDA(At, 0, 1); PG8_STAGE(PG8_SA(0, 0), a2, voffA);
            PG8_BAR; PG8_WAIT_L(0); PG8_MMA(1, 0, At, B0); PG8_BAR; PG8_SCHED;
            PG8_STAGE(PG8_SB(0, 1), b2 + hstep, voffB);
            PG8_WAIT_V(6); PG8_BAR; PG8_MMA(1, 1, At, B1); PG8_BAR;
            PG8_LDB(B0, 1, 0); PG8_SCHED; PG8_LDA(At, 1, 0); PG8_STAGE(PG8_SA(0, 1), a2 + hstep, voffA);
            PG8_WAIT_L(8); PG8_BAR; PG8_WAIT_L(0); PG8_MMA(0, 0, At, B0); PG8_BAR; PG8_SCHED;
            PG8_LDB(B1, 1, 1); PG8_STAGE(PG8_SB(1, 0), b3, voffB);
            PG8_BAR; PG8_WAIT_L(0); PG8_MMA(0, 1, At, B1); PG8_BAR;
            PG8_LDA(At, 1, 1); PG8_STAGE(PG8_SA(1, 0), a3, voffA);
            PG8_BAR; PG8_WAIT_L(0); PG8_MMA(1, 0, At, B0); PG8_BAR; PG8_SCHED;
            PG8_STAGE(PG8_SB(1, 1), b3 + hstep, voffB);
            PG8_WAIT_V(6); PG8_BAR; PG8_MMA(1, 1, At, B1); PG8_BAR;
        }
        PG8_STAMP();
        if constexpr (!Epi::AFTER_DRAIN) { E(acc, cur, wr, wc, fr, fq); S.done(cur); }
        PG8_STAMP();
        if (!has_next) break;
#pragma unroll
        for (int a = 0; a < 2; ++a)
#pragma unroll
            for (int b = 0; b < 2; ++b)
#pragma unroll
                for (int m = 0; m < 4; ++m)
#pragma unroll
                    for (int n = 0; n < 2; ++n) acc[a][b][m][n] = (f32x4){0.f, 0.f, 0.f, 0.f};
        cur = nxt; cA = nA; cB = nB; ++ui;
    }
    PG8_WAIT_V(0);
    if (wr == 0) PG8_BAR;
    PG8_BAR;
    if constexpr (Epi::AFTER_DRAIN) { E.fused(acc, cur, wr, wc, fr, fq, lds, wid, lane); S.done(cur); }
    PG8_STAMP();
    if (STAMP && wid == 0) { stamps[lane] = lane < nts ? (((unsigned long long)(unsigned)ts_hi << 32) | (unsigned)ts_lo) : 0ull;
        if (lane == 62) stamps[62] = rt_entry; if (lane == 63) stamps[63] = (unsigned long long)wall_clock64(); }
#undef PG8_STAMP
#undef PG8_SA
#undef PG8_SB
#undef PG8_STAGE
#undef PG8_LDA
#undef PG8_LDB
#undef PG8_MMA
#undef PG8_WAIT_V
#undef PG8_WAIT_L
#undef PG8_BAR
#undef PG8_SCHED
}
}

__device__ __forceinline__ f32x4 ld_bf4(const bf16_t* p) { const u32x2 w = *(const u32x2*)p; return (f32x4){__uint_as_float(w.x << 16), __uint_as_float(w.x & 0xffff0000u), __uint_as_float(w.y << 16), __uint_as_float(w.y & 0xffff0000u)}; }
__device__ __forceinline__ float fast_sigmoid(float x) { return __builtin_amdgcn_rcpf(1.0f + __builtin_amdgcn_exp2f(-LOG2E * x)); }
__device__ __forceinline__ float fast_tanh(float x) { return 1.0f - 2.0f * __builtin_amdgcn_rcpf(1.0f + __builtin_amdgcn_exp2f(2.0f * LOG2E * x)); }
__device__ __forceinline__ void ld_pq8(const bf16_t* p, const bf16_t* q, bool hp, float (&o)[8]) {
    const u32x4 a = *(const u32x4*)p; u32x4 b = (u32x4){0u, 0u, 0u, 0u}; if (hp) b = *(const u32x4*)q;
    o[0] = __uint_as_float(a.x << 16) + __uint_as_float(b.x << 16); o[1] = __uint_as_float(a.x & 0xffff0000u) + __uint_as_float(b.x & 0xffff0000u);
    o[2] = __uint_as_float(a.y << 16) + __uint_as_float(b.y << 16); o[3] = __uint_as_float(a.y & 0xffff0000u) + __uint_as_float(b.y & 0xffff0000u);
    o[4] = __uint_as_float(a.z << 16) + __uint_as_float(b.z << 16); o[5] = __uint_as_float(a.z & 0xffff0000u) + __uint_as_float(b.z & 0xffff0000u);
    o[6] = __uint_as_float(a.w << 16) + __uint_as_float(b.w << 16); o[7] = __uint_as_float(a.w & 0xffff0000u) + __uint_as_float(b.w & 0xffff0000u);
}
__device__ __forceinline__ bf16x8 pack8(const float (&o)[8]) { u32x4 w; w.x = pk2(o[0], o[1]); w.y = pk2(o[2], o[3]); w.z = pk2(o[4], o[5]); w.w = pk2(o[6], o[7]); return __builtin_bit_cast(bf16x8, w); }
__device__ __forceinline__ void ph_prep(Frame& F, const Args& A, int e, int parts) {
    PHASE_PIN(F);
    unsigned char* ws = F.ws; const int lane = F.lane;
    const bf16_t* proj = (const bf16_t*)(ws + WS_PROJ);
    const float* mu_rkv = F.ka->in[4] + (size_t)e * 3 * 512;
    const float* w0 = F.ka->in[6] + e * 512; const float* a0 = F.ka->in[9] + e * 512;
    const float* k_k = F.ka->in[14] + e * 512; const float* k_a = F.ka->in[15] + e * 512; const float* r_k = F.ka->in[16] + e * 512;
    const float* v0 = F.ka->in[20];
    const float* kvn = F.ka->in[23] + e * 128; const float* ikn = F.ka->in[25] + e * 64;
    float* SIN = (float*)(ws + WS_SIN); float* VF = (float*)(ws + WS_VF); float* GATE = (float*)(ws + WS_GATE); float* BON = (float*)(ws + SM_BONUS);
    unsigned* SGN = (unsigned*)(ws + SM_SGN);
    bf16_t* CN = (bf16_t*)(ws + WS_CN); bf16_t* KI = (bf16_t*)(ws + WS_KI); bf16_t* QI = (bf16_t*)(ws + WS_QI);
    if (parts & 1)
    for (int m = F.gw; m < NT; m += F.ngw) {
        const bf16_t* pr = proj + (size_t)m * NCOL;
        const float c0 = bf2f(pr[C_CKV + lane]), c1 = bf2f(pr[C_CKV + 64 + lane]);
        const float rs = rsqrtf(wave_sum(c0 * c0 + c1 * c1) * (1.f / 128.f) + RMS_EPS);
        CN[(size_t)m * 128 + lane] = (bf16_t)f2bf(c0 * rs * kvn[lane]); CN[(size_t)m * 128 + 64 + lane] = (bf16_t)f2bf(c1 * rs * kvn[64 + lane]);
        const float ki = bf2f(pr[C_KI + lane]); const float rs2 = rsqrtf(wave_sum(ki * ki) * (1.f / 64.f) + RMS_EPS);
        KI[(size_t)m * 64 + lane] = (bf16_t)f2bf(ki * rs2 * ikn[lane]);
        unsigned sg = 0;
#pragma unroll
        for (int hh = 0; hh < 8; ++hh) { const float w = bf2f(pr[C_WI + hh]); if (w < 0.f) sg |= 1u << hh;
            QI[(size_t)m * 512 + hh * 64 + lane] = (bf16_t)f2bf(fabsf(w) * bf2f(pr[C_QI + hh * 64 + lane])); }
        if (lane == 0) SGN[m] = sg;
    }
    if (parts & 2) { const int r = lane & 31, hf = lane >> 5;
      const bf16_t* L2W = (const bf16_t*)(ws + W_L2) + (size_t)e * (288 * 512);
      const bf16_t* w2T = L2W; const bf16_t* a2T = L2W + 64 * 512; const bf16_t* g2T = L2W + 128 * 512; const bf16_t* v2T = L2W + 256 * 512;
      for (int it = F.gw; it < 512 * 2; it += F.ngw) {
        const int half = it & 1, tile = it >> 1, m = tile * 32 + r, t = m & (TT - 1), b = m >> 13; const bool hp = t > 0;
        const bf16_t* pr = proj + (size_t)m * NCOL; const bf16_t* pp = pr - NCOL;
        bf16x8 fw[4], fa[4], fg[8], fv[2];
#pragma unroll
        for (int ks = 0; ks < 4; ++ks) { float o[8]; ld_pq8(pr + C_PW + 16 * ks + 8 * hf, pp + C_QW + 16 * ks + 8 * hf, hp, o);
#pragma unroll
            for (int j = 0; j < 8; ++j) o[j] = fast_tanh(o[j]);
            fw[ks] = pack8(o);
            ld_pq8(pr + C_PA + 16 * ks + 8 * hf, pp + C_QA + 16 * ks + 8 * hf, hp, o); fa[ks] = pack8(o); }
#pragma unroll
        for (int ks = 0; ks < 8; ++ks) { float o[8]; ld_pq8(pr + C_PG + 16 * ks + 8 * hf, pp + C_QG + 16 * ks + 8 * hf, hp, o);
#pragma unroll
            for (int j = 0; j < 8; ++j) o[j] = fast_sigmoid(o[j]);
            fg[ks] = pack8(o); }
#pragma unroll
        for (int ks = 0; ks < 2; ++ks) { float o[8] = {0.f, 0.f, 0.f, 0.f, 0.f, 0.f, 0.f, 0.f}; if (e == 1) ld_pq8(pr + C_PV + 16 * ks + 8 * hf, pp + C_QV + 16 * ks + 8 * hf, hp, o); fv[ks] = pack8(o); }
#pragma unroll 1
        for (int hq = 0; hq < 4; ++hq) {
        const int hh = 4 * half + hq;
        float ss = 0.f, bon = 0.f;
        float* so = SIN + ((size_t)(b * 8 + hh) * TT + t) * 384;
#pragma unroll
        for (int sub = 0; sub < 2; ++sub)
#pragma unroll
            for (int g = 0; g < 4; ++g) { const int ch4 = hh * 64 + sub * 32 + 8 * g + 4 * hf;
                const f32x4 kk0 = ld_bf4(pr + C_K + ch4); f32x4 kp = (f32x4){0.f, 0.f, 0.f, 0.f}; if (hp) kp = ld_bf4(pp + C_K + ch4);
                const f32x4 mk = *(const f32x4*)(mu_rkv + 512 + ch4), kk4 = *(const f32x4*)(k_k + ch4);
#pragma unroll
                for (int j = 0; j < 4; ++j) { const float kx = (kk0[j] + (kp[j] - kk0[j]) * mk[j]) * kk4[j]; ss += kx * kx; } }
        ss += __shfl_xor(ss, 32);
        const float rn = rsqrtf(fmaxf(ss, 1e-12f));
#pragma unroll 1
        for (int sub = 0; sub < 2; ++sub) {
            const int cb = hh * 64 + sub * 32;
            f32x16 acc;
#pragma unroll
            for (int i = 0; i < 16; ++i) acc[i] = 0.f;
#pragma unroll
            for (int ks = 0; ks < 4; ++ks) acc = MFMA32(*(const bf16x8*)(w2T + (size_t)(cb + r) * 64 + 16 * ks + 8 * hf), fw[ks], acc);
#pragma unroll
            for (int g = 0; g < 4; ++g) { const int ch4 = cb + 8 * g + 4 * hf; const f32x4 b0 = *(const f32x4*)(w0 + ch4); f32x4 d;
#pragma unroll
                for (int j = 0; j < 4; ++j) d[j] = __builtin_amdgcn_exp2f(-0.6065306597126334f * LOG2E * fast_sigmoid(b0[j] + acc[4 * g + j]));
                *(f32x4*)(so + 64 + sub * 32 + 8 * g + 4 * hf) = d; }
            float icv[16];
#pragma unroll
            for (int i = 0; i < 16; ++i) acc[i] = 0.f;
#pragma unroll
            for (int ks = 0; ks < 4; ++ks) acc = MFMA32(*(const bf16x8*)(a2T + (size_t)(cb + r) * 64 + 16 * ks + 8 * hf), fa[ks], acc);
#pragma unroll
            for (int g = 0; g < 4; ++g) { const int ch4 = cb + 8 * g + 4 * hf; const f32x4 b0 = *(const f32x4*)(a0 + ch4);
#pragma unroll
                for (int j = 0; j < 4; ++j) icv[4 * g + j] = fast_sigmoid(b0[j] + acc[4 * g + j]); }
#pragma unroll
            for (int i = 0; i < 16; ++i) acc[i] = 0.f;
#pragma unroll
            for (int ks = 0; ks < 8; ++ks) acc = MFMA32(*(const bf16x8*)(g2T + (size_t)(cb + r) * 128 + 16 * ks + 8 * hf), fg[ks], acc);
#pragma unroll
            for (int g = 0; g < 4; ++g) *(f32x4*)(GATE + (size_t)m * 512 + cb + 8 * g + 4 * hf) = (f32x4){acc[4 * g], acc[4 * g + 1], acc[4 * g + 2], acc[4 * g + 3]};
            if (e == 1) {
#pragma unroll
                for (int i = 0; i < 16; ++i) acc[i] = 0.f;
#pragma unroll
                for (int ks = 0; ks < 2; ++ks) acc = MFMA32(*(const bf16x8*)(v2T + (size_t)(cb + r) * 32 + 16 * ks + 8 * hf), fv[ks], acc);
            }
#pragma unroll
            for (int g = 0; g < 4; ++g) {
                const int ch4 = cb + 8 * g + 4 * hf;
                const f32x4 rr = ld_bf4(pr + C_R + ch4), kk0 = ld_bf4(pr + C_K + ch4), vv = ld_bf4(pr + C_V + ch4);
                f32x4 rp = (f32x4){0.f, 0.f, 0.f, 0.f}, kp = rp, vp = rp;
                if (hp) { rp = ld_bf4(pp + C_R + ch4); kp = ld_bf4(pp + C_K + ch4); vp = ld_bf4(pp + C_V + ch4); }
                const f32x4 mr = *(const f32x4*)(mu_rkv + ch4), mk = *(const f32x4*)(mu_rkv + 512 + ch4), mv = *(const f32x4*)(mu_rkv + 1024 + ch4);
                const f32x4 kk4 = *(const f32x4*)(k_k + ch4), ka4 = *(const f32x4*)(k_a + ch4), rk4 = *(const f32x4*)(r_k + ch4);
                const f32x4 r1 = rr + (rp - rr) * mr, k1 = kk0 + (kp - kk0) * mk; f32x4 v1 = vv + (vp - vv) * mv;
                if (e == 1) { const f32x4 vb = *(const f32x4*)(v0 + ch4), vf = *(const f32x4*)(VF + (size_t)m * 512 + ch4);
#pragma unroll
                    for (int j = 0; j < 4; ++j) v1[j] = v1[j] + (vf[j] - v1[j]) * fast_sigmoid(vb[j] + acc[4 * g + j]); }
                else *(f32x4*)(VF + (size_t)m * 512 + ch4) = v1;
                f32x4 km, kn, bb;
#pragma unroll
                for (int j = 0; j < 4; ++j) { kn[j] = k1[j] * kk4[j] * rn; bb[j] = icv[4 * g + j] * kn[j];
                    km[j] = k1[j] * (1.0f + (icv[4 * g + j] - 1.0f) * ka4[j]); bon += r1[j] * km[j] * rk4[j]; }
                *(f32x4*)(so + sub * 32 + 8 * g + 4 * hf) = r1; *(f32x4*)(so + 128 + sub * 32 + 8 * g + 4 * hf) = km; *(f32x4*)(so + 320 + sub * 32 + 8 * g + 4 * hf) = v1;
                *(f32x4*)(so + 192 + sub * 32 + 8 * g + 4 * hf) = kn; *(f32x4*)(so + 256 + sub * 32 + 8 * g + 4 * hf) = bb;
                asm volatile("" ::: "memory");
            }
        }
        bon += __shfl_xor(bon, 32);
        if (hf == 0) BON[m * 8 + hh] = bon;
        }
      } }
    if (parts & 4) { bf16_t* QA = (bf16_t*)(ws + WS_QA); const bf16_t* WkB = (const bf16_t*)(ws + W_WKB) + (size_t)e * 8 * 128 * 64;
      const int ntile = (NT / 64) * 2 * 8;
      for (int tI = F.gw; tI < ntile; tI += F.ngw) {
          const int hh = tI & 7, nt = (tI >> 3) & 1, mt = tI >> 4;
          EpiStoreBf16 E{QA + hh * 128, 1024, nt * 64, nt * 64 + 32};
          sg_tile(proj + C_QB + hh * 64, NCOL, WkB + (size_t)hh * 128 * 64 + (size_t)(nt * 64) * 64, WkB + (size_t)hh * 128 * 64 + (size_t)(nt * 64 + 32) * 64, 64, 64, mt * 64, E, F.lane);
      } }
}

__device__ __forceinline__ float allred16(float x) {
    x += __builtin_bit_cast(float, __builtin_amdgcn_update_dpp(0, __builtin_bit_cast(int, x), 0x128, 0xf, 0xf, false));
    x += __builtin_bit_cast(float, __builtin_amdgcn_update_dpp(0, __builtin_bit_cast(int, x), 0x124, 0xf, 0xf, false));
    x += __builtin_bit_cast(float, __builtin_amdgcn_update_dpp(0, __builtin_bit_cast(int, x), 0x122, 0xf, 0xf, false));
    x += __builtin_bit_cast(float, __builtin_amdgcn_update_dpp(0, __builtin_bit_cast(int, x), 0x121, 0xf, 0xf, false));
    return x;
}
__device__ __forceinline__ void ph_scan(Frame& F) {
    PHASE_PIN(F);
    if (F.wave != 0) return;
    const int lane = F.lane, i = lane >> 4, kq = lane & 15;
    for (int task = blockIdx.x; task < 256; task += gridDim.x) {
        const int bh = task >> 4, rg = task & 15, row = 4 * rg + i, b = bh >> 3, hh = bh & 7;
        const float* sin = (const float*)(F.ws + WS_SIN) + (size_t)bh * TT * 384;
        float* Y = (float*)(F.ws + WS_Y) + (size_t)b * TT * 512 + hh * 64 + row;
        f32x4 R[8], W[8], K[8], KK[8], B[8]; float V[8];
#pragma unroll
        for (int j = 0; j < 8; ++j) { const float* p = sin + (size_t)j * 384; R[j] = *(const f32x4*)(p + 4 * kq); W[j] = *(const f32x4*)(p + 64 + 4 * kq); K[j] = *(const f32x4*)(p + 128 + 4 * kq);
            KK[j] = *(const f32x4*)(p + 192 + 4 * kq); B[j] = *(const f32x4*)(p + 256 + 4 * kq); V[j] = p[320 + row]; }
        float s0 = 0.f, s1 = 0.f, s2 = 0.f, s3 = 0.f;
        for (int t0 = 0; t0 < TT; t0 += 8) {
#pragma unroll
            for (int j = 0; j < 8; ++j) {
                float p = s0 * KK[j].x + s1 * KK[j].y + s2 * KK[j].z + s3 * KK[j].w; p = allred16(p);
                s0 = s0 * W[j].x - p * B[j].x + V[j] * K[j].x; s1 = s1 * W[j].y - p * B[j].y + V[j] * K[j].y;
                s2 = s2 * W[j].z - p * B[j].z + V[j] * K[j].z; s3 = s3 * W[j].w - p * B[j].w + V[j] * K[j].w;
                float y = s0 * R[j].x + s1 * R[j].y + s2 * R[j].z + s3 * R[j].w; y = allred16(y);
                if (kq == 0) Y[(size_t)(t0 + j) * 512] = y;
                if (t0 + j + 8 < TT) { const float* p2 = sin + (size_t)(t0 + j + 8) * 384; R[j] = *(const f32x4*)(p2 + 4 * kq); W[j] = *(const f32x4*)(p2 + 64 + 4 * kq); K[j] = *(const f32x4*)(p2 + 128 + 4 * kq);
                    KK[j] = *(const f32x4*)(p2 + 192 + 4 * kq); B[j] = *(const f32x4*)(p2 + 256 + 4 * kq); V[j] = p2[320 + row]; }
            }
        }
    }
}

constexpr size_t S1_TMP_STRIDE = 131072, S1_OUT_STRIDE = 50176;
constexpr int T_TCK = 0, T_TCB = 8192, T_TCKT = 16384, T_TCR = 24576, T_CTB = 32768, T_CTK = 40960, T_CTV = 49152, T_MAK = 57344, T_AAB = 65536, T_AAK = 73728, T_CTKH = 81920, T_CTU = 90112, T_RHSF = 98304;
constexpr int O_PT = 0, O_RH = 8192, O_G = 16384, O_Y0 = 32768, O_GC = 49152;
static_assert(WS_PROJ + 2048 * S1_OUT_STRIDE <= WS_SIN && WS_BIG + 2048 * S1_TMP_STRIDE <= WS_END, "scan map");
#define STAGE_SYNC() asm volatile("s_waitcnt vmcnt(0) lgkmcnt(0)" ::: "memory")
template <bool TWO>
__device__ __forceinline__ void mm64_acc(const bf16_t* A1, const bf16_t* B1, const bf16_t* A2, const bf16_t* B2, f32x16& c00, f32x16& c01, f32x16& c10, f32x16& c11, int lane) {
    const int r = lane & 31, h = lane >> 5; const int o = r * 64 + 8 * h;
#pragma unroll
    for (int i = 0; i < 16; ++i) { c00[i] = 0.f; c01[i] = 0.f; c10[i] = 0.f; c11[i] = 0.f; }
#pragma unroll
    for (int k = 0; k < 64; k += 16) {
        const bf16x8 fa0 = *(const bf16x8*)(A1 + o + k), fa1 = *(const bf16x8*)(A1 + o + 2048 + k), fb0 = *(const bf16x8*)(B1 + o + k), fb1 = *(const bf16x8*)(B1 + o + 2048 + k);
        c00 = MFMA32(fb0, fa0, c00); c01 = MFMA32(fb1, fa0, c01); c10 = MFMA32(fb0, fa1, c10); c11 = MFMA32(fb1, fa1, c11);
    }
    if (TWO) {
#pragma unroll
        for (int k = 0; k < 64; k += 16) {
            const bf16x8 fa0 = *(const bf16x8*)(A2 + o + k), fa1 = *(const bf16x8*)(A2 + o + 2048 + k), fb0 = *(const bf16x8*)(B2 + o + k), fb1 = *(const bf16x8*)(B2 + o + 2048 + k);
            c00 = MFMA32(fb0, fa0, c00); c01 = MFMA32(fb1, fa0, c01); c10 = MFMA32(fb0, fa1, c10); c11 = MFMA32(fb1, fa1, c11);
        }
    }
}
template <class Epi>
__device__ __forceinline__ void mm64_epi(const Epi& epi, const f32x16& c00, const f32x16& c01, const f32x16& c10, const f32x16& c11, int lane) {
    const int r = lane & 31, h = lane >> 5;
#pragma unroll
    for (int g = 0; g < 4; ++g) { const int j = 8 * g + 4 * h;
        epi.pair(r, j, (f32x4){c00[4 * g], c00[4 * g + 1], c00[4 * g + 2], c00[4 * g + 3]}, (f32x4){c01[4 * g], c01[4 * g + 1], c01[4 * g + 2], c01[4 * g + 3]});
        epi.pair(32 + r, j, (f32x4){c10[4 * g], c10[4 * g + 1], c10[4 * g + 2], c10[4 * g + 3]}, (f32x4){c11[4 * g], c11[4 * g + 1], c11[4 * g + 2], c11[4 * g + 3]}); }
}
__device__ __forceinline__ u32x2 pk4(f32x4 v) { u32x2 w; w.x = pk2(v.x, v.y); w.y = pk2(v.z, v.w); return w; }
struct EpiMaskLds { LAS float* M; __device__ __forceinline__ void pair(int row, int j, f32x4 v0, f32x4 v1) const {
    f32x4 a, b;
#pragma unroll
    for (int q = 0; q < 4; ++q) { a[q] = (j + q < row) ? v0[q] : 0.f; b[q] = (32 + j + q < row) ? v1[q] : 0.f; }
    *(LAS f32x4*)(M + row * 64 + j) = a; *(LAS f32x4*)(M + row * 64 + 32 + j) = b; } };
template <int INCL> struct EpiMaskBf { bf16_t* O; __device__ __forceinline__ void pair(int row, int j, f32x4 v0, f32x4 v1) const {
    f32x4 a, b;
#pragma unroll
    for (int q = 0; q < 4; ++q) { a[q] = (j + q < row + INCL) ? v0[q] : 0.f; b[q] = (32 + j + q < row + INCL) ? v1[q] : 0.f; }
    *(u32x2*)(O + row * 64 + j) = pk4(a); *(u32x2*)(O + row * 64 + 32 + j) = pk4(b); } };
struct EpiF32 { float* O; __device__ __forceinline__ void pair(int row, int j, f32x4 v0, f32x4 v1) const { *(f32x4*)(O + row * 64 + j) = v0; *(f32x4*)(O + row * 64 + 32 + j) = v1; } };
struct EpiRhat { const bf16_t* R; bf16_t* O; __device__ __forceinline__ void pair(int row, int j, f32x4 v0, f32x4 v1) const {
    *(u32x2*)(O + row * 64 + j) = pk4(ld_bf4(R + row * 64 + j) - v0); *(u32x2*)(O + row * 64 + 32 + j) = pk4(ld_bf4(R + row * 64 + 32 + j) - v1); } };
struct EpiPT { const float* gC; bf16_t* O; __device__ __forceinline__ void pair(int row, int j, f32x4 v0, f32x4 v1) const {
    const float gr = gC[row]; f32x4 a, b;
#pragma unroll
    for (int q = 0; q < 4; ++q) { a[q] = gr * (((j + q == row) ? 1.f : 0.f) - v0[q]); b[q] = gr * (((32 + j + q == row) ? 1.f : 0.f) - v1[q]); }
    *(u32x2*)(O + row * 64 + j) = pk4(a); *(u32x2*)(O + row * 64 + 32 + j) = pk4(b); } };
struct EpiGsc { const float* gC; bf16_t* O; __device__ __forceinline__ void pair(int row, int j, f32x4 v0, f32x4 v1) const {
    *(u32x2*)(O + row * 64 + j) = pk4(v0 * *(const f32x4*)(gC + j)); *(u32x2*)(O + row * 64 + 32 + j) = pk4(v1 * *(const f32x4*)(gC + 32 + j)); } };

__device__ __forceinline__ void ph_scan_s1(Frame& F) {
    PHASE_PIN(F);
    if (F.wave >= 4) return;
    const int lane = F.lane; LAS float* Ml = (LAS float*)(F.lds + F.wave * 32768); LAS float* Xl = Ml + 4096;
    for (int item = blockIdx.x * 4 + F.wave; item < 2048; item += gridDim.x * 4) {
        const int bh = item >> 7, chunk = item & 127;
        unsigned char* tmp = F.ws + WS_BIG + (size_t)item * S1_TMP_STRIDE; unsigned char* outp = F.ws + WS_PROJ + (size_t)item * S1_OUT_STRIDE;
        bf16_t* TCk = (bf16_t*)(tmp + T_TCK); bf16_t* TCb = (bf16_t*)(tmp + T_TCB); bf16_t* TCkt = (bf16_t*)(tmp + T_TCKT); bf16_t* TCr = (bf16_t*)(tmp + T_TCR);
        bf16_t* CTb = (bf16_t*)(tmp + T_CTB); bf16_t* CTk = (bf16_t*)(tmp + T_CTK); bf16_t* CTv = (bf16_t*)(tmp + T_CTV);
        bf16_t* MAK = (bf16_t*)(tmp + T_MAK); bf16_t* AAB = (bf16_t*)(tmp + T_AAB); bf16_t* AAK = (bf16_t*)(tmp + T_AAK);
        bf16_t* CTKH = (bf16_t*)(tmp + T_CTKH); bf16_t* CTU = (bf16_t*)(tmp + T_CTU); float* RHSF = (float*)(tmp + T_RHSF);
        bf16_t* PT = (bf16_t*)(outp + O_PT); bf16_t* RH = (bf16_t*)(outp + O_RH); bf16_t* Gm = (bf16_t*)(outp + O_G); float* Y0 = (float*)(outp + O_Y0); float* gC = (float*)(outp + O_GC);
        const float* sin = (const float*)(F.ws + WS_SIN) + ((size_t)bh * TT + chunk * 64) * 384;
#ifndef S1_NO_CT
        { float gam[65]; gam[0] = 1.0f;
#pragma unroll
          for (int i = 0; i < 64; ++i) gam[i + 1] = sin[(size_t)i * 384 + 64 + lane];
#pragma unroll
          for (int i = 0; i < 64; ++i) gam[i + 1] *= gam[i];
#pragma unroll
          for (int blk = 0; blk < 8; ++blk) {
            float bt8[8], kt8[8], v8[8];
#pragma unroll
            for (int el = 0; el < 8; ++el) { const int i = blk * 8 + el; const float* p = sin + (size_t)i * 384;
                const float rr = p[lane], kk = p[128 + lane], ka = p[192 + lane], bb = p[256 + lane], vv = p[320 + lane];
                const float kap = gam[i] * ka; const float g = gam[i + 1]; const float inv = __builtin_amdgcn_rcpf(g); const float bt = bb * inv, kt = kk * inv, rt = rr * g;
                TCk[i * 64 + lane] = (bf16_t)f2bf(kap); TCb[i * 64 + lane] = (bf16_t)f2bf(bt); TCkt[i * 64 + lane] = (bf16_t)f2bf(kt); TCr[i * 64 + lane] = (bf16_t)f2bf(rt);
                RHSF[i * 64 + lane] = kap; bt8[el] = bt; kt8[el] = kt; v8[el] = vv; }
            *(bf16x8*)(CTb + lane * 64 + blk * 8) = pack8(bt8); *(bf16x8*)(CTk + lane * 64 + blk * 8) = pack8(kt8); *(bf16x8*)(CTv + lane * 64 + blk * 8) = pack8(v8);
            asm volatile("" ::: "memory");
          }
          gC[lane] = gam[64]; }
#endif
        STAGE_SYNC();
        f32x16 c00, c01, c10, c11;
        mm64_acc<false>(TCk, TCb, nullptr, nullptr, c00, c01, c10, c11, lane); { EpiMaskLds E{Ml}; mm64_epi(E, c00, c01, c10, c11, lane); }
        mm64_acc<false>(TCk, TCkt, nullptr, nullptr, c00, c01, c10, c11, lane); { EpiMaskBf<0> E{MAK}; mm64_epi(E, c00, c01, c10, c11, lane); }
        STAGE_SYNC();
        mm64_acc<false>(MAK, CTv, nullptr, nullptr, c00, c01, c10, c11, lane); { EpiF32 E{RHSF + 4096}; mm64_epi(E, c00, c01, c10, c11, lane); }
        STAGE_SYNC();
#ifndef S1_NO_SOLVE
#pragma unroll 1
        for (int pass = 0; pass < 2; ++pass) {
#pragma unroll 8
            for (int i = 0; i < 64; ++i) Xl[i * 64 + lane] = RHSF[pass * 4096 + i * 64 + lane];
#pragma unroll 1
            for (int i0 = 0; i0 < 64; i0 += 4) {
                float a0 = Xl[i0 * 64 + lane], a1 = Xl[(i0 + 1) * 64 + lane], a2 = Xl[(i0 + 2) * 64 + lane], a3 = Xl[(i0 + 3) * 64 + lane];
#pragma unroll 2
                for (int j4 = 0; j4 < i0; j4 += 4) {
                    const float x0 = Xl[j4 * 64 + lane], x1 = Xl[(j4 + 1) * 64 + lane], x2 = Xl[(j4 + 2) * 64 + lane], x3 = Xl[(j4 + 3) * 64 + lane];
                    const f32x4 m0 = *(const LAS f32x4*)(Ml + i0 * 64 + j4), m1 = *(const LAS f32x4*)(Ml + (i0 + 1) * 64 + j4), m2 = *(const LAS f32x4*)(Ml + (i0 + 2) * 64 + j4), m3 = *(const LAS f32x4*)(Ml + (i0 + 3) * 64 + j4);
                    a0 -= m0.x * x0 + m0.y * x1 + m0.z * x2 + m0.w * x3; a1 -= m1.x * x0 + m1.y * x1 + m1.z * x2 + m1.w * x3;
                    a2 -= m2.x * x0 + m2.y * x1 + m2.z * x2 + m2.w * x3; a3 -= m3.x * x0 + m3.y * x1 + m3.z * x2 + m3.w * x3;
                }
                const f32x4 d1 = *(const LAS f32x4*)(Ml + (i0 + 1) * 64 + i0), d2 = *(const LAS f32x4*)(Ml + (i0 + 2) * 64 + i0), d3 = *(const LAS f32x4*)(Ml + (i0 + 3) * 64 + i0);
                a1 -= d1.x * a0; a2 -= d2.x * a0 + d2.y * a1; a3 -= d3.x * a0 + d3.y * a1 + d3.z * a2;
                Xl[i0 * 64 + lane] = a0; Xl[(i0 + 1) * 64 + lane] = a1; Xl[(i0 + 2) * 64 + lane] = a2; Xl[(i0 + 3) * 64 + lane] = a3;
            }
            bf16_t* dst = pass ? CTU : CTKH; const float sgn = pass ? -1.0f : 1.0f;
#pragma unroll 1
            for (int blk = 0; blk < 8; ++blk) { float o8[8];
#pragma unroll
                for (int el = 0; el < 8; ++el) o8[el] = sgn * Xl[(blk * 8 + el) * 64 + lane];
                *(bf16x8*)(dst + lane * 64 + blk * 8) = pack8(o8); }
        }
#endif
        mm64_acc<false>(TCr, TCb, nullptr, nullptr, c00, c01, c10, c11, lane); { EpiMaskBf<1> E{AAB}; mm64_epi(E, c00, c01, c10, c11, lane); }
        mm64_acc<false>(TCr, TCkt, nullptr, nullptr, c00, c01, c10, c11, lane); { EpiMaskBf<1> E{AAK}; mm64_epi(E, c00, c01, c10, c11, lane); }
        STAGE_SYNC();
        mm64_acc<false>(AAB, CTKH, nullptr, nullptr, c00, c01, c10, c11, lane); { EpiRhat E{TCr, RH}; mm64_epi(E, c00, c01, c10, c11, lane); }
        mm64_acc<true>(AAB, CTU, AAK, CTv, c00, c01, c10, c11, lane); { EpiF32 E{Y0}; mm64_epi(E, c00, c01, c10, c11, lane); }
        mm64_acc<false>(CTb, CTKH, nullptr, nullptr, c00, c01, c10, c11, lane); { EpiPT E{gC, PT}; mm64_epi(E, c00, c01, c10, c11, lane); }
        mm64_acc<true>(CTU, CTb, CTv, CTk, c00, c01, c10, c11, lane); { EpiGsc E{gC, Gm}; mm64_epi(E, c00, c01, c10, c11, lane); }
        STAGE_SYNC();
    }
}
__device__ __forceinline__ void ph_scan_s2(Frame& F) {
    PHASE_PIN(F);
    if (F.wave != 0 || blockIdx.x >= 32) return;
    const int lane = F.lane, r = lane & 31, hf = lane >> 5; const int bh = blockIdx.x >> 1, vt = blockIdx.x & 1, v = 32 * vt + r;
    bf16_t* SS = (bf16_t*)(F.ws + WS_Y);
    f32x16 acc0, acc1;
#pragma unroll
    for (int i = 0; i < 16; ++i) { acc0[i] = 0.f; acc1[i] = 0.f; }
    u32x2 pt[4][2][4][2]; u32x2 gin[2][2][4];
#define S2_LOADP(buf, chunk) do { const bf16_t* PT_ = (const bf16_t*)(F.ws + WS_PROJ + (size_t)(bh * 128 + (chunk)) * S1_OUT_STRIDE + O_PT); \
        _Pragma("unroll") for (int ni = 0; ni < 2; ++ni) { _Pragma("unroll") for (int s2 = 0; s2 < 4; ++s2) { pt[buf][ni][s2][0] = *(const u32x2*)(PT_ + (32 * ni + r) * 64 + 16 * s2 + 4 * hf); pt[buf][ni][s2][1] = *(const u32x2*)(PT_ + (32 * ni + r) * 64 + 16 * s2 + 8 + 4 * hf); } } } while (0)
#define S2_LOADG(buf, chunk) do { const bf16_t* G_ = (const bf16_t*)(F.ws + WS_PROJ + (size_t)(bh * 128 + (chunk)) * S1_OUT_STRIDE + O_G); \
        _Pragma("unroll") for (int ni = 0; ni < 2; ++ni) { _Pragma("unroll") for (int g = 0; g < 4; ++g) gin[buf][ni][g] = *(const u32x2*)(G_ + v * 64 + 32 * ni + 8 * g + 4 * hf); } } while (0)
#define S2_STEP(pb, gb, chunk) do { bf16_t* so_ = SS + ((size_t)(bh * 128 + (chunk)) * 64 + v) * 64 + 4 * hf; \
        _Pragma("unroll") for (int g = 0; g < 4; ++g) { *(u32x2*)(so_ + 8 * g) = pk4((f32x4){acc0[4 * g], acc0[4 * g + 1], acc0[4 * g + 2], acc0[4 * g + 3]}); *(u32x2*)(so_ + 32 + 8 * g) = pk4((f32x4){acc1[4 * g], acc1[4 * g + 1], acc1[4 * g + 2], acc1[4 * g + 3]}); } \
        bf16x8 sf[4]; { u32x4 w_; \
          w_.x = pk2(acc0[0], acc0[1]); w_.y = pk2(acc0[2], acc0[3]); w_.z = pk2(acc0[4], acc0[5]); w_.w = pk2(acc0[6], acc0[7]); sf[0] = __builtin_bit_cast(bf16x8, w_); \
          w_.x = pk2(acc0[8], acc0[9]); w_.y = pk2(acc0[10], acc0[11]); w_.z = pk2(acc0[12], acc0[13]); w_.w = pk2(acc0[14], acc0[15]); sf[1] = __builtin_bit_cast(bf16x8, w_); \
          w_.x = pk2(acc1[0], acc1[1]); w_.y = pk2(acc1[2], acc1[3]); w_.z = pk2(acc1[4], acc1[5]); w_.w = pk2(acc1[6], acc1[7]); sf[2] = __builtin_bit_cast(bf16x8, w_); \
          w_.x = pk2(acc1[8], acc1[9]); w_.y = pk2(acc1[10], acc1[11]); w_.z = pk2(acc1[12], acc1[13]); w_.w = pk2(acc1[14], acc1[15]); sf[3] = __builtin_bit_cast(bf16x8, w_); } \
        f32x16 n0_, n1_; \
        _Pragma("unroll") for (int q = 0; q < 16; ++q) { n0_[q] = 0.f; n1_[q] = 0.f; } \
        _Pragma("unroll") for (int s2 = 0; s2 < 4; ++s2) { u32x4 a_; a_.x = pt[pb][0][s2][0].x; a_.y = pt[pb][0][s2][0].y; a_.z = pt[pb][0][s2][1].x; a_.w = pt[pb][0][s2][1].y; n0_ = MFMA32(__builtin_bit_cast(bf16x8, a_), sf[s2], n0_); \
            a_.x = pt[pb][1][s2][0].x; a_.y = pt[pb][1][s2][0].y; a_.z = pt[pb][1][s2][1].x; a_.w = pt[pb][1][s2][1].y; n1_ = MFMA32(__builtin_bit_cast(bf16x8, a_), sf[s2], n1_); } \
        _Pragma("unroll") for (int g = 0; g < 4; ++g) { const u32x2 g0_ = gin[gb][0][g], g1_ = gin[gb][1][g]; \
            n0_[4 * g] += __uint_as_float(g0_.x << 16); n0_[4 * g + 1] += __uint_as_float(g0_.x & 0xffff0000u); n0_[4 * g + 2] += __uint_as_float(g0_.y << 16); n0_[4 * g + 3] += __uint_as_float(g0_.y & 0xffff0000u); \
            n1_[4 * g] += __uint_as_float(g1_.x << 16); n1_[4 * g + 1] += __uint_as_float(g1_.x & 0xffff0000u); n1_[4 * g + 2] += __uint_as_float(g1_.y << 16); n1_[4 * g + 3] += __uint_as_float(g1_.y & 0xffff0000u); } \
        acc0 = n0_; acc1 = n1_; } while (0)
    S2_LOADP(0, 0); S2_LOADP(1, 1); S2_LOADP(2, 2); S2_LOADG(0, 0);
    for (int chunk = 0; chunk < 128; chunk += 4) {
        S2_LOADP(3, chunk + 3); S2_LOADG(1, chunk + 1); S2_STEP(0, 0, chunk);
        if (chunk + 4 < 128) S2_LOADP(0, chunk + 4);
        S2_LOADG(0, chunk + 2); S2_STEP(1, 1, chunk + 1);
        if (chunk + 5 < 128) S2_LOADP(1, chunk + 5);
        S2_LOADG(1, chunk + 3); S2_STEP(2, 0, chunk + 2);
        if (chunk + 6 < 128) S2_LOADP(2, chunk + 6);
        if (chunk + 4 < 128) S2_LOADG(0, chunk + 4);
        S2_STEP(3, 1, chunk + 3);
    }
#undef S2_LOADP
#undef S2_LOADG
#undef S2_STEP
}
__device__ __forceinline__ void ph_scan_s3(Frame& F, int e) {
    PHASE_PIN(F);
    const int lane = F.lane, r = lane & 31, hf = lane >> 5;
    const float* ln_g = F.ka->in[17] + e * 512; const float* ln_b = F.ka->in[18] + e * 512;
    const float* GATE = (const float*)(F.ws + WS_GATE); const float* BON = (const float*)(F.ws + SM_BONUS); const float* SIN = (const float*)(F.ws + WS_SIN);
    bf16_t* YC = (bf16_t*)(F.ws + WS_YCAT); const bf16_t* SS = (const bf16_t*)(F.ws + WS_Y);
    for (int item = F.gw; item < 2048; item += F.ngw) {
        const int bh = item >> 7, chunk = item & 127, b = bh >> 3, hh = bh & 7;
        const unsigned char* outp = F.ws + WS_PROJ + (size_t)item * S1_OUT_STRIDE;
        const bf16_t* RH = (const bf16_t*)(outp + O_RH); const float* Y0 = (const float*)(outp + O_Y0);
        f32x16 c[2][2];
        mm64_acc<false>(RH, SS + (size_t)item * 4096, nullptr, nullptr, c[0][0], c[0][1], c[1][0], c[1][1], lane);
#pragma unroll
        for (int mi = 0; mi < 2; ++mi) {
            const int i = 32 * mi + r, t = chunk * 64 + i, m = b * TT + t;
            float s1 = 0.f;
#pragma unroll
            for (int ni = 0; ni < 2; ++ni)
#pragma unroll
                for (int g = 0; g < 4; ++g) { const f32x4 y0 = *(const f32x4*)(Y0 + i * 64 + 32 * ni + 8 * g + 4 * hf);
#pragma unroll
                    for (int q = 0; q < 4; ++q) { c[mi][ni][4 * g + q] += y0[q]; s1 += c[mi][ni][4 * g + q]; } }
            s1 += __shfl_xor(s1, 32); const float mean = s1 * (1.f / 64.f); float s2 = 0.f;
#pragma unroll
            for (int ni = 0; ni < 2; ++ni)
#pragma unroll
                for (int q = 0; q < 16; ++q) { const float d = c[mi][ni][q] - mean; c[mi][ni][q] = d; s2 += d * d; }
            s2 += __shfl_xor(s2, 32); const float rstd = rsqrtf(s2 * (1.f / 64.f) + GN_EPS); const float bon = BON[m * 8 + hh];
            const float* vrow = SIN + ((size_t)bh * TT + t) * 384 + 320;
#pragma unroll
            for (int ni = 0; ni < 2; ++ni)
#pragma unroll
                for (int g = 0; g < 4; ++g) { const int vv = 32 * ni + 8 * g + 4 * hf, ch = hh * 64 + vv;
                    const f32x4 lg = *(const f32x4*)(ln_g + ch), lb = *(const f32x4*)(ln_b + ch), v1 = *(const f32x4*)(vrow + vv), gt = *(const f32x4*)(GATE + (size_t)m * 512 + ch); f32x4 o;
#pragma unroll
                    for (int q = 0; q < 4; ++q) o[q] = (c[mi][ni][4 * g + q] * rstd * lg[q] + lb[q] + bon * v1[q]) * gt[q];
                    *(u32x2*)(YC + (size_t)m * 1024 + ch) = pk4(o); }
        }
    }
}

__device__ __forceinline__ size_t score_row_off(int b, int t) { const int j = t >> 7; return (size_t)b * SCORE_PER_BATCH + (size_t)16384 * (j * (j + 1) / 2) + (size_t)(t & 127) * (128 * (j + 1)); }
__device__ __forceinline__ void ph_idx_score(Frame& F) {
    PHASE_PIN(F);
    const int lane = F.lane, r = lane & 31, h = lane >> 5;
    const bf16_t* QI = (const bf16_t*)(F.ws + WS_QI); const bf16_t* KI = (const bf16_t*)(F.ws + WS_KI); const unsigned* SGN = (const unsigned*)(F.ws + SM_SGN);
    float* SC = (float*)(F.ws + WS_SCORE);
    for (int it = F.gw; it < 4352; it += F.ngw) {
        const int b = it / 2176; int i = it - b * 2176; i = 2175 - i;
        int a = 1; while (8 * a * (a + 1) <= i) ++a;
        const int rem = i - 8 * a * (a - 1), qt = 16 * (a - 1) + rem / a, g = rem % a;
        const int mq = b * TT + qt * 32 + r;
        bf16x8 qf[8][4];
#pragma unroll
        for (int hh = 0; hh < 8; ++hh)
#pragma unroll
            for (int ks = 0; ks < 4; ++ks) qf[hh][ks] = *(const bf16x8*)(QI + (size_t)mq * 512 + hh * 64 + ks * 16 + 8 * h);
        const unsigned sg = SGN[mq];
        float* srow = SC + score_row_off(b, qt * 32 + r);
        const int kt_end = (16 * g + 15 < qt) ? 16 * g + 15 : qt;
        for (int kt = 16 * g; kt <= kt_end; ++kt) {
            const bf16_t* kp = KI + (size_t)(b * TT + kt * 32 + r) * 64 + 8 * h;
            const bf16x8 kf0 = *(const bf16x8*)(kp), kf1 = *(const bf16x8*)(kp + 16), kf2 = *(const bf16x8*)(kp + 32), kf3 = *(const bf16x8*)(kp + 48);
            float sc[16];
#pragma unroll
            for (int q = 0; q < 16; ++q) sc[q] = 0.f;
#pragma unroll
            for (int hh = 0; hh < 8; ++hh) {
                f32x16 acc;
#pragma unroll
                for (int q = 0; q < 16; ++q) acc[q] = 0.f;
                acc = MFMA32(kf0, qf[hh][0], acc); acc = MFMA32(kf1, qf[hh][1], acc); acc = MFMA32(kf2, qf[hh][2], acc); acc = MFMA32(kf3, qf[hh][3], acc);
                const bool neg = (sg >> hh) & 1u;
#pragma unroll
                for (int q = 0; q < 16; ++q) { const float v = fmaxf(acc[q], 0.f); sc[q] = neg ? sc[q] - v : sc[q] + v; }
            }
#pragma unroll
            for (int g4 = 0; g4 < 4; ++g4) *(f32x4*)(srow + kt * 32 + 8 * g4 + 4 * h) = (f32x4){sc[4 * g4], sc[4 * g4 + 1], sc[4 * g4 + 2], sc[4 * g4 + 3]};
        }
    }
}
__device__ __forceinline__ unsigned block_excl_scan(unsigned v, LAS unsigned* scr, int tid, unsigned* total) {
    const int lane = tid & 63, w = tid >> 6; unsigned x = v;
#pragma unroll
    for (int o = 1; o < 64; o <<= 1) { const unsigned y = __shfl_up(x, o); if (lane >= o) x += y; }
    __syncthreads();
    if (lane == 63) scr[w] = x;
    __syncthreads();
    unsigned base = 0, tot = 0;
#pragma unroll
    for (int j = 0; j < 8; ++j) { const unsigned c = scr[j]; if (j < w) base += c; tot += c; }
    *total = tot;
    return base + x - v;
}
__device__ __forceinline__ void ph_idx_select(Frame& F) {
    PHASE_PIN(F);
    const int lane = F.lane;
    LAS unsigned* hist = (LAS unsigned*)(F.lds + F.wave * LDS_WSCR);
    LAS float* cval = (LAS float*)(hist + 2048); LAS int* cidx = (LAS int*)(cval + 1024);
    const float* SC = (const float*)(F.ws + WS_SCORE); int* SEL = (int*)(F.ws + WS_SEL);
    const unsigned long long lt_mask = (1ull << lane) - 1ull;
    for (int m = F.gw; m < NT; m += F.ngw) {
        const int t = m & (TT - 1), b = m >> 13, n = t + 1; int* sel = SEL + (size_t)m * 256;
        if (n <= 256) {
#pragma unroll
            for (int i = 0; i < 4; ++i) sel[lane + 64 * i] = (lane + 64 * i < n) ? lane + 64 * i : -1;
            continue; }
        const float* srow = SC + score_row_off(b, t);
        const int nch = (n + 255) >> 8;
        float lo = INFINITY, hi = -INFINITY;
        for (int c = 0; c < nch; ++c) { const int idx0 = 256 * c + 4 * lane; if (idx0 < n) { const f32x4 v = *(const f32x4*)(srow + idx0);
#pragma unroll
            for (int i = 0; i < 4; ++i) if (idx0 + i < n) { lo = fminf(lo, v[i]); hi = fmaxf(hi, v[i]); } } }
#pragma unroll
        for (int o = 1; o < 64; o <<= 1) { lo = fminf(lo, __shfl_xor(lo, o)); hi = fmaxf(hi, __shfl_xor(hi, o)); }
        unsigned need = 256u, outpos = 0u;
        for (int level = 0; level < 8; ++level) {
            if (!(hi > lo)) {
                for (int c = 0; c < nch && need > 0u; ++c) { const int idx0 = 256 * c + 4 * lane; f32x4 v = (f32x4){0.f, 0.f, 0.f, 0.f}; if (idx0 < n) v = *(const f32x4*)(srow + idx0);
                    bool f[4]; unsigned before = 0, mine = 0;
#pragma unroll
                    for (int i = 0; i < 4; ++i) { f[i] = (idx0 + i < n) && v[i] == lo; before += __popcll(__ballot(f[i]) & lt_mask); }
                    unsigned total = 0;
#pragma unroll
                    for (int i = 0; i < 4; ++i) total += __popcll(__ballot(f[i]));
#pragma unroll
                    for (int i = 0; i < 4; ++i) { if (f[i]) { const unsigned p = before + mine; if (p < need) sel[outpos + p] = idx0 + i; ++mine; } }
                    const unsigned took = total < need ? total : need; outpos += took; need -= took; }
                break;
            }
            const float scale = 2047.0f / (hi - lo);
#pragma unroll
            for (int i = 0; i < 8; ++i) *(LAS u32x4*)(hist + 4 * (lane + 64 * i)) = (u32x4){0u, 0u, 0u, 0u};
            LDS_WAIT(); asm volatile("" ::: "memory");
            for (int c = 0; c < nch; ++c) { const int idx0 = 256 * c + 4 * lane; if (idx0 < n) { const f32x4 v = *(const f32x4*)(srow + idx0);
#pragma unroll
                for (int i = 0; i < 4; ++i) if (idx0 + i < n && v[i] >= lo && v[i] <= hi) { int bq = (int)((v[i] - lo) * scale); bq = bq > 2047 ? 2047 : bq;
                    __hip_atomic_fetch_add(&hist[bq], 1u, __ATOMIC_RELAXED, __HIP_MEMORY_SCOPE_WORKGROUP); } } }
            LDS_WAIT(); asm volatile("" ::: "memory");
            unsigned hv[32], L = 0;
#pragma unroll
            for (int i = 0; i < 8; ++i) { const u32x4 h4 = *(const LAS u32x4*)(hist + 2044 - 32 * lane - 4 * i); hv[4 * i] = h4.w; hv[4 * i + 1] = h4.z; hv[4 * i + 2] = h4.y; hv[4 * i + 3] = h4.x; L += h4.x + h4.y + h4.z + h4.w; }
            unsigned xs = L;
#pragma unroll
            for (int o = 1; o < 64; o <<= 1) { const unsigned y = __shfl_up(xs, o); if (lane >= o) xs += y; }
            unsigned run = xs - L; const bool finder = (run < need && need <= run + L);
            int fb = 0; unsigned fneed = 0, fcnt = 0;
#pragma unroll
            for (int i = 0; i < 32; ++i) { if (run < need && need <= run + hv[i]) { fb = 2047 - 32 * lane - i; fneed = need - run; fcnt = hv[i]; } run += hv[i]; }
            const int fl = __ffsll((long long)__ballot(finder)) - 1;
            const int bstar = __shfl(fb, fl); const unsigned need2 = __shfl(fneed, fl), cnum = __shfl(fcnt, fl);
            const bool listed = cnum <= 1024u;
            float lo2 = INFINITY, hi2 = -INFINITY; unsigned cpos = 0;
            for (int c = 0; c < nch; ++c) { const int idx0 = 256 * c + 4 * lane; f32x4 v = (f32x4){0.f, 0.f, 0.f, 0.f}; if (idx0 < n) v = *(const f32x4*)(srow + idx0);
                bool fg[4], fe[4]; unsigned bg = 0, be = 0, tg = 0, te = 0;
#pragma unroll
                for (int i = 0; i < 4; ++i) { const bool act = (idx0 + i < n) && v[i] >= lo && v[i] <= hi; int bq = (int)((v[i] - lo) * scale); bq = bq > 2047 ? 2047 : bq;
                    fg[i] = act && bq > bstar; fe[i] = act && bq == bstar;
                    const unsigned long long mg = __ballot(fg[i]), me = __ballot(fe[i]); bg += __popcll(mg & lt_mask); be += __popcll(me & lt_mask); tg += __popcll(mg); te += __popcll(me); }
                unsigned mg2 = 0, me2 = 0;
#pragma unroll
                for (int i = 0; i < 4; ++i) {
                    if (fg[i]) { sel[outpos + bg + mg2] = idx0 + i; ++mg2; }
                    if (fe[i]) { lo2 = fminf(lo2, v[i]); hi2 = fmaxf(hi2, v[i]); if (listed) { cval[cpos + be + me2] = v[i]; cidx[cpos + be + me2] = idx0 + i; } ++me2; } }
                outpos += tg; cpos += te; }
            need = need2;
            if (listed) {
                LDS_WAIT(); asm volatile("" ::: "memory");
                for (unsigned i = lane; i < cnum; i += 64) { const float vi = cval[i]; const int ii = cidx[i]; unsigned rank = 0;
                    for (unsigned j = 0; j < cnum; ++j) { const float vj = cval[j]; rank += (vj > vi || (vj == vi && cidx[j] < ii)) ? 1u : 0u; }
                    if (rank < need) sel[outpos + rank] = ii; }
                LDS_WAIT(); asm volatile("" ::: "memory");
                break;
            }
#pragma unroll
            for (int o = 1; o < 64; o <<= 1) { lo2 = fminf(lo2, __shfl_xor(lo2, o)); hi2 = fmaxf(hi2, __shfl_xor(hi2, o)); }
            lo = lo2; hi = hi2;
        }
    }
}

#define MFMA16(a, b, c) __builtin_amdgcn_mfma_f32_16x16x32_bf16((a), (b), (c), 0, 0, 0)
__device__ __forceinline__ void ph_sparse(Frame& F, int e) {
    PHASE_PIN(F);
    const int lane = F.lane, hd = lane & 15, gq = lane >> 4; unsigned char* ws = F.ws;
    LAS unsigned char* Tl = F.lds + F.wave * LDS_WSCR;
    const bf16_t* QA = (const bf16_t*)(ws + WS_QA); bf16_t* CTXo = (bf16_t*)(ws + WS_GATE); const bf16_t* CN = (const bf16_t*)(ws + WS_CN); const int* SEL = (const int*)(ws + WS_SEL);
    for (int m = F.gw; m < NT; m += F.ngw) {
        const int t = m & (TT - 1), b = m >> 13; const int nvalid = (t + 1 < 256) ? t + 1 : 256;
        bf16x8 qf[4];
#pragma unroll
        for (int ks = 0; ks < 4; ++ks) { u32x4 z = (u32x4){0u, 0u, 0u, 0u}; if (hd < 8) z = *(const u32x4*)(QA + (size_t)m * 1024 + hd * 128 + 32 * ks + 8 * gq); qf[ks] = __builtin_bit_cast(bf16x8, z); }
        f32x4 ctx[8];
#pragma unroll
        for (int i = 0; i < 8; ++i) ctx[i] = (f32x4){0.f, 0.f, 0.f, 0.f};
        float mrun = -INFINITY, lsum = 0.f;
        const bf16_t* cbase = CN + (size_t)b * TT * 128;
#pragma unroll 1
        for (int c = 0; c < 4; ++c) {
            if (64 * c >= nvalid) break;
            int sjc = SEL[(size_t)m * 256 + 64 * c + lane]; if (sjc < 0) sjc = 0;
            bf16x8 pc[4][4];
#pragma unroll
            for (int kt = 0; kt < 4; ++kt) { const int s = __shfl(sjc, 16 * kt + hd); const bf16_t* row = cbase + (size_t)s * 128 + 8 * gq;
#pragma unroll
                for (int ks = 0; ks < 4; ++ks) pc[kt][ks] = *(const bf16x8*)(row + 32 * ks); }
            f32x4 d[4];
#pragma unroll
            for (int kt = 0; kt < 4; ++kt) { f32x4 a = (f32x4){0.f, 0.f, 0.f, 0.f};
#pragma unroll
                for (int ks = 0; ks < 4; ++ks) a = MFMA16(pc[kt][ks], qf[ks], a);
#pragma unroll
                for (int q = 0; q < 4; ++q) { const int kidx = 64 * c + 16 * kt + 4 * gq + q; d[kt][q] = (kidx < nvalid) ? a[q] * (0.125f * LOG2E) : -INFINITY; } }
            { LAS unsigned char* wb = Tl + (hd >> 2) * 1024 + (hd & 3) * 2 + gq * 64;
#pragma unroll
              for (int kt = 0; kt < 4; ++kt)
#pragma unroll
                for (int ks = 0; ks < 4; ++ks)
#pragma unroll
                    for (int el = 0; el < 8; ++el) *(LAS bf16_t*)(wb + 4 * kt * 1024 + (32 * ks + el) * 8) = (bf16_t)pc[kt][ks][el]; }
            float mx = fmaxf(fmaxf(fmaxf(d[0][0], d[0][1]), fmaxf(d[0][2], d[0][3])), fmaxf(fmaxf(d[1][0], d[1][1]), fmaxf(d[1][2], d[1][3])));
            mx = fmaxf(mx, fmaxf(fmaxf(fmaxf(d[2][0], d[2][1]), fmaxf(d[2][2], d[2][3])), fmaxf(fmaxf(d[3][0], d[3][1]), fmaxf(d[3][2], d[3][3]))));
            mx = fmaxf(mx, __shfl_xor(mx, 16)); mx = fmaxf(mx, __shfl_xor(mx, 32));
            const float mnew = fmaxf(mrun, mx); const float scale = __builtin_amdgcn_exp2f(mrun - mnew); mrun = mnew;
            float psum = 0.f;
#pragma unroll
            for (int kt = 0; kt < 4; ++kt)
#pragma unroll
                for (int q = 0; q < 4; ++q) { d[kt][q] = __builtin_amdgcn_exp2f(d[kt][q] - mnew); psum += d[kt][q]; }
            lsum = lsum * scale + psum;
#pragma unroll
            for (int i = 0; i < 8; ++i) ctx[i] *= scale;
#pragma unroll
            for (int u = 0; u < 2; ++u) {
                u32x4 pw; pw.x = pk2(d[2 * u][0], d[2 * u][1]); pw.y = pk2(d[2 * u][2], d[2 * u][3]); pw.z = pk2(d[2 * u + 1][0], d[2 * u + 1][1]); pw.w = pk2(d[2 * u + 1][2], d[2 * u + 1][3]);
                const bf16x8 pf = __builtin_bit_cast(bf16x8, pw);
#pragma unroll
                for (int mt = 0; mt < 8; ++mt) { const LAS unsigned char* rb = Tl + gq * 1024 + hd * 8;
                    const u32x2 lo = *(const LAS u32x2*)(rb + (8 * u) * 1024 + 16 * mt * 8);
                    const u32x2 hi = *(const LAS u32x2*)(rb + (8 * u + 4) * 1024 + 16 * mt * 8);
                    u32x4 aw; aw.x = lo.x; aw.y = lo.y; aw.z = hi.x; aw.w = hi.y;
                    ctx[mt] = MFMA16(__builtin_bit_cast(bf16x8, aw), pf, ctx[mt]); }
            }
        }
        lsum += __shfl_xor(lsum, 16); lsum += __shfl_xor(lsum, 32);
        const float inv = 1.0f / lsum;
        if (hd < 8) {
#pragma unroll
            for (int mt = 0; mt < 8; ++mt) { u32x2 w; w.x = pk2(ctx[mt][0] * inv, ctx[mt][1] * inv); w.y = pk2(ctx[mt][2] * inv, ctx[mt][3] * inv);
                *(u32x2*)(CTXo + (size_t)m * 1024 + hd * 128 + 16 * mt + 4 * gq) = w; }
        }
    }
}
__device__ __forceinline__ void ph_mix_finish(Frame& F, int e) {
    PHASE_PIN(F);
    const int lane = F.lane; unsigned char* ws = F.ws;
    bf16_t* YC = (bf16_t*)(ws + WS_YCAT);
    const float* ln_g = F.ka->in[17] + e * 512; const float* ln_b = F.ka->in[18] + e * 512;
    const float* Yr = (const float*)(ws + WS_Y); const float* GATE = (const float*)(ws + WS_GATE); const float* BON = (const float*)(ws + SM_BONUS); const float* SIN = (const float*)(ws + WS_SIN);
#if !CHUNKED
    for (int m = F.gw; m < NT; m += F.ngw) {
        const int t = m & (TT - 1), b = m >> 13;
#pragma unroll 1
        for (int hh = 0; hh < 8; ++hh) {
            const int ch = hh * 64 + lane; const float y = Yr[(size_t)m * 512 + ch];
            const float mean = wave_sum(y) * (1.f / 64.f); const float yc = y - mean; const float var = wave_sum(yc * yc) * (1.f / 64.f);
            const float v1 = SIN[((size_t)(b * 8 + hh) * TT + t) * 384 + 320 + lane];
            const float o = (yc * rsqrtf(var + GN_EPS) * ln_g[ch] + ln_b[ch] + BON[m * 8 + hh] * v1) * GATE[(size_t)m * 512 + ch];
            YC[(size_t)m * 1024 + ch] = (bf16_t)f2bf(o);
        }
    }
#endif
    { const bf16_t* CTX = (const bf16_t*)(ws + WS_GATE); const bf16_t* WvT = (const bf16_t*)(ws + W_WVT) + (size_t)e * 512 * 128;
      for (int tI = F.gw; tI < (NT / 64) * 8; tI += F.ngw) {
          const int hh = tI & 7, mt = tI >> 3;
          EpiStoreBf16 E{YC + 512 + hh * 64, 1024, 0, 32};
          sg_tile(CTX + hh * 128, 1024, WvT + (size_t)(hh * 64) * 128, WvT + (size_t)(hh * 64 + 32) * 128, 128, 128, mt * 64, E, F.lane);
      } }
}

__device__ __forceinline__ void ph_stickbreak(Frame& F) {
    PHASE_PIN(F);
    const int lane = F.lane, r = lane & 31, hf = lane >> 5; unsigned char* ws = F.ws;
    const bf16_t* Q = (const bf16_t*)(ws + WS_PROJ); const bf16_t* Kb = Q + (size_t)NT * 1024; const bf16_t* Vb = Kb + (size_t)NT * 1024;
    bf16_t* YC = (bf16_t*)(ws + WS_YCAT);
    for (int it = F.gw; it < NB * 16 * 256; it += F.ngw) {
        const int qt = it & 255, hh = (it >> 8) & 15, b = it >> 12;
        const int mq = b * TT + qt * 32 + r;
        bf16x8 qf[4];
#pragma unroll
        for (int ks = 0; ks < 4; ++ks) qf[ks] = *(const bf16x8*)(Q + (size_t)mq * 1024 + hh * 64 + ks * 16 + 8 * hf);
        f32x16 o0, o1;
#pragma unroll
        for (int i = 0; i < 16; ++i) { o0[i] = 0.f; o1[i] = 0.f; }
        float P = 1.0f;
        for (int kt = qt; kt >= 0; --kt) {
            const bf16_t* kp = Kb + (size_t)(b * TT + kt * 32 + r) * 1024 + hh * 64 + 8 * hf;
            const bf16x8 kf0 = *(const bf16x8*)(kp), kf1 = *(const bf16x8*)(kp + 16), kf2 = *(const bf16x8*)(kp + 32), kf3 = *(const bf16x8*)(kp + 48);
            const bf16_t* vp = Vb + (size_t)(b * TT + kt * 32 + 4 * hf) * 1024 + hh * 64 + r;
            bf16x8 vf[2][2];
#pragma unroll
            for (int s2 = 0; s2 < 2; ++s2)
#pragma unroll
                for (int j = 0; j < 8; ++j) { const size_t ko = (size_t)(16 * s2 + 8 * (j >> 2) + (j & 3)) * 1024; vf[0][s2][j] = (short)vp[ko]; vf[1][s2][j] = (short)vp[ko + 32]; }
            f32x16 acc;
#pragma unroll
            for (int i = 0; i < 16; ++i) acc[i] = 0.f;
            acc = MFMA32(kf0, qf[0], acc); acc = MFMA32(kf1, qf[1], acc); acc = MFMA32(kf2, qf[2], acc); acc = MFMA32(kf3, qf[3], acc);
            float kp_[16], be[16];
            const bool diag = (kt == qt);
#pragma unroll
            for (int q = 0; q < 16; ++q) {
                const int key = 8 * (q >> 2) + 4 * hf + (q & 3);
                const float e = __builtin_amdgcn_exp2f(acc[q]); float keep = __builtin_amdgcn_rcpf(1.0f + e);
                if (diag && key >= r) keep = 1.0f;
                kp_[q] = keep; be[q] = 1.0f - keep;
            }
            float ls[16], tot[4], oth[4];
#pragma unroll
            for (int g = 0; g < 4; ++g) { ls[4 * g + 3] = 1.0f; ls[4 * g + 2] = kp_[4 * g + 3]; ls[4 * g + 1] = ls[4 * g + 2] * kp_[4 * g + 2]; ls[4 * g] = ls[4 * g + 1] * kp_[4 * g + 1]; tot[g] = ls[4 * g] * kp_[4 * g]; }
#pragma unroll
            for (int g = 0; g < 4; ++g) oth[g] = __shfl_xor(tot[g], 32);
            const float G0 = tot[0] * oth[0], G1 = tot[1] * oth[1], G2 = tot[2] * oth[2], G3 = tot[3] * oth[3];
            float E[4]; E[3] = 1.0f; E[2] = G3; E[1] = G3 * G2; E[0] = E[1] * G1;
            float w[16];
#pragma unroll
            for (int g = 0; g < 4; ++g) { const float mg = E[g] * (hf == 0 ? oth[g] : 1.0f) * P;
#pragma unroll
                for (int j = 0; j < 4; ++j) w[4 * g + j] = be[4 * g + j] * ls[4 * g + j] * mg; }
            P *= E[0] * G0;
            u32x4 w0, w1;
            w0.x = pk2(w[0], w[1]); w0.y = pk2(w[2], w[3]); w0.z = pk2(w[4], w[5]); w0.w = pk2(w[6], w[7]);
            w1.x = pk2(w[8], w[9]); w1.y = pk2(w[10], w[11]); w1.z = pk2(w[12], w[13]); w1.w = pk2(w[14], w[15]);
            const bf16x8 wf0 = __builtin_bit_cast(bf16x8, w0), wf1 = __builtin_bit_cast(bf16x8, w1);
            o0 = MFMA32(vf[0][0], wf0, o0); o0 = MFMA32(vf[0][1], wf1, o0);
            o1 = MFMA32(vf[1][0], wf0, o1); o1 = MFMA32(vf[1][1], wf1, o1);
            if (__ballot(P > 1e-30f) == 0ull) break;
        }
        bf16_t* op = YC + (size_t)mq * 1024 + hh * 64 + 4 * hf;
#pragma unroll
        for (int g = 0; g < 4; ++g) {
            u32x2 a; a.x = pk2(o0[4 * g], o0[4 * g + 1]); a.y = pk2(o0[4 * g + 2], o0[4 * g + 3]); *(u32x2*)(op + 8 * g) = a;
            u32x2 c; c.x = pk2(o1[4 * g], o1[4 * g + 1]); c.y = pk2(o1[4 * g + 2], o1[4 * g + 3]); *(u32x2*)(op + 32 + 8 * g) = c;
        }
    }
}

__device__ __forceinline__ void ph_moe_route(Frame& F, const Args& A, int l, bool claim) {
    PHASE_PIN(F);
    const int lane = F.lane; unsigned char* ws = F.ws;
    const float* X = (const float*)(ws + WS_X); bf16_t* XB = (bf16_t*)(ws + WS_XB);
    const float* g = F.ka->in[29] + l * DM; const float* Wg = F.ka->in[30] + (size_t)l * DM * 4; const float* We = F.ka->in[31] + (size_t)l * 4 * DM * 8;
    int* EIDX = (int*)(ws + SM_EIDX); float* GATEV = (float*)(ws + SM_GATE); int* SLOT = (int*)(ws + SM_SLOT);
    unsigned* cnt = (unsigned*)(ws + WS_CTL) + CW_CNT + 64 * l;
    for (int m = F.gw; m < NT; m += F.ngw) {
        const f32x4* xr = (const f32x4*)(X + (size_t)m * DM) + lane; f32x4 v[4]; float s = 0.f;
#pragma unroll
        for (int j = 0; j < 4; ++j) { v[j] = xr[64 * j]; s += (v[j].x * v[j].x + v[j].y * v[j].y) + (v[j].z * v[j].z + v[j].w * v[j].w); }
        const float rstd = rsqrtf(wave_sum(s) * (1.f / DM) + RMS_EPS);
        u32x2* o8 = (u32x2*)(XB + (size_t)m * DM) + lane;
#pragma unroll
        for (int j = 0; j < 4; ++j) { u32x2 w; w.x = pk2(v[j].x * rstd, v[j].y * rstd); w.y = pk2(v[j].z * rstd, v[j].w * rstd); o8[64 * j] = w; }
#pragma unroll
        for (int j = 0; j < 4; ++j) { const f32x4 gg = *((const f32x4*)g + lane + 64 * j); v[j] = v[j] * gg * rstd; }
        float gl[4] = {0.f, 0.f, 0.f, 0.f};
#pragma unroll
        for (int j = 0; j < 4; ++j)
#pragma unroll
            for (int i = 0; i < 4; ++i) { const int k = 4 * (lane + 64 * j) + i; const f32x4 w = *(const f32x4*)(Wg + (size_t)k * 4); const float xv = v[j][i];
                gl[0] += xv * w.x; gl[1] += xv * w.y; gl[2] += xv * w.z; gl[3] += xv * w.w; }
#pragma unroll
        for (int q = 0; q < 4; ++q) gl[q] = wave_sum(gl[q]);
        int gs = 0; float gm = gl[0];
#pragma unroll
        for (int q = 1; q < 4; ++q) if (gl[q] > gm) { gm = gl[q]; gs = q; }
        float gden = 0.f;
#pragma unroll
        for (int q = 0; q < 4; ++q) gden += __expf(gl[q] - gm);
        const float g_gate = 1.0f / gden;
        const float* Wes = We + (size_t)gs * DM * 8;
        float el[8];
#pragma unroll
        for (int q = 0; q < 8; ++q) el[q] = 0.f;
#pragma unroll
        for (int j = 0; j < 4; ++j)
#pragma unroll
            for (int i = 0; i < 4; ++i) { const int k = 4 * (lane + 64 * j) + i; const f32x4 w0 = *(const f32x4*)(Wes + (size_t)k * 8), w1 = *(const f32x4*)(Wes + (size_t)k * 8 + 4); const float xv = v[j][i];
                el[0] += xv * w0.x; el[1] += xv * w0.y; el[2] += xv * w0.z; el[3] += xv * w0.w; el[4] += xv * w1.x; el[5] += xv * w1.y; el[6] += xv * w1.z; el[7] += xv * w1.w; }
#pragma unroll
        for (int q = 0; q < 8; ++q) el[q] = wave_sum(el[q]);
        int i1 = 0; float m1 = el[0];
#pragma unroll
        for (int q = 1; q < 8; ++q) if (el[q] > m1) { m1 = el[q]; i1 = q; }
        int i2 = -1; float m2 = -INFINITY;
#pragma unroll
        for (int q = 0; q < 8; ++q) if (q != i1 && el[q] > m2) { m2 = el[q]; i2 = q; }
        const float e2 = __expf(m2 - m1); const float ga = g_gate / (1.0f + e2), gb = g_gate * e2 / (1.0f + e2);
        if (lane == 0 && claim) {
            const int ea = gs * 8 + i1, eb = gs * 8 + i2;
            const unsigned sa = atomicAdd(&cnt[ea], 1u), sb = atomicAdd(&cnt[eb], 1u);
            EIDX[2 * m] = ea; EIDX[2 * m + 1] = eb; GATEV[2 * m] = ga; GATEV[2 * m + 1] = gb; SLOT[2 * m] = (int)sa; SLOT[2 * m + 1] = (int)sb;
        }
    }
}
__device__ __forceinline__ int moe_offsets(const unsigned* cnt, int lane, int* total, int* mycnt_pad) {
    const unsigned c = lane < 32 ? __hip_atomic_load(cnt + (lane & 31), __ATOMIC_RELAXED, __HIP_MEMORY_SCOPE_AGENT) : 0u; const int p = (int)((c + 255u) & ~255u);
    int x = p;
#pragma unroll
    for (int o = 1; o < 64; o <<= 1) { const int y = __shfl_up(x, o); if (lane >= o) x += y; }
    *total = __shfl(x, 63); *mycnt_pad = p;
    return x - p;
}
__device__ __forceinline__ void ph_moe_gather(Frame& F, int l) {
    PHASE_PIN(F);
    const int lane = F.lane; unsigned char* ws = F.ws;
    const unsigned* cnt = (const unsigned*)(ws + WS_CTL) + CW_CNT + 64 * l; int total, pad; const int off = moe_offsets(cnt, lane, &total, &pad);
    const int* EIDX = (const int*)(ws + SM_EIDX); const int* SLOT = (const int*)(ws + SM_SLOT);
    const bf16_t* XB = (const bf16_t*)(ws + WS_XB); bf16_t* AM = (bf16_t*)(ws + WS_AMOE);
    for (int a = F.gw; a < NT * 2; a += F.ngw) {
        const int m = a >> 1, e = EIDX[a], row = __shfl(off, e) + SLOT[a];
        const u32x4* src = (const u32x4*)(XB + (size_t)m * DM); u32x4* dst = (u32x4*)(AM + (size_t)row * DM);
        dst[lane] = src[lane]; dst[lane + 64] = src[lane + 64];
    }
}
__device__ __forceinline__ int moe_build_tab(Frame& F, int l) {
    LAS int* tab = (LAS int*)(F.lds + LDS_MISC + 256); LAS int* ends = (LAS int*)(F.lds + LDS_MISC + 1024);
    const unsigned* cnt = (const unsigned*)(F.ws + WS_CTL) + CW_CNT + 64 * l; int total, pad; const int off = moe_offsets(cnt, F.lane, &total, &pad);
    __syncthreads();
    if (F.tid < 32) ends[F.tid] = off + pad;
    __syncthreads();
    for (int rt = F.tid; rt < total / 256; rt += NTHR) { int e = 0; for (int q = 0; q < 32; ++q) e += (ends[q] <= rt * 256) ? 1 : 0; tab[rt] = e; }
    __syncthreads();
    return total;
}
__device__ __forceinline__ void ph_moe_gemm1(Frame& F, int l) {
    PHASE_PIN(F);
    const int total = moe_build_tab(F, l);
    pg8::Gemm g{(const pg8::bf16_t*)(F.ws + WS_AMOE), (const pg8::bf16_t*)(F.ws + WS_W13T), total, 32 * 1024, DM};
    pg8::MoeOrder S{(total / 256) * 4, (int)gridDim.x, (int)blockIdx.x, (const LAS int*)(F.lds + LDS_MISC + 256)};
    pg8::EpiGate E{(pg8::bf16_t*)(F.ws + WS_H)};
    pg8::gemm_phase<pg8::EpiGate, pg8::MoeOrder>(F.lds, g, S, E, nullptr, F.wave);
}
__device__ __forceinline__ void ph_moe_gemm2(Frame& F, int l) {
    PHASE_PIN(F);
    const int total = moe_build_tab(F, l);
    pg8::Gemm g{(const pg8::bf16_t*)(F.ws + WS_H), (const pg8::bf16_t*)(F.ws + WS_W2T), total, 32 * 1024, 512};
    pg8::MoeOrder S{(total / 256) * 4, (int)gridDim.x, (int)blockIdx.x, (const LAS int*)(F.lds + LDS_MISC + 256)};
    pg8::EpiMoeDown E{(pg8::bf16_t*)(F.ws + WS_YM)};
    pg8::gemm_phase<pg8::EpiMoeDown, pg8::MoeOrder>(F.lds, g, S, E, nullptr, F.wave);
}
__device__ __forceinline__ void ph_moe_combine(Frame& F, const Args& A, int l) {
    PHASE_PIN(F);
    const int lane = F.lane; unsigned char* ws = F.ws;
    const unsigned* cnt = (const unsigned*)(ws + WS_CTL) + CW_CNT + 64 * l; int total, pad; const int off = moe_offsets(cnt, lane, &total, &pad);
    const int* EIDX = (const int*)(ws + SM_EIDX); const int* SLOT = (const int*)(ws + SM_SLOT); const float* GATEV = (const float*)(ws + SM_GATE);
    float* X = (float*)(ws + WS_X); bf16_t* XB = (bf16_t*)(ws + WS_XB); const bf16_t* YM = (const bf16_t*)(ws + WS_YM);
    const float* fg = F.ka->in[35];
    for (int m = F.gw; m < NT; m += F.ngw) {
        const int ea = EIDX[2 * m], eb = EIDX[2 * m + 1]; const float ga = GATEV[2 * m], gb = GATEV[2 * m + 1];
        const int ra = __shfl(off, ea) + SLOT[2 * m], rb = __shfl(off, eb) + SLOT[2 * m + 1];
        f32x4* xr = (f32x4*)(X + (size_t)m * DM) + lane; const u32x2* ya = (const u32x2*)(YM + (size_t)ra * DM) + lane; const u32x2* yb = (const u32x2*)(YM + (size_t)rb * DM) + lane;
        f32x4 v[4]; float s = 0.f;
#pragma unroll
        for (int j = 0; j < 4; ++j) { v[j] = xr[64 * j]; const u32x2 a = ya[64 * j], bq = yb[64 * j];
            v[j].x += ga * __uint_as_float(a.x << 16) + gb * __uint_as_float(bq.x << 16); v[j].y += ga * __uint_as_float(a.x & 0xffff0000u) + gb * __uint_as_float(bq.x & 0xffff0000u);
            v[j].z += ga * __uint_as_float(a.y << 16) + gb * __uint_as_float(bq.y << 16); v[j].w += ga * __uint_as_float(a.y & 0xffff0000u) + gb * __uint_as_float(bq.y & 0xffff0000u);
            s += (v[j].x * v[j].x + v[j].y * v[j].y) + (v[j].z * v[j].z + v[j].w * v[j].w); }
        const float rstd = rsqrtf(wave_sum(s) * (1.f / DM) + RMS_EPS);
        if (l < 3) {
            u32x2* o8 = (u32x2*)(XB + (size_t)m * DM) + lane;
#pragma unroll
            for (int j = 0; j < 4; ++j) { xr[64 * j] = v[j]; u32x2 w; w.x = pk2(v[j].x * rstd, v[j].y * rstd); w.y = pk2(v[j].z * rstd, v[j].w * rstd); o8[64 * j] = w; }
        } else {
            f32x4* orow = (f32x4*)(F.out + (size_t)m * DM) + lane;
#pragma unroll
            for (int j = 0; j < 4; ++j) { const f32x4 gg = *((const f32x4*)fg + lane + 64 * j); orow[64 * j] = v[j] * gg * rstd; }
        }
    }
}

__global__ void __launch_bounds__(NTHR, 2) fwd_kernel(Args args) {
    extern __shared__ __attribute__((aligned(16))) unsigned char lds_raw[];
    Frame F; F.lds = (LAS unsigned char*)lds_raw; F.tid = threadIdx.x; F.lane = F.tid & 63; F.wave = __builtin_amdgcn_readfirstlane(F.tid >> 6);
    F.gw = blockIdx.x * NWAVES + F.wave; F.ngw = gridDim.x * NWAVES; F.out = args.out; F.ws = args.ws; F.ka = (const __attribute__((address_space(4))) Args*)__builtin_amdgcn_kernarg_segment_ptr();
    volatile LAS unsigned* MISC = (volatile LAS unsigned*)(F.lds + LDS_MISC);
    if (F.tid < 64) MISC[F.tid] = 0u;
    __syncthreads();
    const int lo = args.ph_lo, hi = args.ph_hi;
    XcdBarrier bar; bar.bar = (unsigned*)(F.ws + WS_CTL) + CW_BAR; bar.x = 0; bar.st = MISC;
    if (hi - lo > 1) bar = xcd_barrier_post((unsigned*)(F.ws + WS_CTL) + CW_BAR, MISC, F.tid == 0);
#define IN(k) (lo <= (k) && (k) < hi)
#define DUP(k) for (int _rep = 0; _rep < ((DUP_PHASE == (k)) ? 2 : 1); ++_rep)
#define SEAM(k) do { if ((k) + 1 < hi) { PHASE_PIN(F); xcd_barrier(bar, F.tid == 0); if (DUP_PHASE == 99) xcd_barrier(bar, F.tid == 0); } } while (0)
    unsigned char* ws = F.ws;
    if (IN(0)) { DUP(0) ph_prologue(F, args); SEAM(0); }
    for (int l = 0; l < 4; ++l) {
        const int pb = 1 + 16 * l, e = l >> 1;
        const float* xsrc = (l == 0) ? args.in[0] : (const float*)(ws + WS_X);
        if ((l & 1) == 0) {
            if (IN(pb + 0)) { PHASE_PIN(F);
                pg8::Gemm g{(const pg8::bf16_t*)(F.ws + WS_XB), (const pg8::bf16_t*)(F.ws + W_WIN) + (size_t)e * NCOL * DM, NT, NCOL, DM}; pg8::StaticOrder S; S.init(NT, NCOL, (int)gridDim.x, (int)blockIdx.x);
                pg8::EpiBf16S E{(pg8::bf16_t*)(F.ws + WS_PROJ), NCOL, 0, 0};
                DUP(11) pg8::gemm_phase<pg8::EpiBf16S, pg8::StaticOrder>(F.lds, g, S, E, nullptr, F.wave);
                SEAM(pb + 0); }
            if (IN(pb + 1)) {
#ifndef NO_PREP
 ph_prep(F, args, e, 7); if (DUP_PHASE >= 20 && DUP_PHASE < 28) ph_prep(F, args, e, DUP_PHASE - 20);
#endif
 SEAM(pb + 1); }
            if (IN(pb + 2)) {
#ifndef NO_SCAN
#if CHUNKED
 DUP(2) ph_scan_s1(F);
#else
 DUP(2) ph_scan(F);
#endif
#endif
 SEAM(pb + 2); }
            if (IN(pb + 3)) {
#if CHUNKED
 DUP(14) ph_scan_s2(F);
#endif
#ifndef NO_SCORE
 DUP(3) ph_idx_score(F);
#endif
 SEAM(pb + 3); }
            if (IN(pb + 4)) {
#if CHUNKED
 DUP(15) ph_scan_s3(F, e);
#endif
#ifndef NO_SELECT
 DUP(4) ph_idx_select(F);
#endif
 SEAM(pb + 4); }
            if (IN(pb + 5)) {
#ifndef NO_SPARSE
 DUP(5) ph_sparse(F, e);
#endif
 SEAM(pb + 5); }
            if (IN(pb + 6)) { DUP(13) ph_mix_finish(F, e); SEAM(pb + 6); }
        } else {
            if (IN(pb + 0)) { PHASE_PIN(F);
                pg8::Gemm g{(const pg8::bf16_t*)(F.ws + WS_XB), (const pg8::bf16_t*)(F.ws + W_WQKV) + (size_t)e * 3072 * DM, NT, 3072, DM}; pg8::StaticOrder S; S.init(NT, 3072, (int)gridDim.x, (int)blockIdx.x);
                pg8::EpiBf16S E{(pg8::bf16_t*)(F.ws + WS_PROJ), 1024, 1024, (size_t)NT * 1024};
                DUP(12) pg8::gemm_phase<pg8::EpiBf16S, pg8::StaticOrder>(F.lds, g, S, E, nullptr, F.wave);
                SEAM(pb + 0); }
            if (IN(pb + 1)) {
#ifndef NO_SB
 DUP(6) ph_stickbreak(F);
#endif
 SEAM(pb + 1); }
        }
        if (IN(pb + 7)) { PHASE_PIN(F);
            pg8::Gemm g{(const pg8::bf16_t*)(F.ws + WS_YCAT), (const pg8::bf16_t*)(F.ws + ((l & 1) ? W_WOUTO : W_WOUTE)) + (size_t)e * DM * DM, NT, DM, DM}; pg8::StaticOrder S; S.init(NT, DM, (int)gridDim.x, (int)blockIdx.x);
            pg8::EpiResid E{xsrc, (float*)(F.ws + WS_X)};
            pg8::gemm_phase<pg8::EpiResid, pg8::StaticOrder>(F.lds, g, S, E, nullptr, F.wave);
            SEAM(pb + 7); }
        if (IN(pb + 8)) {
#ifndef NO_ROUTE
 ph_moe_route(F, args, l, true); if (DUP_PHASE == 16) ph_moe_route(F, args, l, false); DUP(7) moe_weight_prep(F, args, l);
#endif
 SEAM(pb + 8); }
        if (IN(pb + 9)) { DUP(8) ph_moe_gather(F, l); SEAM(pb + 9); }
        if (IN(pb + 10)) { DUP(9) ph_moe_gemm1(F, l); SEAM(pb + 10); }
        if (IN(pb + 11)) { DUP(10) ph_moe_gemm2(F, l); SEAM(pb + 11); }
        if (IN(pb + 12)) { ph_moe_combine(F, args, l); SEAM(pb + 12); }
    }
#undef IN
#undef SEAM
}

extern "C" void kernel_launch(void* const* d_in, const int* in_sizes, int n_in, void* d_out, int out_size, void* d_ws, size_t ws_size, hipStream_t stream) {
    static int grid = 0;
    if (grid == 0) {
        if (n_in != 36 || out_size != NT * DM || ws_size < WS_END) { fprintf(stderr, "kernel_launch: unexpected problem (n_in %d out %d ws %zu)\n", n_in, out_size, ws_size); grid = -1; return; }
        int dev = 0, cus = 0, per_cu = 0;
        if (hipGetDevice(&dev) != hipSuccess || hipDeviceGetAttribute(&cus, hipDeviceAttributeMultiprocessorCount, dev) != hipSuccess) { grid = -1; return; }
        if (hipFuncSetAttribute((const void*)fwd_kernel, hipFuncAttributeMaxDynamicSharedMemorySize, LDS_BYTES) != hipSuccess) { grid = -1; return; }
        if (hipOccupancyMaxActiveBlocksPerMultiprocessor(&per_cu, (const void*)fwd_kernel, NTHR, LDS_BYTES) != hipSuccess || per_cu < 1) { fprintf(stderr, "kernel_launch: occupancy query says %d\n", per_cu); }
        (void)hipGetLastError();
        grid = cus;
    }
    if (grid < 0) return;
    (void)hipMemsetAsync((char*)d_ws + WS_CTL, 0, CTL_ZERO_BYTES, stream);
    Args a{};
    for (int i = 0; i < 36; ++i) a.in[i] = (const float*)d_in[i];
    a.out = (float*)d_out; a.ws = (unsigned char*)d_ws;
#if ONE_LAUNCH
    a.ph_lo = 0; a.ph_hi = 65;
    hipLaunchKernelGGL(fwd_kernel, dim3(grid), dim3(NTHR), LDS_BYTES, stream, a);
#else
    for (int p = 0; p < 65; ++p) {
        const int l = (p - 1) >> 4, k = (p - 1) & 15;
        if (p > 0) { if (k > 12) continue; if ((l & 1) && k >= 2 && k <= 6) continue; }
        a.ph_lo = p; a.ph_hi = p + 1;
        hipLaunchKernelGGL(fwd_kernel, dim3(grid), dim3(NTHR), LDS_BYTES, stream, a);
    }
#endif
}
```

```cpp
#include <hip/hip_runtime.h>
#include <cstdio>
#include <cstdint>

#ifndef DUP_PHASE
#define DUP_PHASE -1
#endif
#ifndef CHUNKED
#define CHUNKED 1
#endif
#ifndef ONE_LAUNCH
#define ONE_LAUNCH 1
#endif

#define GAS __attribute__((address_space(1)))
#define LAS __attribute__((address_space(3)))
typedef unsigned short bf16_t;
typedef short bf16x8 __attribute__((ext_vector_type(8)));
typedef float f32x4 __attribute__((ext_vector_type(4)));
typedef float f32x2 __attribute__((ext_vector_type(2)));
typedef float f32x16 __attribute__((ext_vector_type(16)));
typedef unsigned u32x4 __attribute__((ext_vector_type(4)));
typedef unsigned u32x2 __attribute__((ext_vector_type(2)));

constexpr int NT = 16384, TT = 8192, DM = 1024, NB = 2;
constexpr int NCOL = 3584;
constexpr int C_R = 0, C_K = 512, C_V = 1024, C_QB = 1536, C_CKV = 2048, C_QI = 2176, C_KI = 2688, C_WI = 2752;
constexpr int C_PW = 2816, C_QW = 2880, C_PA = 2944, C_QA = 3008, C_PG = 3072, C_QG = 3200, C_PV = 3328, C_QV = 3360;
constexpr int NWAVES = 8, NTHR = 512;
constexpr float RMS_EPS = 1e-6f, GN_EPS = 64e-5f;
constexpr float LOG2E = 1.4426950408889634f;

constexpr size_t MiB = 1u << 20;
constexpr size_t WS_CTL = 0, CTL_ZERO_BYTES = 1 * MiB;
constexpr size_t WS_SMALL = 1 * MiB;
constexpr size_t SM_EIDX = WS_SMALL, SM_GATE = WS_SMALL + 128 * 1024, SM_SLOT = WS_SMALL + 256 * 1024, SM_BONUS = WS_SMALL + 512 * 1024, SM_SGN = WS_SMALL + 1024 * 1024;
constexpr size_t WS_W = 5 * MiB;
constexpr size_t W_WIN = WS_W, W_WOUTE = WS_W + 14 * MiB, W_WQKV = WS_W + 18 * MiB, W_WOUTO = WS_W + 30 * MiB, W_WKB = WS_W + 34 * MiB, W_WVT = W_WKB + 256 * 1024, W_L2 = W_WKB + 512 * 1024;
constexpr size_t WS_X = 45 * MiB, WS_XB = 109 * MiB, WS_PROJ = 141 * MiB, WS_SIN = 253 * MiB, WS_VF = 445 * MiB, WS_Y = 477 * MiB, WS_GATE = 509 * MiB, WS_YCAT = 541 * MiB;
constexpr size_t WS_CN = 573 * MiB, WS_KI = 577 * MiB, WS_QI = 579 * MiB, WS_QA = 595 * MiB, WS_SEL = 627 * MiB;
constexpr size_t WS_BIG = 645 * MiB;
constexpr size_t WS_SCORE = WS_BIG;
constexpr size_t WS_W13T = WS_BIG, WS_W2T = WS_BIG + 64 * MiB, WS_AMOE = WS_BIG + 96 * MiB, WS_H = WS_BIG + 176 * MiB, WS_YM = WS_BIG + 216 * MiB;
constexpr size_t WS_S1TMP = 905 * MiB;
constexpr size_t WS_END = 1017 * MiB;
constexpr size_t SCORE_PER_BATCH = (size_t)16384 * 2080;
static_assert(WS_SCORE + 2 * SCORE_PER_BATCH * 4 <= WS_END, "score map");
static_assert(WS_YM + (size_t)40960 * 1024 * 2 <= WS_END, "moe map");
constexpr int CW_BAR = 4096;
constexpr int CW_CNT = 16384;

constexpr int LDS_BYTES = 147456;
constexpr int LDS_WSCR = 16384;
constexpr int LDS_MISC = 131072;

__device__ __forceinline__ float bf2f(bf16_t b) { return __uint_as_float(((unsigned)b) << 16); }
typedef __bf16 bf16v2_t __attribute__((ext_vector_type(2)));
__device__ __forceinline__ unsigned pk2(float lo, float hi) { const f32x2 v = {lo, hi}; const bf16v2_t b = __builtin_convertvector(v, bf16v2_t); return __builtin_bit_cast(unsigned, b); }
__device__ __forceinline__ unsigned f2bf(float f) { return pk2(f, f) & 0xffffu; }
__device__ __forceinline__ float wave_sum(float v) {
#pragma unroll
    for (int o = 1; o < 64; o <<= 1) v += __shfl_xor(v, o);
    return v;
}
__device__ __forceinline__ float wave_max(float v) {
#pragma unroll
    for (int o = 1; o < 64; o <<= 1) v = fmaxf(v, __shfl_xor(v, o));
    return v;
}
__device__ __forceinline__ float sigmoidf_(float x) { return 1.0f / (1.0f + __expf(-x)); }
#define LDS_WAIT() asm volatile("s_waitcnt lgkmcnt(0)" ::: "memory")

#define XB_TMO      128
#define XB_XCNT(j)  (256  + 64 * (j))
#define XB_XSUB(j)  (1280 + 64 * (j))
#define XB_XGEN(j)  (2304 + 64 * (j))
#define XB_TOP      3328
#define XB_TOPGEN   3392
#define XCD_BAR_WORDS 3456
#define XB_SPIN_CAP (1u << 18)
__device__ __forceinline__ unsigned xb_ld(unsigned* p)              { return __hip_atomic_load(p, __ATOMIC_RELAXED, __HIP_MEMORY_SCOPE_AGENT); }
__device__ __forceinline__ unsigned xb_add(unsigned* p, unsigned v) { return __hip_atomic_fetch_add(p, v, __ATOMIC_RELAXED, __HIP_MEMORY_SCOPE_AGENT); }
__device__ __forceinline__ unsigned xb_xcc_id() { return (unsigned)__builtin_amdgcn_s_getreg((3 << 11) | 20) & 0xFu; }
#define XB_SPIN(cond, bar) do { unsigned _sp = 0; while (cond) { __builtin_amdgcn_s_sleep(1); \
    if ((++_sp & 255u) == 0u) { if (xb_ld(&(bar)[XB_TMO])) break; if (_sp > XB_SPIN_CAP) { atomicAdd(&(bar)[XB_TMO], 1u); break; } } } } while (0)
struct XcdBarrier { unsigned* bar; unsigned x; volatile LAS unsigned* st; };
__device__ __forceinline__ XcdBarrier xcd_barrier_post(unsigned* bar, volatile LAS unsigned* st, bool t0) {
    XcdBarrier b; b.bar = bar; b.x = xb_xcc_id(); b.st = st;
    if (t0) (void)xb_add(&bar[XB_XCNT(b.x)], 1u);
    return b;
}
__device__ __forceinline__ void xcd_barrier_complete(unsigned* bar, unsigned x, unsigned& nloc, unsigned& nx) {
    const unsigned G = gridDim.x * gridDim.y * gridDim.z;
    unsigned sum, cnt, mine, sp = 0u;
    for (;;) {
        sum = 0u; cnt = 0u; mine = 0u;
#pragma unroll
        for (unsigned j = 0; j < 16; ++j) { const unsigned c = xb_ld(&bar[XB_XCNT(j)]); sum += c; cnt += (c > 0u) ? 1u : 0u; mine = (j == x) ? c : mine; }
        if (sum == G) break;
        __builtin_amdgcn_s_sleep(1);
        if ((++sp & 255u) == 0u) { if (xb_ld(&bar[XB_TMO])) break; if (sp > XB_SPIN_CAP) { atomicAdd(&bar[XB_TMO], 1u); break; } }
    }
    nloc = mine > 0u ? mine : 1u; nx = cnt > 0u ? cnt : 1u;
}
__device__ __forceinline__ void xcd_barrier(const XcdBarrier& b, bool t0) {
    asm volatile("s_waitcnt vmcnt(0)" ::: "memory");
    __syncthreads();
    if (t0) {
        unsigned* bar = b.bar;
        __builtin_amdgcn_s_waitcnt(0);
        unsigned nloc = b.st[0], nx = b.st[1];
        if (nloc == 0u) { xcd_barrier_complete(bar, b.x, nloc, nx); b.st[0] = nloc; b.st[1] = nx; }
        const unsigned old = xb_add(&bar[XB_XSUB(b.x)], 1u);
        const unsigned gen = old / nloc;
        if (old + 1u == (gen + 1u) * nloc) {
            __builtin_amdgcn_fence(__ATOMIC_RELEASE, "agent");
            asm volatile("s_waitcnt vmcnt(0)" ::: "memory");
            const unsigned og = xb_add(&bar[XB_TOP], 1u);
            const unsigned tg = og / nx;
            if (og + 1u == (tg + 1u) * nx) xb_add(&bar[XB_TOPGEN], 1u);
            else XB_SPIN(xb_ld(&bar[XB_TOPGEN]) == tg, bar);
            __builtin_amdgcn_fence(__ATOMIC_ACQUIRE, "agent");
            xb_add(&bar[XB_XGEN(b.x)], 1u);
            asm volatile("s_waitcnt vmcnt(0)" ::: "memory");
        } else {
            XB_SPIN(xb_ld(&bar[XB_XGEN(b.x)]) == gen, bar);
            __builtin_amdgcn_fence(__ATOMIC_ACQUIRE, "agent");
            asm volatile("s_waitcnt vmcnt(0)" ::: "memory");
        }
    }
    __syncthreads();
}

struct Args { const float* in[36]; float* out; unsigned char* ws; int ph_lo, ph_hi; };
struct Frame {
    LAS unsigned char* lds; int tid, lane, wave, gw, ngw;
    float* out; unsigned char* ws;
    const __attribute__((address_space(4))) Args* ka;
};

#define PHASE_PIN(F) do { unsigned long long _z64; int _z32; asm volatile("s_mov_b64 %0, 0\n\ts_mov_b32 %1, 0" : "=s"(_z64), "=s"(_z32)); asm volatile("" : "+v"((F).lane)); \
    (F).ws += _z64; (F).out += _z64; (F).ka = (const __attribute__((address_space(4))) Args*)((const __attribute__((address_space(4))) char*)(F).ka + _z64); \
    (F).gw += _z32; (F).ngw += _z32; (F).wave += _z32; (F).tid = (F).wave * 64 + (F).lane; } while (0)
struct TrJob { const float* W; int K, ldw, col_off, ncols; bf16_t* WT; int ldt, row_off; const float* g; const float* mu; int mode; float cs; };
__device__ __forceinline__ void tr_item(const TrJob& J, int item, LAS float* scr, int lane) {
    const int nblk = (J.ncols + 31) / 32, kb = item / nblk, nb = item % nblk, k0 = 64 * kb, n0 = 32 * nb;
#pragma unroll 8
    for (int i = 0; i < 32; ++i) {
        const int kk = 2 * i + (lane >> 5), n = lane & 31, k = k0 + kk;
        float v = 0.f;
        if (k < J.K && n0 + n < J.ncols) {
            float s = J.cs;
            if (J.g) s *= J.g[k];
            if (J.mode == 1) s *= (1.0f - J.mu[k]); else if (J.mode == 2) s *= J.mu[k];
            v = J.W[(size_t)k * J.ldw + J.col_off + n0 + n] * s;
        }
        scr[kk * 33 + n] = v;
    }
    LDS_WAIT(); asm volatile("" ::: "memory");
    const int c = lane & 7;
#pragma unroll
    for (int j = 0; j < 4; ++j) {
        const int n = (lane >> 3) + 8 * j; const LAS float* s = scr + (8 * c) * 33 + n;
        u32x4 o; o.x = pk2(s[0 * 33], s[1 * 33]); o.y = pk2(s[2 * 33], s[3 * 33]); o.z = pk2(s[4 * 33], s[5 * 33]); o.w = pk2(s[6 * 33], s[7 * 33]);
        if (n0 + n < J.ncols && k0 + 8 * c < J.K) *(u32x4*)(J.WT + (size_t)(J.row_off + n0 + n) * J.ldt + k0 + 8 * c) = o;
    }
    LDS_WAIT(); asm volatile("" ::: "memory");
}
__device__ __forceinline__ void tr_job(Frame& F, const TrJob& J, int rot) {
    LAS float* scr = (LAS float*)(F.lds + F.wave * LDS_WSCR);
    const int nitems = ((J.K + 63) / 64) * ((J.ncols + 31) / 32);
    int start = F.gw - (rot % F.ngw); if (start < 0) start += F.ngw;
    for (int it = start; it < nitems; it += F.ngw) tr_item(J, it, scr, F.lane);
}
__device__ __forceinline__ void zero_rows(Frame& F, bf16_t* WT, int ld, int r0, int r1) {
    const size_t n16 = (size_t)(r1 - r0) * ld / 8; u32x4* p = (u32x4*)(WT + (size_t)r0 * ld);
    for (size_t i = (size_t)F.gw * 64 + F.lane; i < n16; i += (size_t)F.ngw * 64) p[i] = (u32x4){0u, 0u, 0u, 0u};
}
__device__ __forceinline__ void row_norm_to_bf16(const float* xrow, bf16_t* orow, int lane) {
    const f32x4* xr = (const f32x4*)xrow + lane; f32x4 v[4]; float s = 0.f;
#pragma unroll
    for (int j = 0; j < 4; ++j) { v[j] = xr[64 * j]; s += (v[j].x * v[j].x + v[j].y * v[j].y) + (v[j].z * v[j].z + v[j].w * v[j].w); }
    const float rstd = rsqrtf(wave_sum(s) * (1.f / DM) + RMS_EPS);
    u32x2* o8 = (u32x2*)orow + lane;
#pragma unroll
    for (int j = 0; j < 4; ++j) { u32x2 w; w.x = pk2(v[j].x * rstd, v[j].y * rstd); w.y = pk2(v[j].z * rstd, v[j].w * rstd); o8[64 * j] = w; }
}

__device__ __forceinline__ void ph_prologue(Frame& F, const Args& A) {
    PHASE_PIN(F);
    unsigned char* ws = F.ws; int rot = 0;
    for (int e = 0; e < 2; ++e) {
        bf16_t* WT = (bf16_t*)(ws + W_WIN) + (size_t)e * NCOL * DM;
        const float* g = F.ka->in[1] + e * DM; const float* mul = F.ka->in[5] + (size_t)e * 3 * DM;
        TrJob J{F.ka->in[2] + (size_t)e * DM * 2760, DM, 2760, 0, 2760, WT, DM, 0, g, nullptr, 0, 1.0f}; tr_job(F, J, rot); rot += 1392;
        zero_rows(F, WT, DM, 2760, C_PW);
        TrJob Jw1{F.ka->in[7] + (size_t)e * DM * 64, DM, 64, 0, 64, WT, DM, C_PW, g, mul, 1, 1.0f}; tr_job(F, Jw1, rot); rot += 32;
        TrJob Jw2{F.ka->in[7] + (size_t)e * DM * 64, DM, 64, 0, 64, WT, DM, C_QW, g, mul, 2, 1.0f}; tr_job(F, Jw2, rot); rot += 32;
        TrJob Ja1{F.ka->in[10] + (size_t)e * DM * 64, DM, 64, 0, 64, WT, DM, C_PA, g, mul + DM, 1, 1.0f}; tr_job(F, Ja1, rot); rot += 32;
        TrJob Ja2{F.ka->in[10] + (size_t)e * DM * 64, DM, 64, 0, 64, WT, DM, C_QA, g, mul + DM, 2, 1.0f}; tr_job(F, Ja2, rot); rot += 32;
        TrJob Jg1{F.ka->in[12] + (size_t)e * DM * 128, DM, 128, 0, 128, WT, DM, C_PG, g, mul + 2 * DM, 1, 1.0f}; tr_job(F, Jg1, rot); rot += 64;
        TrJob Jg2{F.ka->in[12] + (size_t)e * DM * 128, DM, 128, 0, 128, WT, DM, C_QG, g, mul + 2 * DM, 2, 1.0f}; tr_job(F, Jg2, rot); rot += 64;
        if (e == 1) {
            TrJob Jv1{F.ka->in[21], DM, 32, 0, 32, WT, DM, C_PV, g, F.ka->in[19], 1, 1.0f}; tr_job(F, Jv1, rot); rot += 16;
            TrJob Jv2{F.ka->in[21], DM, 32, 0, 32, WT, DM, C_QV, g, F.ka->in[19], 2, 1.0f}; tr_job(F, Jv2, rot); rot += 16;
            zero_rows(F, WT, DM, C_QV + 32, NCOL);
        } else zero_rows(F, WT, DM, C_PV, NCOL);
        TrJob Jo{F.ka->in[3] + (size_t)e * DM * DM, DM, DM, 0, DM, (bf16_t*)(ws + W_WOUTE) + (size_t)e * DM * DM, DM, 0, nullptr, nullptr, 0, 1.0f}; tr_job(F, Jo, rot); rot += 512;
        { bf16_t* L2W = (bf16_t*)(ws + W_L2) + (size_t)e * (288 * 512);
          TrJob Jl1{F.ka->in[8] + (size_t)e * 64 * 512, 64, 512, 0, 512, L2W, 64, 0, nullptr, nullptr, 0, 1.0f}; tr_job(F, Jl1, rot); rot += 16;
          TrJob Jl2{F.ka->in[11] + (size_t)e * 64 * 512, 64, 512, 0, 512, L2W + 64 * 512, 64, 0, nullptr, nullptr, 0, 1.0f}; tr_job(F, Jl2, rot); rot += 16;
          TrJob Jl3{F.ka->in[13] + (size_t)e * 128 * 512, 128, 512, 0, 512, L2W + 128 * 512, 128, 0, nullptr, nullptr, 0, 1.0f}; tr_job(F, Jl3, rot); rot += 32;
          if (e == 1) { TrJob Jl4{F.ka->in[22], 32, 512, 0, 512, L2W + 256 * 512, 32, 0, nullptr, nullptr, 0, 1.0f}; tr_job(F, Jl4, rot); rot += 16; } }
        { const float* Wkv = F.ka->in[24] + (size_t)e * 128 * 1024; bf16_t* WkB = (bf16_t*)(ws + W_WKB) + (size_t)e * 8 * 128 * 64;
          for (int i = F.gw * 64 + F.lane; i < 8 * 128 * 64; i += F.ngw * 64) { const int d = i & 63, r = (i >> 6) & 127, h = i >> 13; WkB[i] = (bf16_t)f2bf(Wkv[(size_t)r * 1024 + h * 64 + d]); } }
        TrJob Jv{F.ka->in[24] + (size_t)e * 128 * 1024, 128, 1024, 512, 512, (bf16_t*)(ws + W_WVT) + (size_t)e * 512 * 128, 128, 0, nullptr, nullptr, 0, 1.0f}; tr_job(F, Jv, rot); rot += 32;
    }
    for (int o = 0; o < 2; ++o) {
        const float* g = F.ka->in[26] + o * DM; bf16_t* WT = (bf16_t*)(ws + W_WQKV) + (size_t)o * 3072 * DM;
        TrJob Jq{F.ka->in[27] + (size_t)o * DM * 3072, DM, 3072, 0, 1024, WT, DM, 0, g, nullptr, 0, LOG2E * 0.125f}; tr_job(F, Jq, rot); rot += 512;
        TrJob Jk{F.ka->in[27] + (size_t)o * DM * 3072, DM, 3072, 1024, 2048, WT, DM, 1024, g, nullptr, 0, 1.0f}; tr_job(F, Jk, rot); rot += 1024;
        TrJob Jo{F.ka->in[28] + (size_t)o * DM * DM, DM, DM, 0, DM, (bf16_t*)(ws + W_WOUTO) + (size_t)o * DM * DM, DM, 0, nullptr, nullptr, 0, 1.0f}; tr_job(F, Jo, rot); rot += 512;
    }
    for (int m = F.gw; m < NT; m += F.ngw) row_norm_to_bf16(F.ka->in[0] + (size_t)m * DM, (bf16_t*)(ws + WS_XB) + (size_t)m * DM, F.lane);
}

struct MwJob { const float* src; const float* gk; bf16_t* dst; int ldw, ldt; };
__device__ __forceinline__ MwJob mw_job(int it, const float* w1, const float* w3, const float* w2, const float* g, bf16_t* W13T, bf16_t* W2T, int lane) {
    MwJob J;
    if (it < 16384) { const int job = it >> 6, item = it & 63, which = job & 1, j = (job >> 1) & 3, e = job >> 3, k0 = 64 * (item >> 2), n0 = 32 * (item & 3);
        J.src = (which ? w3 : w1) + (size_t)e * DM * 512 + (size_t)(k0 + (lane >> 5)) * 512 + 128 * j + n0 + (lane & 31); J.ldw = 512; J.gk = g + k0 + (lane >> 5);
        J.dst = W13T + (size_t)(e * 1024 + 256 * j + 128 * which + n0 + (lane >> 3)) * DM + k0 + 8 * (lane & 7); J.ldt = DM; }
    else { const int it2 = it - 16384, e = it2 >> 8, item = it2 & 255, k0 = 64 * (item >> 5), n0 = 32 * (item & 31);
        J.src = w2 + (size_t)e * 512 * DM + (size_t)(k0 + (lane >> 5)) * DM + n0 + (lane & 31); J.ldw = DM; J.gk = nullptr;
        J.dst = W2T + (size_t)(e * 1024 + n0 + (lane >> 3)) * 512 + k0 + 8 * (lane & 7); J.ldt = 512; }
    return J;
}
__device__ __forceinline__ void mw_load(const MwJob& J, float (&v)[32]) {
#pragma unroll
    for (int i = 0; i < 32; ++i) { float x = J.src[(size_t)(2 * i) * J.ldw]; if (J.gk) x *= J.gk[2 * i]; v[i] = x; }
}
__device__ __forceinline__ void mw_finish(const MwJob& J, const float (&v)[32], LAS float* scr, int lane) {
#pragma unroll
    for (int i = 0; i < 32; ++i) scr[(2 * i + (lane >> 5)) * 33 + (lane & 31)] = v[i];
    LDS_WAIT(); asm volatile("" ::: "memory");
    const int c = lane & 7;
#pragma unroll
    for (int j = 0; j < 4; ++j) { const LAS float* sp = scr + (8 * c) * 33 + (lane >> 3) + 8 * j;
        u32x4 o; o.x = pk2(sp[0 * 33], sp[1 * 33]); o.y = pk2(sp[2 * 33], sp[3 * 33]); o.z = pk2(sp[4 * 33], sp[5 * 33]); o.w = pk2(sp[6 * 33], sp[7 * 33]);
        *(u32x4*)(J.dst + (size_t)(8 * j) * J.ldt) = o; }
    LDS_WAIT(); asm volatile("" ::: "memory");
}
__device__ __forceinline__ void moe_weight_prep(Frame& F, const Args& A, int l) {
    PHASE_PIN(F);
    LAS float* scr = (LAS float*)(F.lds + F.wave * LDS_WSCR); const int lane = F.lane;
    const float* g = F.ka->in[29] + l * DM;
    const float* w1 = F.ka->in[32] + (size_t)l * 32 * DM * 512; const float* w3 = F.ka->in[33] + (size_t)l * 32 * DM * 512; const float* w2 = F.ka->in[34] + (size_t)l * 32 * 512 * DM;
    bf16_t* W13T = (bf16_t*)(F.ws + WS_W13T); bf16_t* W2T = (bf16_t*)(F.ws + WS_W2T);
    float va[32], vb[32];
    int it = F.gw;
    if (it >= 24576) return;
    MwJob Ja = mw_job(it, w1, w3, w2, g, W13T, W2T, lane), Jb = Ja; mw_load(Ja, va);
    for (;;) {
        const int itb = it + F.ngw; const bool hb = itb < 24576;
        if (hb) { Jb = mw_job(itb, w1, w3, w2, g, W13T, W2T, lane); mw_load(Jb, vb); }
        mw_finish(Ja, va, scr, lane);
        if (!hb) break;
        const int ita = itb + F.ngw; const bool ha = ita < 24576;
        if (ha) { Ja = mw_job(ita, w1, w3, w2, g, W13T, W2T, lane); mw_load(Ja, va); }
        mw_finish(Jb, vb, scr, lane);
        if (!ha) break;
        it = ita;
    }
}

#define MFMA32(a, b, c) __builtin_amdgcn_mfma_f32_32x32x16_bf16((a), (b), (c), 0, 0, 0)
template <class Epi>
__device__ __forceinline__ void sg_tile(const bf16_t* A, int lda, const bf16_t* B0, const bf16_t* B1, int ldb, int K, int m0, const Epi& epi, int lane) {
    const int r = lane & 31, h = lane >> 5;
    const bf16_t* a0 = A + (size_t)(m0 + r) * lda + 8 * h; const bf16_t* a1 = a0 + (size_t)32 * lda;
    const bf16_t* b0 = B0 + (size_t)r * ldb + 8 * h; const bf16_t* b1 = B1 + (size_t)r * ldb + 8 * h;
    f32x16 c00, c01, c10, c11;
#pragma unroll
    for (int i = 0; i < 16; ++i) { c00[i] = 0.f; c01[i] = 0.f; c10[i] = 0.f; c11[i] = 0.f; }
#pragma unroll 4
    for (int k = 0; k < K; k += 16) {
        const bf16x8 fa0 = *(const bf16x8*)(a0 + k), fa1 = *(const bf16x8*)(a1 + k), fb0 = *(const bf16x8*)(b0 + k), fb1 = *(const bf16x8*)(b1 + k);
        c00 = MFMA32(fb0, fa0, c00); c01 = MFMA32(fb1, fa0, c01); c10 = MFMA32(fb0, fa1, c10); c11 = MFMA32(fb1, fa1, c11);
    }
#pragma unroll
    for (int g = 0; g < 4; ++g) {
        const int j = 8 * g + 4 * h;
        epi.pair(m0 + r, j, (f32x4){c00[4 * g], c00[4 * g + 1], c00[4 * g + 2], c00[4 * g + 3]}, (f32x4){c01[4 * g], c01[4 * g + 1], c01[4 * g + 2], c01[4 * g + 3]});
        epi.pair(m0 + 32 + r, j, (f32x4){c10[4 * g], c10[4 * g + 1], c10[4 * g + 2], c10[4 * g + 3]}, (f32x4){c11[4 * g], c11[4 * g + 1], c11[4 * g + 2], c11[4 * g + 3]});
    }
}
struct EpiStoreBf16 {
    bf16_t* O; int ldo, n0, n1;
    __device__ __forceinline__ void pair(int row, int j, f32x4 v0, f32x4 v1) const {
        u32x2 w; w.x = pk2(v0.x, v0.y); w.y = pk2(v0.z, v0.w); *(u32x2*)(O + (size_t)row * ldo + n0 + j) = w;
        w.x = pk2(v1.x, v1.y); w.y = pk2(v1.z, v1.w); *(u32x2*)(O + (size_t)row * ldo + n1 + j) = w;
    }
};
struct EpiResidF32 {
    const float* S; float* X; int n0, n1;
    __device__ __forceinline__ void pair(int row, int j, f32x4 v0, f32x4 v1) const {
        const size_t o0 = (size_t)row * DM + n0 + j, o1 = (size_t)row * DM + n1 + j;
        *(f32x4*)(X + o0) = *(const f32x4*)(S + o0) + v0; *(f32x4*)(X + o1) = *(const f32x4*)(S + o1) + v1;
    }
};
struct EpiGated {
    bf16_t* H; int hc;
    __device__ __forceinline__ void pair(int row, int j, f32x4 a, f32x4 b) const {
        f32x4 o;
#pragma unroll
        for (int i = 0; i < 4; ++i) o[i] = a[i] * sigmoidf_(a[i]) * b[i];
        u32x2 w; w.x = pk2(o.x, o.y); w.y = pk2(o.z, o.w); *(u32x2*)(H + (size_t)row * 512 + hc + j) = w;
    }
};
__device__ __forceinline__ void sg_dense_bf16(Frame& F, const bf16_t* A, int lda, const bf16_t* Bt, int K, int M, int N, bf16_t* O, int ldo) {
    PHASE_PIN(F);
    const int nN = N / 64, ntile = (M / 64) * nN;
    for (int t = F.gw; t < ntile; t += F.ngw) {
        const int mt = t / nN, nt = t % nN; EpiStoreBf16 E{O, ldo, nt * 64, nt * 64 + 32};
        sg_tile(A, lda, Bt + (size_t)(nt * 64) * K, Bt + (size_t)(nt * 64 + 32) * K, K, K, mt * 64, E, F.lane);
    }
}
__device__ __forceinline__ void sg_dense_resid(Frame& F, const bf16_t* A, const bf16_t* Bt, const float* S, float* X) {
    PHASE_PIN(F);
    const int nN = DM / 64, ntile = (NT / 64) * nN;
    for (int t = F.gw; t < ntile; t += F.ngw) {
        const int mt = t / nN, nt = t % nN; EpiResidF32 E{S, X, nt * 64, nt * 64 + 32};
        sg_tile(A, DM, Bt + (size_t)(nt * 64) * DM, Bt + (size_t)(nt * 64 + 32) * DM, DM, DM, mt * 64, E, F.lane);
    }
}

namespace pg8 {
#define PG8_LAS __attribute__((address_space(3)))
typedef unsigned short bf16_t;
typedef short bf16x8 __attribute__((ext_vector_type(8)));
typedef float f32x4 __attribute__((ext_vector_type(4)));
typedef unsigned u32x4 __attribute__((ext_vector_type(4)));
constexpr int BM = 256, BK = 64, HALF = 128, HTB = HALF * BK * 2  , STAGE_BYTES = 8 * HTB, NXCD = 8, WGM = 8;

__host__ __device__ __forceinline__ int lds_byte(int r, int c) { const int st = (r >> 4) * 2 + (c >> 5), rr = r & 15, cc = c & 31, ob = rr * 64 + cc * 2; return st * 1024 + (ob ^ (((ob >> 9) & 1) << 5)); }
__host__ __device__ __forceinline__ void stage_rc(int b, int& R, int& C) { const int st = b / 1024, sb = b % 1024, swz = sb ^ (((sb >> 9) & 1) << 5); R = (st >> 1) * 16 + swz / 64; C = (st & 1) * 32 + (swz % 64) / 2; }
__host__ __device__ __forceinline__ int perm32(int rho) { const int n = rho >> 4, i = rho & 15; return 8 * (i >> 2) + 4 * n + (i & 3); }

struct Unit { int pm, pn; };
struct Gemm { const bf16_t* A; const bf16_t* Bt; int M, N, K; };

struct StaticOrder {
    int nM, nN, nwg, G, c;
    __host__ __device__ void init(int M, int N, int G_, int c_) { nM = M / BM; nN = N / BM; nwg = nM * nN; G = G_; c = c_; }
    __host__ __device__ bool next(int i, Unit& u) const {
        const long L = (long)i * G + c; if (L >= nwg) return false;
        int wgid = (int)L; { const int q = nwg / NXCD, r = nwg % NXCD, xcd = wgid % NXCD, off = wgid / NXCD; wgid = (xcd < r ? xcd * (q + 1) : r * (q + 1) + (xcd - r) * q) + off; }
        const int nig = WGM * nN, gid = wgid / nig, fm = gid * WGM, gsz = (nM - fm) < WGM ? (nM - fm) : WGM;
        u.pm = fm + ((wgid % nig) % gsz); u.pn = (wgid % nig) / gsz; return true;
    }
    __device__ __forceinline__ void a_ready(const Unit&) const {}
    __device__ __forceinline__ void done(const Unit&) const {}
};

__device__ __forceinline__ unsigned cvt_pk_bf16(float lo, float hi) { return ::pk2(lo, hi); }
struct EpiBf16S {
    static constexpr bool PERM = true, AFTER_DRAIN = false;
    bf16_t* O; int ldc; int split_cols; size_t split_stride;
    __device__ __forceinline__ void operator()(const f32x4 (&acc)[2][2][4][2], const Unit& u, int wr, int wc, int fr, int fq) const {
        const int row0 = u.pm * BM + wr * 64 + fr; int colt = u.pn * BM; bf16_t* base = O;
        if (split_cols) { const int t = colt / split_cols; base += (size_t)t * split_stride; colt -= t * split_cols; }
        const int col0 = colt + wc * 32 + 8 * fq;
#pragma unroll
        for (int ai = 0; ai < 2; ++ai)
#pragma unroll
            for (int m = 0; m < 4; ++m) { bf16_t* rowp = base + (size_t)(row0 + ai * HALF + m * 16) * ldc + col0;
#pragma unroll
                for (int bj = 0; bj < 2; ++bj) { const f32x4 v0 = acc[ai][bj][m][0], v1 = acc[ai][bj][m][1];
                    u32x4 w; w.x = cvt_pk_bf16(v0[0], v0[1]); w.y = cvt_pk_bf16(v0[2], v0[3]); w.z = cvt_pk_bf16(v1[0], v1[1]); w.w = cvt_pk_bf16(v1[2], v1[3]);
                    *(u32x4*)(rowp + bj * HALF) = w; } }
    }
};
struct EpiResid {
    static constexpr bool PERM = false, AFTER_DRAIN = false;
    const float* S; float* X;
    __device__ __forceinline__ void operator()(const f32x4 (&acc)[2][2][4][2], const Unit& u, int wr, int wc, int fr, int fq) const {
        const int row0 = u.pm * BM + wr * 64 + fr, col0 = u.pn * BM + wc * 32 + 4 * fq;
#pragma unroll
        for (int ai = 0; ai < 2; ++ai)
#pragma unroll
            for (int m = 0; m < 4; ++m) { const size_t off = (size_t)(row0 + ai * HALF + m * 16) * 1024 + col0;
#pragma unroll
                for (int bj = 0; bj < 2; ++bj)
#pragma unroll
                    for (int n = 0; n < 2; ++n) *(f32x4*)(X + off + bj * HALF + n * 16) = *(const f32x4*)(S + off + bj * HALF + n * 16) + acc[ai][bj][m][n]; }
    }
};
struct EpiGate {
    static constexpr bool PERM = true, AFTER_DRAIN = false;
    bf16_t* H;
    __device__ __forceinline__ void operator()(const f32x4 (&acc)[2][2][4][2], const Unit& u, int wr, int wc, int fr, int fq) const {
        const int row0 = u.pm * BM + wr * 64 + fr, col0 = (u.pn & 3) * 128 + wc * 32 + 8 * fq;
#pragma unroll
        for (int ai = 0; ai < 2; ++ai)
#pragma unroll
            for (int m = 0; m < 4; ++m) { float o[8];
#pragma unroll
                for (int n = 0; n < 2; ++n)
#pragma unroll
                    for (int i = 0; i < 4; ++i) { const float a = acc[ai][0][m][n][i], b = acc[ai][1][m][n][i]; o[4 * n + i] = a * b * __builtin_amdgcn_rcpf(1.0f + __builtin_amdgcn_exp2f(-1.4426950408889634f * a)); }
                u32x4 w; w.x = cvt_pk_bf16(o[0], o[1]); w.y = cvt_pk_bf16(o[2], o[3]); w.z = cvt_pk_bf16(o[4], o[5]); w.w = cvt_pk_bf16(o[6], o[7]);
                *(u32x4*)(H + (size_t)(row0 + ai * HALF + m * 16) * 512 + col0) = w; }
    }
};
struct EpiMoeDown {
    static constexpr bool PERM = true, AFTER_DRAIN = false;
    bf16_t* Y;
    __device__ __forceinline__ void operator()(const f32x4 (&acc)[2][2][4][2], const Unit& u, int wr, int wc, int fr, int fq) const {
        const int row0 = u.pm * BM + wr * 64 + fr, col0 = (u.pn & 3) * BM + wc * 32 + 8 * fq;
#pragma unroll
        for (int ai = 0; ai < 2; ++ai)
#pragma unroll
            for (int m = 0; m < 4; ++m) { bf16_t* rowp = Y + (size_t)(row0 + ai * HALF + m * 16) * 1024 + col0;
#pragma unroll
                for (int bj = 0; bj < 2; ++bj) { const f32x4 v0 = acc[ai][bj][m][0], v1 = acc[ai][bj][m][1];
                    u32x4 w; w.x = cvt_pk_bf16(v0[0], v0[1]); w.y = cvt_pk_bf16(v0[2], v0[3]); w.z = cvt_pk_bf16(v1[0], v1[1]); w.w = cvt_pk_bf16(v1[2], v1[3]);
                    *(u32x4*)(rowp + bj * HALF) = w; } }
    }
};
struct MoeOrder {
    int nunits, G, c; const PG8_LAS int* tab;
    __device__ __forceinline__ bool next(int i, Unit& u) const {
        const int L = i * G + c; if (L >= nunits) return false;
        const int rt = L >> 2; u.pm = rt; u.pn = __builtin_amdgcn_readfirstlane(tab[rt]) * 4 + (L & 3); return true;
    }
    __device__ __forceinline__ void a_ready(const Unit&) const {}
    __device__ __forceinline__ void done(const Unit&) const {}
};
template <class Epi, class Sched, bool STAMP = false>
__device__ __forceinline__ void gemm_phase(PG8_LAS unsigned char* lds, const Gemm g, const Sched& S, const Epi& E, unsigned long long* stamps, const int wid_in) {
    int ln_; asm volatile("v_mbcnt_lo_u32_b32 %0, -1, 0\n\tv_mbcnt_hi_u32_b32 %0, -1, %0" : "=v"(ln_)); const int tid = wid_in * 64 + ln_, wid = wid_in, lane = tid & 63, wr = wid >> 2, wc = wid & 3, fr = lane & 15, fq = lane >> 4;
    const int K = g.K, nt = K / BK;
    int ts_lo = 0, ts_hi = 0, nts = 0; const unsigned long long rt_entry = STAMP ? (unsigned long long)wall_clock64() : 0ull;
#define PG8_STAMP() do { if (STAMP && wid == 0 && nts < 64) { const unsigned long long _c = (unsigned long long)clock64(); \
        ts_lo = (lane == nts) ? (int)(unsigned)_c : ts_lo; ts_hi = (lane == nts) ? (int)(unsigned)(_c >> 32) : ts_hi; ++nts; } } while (0)
    PG8_STAMP();
    unsigned voffA[2], voffB[2];
#pragma unroll
    for (int i = 0; i < 2; ++i) { int R, C; stage_rc(tid * 16 + i * 8192, R, C); const int Rb = Epi::PERM ? ((R & ~31) + perm32(R & 31)) : R;
        voffA[i] = (unsigned)(R * K + C) * 2u; voffB[i] = (unsigned)(Rb * K + C) * 2u; }
    const size_t kstep = (size_t)(BK * 2);
    const size_t hstep = (size_t)HALF * K * 2;
    const size_t tstep = 2 * hstep;
    const unsigned ldsw = (unsigned)wid * 1024u;
    const int aoff = lds_byte(wr * 64 + fr, fq * 8), boff = lds_byte(wc * 32 + fr, fq * 8);
#define PG8_SA(b, h) (((b) * 2 + (h)) * HTB)
#define PG8_SB(b, h) ((4 + (b) * 2 + (h)) * HTB)
#define PG8_STAGE(bufoff, gbase, voff) do { _Pragma("unroll") for (int _i = 0; _i < 2; ++_i) \
        __builtin_amdgcn_global_load_lds((const unsigned*)((const char*)(gbase) + (voff)[_i]), (PG8_LAS unsigned*)(lds + (bufoff) + ldsw + _i * 8192), 16, 0, 0); } while (0)
#define PG8_LDA(dst, b, h) do { _Pragma("unroll") for (int m = 0; m < 4; ++m) _Pragma("unroll") for (int k = 0; k < 2; ++k) dst[m][k] = *(const PG8_LAS bf16x8*)(lds + PG8_SA(b, h) + aoff + m * 2048 + k * 1024); } while (0)
#define PG8_LDB(dst, b, h) do { _Pragma("unroll") for (int n = 0; n < 2; ++n) _Pragma("unroll") for (int k = 0; k < 2; ++k) dst[n][k] = *(const PG8_LAS bf16x8*)(lds + PG8_SB(b, h) + boff + n * 2048 + k * 1024); } while (0)
#define PG8_MMA(ai, bj, At, Bt) do { __builtin_amdgcn_s_setprio(1); _Pragma("unroll") for (int m = 0; m < 4; ++m) _Pragma("unroll") for (int n = 0; n < 2; ++n) _Pragma("unroll") for (int k = 0; k < 2; ++k) \
        acc[ai][bj][m][n] = __builtin_amdgcn_mfma_f32_16x16x32_bf16(Bt[n][k], At[m][k], acc[ai][bj][m][n], 0, 0, 0); __builtin_amdgcn_s_setprio(0); } while (0)
#define PG8_WAIT_V(n) asm volatile("s_waitcnt vmcnt(" #n ")" ::: "memory")
#define PG8_WAIT_L(n) asm volatile("s_waitcnt lgkmcnt(" #n ")" ::: "memory")
#define PG8_BAR __builtin_amdgcn_s_barrier()
#define PG8_SCHED __builtin_amdgcn_sched_barrier(0)
    Unit cur, nxt; int ui = 0;
    if (!S.next(0, cur)) return;
    f32x4 acc[2][2][4][2];
#pragma unroll
    for (int a = 0; a < 2; ++a)
#pragma unroll
        for (int b = 0; b < 2; ++b)
#pragma unroll
            for (int m = 0; m < 4; ++m)
#pragma unroll
                for (int n = 0; n < 2; ++n) acc[a][b][m][n] = (f32x4){0.f, 0.f, 0.f, 0.f};
    bf16x8 At[4][2], B0[2][2], B1[2][2];
    const char* cA = (const char*)g.A + (size_t)cur.pm * tstep; const char* cB = (const char*)g.Bt + (size_t)cur.pn * tstep;
    S.a_ready(cur);
    PG8_STAGE(PG8_SB(0, 0), cB, voffB); PG8_STAGE(PG8_SA(0, 0), cA, voffA); PG8_STAGE(PG8_SB(0, 1), cB + hstep, voffB); PG8_STAGE(PG8_SA(0, 1), cA + hstep, voffA);
    if (wr == 1) PG8_BAR;
    PG8_WAIT_V(4); PG8_BAR;
    PG8_STAGE(PG8_SB(1, 0), cB + kstep, voffB); PG8_STAGE(PG8_SA(1, 0), cA + kstep, voffA); PG8_STAGE(PG8_SB(1, 1), cB + hstep + kstep, voffB);
    PG8_WAIT_V(6); PG8_BAR;
    PG8_STAMP();
    for (;;) {
        const bool has_next = S.next(ui + 1, nxt);
        const char* nA = has_next ? (const char*)g.A + (size_t)nxt.pm * tstep : cA; const char* nB = has_next ? (const char*)g.Bt + (size_t)nxt.pn * tstep : cB;
        for (int t = 0; t < nt; t += 2) {
            const bool last = (t == nt - 2);
            const char* a1 = cA + (size_t)(t + 1) * kstep;
            const char* a2 = last ? nA : cA + (size_t)(t + 2) * kstep; const char* b2 = last ? nB : cB + (size_t)(t + 2) * kstep;
            const char* a3 = a2 + kstep; const char* b3 = b2 + kstep;
            if (last && has_next) S.a_ready(nxt);
            PG8_LDB(B0, 0, 0); PG8_SCHED; PG8_LDA(At, 0, 0); PG8_STAGE(PG8_SA(1, 1), a1 + hstep, voffA);
            PG8_WAIT_L(8); PG8_BAR; PG8_WAIT_L(0); PG8_MMA(0, 0, At, B0); PG8_BAR; PG8_SCHED;
            PG8_LDB(B1, 0, 1); PG8_STAGE(PG8_SB(0, 0), b2, voffB);
            PG8_BAR; PG8_WAIT_L(0); PG8_MMA(0, 1, At, B1); PG8_BAR;
            PG8_LDA(At, 0, 1); PG8_STAGE(PG8_SA(0, 0), a2, voffA);
            PG8_BAR; PG8_WAIT_L(0); PG8_MMA(1, 0, At, B0); PG8_BAR; PG8_SCHED;
            PG8_STAGE(PG8_SB(0, 1), b2 + hstep, voffB);
            PG8_WAIT_V(6); PG8_BAR; PG8_MMA(1, 1, At, B1); PG8_BAR;
            PG8_LDB(B0, 1, 0); PG8_SCHED; PG8_LDA(At, 1, 0); PG8_STAGE(PG8_SA(0, 1), a2 + hstep, voffA);
            PG8_WAIT_L(8); PG8_BAR; PG8_WAIT_L(0); PG8_MMA(0, 0, At, B0); PG8_BAR; PG8_SCHED;
            PG8_LDB(B1, 1, 1); PG8_STAGE(PG8_SB(1, 0), b3, voffB);
            PG8_BAR; PG8_WAIT_L(0); PG8_MMA(0, 1, At, B1); PG8_BAR;
            PG8_LDA(At, 1, 1); PG8_STAGE(PG8_SA(1, 0), a3, voffA);
            PG8_BAR; PG8_WAIT_L(0); PG8_MMA(1, 0, At, B0); PG8_BAR; PG8_SCHED;
            PG8_STAGE(PG8_SB(1, 1), b3 + hstep, voffB);
            PG8_WAIT_V(6); PG8_BAR; PG8_MMA(1, 1, At, B1); PG8_BAR;
        }
        PG8_STAMP();
        if constexpr (!Epi::AFTER_DRAIN) { E(acc, cur, wr, wc, fr, fq); S.done(cur); }
        PG8_STAMP();
        if (!has_next) break;
#pragma unroll
        for (int a = 0; a < 2; ++a)
#pragma unroll
            for (int b = 0; b < 2; ++b)
#pragma unroll
                for (int m = 0; m < 4; ++m)
#pragma unroll
                    for (int n = 0; n < 2; ++n) acc[a][b][m][n] = (f32x4){0.f, 0.f, 0.f, 0.f};
        cur = nxt; cA = nA; cB = nB; ++ui;
    }
    PG8_WAIT_V(0);
    if (wr == 0) PG8_BAR;
    PG8_BAR;
    if constexpr (Epi::AFTER_DRAIN) { E.fused(acc, cur, wr, wc, fr, fq, lds, wid, lane); S.done(cur); }
    PG8_STAMP();
    if (STAMP && wid == 0) { stamps[lane] = lane < nts ? (((unsigned long long)(unsigned)ts_hi << 32) | (unsigned)ts_lo) : 0ull;
        if (lane == 62) stamps[62] = rt_entry; if (lane == 63) stamps[63] = (unsigned long long)wall_clock64(); }
#undef PG8_STAMP
#undef PG8_SA
#undef PG8_SB
#undef PG8_STAGE
#undef PG8_LDA
#undef PG8_LDB
#undef PG8_MMA
#undef PG8_WAIT_V
#undef PG8_WAIT_L
#undef PG8_BAR
#undef PG8_SCHED
}
}

__device__ __forceinline__ f32x4 ld_bf4(const bf16_t* p) { const u32x2 w = *(const u32x2*)p; return (f32x4){__uint_as_float(w.x << 16), __uint_as_float(w.x & 0xffff0000u), __uint_as_float(w.y << 16), __uint_as_float(w.y & 0xffff0000u)}; }
__device__ __forceinline__ float fast_sigmoid(float x) { return __builtin_amdgcn_rcpf(1.0f + __builtin_amdgcn_exp2f(-LOG2E * x)); }
__device__ __forceinline__ float fast_tanh(float x) { return 1.0f - 2.0f * __builtin_amdgcn_rcpf(1.0f + __builtin_amdgcn_exp2f(2.0f * LOG2E * x)); }
__device__ __forceinline__ void ld_pq8(const bf16_t* p, const bf16_t* q, bool hp, float (&o)[8]) {
    const u32x4 a = *(const u32x4*)p; u32x4 b = (u32x4){0u, 0u, 0u, 0u}; if (hp) b = *(const u32x4*)q;
    o[0] = __uint_as_float(a.x << 16) + __uint_as_float(b.x << 16); o[1] = __uint_as_float(a.x & 0xffff0000u) + __uint_as_float(b.x & 0xffff0000u);
    o[2] = __uint_as_float(a.y << 16) + __uint_as_float(b.y << 16); o[3] = __uint_as_float(a.y & 0xffff0000u) + __uint_as_float(b.y & 0xffff0000u);
    o[4] = __uint_as_float(a.z << 16) + __uint_as_float(b.z << 16); o[5] = __uint_as_float(a.z & 0xffff0000u) + __uint_as_float(b.z & 0xffff0000u);
    o[6] = __uint_as_float(a.w << 16) + __uint_as_float(b.w << 16); o[7] = __uint_as_float(a.w & 0xffff0000u) + __uint_as_float(b.w & 0xffff0000u);
}
__device__ __forceinline__ bf16x8 pack8(const float (&o)[8]) { u32x4 w; w.x = pk2(o[0], o[1]); w.y = pk2(o[2], o[3]); w.z = pk2(o[4], o[5]); w.w = pk2(o[6], o[7]); return __builtin_bit_cast(bf16x8, w); }
__device__ __forceinline__ void ph_prep(Frame& F, const Args& A, int e, int parts) {
    PHASE_PIN(F);
    unsigned char* ws = F.ws; const int lane = F.lane;
    const bf16_t* proj = (const bf16_t*)(ws + WS_PROJ);
    const float* mu_rkv = F.ka->in[4] + (size_t)e * 3 * 512;
    const float* w0 = F.ka->in[6] + e * 512; const float* a0 = F.ka->in[9] + e * 512;
    const float* k_k = F.ka->in[14] + e * 512; const float* k_a = F.ka->in[15] + e * 512; const float* r_k = F.ka->in[16] + e * 512;
    const float* v0 = F.ka->in[20];
    const float* kvn = F.ka->in[23] + e * 128; const float* ikn = F.ka->in[25] + e * 64;
    float* SIN = (float*)(ws + WS_SIN); float* VF = (float*)(ws + WS_VF); float* GATE = (float*)(ws + WS_GATE); float* BON = (float*)(ws + SM_BONUS);
    unsigned* SGN = (unsigned*)(ws + SM_SGN);
    bf16_t* CN = (bf16_t*)(ws + WS_CN); bf16_t* KI = (bf16_t*)(ws + WS_KI); bf16_t* QI = (bf16_t*)(ws + WS_QI);
    if (parts & 1)
    for (int m = F.gw; m < NT; m += F.ngw) {
        const bf16_t* pr = proj + (size_t)m * NCOL;
        const float c0 = bf2f(pr[C_CKV + lane]), c1 = bf2f(pr[C_CKV + 64 + lane]);
        const float rs = rsqrtf(wave_sum(c0 * c0 + c1 * c1) * (1.f / 128.f) + RMS_EPS);
        CN[(size_t)m * 128 + lane] = (bf16_t)f2bf(c0 * rs * kvn[lane]); CN[(size_t)m * 128 + 64 + lane] = (bf16_t)f2bf(c1 * rs * kvn[64 + lane]);
        const float ki = bf2f(pr[C_KI + lane]); const float rs2 = rsqrtf(wave_sum(ki * ki) * (1.f / 64.f) + RMS_EPS);
        KI[(size_t)m * 64 + lane] = (bf16_t)f2bf(ki * rs2 * ikn[lane]);
        unsigned sg = 0;
#pragma unroll
        for (int hh = 0; hh < 8; ++hh) { const float w = bf2f(pr[C_WI + hh]); if (w < 0.f) sg |= 1u << hh;
            QI[(size_t)m * 512 + hh * 64 + lane] = (bf16_t)f2bf(fabsf(w) * bf2f(pr[C_QI + hh * 64 + lane])); }
        if (lane == 0) SGN[m] = sg;
    }
    if (parts & 2) { const int r = lane & 31, hf = lane >> 5;
      const bf16_t* L2W = (const bf16_t*)(ws + W_L2) + (size_t)e * (288 * 512);
      const bf16_t* w2T = L2W; const bf16_t* a2T = L2W + 64 * 512; const bf16_t* g2T = L2W + 128 * 512; const bf16_t* v2T = L2W + 256 * 512;
      for (int it = F.gw; it < 512 * 2; it += F.ngw) {
        const int half = it & 1, tile = it >> 1, m = tile * 32 + r, t = m & (TT - 1), b = m >> 13; const bool hp = t > 0;
        const bf16_t* pr = proj + (size_t)m * NCOL; const bf16_t* pp = pr - NCOL;
        bf16x8 fw[4], fa[4], fg[8], fv[2];
#pragma unroll
        for (int ks = 0; ks < 4; ++ks) { float o[8]; ld_pq8(pr + C_PW + 16 * ks + 8 * hf, pp + C_QW + 16 * ks + 8 * hf, hp, o);
#pragma unroll
            for (int j = 0; j < 8; ++j) o[j] = fast_tanh(o[j]);
            fw[ks] = pack8(o);
            ld_pq8(pr + C_PA + 16 * ks + 8 * hf, pp + C_QA + 16 * ks + 8 * hf, hp, o); fa[ks] = pack8(o); }
#pragma unroll
        for (int ks = 0; ks < 8; ++ks) { float o[8]; ld_pq8(pr + C_PG + 16 * ks + 8 * hf, pp + C_QG + 16 * ks + 8 * hf, hp, o);
#pragma unroll
            for (int j = 0; j < 8; ++j) o[j] = fast_sigmoid(o[j]);
            fg[ks] = pack8(o); }
#pragma unroll
        for (int ks = 0; ks < 2; ++ks) { float o[8] = {0.f, 0.f, 0.f, 0.f, 0.f, 0.f, 0.f, 0.f}; if (e == 1) ld_pq8(pr + C_PV + 16 * ks + 8 * hf, pp + C_QV + 16 * ks + 8 * hf, hp, o); fv[ks] = pack8(o); }
#pragma unroll 1
        for (int hq = 0; hq < 4; ++hq) {
        const int hh = 4 * half + hq;
        float ss = 0.f, bon = 0.f;
        float* so = SIN + ((size_t)(b * 8 + hh) * TT + t) * 384;
#pragma unroll
        for (int sub = 0; sub < 2; ++sub)
#pragma unroll
            for (int g = 0; g < 4; ++g) { const int ch4 = hh * 64 + sub * 32 + 8 * g + 4 * hf;
                const f32x4 kk0 = ld_bf4(pr + C_K + ch4); f32x4 kp = (f32x4){0.f, 0.f, 0.f, 0.f}; if (hp) kp = ld_bf4(pp + C_K + ch4);
                const f32x4 mk = *(const f32x4*)(mu_rkv + 512 + ch4), kk4 = *(const f32x4*)(k_k + ch4);
#pragma unroll
                for (int j = 0; j < 4; ++j) { const float kx = (kk0[j] + (kp[j] - kk0[j]) * mk[j]) * kk4[j]; ss += kx * kx; } }
        ss += __shfl_xor(ss, 32);
        const float rn = rsqrtf(fmaxf(ss, 1e-12f));
#pragma unroll 1
        for (int sub = 0; sub < 2; ++sub) {
            const int cb = hh * 64 + sub * 32;
            f32x16 acc;
#pragma unroll
            for (int i = 0; i < 16; ++i) acc[i] = 0.f;
#pragma unroll
            for (int ks = 0; ks < 4; ++ks) acc = MFMA32(*(const bf16x8*)(w2T + (size_t)(cb + r) * 64 + 16 * ks + 8 * hf), fw[ks], acc);
#pragma unroll
            for (int g = 0; g < 4; ++g) { const int ch4 = cb + 8 * g + 4 * hf; const f32x4 b0 = *(const f32x4*)(w0 + ch4); f32x4 d;
#pragma unroll
                for (int j = 0; j < 4; ++j) d[j] = __builtin_amdgcn_exp2f(-0.6065306597126334f * LOG2E * fast_sigmoid(b0[j] + acc[4 * g + j]));
                *(f32x4*)(so + 64 + sub * 32 + 8 * g + 4 * hf) = d; }
            float icv[16];
#pragma unroll
            for (int i = 0; i < 16; ++i) acc[i] = 0.f;
#pragma unroll
            for (int ks = 0; ks < 4; ++ks) acc = MFMA32(*(const bf16x8*)(a2T + (size_t)(cb + r) * 64 + 16 * ks + 8 * hf), fa[ks], acc);
#pragma unroll
            for (int g = 0; g < 4; ++g) { const int ch4 = cb + 8 * g + 4 * hf; const f32x4 b0 = *(const f32x4*)(a0 + ch4);
#pragma unroll
                for (int j = 0; j < 4; ++j) icv[4 * g + j] = fast_sigmoid(b0[j] + acc[4 * g + j]); }
#pragma unroll
            for (int i = 0; i < 16; ++i) acc[i] = 0.f;
#pragma unroll
            for (int ks = 0; ks < 8; ++ks) acc = MFMA32(*(const bf16x8*)(g2T + (size_t)(cb + r) * 128 + 16 * ks + 8 * hf), fg[ks], acc);
#pragma unroll
            for (int g = 0; g < 4; ++g) *(f32x4*)(GATE + (size_t)m * 512 + cb + 8 * g + 4 * hf) = (f32x4){acc[4 * g], acc[4 * g + 1], acc[4 * g + 2], acc[4 * g + 3]};
            if (e == 1) {
#pragma unroll
                for (int i = 0; i < 16; ++i) acc[i] = 0.f;
#pragma unroll
                for (int ks = 0; ks < 2; ++ks) acc = MFMA32(*(const bf16x8*)(v2T + (size_t)(cb + r) * 32 + 16 * ks + 8 * hf), fv[ks], acc);
            }
#pragma unroll
            for (int g = 0; g < 4; ++g) {
                const int ch4 = cb + 8 * g + 4 * hf;
                const f32x4 rr = ld_bf4(pr + C_R + ch4), kk0 = ld_bf4(pr + C_K + ch4), vv = ld_bf4(pr + C_V + ch4);
                f32x4 rp = (f32x4){0.f, 0.f, 0.f, 0.f}, kp = rp, vp = rp;
                if (hp) { rp = ld_bf4(pp + C_R + ch4); kp = ld_bf4(pp + C_K + ch4); vp = ld_bf4(pp + C_V + ch4); }
                const f32x4 mr = *(const f32x4*)(mu_rkv + ch4), mk = *(const f32x4*)(mu_rkv + 512 + ch4), mv = *(const f32x4*)(mu_rkv + 1024 + ch4);
                const f32x4 kk4 = *(const f32x4*)(k_k + ch4), ka4 = *(const f32x4*)(k_a + ch4), rk4 = *(const f32x4*)(r_k + ch4);
                const f32x4 r1 = rr + (rp - rr) * mr, k1 = kk0 + (kp - kk0) * mk; f32x4 v1 = vv + (vp - vv) * mv;
                if (e == 1) { const f32x4 vb = *(const f32x4*)(v0 + ch4), vf = *(const f32x4*)(VF + (size_t)m * 512 + ch4);
#pragma unroll
                    for (int j = 0; j < 4; ++j) v1[j] = v1[j] + (vf[j] - v1[j]) * fast_sigmoid(vb[j] + acc[4 * g + j]); }
                else *(f32x4*)(VF + (size_t)m * 512 + ch4) = v1;
                f32x4 km, kn, bb;
#pragma unroll
                for (int j = 0; j < 4; ++j) { kn[j] = k1[j] * kk4[j] * rn; bb[j] = icv[4 * g + j] * kn[j];
                    km[j] = k1[j] * (1.0f + (icv[4 * g + j] - 1.0f) * ka4[j]); bon += r1[j] * km[j] * rk4[j]; }
                *(f32x4*)(so + sub * 32 + 8 * g + 4 * hf) = r1; *(f32x4*)(so + 128 + sub * 32 + 8 * g + 4 * hf) = km; *(f32x4*)(so + 320 + sub * 32 + 8 * g + 4 * hf) = v1;
                *(f32x4*)(so + 192 + sub * 32 + 8 * g + 4 * hf) = kn; *(f32x4*)(so + 256 + sub * 32 + 8 * g + 4 * hf) = bb;
                asm volatile("" ::: "memory");
            }
        }
        bon += __shfl_xor(bon, 32);
        if (hf == 0) BON[m * 8 + hh] = bon;
        }
      } }
    if (parts & 4) { bf16_t* QA = (bf16_t*)(ws + WS_QA); const bf16_t* WkB = (const bf16_t*)(ws + W_WKB) + (size_t)e * 8 * 128 * 64;
      const int ntile = (NT / 64) * 2 * 8;
      for (int tI = F.gw; tI < ntile; tI += F.ngw) {
          const int hh = tI & 7, nt = (tI >> 3) & 1, mt = tI >> 4;
          EpiStoreBf16 E{QA + hh * 128, 1024, nt * 64, nt * 64 + 32};
          sg_tile(proj + C_QB + hh * 64, NCOL, WkB + (size_t)hh * 128 * 64 + (size_t)(nt * 64) * 64, WkB + (size_t)hh * 128 * 64 + (size_t)(nt * 64 + 32) * 64, 64, 64, mt * 64, E, F.lane);
      } }
}

__device__ __forceinline__ float allred16(float x) {
    x += __builtin_bit_cast(float, __builtin_amdgcn_update_dpp(0, __builtin_bit_cast(int, x), 0x128, 0xf, 0xf, false));
    x += __builtin_bit_cast(float, __builtin_amdgcn_update_dpp(0, __builtin_bit_cast(int, x), 0x124, 0xf, 0xf, false));
    x += __builtin_bit_cast(float, __builtin_amdgcn_update_dpp(0, __builtin_bit_cast(int, x), 0x122, 0xf, 0xf, false));
    x += __builtin_bit_cast(float, __builtin_amdgcn_update_dpp(0, __builtin_bit_cast(int, x), 0x121, 0xf, 0xf, false));
    return x;
}
__device__ __forceinline__ void ph_scan(Frame& F) {
    PHASE_PIN(F);
    if (F.wave != 0) return;
    const int lane = F.lane, i = lane >> 4, kq = lane & 15;
    for (int task = blockIdx.x; task < 256; task += gridDim.x) {
        const int bh = task >> 4, rg = task & 15, row = 4 * rg + i, b = bh >> 3, hh = bh & 7;
        const float* sin = (const float*)(F.ws + WS_SIN) + (size_t)bh * TT * 384;
        float* Y = (float*)(F.ws + WS_Y) + (size_t)b * TT * 512 + hh * 64 + row;
        f32x4 R[8], W[8], K[8], KK[8], B[8]; float V[8];
#pragma unroll
        for (int j = 0; j < 8; ++j) { const float* p = sin + (size_t)j * 384; R[j] = *(const f32x4*)(p + 4 * kq); W[j] = *(const f32x4*)(p + 64 + 4 * kq); K[j] = *(const f32x4*)(p + 128 + 4 * kq);
            KK[j] = *(const f32x4*)(p + 192 + 4 * kq); B[j] = *(const f32x4*)(p + 256 + 4 * kq); V[j] = p[320 + row]; }
        float s0 = 0.f, s1 = 0.f, s2 = 0.f, s3 = 0.f;
        for (int t0 = 0; t0 < TT; t0 += 8) {
#pragma unroll
            for (int j = 0; j < 8; ++j) {
                float p = s0 * KK[j].x + s1 * KK[j].y + s2 * KK[j].z + s3 * KK[j].w; p = allred16(p);
                s0 = s0 * W[j].x - p * B[j].x + V[j] * K[j].x; s1 = s1 * W[j].y - p * B[j].y + V[j] * K[j].y;
                s2 = s2 * W[j].z - p * B[j].z + V[j] * K[j].z; s3 = s3 * W[j].w - p * B[j].w + V[j] * K[j].w;
                float y = s0 * R[j].x + s1 * R[j].y + s2 * R[j].z + s3 * R[j].w; y = allred16(y);
                if (kq == 0) Y[(size_t)(t0 + j) * 512] = y;
                if (t0 + j + 8 < TT) { const float* p2 = sin + (size_t)(t0 + j + 8) * 384; R[j] = *(const f32x4*)(p2 + 4 * kq); W[j] = *(const f32x4*)(p2 + 64 + 4 * kq); K[j] = *(const f32x4*)(p2 + 128 + 4 * kq);
                    KK[j] = *(const f32x4*)(p2 + 192 + 4 * kq); B[j] = *(const f32x4*)(p2 + 256 + 4 * kq); V[j] = p2[320 + row]; }
            }
        }
    }
}

constexpr size_t S1_TMP_STRIDE = 114688, S1_OUT_STRIDE = 50176;
constexpr int T_TCK = 0, T_TCB = 8192, T_TCKT = 16384, T_TCR = 24576, T_CTB = 32768, T_CTK = 40960, T_CTV = 49152, T_MAK = 57344, T_AAB = 65536, T_AAK = 73728, T_CTKH = 81920, T_CTU = 90112, T_RHSF = 98304;
constexpr int O_PT = 0, O_RH = 8192, O_G = 16384, O_Y0 = 32768, O_GC = 49152;
static_assert(WS_PROJ + 2048 * S1_OUT_STRIDE <= WS_SIN && WS_S1TMP + 1024 * S1_TMP_STRIDE <= WS_END, "scan map");
#define STAGE_SYNC() asm volatile("s_waitcnt vmcnt(0) lgkmcnt(0)" ::: "memory")
template <bool TWO>
__device__ __forceinline__ void mm64_acc(const bf16_t* A1, const bf16_t* B1, const bf16_t* A2, const bf16_t* B2, f32x16& c00, f32x16& c01, f32x16& c10, f32x16& c11, int lane) {
    const int r = lane & 31, h = lane >> 5; const int o = r * 64 + 8 * h;
#pragma unroll
    for (int i = 0; i < 16; ++i) { c00[i] = 0.f; c01[i] = 0.f; c10[i] = 0.f; c11[i] = 0.f; }
#pragma unroll
    for (int k = 0; k < 64; k += 16) {
        const bf16x8 fa0 = *(const bf16x8*)(A1 + o + k), fa1 = *(const bf16x8*)(A1 + o + 2048 + k), fb0 = *(const bf16x8*)(B1 + o + k), fb1 = *(const bf16x8*)(B1 + o + 2048 + k);
        c00 = MFMA32(fb0, fa0, c00); c01 = MFMA32(fb1, fa0, c01); c10 = MFMA32(fb0, fa1, c10); c11 = MFMA32(fb1, fa1, c11);
    }
    if (TWO) {
#pragma unroll
        for (int k = 0; k < 64; k += 16) {
            const bf16x8 fa0 = *(const bf16x8*)(A2 + o + k), fa1 = *(const bf16x8*)(A2 + o + 2048 + k), fb0 = *(const bf16x8*)(B2 + o + k), fb1 = *(const bf16x8*)(B2 + o + 2048 + k);
            c00 = MFMA32(fb0, fa0, c00); c01 = MFMA32(fb1, fa0, c01); c10 = MFMA32(fb0, fa1, c10); c11 = MFMA32(fb1, fa1, c11);
        }
    }
}
template <class Epi>
__device__ __forceinline__ void mm64_epi(const Epi& epi, const f32x16& c00, const f32x16& c01, const f32x16& c10, const f32x16& c11, int lane) {
    const int r = lane & 31, h = lane >> 5;
#pragma unroll
    for (int g = 0; g < 4; ++g) { const int j = 8 * g + 4 * h;
        epi.pair(r, j, (f32x4){c00[4 * g], c00[4 * g + 1], c00[4 * g + 2], c00[4 * g + 3]}, (f32x4){c01[4 * g], c01[4 * g + 1], c01[4 * g + 2], c01[4 * g + 3]});
        epi.pair(32 + r, j, (f32x4){c10[4 * g], c10[4 * g + 1], c10[4 * g + 2], c10[4 * g + 3]}, (f32x4){c11[4 * g], c11[4 * g + 1], c11[4 * g + 2], c11[4 * g + 3]}); }
}
__device__ __forceinline__ u32x2 pk4(f32x4 v) { u32x2 w; w.x = pk2(v.x, v.y); w.y = pk2(v.z, v.w); return w; }
struct EpiMaskLds { LAS float* M; __device__ __forceinline__ void pair(int row, int j, f32x4 v0, f32x4 v1) const {
    f32x4 a, b;
#pragma unroll
    for (int q = 0; q < 4; ++q) { a[q] = (j + q < row) ? v0[q] : 0.f; b[q] = (32 + j + q < row) ? v1[q] : 0.f; }
    *(LAS f32x4*)(M + row * 64 + j) = a; *(LAS f32x4*)(M + row * 64 + 32 + j) = b; } };
template <int INCL> struct EpiMaskBf { bf16_t* O; __device__ __forceinline__ void pair(int row, int j, f32x4 v0, f32x4 v1) const {
    f32x4 a, b;
#pragma unroll
    for (int q = 0; q < 4; ++q) { a[q] = (j + q < row + INCL) ? v0[q] : 0.f; b[q] = (32 + j + q < row + INCL) ? v1[q] : 0.f; }
    *(u32x2*)(O + row * 64 + j) = pk4(a); *(u32x2*)(O + row * 64 + 32 + j) = pk4(b); } };
struct EpiF32 { float* O; __device__ __forceinline__ void pair(int row, int j, f32x4 v0, f32x4 v1) const { *(f32x4*)(O + row * 64 + j) = v0; *(f32x4*)(O + row * 64 + 32 + j) = v1; } };
struct EpiRhat { const bf16_t* R; bf16_t* O; __device__ __forceinline__ void pair(int row, int j, f32x4 v0, f32x4 v1) const {
    *(u32x2*)(O + row * 64 + j) = pk4(ld_bf4(R + row * 64 + j) - v0); *(u32x2*)(O + row * 64 + 32 + j) = pk4(ld_bf4(R + row * 64 + 32 + j) - v1); } };
struct EpiPT { const float* gC; bf16_t* O; __device__ __forceinline__ void pair(int row, int j, f32x4 v0, f32x4 v1) const {
    const float gr = gC[row]; f32x4 a, b;
#pragma unroll
    for (int q = 0; q < 4; ++q) { a[q] = gr * (((j + q == row) ? 1.f : 0.f) - v0[q]); b[q] = gr * (((32 + j + q == row) ? 1.f : 0.f) - v1[q]); }
    *(u32x2*)(O + row * 64 + j) = pk4(a); *(u32x2*)(O + row * 64 + 32 + j) = pk4(b); } };
struct EpiGsc { const float* gC; bf16_t* O; __device__ __forceinline__ void pair(int row, int j, f32x4 v0, f32x4 v1) const {
    *(u32x2*)(O + row * 64 + j) = pk4(v0 * *(const f32x4*)(gC + j)); *(u32x2*)(O + row * 64 + 32 + j) = pk4(v1 * *(const f32x4*)(gC + 32 + j)); } };

__device__ __forceinline__ void ph_scan_s1(Frame& F) {
    PHASE_PIN(F);
    if (F.wave >= 4) return;
    LAS float* Ml = (LAS float*)(F.lds + F.wave * 32768); LAS float* Xl = Ml + 4096;
    const int lane0 = F.lane;
    for (int item = blockIdx.x * 4 + F.wave; item < 2048; item += gridDim.x * 4) {
        int lane = lane0; asm volatile("" : "+v"(lane));
        const int bh = item >> 7, chunk = item & 127;
        unsigned long long zt_; asm volatile("s_mov_b64 %0, 0" : "=s"(zt_));
        unsigned char* tmp = F.ws + WS_S1TMP + (size_t)(blockIdx.x * 4 + F.wave) * S1_TMP_STRIDE + zt_;
        __builtin_amdgcn_fence(__ATOMIC_ACQUIRE, "agent"); asm volatile("s_waitcnt vmcnt(0)" ::: "memory");
        unsigned char* outp = F.ws + WS_PROJ + (size_t)item * S1_OUT_STRIDE;
        bf16_t* TCk = (bf16_t*)(tmp + T_TCK); bf16_t* TCb = (bf16_t*)(tmp + T_TCB); bf16_t* TCkt = (bf16_t*)(tmp + T_TCKT); bf16_t* TCr = (bf16_t*)(tmp + T_TCR);
        bf16_t* CTb = (bf16_t*)(tmp + T_CTB); bf16_t* CTk = (bf16_t*)(tmp + T_CTK); bf16_t* CTv = (bf16_t*)(tmp + T_CTV);
        bf16_t* MAK = (bf16_t*)(tmp + T_MAK); bf16_t* AAB = (bf16_t*)(tmp + T_AAB); bf16_t* AAK = (bf16_t*)(tmp + T_AAK);
        bf16_t* CTKH = (bf16_t*)(tmp + T_CTKH); bf16_t* CTU = (bf16_t*)(tmp + T_CTU); float* RHSF = (float*)(tmp + T_RHSF);
        bf16_t* PT = (bf16_t*)(outp + O_PT); bf16_t* RH = (bf16_t*)(outp + O_RH); bf16_t* Gm = (bf16_t*)(outp + O_G); float* Y0 = (float*)(outp + O_Y0); float* gC = (float*)(outp + O_GC);
        const float* sin = (const float*)(F.ws + WS_SIN) + ((size_t)bh * TT + chunk * 64) * 384;
#ifndef S1_NO_CT
        { float gam[65]; gam[0] = 1.0f;
#pragma unroll
          for (int i = 0; i < 64; ++i) gam[i + 1] = sin[(size_t)i * 384 + 64 + lane];
#pragma unroll
          for (int i = 0; i < 64; ++i) gam[i + 1] *= gam[i];
#pragma unroll
          for (int blk = 0; blk < 8; ++blk) {
            float bt8[8], kt8[8], v8[8];
#pragma unroll
            for (int el = 0; el < 8; ++el) { const int i = blk * 8 + el; const float* p = sin + (size_t)i * 384;
                const float rr = p[lane], kk = p[128 + lane], ka = p[192 + lane], bb = p[256 + lane], vv = p[320 + lane];
                const float kap = gam[i] * ka; const float g = gam[i + 1]; const float inv = __builtin_amdgcn_rcpf(g); const float bt = bb * inv, kt = kk * inv, rt = rr * g;
                TCk[i * 64 + lane] = (bf16_t)f2bf(kap); TCb[i * 64 + lane] = (bf16_t)f2bf(bt); TCkt[i * 64 + lane] = (bf16_t)f2bf(kt); TCr[i * 64 + lane] = (bf16_t)f2bf(rt);
                bt8[el] = bt; kt8[el] = kt; v8[el] = vv; }
            *(bf16x8*)(CTb + lane * 64 + blk * 8) = pack8(bt8); *(bf16x8*)(CTk + lane * 64 + blk * 8) = pack8(kt8); *(bf16x8*)(CTv + lane * 64 + blk * 8) = pack8(v8);
            asm volatile("" ::: "memory");
          }
          gC[lane] = gam[64]; }
#endif
        STAGE_SYNC();
        f32x16 c00, c01, c10, c11;
        mm64_acc<false>(TCk, TCb, nullptr, nullptr, c00, c01, c10, c11, lane); { EpiMaskLds E{Ml}; mm64_epi(E, c00, c01, c10, c11, lane); }
        mm64_acc<false>(TCk, TCkt, nullptr, nullptr, c00, c01, c10, c11, lane); { EpiMaskBf<0> E{MAK}; mm64_epi(E, c00, c01, c10, c11, lane); }
        STAGE_SYNC();
        mm64_acc<false>(MAK, CTv, nullptr, nullptr, c00, c01, c10, c11, lane); { EpiF32 E{RHSF}; mm64_epi(E, c00, c01, c10, c11, lane); }
        STAGE_SYNC();
#ifndef S1_NO_SOLVE
#pragma unroll 1
        for (int pass = 0; pass < 2; ++pass) {
            if (pass & 1) {
#pragma unroll 8
                for (int i = 0; i < 64; ++i) Xl[i * 64 + lane] = RHSF[i * 64 + lane];
            } else {
#pragma unroll 8
                for (int i = 0; i < 64; ++i) Xl[i * 64 + lane] = bf2f(TCk[i * 64 + lane]);
            }
#pragma unroll 1
            for (int i0 = 0; i0 < 64; i0 += 4) {
                float a0 = Xl[i0 * 64 + lane], a1 = Xl[(i0 + 1) * 64 + lane], a2 = Xl[(i0 + 2) * 64 + lane], a3 = Xl[(i0 + 3) * 64 + lane];
#pragma unroll 2
                for (int j4 = 0; j4 < i0; j4 += 4) {
                    const float x0 = Xl[j4 * 64 + lane], x1 = Xl[(j4 + 1) * 64 + lane], x2 = Xl[(j4 + 2) * 64 + lane], x3 = Xl[(j4 + 3) * 64 + lane];
                    const f32x4 m0 = *(const LAS f32x4*)(Ml + i0 * 64 + j4), m1 = *(const LAS f32x4*)(Ml + (i0 + 1) * 64 + j4), m2 = *(const LAS f32x4*)(Ml + (i0 + 2) * 64 + j4), m3 = *(const LAS f32x4*)(Ml + (i0 + 3) * 64 + j4);
                    a0 -= m0.x * x0 + m0.y * x1 + m0.z * x2 + m0.w * x3; a1 -= m1.x * x0 + m1.y * x1 + m1.z * x2 + m1.w * x3;
                    a2 -= m2.x * x0 + m2.y * x1 + m2.z * x2 + m2.w * x3; a3 -= m3.x * x0 + m3.y * x1 + m3.z * x2 + m3.w * x3;
                }
                const f32x4 d1 = *(const LAS f32x4*)(Ml + (i0 + 1) * 64 + i0), d2 = *(const LAS f32x4*)(Ml + (i0 + 2) * 64 + i0), d3 = *(const LAS f32x4*)(Ml + (i0 + 3) * 64 + i0);
                a1 -= d1.x * a0; a2 -= d2.x * a0 + d2.y * a1; a3 -= d3.x * a0 + d3.y * a1 + d3.z * a2;
                Xl[i0 * 64 + lane] = a0; Xl[(i0 + 1) * 64 + lane] = a1; Xl[(i0 + 2) * 64 + lane] = a2; Xl[(i0 + 3) * 64 + lane] = a3;
            }
            bf16_t* dst = (pass & 1) ? CTU : CTKH; const float sgn = (pass & 1) ? -1.0f : 1.0f;
#pragma unroll 1
            for (int blk = 0; blk < 8; ++blk) { float o8[8];
#pragma unroll
                for (int el = 0; el < 8; ++el) o8[el] = sgn * Xl[(blk * 8 + el) * 64 + lane];
                *(bf16x8*)(dst + lane * 64 + blk * 8) = pack8(o8); }
        }
#endif
        mm64_acc<false>(TCr, TCb, nullptr, nullptr, c00, c01, c10, c11, lane); { EpiMaskBf<1> E{AAB}; mm64_epi(E, c00, c01, c10, c11, lane); }
        mm64_acc<false>(TCr, TCkt, nullptr, nullptr, c00, c01, c10, c11, lane); { EpiMaskBf<1> E{AAK}; mm64_epi(E, c00, c01, c10, c11, lane); }
        STAGE_SYNC();
        mm64_acc<false>(AAB, CTKH, nullptr, nullptr, c00, c01, c10, c11, lane); { EpiRhat E{TCr, RH}; mm64_epi(E, c00, c01, c10, c11, lane); }
        mm64_acc<true>(AAB, CTU, AAK, CTv, c00, c01, c10, c11, lane); { EpiF32 E{Y0}; mm64_epi(E, c00, c01, c10, c11, lane); }
        mm64_acc<false>(CTb, CTKH, nullptr, nullptr, c00, c01, c10, c11, lane); { EpiPT E{gC, PT}; mm64_epi(E, c00, c01, c10, c11, lane); }
        mm64_acc<true>(CTU, CTb, CTv, CTk, c00, c01, c10, c11, lane); { EpiGsc E{gC, Gm}; mm64_epi(E, c00, c01, c10, c11, lane); }
        STAGE_SYNC();
    }
}
__device__ __forceinline__ void ph_scan_s2(Frame& F) {
    PHASE_PIN(F);
    if (F.wave != 0 || blockIdx.x >= 32) return;
    const int lane = F.lane, r = lane & 31, hf = lane >> 5; const int bh = blockIdx.x >> 1, vt = blockIdx.x & 1, v = 32 * vt + r;
    bf16_t* SS = (bf16_t*)(F.ws + WS_Y);
    f32x16 acc0, acc1;
#pragma unroll
    for (int i = 0; i < 16; ++i) { acc0[i] = 0.f; acc1[i] = 0.f; }
    u32x2 pt[4][2][4][2]; u32x2 gin[2][2][4];
#define S2_LOADP(buf, chunk) do { const bf16_t* PT_ = (const bf16_t*)(F.ws + WS_PROJ + (size_t)(bh * 128 + (chunk)) * S1_OUT_STRIDE + O_PT); \
        _Pragma("unroll") for (int ni = 0; ni < 2; ++ni) { _Pragma("unroll") for (int s2 = 0; s2 < 4; ++s2) { pt[buf][ni][s2][0] = *(const u32x2*)(PT_ + (32 * ni + r) * 64 + 16 * s2 + 4 * hf); pt[buf][ni][s2][1] = *(const u32x2*)(PT_ + (32 * ni + r) * 64 + 16 * s2 + 8 + 4 * hf); } } } while (0)
#define S2_LOADG(buf, chunk) do { const bf16_t* G_ = (const bf16_t*)(F.ws + WS_PROJ + (size_t)(bh * 128 + (chunk)) * S1_OUT_STRIDE + O_G); \
        _Pragma("unroll") for (int ni = 0; ni < 2; ++ni) { _Pragma("unroll") for (int g = 0; g < 4; ++g) gin[buf][ni][g] = *(const u32x2*)(G_ + v * 64 + 32 * ni + 8 * g + 4 * hf); } } while (0)
#define S2_STEP(pb, gb, chunk) do { bf16_t* so_ = SS + ((size_t)(bh * 128 + (chunk)) * 64 + v) * 64 + 4 * hf; \
        _Pragma("unroll") for (int g = 0; g < 4; ++g) { *(u32x2*)(so_ + 8 * g) = pk4((f32x4){acc0[4 * g], acc0[4 * g + 1], acc0[4 * g + 2], acc0[4 * g + 3]}); *(u32x2*)(so_ + 32 + 8 * g) = pk4((f32x4){acc1[4 * g], acc1[4 * g + 1], acc1[4 * g + 2], acc1[4 * g + 3]}); } \
        bf16x8 sf[4]; { u32x4 w_; \
          w_.x = pk2(acc0[0], acc0[1]); w_.y = pk2(acc0[2], acc0[3]); w_.z = pk2(acc0[4], acc0[5]); w_.w = pk2(acc0[6], acc0[7]); sf[0] = __builtin_bit_cast(bf16x8, w_); \
          w_.x = pk2(acc0[8], acc0[9]); w_.y = pk2(acc0[10], acc0[11]); w_.z = pk2(acc0[12], acc0[13]); w_.w = pk2(acc0[14], acc0[15]); sf[1] = __builtin_bit_cast(bf16x8, w_); \
          w_.x = pk2(acc1[0], acc1[1]); w_.y = pk2(acc1[2], acc1[3]); w_.z = pk2(acc1[4], acc1[5]); w_.w = pk2(acc1[6], acc1[7]); sf[2] = __builtin_bit_cast(bf16x8, w_); \
          w_.x = pk2(acc1[8], acc1[9]); w_.y = pk2(acc1[10], acc1[11]); w_.z = pk2(acc1[12], acc1[13]); w_.w = pk2(acc1[14], acc1[15]); sf[3] = __builtin_bit_cast(bf16x8, w_); } \
        f32x16 n0_, n1_; \
        _Pragma("unroll") for (int q = 0; q < 16; ++q) { n0_[q] = 0.f; n1_[q] = 0.f; } \
        _Pragma("unroll") for (int s2 = 0; s2 < 4; ++s2) { u32x4 a_; a_.x = pt[pb][0][s2][0].x; a_.y = pt[pb][0][s2][0].y; a_.z = pt[pb][0][s2][1].x; a_.w = pt[pb][0][s2][1].y; n0_ = MFMA32(__builtin_bit_cast(bf16x8, a_), sf[s2], n0_); \
            a_.x = pt[pb][1][s2][0].x; a_.y = pt[pb][1][s2][0].y; a_.z = pt[pb][1][s2][1].x; a_.w = pt[pb][1][s2][1].y; n1_ = MFMA32(__builtin_bit_cast(bf16x8, a_), sf[s2], n1_); } \
        _Pragma("unroll") for (int g = 0; g < 4; ++g) { const u32x2 g0_ = gin[gb][0][g], g1_ = gin[gb][1][g]; \
            n0_[4 * g] += __uint_as_float(g0_.x << 16); n0_[4 * g + 1] += __uint_as_float(g0_.x & 0xffff0000u); n0_[4 * g + 2] += __uint_as_float(g0_.y << 16); n0_[4 * g + 3] += __uint_as_float(g0_.y & 0xffff0000u); \
            n1_[4 * g] += __uint_as_float(g1_.x << 16); n1_[4 * g + 1] += __uint_as_float(g1_.x & 0xffff0000u); n1_[4 * g + 2] += __uint_as_float(g1_.y << 16); n1_[4 * g + 3] += __uint_as_float(g1_.y & 0xffff0000u); } \
        acc0 = n0_; acc1 = n1_; } while (0)
    S2_LOADP(0, 0); S2_LOADP(1, 1); S2_LOADP(2, 2); S2_LOADG(0, 0);
    for (int chunk = 0; chunk < 128; chunk += 4) {
        S2_LOADP(3, chunk + 3); S2_LOADG(1, chunk + 1); S2_STEP(0, 0, chunk);
        if (chunk + 4 < 128) S2_LOADP(0, chunk + 4);
        S2_LOADG(0, chunk + 2); S2_STEP(1, 1, chunk + 1);
        if (chunk + 5 < 128) S2_LOADP(1, chunk + 5);
        S2_LOADG(1, chunk + 3); S2_STEP(2, 0, chunk + 2);
        if (chunk + 6 < 128) S2_LOADP(2, chunk + 6);
        if (chunk + 4 < 128) S2_LOADG(0, chunk + 4);
        S2_STEP(3, 1, chunk + 3);
    }
#undef S2_LOADP
#undef S2_LOADG
#undef S2_STEP
}
__device__ __forceinline__ void ph_scan_s3(Frame& F, int e) {
    PHASE_PIN(F);
    const int lane = F.lane, r = lane & 31, hf = lane >> 5;
    const float* ln_g = F.ka->in[17] + e * 512; const float* ln_b = F.ka->in[18] + e * 512;
    const float* GATE = (const float*)(F.ws + WS_GATE); const float* BON = (const float*)(F.ws + SM_BONUS); const float* SIN = (const float*)(F.ws + WS_SIN);
    bf16_t* YC = (bf16_t*)(F.ws + WS_YCAT); const bf16_t* SS = (const bf16_t*)(F.ws + WS_Y);
    for (int item = F.gw; item < 2048; item += F.ngw) {
        const int bh = item >> 7, chunk = item & 127, b = bh >> 3, hh = bh & 7;
        const unsigned char* outp = F.ws + WS_PROJ + (size_t)item * S1_OUT_STRIDE;
        const bf16_t* RH = (const bf16_t*)(outp + O_RH); const float* Y0 = (const float*)(outp + O_Y0);
        f32x16 c[2][2];
        mm64_acc<false>(RH, SS + (size_t)item * 4096, nullptr, nullptr, c[0][0], c[0][1], c[1][0], c[1][1], lane);
#pragma unroll
        for (int mi = 0; mi < 2; ++mi) {
            const int i = 32 * mi + r, t = chunk * 64 + i, m = b * TT + t;
            float s1 = 0.f;
#pragma unroll
            for (int ni = 0; ni < 2; ++ni)
#pragma unroll
                for (int g = 0; g < 4; ++g) { const f32x4 y0 = *(const f32x4*)(Y0 + i * 64 + 32 * ni + 8 * g + 4 * hf);
#pragma unroll
                    for (int q = 0; q < 4; ++q) { c[mi][ni][4 * g + q] += y0[q]; s1 += c[mi][ni][4 * g + q]; } }
            s1 += __shfl_xor(s1, 32); const float mean = s1 * (1.f / 64.f); float s2 = 0.f;
#pragma unroll
            for (int ni = 0; ni < 2; ++ni)
#pragma unroll
                for (int q = 0; q < 16; ++q) { const float d = c[mi][ni][q] - mean; c[mi][ni][q] = d; s2 += d * d; }
            s2 += __shfl_xor(s2, 32); const float rstd = rsqrtf(s2 * (1.f / 64.f) + GN_EPS); const float bon = BON[m * 8 + hh];
            const float* vrow = SIN + ((size_t)bh * TT + t) * 384 + 320;
#pragma unroll
            for (int ni = 0; ni < 2; ++ni)
#pragma unroll
                for (int g = 0; g < 4; ++g) { const int vv = 32 * ni + 8 * g + 4 * hf, ch = hh * 64 + vv;
                    const f32x4 lg = *(const f32x4*)(ln_g + ch), lb = *(const f32x4*)(ln_b + ch), v1 = *(const f32x4*)(vrow + vv), gt = *(const f32x4*)(GATE + (size_t)m * 512 + ch); f32x4 o;
#pragma unroll
                    for (int q = 0; q < 4; ++q) o[q] = (c[mi][ni][4 * g + q] * rstd * lg[q] + lb[q] + bon * v1[q]) * gt[q];
                    *(u32x2*)(YC + (size_t)m * 1024 + ch) = pk4(o); }
        }
    }
}

__device__ __forceinline__ size_t score_row_off(int b, int t) { const int j = t >> 7; return (size_t)b * SCORE_PER_BATCH + (size_t)16384 * (j * (j + 1) / 2) + (size_t)(t & 127) * (128 * (j + 1)); }
__device__ __forceinline__ void ph_idx_score(Frame& F) {
    PHASE_PIN(F);
    const int lane = F.lane, r = lane & 31, h = lane >> 5;
    const bf16_t* QI = (const bf16_t*)(F.ws + WS_QI); const bf16_t* KI = (const bf16_t*)(F.ws + WS_KI); const unsigned* SGN = (const unsigned*)(F.ws + SM_SGN);
    float* SC = (float*)(F.ws + WS_SCORE);
    if (F.wave < 4) return;
    for (int it = blockIdx.x * 4 + (F.wave - 4); it < 4352; it += gridDim.x * 4) {
        const int b = it / 2176; int i = it - b * 2176; i = 2175 - i;
        int a = 1; while (8 * a * (a + 1) <= i) ++a;
        const int rem = i - 8 * a * (a - 1), qt = 16 * (a - 1) + rem / a, g = rem % a;
        const int mq = b * TT + qt * 32 + r;
        bf16x8 qf[8][4];
#pragma unroll
        for (int hh = 0; hh < 8; ++hh)
#pragma unroll
            for (int ks = 0; ks < 4; ++ks) qf[hh][ks] = *(const bf16x8*)(QI + (size_t)mq * 512 + hh * 64 + ks * 16 + 8 * h);
        const unsigned sg = SGN[mq];
        float* srow = SC + score_row_off(b, qt * 32 + r);
        const int kt_end = (16 * g + 15 < qt) ? 16 * g + 15 : qt;
        for (int kt = 16 * g; kt <= kt_end; ++kt) {
            const bf16_t* kp = KI + (size_t)(b * TT + kt * 32 + r) * 64 + 8 * h;
            const bf16x8 kf0 = *(const bf16x8*)(kp), kf1 = *(const bf16x8*)(kp + 16), kf2 = *(const bf16x8*)(kp + 32), kf3 = *(const bf16x8*)(kp + 48);
            float sc[16];
#pragma unroll
            for (int q = 0; q < 16; ++q) sc[q] = 0.f;
#pragma unroll
            for (int hh = 0; hh < 8; ++hh) {
                f32x16 acc;
#pragma unroll
                for (int q = 0; q < 16; ++q) acc[q] = 0.f;
                acc = MFMA32(kf0, qf[hh][0], acc); acc = MFMA32(kf1, qf[hh][1], acc); acc = MFMA32(kf2, qf[hh][2], acc); acc = MFMA32(kf3, qf[hh][3], acc);
                const bool neg = (sg >> hh) & 1u;
#pragma unroll
                for (int q = 0; q < 16; ++q) { const float v = fmaxf(acc[q], 0.f); sc[q] = neg ? sc[q] - v : sc[q] + v; }
            }
#pragma unroll
            for (int g4 = 0; g4 < 4; ++g4) *(f32x4*)(srow + kt * 32 + 8 * g4 + 4 * h) = (f32x4){sc[4 * g4], sc[4 * g4 + 1], sc[4 * g4 + 2], sc[4 * g4 + 3]};
        }
    }
}
__device__ __forceinline__ unsigned block_excl_scan(unsigned v, LAS unsigned* scr, int tid, unsigned* total) {
    const int lane = tid & 63, w = tid >> 6; unsigned x = v;
#pragma unroll
    for (int o = 1; o < 64; o <<= 1) { const unsigned y = __shfl_up(x, o); if (lane >= o) x += y; }
    __syncthreads();
    if (lane == 63) scr[w] = x;
    __syncthreads();
    unsigned base = 0, tot = 0;
#pragma unroll
    for (int j = 0; j < 8; ++j) { const unsigned c = scr[j]; if (j < w) base += c; tot += c; }
    *total = tot;
    return base + x - v;
}
__device__ __forceinline__ void ph_idx_select(Frame& F) {
    PHASE_PIN(F);
    const int lane = F.lane;
    LAS unsigned* hist = (LAS unsigned*)(F.lds + F.wave * LDS_WSCR);
    LAS float* cval = (LAS float*)(hist + 2048); LAS int* cidx = (LAS int*)(cval + 1024);
    const float* SC = (const float*)(F.ws + WS_SCORE); int* SEL = (int*)(F.ws + WS_SEL);
    const unsigned long long lt_mask = (1ull << lane) - 1ull;
    if (F.wave == 0 && blockIdx.x < 32) return;
    const int nsel = F.ngw - 32, wsel = (blockIdx.x < 32) ? blockIdx.x * 7 + F.wave - 1 : 224 + (blockIdx.x - 32) * 8 + F.wave;
    for (int m = wsel; m < NT; m += nsel) {
        const int t = m & (TT - 1), b = m >> 13, n = t + 1; int* sel = SEL + (size_t)m * 256;
        if (n <= 256) {
#pragma unroll
            for (int i = 0; i < 4; ++i) sel[lane + 64 * i] = (lane + 64 * i < n) ? lane + 64 * i : -1;
            continue; }
        const float* srow = SC + score_row_off(b, t);
        const int nch = (n + 255) >> 8;
        float lo = INFINITY, hi = -INFINITY;
        for (int c = 0; c < nch; ++c) { const int idx0 = 256 * c + 4 * lane; if (idx0 < n) { const f32x4 v = *(const f32x4*)(srow + idx0);
#pragma unroll
            for (int i = 0; i < 4; ++i) if (idx0 + i < n) { lo = fminf(lo, v[i]); hi = fmaxf(hi, v[i]); } } }
#pragma unroll
        for (int o = 1; o < 64; o <<= 1) { lo = fminf(lo, __shfl_xor(lo, o)); hi = fmaxf(hi, __shfl_xor(hi, o)); }
        unsigned need = 256u, outpos = 0u;
        for (int level = 0; level < 8; ++level) {
            if (!(hi > lo)) {
                for (int c = 0; c < nch && need > 0u; ++c) { const int idx0 = 256 * c + 4 * lane; f32x4 v = (f32x4){0.f, 0.f, 0.f, 0.f}; if (idx0 < n) v = *(const f32x4*)(srow + idx0);
                    bool f[4]; unsigned before = 0, mine = 0;
#pragma unroll
                    for (int i = 0; i < 4; ++i) { f[i] = (idx0 + i < n) && v[i] == lo; before += __popcll(__ballot(f[i]) & lt_mask); }
                    unsigned total = 0;
#pragma unroll
                    for (int i = 0; i < 4; ++i) total += __popcll(__ballot(f[i]));
#pragma unroll
                    for (int i = 0; i < 4; ++i) { if (f[i]) { const unsigned p = before + mine; if (p < need) sel[outpos + p] = idx0 + i; ++mine; } }
                    const unsigned took = total < need ? total : need; outpos += took; need -= took; }
                break;
            }
            const float scale = 2047.0f / (hi - lo);
#pragma unroll
            for (int i = 0; i < 8; ++i) *(LAS u32x4*)(hist + 4 * (lane + 64 * i)) = (u32x4){0u, 0u, 0u, 0u};
            LDS_WAIT(); asm volatile("" ::: "memory");
            for (int c = 0; c < nch; ++c) { const int idx0 = 256 * c + 4 * lane; if (idx0 < n) { const f32x4 v = *(const f32x4*)(srow + idx0);
#pragma unroll
                for (int i = 0; i < 4; ++i) if (idx0 + i < n && v[i] >= lo && v[i] <= hi) { int bq = (int)((v[i] - lo) * scale); bq = bq > 2047 ? 2047 : bq;
                    __hip_atomic_fetch_add(&hist[bq], 1u, __ATOMIC_RELAXED, __HIP_MEMORY_SCOPE_WORKGROUP); } } }
            LDS_WAIT(); asm volatile("" ::: "memory");
            unsigned hv[32], L = 0;
#pragma unroll
            for (int i = 0; i < 8; ++i) { const u32x4 h4 = *(const LAS u32x4*)(hist + 2044 - 32 * lane - 4 * i); hv[4 * i] = h4.w; hv[4 * i + 1] = h4.z; hv[4 * i + 2] = h4.y; hv[4 * i + 3] = h4.x; L += h4.x + h4.y + h4.z + h4.w; }
            unsigned xs = L;
#pragma unroll
            for (int o = 1; o < 64; o <<= 1) { const unsigned y = __shfl_up(xs, o); if (lane >= o) xs += y; }
            unsigned run = xs - L; const bool finder = (run < need && need <= run + L);
            int fb = 0; unsigned fneed = 0, fcnt = 0;
#pragma unroll
            for (int i = 0; i < 32; ++i) { if (run < need && need <= run + hv[i]) { fb = 2047 - 32 * lane - i; fneed = need - run; fcnt = hv[i]; } run += hv[i]; }
            const int fl = __ffsll((long long)__ballot(finder)) - 1;
            const int bstar = __shfl(fb, fl); const unsigned need2 = __shfl(fneed, fl), cnum = __shfl(fcnt, fl);
            const bool listed = cnum <= 1024u;
            float lo2 = INFINITY, hi2 = -INFINITY; unsigned cpos = 0;
            for (int c = 0; c < nch; ++c) { const int idx0 = 256 * c + 4 * lane; f32x4 v = (f32x4){0.f, 0.f, 0.f, 0.f}; if (idx0 < n) v = *(const f32x4*)(srow + idx0);
                bool fg[4], fe[4]; unsigned bg = 0, be = 0, tg = 0, te = 0;
#pragma unroll
                for (int i = 0; i < 4; ++i) { const bool act = (idx0 + i < n) && v[i] >= lo && v[i] <= hi; int bq = (int)((v[i] - lo) * scale); bq = bq > 2047 ? 2047 : bq;
                    fg[i] = act && bq > bstar; fe[i] = act && bq == bstar;
                    const unsigned long long mg = __ballot(fg[i]), me = __ballot(fe[i]); bg += __popcll(mg & lt_mask); be += __popcll(me & lt_mask); tg += __popcll(mg); te += __popcll(me); }
                unsigned mg2 = 0, me2 = 0;
#pragma unroll
                for (int i = 0; i < 4; ++i) {
                    if (fg[i]) { sel[outpos + bg + mg2] = idx0 + i; ++mg2; }
                    if (fe[i]) { lo2 = fminf(lo2, v[i]); hi2 = fmaxf(hi2, v[i]); if (listed) { cval[cpos + be + me2] = v[i]; cidx[cpos + be + me2] = idx0 + i; } ++me2; } }
                outpos += tg; cpos += te; }
            need = need2;
            if (listed) {
                LDS_WAIT(); asm volatile("" ::: "memory");
                for (unsigned i = lane; i < cnum; i += 64) { const float vi = cval[i]; const int ii = cidx[i]; unsigned rank = 0;
                    for (unsigned j = 0; j < cnum; ++j) { const float vj = cval[j]; rank += (vj > vi || (vj == vi && cidx[j] < ii)) ? 1u : 0u; }
                    if (rank < need) sel[outpos + rank] = ii; }
                LDS_WAIT(); asm volatile("" ::: "memory");
                break;
            }
#pragma unroll
            for (int o = 1; o < 64; o <<= 1) { lo2 = fminf(lo2, __shfl_xor(lo2, o)); hi2 = fmaxf(hi2, __shfl_xor(hi2, o)); }
            lo = lo2; hi = hi2;
        }
    }
}

#define MFMA16(a, b, c) __builtin_amdgcn_mfma_f32_16x16x32_bf16((a), (b), (c), 0, 0, 0)
__device__ __forceinline__ void ph_sparse(Frame& F, int e) {
    PHASE_PIN(F);
    const int lane = F.lane, hd = lane & 15, gq = lane >> 4; unsigned char* ws = F.ws;
    LAS unsigned char* Tl = F.lds + F.wave * LDS_WSCR;
    const bf16_t* QA = (const bf16_t*)(ws + WS_QA); bf16_t* CTXo = (bf16_t*)(ws + WS_XB);   const bf16_t* CN = (const bf16_t*)(ws + WS_CN); const int* SEL = (const int*)(ws + WS_SEL);
    for (int m = F.gw; m < NT; m += F.ngw) {
        const int t = m & (TT - 1), b = m >> 13; const int nvalid = (t + 1 < 256) ? t + 1 : 256;
        bf16x8 qf[4];
#pragma unroll
        for (int ks = 0; ks < 4; ++ks) { u32x4 z = (u32x4){0u, 0u, 0u, 0u}; if (hd < 8) z = *(const u32x4*)(QA + (size_t)m * 1024 + hd * 128 + 32 * ks + 8 * gq); qf[ks] = __builtin_bit_cast(bf16x8, z); }
        f32x4 ctx[8];
#pragma unroll
        for (int i = 0; i < 8; ++i) ctx[i] = (f32x4){0.f, 0.f, 0.f, 0.f};
        float mrun = -INFINITY, lsum = 0.f;
        const bf16_t* cbase = CN + (size_t)b * TT * 128;
#pragma unroll 1
        for (int c = 0; c < 4; ++c) {
            if (64 * c >= nvalid) break;
            int sjc = SEL[(size_t)m * 256 + 64 * c + lane]; if (sjc < 0) sjc = 0;
            bf16x8 pc[4][4];
#pragma unroll
            for (int kt = 0; kt < 4; ++kt) { const int s = __shfl(sjc, 16 * kt + hd); const bf16_t* row = cbase + (size_t)s * 128 + 8 * gq;
#pragma unroll
                for (int ks = 0; ks < 4; ++ks) pc[kt][ks] = *(const bf16x8*)(row + 32 * ks); }
            f32x4 d[4];
#pragma unroll
            for (int kt = 0; kt < 4; ++kt) { f32x4 a = (f32x4){0.f, 0.f, 0.f, 0.f};
#pragma unroll
                for (int ks = 0; ks < 4; ++ks) a = MFMA16(pc[kt][ks], qf[ks], a);
#pragma unroll
                for (int q = 0; q < 4; ++q) { const int kidx = 64 * c + 16 * kt + 4 * gq + q; d[kt][q] = (kidx < nvalid) ? a[q] * (0.125f * LOG2E) : -INFINITY; } }
            { LAS unsigned char* wb = Tl + (hd >> 2) * 1024 + (hd & 3) * 2 + gq * 64;
#pragma unroll
              for (int kt = 0; kt < 4; ++kt)
#pragma unroll
                for (int ks = 0; ks < 4; ++ks)
#pragma unroll
                    for (int el = 0; el < 8; ++el) *(LAS bf16_t*)(wb + 4 * kt * 1024 + (32 * ks + el) * 8) = (bf16_t)pc[kt][ks][el]; }
            float mx = fmaxf(fmaxf(fmaxf(d[0][0], d[0][1]), fmaxf(d[0][2], d[0][3])), fmaxf(fmaxf(d[1][0], d[1][1]), fmaxf(d[1][2], d[1][3])));
            mx = fmaxf(mx, fmaxf(fmaxf(fmaxf(d[2][0], d[2][1]), fmaxf(d[2][2], d[2][3])), fmaxf(fmaxf(d[3][0], d[3][1]), fmaxf(d[3][2], d[3][3]))));
            mx = fmaxf(mx, __shfl_xor(mx, 16)); mx = fmaxf(mx, __shfl_xor(mx, 32));
            const float mnew = fmaxf(mrun, mx); const float scale = __builtin_amdgcn_exp2f(mrun - mnew); mrun = mnew;
            float psum = 0.f;
#pragma unroll
            for (int kt = 0; kt < 4; ++kt)
#pragma unroll
                for (int q = 0; q < 4; ++q) { d[kt][q] = __builtin_amdgcn_exp2f(d[kt][q] - mnew); psum += d[kt][q]; }
            lsum = lsum * scale + psum;
#pragma unroll
            for (int i = 0; i < 8; ++i) ctx[i] *= scale;
#pragma unroll
            for (int u = 0; u < 2; ++u) {
                u32x4 pw; pw.x = pk2(d[2 * u][0], d[2 * u][1]); pw.y = pk2(d[2 * u][2], d[2 * u][3]); pw.z = pk2(d[2 * u + 1][0], d[2 * u + 1][1]); pw.w = pk2(d[2 * u + 1][2], d[2 * u + 1][3]);
                const bf16x8 pf = __builtin_bit_cast(bf16x8, pw);
#pragma unroll
                for (int mt = 0; mt < 8; ++mt) { const LAS unsigned char* rb = Tl + gq * 1024 + hd * 8;
                    const u32x2 lo = *(const LAS u32x2*)(rb + (8 * u) * 1024 + 16 * mt * 8);
                    const u32x2 hi = *(const LAS u32x2*)(rb + (8 * u + 4) * 1024 + 16 * mt * 8);
                    u32x4 aw; aw.x = lo.x; aw.y = lo.y; aw.z = hi.x; aw.w = hi.y;
                    ctx[mt] = MFMA16(__builtin_bit_cast(bf16x8, aw), pf, ctx[mt]); }
            }
        }
        lsum += __shfl_xor(lsum, 16); lsum += __shfl_xor(lsum, 32);
        const float inv = 1.0f / lsum;
        if (hd < 8) {
#pragma unroll
            for (int mt = 0; mt < 8; ++mt) { u32x2 w; w.x = pk2(ctx[mt][0] * inv, ctx[mt][1] * inv); w.y = pk2(ctx[mt][2] * inv, ctx[mt][3] * inv);
                *(u32x2*)(CTXo + (size_t)m * 1024 + hd * 128 + 16 * mt + 4 * gq) = w; }
        }
    }
}
__device__ __forceinline__ void ph_mix_finish(Frame& F, int e) {
    PHASE_PIN(F);
    const int lane = F.lane; unsigned char* ws = F.ws;
    bf16_t* YC = (bf16_t*)(ws + WS_YCAT);
    const float* ln_g = F.ka->in[17] + e * 512; const float* ln_b = F.ka->in[18] + e * 512;
    const float* Yr = (const float*)(ws + WS_Y); const float* GATE = (const float*)(ws + WS_GATE); const float* BON = (const float*)(ws + SM_BONUS); const float* SIN = (const float*)(ws + WS_SIN);
#if !CHUNKED
    for (int m = F.gw; m < NT; m += F.ngw) {
        const int t = m & (TT - 1), b = m >> 13;
#pragma unroll 1
        for (int hh = 0; hh < 8; ++hh) {
            const int ch = hh * 64 + lane; const float y = Yr[(size_t)m * 512 + ch];
            const float mean = wave_sum(y) * (1.f / 64.f); const float yc = y - mean; const float var = wave_sum(yc * yc) * (1.f / 64.f);
            const float v1 = SIN[((size_t)(b * 8 + hh) * TT + t) * 384 + 320 + lane];
            const float o = (yc * rsqrtf(var + GN_EPS) * ln_g[ch] + ln_b[ch] + BON[m * 8 + hh] * v1) * GATE[(size_t)m * 512 + ch];
            YC[(size_t)m * 1024 + ch] = (bf16_t)f2bf(o);
        }
    }
#endif
    { const bf16_t* CTX = (const bf16_t*)(ws + WS_XB); const bf16_t* WvT = (const bf16_t*)(ws + W_WVT) + (size_t)e * 512 * 128;
      for (int tI = F.gw; tI < (NT / 64) * 8; tI += F.ngw) {
          const int hh = tI & 7, mt = tI >> 3;
          EpiStoreBf16 E{YC + 512 + hh * 64, 1024, 0, 32};
          sg_tile(CTX + hh * 128, 1024, WvT + (size_t)(hh * 64) * 128, WvT + (size_t)(hh * 64 + 32) * 128, 128, 128, mt * 64, E, F.lane);
      } }
}

__device__ __forceinline__ void ph_stickbreak(Frame& F) {
    PHASE_PIN(F);
    const int lane = F.lane, r = lane & 31, hf = lane >> 5; unsigned char* ws = F.ws;
    const bf16_t* Q = (const bf16_t*)(ws + WS_PROJ); const bf16_t* Kb = Q + (size_t)NT * 1024; const bf16_t* Vb = Kb + (size_t)NT * 1024;
    bf16_t* YC = (bf16_t*)(ws + WS_YCAT);
    for (int it = F.gw; it < NB * 16 * 256; it += F.ngw) {
        const int qt = it & 255, hh = (it >> 8) & 15, b = it >> 12;
        const int mq = b * TT + qt * 32 + r;
        bf16x8 qf[4];
#pragma unroll
        for (int ks = 0; ks < 4; ++ks) qf[ks] = *(const bf16x8*)(Q + (size_t)mq * 1024 + hh * 64 + ks * 16 + 8 * hf);
        f32x16 o0, o1;
#pragma unroll
        for (int i = 0; i < 16; ++i) { o0[i] = 0.f; o1[i] = 0.f; }
        float P = 1.0f;
        for (int kt = qt; kt >= 0; --kt) {
            const bf16_t* kp = Kb + (size_t)(b * TT + kt * 32 + r) * 1024 + hh * 64 + 8 * hf;
            const bf16x8 kf0 = *(const bf16x8*)(kp), kf1 = *(const bf16x8*)(kp + 16), kf2 = *(const bf16x8*)(kp + 32), kf3 = *(const bf16x8*)(kp + 48);
            const bf16_t* vp = Vb + (size_t)(b * TT + kt * 32 + 4 * hf) * 1024 + hh * 64 + r;
            bf16x8 vf[2][2];
#pragma unroll
            for (int s2 = 0; s2 < 2; ++s2)
#pragma unroll
                for (int j = 0; j < 8; ++j) { const size_t ko = (size_t)(16 * s2 + 8 * (j >> 2) + (j & 3)) * 1024; vf[0][s2][j] = (short)vp[ko]; vf[1][s2][j] = (short)vp[ko + 32]; }
            f32x16 acc;
#pragma unroll
            for (int i = 0; i < 16; ++i) acc[i] = 0.f;
            acc = MFMA32(kf0, qf[0], acc); acc = MFMA32(kf1, qf[1], acc); acc = MFMA32(kf2, qf[2], acc); acc = MFMA32(kf3, qf[3], acc);
            float kp_[16], be[16];
            const bool diag = (kt == qt);
#pragma unroll
            for (int q = 0; q < 16; ++q) {
                const int key = 8 * (q >> 2) + 4 * hf + (q & 3);
                const float e = __builtin_amdgcn_exp2f(acc[q]); float keep = __builtin_amdgcn_rcpf(1.0f + e);
                if (diag && key >= r) keep = 1.0f;
                kp_[q] = keep; be[q] = 1.0f - keep;
            }
            float ls[16], tot[4], oth[4];
#pragma unroll
            for (int g = 0; g < 4; ++g) { ls[4 * g + 3] = 1.0f; ls[4 * g + 2] = kp_[4 * g + 3]; ls[4 * g + 1] = ls[4 * g + 2] * kp_[4 * g + 2]; ls[4 * g] = ls[4 * g + 1] * kp_[4 * g + 1]; tot[g] = ls[4 * g] * kp_[4 * g]; }
#pragma unroll
            for (int g = 0; g < 4; ++g) oth[g] = __shfl_xor(tot[g], 32);
            const float G0 = tot[0] * oth[0], G1 = tot[1] * oth[1], G2 = tot[2] * oth[2], G3 = tot[3] * oth[3];
            float E[4]; E[3] = 1.0f; E[2] = G3; E[1] = G3 * G2; E[0] = E[1] * G1;
            float w[16];
#pragma unroll
            for (int g = 0; g < 4; ++g) { const float mg = E[g] * (hf == 0 ? oth[g] : 1.0f) * P;
#pragma unroll
                for (int j = 0; j < 4; ++j) w[4 * g + j] = be[4 * g + j] * ls[4 * g + j] * mg; }
            P *= E[0] * G0;
            u32x4 w0, w1;
            w0.x = pk2(w[0], w[1]); w0.y = pk2(w[2], w[3]); w0.z = pk2(w[4], w[5]); w0.w = pk2(w[6], w[7]);
            w1.x = pk2(w[8], w[9]); w1.y = pk2(w[10], w[11]); w1.z = pk2(w[12], w[13]); w1.w = pk2(w[14], w[15]);
            const bf16x8 wf0 = __builtin_bit_cast(bf16x8, w0), wf1 = __builtin_bit_cast(bf16x8, w1);
            o0 = MFMA32(vf[0][0], wf0, o0); o0 = MFMA32(vf[0][1], wf1, o0);
            o1 = MFMA32(vf[1][0], wf0, o1); o1 = MFMA32(vf[1][1], wf1, o1);
            if (__ballot(P > 1e-30f) == 0ull) break;
        }
        bf16_t* op = YC + (size_t)mq * 1024 + hh * 64 + 4 * hf;
#pragma unroll
        for (int g = 0; g < 4; ++g) {
            u32x2 a; a.x = pk2(o0[4 * g], o0[4 * g + 1]); a.y = pk2(o0[4 * g + 2], o0[4 * g + 3]); *(u32x2*)(op + 8 * g) = a;
            u32x2 c; c.x = pk2(o1[4 * g], o1[4 * g + 1]); c.y = pk2(o1[4 * g + 2], o1[4 * g + 3]); *(u32x2*)(op + 32 + 8 * g) = c;
        }
    }
}

__device__ __forceinline__ void ph_moe_route(Frame& F, const Args& A, int l, bool claim) {
    PHASE_PIN(F);
    const int lane = F.lane; unsigned char* ws = F.ws;
    const float* X = (const float*)(ws + WS_X); bf16_t* XB = (bf16_t*)(ws + WS_XB);
    const float* g = F.ka->in[29] + l * DM; const float* Wg = F.ka->in[30] + (size_t)l * DM * 4; const float* We = F.ka->in[31] + (size_t)l * 4 * DM * 8;
    int* EIDX = (int*)(ws + SM_EIDX); float* GATEV = (float*)(ws + SM_GATE); int* SLOT = (int*)(ws + SM_SLOT);
    unsigned* cnt = (unsigned*)(ws + WS_CTL) + CW_CNT + 64 * l;
    for (int m = F.gw; m < NT; m += F.ngw) {
        const f32x4* xr = (const f32x4*)(X + (size_t)m * DM) + lane; f32x4 v[4]; float s = 0.f;
#pragma unroll
        for (int j = 0; j < 4; ++j) { v[j] = xr[64 * j]; s += (v[j].x * v[j].x + v[j].y * v[j].y) + (v[j].z * v[j].z + v[j].w * v[j].w); }
        const float rstd = rsqrtf(wave_sum(s) * (1.f / DM) + RMS_EPS);
        u32x2* o8 = (u32x2*)(XB + (size_t)m * DM) + lane;
#pragma unroll
        for (int j = 0; j < 4; ++j) { u32x2 w; w.x = pk2(v[j].x * rstd, v[j].y * rstd); w.y = pk2(v[j].z * rstd, v[j].w * rstd); o8[64 * j] = w; }
#pragma unroll
        for (int j = 0; j < 4; ++j) { const f32x4 gg = *((const f32x4*)g + lane + 64 * j); v[j] = v[j] * gg * rstd; }
        float gl[4] = {0.f, 0.f, 0.f, 0.f};
#pragma unroll
        for (int j = 0; j < 4; ++j)
#pragma unroll
            for (int i = 0; i < 4; ++i) { const int k = 4 * (lane + 64 * j) + i; const f32x4 w = *(const f32x4*)(Wg + (size_t)k * 4); const float xv = v[j][i];
                gl[0] += xv * w.x; gl[1] += xv * w.y; gl[2] += xv * w.z; gl[3] += xv * w.w; }
#pragma unroll
        for (int q = 0; q < 4; ++q) gl[q] = wave_sum(gl[q]);
        int gs = 0; float gm = gl[0];
#pragma unroll
        for (int q = 1; q < 4; ++q) if (gl[q] > gm) { gm = gl[q]; gs = q; }
        float gden = 0.f;
#pragma unroll
        for (int q = 0; q < 4; ++q) gden += __expf(gl[q] - gm);
        const float g_gate = 1.0f / gden;
        const float* Wes = We + (size_t)gs * DM * 8;
        float el[8];
#pragma unroll
        for (int q = 0; q < 8; ++q) el[q] = 0.f;
#pragma unroll
        for (int j = 0; j < 4; ++j)
#pragma unroll
            for (int i = 0; i < 4; ++i) { const int k = 4 * (lane + 64 * j) + i; const f32x4 w0 = *(const f32x4*)(Wes + (size_t)k * 8), w1 = *(const f32x4*)(Wes + (size_t)k * 8 + 4); const float xv = v[j][i];
                el[0] += xv * w0.x; el[1] += xv * w0.y; el[2] += xv * w0.z; el[3] += xv * w0.w; el[4] += xv * w1.x; el[5] += xv * w1.y; el[6] += xv * w1.z; el[7] += xv * w1.w; }
#pragma unroll
        for (int q = 0; q < 8; ++q) el[q] = wave_sum(el[q]);
        int i1 = 0; float m1 = el[0];
#pragma unroll
        for (int q = 1; q < 8; ++q) if (el[q] > m1) { m1 = el[q]; i1 = q; }
        int i2 = -1; float m2 = -INFINITY;
#pragma unroll
        for (int q = 0; q < 8; ++q) if (q != i1 && el[q] > m2) { m2 = el[q]; i2 = q; }
        const float e2 = __expf(m2 - m1); const float ga = g_gate / (1.0f + e2), gb = g_gate * e2 / (1.0f + e2);
        if (lane == 0 && claim) {
            const int ea = gs * 8 + i1, eb = gs * 8 + i2;
            const unsigned sa = atomicAdd(&cnt[ea], 1u), sb = atomicAdd(&cnt[eb], 1u);
            EIDX[2 * m] = ea; EIDX[2 * m + 1] = eb; GATEV[2 * m] = ga; GATEV[2 * m + 1] = gb; SLOT[2 * m] = (int)sa; SLOT[2 * m + 1] = (int)sb;
        }
    }
}
__device__ __forceinline__ int moe_offsets(const unsigned* cnt, int lane, int* total, int* mycnt_pad) {
    const unsigned c = lane < 32 ? __hip_atomic_load(cnt + (lane & 31), __ATOMIC_RELAXED, __HIP_MEMORY_SCOPE_AGENT) : 0u; const int p = (int)((c + 255u) & ~255u);
    int x = p;
#pragma unroll
    for (int o = 1; o < 64; o <<= 1) { const int y = __shfl_up(x, o); if (lane >= o) x += y; }
    *total = __shfl(x, 63); *mycnt_pad = p;
    return x - p;
}
__device__ __forceinline__ void ph_moe_gather(Frame& F, int l) {
    PHASE_PIN(F);
    const int lane = F.lane; unsigned char* ws = F.ws;
    const unsigned* cnt = (const unsigned*)(ws + WS_CTL) + CW_CNT + 64 * l; int total, pad; const int off = moe_offsets(cnt, lane, &total, &pad);
    const int* EIDX = (const int*)(ws + SM_EIDX); const int* SLOT = (const int*)(ws + SM_SLOT);
    const bf16_t* XB = (const bf16_t*)(ws + WS_XB); bf16_t* AM = (bf16_t*)(ws + WS_AMOE);
    for (int a = F.gw; a < NT * 2; a += F.ngw) {
        const int m = a >> 1, e = EIDX[a], row = __shfl(off, e) + SLOT[a];
        const u32x4* src = (const u32x4*)(XB + (size_t)m * DM); u32x4* dst = (u32x4*)(AM + (size_t)row * DM);
        dst[lane] = src[lane]; dst[lane + 64] = src[lane + 64];
    }
}
__device__ __forceinline__ int moe_build_tab(Frame& F, int l) {
    LAS int* tab = (LAS int*)(F.lds + LDS_MISC + 256); LAS int* ends = (LAS int*)(F.lds + LDS_MISC + 1024);
    const unsigned* cnt = (const unsigned*)(F.ws + WS_CTL) + CW_CNT + 64 * l; int total, pad; const int off = moe_offsets(cnt, F.lane, &total, &pad);
    __syncthreads();
    if (F.tid < 32) ends[F.tid] = off + pad;
    __syncthreads();
    for (int rt = F.tid; rt < total / 256; rt += NTHR) { int e = 0; for (int q = 0; q < 32; ++q) e += (ends[q] <= rt * 256) ? 1 : 0; tab[rt] = e; }
    __syncthreads();
    return total;
}
__device__ __forceinline__ void ph_moe_gemm1(Frame& F, int l) {
    PHASE_PIN(F);
    const int total = moe_build_tab(F, l);
    pg8::Gemm g{(const pg8::bf16_t*)(F.ws + WS_AMOE), (const pg8::bf16_t*)(F.ws + WS_W13T), total, 32 * 1024, DM};
    pg8::MoeOrder S{(total / 256) * 4, (int)gridDim.x, (int)blockIdx.x, (const LAS int*)(F.lds + LDS_MISC + 256)};
    pg8::EpiGate E{(pg8::bf16_t*)(F.ws + WS_H)};
    pg8::gemm_phase<pg8::EpiGate, pg8::MoeOrder>(F.lds, g, S, E, nullptr, F.wave);
}
__device__ __forceinline__ void ph_moe_gemm2(Frame& F, int l) {
    PHASE_PIN(F);
    const int total = moe_build_tab(F, l);
    pg8::Gemm g{(const pg8::bf16_t*)(F.ws + WS_H), (const pg8::bf16_t*)(F.ws + WS_W2T), total, 32 * 1024, 512};
    pg8::MoeOrder S{(total / 256) * 4, (int)gridDim.x, (int)blockIdx.x, (const LAS int*)(F.lds + LDS_MISC + 256)};
    pg8::EpiMoeDown E{(pg8::bf16_t*)(F.ws + WS_YM)};
    pg8::gemm_phase<pg8::EpiMoeDown, pg8::MoeOrder>(F.lds, g, S, E, nullptr, F.wave);
}
__device__ __forceinline__ void ph_moe_combine(Frame& F, const Args& A, int l, bool wr) {
    PHASE_PIN(F);
    const int lane = F.lane; unsigned char* ws = F.ws;
    const unsigned* cnt = (const unsigned*)(ws + WS_CTL) + CW_CNT + 64 * l; int total, pad; const int off = moe_offsets(cnt, lane, &total, &pad);
    const int* EIDX = (const int*)(ws + SM_EIDX); const int* SLOT = (const int*)(ws + SM_SLOT); const float* GATEV = (const float*)(ws + SM_GATE);
    float* X = (float*)(ws + WS_X); bf16_t* XB = (bf16_t*)(ws + WS_XB); const bf16_t* YM = (const bf16_t*)(ws + WS_YM);
    const float* fg = F.ka->in[35];
    for (int m = F.gw; m < NT; m += F.ngw) {
        const int ea = EIDX[2 * m], eb = EIDX[2 * m + 1]; const float ga = GATEV[2 * m], gb = GATEV[2 * m + 1];
        const int ra = __shfl(off, ea) + SLOT[2 * m], rb = __shfl(off, eb) + SLOT[2 * m + 1];
        f32x4* xr = (f32x4*)(X + (size_t)m * DM) + lane; const u32x2* ya = (const u32x2*)(YM + (size_t)ra * DM) + lane; const u32x2* yb = (const u32x2*)(YM + (size_t)rb * DM) + lane;
        f32x4 v[4]; float s = 0.f;
#pragma unroll
        for (int j = 0; j < 4; ++j) { v[j] = xr[64 * j]; const u32x2 a = ya[64 * j], bq = yb[64 * j];
            v[j].x += ga * __uint_as_float(a.x << 16) + gb * __uint_as_float(bq.x << 16); v[j].y += ga * __uint_as_float(a.x & 0xffff0000u) + gb * __uint_as_float(bq.x & 0xffff0000u);
            v[j].z += ga * __uint_as_float(a.y << 16) + gb * __uint_as_float(bq.y << 16); v[j].w += ga * __uint_as_float(a.y & 0xffff0000u) + gb * __uint_as_float(bq.y & 0xffff0000u);
            s += (v[j].x * v[j].x + v[j].y * v[j].y) + (v[j].z * v[j].z + v[j].w * v[j].w); }
        const float rstd = rsqrtf(wave_sum(s) * (1.f / DM) + RMS_EPS);
        if (l < 3) {
            u32x2* o8 = (u32x2*)(XB + (size_t)m * DM) + lane;
#pragma unroll
            for (int j = 0; j < 4; ++j) { if (wr) xr[64 * j] = v[j]; u32x2 w; w.x = pk2(v[j].x * rstd, v[j].y * rstd); w.y = pk2(v[j].z * rstd, v[j].w * rstd); o8[64 * j] = w; }
        } else {
            f32x4* orow = (f32x4*)(F.out + (size_t)m * DM) + lane;
#pragma unroll
            for (int j = 0; j < 4; ++j) { const f32x4 gg = *((const f32x4*)fg + lane + 64 * j); orow[64 * j] = v[j] * gg * rstd; }
        }
    }
}

__global__ void __launch_bounds__(NTHR, 2) fwd_kernel(Args args) {
    extern __shared__ __attribute__((aligned(16))) unsigned char lds_raw[];
    Frame F; F.lds = (LAS unsigned char*)lds_raw; F.tid = threadIdx.x; F.lane = F.tid & 63; F.wave = __builtin_amdgcn_readfirstlane(F.tid >> 6);
    F.gw = blockIdx.x * NWAVES + F.wave; F.ngw = gridDim.x * NWAVES; F.out = args.out; F.ws = args.ws; F.ka = (const __attribute__((address_space(4))) Args*)__builtin_amdgcn_kernarg_segment_ptr();
    volatile LAS unsigned* MISC = (volatile LAS unsigned*)(F.lds + LDS_MISC);
    if (F.tid < 64) MISC[F.tid] = 0u;
    __syncthreads();
    const int lo = args.ph_lo, hi = args.ph_hi;
    XcdBarrier bar; bar.bar = (unsigned*)(F.ws + WS_CTL) + CW_BAR; bar.x = 0; bar.st = MISC;
    if (hi - lo > 1) bar = xcd_barrier_post((unsigned*)(F.ws + WS_CTL) + CW_BAR, MISC, F.tid == 0);
#define IN(k) (lo <= (k) && (k) < hi)
#define DUP(k) for (int _rep = 0; _rep < ((DUP_PHASE == (k)) ? 2 : 1); ++_rep)
#define SEAM(k) do { if ((k) + 1 < hi) { PHASE_PIN(F); xcd_barrier(bar, F.tid == 0); if (DUP_PHASE == 99) xcd_barrier(bar, F.tid == 0); } } while (0)
    unsigned char* ws = F.ws;
    if (IN(0)) { DUP(0) ph_prologue(F, args); SEAM(0); }
    for (int l = 0; l < 4; ++l) {
        const int pb = 1 + 16 * l, e = l >> 1;
        const float* xsrc = (l == 0) ? args.in[0] : (const float*)(ws + WS_X);
        if ((l & 1) == 0) {
            if (IN(pb + 0)) { PHASE_PIN(F);
                pg8::Gemm g{(const pg8::bf16_t*)(F.ws + WS_XB), (const pg8::bf16_t*)(F.ws + W_WIN) + (size_t)e * NCOL * DM, NT, NCOL, DM}; pg8::StaticOrder S; S.init(NT, NCOL, (int)gridDim.x, (int)blockIdx.x);
                pg8::EpiBf16S E{(pg8::bf16_t*)(F.ws + WS_PROJ), NCOL, 0, 0};
                DUP(11) pg8::gemm_phase<pg8::EpiBf16S, pg8::StaticOrder>(F.lds, g, S, E, nullptr, F.wave);
                SEAM(pb + 0); }
            if (IN(pb + 1)) {
#ifndef NO_PREP
 ph_prep(F, args, e, 7); if (DUP_PHASE >= 20 && DUP_PHASE < 28) ph_prep(F, args, e, DUP_PHASE - 20);
#endif
 SEAM(pb + 1); }
            if (IN(pb + 2)) { ph_scan_s1(F); ph_idx_score(F); SEAM(pb + 2); }
            if (IN(pb + 3)) { ph_scan_s2(F); ph_idx_select(F); SEAM(pb + 3); }
            if (IN(pb + 4)) { ph_scan_s3(F, e); ph_sparse(F, e); SEAM(pb + 4); }
            if (IN(pb + 6)) { DUP(13) ph_mix_finish(F, e); SEAM(pb + 6); }
        } else {
            if (IN(pb + 0)) { PHASE_PIN(F);
                pg8::Gemm g{(const pg8::bf16_t*)(F.ws + WS_XB), (const pg8::bf16_t*)(F.ws + W_WQKV) + (size_t)e * 3072 * DM, NT, 3072, DM}; pg8::StaticOrder S; S.init(NT, 3072, (int)gridDim.x, (int)blockIdx.x);
                pg8::EpiBf16S E{(pg8::bf16_t*)(F.ws + WS_PROJ), 1024, 1024, (size_t)NT * 1024};
                DUP(12) pg8::gemm_phase<pg8::EpiBf16S, pg8::StaticOrder>(F.lds, g, S, E, nullptr, F.wave);
                SEAM(pb + 0); }
            if (IN(pb + 1)) {
#ifndef NO_SB
 DUP(6) ph_stickbreak(F);
#endif
 SEAM(pb + 1); }
        }
        if (IN(pb + 7)) { PHASE_PIN(F);
            pg8::Gemm g{(const pg8::bf16_t*)(F.ws + WS_YCAT), (const pg8::bf16_t*)(F.ws + ((l & 1) ? W_WOUTO : W_WOUTE)) + (size_t)e * DM * DM, NT, DM, DM}; pg8::StaticOrder S; S.init(NT, DM, (int)gridDim.x, (int)blockIdx.x);
            pg8::EpiResid E{xsrc, (float*)(F.ws + WS_X)};
            pg8::gemm_phase<pg8::EpiResid, pg8::StaticOrder>(F.lds, g, S, E, nullptr, F.wave);
            if (DUP_PHASE == 17 && l == 0) pg8::gemm_phase<pg8::EpiResid, pg8::StaticOrder>(F.lds, g, S, E, nullptr, F.wave);
            SEAM(pb + 7); }
        if (IN(pb + 8)) {
#ifndef NO_ROUTE
 ph_moe_route(F, args, l, true); if (DUP_PHASE == 16) ph_moe_route(F, args, l, false); DUP(7) moe_weight_prep(F, args, l);
#endif
 SEAM(pb + 8); }
        if (IN(pb + 9)) { DUP(8) ph_moe_gather(F, l); SEAM(pb + 9); }
        if (IN(pb + 10)) { DUP(9) ph_moe_gemm1(F, l); SEAM(pb + 10); }
        if (IN(pb + 11)) { DUP(10) ph_moe_gemm2(F, l); SEAM(pb + 11); }
        if (IN(pb + 12)) { if (DUP_PHASE == 18) ph_moe_combine(F, args, l, false); ph_moe_combine(F, args, l, true); SEAM(pb + 12); }
    }
#undef IN
#undef SEAM
}

extern "C" void kernel_launch(void* const* d_in, const int* in_sizes, int n_in, void* d_out, int out_size, void* d_ws, size_t ws_size, hipStream_t stream) {
    static int grid = 0;
    if (grid == 0) {
        if (n_in != 36 || out_size != NT * DM || ws_size < WS_END) { fprintf(stderr, "kernel_launch: unexpected problem (n_in %d out %d ws %zu)\n", n_in, out_size, ws_size); grid = -1; return; }
        int dev = 0, cus = 0, per_cu = 0;
        if (hipGetDevice(&dev) != hipSuccess || hipDeviceGetAttribute(&cus, hipDeviceAttributeMultiprocessorCount, dev) != hipSuccess) { grid = -1; return; }
        if (hipFuncSetAttribute((const void*)fwd_kernel, hipFuncAttributeMaxDynamicSharedMemorySize, LDS_BYTES) != hipSuccess) { grid = -1; return; }
        if (hipOccupancyMaxActiveBlocksPerMultiprocessor(&per_cu, (const void*)fwd_kernel, NTHR, LDS_BYTES) != hipSuccess || per_cu < 1) { fprintf(stderr, "kernel_launch: occupancy query says %d\n", per_cu); }
        (void)hipGetLastError();
        grid = cus;
    }
    if (grid < 0) return;
    (void)hipMemsetAsync((char*)d_ws + WS_CTL, 0, CTL_ZERO_BYTES, stream);
    Args a{};
    for (int i = 0; i < 36; ++i) a.in[i] = (const float*)d_in[i];
    a.out = (float*)d_out; a.ws = (unsigned char*)d_ws;
#if ONE_LAUNCH
    a.ph_lo = 0; a.ph_hi = 65;
    hipLaunchKernelGGL(fwd_kernel, dim3(grid), dim3(NTHR), LDS_BYTES, stream, a);
    if (DUP_PHASE == 97) { (void)hipMemsetAsync((char*)d_ws + WS_CTL, 0, CTL_ZERO_BYTES, stream); hipLaunchKernelGGL(fwd_kernel, dim3(grid), dim3(NTHR), LDS_BYTES, stream, a); }
#else
    for (int p = 0; p < 65; ++p) {
        const int l = (p - 1) >> 4, k = (p - 1) & 15;
        if (p > 0) { if (k > 12) continue; if ((l & 1) && k >= 2 && k <= 6) continue; if (!(l & 1) && k == 5) continue; }
        a.ph_lo = p; a.ph_hi = p + 1;
        hipLaunchKernelGGL(fwd_kernel, dim3(grid), dim3(NTHR), LDS_BYTES, stream, a);
    }
#endif
}
```

```cpp
#include <hip/hip_runtime.h>
#include <cstdio>
#include <cstdint>

#ifndef DUP_PHASE
#define DUP_PHASE -1
#endif
#ifndef CHUNKED
#define CHUNKED 1
#endif
#ifndef ONE_LAUNCH
#define ONE_LAUNCH 1
#endif

#define GAS __attribute__((address_space(1)))
#define LAS __attribute__((address_space(3)))
typedef unsigned short bf16_t;
typedef short bf16x8 __attribute__((ext_vector_type(8)));
typedef float f32x4 __attribute__((ext_vector_type(4)));
typedef float f32x2 __attribute__((ext_vector_type(2)));
typedef float f32x16 __attribute__((ext_vector_type(16)));
typedef unsigned u32x4 __attribute__((ext_vector_type(4)));
typedef unsigned u32x2 __attribute__((ext_vector_type(2)));

constexpr int NT = 16384, TT = 8192, DM = 1024, NB = 2;
constexpr int NCOL = 3584;
constexpr int C_R = 0, C_K = 512, C_V = 1024, C_QB = 1536, C_CKV = 2048, C_QI = 2176, C_KI = 2688, C_WI = 2752;
constexpr int C_PW = 2816, C_QW = 2880, C_PA = 2944, C_QA = 3008, C_PG = 3072, C_QG = 3200, C_PV = 3328, C_QV = 3360;
constexpr int NWAVES = 8, NTHR = 512;
constexpr float RMS_EPS = 1e-6f, GN_EPS = 64e-5f;
constexpr float LOG2E = 1.4426950408889634f;

constexpr size_t MiB = 1u << 20;
constexpr size_t WS_CTL = 0, CTL_ZERO_BYTES = 1 * MiB;
constexpr size_t WS_SMALL = 1 * MiB;
constexpr size_t SM_EIDX = WS_SMALL, SM_GATE = WS_SMALL + 128 * 1024, SM_SLOT = WS_SMALL + 256 * 1024, SM_BONUS = WS_SMALL + 512 * 1024, SM_SGN = WS_SMALL + 1024 * 1024, SM_QLIN = WS_SMALL + 2 * MiB;
constexpr size_t WS_W = 5 * MiB;
constexpr size_t W_WIN = WS_W, W_WOUTE = WS_W + 14 * MiB, W_WQKV = WS_W + 18 * MiB, W_WOUTO = WS_W + 30 * MiB, W_WKB = WS_W + 34 * MiB, W_WVT = W_WKB + 256 * 1024, W_L2 = W_WKB + 512 * 1024;
constexpr size_t WS_X = 45 * MiB, WS_XB = 109 * MiB, WS_PROJ = 141 * MiB, WS_SIN = 253 * MiB, WS_VF = 445 * MiB, WS_Y = 477 * MiB, WS_GATE = 509 * MiB, WS_YCAT = 541 * MiB;
constexpr size_t WS_CN = 573 * MiB, WS_KI = 577 * MiB, WS_QI = 579 * MiB, WS_QA = 595 * MiB, WS_SEL = 627 * MiB;
constexpr size_t WS_BIG = 645 * MiB;
constexpr size_t WS_SCORE = WS_BIG;
constexpr size_t WS_W13T = WS_BIG, WS_W2T = WS_BIG + 64 * MiB, WS_AMOE = WS_BIG + 96 * MiB, WS_H = WS_BIG + 176 * MiB, WS_YM = WS_BIG + 216 * MiB;
constexpr size_t WS_S1TMP = 905 * MiB;
constexpr size_t WS_END = 1017 * MiB;
constexpr size_t SCORE_PER_BATCH = (size_t)16384 * 2080;
static_assert(WS_SCORE + 2 * SCORE_PER_BATCH * 4 <= WS_END, "score map");
static_assert(WS_YM + (size_t)40960 * 1024 * 2 <= WS_END, "moe map");
constexpr int CW_BAR = 4096;
constexpr int CW_CNT = 16384;

constexpr int LDS_BYTES = 147456;
constexpr int LDS_WSCR = 16384;
constexpr int LDS_MISC = 131072;

__device__ __forceinline__ float bf2f(bf16_t b) { return __uint_as_float(((unsigned)b) << 16); }
typedef __bf16 bf16v2_t __attribute__((ext_vector_type(2)));
__device__ __forceinline__ unsigned pk2(float lo, float hi) { const f32x2 v = {lo, hi}; const bf16v2_t b = __builtin_convertvector(v, bf16v2_t); return __builtin_bit_cast(unsigned, b); }
__device__ __forceinline__ unsigned f2bf(float f) { return pk2(f, f) & 0xffffu; }
__device__ __forceinline__ float wave_sum(float v) {
#pragma unroll
    for (int o = 1; o < 64; o <<= 1) v += __shfl_xor(v, o);
    return v;
}
__device__ __forceinline__ float wave_max(float v) {
#pragma unroll
    for (int o = 1; o < 64; o <<= 1) v = fmaxf(v, __shfl_xor(v, o));
    return v;
}
__device__ __forceinline__ float sigmoidf_(float x) { return 1.0f / (1.0f + __expf(-x)); }
#define LDS_WAIT() asm volatile("s_waitcnt lgkmcnt(0)" ::: "memory")

#define XB_TMO      128
#define XB_XCNT(j)  (256  + 64 * (j))
#define XB_XSUB(j)  (1280 + 64 * (j))
#define XB_XGEN(j)  (2304 + 64 * (j))
#define XB_TOP      3328
#define XB_TOPGEN   3392
#define XCD_BAR_WORDS 3456
#define XB_SPIN_CAP (1u << 18)
__device__ __forceinline__ unsigned xb_ld(unsigned* p)              { return __hip_atomic_load(p, __ATOMIC_RELAXED, __HIP_MEMORY_SCOPE_AGENT); }
__device__ __forceinline__ unsigned xb_add(unsigned* p, unsigned v) { return __hip_atomic_fetch_add(p, v, __ATOMIC_RELAXED, __HIP_MEMORY_SCOPE_AGENT); }
__device__ __forceinline__ unsigned xb_xcc_id() { return (unsigned)__builtin_amdgcn_s_getreg((3 << 11) | 20) & 0xFu; }
#define XB_SPIN(cond, bar) do { unsigned _sp = 0; while (cond) { __builtin_amdgcn_s_sleep(1); \
    if ((++_sp & 255u) == 0u) { if (xb_ld(&(bar)[XB_TMO])) break; if (_sp > XB_SPIN_CAP) { atomicAdd(&(bar)[XB_TMO], 1u); break; } } } } while (0)
struct XcdBarrier { unsigned* bar; unsigned x; volatile LAS unsigned* st; };
__device__ __forceinline__ XcdBarrier xcd_barrier_post(unsigned* bar, volatile LAS unsigned* st, bool t0) {
    XcdBarrier b; b.bar = bar; b.x = xb_xcc_id(); b.st = st;
    if (t0) (void)xb_add(&bar[XB_XCNT(b.x)], 1u);
    return b;
}
__device__ __forceinline__ void xcd_barrier_complete(unsigned* bar, unsigned x, unsigned& nloc, unsigned& nx) {
    const unsigned G = gridDim.x * gridDim.y * gridDim.z;
    unsigned sum, cnt, mine, sp = 0u;
    for (;;) {
        sum = 0u; cnt = 0u; mine = 0u;
#pragma unroll
        for (unsigned j = 0; j < 16; ++j) { const unsigned c = xb_ld(&bar[XB_XCNT(j)]); sum += c; cnt += (c > 0u) ? 1u : 0u; mine = (j == x) ? c : mine; }
        if (sum == G) break;
        __builtin_amdgcn_s_sleep(1);
        if ((++sp & 255u) == 0u) { if (xb_ld(&bar[XB_TMO])) break; if (sp > XB_SPIN_CAP) { atomicAdd(&bar[XB_TMO], 1u); break; } }
    }
    nloc = mine > 0u ? mine : 1u; nx = cnt > 0u ? cnt : 1u;
}
__device__ __forceinline__ void xcd_barrier(const XcdBarrier& b, bool t0) {
    asm volatile("s_waitcnt vmcnt(0)" ::: "memory");
    __syncthreads();
    if (t0) {
        unsigned* bar = b.bar;
        __builtin_amdgcn_s_waitcnt(0);
        unsigned nloc = b.st[0], nx = b.st[1];
        if (nloc == 0u) { xcd_barrier_complete(bar, b.x, nloc, nx); b.st[0] = nloc; b.st[1] = nx; }
        const unsigned old = xb_add(&bar[XB_XSUB(b.x)], 1u);
        const unsigned gen = old / nloc;
        if (old + 1u == (gen + 1u) * nloc) {
            __builtin_amdgcn_fence(__ATOMIC_RELEASE, "agent");
            asm volatile("s_waitcnt vmcnt(0)" ::: "memory");
            const unsigned og = xb_add(&bar[XB_TOP], 1u);
            const unsigned tg = og / nx;
            if (og + 1u == (tg + 1u) * nx) xb_add(&bar[XB_TOPGEN], 1u);
            else XB_SPIN(xb_ld(&bar[XB_TOPGEN]) == tg, bar);
            __builtin_amdgcn_fence(__ATOMIC_ACQUIRE, "agent");
            xb_add(&bar[XB_XGEN(b.x)], 1u);
            asm volatile("s_waitcnt vmcnt(0)" ::: "memory");
        } else {
            XB_SPIN(xb_ld(&bar[XB_XGEN(b.x)]) == gen, bar);
            __builtin_amdgcn_fence(__ATOMIC_ACQUIRE, "agent");
            asm volatile("s_waitcnt vmcnt(0)" ::: "memory");
        }
    }
    __syncthreads();
}

struct Args { const float* in[36]; float* out; unsigned char* ws; int ph_lo, ph_hi; };
struct Frame {
    LAS unsigned char* lds; int tid, lane, wave, gw, ngw;
    float* out; unsigned char* ws;
    const __attribute__((address_space(4))) Args* ka;
};

#define PHASE_PIN(F) do { unsigned long long _z64; int _z32; asm volatile("s_mov_b64 %0, 0\n\ts_mov_b32 %1, 0" : "=s"(_z64), "=s"(_z32)); asm volatile("" : "+v"((F).lane)); \
    (F).ws += _z64; (F).out += _z64; (F).ka = (const __attribute__((address_space(4))) Args*)((const __attribute__((address_space(4))) char*)(F).ka + _z64); \
    (F).gw += _z32; (F).ngw += _z32; (F).wave += _z32; (F).tid = (F).wave * 64 + (F).lane; } while (0)
struct TrJob { const float* W; int K, ldw, col_off, ncols; bf16_t* WT; int ldt, row_off; const float* g; const float* mu; int mode; float cs; };
__device__ __forceinline__ void tr_item(const TrJob& J, int item, LAS float* scr, int lane) {
    const int nblk = (J.ncols + 31) / 32, kb = item / nblk, nb = item % nblk, k0 = 64 * kb, n0 = 32 * nb;
#pragma unroll 8
    for (int i = 0; i < 32; ++i) {
        const int kk = 2 * i + (lane >> 5), n = lane & 31, k = k0 + kk;
        float v = 0.f;
        if (k < J.K && n0 + n < J.ncols) {
            float s = J.cs;
            if (J.g) s *= J.g[k];
            if (J.mode == 1) s *= (1.0f - J.mu[k]); else if (J.mode == 2) s *= J.mu[k];
            v = J.W[(size_t)k * J.ldw + J.col_off + n0 + n] * s;
        }
        scr[kk * 33 + n] = v;
    }
    LDS_WAIT(); asm volatile("" ::: "memory");
    const int c = lane & 7;
#pragma unroll
    for (int j = 0; j < 4; ++j) {
        const int n = (lane >> 3) + 8 * j; const LAS float* s = scr + (8 * c) * 33 + n;
        u32x4 o; o.x = pk2(s[0 * 33], s[1 * 33]); o.y = pk2(s[2 * 33], s[3 * 33]); o.z = pk2(s[4 * 33], s[5 * 33]); o.w = pk2(s[6 * 33], s[7 * 33]);
        if (n0 + n < J.ncols && k0 + 8 * c < J.K) *(u32x4*)(J.WT + (size_t)(J.row_off + n0 + n) * J.ldt + k0 + 8 * c) = o;
    }
    LDS_WAIT(); asm volatile("" ::: "memory");
}
__device__ __forceinline__ void tr_job(Frame& F, const TrJob& J, int rot) {
    LAS float* scr = (LAS float*)(F.lds + F.wave * LDS_WSCR);
    const int nitems = ((J.K + 63) / 64) * ((J.ncols + 31) / 32);
    int start = F.gw - (rot % F.ngw); if (start < 0) start += F.ngw;
    for (int it = start; it < nitems; it += F.ngw) tr_item(J, it, scr, F.lane);
}
__device__ __forceinline__ void zero_rows(Frame& F, bf16_t* WT, int ld, int r0, int r1) {
    const size_t n16 = (size_t)(r1 - r0) * ld / 8; u32x4* p = (u32x4*)(WT + (size_t)r0 * ld);
    for (size_t i = (size_t)F.gw * 64 + F.lane; i < n16; i += (size_t)F.ngw * 64) p[i] = (u32x4){0u, 0u, 0u, 0u};
}
__device__ __forceinline__ void row_norm_to_bf16(const float* xrow, bf16_t* orow, int lane) {
    const f32x4* xr = (const f32x4*)xrow + lane; f32x4 v[4]; float s = 0.f;
#pragma unroll
    for (int j = 0; j < 4; ++j) { v[j] = xr[64 * j]; s += (v[j].x * v[j].x + v[j].y * v[j].y) + (v[j].z * v[j].z + v[j].w * v[j].w); }
    const float rstd = rsqrtf(wave_sum(s) * (1.f / DM) + RMS_EPS);
    u32x2* o8 = (u32x2*)orow + lane;
#pragma unroll
    for (int j = 0; j < 4; ++j) { u32x2 w; w.x = pk2(v[j].x * rstd, v[j].y * rstd); w.y = pk2(v[j].z * rstd, v[j].w * rstd); o8[64 * j] = w; }
}

__device__ __forceinline__ void ph_prologue(Frame& F, const Args& A) {
    PHASE_PIN(F);
    unsigned char* ws = F.ws; int rot = 0;
    for (int e = 0; e < 2; ++e) {
        bf16_t* WT = (bf16_t*)(ws + W_WIN) + (size_t)e * NCOL * DM;
        const float* g = F.ka->in[1] + e * DM; const float* mul = F.ka->in[5] + (size_t)e * 3 * DM;
        TrJob J{F.ka->in[2] + (size_t)e * DM * 2760, DM, 2760, 0, 2760, WT, DM, 0, g, nullptr, 0, 1.0f}; tr_job(F, J, rot); rot += 1392;
        zero_rows(F, WT, DM, 2760, C_PW);
        TrJob Jw1{F.ka->in[7] + (size_t)e * DM * 64, DM, 64, 0, 64, WT, DM, C_PW, g, mul, 1, 1.0f}; tr_job(F, Jw1, rot); rot += 32;
        TrJob Jw2{F.ka->in[7] + (size_t)e * DM * 64, DM, 64, 0, 64, WT, DM, C_QW, g, mul, 2, 1.0f}; tr_job(F, Jw2, rot); rot += 32;
        TrJob Ja1{F.ka->in[10] + (size_t)e * DM * 64, DM, 64, 0, 64, WT, DM, C_PA, g, mul + DM, 1, 1.0f}; tr_job(F, Ja1, rot); rot += 32;
        TrJob Ja2{F.ka->in[10] + (size_t)e * DM * 64, DM, 64, 0, 64, WT, DM, C_QA, g, mul + DM, 2, 1.0f}; tr_job(F, Ja2, rot); rot += 32;
        TrJob Jg1{F.ka->in[12] + (size_t)e * DM * 128, DM, 128, 0, 128, WT, DM, C_PG, g, mul + 2 * DM, 1, 1.0f}; tr_job(F, Jg1, rot); rot += 64;
        TrJob Jg2{F.ka->in[12] + (size_t)e * DM * 128, DM, 128, 0, 128, WT, DM, C_QG, g, mul + 2 * DM, 2, 1.0f}; tr_job(F, Jg2, rot); rot += 64;
        if (e == 1) {
            TrJob Jv1{F.ka->in[21], DM, 32, 0, 32, WT, DM, C_PV, g, F.ka->in[19], 1, 1.0f}; tr_job(F, Jv1, rot); rot += 16;
            TrJob Jv2{F.ka->in[21], DM, 32, 0, 32, WT, DM, C_QV, g, F.ka->in[19], 2, 1.0f}; tr_job(F, Jv2, rot); rot += 16;
            zero_rows(F, WT, DM, C_QV + 32, NCOL);
        } else zero_rows(F, WT, DM, C_PV, NCOL);
        TrJob Jo{F.ka->in[3] + (size_t)e * DM * DM, DM, DM, 0, DM, (bf16_t*)(ws + W_WOUTE) + (size_t)e * DM * DM, DM, 0, nullptr, nullptr, 0, 1.0f}; tr_job(F, Jo, rot); rot += 512;
        { bf16_t* L2W = (bf16_t*)(ws + W_L2) + (size_t)e * (288 * 512);
          TrJob Jl1{F.ka->in[8] + (size_t)e * 64 * 512, 64, 512, 0, 512, L2W, 64, 0, nullptr, nullptr, 0, 1.0f}; tr_job(F, Jl1, rot); rot += 16;
          TrJob Jl2{F.ka->in[11] + (size_t)e * 64 * 512, 64, 512, 0, 512, L2W + 64 * 512, 64, 0, nullptr, nullptr, 0, 1.0f}; tr_job(F, Jl2, rot); rot += 16;
          TrJob Jl3{F.ka->in[13] + (size_t)e * 128 * 512, 128, 512, 0, 512, L2W + 128 * 512, 128, 0, nullptr, nullptr, 0, 1.0f}; tr_job(F, Jl3, rot); rot += 32;
          if (e == 1) { TrJob Jl4{F.ka->in[22], 32, 512, 0, 512, L2W + 256 * 512, 32, 0, nullptr, nullptr, 0, 1.0f}; tr_job(F, Jl4, rot); rot += 16; } }
        { const float* Wkv = F.ka->in[24] + (size_t)e * 128 * 1024; bf16_t* WkB = (bf16_t*)(ws + W_WKB) + (size_t)e * 8 * 128 * 64;
          for (int i = F.gw * 64 + F.lane; i < 8 * 128 * 64; i += F.ngw * 64) { const int d = i & 63, r = (i >> 6) & 127, h = i >> 13; WkB[i] = (bf16_t)f2bf(Wkv[(size_t)r * 1024 + h * 64 + d]); } }
        TrJob Jv{F.ka->in[24] + (size_t)e * 128 * 1024, 128, 1024, 512, 512, (bf16_t*)(ws + W_WVT) + (size_t)e * 512 * 128, 128, 0, nullptr, nullptr, 0, 1.0f}; tr_job(F, Jv, rot); rot += 32;
    }
    for (int o = 0; o < 2; ++o) {
        const float* g = F.ka->in[26] + o * DM; bf16_t* WT = (bf16_t*)(ws + W_WQKV) + (size_t)o * 3072 * DM;
        TrJob Jq{F.ka->in[27] + (size_t)o * DM * 3072, DM, 3072, 0, 1024, WT, DM, 0, g, nullptr, 0, LOG2E * 0.125f}; tr_job(F, Jq, rot); rot += 512;
        TrJob Jk{F.ka->in[27] + (size_t)o * DM * 3072, DM, 3072, 1024, 2048, WT, DM, 1024, g, nullptr, 0, 1.0f}; tr_job(F, Jk, rot); rot += 1024;
        TrJob Jo{F.ka->in[28] + (size_t)o * DM * DM, DM, DM, 0, DM, (bf16_t*)(ws + W_WOUTO) + (size_t)o * DM * DM, DM, 0, nullptr, nullptr, 0, 1.0f}; tr_job(F, Jo, rot); rot += 512;
    }
    for (int m = F.gw; m < NT; m += F.ngw) row_norm_to_bf16(F.ka->in[0] + (size_t)m * DM, (bf16_t*)(ws + WS_XB) + (size_t)m * DM, F.lane);
}

struct MwJob { const float* src; const float* gk; bf16_t* dst; int ldw, ldt; };
__device__ __forceinline__ MwJob mw_job(int it, const float* w1, const float* w3, const float* w2, const float* g, bf16_t* W13T, bf16_t* W2T, int lane) {
    MwJob J;
    if (it < 16384) { const int job = it >> 6, item = it & 63, which = job & 1, j = (job >> 1) & 3, e = job >> 3, k0 = 64 * (item >> 2), n0 = 32 * (item & 3);
        J.src = (which ? w3 : w1) + (size_t)e * DM * 512 + (size_t)(k0 + (lane >> 3)) * 512 + 128 * j + n0 + 4 * (lane & 7); J.ldw = 512; J.gk = g + k0 + 8 * (lane & 7);
        J.dst = W13T + (size_t)(e * 1024 + 256 * j + 128 * which + n0 + (lane >> 3)) * DM + k0 + 8 * (lane & 7); J.ldt = DM; }
    else { const int it2 = it - 16384, e = it2 >> 8, item = it2 & 255, k0 = 64 * (item >> 5), n0 = 32 * (item & 31);
        J.src = w2 + (size_t)e * 512 * DM + (size_t)(k0 + (lane >> 3)) * DM + n0 + 4 * (lane & 7); J.ldw = DM; J.gk = nullptr;
        J.dst = W2T + (size_t)(e * 1024 + n0 + (lane >> 3)) * 512 + k0 + 8 * (lane & 7); J.ldt = 512; }
    return J;
}
__device__ __forceinline__ void mw_load(const MwJob& J, f32x4 (&v)[8], f32x4 (&gv)[2]) {
#pragma unroll
    for (int i = 0; i < 8; ++i) v[i] = *(const f32x4*)(J.src + (size_t)(8 * i) * J.ldw);
    if (J.gk) { gv[0] = *(const f32x4*)(J.gk); gv[1] = *(const f32x4*)(J.gk + 4); } else { gv[0] = (f32x4){1.f, 1.f, 1.f, 1.f}; gv[1] = gv[0]; }
}
__device__ __forceinline__ void mw_finish(const MwJob& J, const f32x4 (&v)[8], const f32x4 (&gv)[2], LAS float* scr, int lane) {
#pragma unroll
    for (int i = 0; i < 8; ++i) { LAS float* sp = scr + (8 * i + (lane >> 3)) * 33 + 4 * (lane & 7); sp[0] = v[i].x; sp[1] = v[i].y; sp[2] = v[i].z; sp[3] = v[i].w; }
    LDS_WAIT(); asm volatile("" ::: "memory");
    const int c = lane & 7;
#pragma unroll
    for (int j = 0; j < 4; ++j) { const LAS float* sp = scr + (8 * c) * 33 + (lane >> 3) + 8 * j;
        u32x4 o; o.x = pk2(sp[0 * 33] * gv[0].x, sp[1 * 33] * gv[0].y); o.y = pk2(sp[2 * 33] * gv[0].z, sp[3 * 33] * gv[0].w); o.z = pk2(sp[4 * 33] * gv[1].x, sp[5 * 33] * gv[1].y); o.w = pk2(sp[6 * 33] * gv[1].z, sp[7 * 33] * gv[1].w);
        *(u32x4*)(J.dst + (size_t)(8 * j) * J.ldt) = o; }
    LDS_WAIT(); asm volatile("" ::: "memory");
}
__device__ __forceinline__ void moe_weight_prep(Frame& F, const Args& A, int l) {
    PHASE_PIN(F);
    LAS float* scr = (LAS float*)(F.lds + F.wave * LDS_WSCR); const int lane = F.lane;
    const float* g = F.ka->in[29] + l * DM;
    const float* w1 = F.ka->in[32] + (size_t)l * 32 * DM * 512; const float* w3 = F.ka->in[33] + (size_t)l * 32 * DM * 512; const float* w2 = F.ka->in[34] + (size_t)l * 32 * 512 * DM;
    bf16_t* W13T = (bf16_t*)(F.ws + WS_W13T); bf16_t* W2T = (bf16_t*)(F.ws + WS_W2T);
    f32x4 va[8], vb[8], ga[2], gb[2];
    int it = F.gw;
    if (it >= 24576) return;
    MwJob Ja = mw_job(it, w1, w3, w2, g, W13T, W2T, lane), Jb = Ja; mw_load(Ja, va, ga);
    for (;;) {
        const int itb = it + F.ngw; const bool hb = itb < 24576;
        if (hb) { Jb = mw_job(itb, w1, w3, w2, g, W13T, W2T, lane); mw_load(Jb, vb, gb); }
        mw_finish(Ja, va, ga, scr, lane);
        if (!hb) break;
        const int ita = itb + F.ngw; const bool ha = ita < 24576;
        if (ha) { Ja = mw_job(ita, w1, w3, w2, g, W13T, W2T, lane); mw_load(Ja, va, ga); }
        mw_finish(Jb, vb, gb, scr, lane);
        if (!ha) break;
        it = ita;
    }
}

#define MFMA32(a, b, c) __builtin_amdgcn_mfma_f32_32x32x16_bf16((a), (b), (c), 0, 0, 0)
template <class Epi>
__device__ __forceinline__ void sg_tile(const bf16_t* A, int lda, const bf16_t* B0, const bf16_t* B1, int ldb, int K, int m0, const Epi& epi, int lane) {
    const int r = lane & 31, h = lane >> 5;
    const bf16_t* a0 = A + (size_t)(m0 + r) * lda + 8 * h; const bf16_t* a1 = a0 + (size_t)32 * lda;
    const bf16_t* b0 = B0 + (size_t)r * ldb + 8 * h; const bf16_t* b1 = B1 + (size_t)r * ldb + 8 * h;
    f32x16 c00, c01, c10, c11;
#pragma unroll
    for (int i = 0; i < 16; ++i) { c00[i] = 0.f; c01[i] = 0.f; c10[i] = 0.f; c11[i] = 0.f; }
#pragma unroll 4
    for (int k = 0; k < K; k += 16) {
        const bf16x8 fa0 = *(const bf16x8*)(a0 + k), fa1 = *(const bf16x8*)(a1 + k), fb0 = *(const bf16x8*)(b0 + k), fb1 = *(const bf16x8*)(b1 + k);
        c00 = MFMA32(fb0, fa0, c00); c01 = MFMA32(fb1, fa0, c01); c10 = MFMA32(fb0, fa1, c10); c11 = MFMA32(fb1, fa1, c11);
    }
#pragma unroll
    for (int g = 0; g < 4; ++g) {
        const int j = 8 * g + 4 * h;
        epi.pair(m0 + r, j, (f32x4){c00[4 * g], c00[4 * g + 1], c00[4 * g + 2], c00[4 * g + 3]}, (f32x4){c01[4 * g], c01[4 * g + 1], c01[4 * g + 2], c01[4 * g + 3]});
        epi.pair(m0 + 32 + r, j, (f32x4){c10[4 * g], c10[4 * g + 1], c10[4 * g + 2], c10[4 * g + 3]}, (f32x4){c11[4 * g], c11[4 * g + 1], c11[4 * g + 2], c11[4 * g + 3]});
    }
}
struct EpiStoreBf16 {
    bf16_t* O; int ldo, n0, n1;
    __device__ __forceinline__ void pair(int row, int j, f32x4 v0, f32x4 v1) const {
        u32x2 w; w.x = pk2(v0.x, v0.y); w.y = pk2(v0.z, v0.w); *(u32x2*)(O + (size_t)row * ldo + n0 + j) = w;
        w.x = pk2(v1.x, v1.y); w.y = pk2(v1.z, v1.w); *(u32x2*)(O + (size_t)row * ldo + n1 + j) = w;
    }
};
struct EpiResidF32 {
    const float* S; float* X; int n0, n1;
    __device__ __forceinline__ void pair(int row, int j, f32x4 v0, f32x4 v1) const {
        const size_t o0 = (size_t)row * DM + n0 + j, o1 = (size_t)row * DM + n1 + j;
        *(f32x4*)(X + o0) = *(const f32x4*)(S + o0) + v0; *(f32x4*)(X + o1) = *(const f32x4*)(S + o1) + v1;
    }
};
struct EpiGated {
    bf16_t* H; int hc;
    __device__ __forceinline__ void pair(int row, int j, f32x4 a, f32x4 b) const {
        f32x4 o;
#pragma unroll
        for (int i = 0; i < 4; ++i) o[i] = a[i] * sigmoidf_(a[i]) * b[i];
        u32x2 w; w.x = pk2(o.x, o.y); w.y = pk2(o.z, o.w); *(u32x2*)(H + (size_t)row * 512 + hc + j) = w;
    }
};
__device__ __forceinline__ void sg_dense_bf16(Frame& F, const bf16_t* A, int lda, const bf16_t* Bt, int K, int M, int N, bf16_t* O, int ldo) {
    PHASE_PIN(F);
    const int nN = N / 64, ntile = (M / 64) * nN;
    for (int t = F.gw; t < ntile; t += F.ngw) {
        const int mt = t / nN, nt = t % nN; EpiStoreBf16 E{O, ldo, nt * 64, nt * 64 + 32};
        sg_tile(A, lda, Bt + (size_t)(nt * 64) * K, Bt + (size_t)(nt * 64 + 32) * K, K, K, mt * 64, E, F.lane);
    }
}
__device__ __forceinline__ void sg_dense_resid(Frame& F, const bf16_t* A, const bf16_t* Bt, const float* S, float* X) {
    PHASE_PIN(F);
    const int nN = DM / 64, ntile = (NT / 64) * nN;
    for (int t = F.gw; t < ntile; t += F.ngw) {
        const int mt = t / nN, nt = t % nN; EpiResidF32 E{S, X, nt * 64, nt * 64 + 32};
        sg_tile(A, DM, Bt + (size_t)(nt * 64) * DM, Bt + (size_t)(nt * 64 + 32) * DM, DM, DM, mt * 64, E, F.lane);
    }
}

namespace pg8 {
#define PG8_LAS __attribute__((address_space(3)))
typedef unsigned short bf16_t;
typedef short bf16x8 __attribute__((ext_vector_type(8)));
typedef float f32x4 __attribute__((ext_vector_type(4)));
typedef unsigned u32x4 __attribute__((ext_vector_type(4)));
constexpr int BM = 256, BK = 64, HALF = 128, HTB = HALF * BK * 2  , STAGE_BYTES = 8 * HTB, NXCD = 8, WGM = 8;

__host__ __device__ __forceinline__ int lds_byte(int r, int c) { const int st = (r >> 4) * 2 + (c >> 5), rr = r & 15, cc = c & 31, ob = rr * 64 + cc * 2; return st * 1024 + (ob ^ (((ob >> 9) & 1) << 5)); }
__host__ __device__ __forceinline__ void stage_rc(int b, int& R, int& C) { const int st = b / 1024, sb = b % 1024, swz = sb ^ (((sb >> 9) & 1) << 5); R = (st >> 1) * 16 + swz / 64; C = (st & 1) * 32 + (swz % 64) / 2; }
__host__ __device__ __forceinline__ int perm32(int rho) { const int n = rho >> 4, i = rho & 15; return 8 * (i >> 2) + 4 * n + (i & 3); }

struct Unit { int pm, pn; };
struct Gemm { const bf16_t* A; const bf16_t* Bt; int M, N, K; };

struct StaticOrder {
    int nM, nN, nwg, G, c;
    __host__ __device__ void init(int M, int N, int G_, int c_) { nM = M / BM; nN = N / BM; nwg = nM * nN; G = G_; c = c_; }
    __host__ __device__ bool next(int i, Unit& u) const {
        const long L = (long)i * G + c; if (L >= nwg) return false;
        int wgid = (int)L; { const int q = nwg / NXCD, r = nwg % NXCD, xcd = wgid % NXCD, off = wgid / NXCD; wgid = (xcd < r ? xcd * (q + 1) : r * (q + 1) + (xcd - r) * q) + off; }
        const int nig = WGM * nN, gid = wgid / nig, fm = gid * WGM, gsz = (nM - fm) < WGM ? (nM - fm) : WGM;
        u.pm = fm + ((wgid % nig) % gsz); u.pn = (wgid % nig) / gsz; return true;
    }
    __device__ __forceinline__ void a_ready(const Unit&) const {}
    __device__ __forceinline__ void done(const Unit&) const {}
};

__device__ __forceinline__ unsigned cvt_pk_bf16(float lo, float hi) { return ::pk2(lo, hi); }
struct EpiBf16S {
    static constexpr bool PERM = true, AFTER_DRAIN = false;
    bf16_t* O; int ldc; int split_cols; size_t split_stride;
    __device__ __forceinline__ void operator()(const f32x4 (&acc)[2][2][4][2], const Unit& u, int wr, int wc, int fr, int fq) const {
        const int row0 = u.pm * BM + wr * 64 + fr; int colt = u.pn * BM; bf16_t* base = O;
        if (split_cols) { const int t = colt / split_cols; base += (size_t)t * split_stride; colt -= t * split_cols; }
        const int col0 = colt + wc * 32 + 8 * fq;
#pragma unroll
        for (int ai = 0; ai < 2; ++ai)
#pragma unroll
            for (int m = 0; m < 4; ++m) { bf16_t* rowp = base + (size_t)(row0 + ai * HALF + m * 16) * ldc + col0;
#pragma unroll
                for (int bj = 0; bj < 2; ++bj) { const f32x4 v0 = acc[ai][bj][m][0], v1 = acc[ai][bj][m][1];
                    u32x4 w; w.x = cvt_pk_bf16(v0[0], v0[1]); w.y = cvt_pk_bf16(v0[2], v0[3]); w.z = cvt_pk_bf16(v1[0], v1[1]); w.w = cvt_pk_bf16(v1[2], v1[3]);
                    *(u32x4*)(rowp + bj * HALF) = w; } }
    }
};
struct EpiResid {
    static constexpr bool PERM = false, AFTER_DRAIN = false;
    const float* S; float* X;
    __device__ __forceinline__ void operator()(const f32x4 (&acc)[2][2][4][2], const Unit& u, int wr, int wc, int fr, int fq) const {
        const int row0 = u.pm * BM + wr * 64 + fr, col0 = u.pn * BM + wc * 32 + 4 * fq;
#pragma unroll
        for (int ai = 0; ai < 2; ++ai)
#pragma unroll
            for (int m = 0; m < 4; ++m) { const size_t off = (size_t)(row0 + ai * HALF + m * 16) * 1024 + col0;
#pragma unroll
                for (int bj = 0; bj < 2; ++bj)
#pragma unroll
                    for (int n = 0; n < 2; ++n) *(f32x4*)(X + off + bj * HALF + n * 16) = *(const f32x4*)(S + off + bj * HALF + n * 16) + acc[ai][bj][m][n]; }
    }
};
struct EpiGate {
    static constexpr bool PERM = true, AFTER_DRAIN = false;
    bf16_t* H;
    __device__ __forceinline__ void operator()(const f32x4 (&acc)[2][2][4][2], const Unit& u, int wr, int wc, int fr, int fq) const {
        const int row0 = u.pm * BM + wr * 64 + fr, col0 = (u.pn & 3) * 128 + wc * 32 + 8 * fq;
#pragma unroll
        for (int ai = 0; ai < 2; ++ai)
#pragma unroll
            for (int m = 0; m < 4; ++m) { float o[8];
#pragma unroll
                for (int n = 0; n < 2; ++n)
#pragma unroll
                    for (int i = 0; i < 4; ++i) { const float a = acc[ai][0][m][n][i], b = acc[ai][1][m][n][i]; o[4 * n + i] = a * b * __builtin_amdgcn_rcpf(1.0f + __builtin_amdgcn_exp2f(-1.4426950408889634f * a)); }
                u32x4 w; w.x = cvt_pk_bf16(o[0], o[1]); w.y = cvt_pk_bf16(o[2], o[3]); w.z = cvt_pk_bf16(o[4], o[5]); w.w = cvt_pk_bf16(o[6], o[7]);
                *(u32x4*)(H + (size_t)(row0 + ai * HALF + m * 16) * 512 + col0) = w; }
    }
};
struct EpiMoeDown {
    static constexpr bool PERM = true, AFTER_DRAIN = false;
    bf16_t* Y;
    __device__ __forceinline__ void operator()(const f32x4 (&acc)[2][2][4][2], const Unit& u, int wr, int wc, int fr, int fq) const {
        const int row0 = u.pm * BM + wr * 64 + fr, col0 = (u.pn & 3) * BM + wc * 32 + 8 * fq;
#pragma unroll
        for (int ai = 0; ai < 2; ++ai)
#pragma unroll
            for (int m = 0; m < 4; ++m) { bf16_t* rowp = Y + (size_t)(row0 + ai * HALF + m * 16) * 1024 + col0;
#pragma unroll
                for (int bj = 0; bj < 2; ++bj) { const f32x4 v0 = acc[ai][bj][m][0], v1 = acc[ai][bj][m][1];
                    u32x4 w; w.x = cvt_pk_bf16(v0[0], v0[1]); w.y = cvt_pk_bf16(v0[2], v0[3]); w.z = cvt_pk_bf16(v1[0], v1[1]); w.w = cvt_pk_bf16(v1[2], v1[3]);
                    *(u32x4*)(rowp + bj * HALF) = w; } }
    }
};
struct MoeOrder {
    int nunits, G, c; const PG8_LAS int* tab;
    __device__ __forceinline__ bool next(int i, Unit& u) const {
        const int L = i * G + c; if (L >= nunits) return false;
        const int rt = L >> 2; u.pm = rt; u.pn = __builtin_amdgcn_readfirstlane(tab[rt]) * 4 + (L & 3); return true;
    }
    __device__ __forceinline__ void a_ready(const Unit&) const {}
    __device__ __forceinline__ void done(const Unit&) const {}
};
template <class Epi, class Sched, bool STAMP = false>
__device__ __forceinline__ void gemm_phase(PG8_LAS unsigned char* lds, const Gemm g, const Sched& S, const Epi& E, unsigned long long* stamps, const int wid_in) {
    int ln_; asm volatile("v_mbcnt_lo_u32_b32 %0, -1, 0\n\tv_mbcnt_hi_u32_b32 %0, -1, %0" : "=v"(ln_)); const int tid = wid_in * 64 + ln_, wid = wid_in, lane = tid & 63, wr = wid >> 2, wc = wid & 3, fr = lane & 15, fq = lane >> 4;
    const int K = g.K, nt = K / BK;
    int ts_lo = 0, ts_hi = 0, nts = 0; const unsigned long long rt_entry = STAMP ? (unsigned long long)wall_clock64() : 0ull;
#define PG8_STAMP() do { if (STAMP && wid == 0 && nts < 64) { const unsigned long long _c = (unsigned long long)clock64(); \
        ts_lo = (lane == nts) ? (int)(unsigned)_c : ts_lo; ts_hi = (lane == nts) ? (int)(unsigned)(_c >> 32) : ts_hi; ++nts; } } while (0)
    PG8_STAMP();
    unsigned voffA[2], voffB[2];
#pragma unroll
    for (int i = 0; i < 2; ++i) { int R, C; stage_rc(tid * 16 + i * 8192, R, C); const int Rb = Epi::PERM ? ((R & ~31) + perm32(R & 31)) : R;
        voffA[i] = (unsigned)(R * K + C) * 2u; voffB[i] = (unsigned)(Rb * K + C) * 2u; }
    const size_t kstep = (size_t)(BK * 2);
    const size_t hstep = (size_t)HALF * K * 2;
    const size_t tstep = 2 * hstep;
    const unsigned ldsw = (unsigned)wid * 1024u;
    const int aoff = lds_byte(wr * 64 + fr, fq * 8), boff = lds_byte(wc * 32 + fr, fq * 8);
#define PG8_SA(b, h) (((b) * 2 + (h)) * HTB)
#define PG8_SB(b, h) ((4 + (b) * 2 + (h)) * HTB)
#define PG8_STAGE(bufoff, gbase, voff) do { _Pragma("unroll") for (int _i = 0; _i < 2; ++_i) \
        __builtin_amdgcn_global_load_lds((const unsigned*)((const char*)(gbase) + (voff)[_i]), (PG8_LAS unsigned*)(lds + (bufoff) + ldsw + _i * 8192), 16, 0, 0); } while (0)
#define PG8_LDA(dst, b, h) do { _Pragma("unroll") for (int m = 0; m < 4; ++m) _Pragma("unroll") for (int k = 0; k < 2; ++k) dst[m][k] = *(const PG8_LAS bf16x8*)(lds + PG8_SA(b, h) + aoff + m * 2048 + k * 1024); } while (0)
#define PG8_LDB(dst, b, h) do { _Pragma("unroll") for (int n = 0; n < 2; ++n) _Pragma("unroll") for (int k = 0; k < 2; ++k) dst[n][k] = *(const PG8_LAS bf16x8*)(lds + PG8_SB(b, h) + boff + n * 2048 + k * 1024); } while (0)
#define PG8_MMA(ai, bj, At, Bt) do { __builtin_amdgcn_s_setprio(1); _Pragma("unroll") for (int m = 0; m < 4; ++m) _Pragma("unroll") for (int n = 0; n < 2; ++n) _Pragma("unroll") for (int k = 0; k < 2; ++k) \
        acc[ai][bj][m][n] = __builtin_amdgcn_mfma_f32_16x16x32_bf16(Bt[n][k], At[m][k], acc[ai][bj][m][n], 0, 0, 0); __builtin_amdgcn_s_setprio(0); } while (0)
#define PG8_WAIT_V(n) asm volatile("s_waitcnt vmcnt(" #n ")" ::: "memory")
#define PG8_WAIT_L(n) asm volatile("s_waitcnt lgkmcnt(" #n ")" ::: "memory")
#define PG8_BAR __builtin_amdgcn_s_barrier()
#define PG8_SCHED __builtin_amdgcn_sched_barrier(0)
    Unit cur, nxt; int ui = 0;
    if (!S.next(0, cur)) return;
    f32x4 acc[2][2][4][2];
#pragma unroll
    for (int a = 0; a < 2; ++a)
#pragma unroll
        for (int b = 0; b < 2; ++b)
#pragma unroll
            for (int m = 0; m < 4; ++m)
#pragma unroll
                for (int n = 0; n < 2; ++n) acc[a][b][m][n] = (f32x4){0.f, 0.f, 0.f, 0.f};
    bf16x8 At[4][2], B0[2][2], B1[2][2];
    const char* cA = (const char*)g.A + (size_t)cur.pm * tstep; const char* cB = (const char*)g.Bt + (size_t)cur.pn * tstep;
    S.a_ready(cur);
    PG8_STAGE(PG8_SB(0, 0), cB, voffB); PG8_STAGE(PG8_SA(0, 0), cA, voffA); PG8_STAGE(PG8_SB(0, 1), cB + hstep, voffB); PG8_STAGE(PG8_SA(0, 1), cA + hstep, voffA);
    if (wr == 1) PG8_BAR;
    PG8_WAIT_V(4); PG8_BAR;
    PG8_STAGE(PG8_SB(1, 0), cB + kstep, voffB); PG8_STAGE(PG8_SA(1, 0), cA + kstep, voffA); PG8_STAGE(PG8_SB(1, 1), cB + hstep + kstep, voffB);
    PG8_WAIT_V(6); PG8_BAR;
    PG8_STAMP();
    for (;;) {
        const bool has_next = S.next(ui + 1, nxt);
        const char* nA = has_next ? (const char*)g.A + (size_t)nxt.pm * tstep : cA; const char* nB = has_next ? (const char*)g.Bt + (size_t)nxt.pn * tstep : cB;
        for (int t = 0; t < nt; t += 2) {
            const bool last = (t == nt - 2);
            const char* a1 = cA + (size_t)(t + 1) * kstep;
            const char* a2 = last ? nA : cA + (size_t)(t + 2) * kstep; const char* b2 = last ? nB : cB + (size_t)(t + 2) * kstep;
            const char* a3 = a2 + kstep; const char* b3 = b2 + kstep;
            if (last && has_next) S.a_ready(nxt);
            PG8_LDB(B0, 0, 0); PG8_SCHED; PG8_LDA(At, 0, 0); PG8_STAGE(PG8_SA(1, 1), a1 + hstep, voffA);
            PG8_WAIT_L(8); PG8_BAR; PG8_WAIT_L(0); PG8_MMA(0, 0, At, B0); PG8_BAR; PG8_SCHED;
            PG8_LDB(B1, 0, 1); PG8_STAGE(PG8_SB(0, 0), b2, voffB);
            PG8_BAR; PG8_WAIT_L(0); PG8_MMA(0, 1, At, B1); PG8_BAR;
            PG8_LDA(At, 0, 1); PG8_STAGE(PG8_SA(0, 0), a2, voffA);
            PG8_BAR; PG8_WAIT_L(0); PG8_MMA(1, 0, At, B0); PG8_BAR; PG8_SCHED;
            PG8_STAGE(PG8_SB(0, 1), b2 + hstep, voffB);
            PG8_WAIT_V(6); PG8_BAR; PG8_MMA(1, 1, At, B1); PG8_BAR;
            PG8_LDB(B0, 1, 0); PG8_SCHED; PG8_LDA(At, 1, 0); PG8_STAGE(PG8_SA(0, 1), a2 + hstep, voffA);
            PG8_WAIT_L(8); PG8_BAR; PG8_WAIT_L(0); PG8_MMA(0, 0, At, B0); PG8_BAR; PG8_SCHED;
            PG8_LDB(B1, 1, 1); PG8_STAGE(PG8_SB(1, 0), b3, voffB);
            PG8_BAR; PG8_WAIT_L(0); PG8_MMA(0, 1, At, B1); PG8_BAR;
            PG8_LDA(At, 1, 1); PG8_STAGE(PG8_SA(1, 0), a3, voffA);
            PG8_BAR; PG8_WAIT_L(0); PG8_MMA(1, 0, At, B0); PG8_BAR; PG8_SCHED;
            PG8_STAGE(PG8_SB(1, 1), b3 + hstep, voffB);
            PG8_WAIT_V(6); PG8_BAR; PG8_MMA(1, 1, At, B1); PG8_BAR;
        }
        PG8_STAMP();
        if constexpr (!Epi::AFTER_DRAIN) { E(acc, cur, wr, wc, fr, fq); S.done(cur); }
        PG8_STAMP();
        if (!has_next) break;
#pragma unroll
        for (int a = 0; a < 2; ++a)
#pragma unroll
            for (int b = 0; b < 2; ++b)
#pragma unroll
                for (int m = 0; m < 4; ++m)
#pragma unroll
                    for (int n = 0; n < 2; ++n) acc[a][b][m][n] = (f32x4){0.f, 0.f, 0.f, 0.f};
        cur = nxt; cA = nA; cB = nB; ++ui;
    }
    PG8_WAIT_V(0);
    if (wr == 0) PG8_BAR;
    PG8_BAR;
    if constexpr (Epi::AFTER_DRAIN) { E.fused(acc, cur, wr, wc, fr, fq, lds, wid, lane); S.done(cur); }
    PG8_STAMP();
    if (STAMP && wid == 0) { stamps[lane] = lane < nts ? (((unsigned long long)(unsigned)ts_hi << 32) | (unsigned)ts_lo) : 0ull;
        if (lane == 62) stamps[62] = rt_entry; if (lane == 63) stamps[63] = (unsigned long long)wall_clock64(); }
#undef PG8_STAMP
#undef PG8_SA
#undef PG8_SB
#undef PG8_STAGE
#undef PG8_LDA
#undef PG8_LDB
#undef PG8_MMA
#undef PG8_WAIT_V
#undef PG8_WAIT_L
#undef PG8_BAR
#undef PG8_SCHED
}
}

__device__ __forceinline__ f32x4 ld_bf4(const bf16_t* p) { const u32x2 w = *(const u32x2*)p; return (f32x4){__uint_as_float(w.x << 16), __uint_as_float(w.x & 0xffff0000u), __uint_as_float(w.y << 16), __uint_as_float(w.y & 0xffff0000u)}; }
__device__ __forceinline__ float fast_sigmoid(float x) { return __builtin_amdgcn_rcpf(1.0f + __builtin_amdgcn_exp2f(-LOG2E * x)); }
__device__ __forceinline__ float fast_tanh(float x) { return 1.0f - 2.0f * __builtin_amdgcn_rcpf(1.0f + __builtin_amdgcn_exp2f(2.0f * LOG2E * x)); }
__device__ __forceinline__ void ld_pq8(const bf16_t* p, const bf16_t* q, bool hp, float (&o)[8]) {
    const u32x4 a = *(const u32x4*)p; u32x4 b = (u32x4){0u, 0u, 0u, 0u}; if (hp) b = *(const u32x4*)q;
    o[0] = __uint_as_float(a.x << 16) + __uint_as_float(b.x << 16); o[1] = __uint_as_float(a.x & 0xffff0000u) + __uint_as_float(b.x & 0xffff0000u);
    o[2] = __uint_as_float(a.y << 16) + __uint_as_float(b.y << 16); o[3] = __uint_as_float(a.y & 0xffff0000u) + __uint_as_float(b.y & 0xffff0000u);
    o[4] = __uint_as_float(a.z << 16) + __uint_as_float(b.z << 16); o[5] = __uint_as_float(a.z & 0xffff0000u) + __uint_as_float(b.z & 0xffff0000u);
    o[6] = __uint_as_float(a.w << 16) + __uint_as_float(b.w << 16); o[7] = __uint_as_float(a.w & 0xffff0000u) + __uint_as_float(b.w & 0xffff0000u);
}
__device__ __forceinline__ bf16x8 pack8(const float (&o)[8]) { u32x4 w; w.x = pk2(o[0], o[1]); w.y = pk2(o[2], o[3]); w.z = pk2(o[4], o[5]); w.w = pk2(o[6], o[7]); return __builtin_bit_cast(bf16x8, w); }
__device__ __forceinline__ void ph_prep(Frame& F, const Args& A, int e, int parts) {
    PHASE_PIN(F);
    unsigned char* ws = F.ws; const int lane = F.lane;
    const bf16_t* proj = (const bf16_t*)(ws + WS_PROJ);
    const float* mu_rkv = F.ka->in[4] + (size_t)e * 3 * 512;
    const float* w0 = F.ka->in[6] + e * 512; const float* a0 = F.ka->in[9] + e * 512;
    const float* k_k = F.ka->in[14] + e * 512; const float* k_a = F.ka->in[15] + e * 512; const float* r_k = F.ka->in[16] + e * 512;
    const float* v0 = F.ka->in[20];
    const float* kvn = F.ka->in[23] + e * 128; const float* ikn = F.ka->in[25] + e * 64;
    float* SIN = (float*)(ws + WS_SIN); float* VF = (float*)(ws + WS_VF); float* GATE = (float*)(ws + WS_GATE); float* BON = (float*)(ws + SM_BONUS);
    unsigned* SGN = (unsigned*)(ws + SM_SGN);
    bf16_t* CN = (bf16_t*)(ws + WS_CN); bf16_t* KI = (bf16_t*)(ws + WS_KI); bf16_t* QI = (bf16_t*)(ws + WS_QI); bf16_t* QLIN = (bf16_t*)(ws + SM_QLIN);
    if (parts & 1)
    for (int m = F.gw; m < NT; m += F.ngw) {
        const bf16_t* pr = proj + (size_t)m * NCOL;
        const float c0 = bf2f(pr[C_CKV + lane]), c1 = bf2f(pr[C_CKV + 64 + lane]);
        const float rs = rsqrtf(wave_sum(c0 * c0 + c1 * c1) * (1.f / 128.f) + RMS_EPS);
        CN[(size_t)m * 128 + lane] = (bf16_t)f2bf(c0 * rs * kvn[lane]); CN[(size_t)m * 128 + 64 + lane] = (bf16_t)f2bf(c1 * rs * kvn[64 + lane]);
        const float ki = bf2f(pr[C_KI + lane]); const float rs2 = rsqrtf(wave_sum(ki * ki) * (1.f / 64.f) + RMS_EPS);
        KI[(size_t)m * 64 + lane] = (bf16_t)f2bf(ki * rs2 * ikn[lane]);
        unsigned sg = 0;
#pragma unroll
        for (int hh = 0; hh < 8; ++hh) { const float w = bf2f(pr[C_WI + hh]); if (w < 0.f) sg |= 1u << hh; const float qv = bf2f(pr[C_QI + hh * 64 + lane]);
            QI[(size_t)m * 512 + hh * 64 + lane] = (bf16_t)f2bf(fabsf(w) * qv); }
        if (lane == 0) SGN[m] = sg;
    }
    if (parts & 2) { const int r = lane & 31, hf = lane >> 5;
      const bf16_t* L2W = (const bf16_t*)(ws + W_L2) + (size_t)e * (288 * 512);
      const bf16_t* w2T = L2W; const bf16_t* a2T = L2W + 64 * 512; const bf16_t* g2T = L2W + 128 * 512; const bf16_t* v2T = L2W + 256 * 512;
      for (int it = F.gw; it < 512 * 2; it += F.ngw) {
        const int half = it & 1, tile = it >> 1, m = tile * 32 + r, t = m & (TT - 1), b = m >> 13; const bool hp = t > 0;
        const bf16_t* pr = proj + (size_t)m * NCOL; const bf16_t* pp = pr - NCOL;
        bf16x8 fw[4], fa[4], fg[8], fv[2];
#pragma unroll
        for (int ks = 0; ks < 4; ++ks) { float o[8]; ld_pq8(pr + C_PW + 16 * ks + 8 * hf, pp + C_QW + 16 * ks + 8 * hf, hp, o);
#pragma unroll
            for (int j = 0; j < 8; ++j) o[j] = fast_tanh(o[j]);
            fw[ks] = pack8(o);
            ld_pq8(pr + C_PA + 16 * ks + 8 * hf, pp + C_QA + 16 * ks + 8 * hf, hp, o); fa[ks] = pack8(o); }
#pragma unroll
        for (int ks = 0; ks < 8; ++ks) { float o[8]; ld_pq8(pr + C_PG + 16 * ks + 8 * hf, pp + C_QG + 16 * ks + 8 * hf, hp, o);
#pragma unroll
            for (int j = 0; j < 8; ++j) o[j] = fast_sigmoid(o[j]);
            fg[ks] = pack8(o); }
#pragma unroll
        for (int ks = 0; ks < 2; ++ks) { float o[8] = {0.f, 0.f, 0.f, 0.f, 0.f, 0.f, 0.f, 0.f}; if (e == 1) ld_pq8(pr + C_PV + 16 * ks + 8 * hf, pp + C_QV + 16 * ks + 8 * hf, hp, o); fv[ks] = pack8(o); }
#pragma unroll 1
        for (int hq = 0; hq < 4; ++hq) {
        const int hh = 4 * half + hq;
        float ss = 0.f, bon = 0.f;
        float* so = SIN + ((size_t)(b * 8 + hh) * TT + t) * 384;
#pragma unroll
        for (int sub = 0; sub < 2; ++sub)
#pragma unroll
            for (int g = 0; g < 4; ++g) { const int ch4 = hh * 64 + sub * 32 + 8 * g + 4 * hf;
                const f32x4 kk0 = ld_bf4(pr + C_K + ch4); f32x4 kp = (f32x4){0.f, 0.f, 0.f, 0.f}; if (hp) kp = ld_bf4(pp + C_K + ch4);
                const f32x4 mk = *(const f32x4*)(mu_rkv + 512 + ch4), kk4 = *(const f32x4*)(k_k + ch4);
#pragma unroll
                for (int j = 0; j < 4; ++j) { const float kx = (kk0[j] + (kp[j] - kk0[j]) * mk[j]) * kk4[j]; ss += kx * kx; } }
        ss += __shfl_xor(ss, 32);
        const float rn = rsqrtf(fmaxf(ss, 1e-12f));
#pragma unroll 1
        for (int sub = 0; sub < 2; ++sub) {
            const int cb = hh * 64 + sub * 32;
            f32x16 acc;
#pragma unroll
            for (int i = 0; i < 16; ++i) acc[i] = 0.f;
#pragma unroll
            for (int ks = 0; ks < 4; ++ks) acc = MFMA32(*(const bf16x8*)(w2T + (size_t)(cb + r) * 64 + 16 * ks + 8 * hf), fw[ks], acc);
#pragma unroll
            for (int g = 0; g < 4; ++g) { const int ch4 = cb + 8 * g + 4 * hf; const f32x4 b0 = *(const f32x4*)(w0 + ch4); f32x4 d;
#pragma unroll
                for (int j = 0; j < 4; ++j) d[j] = __builtin_amdgcn_exp2f(-0.6065306597126334f * LOG2E * fast_sigmoid(b0[j] + acc[4 * g + j]));
                *(f32x4*)(so + 64 + sub * 32 + 8 * g + 4 * hf) = d; }
            float icv[16];
#pragma unroll
            for (int i = 0; i < 16; ++i) acc[i] = 0.f;
#pragma unroll
            for (int ks = 0; ks < 4; ++ks) acc = MFMA32(*(const bf16x8*)(a2T + (size_t)(cb + r) * 64 + 16 * ks + 8 * hf), fa[ks], acc);
#pragma unroll
            for (int g = 0; g < 4; ++g) { const int ch4 = cb + 8 * g + 4 * hf; const f32x4 b0 = *(const f32x4*)(a0 + ch4);
#pragma unroll
                for (int j = 0; j < 4; ++j) icv[4 * g + j] = fast_sigmoid(b0[j] + acc[4 * g + j]); }
#pragma unroll
            for (int i = 0; i < 16; ++i) acc[i] = 0.f;
#pragma unroll
            for (int ks = 0; ks < 8; ++ks) acc = MFMA32(*(const bf16x8*)(g2T + (size_t)(cb + r) * 128 + 16 * ks + 8 * hf), fg[ks], acc);
#pragma unroll
            for (int g = 0; g < 4; ++g) *(f32x4*)(GATE + (size_t)m * 512 + cb + 8 * g + 4 * hf) = (f32x4){acc[4 * g], acc[4 * g + 1], acc[4 * g + 2], acc[4 * g + 3]};
            if (e == 1) {
#pragma unroll
                for (int i = 0; i < 16; ++i) acc[i] = 0.f;
#pragma unroll
                for (int ks = 0; ks < 2; ++ks) acc = MFMA32(*(const bf16x8*)(v2T + (size_t)(cb + r) * 32 + 16 * ks + 8 * hf), fv[ks], acc);
            }
#pragma unroll
            for (int g = 0; g < 4; ++g) {
                const int ch4 = cb + 8 * g + 4 * hf;
                const f32x4 rr = ld_bf4(pr + C_R + ch4), kk0 = ld_bf4(pr + C_K + ch4), vv = ld_bf4(pr + C_V + ch4);
                f32x4 rp = (f32x4){0.f, 0.f, 0.f, 0.f}, kp = rp, vp = rp;
                if (hp) { rp = ld_bf4(pp + C_R + ch4); kp = ld_bf4(pp + C_K + ch4); vp = ld_bf4(pp + C_V + ch4); }
                const f32x4 mr = *(const f32x4*)(mu_rkv + ch4), mk = *(const f32x4*)(mu_rkv + 512 + ch4), mv = *(const f32x4*)(mu_rkv + 1024 + ch4);
                const f32x4 kk4 = *(const f32x4*)(k_k + ch4), ka4 = *(const f32x4*)(k_a + ch4), rk4 = *(const f32x4*)(r_k + ch4);
                const f32x4 r1 = rr + (rp - rr) * mr, k1 = kk0 + (kp - kk0) * mk; f32x4 v1 = vv + (vp - vv) * mv;
                if (e == 1) { const f32x4 vb = *(const f32x4*)(v0 + ch4), vf = *(const f32x4*)(VF + (size_t)m * 512 + ch4);
#pragma unroll
                    for (int j = 0; j < 4; ++j) v1[j] = v1[j] + (vf[j] - v1[j]) * fast_sigmoid(vb[j] + acc[4 * g + j]); }
                else *(f32x4*)(VF + (size_t)m * 512 + ch4) = v1;
                f32x4 km, kn, bb;
#pragma unroll
                for (int j = 0; j < 4; ++j) { kn[j] = k1[j] * kk4[j] * rn; bb[j] = icv[4 * g + j] * kn[j];
                    km[j] = k1[j] * (1.0f + (icv[4 * g + j] - 1.0f) * ka4[j]); bon += r1[j] * km[j] * rk4[j]; }
                *(f32x4*)(so + sub * 32 + 8 * g + 4 * hf) = r1; *(f32x4*)(so + 128 + sub * 32 + 8 * g + 4 * hf) = km; *(f32x4*)(so + 320 + sub * 32 + 8 * g + 4 * hf) = v1;
                *(f32x4*)(so + 192 + sub * 32 + 8 * g + 4 * hf) = kn; *(f32x4*)(so + 256 + sub * 32 + 8 * g + 4 * hf) = bb;
                asm volatile("" ::: "memory");
            }
        }
        bon += __shfl_xor(bon, 32);
        if (hf == 0) BON[m * 8 + hh] = bon;
        }
      } }
    if (parts & 4) { bf16_t* QA = (bf16_t*)(ws + WS_QA); const bf16_t* WkB = (const bf16_t*)(ws + W_WKB) + (size_t)e * 8 * 128 * 64;
      const int ntile = (NT / 64) * 2 * 8;
      for (int tI = F.gw; tI < ntile; tI += F.ngw) {
          const int hh = tI & 7, nt = (tI >> 3) & 1, mt = tI >> 4;
          EpiStoreBf16 E{QA + hh * 128, 1024, nt * 64, nt * 64 + 32};
          sg_tile(proj + C_QB + hh * 64, NCOL, WkB + (size_t)hh * 128 * 64 + (size_t)(nt * 64) * 64, WkB + (size_t)hh * 128 * 64 + (size_t)(nt * 64 + 32) * 64, 64, 64, mt * 64, E, F.lane);
      } }
}

__device__ __forceinline__ float allred16(float x) {
    x += __builtin_bit_cast(float, __builtin_amdgcn_update_dpp(0, __builtin_bit_cast(int, x), 0x128, 0xf, 0xf, false));
    x += __builtin_bit_cast(float, __builtin_amdgcn_update_dpp(0, __builtin_bit_cast(int, x), 0x124, 0xf, 0xf, false));
    x += __builtin_bit_cast(float, __builtin_amdgcn_update_dpp(0, __builtin_bit_cast(int, x), 0x122, 0xf, 0xf, false));
    x += __builtin_bit_cast(float, __builtin_amdgcn_update_dpp(0, __builtin_bit_cast(int, x), 0x121, 0xf, 0xf, false));
    return x;
}
__device__ __forceinline__ void ph_scan(Frame& F) {
    PHASE_PIN(F);
    if (F.wave != 0) return;
    const int lane = F.lane, i = lane >> 4, kq = lane & 15;
    for (int task = blockIdx.x; task < 256; task += gridDim.x) {
        const int bh = task >> 4, rg = task & 15, row = 4 * rg + i, b = bh >> 3, hh = bh & 7;
        const float* sin = (const float*)(F.ws + WS_SIN) + (size_t)bh * TT * 384;
        float* Y = (float*)(F.ws + WS_Y) + (size_t)b * TT * 512 + hh * 64 + row;
        f32x4 R[8], W[8], K[8], KK[8], B[8]; float V[8];
#pragma unroll
        for (int j = 0; j < 8; ++j) { const float* p = sin + (size_t)j * 384; R[j] = *(const f32x4*)(p + 4 * kq); W[j] = *(const f32x4*)(p + 64 + 4 * kq); K[j] = *(const f32x4*)(p + 128 + 4 * kq);
            KK[j] = *(const f32x4*)(p + 192 + 4 * kq); B[j] = *(const f32x4*)(p + 256 + 4 * kq); V[j] = p[320 + row]; }
        float s0 = 0.f, s1 = 0.f, s2 = 0.f, s3 = 0.f;
        for (int t0 = 0; t0 < TT; t0 += 8) {
#pragma unroll
            for (int j = 0; j < 8; ++j) {
                float p = s0 * KK[j].x + s1 * KK[j].y + s2 * KK[j].z + s3 * KK[j].w; p = allred16(p);
                s0 = s0 * W[j].x - p * B[j].x + V[j] * K[j].x; s1 = s1 * W[j].y - p * B[j].y + V[j] * K[j].y;
                s2 = s2 * W[j].z - p * B[j].z + V[j] * K[j].z; s3 = s3 * W[j].w - p * B[j].w + V[j] * K[j].w;
                float y = s0 * R[j].x + s1 * R[j].y + s2 * R[j].z + s3 * R[j].w; y = allred16(y);
                if (kq == 0) Y[(size_t)(t0 + j) * 512] = y;
                if (t0 + j + 8 < TT) { const float* p2 = sin + (size_t)(t0 + j + 8) * 384; R[j] = *(const f32x4*)(p2 + 4 * kq); W[j] = *(const f32x4*)(p2 + 64 + 4 * kq); K[j] = *(const f32x4*)(p2 + 128 + 4 * kq);
                    KK[j] = *(const f32x4*)(p2 + 192 + 4 * kq); B[j] = *(const f32x4*)(p2 + 256 + 4 * kq); V[j] = p2[320 + row]; }
            }
        }
    }
}

constexpr size_t S1_TMP_STRIDE = 114688, S1_OUT_STRIDE = 50176;
constexpr int T_TCK = 0, T_TCB = 8192, T_TCKT = 16384, T_TCR = 24576, T_CTB = 32768, T_CTK = 40960, T_CTV = 49152, T_MAK = 57344, T_AAB = 65536, T_AAK = 73728, T_CTKH = 81920, T_CTU = 90112, T_RHSF = 98304;
constexpr int O_PT = 0, O_RH = 8192, O_G = 16384, O_Y0 = 32768, O_GC = 49152;
static_assert(WS_PROJ + 2048 * S1_OUT_STRIDE <= WS_SIN && WS_S1TMP + 1024 * S1_TMP_STRIDE <= WS_END, "scan map");
#define STAGE_SYNC() asm volatile("s_waitcnt vmcnt(0) lgkmcnt(0)" ::: "memory")
template <bool TWO>
__device__ __forceinline__ void mm64_acc(const bf16_t* A1, const bf16_t* B1, const bf16_t* A2, const bf16_t* B2, f32x16& c00, f32x16& c01, f32x16& c10, f32x16& c11, int lane) {
    const int r = lane & 31, h = lane >> 5; const int o = r * 64 + 8 * h;
#pragma unroll
    for (int i = 0; i < 16; ++i) { c00[i] = 0.f; c01[i] = 0.f; c10[i] = 0.f; c11[i] = 0.f; }
#pragma unroll
    for (int k = 0; k < 64; k += 16) {
        const bf16x8 fa0 = *(const bf16x8*)(A1 + o + k), fa1 = *(const bf16x8*)(A1 + o + 2048 + k), fb0 = *(const bf16x8*)(B1 + o + k), fb1 = *(const bf16x8*)(B1 + o + 2048 + k);
        c00 = MFMA32(fb0, fa0, c00); c01 = MFMA32(fb1, fa0, c01); c10 = MFMA32(fb0, fa1, c10); c11 = MFMA32(fb1, fa1, c11);
    }
    if (TWO) {
#pragma unroll
        for (int k = 0; k < 64; k += 16) {
            const bf16x8 fa0 = *(const bf16x8*)(A2 + o + k), fa1 = *(const bf16x8*)(A2 + o + 2048 + k), fb0 = *(const bf16x8*)(B2 + o + k), fb1 = *(const bf16x8*)(B2 + o + 2048 + k);
            c00 = MFMA32(fb0, fa0, c00); c01 = MFMA32(fb1, fa0, c01); c10 = MFMA32(fb0, fa1, c10); c11 = MFMA32(fb1, fa1, c11);
        }
    }
}
template <class Epi>
__device__ __forceinline__ void mm64_epi(const Epi& epi, const f32x16& c00, const f32x16& c01, const f32x16& c10, const f32x16& c11, int lane) {
    const int r = lane & 31, h = lane >> 5;
#pragma unroll
    for (int g = 0; g < 4; ++g) { const int j = 8 * g + 4 * h;
        epi.pair(r, j, (f32x4){c00[4 * g], c00[4 * g + 1], c00[4 * g + 2], c00[4 * g + 3]}, (f32x4){c01[4 * g], c01[4 * g + 1], c01[4 * g + 2], c01[4 * g + 3]});
        epi.pair(32 + r, j, (f32x4){c10[4 * g], c10[4 * g + 1], c10[4 * g + 2], c10[4 * g + 3]}, (f32x4){c11[4 * g], c11[4 * g + 1], c11[4 * g + 2], c11[4 * g + 3]}); }
}
__device__ __forceinline__ u32x2 pk4(f32x4 v) { u32x2 w; w.x = pk2(v.x, v.y); w.y = pk2(v.z, v.w); return w; }
struct EpiMaskLds { LAS float* M; __device__ __forceinline__ void pair(int row, int j, f32x4 v0, f32x4 v1) const {
    f32x4 a, b;
#pragma unroll
    for (int q = 0; q < 4; ++q) { a[q] = (j + q < row) ? v0[q] : 0.f; b[q] = (32 + j + q < row) ? v1[q] : 0.f; }
    *(LAS f32x4*)(M + row * 64 + j) = a; *(LAS f32x4*)(M + row * 64 + 32 + j) = b; } };
template <int INCL> struct EpiMaskBf { bf16_t* O; __device__ __forceinline__ void pair(int row, int j, f32x4 v0, f32x4 v1) const {
    f32x4 a, b;
#pragma unroll
    for (int q = 0; q < 4; ++q) { a[q] = (j + q < row + INCL) ? v0[q] : 0.f; b[q] = (32 + j + q < row + INCL) ? v1[q] : 0.f; }
    *(u32x2*)(O + row * 64 + j) = pk4(a); *(u32x2*)(O + row * 64 + 32 + j) = pk4(b); } };
struct EpiF32 { float* O; __device__ __forceinline__ void pair(int row, int j, f32x4 v0, f32x4 v1) const { *(f32x4*)(O + row * 64 + j) = v0; *(f32x4*)(O + row * 64 + 32 + j) = v1; } };
struct EpiRhat { const bf16_t* R; bf16_t* O; __device__ __forceinline__ void pair(int row, int j, f32x4 v0, f32x4 v1) const {
    *(u32x2*)(O + row * 64 + j) = pk4(ld_bf4(R + row * 64 + j) - v0); *(u32x2*)(O + row * 64 + 32 + j) = pk4(ld_bf4(R + row * 64 + 32 + j) - v1); } };
struct EpiPT { const float* gC; bf16_t* O; __device__ __forceinline__ void pair(int row, int j, f32x4 v0, f32x4 v1) const {
    const float gr = gC[row]; f32x4 a, b;
#pragma unroll
    for (int q = 0; q < 4; ++q) { a[q] = gr * (((j + q == row) ? 1.f : 0.f) - v0[q]); b[q] = gr * (((32 + j + q == row) ? 1.f : 0.f) - v1[q]); }
    *(u32x2*)(O + row * 64 + j) = pk4(a); *(u32x2*)(O + row * 64 + 32 + j) = pk4(b); } };
struct EpiGsc { const float* gC; bf16_t* O; __device__ __forceinline__ void pair(int row, int j, f32x4 v0, f32x4 v1) const {
    *(u32x2*)(O + row * 64 + j) = pk4(v0 * *(const f32x4*)(gC + j)); *(u32x2*)(O + row * 64 + 32 + j) = pk4(v1 * *(const f32x4*)(gC + 32 + j)); } };

__device__ __forceinline__ void ph_scan_s1(Frame& F) {
    PHASE_PIN(F);
    if (F.wave >= 4) return;
    LAS float* Ml = (LAS float*)(F.lds + F.wave * 32768); LAS float* Xl = Ml + 4096;
    const int lane0 = F.lane;
    for (int item = blockIdx.x * 4 + F.wave; item < 2048; item += gridDim.x * 4) {
        int lane = lane0; asm volatile("" : "+v"(lane));
        const int bh = item >> 7, chunk = item & 127;
        unsigned long long zt_; asm volatile("s_mov_b64 %0, 0" : "=s"(zt_));
        unsigned char* tmp = F.ws + WS_S1TMP + (size_t)(blockIdx.x * 4 + F.wave) * S1_TMP_STRIDE + zt_;
        __builtin_amdgcn_fence(__ATOMIC_ACQUIRE, "agent"); asm volatile("s_waitcnt vmcnt(0)" ::: "memory");
        unsigned char* outp = F.ws + WS_PROJ + (size_t)item * S1_OUT_STRIDE;
        bf16_t* TCk = (bf16_t*)(tmp + T_TCK); bf16_t* TCb = (bf16_t*)(tmp + T_TCB); bf16_t* TCkt = (bf16_t*)(tmp + T_TCKT); bf16_t* TCr = (bf16_t*)(tmp + T_TCR);
        bf16_t* CTb = (bf16_t*)(tmp + T_CTB); bf16_t* CTk = (bf16_t*)(tmp + T_CTK); bf16_t* CTv = (bf16_t*)(tmp + T_CTV);
        bf16_t* MAK = (bf16_t*)(tmp + T_MAK); bf16_t* AAB = (bf16_t*)(tmp + T_AAB); bf16_t* AAK = (bf16_t*)(tmp + T_AAK);
        bf16_t* CTKH = (bf16_t*)(tmp + T_CTKH); bf16_t* CTU = (bf16_t*)(tmp + T_CTU); float* RHSF = (float*)(tmp + T_RHSF);
        bf16_t* PT = (bf16_t*)(outp + O_PT); bf16_t* RH = (bf16_t*)(outp + O_RH); bf16_t* Gm = (bf16_t*)(outp + O_G); float* Y0 = (float*)(outp + O_Y0); float* gC = (float*)(outp + O_GC);
        const float* sin = (const float*)(F.ws + WS_SIN) + ((size_t)bh * TT + chunk * 64) * 384;
#ifndef S1_NO_CT
        { float gam[65]; gam[0] = 1.0f;
#pragma unroll
          for (int i = 0; i < 64; ++i) gam[i + 1] = sin[(size_t)i * 384 + 64 + lane];
#pragma unroll
          for (int i = 0; i < 64; ++i) gam[i + 1] *= gam[i];
#pragma unroll
          for (int blk = 0; blk < 8; ++blk) {
            float bt8[8], kt8[8], v8[8];
#pragma unroll
            for (int el = 0; el < 8; ++el) { const int i = blk * 8 + el; const float* p = sin + (size_t)i * 384;
                const float rr = p[lane], kk = p[128 + lane], ka = p[192 + lane], bb = p[256 + lane], vv = p[320 + lane];
                const float kap = gam[i] * ka; const float g = gam[i + 1]; const float inv = __builtin_amdgcn_rcpf(g); const float bt = bb * inv, kt = kk * inv, rt = rr * g;
                TCk[i * 64 + lane] = (bf16_t)f2bf(kap); TCb[i * 64 + lane] = (bf16_t)f2bf(bt); TCkt[i * 64 + lane] = (bf16_t)f2bf(kt); TCr[i * 64 + lane] = (bf16_t)f2bf(rt);
                bt8[el] = bt; kt8[el] = kt; v8[el] = vv; }
            *(bf16x8*)(CTb + lane * 64 + blk * 8) = pack8(bt8); *(bf16x8*)(CTk + lane * 64 + blk * 8) = pack8(kt8); *(bf16x8*)(CTv + lane * 64 + blk * 8) = pack8(v8);
            asm volatile("" ::: "memory");
          }
          gC[lane] = gam[64]; }
#endif
        STAGE_SYNC();
        f32x16 c00, c01, c10, c11;
        mm64_acc<false>(TCk, TCb, nullptr, nullptr, c00, c01, c10, c11, lane); { EpiMaskLds E{Ml}; mm64_epi(E, c00, c01, c10, c11, lane); }
        mm64_acc<false>(TCk, TCkt, nullptr, nullptr, c00, c01, c10, c11, lane); { EpiMaskBf<0> E{MAK}; mm64_epi(E, c00, c01, c10, c11, lane); }
        STAGE_SYNC();
        mm64_acc<false>(MAK, CTv, nullptr, nullptr, c00, c01, c10, c11, lane); { EpiF32 E{RHSF}; mm64_epi(E, c00, c01, c10, c11, lane); }
        STAGE_SYNC();
#ifndef S1_NO_SOLVE
#pragma unroll 1
        for (int pass = 0; pass < 2; ++pass) {
            if (pass & 1) {
#pragma unroll 8
                for (int i = 0; i < 64; ++i) Xl[i * 64 + lane] = RHSF[i * 64 + lane];
            } else {
#pragma unroll 8
                for (int i = 0; i < 64; ++i) Xl[i * 64 + lane] = bf2f(TCk[i * 64 + lane]);
            }
#pragma unroll 1
            for (int i0 = 0; i0 < 64; i0 += 4) {
                float a0 = Xl[i0 * 64 + lane], a1 = Xl[(i0 + 1) * 64 + lane], a2 = Xl[(i0 + 2) * 64 + lane], a3 = Xl[(i0 + 3) * 64 + lane];
#pragma unroll 2
                for (int j4 = 0; j4 < i0; j4 += 4) {
                    const float x0 = Xl[j4 * 64 + lane], x1 = Xl[(j4 + 1) * 64 + lane], x2 = Xl[(j4 + 2) * 64 + lane], x3 = Xl[(j4 + 3) * 64 + lane];
                    const f32x4 m0 = *(const LAS f32x4*)(Ml + i0 * 64 + j4), m1 = *(const LAS f32x4*)(Ml + (i0 + 1) * 64 + j4), m2 = *(const LAS f32x4*)(Ml + (i0 + 2) * 64 + j4), m3 = *(const LAS f32x4*)(Ml + (i0 + 3) * 64 + j4);
                    a0 -= m0.x * x0 + m0.y * x1 + m0.z * x2 + m0.w * x3; a1 -= m1.x * x0 + m1.y * x1 + m1.z * x2 + m1.w * x3;
                    a2 -= m2.x * x0 + m2.y * x1 + m2.z * x2 + m2.w * x3; a3 -= m3.x * x0 + m3.y * x1 + m3.z * x2 + m3.w * x3;
                }
                const f32x4 d1 = *(const LAS f32x4*)(Ml + (i0 + 1) * 64 + i0), d2 = *(const LAS f32x4*)(Ml + (i0 + 2) * 64 + i0), d3 = *(const LAS f32x4*)(Ml + (i0 + 3) * 64 + i0);
                a1 -= d1.x * a0; a2 -= d2.x * a0 + d2.y * a1; a3 -= d3.x * a0 + d3.y * a1 + d3.z * a2;
                Xl[i0 * 64 + lane] = a0; Xl[(i0 + 1) * 64 + lane] = a1; Xl[(i0 + 2) * 64 + lane] = a2; Xl[(i0 + 3) * 64 + lane] = a3;
            }
            bf16_t* dst = (pass & 1) ? CTU : CTKH; const float sgn = (pass & 1) ? -1.0f : 1.0f;
#pragma unroll 1
            for (int blk = 0; blk < 8; ++blk) { float o8[8];
#pragma unroll
                for (int el = 0; el < 8; ++el) o8[el] = sgn * Xl[(blk * 8 + el) * 64 + lane];
                *(bf16x8*)(dst + lane * 64 + blk * 8) = pack8(o8); }
        }
#endif
        mm64_acc<false>(TCr, TCb, nullptr, nullptr, c00, c01, c10, c11, lane); { EpiMaskBf<1> E{AAB}; mm64_epi(E, c00, c01, c10, c11, lane); }
        mm64_acc<false>(TCr, TCkt, nullptr, nullptr, c00, c01, c10, c11, lane); { EpiMaskBf<1> E{AAK}; mm64_epi(E, c00, c01, c10, c11, lane); }
        STAGE_SYNC();
        mm64_acc<false>(AAB, CTKH, nullptr, nullptr, c00, c01, c10, c11, lane); { EpiRhat E{TCr, RH}; mm64_epi(E, c00, c01, c10, c11, lane); }
        mm64_acc<true>(AAB, CTU, AAK, CTv, c00, c01, c10, c11, lane); { EpiF32 E{Y0}; mm64_epi(E, c00, c01, c10, c11, lane); }
        mm64_acc<false>(CTb, CTKH, nullptr, nullptr, c00, c01, c10, c11, lane); { EpiPT E{gC, PT}; mm64_epi(E, c00, c01, c10, c11, lane); }
        mm64_acc<true>(CTU, CTb, CTv, CTk, c00, c01, c10, c11, lane); { EpiGsc E{gC, Gm}; mm64_epi(E, c00, c01, c10, c11, lane); }
        STAGE_SYNC();
    }
}
__device__ __forceinline__ void ph_scan_s2(Frame& F) {
    PHASE_PIN(F);
    if (F.wave != 0 || blockIdx.x >= 32) return;
    const int lane = F.lane, r = lane & 31, hf = lane >> 5; const int bh = blockIdx.x >> 1, vt = blockIdx.x & 1, v = 32 * vt + r;
    bf16_t* SS = (bf16_t*)(F.ws + WS_Y);
    f32x16 acc0, acc1;
#pragma unroll
    for (int i = 0; i < 16; ++i) { acc0[i] = 0.f; acc1[i] = 0.f; }
    u32x2 pt[4][2][4][2]; u32x2 gin[2][2][4];
#define S2_LOADP(buf, chunk) do { const bf16_t* PT_ = (const bf16_t*)(F.ws + WS_PROJ + (size_t)(bh * 128 + (chunk)) * S1_OUT_STRIDE + O_PT); \
        _Pragma("unroll") for (int ni = 0; ni < 2; ++ni) { _Pragma("unroll") for (int s2 = 0; s2 < 4; ++s2) { pt[buf][ni][s2][0] = *(const u32x2*)(PT_ + (32 * ni + r) * 64 + 16 * s2 + 4 * hf); pt[buf][ni][s2][1] = *(const u32x2*)(PT_ + (32 * ni + r) * 64 + 16 * s2 + 8 + 4 * hf); } } } while (0)
#define S2_LOADG(buf, chunk) do { const bf16_t* G_ = (const bf16_t*)(F.ws + WS_PROJ + (size_t)(bh * 128 + (chunk)) * S1_OUT_STRIDE + O_G); \
        _Pragma("unroll") for (int ni = 0; ni < 2; ++ni) { _Pragma("unroll") for (int g = 0; g < 4; ++g) gin[buf][ni][g] = *(const u32x2*)(G_ + v * 64 + 32 * ni + 8 * g + 4 * hf); } } while (0)
#define S2_STEP(pb, gb, chunk) do { bf16_t* so_ = SS + ((size_t)(bh * 128 + (chunk)) * 64 + v) * 64 + 4 * hf; \
        _Pragma("unroll") for (int g = 0; g < 4; ++g) { *(u32x2*)(so_ + 8 * g) = pk4((f32x4){acc0[4 * g], acc0[4 * g + 1], acc0[4 * g + 2], acc0[4 * g + 3]}); *(u32x2*)(so_ + 32 + 8 * g) = pk4((f32x4){acc1[4 * g], acc1[4 * g + 1], acc1[4 * g + 2], acc1[4 * g + 3]}); } \
        bf16x8 sf[4]; { u32x4 w_; \
          w_.x = pk2(acc0[0], acc0[1]); w_.y = pk2(acc0[2], acc0[3]); w_.z = pk2(acc0[4], acc0[5]); w_.w = pk2(acc0[6], acc0[7]); sf[0] = __builtin_bit_cast(bf16x8, w_); \
          w_.x = pk2(acc0[8], acc0[9]); w_.y = pk2(acc0[10], acc0[11]); w_.z = pk2(acc0[12], acc0[13]); w_.w = pk2(acc0[14], acc0[15]); sf[1] = __builtin_bit_cast(bf16x8, w_); \
          w_.x = pk2(acc1[0], acc1[1]); w_.y = pk2(acc1[2], acc1[3]); w_.z = pk2(acc1[4], acc1[5]); w_.w = pk2(acc1[6], acc1[7]); sf[2] = __builtin_bit_cast(bf16x8, w_); \
          w_.x = pk2(acc1[8], acc1[9]); w_.y = pk2(acc1[10], acc1[11]); w_.z = pk2(acc1[12], acc1[13]); w_.w = pk2(acc1[14], acc1[15]); sf[3] = __builtin_bit_cast(bf16x8, w_); } \
        f32x16 n0_, n1_; \
        _Pragma("unroll") for (int q = 0; q < 16; ++q) { n0_[q] = 0.f; n1_[q] = 0.f; } \
        _Pragma("unroll") for (int s2 = 0; s2 < 4; ++s2) { u32x4 a_; a_.x = pt[pb][0][s2][0].x; a_.y = pt[pb][0][s2][0].y; a_.z = pt[pb][0][s2][1].x; a_.w = pt[pb][0][s2][1].y; n0_ = MFMA32(__builtin_bit_cast(bf16x8, a_), sf[s2], n0_); \
            a_.x = pt[pb][1][s2][0].x; a_.y = pt[pb][1][s2][0].y; a_.z = pt[pb][1][s2][1].x; a_.w = pt[pb][1][s2][1].y; n1_ = MFMA32(__builtin_bit_cast(bf16x8, a_), sf[s2], n1_); } \
        _Pragma("unroll") for (int g = 0; g < 4; ++g) { const u32x2 g0_ = gin[gb][0][g], g1_ = gin[gb][1][g]; \
            n0_[4 * g] += __uint_as_float(g0_.x << 16); n0_[4 * g + 1] += __uint_as_float(g0_.x & 0xffff0000u); n0_[4 * g + 2] += __uint_as_float(g0_.y << 16); n0_[4 * g + 3] += __uint_as_float(g0_.y & 0xffff0000u); \
            n1_[4 * g] += __uint_as_float(g1_.x << 16); n1_[4 * g + 1] += __uint_as_float(g1_.x & 0xffff0000u); n1_[4 * g + 2] += __uint_as_float(g1_.y << 16); n1_[4 * g + 3] += __uint_as_float(g1_.y & 0xffff0000u); } \
        acc0 = n0_; acc1 = n1_; } while (0)
    S2_LOADP(0, 0); S2_LOADP(1, 1); S2_LOADP(2, 2); S2_LOADG(0, 0);
    for (int chunk = 0; chunk < 128; chunk += 4) {
        S2_LOADP(3, chunk + 3); S2_LOADG(1, chunk + 1); S2_STEP(0, 0, chunk);
        if (chunk + 4 < 128) S2_LOADP(0, chunk + 4);
        S2_LOADG(0, chunk + 2); S2_STEP(1, 1, chunk + 1);
        if (chunk + 5 < 128) S2_LOADP(1, chunk + 5);
        S2_LOADG(1, chunk + 3); S2_STEP(2, 0, chunk + 2);
        if (chunk + 6 < 128) S2_LOADP(2, chunk + 6);
        if (chunk + 4 < 128) S2_LOADG(0, chunk + 4);
        S2_STEP(3, 1, chunk + 3);
    }
#undef S2_LOADP
#undef S2_LOADG
#undef S2_STEP
}
__device__ __forceinline__ void ph_scan_s3(Frame& F, int e) {
    PHASE_PIN(F);
    const int lane = F.lane, r = lane & 31, hf = lane >> 5;
    const float* ln_g = F.ka->in[17] + e * 512; const float* ln_b = F.ka->in[18] + e * 512;
    const float* GATE = (const float*)(F.ws + WS_GATE); const float* BON = (const float*)(F.ws + SM_BONUS); const float* SIN = (const float*)(F.ws + WS_SIN);
    bf16_t* YC = (bf16_t*)(F.ws + WS_YCAT); const bf16_t* SS = (const bf16_t*)(F.ws + WS_Y);
    for (int item = F.gw; item < 2048; item += F.ngw) {
        const int bh = item >> 7, chunk = item & 127, b = bh >> 3, hh = bh & 7;
        const unsigned char* outp = F.ws + WS_PROJ + (size_t)item * S1_OUT_STRIDE;
        const bf16_t* RH = (const bf16_t*)(outp + O_RH); const float* Y0 = (const float*)(outp + O_Y0);
        f32x16 c[2][2];
        mm64_acc<false>(RH, SS + (size_t)item * 4096, nullptr, nullptr, c[0][0], c[0][1], c[1][0], c[1][1], lane);
#pragma unroll
        for (int mi = 0; mi < 2; ++mi) {
            const int i = 32 * mi + r, t = chunk * 64 + i, m = b * TT + t;
            float s1 = 0.f;
#pragma unroll
            for (int ni = 0; ni < 2; ++ni)
#pragma unroll
                for (int g = 0; g < 4; ++g) { const f32x4 y0 = *(const f32x4*)(Y0 + i * 64 + 32 * ni + 8 * g + 4 * hf);
#pragma unroll
                    for (int q = 0; q < 4; ++q) { c[mi][ni][4 * g + q] += y0[q]; s1 += c[mi][ni][4 * g + q]; } }
            s1 += __shfl_xor(s1, 32); const float mean = s1 * (1.f / 64.f); float s2 = 0.f;
#pragma unroll
            for (int ni = 0; ni < 2; ++ni)
#pragma unroll
                for (int q = 0; q < 16; ++q) { const float d = c[mi][ni][q] - mean; c[mi][ni][q] = d; s2 += d * d; }
            s2 += __shfl_xor(s2, 32); const float rstd = rsqrtf(s2 * (1.f / 64.f) + GN_EPS); const float bon = BON[m * 8 + hh];
            const float* vrow = SIN + ((size_t)bh * TT + t) * 384 + 320;
#pragma unroll
            for (int ni = 0; ni < 2; ++ni)
#pragma unroll
                for (int g = 0; g < 4; ++g) { const int vv = 32 * ni + 8 * g + 4 * hf, ch = hh * 64 + vv;
                    const f32x4 lg = *(const f32x4*)(ln_g + ch), lb = *(const f32x4*)(ln_b + ch), v1 = *(const f32x4*)(vrow + vv), gt = *(const f32x4*)(GATE + (size_t)m * 512 + ch); f32x4 o;
#pragma unroll
                    for (int q = 0; q < 4; ++q) o[q] = (c[mi][ni][4 * g + q] * rstd * lg[q] + lb[q] + bon * v1[q]) * gt[q];
                    *(u32x2*)(YC + (size_t)m * 1024 + ch) = pk4(o); }
        }
    }
}

__device__ __forceinline__ size_t score_row_off(int b, int t) { const int j = t >> 7; return (size_t)b * SCORE_PER_BATCH + (size_t)16384 * (j * (j + 1) / 2) + (size_t)(t & 127) * (128 * (j + 1)); }
__device__ __forceinline__ void ph_idx_score(Frame& F) {
    PHASE_PIN(F);
    const int lane = F.lane, r = lane & 31, h = lane >> 5;
    const bf16_t* QI = (const bf16_t*)(F.ws + WS_QI); const bf16_t* KI = (const bf16_t*)(F.ws + WS_KI); const unsigned* SGN = (const unsigned*)(F.ws + SM_SGN);
    float* SC = (float*)(F.ws + WS_SCORE);
    if (F.wave < 4) return;
    for (int it = blockIdx.x * 4 + (F.wave - 4); it < 4352; it += gridDim.x * 4) {
        const int b = it / 2176; int i = it - b * 2176; i = 2175 - i;
        int a = 1; while (8 * a * (a + 1) <= i) ++a;
        const int rem = i - 8 * a * (a - 1), qt = 16 * (a - 1) + rem / a, g = rem % a;
        const int mq = b * TT + qt * 32 + r;
        bf16x8 qf[8][4];
#pragma unroll
        for (int hh = 0; hh < 8; ++hh)
#pragma unroll
            for (int ks = 0; ks < 4; ++ks) qf[hh][ks] = *(const bf16x8*)(QI + (size_t)mq * 512 + hh * 64 + ks * 16 + 8 * h);
        const unsigned sg = SGN[mq];
        float* srow = SC + score_row_off(b, qt * 32 + r);
        const int kt_end = (16 * g + 15 < qt) ? 16 * g + 15 : qt;
        for (int kt = 16 * g; kt <= kt_end; ++kt) {
            const bf16_t* kp = KI + (size_t)(b * TT + kt * 32 + r) * 64 + 8 * h;
            const bf16x8 kf0 = *(const bf16x8*)(kp), kf1 = *(const bf16x8*)(kp + 16), kf2 = *(const bf16x8*)(kp + 32), kf3 = *(const bf16x8*)(kp + 48);
            float sc[16];
#pragma unroll
            for (int q = 0; q < 16; ++q) sc[q] = 0.f;
#pragma unroll
            for (int hh = 0; hh < 8; ++hh) {
                f32x16 acc;
#pragma unroll
                for (int q = 0; q < 16; ++q) acc[q] = 0.f;
                acc = MFMA32(kf0, qf[hh][0], acc); acc = MFMA32(kf1, qf[hh][1], acc); acc = MFMA32(kf2, qf[hh][2], acc); acc = MFMA32(kf3, qf[hh][3], acc);
                const bool neg = (sg >> hh) & 1u;
#pragma unroll
                for (int q = 0; q < 16; ++q) { const float v = fmaxf(acc[q], 0.f); sc[q] = neg ? sc[q] - v : sc[q] + v; }
            }
#pragma unroll
            for (int g4 = 0; g4 < 4; ++g4) *(f32x4*)(srow + kt * 32 + 8 * g4 + 4 * h) = (f32x4){sc[4 * g4], sc[4 * g4 + 1], sc[4 * g4 + 2], sc[4 * g4 + 3]};
        }
    }
}
__device__ __forceinline__ unsigned block_excl_scan(unsigned v, LAS unsigned* scr, int tid, unsigned* total) {
    const int lane = tid & 63, w = tid >> 6; unsigned x = v;
#pragma unroll
    for (int o = 1; o < 64; o <<= 1) { const unsigned y = __shfl_up(x, o); if (lane >= o) x += y; }
    __syncthreads();
    if (lane == 63) scr[w] = x;
    __syncthreads();
    unsigned base = 0, tot = 0;
#pragma unroll
    for (int j = 0; j < 8; ++j) { const unsigned c = scr[j]; if (j < w) base += c; tot += c; }
    *total = tot;
    return base + x - v;
}
__device__ __forceinline__ void ph_idx_select(Frame& F) {
    PHASE_PIN(F);
    const int lane = F.lane;
    LAS unsigned* hist = (LAS unsigned*)(F.lds + F.wave * LDS_WSCR);
    LAS float* cval = (LAS float*)(hist + 2048); LAS int* cidx = (LAS int*)(cval + 1024);
    const float* SC = (const float*)(F.ws + WS_SCORE); int* SEL = (int*)(F.ws + WS_SEL);
    const unsigned long long lt_mask = (1ull << lane) - 1ull;
    if (F.wave == 0 && blockIdx.x < 32) return;
    const int nsel = F.ngw - 32, wsel = (blockIdx.x < 32) ? blockIdx.x * 7 + F.wave - 1 : 224 + (blockIdx.x - 32) * 8 + F.wave;
    for (int m = wsel; m < NT; m += nsel) {
        const int t = m & (TT - 1), b = m >> 13, n = t + 1; int* sel = SEL + (size_t)m * 256;
        if (n <= 256) {
#pragma unroll
            for (int i = 0; i < 4; ++i) sel[lane + 64 * i] = (lane + 64 * i < n) ? lane + 64 * i : -1;
            continue; }
        const float* srow = SC + score_row_off(b, t);
        const int nch = (n + 255) >> 8;
        float lo = INFINITY, hi = -INFINITY;
        { const f32x4 v = *(const f32x4*)(srow + 4 * lane);
#pragma unroll
          for (int i = 0; i < 4; ++i) { lo = fminf(lo, v[i]); hi = fmaxf(hi, v[i]); } }
#pragma unroll
        for (int o = 1; o < 64; o <<= 1) { lo = fminf(lo, __shfl_xor(lo, o)); hi = fmaxf(hi, __shfl_xor(hi, o)); }
        if (!(hi > lo)) { lo -= 1.0f; hi += 1.0f; }
        unsigned need = 256u, outpos = 0u;
        for (int level = 0; level < 8; ++level) {
            const bool l0 = (level == 0);
            if (!(hi > lo)) {
                for (int c = 0; c < nch && need > 0u; ++c) { const int idx0 = 256 * c + 4 * lane; f32x4 v = (f32x4){0.f, 0.f, 0.f, 0.f}; if (idx0 < n) v = *(const f32x4*)(srow + idx0);
                    bool f[4]; unsigned before = 0, mine = 0;
#pragma unroll
                    for (int i = 0; i < 4; ++i) { f[i] = (idx0 + i < n) && v[i] == lo; before += __popcll(__ballot(f[i]) & lt_mask); }
                    unsigned total = 0;
#pragma unroll
                    for (int i = 0; i < 4; ++i) total += __popcll(__ballot(f[i]));
#pragma unroll
                    for (int i = 0; i < 4; ++i) { if (f[i]) { const unsigned p = before + mine; if (p < need) sel[outpos + p] = idx0 + i; ++mine; } }
                    const unsigned took = total < need ? total : need; outpos += took; need -= took; }
                break;
            }
            const float scale = 2047.0f / (hi - lo);
#pragma unroll
            for (int i = 0; i < 8; ++i) *(LAS u32x4*)(hist + 4 * (lane + 64 * i)) = (u32x4){0u, 0u, 0u, 0u};
            LDS_WAIT(); asm volatile("" ::: "memory");
            for (int c0 = 0; c0 < nch; c0 += 4) {
                f32x4 vv[4];
#pragma unroll
                for (int u = 0; u < 4; ++u) { const int idx0 = 256 * (c0 + u) + 4 * lane; vv[u] = (f32x4){0.f, 0.f, 0.f, 0.f}; if (idx0 < n) vv[u] = *(const f32x4*)(srow + idx0); }
#pragma unroll
                for (int u = 0; u < 4; ++u) { const int idx0 = 256 * (c0 + u) + 4 * lane; const f32x4 v = vv[u];
#pragma unroll
                    for (int i = 0; i < 4; ++i) if (idx0 + i < n && (l0 || (v[i] >= lo && v[i] <= hi))) { int bq = (int)((v[i] - lo) * scale); bq = bq < 0 ? 0 : (bq > 2047 ? 2047 : bq);
                        __hip_atomic_fetch_add(&hist[bq], 1u, __ATOMIC_RELAXED, __HIP_MEMORY_SCOPE_WORKGROUP); } } }
            LDS_WAIT(); asm volatile("" ::: "memory");
            unsigned hv[32], L = 0;
#pragma unroll
            for (int i = 0; i < 8; ++i) { const u32x4 h4 = *(const LAS u32x4*)(hist + 2044 - 32 * lane - 4 * i); hv[4 * i] = h4.w; hv[4 * i + 1] = h4.z; hv[4 * i + 2] = h4.y; hv[4 * i + 3] = h4.x; L += h4.x + h4.y + h4.z + h4.w; }
            unsigned xs = L;
#pragma unroll
            for (int o = 1; o < 64; o <<= 1) { const unsigned y = __shfl_up(xs, o); if (lane >= o) xs += y; }
            unsigned run = xs - L; const bool finder = (run < need && need <= run + L);
            int fb = 0; unsigned fneed = 0, fcnt = 0;
#pragma unroll
            for (int i = 0; i < 32; ++i) { if (run < need && need <= run + hv[i]) { fb = 2047 - 32 * lane - i; fneed = need - run; fcnt = hv[i]; } run += hv[i]; }
            const int fl = __ffsll((long long)__ballot(finder)) - 1;
            const int bstar = __shfl(fb, fl); const unsigned need2 = __shfl(fneed, fl), cnum = __shfl(fcnt, fl);
            const bool listed = cnum <= 1024u;
            float lo2 = INFINITY, hi2 = -INFINITY; unsigned cpos = 0;
            for (int c0 = 0; c0 < nch; c0 += 4) {
              f32x4 vv[4];
#pragma unroll
              for (int u = 0; u < 4; ++u) { const int idx0 = 256 * (c0 + u) + 4 * lane; vv[u] = (f32x4){0.f, 0.f, 0.f, 0.f}; if (idx0 < n) vv[u] = *(const f32x4*)(srow + idx0); }
#pragma unroll
              for (int u = 0; u < 4; ++u) { const int idx0 = 256 * (c0 + u) + 4 * lane; const f32x4 v = vv[u];
                bool fg[4], fe[4]; unsigned bg = 0, be = 0, tg = 0, te = 0;
#pragma unroll
                for (int i = 0; i < 4; ++i) { const bool act = (idx0 + i < n) && (l0 || (v[i] >= lo && v[i] <= hi)); int bq = (int)((v[i] - lo) * scale); bq = bq < 0 ? 0 : (bq > 2047 ? 2047 : bq);
                    fg[i] = act && bq > bstar; fe[i] = act && bq == bstar;
                    const unsigned long long mg = __ballot(fg[i]), me = __ballot(fe[i]); bg += __popcll(mg & lt_mask); be += __popcll(me & lt_mask); tg += __popcll(mg); te += __popcll(me); }
                unsigned mg2 = 0, me2 = 0;
#pragma unroll
                for (int i = 0; i < 4; ++i) {
                    if (fg[i]) { sel[outpos + bg + mg2] = idx0 + i; ++mg2; }
                    if (fe[i]) { lo2 = fminf(lo2, v[i]); hi2 = fmaxf(hi2, v[i]); if (listed) { cval[cpos + be + me2] = v[i]; cidx[cpos + be + me2] = idx0 + i; } ++me2; } }
                outpos += tg; cpos += te; } }
            need = need2;
            if (listed) {
                LDS_WAIT(); asm volatile("" ::: "memory");
                for (unsigned i = lane; i < cnum; i += 64) { const float vi = cval[i]; const int ii = cidx[i]; unsigned rank = 0;
                    for (unsigned j = 0; j < cnum; ++j) { const float vj = cval[j]; rank += (vj > vi || (vj == vi && cidx[j] < ii)) ? 1u : 0u; }
                    if (rank < need) sel[outpos + rank] = ii; }
                LDS_WAIT(); asm volatile("" ::: "memory");
                break;
            }
#pragma unroll
            for (int o = 1; o < 64; o <<= 1) { lo2 = fminf(lo2, __shfl_xor(lo2, o)); hi2 = fmaxf(hi2, __shfl_xor(hi2, o)); }
            lo = lo2; hi = hi2;
        }
    }
}

#define MFMA16(a, b, c) __builtin_amdgcn_mfma_f32_16x16x32_bf16((a), (b), (c), 0, 0, 0)
__device__ __forceinline__ void ph_sparse(Frame& F, int e) {
    PHASE_PIN(F);
    const int lane = F.lane, hd = lane & 15, gq = lane >> 4; unsigned char* ws = F.ws;
    LAS unsigned char* Tl = F.lds + F.wave * LDS_WSCR;
    const bf16_t* QA = (const bf16_t*)(ws + WS_QA); bf16_t* CTXo = (bf16_t*)(ws + WS_XB);   const bf16_t* CN = (const bf16_t*)(ws + WS_CN); const int* SEL = (const int*)(ws + WS_SEL);
    for (int m = F.gw; m < NT; m += F.ngw) {
        const int t = m & (TT - 1), b = m >> 13; const int nvalid = (t + 1 < 256) ? t + 1 : 256;
        bf16x8 qf[4];
#pragma unroll
        for (int ks = 0; ks < 4; ++ks) { u32x4 z = (u32x4){0u, 0u, 0u, 0u}; if (hd < 8) z = *(const u32x4*)(QA + (size_t)m * 1024 + hd * 128 + 32 * ks + 8 * gq); qf[ks] = __builtin_bit_cast(bf16x8, z); }
        f32x4 ctx[8];
#pragma unroll
        for (int i = 0; i < 8; ++i) ctx[i] = (f32x4){0.f, 0.f, 0.f, 0.f};
        float mrun = -INFINITY, lsum = 0.f;
        const bf16_t* cbase = CN + (size_t)b * TT * 128;
#pragma unroll 1
        for (int c = 0; c < 4; ++c) {
            if (64 * c >= nvalid) break;
            int sjc = SEL[(size_t)m * 256 + 64 * c + lane]; if (sjc < 0) sjc = 0;
            bf16x8 pc[4][4];
#pragma unroll
            for (int kt = 0; kt < 4; ++kt) { const int s = __shfl(sjc, 16 * kt + hd); const bf16_t* row = cbase + (size_t)s * 128 + 8 * gq;
#pragma unroll
                for (int ks = 0; ks < 4; ++ks) pc[kt][ks] = *(const bf16x8*)(row + 32 * ks); }
            f32x4 d[4];
#pragma unroll
            for (int kt = 0; kt < 4; ++kt) { f32x4 a = (f32x4){0.f, 0.f, 0.f, 0.f};
#pragma unroll
                for (int ks = 0; ks < 4; ++ks) a = MFMA16(pc[kt][ks], qf[ks], a);
#pragma unroll
                for (int q = 0; q < 4; ++q) { const int kidx = 64 * c + 16 * kt + 4 * gq + q; d[kt][q] = (kidx < nvalid) ? a[q] * (0.125f * LOG2E) : -INFINITY; } }
            { LAS unsigned char* wb = Tl + (hd >> 2) * 1024 + (hd & 3) * 2 + gq * 64;
#pragma unroll
              for (int kt = 0; kt < 4; ++kt)
#pragma unroll
                for (int ks = 0; ks < 4; ++ks)
#pragma unroll
                    for (int el = 0; el < 8; ++el) *(LAS bf16_t*)(wb + 4 * kt * 1024 + (32 * ks + el) * 8) = (bf16_t)pc[kt][ks][el]; }
            float mx = fmaxf(fmaxf(fmaxf(d[0][0], d[0][1]), fmaxf(d[0][2], d[0][3])), fmaxf(fmaxf(d[1][0], d[1][1]), fmaxf(d[1][2], d[1][3])));
            mx = fmaxf(mx, fmaxf(fmaxf(fmaxf(d[2][0], d[2][1]), fmaxf(d[2][2], d[2][3])), fmaxf(fmaxf(d[3][0], d[3][1]), fmaxf(d[3][2], d[3][3]))));
            mx = fmaxf(mx, __shfl_xor(mx, 16)); mx = fmaxf(mx, __shfl_xor(mx, 32));
            const float mnew = fmaxf(mrun, mx); const float scale = __builtin_amdgcn_exp2f(mrun - mnew); mrun = mnew;
            float psum = 0.f;
#pragma unroll
            for (int kt = 0; kt < 4; ++kt)
#pragma unroll
                for (int q = 0; q < 4; ++q) { d[kt][q] = __builtin_amdgcn_exp2f(d[kt][q] - mnew); psum += d[kt][q]; }
            lsum = lsum * scale + psum;
#pragma unroll
            for (int i = 0; i < 8; ++i) ctx[i] *= scale;
#pragma unroll
            for (int u = 0; u < 2; ++u) {
                u32x4 pw; pw.x = pk2(d[2 * u][0], d[2 * u][1]); pw.y = pk2(d[2 * u][2], d[2 * u][3]); pw.z = pk2(d[2 * u + 1][0], d[2 * u + 1][1]); pw.w = pk2(d[2 * u + 1][2], d[2 * u + 1][3]);
                const bf16x8 pf = __builtin_bit_cast(bf16x8, pw);
#pragma unroll
                for (int mt = 0; mt < 8; ++mt) { const LAS unsigned char* rb = Tl + gq * 1024 + hd * 8;
                    const u32x2 lo = *(const LAS u32x2*)(rb + (8 * u) * 1024 + 16 * mt * 8);
                    const u32x2 hi = *(const LAS u32x2*)(rb + (8 * u + 4) * 1024 + 16 * mt * 8);
                    u32x4 aw; aw.x = lo.x; aw.y = lo.y; aw.z = hi.x; aw.w = hi.y;
                    ctx[mt] = MFMA16(__builtin_bit_cast(bf16x8, aw), pf, ctx[mt]); }
            }
        }
        lsum += __shfl_xor(lsum, 16); lsum += __shfl_xor(lsum, 32);
        const float inv = 1.0f / lsum;
        if (hd < 8) {
#pragma unroll
            for (int mt = 0; mt < 8; ++mt) { u32x2 w; w.x = pk2(ctx[mt][0] * inv, ctx[mt][1] * inv); w.y = pk2(ctx[mt][2] * inv, ctx[mt][3] * inv);
                *(u32x2*)(CTXo + (size_t)m * 1024 + hd * 128 + 16 * mt + 4 * gq) = w; }
        }
    }
}
__device__ __forceinline__ void ph_mix_finish(Frame& F, int e) {
    PHASE_PIN(F);
    const int lane = F.lane; unsigned char* ws = F.ws;
    bf16_t* YC = (bf16_t*)(ws + WS_YCAT);
    const float* ln_g = F.ka->in[17] + e * 512; const float* ln_b = F.ka->in[18] + e * 512;
    const float* Yr = (const float*)(ws + WS_Y); const float* GATE = (const float*)(ws + WS_GATE); const float* BON = (const float*)(ws + SM_BONUS); const float* SIN = (const float*)(ws + WS_SIN);
#if !CHUNKED
    for (int m = F.gw; m < NT; m += F.ngw) {
        const int t = m & (TT - 1), b = m >> 13;
#pragma unroll 1
        for (int hh = 0; hh < 8; ++hh) {
            const int ch = hh * 64 + lane; const float y = Yr[(size_t)m * 512 + ch];
            const float mean = wave_sum(y) * (1.f / 64.f); const float yc = y - mean; const float var = wave_sum(yc * yc) * (1.f / 64.f);
            const float v1 = SIN[((size_t)(b * 8 + hh) * TT + t) * 384 + 320 + lane];
            const float o = (yc * rsqrtf(var + GN_EPS) * ln_g[ch] + ln_b[ch] + BON[m * 8 + hh] * v1) * GATE[(size_t)m * 512 + ch];
            YC[(size_t)m * 1024 + ch] = (bf16_t)f2bf(o);
        }
    }
#endif
    { const bf16_t* CTX = (const bf16_t*)(ws + WS_XB); const bf16_t* WvT = (const bf16_t*)(ws + W_WVT) + (size_t)e * 512 * 128;
      for (int tI = F.gw; tI < (NT / 64) * 8; tI += F.ngw) {
          const int hh = tI & 7, mt = tI >> 3;
          EpiStoreBf16 E{YC + 512 + hh * 64, 1024, 0, 32};
          sg_tile(CTX + hh * 128, 1024, WvT + (size_t)(hh * 64) * 128, WvT + (size_t)(hh * 64 + 32) * 128, 128, 128, mt * 64, E, F.lane);
      } }
}

__device__ __forceinline__ void ph_stickbreak(Frame& F) {
    PHASE_PIN(F);
    const int lane = F.lane, r = lane & 31, hf = lane >> 5; unsigned char* ws = F.ws;
    const bf16_t* Q = (const bf16_t*)(ws + WS_PROJ); const bf16_t* Kb = Q + (size_t)NT * 1024; const bf16_t* Vb = Kb + (size_t)NT * 1024;
    bf16_t* YC = (bf16_t*)(ws + WS_YCAT);
    for (int it = F.gw; it < NB * 16 * 256; it += F.ngw) {
        const int qt = it & 255, hh = (it >> 8) & 15, b = it >> 12;
        const int mq = b * TT + qt * 32 + r;
        bf16x8 qf[4];
#pragma unroll
        for (int ks = 0; ks < 4; ++ks) qf[ks] = *(const bf16x8*)(Q + (size_t)mq * 1024 + hh * 64 + ks * 16 + 8 * hf);
        f32x16 o0, o1;
#pragma unroll
        for (int i = 0; i < 16; ++i) { o0[i] = 0.f; o1[i] = 0.f; }
        float P = 1.0f;
        for (int kt = qt; kt >= 0; --kt) {
            const bf16_t* kp = Kb + (size_t)(b * TT + kt * 32 + r) * 1024 + hh * 64 + 8 * hf;
            const bf16x8 kf0 = *(const bf16x8*)(kp), kf1 = *(const bf16x8*)(kp + 16), kf2 = *(const bf16x8*)(kp + 32), kf3 = *(const bf16x8*)(kp + 48);
            const bf16_t* vp = Vb + (size_t)(b * TT + kt * 32 + 4 * hf) * 1024 + hh * 64 + r;
            bf16x8 vf[2][2];
#pragma unroll
            for (int s2 = 0; s2 < 2; ++s2)
#pragma unroll
                for (int j = 0; j < 8; ++j) { const size_t ko = (size_t)(16 * s2 + 8 * (j >> 2) + (j & 3)) * 1024; vf[0][s2][j] = (short)vp[ko]; vf[1][s2][j] = (short)vp[ko + 32]; }
            f32x16 acc;
#pragma unroll
            for (int i = 0; i < 16; ++i) acc[i] = 0.f;
            acc = MFMA32(kf0, qf[0], acc); acc = MFMA32(kf1, qf[1], acc); acc = MFMA32(kf2, qf[2], acc); acc = MFMA32(kf3, qf[3], acc);
            float kp_[16], be[16];
            const bool diag = (kt == qt);
#pragma unroll
            for (int q = 0; q < 16; ++q) {
                const int key = 8 * (q >> 2) + 4 * hf + (q & 3);
                const float e = __builtin_amdgcn_exp2f(acc[q]); float keep = __builtin_amdgcn_rcpf(1.0f + e);
                if (diag && key >= r) keep = 1.0f;
                kp_[q] = keep; be[q] = 1.0f - keep;
            }
            float ls[16], tot[4], oth[4];
#pragma unroll
            for (int g = 0; g < 4; ++g) { ls[4 * g + 3] = 1.0f; ls[4 * g + 2] = kp_[4 * g + 3]; ls[4 * g + 1] = ls[4 * g + 2] * kp_[4 * g + 2]; ls[4 * g] = ls[4 * g + 1] * kp_[4 * g + 1]; tot[g] = ls[4 * g] * kp_[4 * g]; }
#pragma unroll
            for (int g = 0; g < 4; ++g) oth[g] = __shfl_xor(tot[g], 32);
            const float G0 = tot[0] * oth[0], G1 = tot[1] * oth[1], G2 = tot[2] * oth[2], G3 = tot[3] * oth[3];
            float E[4]; E[3] = 1.0f; E[2] = G3; E[1] = G3 * G2; E[0] = E[1] * G1;
            float w[16];
#pragma unroll
            for (int g = 0; g < 4; ++g) { const float mg = E[g] * (hf == 0 ? oth[g] : 1.0f) * P;
#pragma unroll
                for (int j = 0; j < 4; ++j) w[4 * g + j] = be[4 * g + j] * ls[4 * g + j] * mg; }
            P *= E[0] * G0;
            u32x4 w0, w1;
            w0.x = pk2(w[0], w[1]); w0.y = pk2(w[2], w[3]); w0.z = pk2(w[4], w[5]); w0.w = pk2(w[6], w[7]);
            w1.x = pk2(w[8], w[9]); w1.y = pk2(w[10], w[11]); w1.z = pk2(w[12], w[13]); w1.w = pk2(w[14], w[15]);
            const bf16x8 wf0 = __builtin_bit_cast(bf16x8, w0), wf1 = __builtin_bit_cast(bf16x8, w1);
            o0 = MFMA32(vf[0][0], wf0, o0); o0 = MFMA32(vf[0][1], wf1, o0);
            o1 = MFMA32(vf[1][0], wf0, o1); o1 = MFMA32(vf[1][1], wf1, o1);
            if (__ballot(P > 1e-30f) == 0ull) break;
        }
        bf16_t* op = YC + (size_t)mq * 1024 + hh * 64 + 4 * hf;
#pragma unroll
        for (int g = 0; g < 4; ++g) {
            u32x2 a; a.x = pk2(o0[4 * g], o0[4 * g + 1]); a.y = pk2(o0[4 * g + 2], o0[4 * g + 3]); *(u32x2*)(op + 8 * g) = a;
            u32x2 c; c.x = pk2(o1[4 * g], o1[4 * g + 1]); c.y = pk2(o1[4 * g + 2], o1[4 * g + 3]); *(u32x2*)(op + 32 + 8 * g) = c;
        }
    }
}

__device__ __forceinline__ void ph_moe_route(Frame& F, const Args& A, int l, bool claim) {
    PHASE_PIN(F);
    const int lane = F.lane; unsigned char* ws = F.ws;
    const float* X = (const float*)(ws + WS_X); bf16_t* XB = (bf16_t*)(ws + WS_XB);
    const float* g = F.ka->in[29] + l * DM; const float* Wg = F.ka->in[30] + (size_t)l * DM * 4; const float* We = F.ka->in[31] + (size_t)l * 4 * DM * 8;
    int* EIDX = (int*)(ws + SM_EIDX); float* GATEV = (float*)(ws + SM_GATE); int* SLOT = (int*)(ws + SM_SLOT);
    unsigned* cnt = (unsigned*)(ws + WS_CTL) + CW_CNT + 64 * l;
    for (int m = F.gw; m < NT; m += F.ngw) {
        const f32x4* xr = (const f32x4*)(X + (size_t)m * DM) + lane; f32x4 v[4]; float s = 0.f;
#pragma unroll
        for (int j = 0; j < 4; ++j) { v[j] = xr[64 * j]; s += (v[j].x * v[j].x + v[j].y * v[j].y) + (v[j].z * v[j].z + v[j].w * v[j].w); }
        const float rstd = rsqrtf(wave_sum(s) * (1.f / DM) + RMS_EPS);
        u32x2* o8 = (u32x2*)(XB + (size_t)m * DM) + lane;
#pragma unroll
        for (int j = 0; j < 4; ++j) { u32x2 w; w.x = pk2(v[j].x * rstd, v[j].y * rstd); w.y = pk2(v[j].z * rstd, v[j].w * rstd); o8[64 * j] = w; }
#pragma unroll
        for (int j = 0; j < 4; ++j) { const f32x4 gg = *((const f32x4*)g + lane + 64 * j); v[j] = v[j] * gg * rstd; }
        float gl[4] = {0.f, 0.f, 0.f, 0.f};
#pragma unroll
        for (int j = 0; j < 4; ++j)
#pragma unroll
            for (int i = 0; i < 4; ++i) { const int k = 4 * (lane + 64 * j) + i; const f32x4 w = *(const f32x4*)(Wg + (size_t)k * 4); const float xv = v[j][i];
                gl[0] += xv * w.x; gl[1] += xv * w.y; gl[2] += xv * w.z; gl[3] += xv * w.w; }
#pragma unroll
        for (int q = 0; q < 4; ++q) gl[q] = wave_sum(gl[q]);
        int gs = 0; float gm = gl[0];
#pragma unroll
        for (int q = 1; q < 4; ++q) if (gl[q] > gm) { gm = gl[q]; gs = q; }
        float gden = 0.f;
#pragma unroll
        for (int q = 0; q < 4; ++q) gden += __expf(gl[q] - gm);
        const float g_gate = 1.0f / gden;
        const float* Wes = We + (size_t)gs * DM * 8;
        float el[8];
#pragma unroll
        for (int q = 0; q < 8; ++q) el[q] = 0.f;
#pragma unroll
        for (int j = 0; j < 4; ++j)
#pragma unroll
            for (int i = 0; i < 4; ++i) { const int k = 4 * (lane + 64 * j) + i; const f32x4 w0 = *(const f32x4*)(Wes + (size_t)k * 8), w1 = *(const f32x4*)(Wes + (size_t)k * 8 + 4); const float xv = v[j][i];
                el[0] += xv * w0.x; el[1] += xv * w0.y; el[2] += xv * w0.z; el[3] += xv * w0.w; el[4] += xv * w1.x; el[5] += xv * w1.y; el[6] += xv * w1.z; el[7] += xv * w1.w; }
#pragma unroll
        for (int q = 0; q < 8; ++q) el[q] = wave_sum(el[q]);
        int i1 = 0; float m1 = el[0];
#pragma unroll
        for (int q = 1; q < 8; ++q) if (el[q] > m1) { m1 = el[q]; i1 = q; }
        int i2 = -1; float m2 = -INFINITY;
#pragma unroll
        for (int q = 0; q < 8; ++q) if (q != i1 && el[q] > m2) { m2 = el[q]; i2 = q; }
        const float e2 = __expf(m2 - m1); const float ga = g_gate / (1.0f + e2), gb = g_gate * e2 / (1.0f + e2);
        if (lane == 0 && claim) {
            const int ea = gs * 8 + i1, eb = gs * 8 + i2;
            const unsigned sa = atomicAdd(&cnt[ea], 1u), sb = atomicAdd(&cnt[eb], 1u);
            EIDX[2 * m] = ea; EIDX[2 * m + 1] = eb; GATEV[2 * m] = ga; GATEV[2 * m + 1] = gb; SLOT[2 * m] = (int)sa; SLOT[2 * m + 1] = (int)sb;
        }
    }
}
__device__ __forceinline__ int moe_offsets(const unsigned* cnt, int lane, int* total, int* mycnt_pad) {
    const unsigned c = lane < 32 ? __hip_atomic_load(cnt + (lane & 31), __ATOMIC_RELAXED, __HIP_MEMORY_SCOPE_AGENT) : 0u; const int p = (int)((c + 255u) & ~255u);
    int x = p;
#pragma unroll
    for (int o = 1; o < 64; o <<= 1) { const int y = __shfl_up(x, o); if (lane >= o) x += y; }
    *total = __shfl(x, 63); *mycnt_pad = p;
    return x - p;
}
__device__ __forceinline__ void ph_moe_gather(Frame& F, int l) {
    PHASE_PIN(F);
    const int lane = F.lane; unsigned char* ws = F.ws;
    const unsigned* cnt = (const unsigned*)(ws + WS_CTL) + CW_CNT + 64 * l; int total, pad; const int off = moe_offsets(cnt, lane, &total, &pad);
    const int* EIDX = (const int*)(ws + SM_EIDX); const int* SLOT = (const int*)(ws + SM_SLOT);
    const bf16_t* XB = (const bf16_t*)(ws + WS_XB); bf16_t* AM = (bf16_t*)(ws + WS_AMOE);
    for (int a = F.gw; a < NT * 2; a += F.ngw) {
        const int m = a >> 1, e = EIDX[a], row = __shfl(off, e) + SLOT[a];
        const u32x4* src = (const u32x4*)(XB + (size_t)m * DM); u32x4* dst = (u32x4*)(AM + (size_t)row * DM);
        dst[lane] = src[lane]; dst[lane + 64] = src[lane + 64];
    }
}
__device__ __forceinline__ int moe_build_tab(Frame& F, int l) {
    LAS int* tab = (LAS int*)(F.lds + LDS_MISC + 256); LAS int* ends = (LAS int*)(F.lds + LDS_MISC + 1024);
    const unsigned* cnt = (const unsigned*)(F.ws + WS_CTL) + CW_CNT + 64 * l; int total, pad; const int off = moe_offsets(cnt, F.lane, &total, &pad);
    __syncthreads();
    if (F.tid < 32) ends[F.tid] = off + pad;
    __syncthreads();
    for (int rt = F.tid; rt < total / 256; rt += NTHR) { int e = 0; for (int q = 0; q < 32; ++q) e += (ends[q] <= rt * 256) ? 1 : 0; tab[rt] = e; }
    __syncthreads();
    return total;
}
__device__ __forceinline__ void ph_moe_gemm1(Frame& F, int l) {
    PHASE_PIN(F);
    const int total = moe_build_tab(F, l);
    pg8::Gemm g{(const pg8::bf16_t*)(F.ws + WS_AMOE), (const pg8::bf16_t*)(F.ws + WS_W13T), total, 32 * 1024, DM};
    pg8::MoeOrder S{(total / 256) * 4, (int)gridDim.x, (int)blockIdx.x, (const LAS int*)(F.lds + LDS_MISC + 256)};
    pg8::EpiGate E{(pg8::bf16_t*)(F.ws + WS_H)};
    pg8::gemm_phase<pg8::EpiGate, pg8::MoeOrder>(F.lds, g, S, E, nullptr, F.wave);
}
__device__ __forceinline__ void ph_moe_gemm2(Frame& F, int l) {
    PHASE_PIN(F);
    const int total = moe_build_tab(F, l);
    pg8::Gemm g{(const pg8::bf16_t*)(F.ws + WS_H), (const pg8::bf16_t*)(F.ws + WS_W2T), total, 32 * 1024, 512};
    pg8::MoeOrder S{(total / 256) * 4, (int)gridDim.x, (int)blockIdx.x, (const LAS int*)(F.lds + LDS_MISC + 256)};
    pg8::EpiMoeDown E{(pg8::bf16_t*)(F.ws + WS_YM)};
    pg8::gemm_phase<pg8::EpiMoeDown, pg8::MoeOrder>(F.lds, g, S, E, nullptr, F.wave);
}
__device__ __forceinline__ void ph_moe_combine(Frame& F, const Args& A, int l, bool wr) {
    PHASE_PIN(F);
    const int lane = F.lane; unsigned char* ws = F.ws;
    const unsigned* cnt = (const unsigned*)(ws + WS_CTL) + CW_CNT + 64 * l; int total, pad; const int off = moe_offsets(cnt, lane, &total, &pad);
    const int* EIDX = (const int*)(ws + SM_EIDX); const int* SLOT = (const int*)(ws + SM_SLOT); const float* GATEV = (const float*)(ws + SM_GATE);
    float* X = (float*)(ws + WS_X); bf16_t* XB = (bf16_t*)(ws + WS_XB); const bf16_t* YM = (const bf16_t*)(ws + WS_YM);
    const float* fg = F.ka->in[35];
    for (int m = F.gw; m < NT; m += F.ngw) {
        const int ea = EIDX[2 * m], eb = EIDX[2 * m + 1]; const float ga = GATEV[2 * m], gb = GATEV[2 * m + 1];
        const int ra = __shfl(off, ea) + SLOT[2 * m], rb = __shfl(off, eb) + SLOT[2 * m + 1];
        f32x4* xr = (f32x4*)(X + (size_t)m * DM) + lane; const u32x2* ya = (const u32x2*)(YM + (size_t)ra * DM) + lane; const u32x2* yb = (const u32x2*)(YM + (size_t)rb * DM) + lane;
        f32x4 v[4]; float s = 0.f;
#pragma unroll
        for (int j = 0; j < 4; ++j) { v[j] = xr[64 * j]; const u32x2 a = ya[64 * j], bq = yb[64 * j];
            v[j].x += ga * __uint_as_float(a.x << 16) + gb * __uint_as_float(bq.x << 16); v[j].y += ga * __uint_as_float(a.x & 0xffff0000u) + gb * __uint_as_float(bq.x & 0xffff0000u);
            v[j].z += ga * __uint_as_float(a.y << 16) + gb * __uint_as_float(bq.y << 16); v[j].w += ga * __uint_as_float(a.y & 0xffff0000u) + gb * __uint_as_float(bq.y & 0xffff0000u);
            s += (v[j].x * v[j].x + v[j].y * v[j].y) + (v[j].z * v[j].z + v[j].w * v[j].w); }
        const float rstd = rsqrtf(wave_sum(s) * (1.f / DM) + RMS_EPS);
        if (l < 3) {
            u32x2* o8 = (u32x2*)(XB + (size_t)m * DM) + lane;
#pragma unroll
            for (int j = 0; j < 4; ++j) { if (wr) xr[64 * j] = v[j]; u32x2 w; w.x = pk2(v[j].x * rstd, v[j].y * rstd); w.y = pk2(v[j].z * rstd, v[j].w * rstd); o8[64 * j] = w; }
        } else {
            f32x4* orow = (f32x4*)(F.out + (size_t)m * DM) + lane;
#pragma unroll
            for (int j = 0; j < 4; ++j) { const f32x4 gg = *((const f32x4*)fg + lane + 64 * j); orow[64 * j] = v[j] * gg * rstd; }
        }
    }
}

__global__ void __launch_bounds__(NTHR, 2) fwd_kernel(Args args) {
    extern __shared__ __attribute__((aligned(16))) unsigned char lds_raw[];
    Frame F; F.lds = (LAS unsigned char*)lds_raw; F.tid = threadIdx.x; F.lane = F.tid & 63; F.wave = __builtin_amdgcn_readfirstlane(F.tid >> 6);
    F.gw = blockIdx.x * NWAVES + F.wave; F.ngw = gridDim.x * NWAVES; F.out = args.out; F.ws = args.ws; F.ka = (const __attribute__((address_space(4))) Args*)__builtin_amdgcn_kernarg_segment_ptr();
    volatile LAS unsigned* MISC = (volatile LAS unsigned*)(F.lds + LDS_MISC);
    if (F.tid < 64) MISC[F.tid] = 0u;
    __syncthreads();
    const int lo = args.ph_lo, hi = args.ph_hi;
    XcdBarrier bar; bar.bar = (unsigned*)(F.ws + WS_CTL) + CW_BAR; bar.x = 0; bar.st = MISC;
    if (hi - lo > 1) bar = xcd_barrier_post((unsigned*)(F.ws + WS_CTL) + CW_BAR, MISC, F.tid == 0);
#define IN(k) (lo <= (k) && (k) < hi)
#define DUP(k) for (int _rep = 0; _rep < ((DUP_PHASE == (k)) ? 2 : 1); ++_rep)
#define SEAM(k) do { if ((k) + 1 < hi) { PHASE_PIN(F); xcd_barrier(bar, F.tid == 0); if (DUP_PHASE == 99) xcd_barrier(bar, F.tid == 0); } } while (0)
    unsigned char* ws = F.ws;
    if (IN(0)) { DUP(0) ph_prologue(F, args); SEAM(0); }
    for (int l = 0; l < 4; ++l) {
        const int pb = 1 + 16 * l, e = l >> 1;
        const float* xsrc = (l == 0) ? args.in[0] : (const float*)(ws + WS_X);
        if ((l & 1) == 0) {
            if (IN(pb + 0)) { PHASE_PIN(F);
                pg8::Gemm g{(const pg8::bf16_t*)(F.ws + WS_XB), (const pg8::bf16_t*)(F.ws + W_WIN) + (size_t)e * NCOL * DM, NT, NCOL, DM}; pg8::StaticOrder S; S.init(NT, NCOL, (int)gridDim.x, (int)blockIdx.x);
                pg8::EpiBf16S E{(pg8::bf16_t*)(F.ws + WS_PROJ), NCOL, 0, 0};
                DUP(11) pg8::gemm_phase<pg8::EpiBf16S, pg8::StaticOrder>(F.lds, g, S, E, nullptr, F.wave);
                SEAM(pb + 0); }
            if (IN(pb + 1)) {
#ifndef NO_PREP
 ph_prep(F, args, e, 7); if (DUP_PHASE >= 20 && DUP_PHASE < 28) ph_prep(F, args, e, DUP_PHASE - 20);
#endif
 SEAM(pb + 1); }
            if (IN(pb + 2)) { ph_scan_s1(F); ph_idx_score(F); SEAM(pb + 2); }
            if (IN(pb + 3)) { ph_scan_s2(F); ph_idx_select(F); SEAM(pb + 3); }
            if (IN(pb + 4)) { ph_scan_s3(F, e); ph_sparse(F, e); SEAM(pb + 4); }
            if (IN(pb + 6)) { DUP(13) ph_mix_finish(F, e); SEAM(pb + 6); }
        } else {
            if (IN(pb + 0)) { PHASE_PIN(F);
                pg8::Gemm g{(const pg8::bf16_t*)(F.ws + WS_XB), (const pg8::bf16_t*)(F.ws + W_WQKV) + (size_t)e * 3072 * DM, NT, 3072, DM}; pg8::StaticOrder S; S.init(NT, 3072, (int)gridDim.x, (int)blockIdx.x);
                pg8::EpiBf16S E{(pg8::bf16_t*)(F.ws + WS_PROJ), 1024, 1024, (size_t)NT * 1024};
                DUP(12) pg8::gemm_phase<pg8::EpiBf16S, pg8::StaticOrder>(F.lds, g, S, E, nullptr, F.wave);
                SEAM(pb + 0); }
            if (IN(pb + 1)) {
#ifndef NO_SB
 DUP(6) ph_stickbreak(F);
#endif
 SEAM(pb + 1); }
        }
        if (IN(pb + 7)) { PHASE_PIN(F);
            pg8::Gemm g{(const pg8::bf16_t*)(F.ws + WS_YCAT), (const pg8::bf16_t*)(F.ws + ((l & 1) ? W_WOUTO : W_WOUTE)) + (size_t)e * DM * DM, NT, DM, DM}; pg8::StaticOrder S; S.init(NT, DM, (int)gridDim.x, (int)blockIdx.x);
            pg8::EpiResid E{xsrc, (float*)(F.ws + WS_X)};
            pg8::gemm_phase<pg8::EpiResid, pg8::StaticOrder>(F.lds, g, S, E, nullptr, F.wave);
            if (DUP_PHASE == 17 && l == 0) pg8::gemm_phase<pg8::EpiResid, pg8::StaticOrder>(F.lds, g, S, E, nullptr, F.wave);
            SEAM(pb + 7); }
        if (IN(pb + 8)) {
#ifndef NO_ROUTE
 ph_moe_route(F, args, l, true); if (DUP_PHASE == 16) ph_moe_route(F, args, l, false); DUP(7) moe_weight_prep(F, args, l);
#endif
 SEAM(pb + 8); }
        if (IN(pb + 9)) { DUP(8) ph_moe_gather(F, l); SEAM(pb + 9); }
        if (IN(pb + 10)) { DUP(9) ph_moe_gemm1(F, l); SEAM(pb + 10); }
        if (IN(pb + 11)) { DUP(10) ph_moe_gemm2(F, l); SEAM(pb + 11); }
        if (IN(pb + 12)) { if (DUP_PHASE == 18) ph_moe_combine(F, args, l, false); ph_moe_combine(F, args, l, true); SEAM(pb + 12); }
    }
#undef IN
#undef SEAM
}

extern "C" void kernel_launch(void* const* d_in, const int* in_sizes, int n_in, void* d_out, int out_size, void* d_ws, size_t ws_size, hipStream_t stream) {
    static int grid = 0;
    if (grid == 0) {
        if (n_in != 36 || out_size != NT * DM || ws_size < WS_END) { fprintf(stderr, "kernel_launch: unexpected problem (n_in %d out %d ws %zu)\n", n_in, out_size, ws_size); grid = -1; return; }
        int dev = 0, cus = 0, per_cu = 0;
        if (hipGetDevice(&dev) != hipSuccess || hipDeviceGetAttribute(&cus, hipDeviceAttributeMultiprocessorCount, dev) != hipSuccess) { grid = -1; return; }
        if (hipFuncSetAttribute((const void*)fwd_kernel, hipFuncAttributeMaxDynamicSharedMemorySize, LDS_BYTES) != hipSuccess) { grid = -1; return; }
        if (hipOccupancyMaxActiveBlocksPerMultiprocessor(&per_cu, (const void*)fwd_kernel, NTHR, LDS_BYTES) != hipSuccess || per_cu < 1) { fprintf(stderr, "kernel_launch: occupancy query says %d\n", per_cu); }
        (void)hipGetLastError();
        grid = cus;
    }
    if (grid < 0) return;
    (void)hipMemsetAsync((char*)d_ws + WS_CTL, 0, CTL_ZERO_BYTES, stream);
    Args a{};
    for (int i = 0; i < 36; ++i) a.in[i] = (const float*)d_in[i];
    a.out = (float*)d_out; a.ws = (unsigned char*)d_ws;
#if ONE_LAUNCH
    a.ph_lo = 0; a.ph_hi = 65;
    hipLaunchKernelGGL(fwd_kernel, dim3(grid), dim3(NTHR), LDS_BYTES, stream, a);
    if (DUP_PHASE >= 100 && DUP_PHASE < 200) { a.ph_lo = DUP_PHASE - 100; a.ph_hi = a.ph_lo + 1; a.out = (float*)((char*)d_ws + WS_SIN); hipLaunchKernelGGL(fwd_kernel, dim3(grid), dim3(NTHR), LDS_BYTES, stream, a); }
#else
    for (int p = 0; p < 65; ++p) {
        const int l = (p - 1) >> 4, k = (p - 1) & 15;
        if (p > 0) { if (k > 12) continue; if ((l & 1) && k >= 2 && k <= 6) continue; if (!(l & 1) && k == 5) continue; }
        a.ph_lo = p; a.ph_hi = p + 1;
        hipLaunchKernelGGL(fwd_kernel, dim3(grid), dim3(NTHR), LDS_BYTES, stream, a);
    }
#endif
}
```

```cpp
#include <hip/hip_runtime.h>
#include <cstdio>
#include <cstdint>

#ifndef DUP_PHASE
#define DUP_PHASE -1
#endif
#ifndef CHUNKED
#define CHUNKED 1
#endif
#ifndef ONE_LAUNCH
#define ONE_LAUNCH 1
#endif

#define GAS __attribute__((address_space(1)))
#define LAS __attribute__((address_space(3)))
typedef unsigned short bf16_t;
typedef short bf16x8 __attribute__((ext_vector_type(8)));
typedef float f32x4 __attribute__((ext_vector_type(4)));
typedef float f32x2 __attribute__((ext_vector_type(2)));
typedef float f32x16 __attribute__((ext_vector_type(16)));
typedef unsigned u32x4 __attribute__((ext_vector_type(4)));
typedef unsigned u32x2 __attribute__((ext_vector_type(2)));

constexpr int NT = 16384, TT = 8192, DM = 1024, NB = 2;
constexpr int NCOL = 3584;
constexpr int C_R = 0, C_K = 512, C_V = 1024, C_QB = 1536, C_CKV = 2048, C_QI = 2176, C_KI = 2688, C_WI = 2752;
constexpr int C_PW = 2816, C_QW = 2880, C_PA = 2944, C_QA = 3008, C_PG = 3072, C_QG = 3200, C_PV = 3328, C_QV = 3360;
constexpr int NWAVES = 8, NTHR = 512;
constexpr float RMS_EPS = 1e-6f, GN_EPS = 64e-5f;
constexpr float LOG2E = 1.4426950408889634f;

constexpr size_t MiB = 1u << 20;
constexpr size_t WS_CTL = 0, CTL_ZERO_BYTES = 1 * MiB;
constexpr size_t WS_SMALL = 1 * MiB;
constexpr size_t SM_EIDX = WS_SMALL, SM_GATE = WS_SMALL + 128 * 1024, SM_SLOT = WS_SMALL + 256 * 1024, SM_BONUS = WS_SMALL + 512 * 1024, SM_SGN = WS_SMALL + 1024 * 1024, SM_QLIN = WS_SMALL + 2 * MiB;
constexpr size_t WS_W = 5 * MiB;
constexpr size_t W_WIN = WS_W, W_WOUTE = WS_W + 14 * MiB, W_WQKV = WS_W + 18 * MiB, W_WOUTO = WS_W + 30 * MiB, W_WKB = WS_W + 34 * MiB, W_WVT = W_WKB + 256 * 1024, W_L2 = W_WKB + 512 * 1024;
constexpr size_t WS_X = 45 * MiB, WS_XB = 109 * MiB, WS_PROJ = 141 * MiB, WS_SIN = 253 * MiB, WS_VF = 445 * MiB, WS_Y = 477 * MiB, WS_GATE = 509 * MiB, WS_YCAT = 541 * MiB;
constexpr size_t WS_CN = 573 * MiB, WS_KI = 577 * MiB, WS_QI = 579 * MiB, WS_QA = 595 * MiB, WS_SEL = 627 * MiB;
constexpr size_t WS_BIG = 645 * MiB;
constexpr size_t WS_SCORE = WS_BIG;
constexpr size_t WS_W13T = WS_BIG, WS_W2T = WS_BIG + 64 * MiB, WS_AMOE = WS_BIG + 96 * MiB, WS_H = WS_BIG + 176 * MiB, WS_YM = WS_BIG + 216 * MiB;
constexpr size_t WS_S1TMP = 905 * MiB;
constexpr size_t WS_END = 1017 * MiB;
constexpr size_t SCORE_PER_BATCH = (size_t)16384 * 2080;
static_assert(WS_SCORE + 2 * SCORE_PER_BATCH * 4 <= WS_END, "score map");
static_assert(WS_YM + (size_t)40960 * 1024 * 2 <= WS_END, "moe map");
constexpr int CW_BAR = 4096;
constexpr int CW_CNT = 16384;

constexpr int LDS_BYTES = 147456;
constexpr int LDS_WSCR = 16384;
constexpr int LDS_MISC = 131072;

__device__ __forceinline__ float bf2f(bf16_t b) { return __uint_as_float(((unsigned)b) << 16); }
typedef __bf16 bf16v2_t __attribute__((ext_vector_type(2)));
__device__ __forceinline__ unsigned pk2(float lo, float hi) { const f32x2 v = {lo, hi}; const bf16v2_t b = __builtin_convertvector(v, bf16v2_t); return __builtin_bit_cast(unsigned, b); }
__device__ __forceinline__ unsigned f2bf(float f) { return pk2(f, f) & 0xffffu; }
__device__ __forceinline__ float wave_sum(float v) {
#pragma unroll
    for (int o = 1; o < 64; o <<= 1) v += __shfl_xor(v, o);
    return v;
}
__device__ __forceinline__ float wave_max(float v) {
#pragma unroll
    for (int o = 1; o < 64; o <<= 1) v = fmaxf(v, __shfl_xor(v, o));
    return v;
}
__device__ __forceinline__ float sigmoidf_(float x) { return 1.0f / (1.0f + __expf(-x)); }
#define LDS_WAIT() asm volatile("s_waitcnt lgkmcnt(0)" ::: "memory")

#define XB_TMO      128
#define XB_XCNT(j)  (256  + 64 * (j))
#define XB_XSUB(j)  (1280 + 64 * (j))
#define XB_XGEN(j)  (2304 + 64 * (j))
#define XB_TOP      3328
#define XB_TOPGEN   3392
#define XCD_BAR_WORDS 3456
#define XB_SPIN_CAP (1u << 18)
__device__ __forceinline__ unsigned xb_ld(unsigned* p)              { return __hip_atomic_load(p, __ATOMIC_RELAXED, __HIP_MEMORY_SCOPE_AGENT); }
__device__ __forceinline__ unsigned xb_add(unsigned* p, unsigned v) { return __hip_atomic_fetch_add(p, v, __ATOMIC_RELAXED, __HIP_MEMORY_SCOPE_AGENT); }
__device__ __forceinline__ unsigned xb_xcc_id() { return (unsigned)__builtin_amdgcn_s_getreg((3 << 11) | 20) & 0xFu; }
#define XB_SPIN(cond, bar) do { unsigned _sp = 0; while (cond) { __builtin_amdgcn_s_sleep(1); \
    if ((++_sp & 255u) == 0u) { if (xb_ld(&(bar)[XB_TMO])) break; if (_sp > XB_SPIN_CAP) { atomicAdd(&(bar)[XB_TMO], 1u); break; } } } } while (0)
struct XcdBarrier { unsigned* bar; unsigned x; volatile LAS unsigned* st; };
__device__ __forceinline__ XcdBarrier xcd_barrier_post(unsigned* bar, volatile LAS unsigned* st, bool t0) {
    XcdBarrier b; b.bar = bar; b.x = xb_xcc_id(); b.st = st;
    if (t0) (void)xb_add(&bar[XB_XCNT(b.x)], 1u);
    return b;
}
__device__ __forceinline__ void xcd_barrier_complete(unsigned* bar, unsigned x, unsigned& nloc, unsigned& nx) {
    const unsigned G = gridDim.x * gridDim.y * gridDim.z;
    unsigned sum, cnt, mine, sp = 0u;
    for (;;) {
        sum = 0u; cnt = 0u; mine = 0u;
#pragma unroll
        for (unsigned j = 0; j < 16; ++j) { const unsigned c = xb_ld(&bar[XB_XCNT(j)]); sum += c; cnt += (c > 0u) ? 1u : 0u; mine = (j == x) ? c : mine; }
        if (sum == G) break;
        __builtin_amdgcn_s_sleep(1);
        if ((++sp & 255u) == 0u) { if (xb_ld(&bar[XB_TMO])) break; if (sp > XB_SPIN_CAP) { atomicAdd(&bar[XB_TMO], 1u); break; } }
    }
    nloc = mine > 0u ? mine : 1u; nx = cnt > 0u ? cnt : 1u;
}
__device__ __forceinline__ void xcd_barrier(const XcdBarrier& b, bool t0) {
    asm volatile("s_waitcnt vmcnt(0)" ::: "memory");
    __syncthreads();
    if (t0) {
        unsigned* bar = b.bar;
        __builtin_amdgcn_s_waitcnt(0);
        unsigned nloc = b.st[0], nx = b.st[1];
        if (nloc == 0u) { xcd_barrier_complete(bar, b.x, nloc, nx); b.st[0] = nloc; b.st[1] = nx; }
        const unsigned old = xb_add(&bar[XB_XSUB(b.x)], 1u);
        const unsigned gen = old / nloc;
        if (old + 1u == (gen + 1u) * nloc) {
            __builtin_amdgcn_fence(__ATOMIC_RELEASE, "agent");
            asm volatile("s_waitcnt vmcnt(0)" ::: "memory");
            const unsigned og = xb_add(&bar[XB_TOP], 1u);
            const unsigned tg = og / nx;
            if (og + 1u == (tg + 1u) * nx) xb_add(&bar[XB_TOPGEN], 1u);
            else XB_SPIN(xb_ld(&bar[XB_TOPGEN]) == tg, bar);
            __builtin_amdgcn_fence(__ATOMIC_ACQUIRE, "agent");
            xb_add(&bar[XB_XGEN(b.x)], 1u);
            asm volatile("s_waitcnt vmcnt(0)" ::: "memory");
        } else {
            XB_SPIN(xb_ld(&bar[XB_XGEN(b.x)]) == gen, bar);
            __builtin_amdgcn_fence(__ATOMIC_ACQUIRE, "agent");
            asm volatile("s_waitcnt vmcnt(0)" ::: "memory");
        }
    }
    __syncthreads();
}

struct Args { const float* in[36]; float* out; unsigned char* ws; int ph_lo, ph_hi, flags, pad; };
struct Frame {
    LAS unsigned char* lds; int tid, lane, wave, gw, ngw;
    float* out; unsigned char* ws;
    const __attribute__((address_space(4))) Args* ka;
};

#define PHASE_PIN(F) do { unsigned long long _z64; int _z32; asm volatile("s_mov_b64 %0, 0\n\ts_mov_b32 %1, 0" : "=s"(_z64), "=s"(_z32)); asm volatile("" : "+v"((F).lane)); \
    (F).ws += _z64; (F).out += _z64; (F).ka = (const __attribute__((address_space(4))) Args*)((const __attribute__((address_space(4))) char*)(F).ka + _z64); \
    (F).gw += _z32; (F).ngw += _z32; (F).wave += _z32; (F).tid = (F).wave * 64 + (F).lane; } while (0)
struct TrJob { const float* W; int K, ldw, col_off, ncols; bf16_t* WT; int ldt, row_off; const float* g; const float* mu; int mode; float cs; };
__device__ __forceinline__ void tr_item(const TrJob& J, int item, LAS float* scr, int lane) {
    const int nblk = (J.ncols + 31) / 32, kb = item / nblk, nb = item % nblk, k0 = 64 * kb, n0 = 32 * nb;
#pragma unroll 8
    for (int i = 0; i < 32; ++i) {
        const int kk = 2 * i + (lane >> 5), n = lane & 31, k = k0 + kk;
        float v = 0.f;
        if (k < J.K && n0 + n < J.ncols) {
            float s = J.cs;
            if (J.g) s *= J.g[k];
            if (J.mode == 1) s *= (1.0f - J.mu[k]); else if (J.mode == 2) s *= J.mu[k];
            v = J.W[(size_t)k * J.ldw + J.col_off + n0 + n] * s;
        }
        scr[kk * 33 + n] = v;
    }
    LDS_WAIT(); asm volatile("" ::: "memory");
    const int c = lane & 7;
#pragma unroll
    for (int j = 0; j < 4; ++j) {
        const int n = (lane >> 3) + 8 * j; const LAS float* s = scr + (8 * c) * 33 + n;
        u32x4 o; o.x = pk2(s[0 * 33], s[1 * 33]); o.y = pk2(s[2 * 33], s[3 * 33]); o.z = pk2(s[4 * 33], s[5 * 33]); o.w = pk2(s[6 * 33], s[7 * 33]);
        if (n0 + n < J.ncols && k0 + 8 * c < J.K) *(u32x4*)(J.WT + (size_t)(J.row_off + n0 + n) * J.ldt + k0 + 8 * c) = o;
    }
    LDS_WAIT(); asm volatile("" ::: "memory");
}
__device__ __forceinline__ void tr_job(Frame& F, const TrJob& J, int rot) {
    LAS float* scr = (LAS float*)(F.lds + F.wave * LDS_WSCR);
    const int nitems = ((J.K + 63) / 64) * ((J.ncols + 31) / 32);
    int start = F.gw - (rot % F.ngw); if (start < 0) start += F.ngw;
    for (int it = start; it < nitems; it += F.ngw) tr_item(J, it, scr, F.lane);
}
__device__ __forceinline__ void zero_rows(Frame& F, bf16_t* WT, int ld, int r0, int r1) {
    const size_t n16 = (size_t)(r1 - r0) * ld / 8; u32x4* p = (u32x4*)(WT + (size_t)r0 * ld);
    for (size_t i = (size_t)F.gw * 64 + F.lane; i < n16; i += (size_t)F.ngw * 64) p[i] = (u32x4){0u, 0u, 0u, 0u};
}
__device__ __forceinline__ void row_norm_to_bf16(const float* xrow, bf16_t* orow, int lane) {
    const f32x4* xr = (const f32x4*)xrow + lane; f32x4 v[4]; float s = 0.f;
#pragma unroll
    for (int j = 0; j < 4; ++j) { v[j] = xr[64 * j]; s += (v[j].x * v[j].x + v[j].y * v[j].y) + (v[j].z * v[j].z + v[j].w * v[j].w); }
    const float rstd = rsqrtf(wave_sum(s) * (1.f / DM) + RMS_EPS);
    u32x2* o8 = (u32x2*)orow + lane;
#pragma unroll
    for (int j = 0; j < 4; ++j) { u32x2 w; w.x = pk2(v[j].x * rstd, v[j].y * rstd); w.y = pk2(v[j].z * rstd, v[j].w * rstd); o8[64 * j] = w; }
}

__device__ __forceinline__ void ph_prologue(Frame& F, const Args& A) {
    PHASE_PIN(F);
    unsigned char* ws = F.ws; int rot = 0;
    for (int e = 0; e < 2; ++e) {
        bf16_t* WT = (bf16_t*)(ws + W_WIN) + (size_t)e * NCOL * DM;
        const float* g = F.ka->in[1] + e * DM; const float* mul = F.ka->in[5] + (size_t)e * 3 * DM;
        TrJob J{F.ka->in[2] + (size_t)e * DM * 2760, DM, 2760, 0, 2760, WT, DM, 0, g, nullptr, 0, 1.0f}; tr_job(F, J, rot); rot += 1392;
        zero_rows(F, WT, DM, 2760, C_PW);
        TrJob Jw1{F.ka->in[7] + (size_t)e * DM * 64, DM, 64, 0, 64, WT, DM, C_PW, g, mul, 1, 1.0f}; tr_job(F, Jw1, rot); rot += 32;
        TrJob Jw2{F.ka->in[7] + (size_t)e * DM * 64, DM, 64, 0, 64, WT, DM, C_QW, g, mul, 2, 1.0f}; tr_job(F, Jw2, rot); rot += 32;
        TrJob Ja1{F.ka->in[10] + (size_t)e * DM * 64, DM, 64, 0, 64, WT, DM, C_PA, g, mul + DM, 1, 1.0f}; tr_job(F, Ja1, rot); rot += 32;
        TrJob Ja2{F.ka->in[10] + (size_t)e * DM * 64, DM, 64, 0, 64, WT, DM, C_QA, g, mul + DM, 2, 1.0f}; tr_job(F, Ja2, rot); rot += 32;
        TrJob Jg1{F.ka->in[12] + (size_t)e * DM * 128, DM, 128, 0, 128, WT, DM, C_PG, g, mul + 2 * DM, 1, 1.0f}; tr_job(F, Jg1, rot); rot += 64;
        TrJob Jg2{F.ka->in[12] + (size_t)e * DM * 128, DM, 128, 0, 128, WT, DM, C_QG, g, mul + 2 * DM, 2, 1.0f}; tr_job(F, Jg2, rot); rot += 64;
        if (e == 1) {
            TrJob Jv1{F.ka->in[21], DM, 32, 0, 32, WT, DM, C_PV, g, F.ka->in[19], 1, 1.0f}; tr_job(F, Jv1, rot); rot += 16;
            TrJob Jv2{F.ka->in[21], DM, 32, 0, 32, WT, DM, C_QV, g, F.ka->in[19], 2, 1.0f}; tr_job(F, Jv2, rot); rot += 16;
            zero_rows(F, WT, DM, C_QV + 32, NCOL);
        } else zero_rows(F, WT, DM, C_PV, NCOL);
        TrJob Jo{F.ka->in[3] + (size_t)e * DM * DM, DM, DM, 0, DM, (bf16_t*)(ws + W_WOUTE) + (size_t)e * DM * DM, DM, 0, nullptr, nullptr, 0, 1.0f}; tr_job(F, Jo, rot); rot += 512;
        { bf16_t* L2W = (bf16_t*)(ws + W_L2) + (size_t)e * (288 * 512);
          TrJob Jl1{F.ka->in[8] + (size_t)e * 64 * 512, 64, 512, 0, 512, L2W, 64, 0, nullptr, nullptr, 0, 1.0f}; tr_job(F, Jl1, rot); rot += 16;
          TrJob Jl2{F.ka->in[11] + (size_t)e * 64 * 512, 64, 512, 0, 512, L2W + 64 * 512, 64, 0, nullptr, nullptr, 0, 1.0f}; tr_job(F, Jl2, rot); rot += 16;
          TrJob Jl3{F.ka->in[13] + (size_t)e * 128 * 512, 128, 512, 0, 512, L2W + 128 * 512, 128, 0, nullptr, nullptr, 0, 1.0f}; tr_job(F, Jl3, rot); rot += 32;
          if (e == 1) { TrJob Jl4{F.ka->in[22], 32, 512, 0, 512, L2W + 256 * 512, 32, 0, nullptr, nullptr, 0, 1.0f}; tr_job(F, Jl4, rot); rot += 16; } }
        { const float* Wkv = F.ka->in[24] + (size_t)e * 128 * 1024; bf16_t* WkB = (bf16_t*)(ws + W_WKB) + (size_t)e * 8 * 128 * 64;
          for (int i = F.gw * 64 + F.lane; i < 8 * 128 * 64; i += F.ngw * 64) { const int d = i & 63, r = (i >> 6) & 127, h = i >> 13; WkB[i] = (bf16_t)f2bf(Wkv[(size_t)r * 1024 + h * 64 + d]); } }
        TrJob Jv{F.ka->in[24] + (size_t)e * 128 * 1024, 128, 1024, 512, 512, (bf16_t*)(ws + W_WVT) + (size_t)e * 512 * 128, 128, 0, nullptr, nullptr, 0, 1.0f}; tr_job(F, Jv, rot); rot += 32;
    }
    for (int o = 0; o < 2; ++o) {
        const float* g = F.ka->in[26] + o * DM; bf16_t* WT = (bf16_t*)(ws + W_WQKV) + (size_t)o * 3072 * DM;
        TrJob Jq{F.ka->in[27] + (size_t)o * DM * 3072, DM, 3072, 0, 1024, WT, DM, 0, g, nullptr, 0, LOG2E * 0.125f}; tr_job(F, Jq, rot); rot += 512;
        TrJob Jk{F.ka->in[27] + (size_t)o * DM * 3072, DM, 3072, 1024, 2048, WT, DM, 1024, g, nullptr, 0, 1.0f}; tr_job(F, Jk, rot); rot += 1024;
        TrJob Jo{F.ka->in[28] + (size_t)o * DM * DM, DM, DM, 0, DM, (bf16_t*)(ws + W_WOUTO) + (size_t)o * DM * DM, DM, 0, nullptr, nullptr, 0, 1.0f}; tr_job(F, Jo, rot); rot += 512;
    }
    for (int m = F.gw; m < NT; m += F.ngw) row_norm_to_bf16(F.ka->in[0] + (size_t)m * DM, (bf16_t*)(ws + WS_XB) + (size_t)m * DM, F.lane);
}

struct MwJob { const float* src; const float* gk; bf16_t* dst; int ldw, ldt; };
__device__ __forceinline__ MwJob mw_job(int it, const float* w1, const float* w3, const float* w2, const float* g, bf16_t* W13T, bf16_t* W2T, int lane) {
    MwJob J;
    if (it < 16384) { const int job = it >> 6, item = it & 63, which = job & 1, j = (job >> 1) & 3, e = job >> 3, k0 = 64 * (item >> 2), n0 = 32 * (item & 3);
        J.src = (which ? w3 : w1) + (size_t)e * DM * 512 + (size_t)(k0 + (lane >> 3)) * 512 + 128 * j + n0 + 4 * (lane & 7); J.ldw = 512; J.gk = g + k0 + 8 * (lane & 7);
        J.dst = W13T + (size_t)(e * 1024 + 256 * j + 128 * which + n0 + (lane >> 3)) * DM + k0 + 8 * (lane & 7); J.ldt = DM; }
    else { const int it2 = it - 16384, e = it2 >> 8, item = it2 & 255, k0 = 64 * (item >> 5), n0 = 32 * (item & 31);
        J.src = w2 + (size_t)e * 512 * DM + (size_t)(k0 + (lane >> 3)) * DM + n0 + 4 * (lane & 7); J.ldw = DM; J.gk = nullptr;
        J.dst = W2T + (size_t)(e * 1024 + n0 + (lane >> 3)) * 512 + k0 + 8 * (lane & 7); J.ldt = 512; }
    return J;
}
__device__ __forceinline__ void mw_load(const MwJob& J, f32x4 (&v)[8], f32x4 (&gv)[2]) {
#pragma unroll
    for (int i = 0; i < 8; ++i) v[i] = __builtin_nontemporal_load((const f32x4*)(J.src + (size_t)(8 * i) * J.ldw));
    if (J.gk) { gv[0] = *(const f32x4*)(J.gk); gv[1] = *(const f32x4*)(J.gk + 4); } else { gv[0] = (f32x4){1.f, 1.f, 1.f, 1.f}; gv[1] = gv[0]; }
}
__device__ __forceinline__ void mw_finish(const MwJob& J, const f32x4 (&v)[8], const f32x4 (&gv)[2], LAS float* scr, int lane) {
#pragma unroll
    for (int i = 0; i < 8; ++i) { LAS float* sp = scr + (8 * i + (lane >> 3)) * 33 + 4 * (lane & 7); sp[0] = v[i].x; sp[1] = v[i].y; sp[2] = v[i].z; sp[3] = v[i].w; }
    LDS_WAIT(); asm volatile("" ::: "memory");
    const int c = lane & 7;
#pragma unroll
    for (int j = 0; j < 4; ++j) { const LAS float* sp = scr + (8 * c) * 33 + (lane >> 3) + 8 * j;
        u32x4 o; o.x = pk2(sp[0 * 33] * gv[0].x, sp[1 * 33] * gv[0].y); o.y = pk2(sp[2 * 33] * gv[0].z, sp[3 * 33] * gv[0].w); o.z = pk2(sp[4 * 33] * gv[1].x, sp[5 * 33] * gv[1].y); o.w = pk2(sp[6 * 33] * gv[1].z, sp[7 * 33] * gv[1].w);
        *(u32x4*)(J.dst + (size_t)(8 * j) * J.ldt) = o; }
    LDS_WAIT(); asm volatile("" ::: "memory");
}
__device__ __forceinline__ void moe_weight_prep(Frame& F, const Args& A, int l) {
    PHASE_PIN(F);
    LAS float* scr = (LAS float*)(F.lds + F.wave * LDS_WSCR); const int lane = F.lane;
    const float* g = F.ka->in[29] + l * DM;
    const float* w1 = F.ka->in[32] + (size_t)l * 32 * DM * 512; const float* w3 = F.ka->in[33] + (size_t)l * 32 * DM * 512; const float* w2 = F.ka->in[34] + (size_t)l * 32 * 512 * DM;
    bf16_t* W13T = (bf16_t*)(F.ws + WS_W13T); bf16_t* W2T = (bf16_t*)(F.ws + WS_W2T);
    f32x4 va[8], vb[8], ga[2], gb[2];
    int it = F.gw;
    if (it >= 24576) return;
    MwJob Ja = mw_job(it, w1, w3, w2, g, W13T, W2T, lane), Jb = Ja; mw_load(Ja, va, ga);
    for (;;) {
        const int itb = it + F.ngw; const bool hb = itb < 24576;
        if (hb) { Jb = mw_job(itb, w1, w3, w2, g, W13T, W2T, lane); mw_load(Jb, vb, gb); }
        mw_finish(Ja, va, ga, scr, lane);
        if (!hb) break;
        const int ita = itb + F.ngw; const bool ha = ita < 24576;
        if (ha) { Ja = mw_job(ita, w1, w3, w2, g, W13T, W2T, lane); mw_load(Ja, va, ga); }
        mw_finish(Jb, vb, gb, scr, lane);
        if (!ha) break;
        it = ita;
    }
}

#define MFMA32(a, b, c) __builtin_amdgcn_mfma_f32_32x32x16_bf16((a), (b), (c), 0, 0, 0)
template <class Epi>
__device__ __forceinline__ void sg_tile(const bf16_t* A, int lda, const bf16_t* B0, const bf16_t* B1, int ldb, int K, int m0, const Epi& epi, int lane) {
    const int r = lane & 31, h = lane >> 5;
    const bf16_t* a0 = A + (size_t)(m0 + r) * lda + 8 * h; const bf16_t* a1 = a0 + (size_t)32 * lda;
    const bf16_t* b0 = B0 + (size_t)r * ldb + 8 * h; const bf16_t* b1 = B1 + (size_t)r * ldb + 8 * h;
    f32x16 c00, c01, c10, c11;
#pragma unroll
    for (int i = 0; i < 16; ++i) { c00[i] = 0.f; c01[i] = 0.f; c10[i] = 0.f; c11[i] = 0.f; }
#pragma unroll 4
    for (int k = 0; k < K; k += 16) {
        const bf16x8 fa0 = *(const bf16x8*)(a0 + k), fa1 = *(const bf16x8*)(a1 + k), fb0 = *(const bf16x8*)(b0 + k), fb1 = *(const bf16x8*)(b1 + k);
        c00 = MFMA32(fb0, fa0, c00); c01 = MFMA32(fb1, fa0, c01); c10 = MFMA32(fb0, fa1, c10); c11 = MFMA32(fb1, fa1, c11);
    }
#pragma unroll
    for (int g = 0; g < 4; ++g) {
        const int j = 8 * g + 4 * h;
        epi.pair(m0 + r, j, (f32x4){c00[4 * g], c00[4 * g + 1], c00[4 * g + 2], c00[4 * g + 3]}, (f32x4){c01[4 * g], c01[4 * g + 1], c01[4 * g + 2], c01[4 * g + 3]});
        epi.pair(m0 + 32 + r, j, (f32x4){c10[4 * g], c10[4 * g + 1], c10[4 * g + 2], c10[4 * g + 3]}, (f32x4){c11[4 * g], c11[4 * g + 1], c11[4 * g + 2], c11[4 * g + 3]});
    }
}
struct EpiStoreBf16 {
    bf16_t* O; int ldo, n0, n1;
    __device__ __forceinline__ void pair(int row, int j, f32x4 v0, f32x4 v1) const {
        u32x2 w; w.x = pk2(v0.x, v0.y); w.y = pk2(v0.z, v0.w); *(u32x2*)(O + (size_t)row * ldo + n0 + j) = w;
        w.x = pk2(v1.x, v1.y); w.y = pk2(v1.z, v1.w); *(u32x2*)(O + (size_t)row * ldo + n1 + j) = w;
    }
};
struct EpiResidF32 {
    const float* S; float* X; int n0, n1;
    __device__ __forceinline__ void pair(int row, int j, f32x4 v0, f32x4 v1) const {
        const size_t o0 = (size_t)row * DM + n0 + j, o1 = (size_t)row * DM + n1 + j;
        *(f32x4*)(X + o0) = *(const f32x4*)(S + o0) + v0; *(f32x4*)(X + o1) = *(const f32x4*)(S + o1) + v1;
    }
};
struct EpiGated {
    bf16_t* H; int hc;
    __device__ __forceinline__ void pair(int row, int j, f32x4 a, f32x4 b) const {
        f32x4 o;
#pragma unroll
        for (int i = 0; i < 4; ++i) o[i] = a[i] * sigmoidf_(a[i]) * b[i];
        u32x2 w; w.x = pk2(o.x, o.y); w.y = pk2(o.z, o.w); *(u32x2*)(H + (size_t)row * 512 + hc + j) = w;
    }
};
__device__ __forceinline__ void sg_dense_bf16(Frame& F, const bf16_t* A, int lda, const bf16_t* Bt, int K, int M, int N, bf16_t* O, int ldo) {
    PHASE_PIN(F);
    const int nN = N / 64, ntile = (M / 64) * nN;
    for (int t = F.gw; t < ntile; t += F.ngw) {
        const int mt = t / nN, nt = t % nN; EpiStoreBf16 E{O, ldo, nt * 64, nt * 64 + 32};
        sg_tile(A, lda, Bt + (size_t)(nt * 64) * K, Bt + (size_t)(nt * 64 + 32) * K, K, K, mt * 64, E, F.lane);
    }
}
__device__ __forceinline__ void sg_dense_resid(Frame& F, const bf16_t* A, const bf16_t* Bt, const float* S, float* X) {
    PHASE_PIN(F);
    const int nN = DM / 64, ntile = (NT / 64) * nN;
    for (int t = F.gw; t < ntile; t += F.ngw) {
        const int mt = t / nN, nt = t % nN; EpiResidF32 E{S, X, nt * 64, nt * 64 + 32};
        sg_tile(A, DM, Bt + (size_t)(nt * 64) * DM, Bt + (size_t)(nt * 64 + 32) * DM, DM, DM, mt * 64, E, F.lane);
    }
}

namespace pg8 {
#define PG8_LAS __attribute__((address_space(3)))
typedef unsigned short bf16_t;
typedef short bf16x8 __attribute__((ext_vector_type(8)));
typedef float f32x4 __attribute__((ext_vector_type(4)));
typedef unsigned u32x4 __attribute__((ext_vector_type(4)));
constexpr int BM = 256, BK = 64, HALF = 128, HTB = HALF * BK * 2  , STAGE_BYTES = 8 * HTB, NXCD = 8, WGM = 8;

__host__ __device__ __forceinline__ int lds_byte(int r, int c) { const int st = (r >> 4) * 2 + (c >> 5), rr = r & 15, cc = c & 31, ob = rr * 64 + cc * 2; return st * 1024 + (ob ^ (((ob >> 9) & 1) << 5)); }
__host__ __device__ __forceinline__ void stage_rc(int b, int& R, int& C) { const int st = b / 1024, sb = b % 1024, swz = sb ^ (((sb >> 9) & 1) << 5); R = (st >> 1) * 16 + swz / 64; C = (st & 1) * 32 + (swz % 64) / 2; }
__host__ __device__ __forceinline__ int perm32(int rho) { const int n = rho >> 4, i = rho & 15; return 8 * (i >> 2) + 4 * n + (i & 3); }

struct Unit { int pm, pn; };
struct Gemm { const bf16_t* A; const bf16_t* Bt; int M, N, K; };

struct StaticOrder {
    int nM, nN, nwg, G, c;
    __host__ __device__ void init(int M, int N, int G_, int c_) { nM = M / BM; nN = N / BM; nwg = nM * nN; G = G_; c = c_; }
    __host__ __device__ bool next(int i, Unit& u) const {
        const long L = (long)i * G + c; if (L >= nwg) return false;
        int wgid = (int)L; { const int q = nwg / NXCD, r = nwg % NXCD, xcd = wgid % NXCD, off = wgid / NXCD; wgid = (xcd < r ? xcd * (q + 1) : r * (q + 1) + (xcd - r) * q) + off; }
        const int nig = WGM * nN, gid = wgid / nig, fm = gid * WGM, gsz = (nM - fm) < WGM ? (nM - fm) : WGM;
        u.pm = fm + ((wgid % nig) % gsz); u.pn = (wgid % nig) / gsz; return true;
    }
    __device__ __forceinline__ void a_ready(const Unit&) const {}
    __device__ __forceinline__ void done(const Unit&) const {}
};

__device__ __forceinline__ unsigned cvt_pk_bf16(float lo, float hi) { return ::pk2(lo, hi); }
struct EpiBf16S {
    static constexpr bool PERM = true, AFTER_DRAIN = false;
    bf16_t* O; int ldc; int split_cols; size_t split_stride;
    __device__ __forceinline__ void operator()(const f32x4 (&acc)[2][2][4][2], const Unit& u, int wr, int wc, int fr, int fq) const {
        const int row0 = u.pm * BM + wr * 64 + fr; int colt = u.pn * BM; bf16_t* base = O;
        if (split_cols) { const int t = colt / split_cols; base += (size_t)t * split_stride; colt -= t * split_cols; }
        const int col0 = colt + wc * 32 + 8 * fq;
#pragma unroll
        for (int ai = 0; ai < 2; ++ai)
#pragma unroll
            for (int m = 0; m < 4; ++m) { bf16_t* rowp = base + (size_t)(row0 + ai * HALF + m * 16) * ldc + col0;
#pragma unroll
                for (int bj = 0; bj < 2; ++bj) { const f32x4 v0 = acc[ai][bj][m][0], v1 = acc[ai][bj][m][1];
                    u32x4 w; w.x = cvt_pk_bf16(v0[0], v0[1]); w.y = cvt_pk_bf16(v0[2], v0[3]); w.z = cvt_pk_bf16(v1[0], v1[1]); w.w = cvt_pk_bf16(v1[2], v1[3]);
                    *(u32x4*)(rowp + bj * HALF) = w; } }
    }
};
struct EpiResid {
    static constexpr bool PERM = false, AFTER_DRAIN = false;
    const float* S; float* X;
    __device__ __forceinline__ void operator()(const f32x4 (&acc)[2][2][4][2], const Unit& u, int wr, int wc, int fr, int fq) const {
        const int row0 = u.pm * BM + wr * 64 + fr, col0 = u.pn * BM + wc * 32 + 4 * fq;
#pragma unroll
        for (int ai = 0; ai < 2; ++ai)
#pragma unroll
            for (int m = 0; m < 4; ++m) { const size_t off = (size_t)(row0 + ai * HALF + m * 16) * 1024 + col0;
#pragma unroll
                for (int bj = 0; bj < 2; ++bj)
#pragma unroll
                    for (int n = 0; n < 2; ++n) *(f32x4*)(X + off + bj * HALF + n * 16) = *(const f32x4*)(S + off + bj * HALF + n * 16) + acc[ai][bj][m][n]; }
    }
};
struct EpiGate {
    static constexpr bool PERM = true, AFTER_DRAIN = false;
    bf16_t* H;
    __device__ __forceinline__ void operator()(const f32x4 (&acc)[2][2][4][2], const Unit& u, int wr, int wc, int fr, int fq) const {
        const int row0 = u.pm * BM + wr * 64 + fr, col0 = (u.pn & 3) * 128 + wc * 32 + 8 * fq;
#pragma unroll
        for (int ai = 0; ai < 2; ++ai)
#pragma unroll
            for (int m = 0; m < 4; ++m) { float o[8];
#pragma unroll
                for (int n = 0; n < 2; ++n)
#pragma unroll
                    for (int i = 0; i < 4; ++i) { const float a = acc[ai][0][m][n][i], b = acc[ai][1][m][n][i]; o[4 * n + i] = a * b * __builtin_amdgcn_rcpf(1.0f + __builtin_amdgcn_exp2f(-1.4426950408889634f * a)); }
                u32x4 w; w.x = cvt_pk_bf16(o[0], o[1]); w.y = cvt_pk_bf16(o[2], o[3]); w.z = cvt_pk_bf16(o[4], o[5]); w.w = cvt_pk_bf16(o[6], o[7]);
                *(u32x4*)(H + (size_t)(row0 + ai * HALF + m * 16) * 512 + col0) = w; }
    }
};
struct EpiMoeDown {
    static constexpr bool PERM = true, AFTER_DRAIN = false;
    bf16_t* Y;
    __device__ __forceinline__ void operator()(const f32x4 (&acc)[2][2][4][2], const Unit& u, int wr, int wc, int fr, int fq) const {
        const int row0 = u.pm * BM + wr * 64 + fr, col0 = (u.pn & 3) * BM + wc * 32 + 8 * fq;
#pragma unroll
        for (int ai = 0; ai < 2; ++ai)
#pragma unroll
            for (int m = 0; m < 4; ++m) { bf16_t* rowp = Y + (size_t)(row0 + ai * HALF + m * 16) * 1024 + col0;
#pragma unroll
                for (int bj = 0; bj < 2; ++bj) { const f32x4 v0 = acc[ai][bj][m][0], v1 = acc[ai][bj][m][1];
                    u32x4 w; w.x = cvt_pk_bf16(v0[0], v0[1]); w.y = cvt_pk_bf16(v0[2], v0[3]); w.z = cvt_pk_bf16(v1[0], v1[1]); w.w = cvt_pk_bf16(v1[2], v1[3]);
                    *(u32x4*)(rowp + bj * HALF) = w; } }
    }
};
struct MoeOrder {
    int nunits, G, c; const PG8_LAS int* tab;
    __device__ __forceinline__ bool next(int i, Unit& u) const {
        const int L = i * G + c; if (L >= nunits) return false;
        const int rt = L >> 2; u.pm = rt; u.pn = __builtin_amdgcn_readfirstlane(tab[rt]) * 4 + (L & 3); return true;
    }
    __device__ __forceinline__ void a_ready(const Unit&) const {}
    __device__ __forceinline__ void done(const Unit&) const {}
};
template <class Epi, class Sched, bool STAMP = false>
__device__ __forceinline__ void gemm_phase(PG8_LAS unsigned char* lds, const Gemm g, const Sched& S, const Epi& E, unsigned long long* stamps, const int wid_in) {
    int ln_; asm volatile("v_mbcnt_lo_u32_b32 %0, -1, 0\n\tv_mbcnt_hi_u32_b32 %0, -1, %0" : "=v"(ln_)); const int tid = wid_in * 64 + ln_, wid = wid_in, lane = tid & 63, wr = wid >> 2, wc = wid & 3, fr = lane & 15, fq = lane >> 4;
    const int K = g.K, nt = K / BK;
    int ts_lo = 0, ts_hi = 0, nts = 0; const unsigned long long rt_entry = STAMP ? (unsigned long long)wall_clock64() : 0ull;
#define PG8_STAMP() do { if (STAMP && wid == 0 && nts < 64) { const unsigned long long _c = (unsigned long long)clock64(); \
        ts_lo = (lane == nts) ? (int)(unsigned)_c : ts_lo; ts_hi = (lane == nts) ? (int)(unsigned)(_c >> 32) : ts_hi; ++nts; } } while (0)
    PG8_STAMP();
    unsigned voffA[2], voffB[2];
#pragma unroll
    for (int i = 0; i < 2; ++i) { int R, C; stage_rc(tid * 16 + i * 8192, R, C); const int Rb = Epi::PERM ? ((R & ~31) + perm32(R & 31)) : R;
        voffA[i] = (unsigned)(R * K + C) * 2u; voffB[i] = (unsigned)(Rb * K + C) * 2u; }
    const size_t kstep = (size_t)(BK * 2);
    const size_t hstep = (size_t)HALF * K * 2;
    const size_t tstep = 2 * hstep;
    const unsigned ldsw = (unsigned)wid * 1024u;
    const int aoff = lds_byte(wr * 64 + fr, fq * 8), boff = lds_byte(wc * 32 + fr, fq * 8);
#define PG8_SA(b, h) (((b) * 2 + (h)) * HTB)
#define PG8_SB(b, h) ((4 + (b) * 2 + (h)) * HTB)
#define PG8_STAGE(bufoff, gbase, voff) do { _Pragma("unroll") for (int _i = 0; _i < 2; ++_i) \
        __builtin_amdgcn_global_load_lds((const unsigned*)((const char*)(gbase) + (voff)[_i]), (PG8_LAS unsigned*)(lds + (bufoff) + ldsw + _i * 8192), 16, 0, 0); } while (0)
#define PG8_LDA(dst, b, h) do { _Pragma("unroll") for (int m = 0; m < 4; ++m) _Pragma("unroll") for (int k = 0; k < 2; ++k) dst[m][k] = *(const PG8_LAS bf16x8*)(lds + PG8_SA(b, h) + aoff + m * 2048 + k * 1024); } while (0)
#define PG8_LDB(dst, b, h) do { _Pragma("unroll") for (int n = 0; n < 2; ++n) _Pragma("unroll") for (int k = 0; k < 2; ++k) dst[n][k] = *(const PG8_LAS bf16x8*)(lds + PG8_SB(b, h) + boff + n * 2048 + k * 1024); } while (0)
#define PG8_MMA(ai, bj, At, Bt) do { __builtin_amdgcn_s_setprio(1); _Pragma("unroll") for (int m = 0; m < 4; ++m) _Pragma("unroll") for (int n = 0; n < 2; ++n) _Pragma("unroll") for (int k = 0; k < 2; ++k) \
        acc[ai][bj][m][n] = __builtin_amdgcn_mfma_f32_16x16x32_bf16(Bt[n][k], At[m][k], acc[ai][bj][m][n], 0, 0, 0); __builtin_amdgcn_s_setprio(0); } while (0)
#define PG8_WAIT_V(n) asm volatile("s_waitcnt vmcnt(" #n ")" ::: "memory")
#define PG8_WAIT_L(n) asm volatile("s_waitcnt lgkmcnt(" #n ")" ::: "memory")
#define PG8_BAR __builtin_amdgcn_s_barrier()
#define PG8_SCHED __builtin_amdgcn_sched_barrier(0)
    Unit cur, nxt; int ui = 0;
    if (!S.next(0, cur)) return;
    f32x4 acc[2][2][4][2];
#pragma unroll
    for (int a = 0; a < 2; ++a)
#pragma unroll
        for (int b = 0; b < 2; ++b)
#pragma unroll
            for (int m = 0; m < 4; ++m)
#pragma unroll
                for (int n = 0; n < 2; ++n) acc[a][b][m][n] = (f32x4){0.f, 0.f, 0.f, 0.f};
    bf16x8 At[4][2], B0[2][2], B1[2][2];
    const char* cA = (const char*)g.A + (size_t)cur.pm * tstep; const char* cB = (const char*)g.Bt + (size_t)cur.pn * tstep;
    S.a_ready(cur);
    PG8_STAGE(PG8_SB(0, 0), cB, voffB); PG8_STAGE(PG8_SA(0, 0), cA, voffA); PG8_STAGE(PG8_SB(0, 1), cB + hstep, voffB); PG8_STAGE(PG8_SA(0, 1), cA + hstep, voffA);
    if (wr == 1) PG8_BAR;
    PG8_WAIT_V(4); PG8_BAR;
    PG8_STAGE(PG8_SB(1, 0), cB + kstep, voffB); PG8_STAGE(PG8_SA(1, 0), cA + kstep, voffA); PG8_STAGE(PG8_SB(1, 1), cB + hstep + kstep, voffB);
    PG8_WAIT_V(6); PG8_BAR;
    PG8_STAMP();
    for (;;) {
        const bool has_next = S.next(ui + 1, nxt);
        const char* nA = has_next ? (const char*)g.A + (size_t)nxt.pm * tstep : cA; const char* nB = has_next ? (const char*)g.Bt + (size_t)nxt.pn * tstep : cB;
        for (int t = 0; t < nt; t += 2) {
            const bool last = (t == nt - 2);
            const char* a1 = cA + (size_t)(t + 1) * kstep;
            const char* a2 = last ? nA : cA + (size_t)(t + 2) * kstep; const char* b2 = last ? nB : cB + (size_t)(t + 2) * kstep;
            const char* a3 = a2 + kstep; const char* b3 = b2 + kstep;
            if (last && has_next) S.a_ready(nxt);
            PG8_LDB(B0, 0, 0); PG8_SCHED; PG8_LDA(At, 0, 0); PG8_STAGE(PG8_SA(1, 1), a1 + hstep, voffA);
            PG8_WAIT_L(8); PG8_BAR; PG8_WAIT_L(0); PG8_MMA(0, 0, At, B0); PG8_BAR; PG8_SCHED;
            PG8_LDB(B1, 0, 1); PG8_STAGE(PG8_SB(0, 0), b2, voffB);
            PG8_BAR; PG8_WAIT_L(0); PG8_MMA(0, 1, At, B1); PG8_BAR;
            PG8_LDA(At, 0, 1); PG8_STAGE(PG8_SA(0, 0), a2, voffA);
            PG8_BAR; PG8_WAIT_L(0); PG8_MMA(1, 0, At, B0); PG8_BAR; PG8_SCHED;
            PG8_STAGE(PG8_SB(0, 1), b2 + hstep, voffB);
            PG8_WAIT_V(6); PG8_BAR; PG8_MMA(1, 1, At, B1); PG8_BAR;
            PG8_LDB(B0, 1, 0); PG8_SCHED; PG8_LDA(At, 1, 0); PG8_STAGE(PG8_SA(0, 1), a2 + hstep, voffA);
            PG8_WAIT_L(8); PG8_BAR; PG8_WAIT_L(0); PG8_MMA(0, 0, At, B0); PG8_BAR; PG8_SCHED;
            PG8_LDB(B1, 1, 1); PG8_STAGE(PG8_SB(1, 0), b3, voffB);
            PG8_BAR; PG8_WAIT_L(0); PG8_MMA(0, 1, At, B1); PG8_BAR;
            PG8_LDA(At, 1, 1); PG8_STAGE(PG8_SA(1, 0), a3, voffA);
            PG8_BAR; PG8_WAIT_L(0); PG8_MMA(1, 0, At, B0); PG8_BAR; PG8_SCHED;
            PG8_STAGE(PG8_SB(1, 1), b3 + hstep, voffB);
            PG8_WAIT_V(6); PG8_BAR; PG8_MMA(1, 1, At, B1); PG8_BAR;
        }
        PG8_STAMP();
        if constexpr (!Epi::AFTER_DRAIN) { E(acc, cur, wr, wc, fr, fq); S.done(cur); }
        PG8_STAMP();
        if (!has_next) break;
#pragma unroll
        for (int a = 0; a < 2; ++a)
#pragma unroll
            for (int b = 0; b < 2; ++b)
#pragma unroll
                for (int m = 0; m < 4; ++m)
#pragma unroll
                    for (int n = 0; n < 2; ++n) acc[a][b][m][n] = (f32x4){0.f, 0.f, 0.f, 0.f};
        cur = nxt; cA = nA; cB = nB; ++ui;
    }
    PG8_WAIT_V(0);
    if (wr == 0) PG8_BAR;
    PG8_BAR;
    if constexpr (Epi::AFTER_DRAIN) { E.fused(acc, cur, wr, wc, fr, fq, lds, wid, lane); S.done(cur); }
    PG8_STAMP();
    if (STAMP && wid == 0) { stamps[lane] = lane < nts ? (((unsigned long long)(unsigned)ts_hi << 32) | (unsigned)ts_lo) : 0ull;
        if (lane == 62) stamps[62] = rt_entry; if (lane == 63) stamps[63] = (unsigned long long)wall_clock64(); }
#undef PG8_STAMP
#undef PG8_SA
#undef PG8_SB
#undef PG8_STAGE
#undef PG8_LDA
#undef PG8_LDB
#undef PG8_MMA
#undef PG8_WAIT_V
#undef PG8_WAIT_L
#undef PG8_BAR
#undef PG8_SCHED
}
}

__device__ __forceinline__ f32x4 ld_bf4(const bf16_t* p) { const u32x2 w = *(const u32x2*)p; return (f32x4){__uint_as_float(w.x << 16), __uint_as_float(w.x & 0xffff0000u), __uint_as_float(w.y << 16), __uint_as_float(w.y & 0xffff0000u)}; }
__device__ __forceinline__ float fast_sigmoid(float x) { return __builtin_amdgcn_rcpf(1.0f + __builtin_amdgcn_exp2f(-LOG2E * x)); }
__device__ __forceinline__ float fast_tanh(float x) { return 1.0f - 2.0f * __builtin_amdgcn_rcpf(1.0f + __builtin_amdgcn_exp2f(2.0f * LOG2E * x)); }
__device__ __forceinline__ void ld_pq8(const bf16_t* p, const bf16_t* q, bool hp, float (&o)[8]) {
    const u32x4 a = *(const u32x4*)p; u32x4 b = (u32x4){0u, 0u, 0u, 0u}; if (hp) b = *(const u32x4*)q;
    o[0] = __uint_as_float(a.x << 16) + __uint_as_float(b.x << 16); o[1] = __uint_as_float(a.x & 0xffff0000u) + __uint_as_float(b.x & 0xffff0000u);
    o[2] = __uint_as_float(a.y << 16) + __uint_as_float(b.y << 16); o[3] = __uint_as_float(a.y & 0xffff0000u) + __uint_as_float(b.y & 0xffff0000u);
    o[4] = __uint_as_float(a.z << 16) + __uint_as_float(b.z << 16); o[5] = __uint_as_float(a.z & 0xffff0000u) + __uint_as_float(b.z & 0xffff0000u);
    o[6] = __uint_as_float(a.w << 16) + __uint_as_float(b.w << 16); o[7] = __uint_as_float(a.w & 0xffff0000u) + __uint_as_float(b.w & 0xffff0000u);
}
__device__ __forceinline__ bf16x8 pack8(const float (&o)[8]) { u32x4 w; w.x = pk2(o[0], o[1]); w.y = pk2(o[2], o[3]); w.z = pk2(o[4], o[5]); w.w = pk2(o[6], o[7]); return __builtin_bit_cast(bf16x8, w); }
__device__ __forceinline__ void ph_prep(Frame& F, const Args& A, int e, int parts) {
    PHASE_PIN(F);
    unsigned char* ws = F.ws; const int lane = F.lane;
    const bf16_t* proj = (const bf16_t*)(ws + WS_PROJ);
    const float* mu_rkv = F.ka->in[4] + (size_t)e * 3 * 512;
    const float* w0 = F.ka->in[6] + e * 512; const float* a0 = F.ka->in[9] + e * 512;
    const float* k_k = F.ka->in[14] + e * 512; const float* k_a = F.ka->in[15] + e * 512; const float* r_k = F.ka->in[16] + e * 512;
    const float* v0 = F.ka->in[20];
    const float* kvn = F.ka->in[23] + e * 128; const float* ikn = F.ka->in[25] + e * 64;
    float* SIN = (float*)(ws + WS_SIN); float* VF = (float*)(ws + WS_VF); float* GATE = (float*)(ws + WS_GATE); float* BON = (float*)(ws + SM_BONUS);
    unsigned* SGN = (unsigned*)(ws + SM_SGN);
    bf16_t* CN = (bf16_t*)(ws + WS_CN); bf16_t* KI = (bf16_t*)(ws + WS_KI); bf16_t* QI = (bf16_t*)(ws + WS_QI); bf16_t* QLIN = (bf16_t*)(ws + SM_QLIN);
    if (parts & 1)
    for (int m = F.gw; m < NT; m += F.ngw) {
        const bf16_t* pr = proj + (size_t)m * NCOL;
        const float c0 = bf2f(pr[C_CKV + lane]), c1 = bf2f(pr[C_CKV + 64 + lane]);
        const float rs = rsqrtf(wave_sum(c0 * c0 + c1 * c1) * (1.f / 128.f) + RMS_EPS);
        CN[(size_t)m * 128 + lane] = (bf16_t)f2bf(c0 * rs * kvn[lane]); CN[(size_t)m * 128 + 64 + lane] = (bf16_t)f2bf(c1 * rs * kvn[64 + lane]);
        const float ki = bf2f(pr[C_KI + lane]); const float rs2 = rsqrtf(wave_sum(ki * ki) * (1.f / 64.f) + RMS_EPS);
        KI[(size_t)m * 64 + lane] = (bf16_t)f2bf(ki * rs2 * ikn[lane]);
        unsigned sg = 0;
#pragma unroll
        for (int hh = 0; hh < 8; ++hh) { const float w = bf2f(pr[C_WI + hh]); if (w < 0.f) sg |= 1u << hh; const float qv = bf2f(pr[C_QI + hh * 64 + lane]);
            QI[(size_t)m * 512 + hh * 64 + lane] = (bf16_t)f2bf(fabsf(w) * qv); }
        if (lane == 0) SGN[m] = sg;
    }
    if (parts & 2) { const int r = lane & 31, hf = lane >> 5;
      const bf16_t* L2W = (const bf16_t*)(ws + W_L2) + (size_t)e * (288 * 512);
      const bf16_t* w2T = L2W; const bf16_t* a2T = L2W + 64 * 512; const bf16_t* g2T = L2W + 128 * 512; const bf16_t* v2T = L2W + 256 * 512;
      for (int it = F.gw; it < 512 * 2; it += F.ngw) {
        const int half = it & 1, tile = it >> 1, m = tile * 32 + r, t = m & (TT - 1), b = m >> 13; const bool hp = t > 0;
        const bf16_t* pr = proj + (size_t)m * NCOL; const bf16_t* pp = pr - NCOL;
        bf16x8 fw[4], fa[4], fg[8], fv[2];
#pragma unroll
        for (int ks = 0; ks < 4; ++ks) { float o[8]; ld_pq8(pr + C_PW + 16 * ks + 8 * hf, pp + C_QW + 16 * ks + 8 * hf, hp, o);
#pragma unroll
            for (int j = 0; j < 8; ++j) o[j] = fast_tanh(o[j]);
            fw[ks] = pack8(o);
            ld_pq8(pr + C_PA + 16 * ks + 8 * hf, pp + C_QA + 16 * ks + 8 * hf, hp, o); fa[ks] = pack8(o); }
#pragma unroll
        for (int ks = 0; ks < 8; ++ks) { float o[8]; ld_pq8(pr + C_PG + 16 * ks + 8 * hf, pp + C_QG + 16 * ks + 8 * hf, hp, o);
#pragma unroll
            for (int j = 0; j < 8; ++j) o[j] = fast_sigmoid(o[j]);
            fg[ks] = pack8(o); }
#pragma unroll
        for (int ks = 0; ks < 2; ++ks) { float o[8] = {0.f, 0.f, 0.f, 0.f, 0.f, 0.f, 0.f, 0.f}; if (e == 1) ld_pq8(pr + C_PV + 16 * ks + 8 * hf, pp + C_QV + 16 * ks + 8 * hf, hp, o); fv[ks] = pack8(o); }
#pragma unroll 1
        for (int hq = 0; hq < 4; ++hq) {
        const int hh = 4 * half + hq;
        float ss = 0.f, bon = 0.f;
        float* so = SIN + ((size_t)(b * 8 + hh) * TT + t) * 384;
#pragma unroll
        for (int sub = 0; sub < 2; ++sub)
#pragma unroll
            for (int g = 0; g < 4; ++g) { const int ch4 = hh * 64 + sub * 32 + 8 * g + 4 * hf;
                const f32x4 kk0 = ld_bf4(pr + C_K + ch4); f32x4 kp = (f32x4){0.f, 0.f, 0.f, 0.f}; if (hp) kp = ld_bf4(pp + C_K + ch4);
                const f32x4 mk = *(const f32x4*)(mu_rkv + 512 + ch4), kk4 = *(const f32x4*)(k_k + ch4);
#pragma unroll
                for (int j = 0; j < 4; ++j) { const float kx = (kk0[j] + (kp[j] - kk0[j]) * mk[j]) * kk4[j]; ss += kx * kx; } }
        ss += __shfl_xor(ss, 32);
        const float rn = rsqrtf(fmaxf(ss, 1e-12f));
#pragma unroll 1
        for (int sub = 0; sub < 2; ++sub) {
            const int cb = hh * 64 + sub * 32;
            f32x16 acc;
#pragma unroll
            for (int i = 0; i < 16; ++i) acc[i] = 0.f;
#pragma unroll
            for (int ks = 0; ks < 4; ++ks) acc = MFMA32(*(const bf16x8*)(w2T + (size_t)(cb + r) * 64 + 16 * ks + 8 * hf), fw[ks], acc);
#pragma unroll
            for (int g = 0; g < 4; ++g) { const int ch4 = cb + 8 * g + 4 * hf; const f32x4 b0 = *(const f32x4*)(w0 + ch4); f32x4 d;
#pragma unroll
                for (int j = 0; j < 4; ++j) d[j] = __builtin_amdgcn_exp2f(-0.6065306597126334f * LOG2E * fast_sigmoid(b0[j] + acc[4 * g + j]));
                *(f32x4*)(so + 64 + sub * 32 + 8 * g + 4 * hf) = d; }
            float icv[16];
#pragma unroll
            for (int i = 0; i < 16; ++i) acc[i] = 0.f;
#pragma unroll
            for (int ks = 0; ks < 4; ++ks) acc = MFMA32(*(const bf16x8*)(a2T + (size_t)(cb + r) * 64 + 16 * ks + 8 * hf), fa[ks], acc);
#pragma unroll
            for (int g = 0; g < 4; ++g) { const int ch4 = cb + 8 * g + 4 * hf; const f32x4 b0 = *(const f32x4*)(a0 + ch4);
#pragma unroll
                for (int j = 0; j < 4; ++j) icv[4 * g + j] = fast_sigmoid(b0[j] + acc[4 * g + j]); }
#pragma unroll
            for (int i = 0; i < 16; ++i) acc[i] = 0.f;
#pragma unroll
            for (int ks = 0; ks < 8; ++ks) acc = MFMA32(*(const bf16x8*)(g2T + (size_t)(cb + r) * 128 + 16 * ks + 8 * hf), fg[ks], acc);
#pragma unroll
            for (int g = 0; g < 4; ++g) *(f32x4*)(GATE + (size_t)m * 512 + cb + 8 * g + 4 * hf) = (f32x4){acc[4 * g], acc[4 * g + 1], acc[4 * g + 2], acc[4 * g + 3]};
            if (e == 1) {
#pragma unroll
                for (int i = 0; i < 16; ++i) acc[i] = 0.f;
#pragma unroll
                for (int ks = 0; ks < 2; ++ks) acc = MFMA32(*(const bf16x8*)(v2T + (size_t)(cb + r) * 32 + 16 * ks + 8 * hf), fv[ks], acc);
            }
#pragma unroll
            for (int g = 0; g < 4; ++g) {
                const int ch4 = cb + 8 * g + 4 * hf;
                const f32x4 rr = ld_bf4(pr + C_R + ch4), kk0 = ld_bf4(pr + C_K + ch4), vv = ld_bf4(pr + C_V + ch4);
                f32x4 rp = (f32x4){0.f, 0.f, 0.f, 0.f}, kp = rp, vp = rp;
                if (hp) { rp = ld_bf4(pp + C_R + ch4); kp = ld_bf4(pp + C_K + ch4); vp = ld_bf4(pp + C_V + ch4); }
                const f32x4 mr = *(const f32x4*)(mu_rkv + ch4), mk = *(const f32x4*)(mu_rkv + 512 + ch4), mv = *(const f32x4*)(mu_rkv + 1024 + ch4);
                const f32x4 kk4 = *(const f32x4*)(k_k + ch4), ka4 = *(const f32x4*)(k_a + ch4), rk4 = *(const f32x4*)(r_k + ch4);
                const f32x4 r1 = rr + (rp - rr) * mr, k1 = kk0 + (kp - kk0) * mk; f32x4 v1 = vv + (vp - vv) * mv;
                if (e == 1) { const f32x4 vb = *(const f32x4*)(v0 + ch4), vf = *(const f32x4*)(VF + (size_t)m * 512 + ch4);
#pragma unroll
                    for (int j = 0; j < 4; ++j) v1[j] = v1[j] + (vf[j] - v1[j]) * fast_sigmoid(vb[j] + acc[4 * g + j]); }
                else *(f32x4*)(VF + (size_t)m * 512 + ch4) = v1;
                f32x4 km, kn, bb;
#pragma unroll
                for (int j = 0; j < 4; ++j) { kn[j] = k1[j] * kk4[j] * rn; bb[j] = icv[4 * g + j] * kn[j];
                    km[j] = k1[j] * (1.0f + (icv[4 * g + j] - 1.0f) * ka4[j]); bon += r1[j] * km[j] * rk4[j]; }
                *(f32x4*)(so + sub * 32 + 8 * g + 4 * hf) = r1; *(f32x4*)(so + 128 + sub * 32 + 8 * g + 4 * hf) = km; *(f32x4*)(so + 320 + sub * 32 + 8 * g + 4 * hf) = v1;
                *(f32x4*)(so + 192 + sub * 32 + 8 * g + 4 * hf) = kn; *(f32x4*)(so + 256 + sub * 32 + 8 * g + 4 * hf) = bb;
                asm volatile("" ::: "memory");
            }
        }
        bon += __shfl_xor(bon, 32);
        if (hf == 0) BON[m * 8 + hh] = bon;
        }
      } }
    if (parts & 4) { bf16_t* QA = (bf16_t*)(ws + WS_QA); const bf16_t* WkB = (const bf16_t*)(ws + W_WKB) + (size_t)e * 8 * 128 * 64;
      const int ntile = (NT / 64) * 2 * 8;
      for (int tI = F.gw; tI < ntile; tI += F.ngw) {
          const int hh = tI & 7, nt = (tI >> 3) & 1, mt = tI >> 4;
          EpiStoreBf16 E{QA + hh * 128, 1024, nt * 64, nt * 64 + 32};
          sg_tile(proj + C_QB + hh * 64, NCOL, WkB + (size_t)hh * 128 * 64 + (size_t)(nt * 64) * 64, WkB + (size_t)hh * 128 * 64 + (size_t)(nt * 64 + 32) * 64, 64, 64, mt * 64, E, F.lane);
      } }
}

__device__ __forceinline__ float allred16(float x) {
    x += __builtin_bit_cast(float, __builtin_amdgcn_update_dpp(0, __builtin_bit_cast(int, x), 0x128, 0xf, 0xf, false));
    x += __builtin_bit_cast(float, __builtin_amdgcn_update_dpp(0, __builtin_bit_cast(int, x), 0x124, 0xf, 0xf, false));
    x += __builtin_bit_cast(float, __builtin_amdgcn_update_dpp(0, __builtin_bit_cast(int, x), 0x122, 0xf, 0xf, false));
    x += __builtin_bit_cast(float, __builtin_amdgcn_update_dpp(0, __builtin_bit_cast(int, x), 0x121, 0xf, 0xf, false));
    return x;
}
__device__ __forceinline__ void ph_scan(Frame& F) {
    PHASE_PIN(F);
    if (F.wave != 0) return;
    const int lane = F.lane, i = lane >> 4, kq = lane & 15;
    for (int task = blockIdx.x; task < 256; task += gridDim.x) {
        const int bh = task >> 4, rg = task & 15, row = 4 * rg + i, b = bh >> 3, hh = bh & 7;
        const float* sin = (const float*)(F.ws + WS_SIN) + (size_t)bh * TT * 384;
        float* Y = (float*)(F.ws + WS_Y) + (size_t)b * TT * 512 + hh * 64 + row;
        f32x4 R[8], W[8], K[8], KK[8], B[8]; float V[8];
#pragma unroll
        for (int j = 0; j < 8; ++j) { const float* p = sin + (size_t)j * 384; R[j] = *(const f32x4*)(p + 4 * kq); W[j] = *(const f32x4*)(p + 64 + 4 * kq); K[j] = *(const f32x4*)(p + 128 + 4 * kq);
            KK[j] = *(const f32x4*)(p + 192 + 4 * kq); B[j] = *(const f32x4*)(p + 256 + 4 * kq); V[j] = p[320 + row]; }
        float s0 = 0.f, s1 = 0.f, s2 = 0.f, s3 = 0.f;
        for (int t0 = 0; t0 < TT; t0 += 8) {
#pragma unroll
            for (int j = 0; j < 8; ++j) {
                float p = s0 * KK[j].x + s1 * KK[j].y + s2 * KK[j].z + s3 * KK[j].w; p = allred16(p);
                s0 = s0 * W[j].x - p * B[j].x + V[j] * K[j].x; s1 = s1 * W[j].y - p * B[j].y + V[j] * K[j].y;
                s2 = s2 * W[j].z - p * B[j].z + V[j] * K[j].z; s3 = s3 * W[j].w - p * B[j].w + V[j] * K[j].w;
                float y = s0 * R[j].x + s1 * R[j].y + s2 * R[j].z + s3 * R[j].w; y = allred16(y);
                if (kq == 0) Y[(size_t)(t0 + j) * 512] = y;
                if (t0 + j + 8 < TT) { const float* p2 = sin + (size_t)(t0 + j + 8) * 384; R[j] = *(const f32x4*)(p2 + 4 * kq); W[j] = *(const f32x4*)(p2 + 64 + 4 * kq); K[j] = *(const f32x4*)(p2 + 128 + 4 * kq);
                    KK[j] = *(const f32x4*)(p2 + 192 + 4 * kq); B[j] = *(const f32x4*)(p2 + 256 + 4 * kq); V[j] = p2[320 + row]; }
            }
        }
    }
}

constexpr size_t S1_TMP_STRIDE = 114688, S1_OUT_STRIDE = 50176;
constexpr int T_TCK = 0, T_TCB = 8192, T_TCKT = 16384, T_TCR = 24576, T_CTB = 32768, T_CTK = 40960, T_CTV = 49152, T_MAK = 57344, T_AAB = 65536, T_AAK = 73728, T_CTKH = 81920, T_CTU = 90112, T_RHSF = 98304;
constexpr int O_PT = 0, O_RH = 8192, O_G = 16384, O_Y0 = 32768, O_GC = 49152;
static_assert(WS_PROJ + 2048 * S1_OUT_STRIDE <= WS_SIN && WS_S1TMP + 1024 * S1_TMP_STRIDE <= WS_END, "scan map");
#define STAGE_SYNC() asm volatile("s_waitcnt vmcnt(0) lgkmcnt(0)" ::: "memory")
template <bool TWO>
__device__ __forceinline__ void mm64_acc(const bf16_t* A1, const bf16_t* B1, const bf16_t* A2, const bf16_t* B2, f32x16& c00, f32x16& c01, f32x16& c10, f32x16& c11, int lane) {
    const int r = lane & 31, h = lane >> 5; const int o = r * 64 + 8 * h;
#pragma unroll
    for (int i = 0; i < 16; ++i) { c00[i] = 0.f; c01[i] = 0.f; c10[i] = 0.f; c11[i] = 0.f; }
#pragma unroll
    for (int k = 0; k < 64; k += 16) {
        const bf16x8 fa0 = *(const bf16x8*)(A1 + o + k), fa1 = *(const bf16x8*)(A1 + o + 2048 + k), fb0 = *(const bf16x8*)(B1 + o + k), fb1 = *(const bf16x8*)(B1 + o + 2048 + k);
        c00 = MFMA32(fb0, fa0, c00); c01 = MFMA32(fb1, fa0, c01); c10 = MFMA32(fb0, fa1, c10); c11 = MFMA32(fb1, fa1, c11);
    }
    if (TWO) {
#pragma unroll
        for (int k = 0; k < 64; k += 16) {
            const bf16x8 fa0 = *(const bf16x8*)(A2 + o + k), fa1 = *(const bf16x8*)(A2 + o + 2048 + k), fb0 = *(const bf16x8*)(B2 + o + k), fb1 = *(const bf16x8*)(B2 + o + 2048 + k);
            c00 = MFMA32(fb0, fa0, c00); c01 = MFMA32(fb1, fa0, c01); c10 = MFMA32(fb0, fa1, c10); c11 = MFMA32(fb1, fa1, c11);
        }
    }
}
template <class Epi>
__device__ __forceinline__ void mm64_epi(const Epi& epi, const f32x16& c00, const f32x16& c01, const f32x16& c10, const f32x16& c11, int lane) {
    const int r = lane & 31, h = lane >> 5;
#pragma unroll
    for (int g = 0; g < 4; ++g) { const int j = 8 * g + 4 * h;
        epi.pair(r, j, (f32x4){c00[4 * g], c00[4 * g + 1], c00[4 * g + 2], c00[4 * g + 3]}, (f32x4){c01[4 * g], c01[4 * g + 1], c01[4 * g + 2], c01[4 * g + 3]});
        epi.pair(32 + r, j, (f32x4){c10[4 * g], c10[4 * g + 1], c10[4 * g + 2], c10[4 * g + 3]}, (f32x4){c11[4 * g], c11[4 * g + 1], c11[4 * g + 2], c11[4 * g + 3]}); }
}
__device__ __forceinline__ u32x2 pk4(f32x4 v) { u32x2 w; w.x = pk2(v.x, v.y); w.y = pk2(v.z, v.w); return w; }
struct EpiMaskLds { LAS float* M; __device__ __forceinline__ void pair(int row, int j, f32x4 v0, f32x4 v1) const {
    f32x4 a, b;
#pragma unroll
    for (int q = 0; q < 4; ++q) { a[q] = (j + q < row) ? v0[q] : 0.f; b[q] = (32 + j + q < row) ? v1[q] : 0.f; }
    *(LAS f32x4*)(M + row * 64 + j) = a; *(LAS f32x4*)(M + row * 64 + 32 + j) = b; } };
template <int INCL> struct EpiMaskBf { bf16_t* O; __device__ __forceinline__ void pair(int row, int j, f32x4 v0, f32x4 v1) const {
    f32x4 a, b;
#pragma unroll
    for (int q = 0; q < 4; ++q) { a[q] = (j + q < row + INCL) ? v0[q] : 0.f; b[q] = (32 + j + q < row + INCL) ? v1[q] : 0.f; }
    *(u32x2*)(O + row * 64 + j) = pk4(a); *(u32x2*)(O + row * 64 + 32 + j) = pk4(b); } };
struct EpiF32 { float* O; __device__ __forceinline__ void pair(int row, int j, f32x4 v0, f32x4 v1) const { *(f32x4*)(O + row * 64 + j) = v0; *(f32x4*)(O + row * 64 + 32 + j) = v1; } };
struct EpiRhat { const bf16_t* R; bf16_t* O; __device__ __forceinline__ void pair(int row, int j, f32x4 v0, f32x4 v1) const {
    *(u32x2*)(O + row * 64 + j) = pk4(ld_bf4(R + row * 64 + j) - v0); *(u32x2*)(O + row * 64 + 32 + j) = pk4(ld_bf4(R + row * 64 + 32 + j) - v1); } };
struct EpiPT { const float* gC; bf16_t* O; __device__ __forceinline__ void pair(int row, int j, f32x4 v0, f32x4 v1) const {
    const float gr = gC[row]; f32x4 a, b;
#pragma unroll
    for (int q = 0; q < 4; ++q) { a[q] = gr * (((j + q == row) ? 1.f : 0.f) - v0[q]); b[q] = gr * (((32 + j + q == row) ? 1.f : 0.f) - v1[q]); }
    *(u32x2*)(O + row * 64 + j) = pk4(a); *(u32x2*)(O + row * 64 + 32 + j) = pk4(b); } };
struct EpiGsc { const float* gC; bf16_t* O; __device__ __forceinline__ void pair(int row, int j, f32x4 v0, f32x4 v1) const {
    *(u32x2*)(O + row * 64 + j) = pk4(v0 * *(const f32x4*)(gC + j)); *(u32x2*)(O + row * 64 + 32 + j) = pk4(v1 * *(const f32x4*)(gC + 32 + j)); } };

__device__ __forceinline__ void ph_scan_s1(Frame& F) {
    PHASE_PIN(F);
    if (F.wave >= 4) return;
    LAS float* Ml = (LAS float*)(F.lds + F.wave * 32768); LAS float* Xl = Ml + 4096;
    const int lane0 = F.lane;
    for (int item = blockIdx.x * 4 + F.wave; item < 2048; item += gridDim.x * 4) {
        int lane = lane0; asm volatile("" : "+v"(lane));
        const int bh = item >> 7, chunk = item & 127;
        unsigned long long zt_; asm volatile("s_mov_b64 %0, 0" : "=s"(zt_));
        unsigned char* tmp = F.ws + WS_S1TMP + (size_t)(blockIdx.x * 4 + F.wave) * S1_TMP_STRIDE + zt_;
        __builtin_amdgcn_fence(__ATOMIC_ACQUIRE, "agent"); asm volatile("s_waitcnt vmcnt(0)" ::: "memory");
        unsigned char* outp = F.ws + WS_PROJ + (size_t)item * S1_OUT_STRIDE;
        bf16_t* TCk = (bf16_t*)(tmp + T_TCK); bf16_t* TCb = (bf16_t*)(tmp + T_TCB); bf16_t* TCkt = (bf16_t*)(tmp + T_TCKT); bf16_t* TCr = (bf16_t*)(tmp + T_TCR);
        bf16_t* CTb = (bf16_t*)(tmp + T_CTB); bf16_t* CTk = (bf16_t*)(tmp + T_CTK); bf16_t* CTv = (bf16_t*)(tmp + T_CTV);
        bf16_t* MAK = (bf16_t*)(tmp + T_MAK); bf16_t* AAB = (bf16_t*)(tmp + T_AAB); bf16_t* AAK = (bf16_t*)(tmp + T_AAK);
        bf16_t* CTKH = (bf16_t*)(tmp + T_CTKH); bf16_t* CTU = (bf16_t*)(tmp + T_CTU); float* RHSF = (float*)(tmp + T_RHSF);
        bf16_t* PT = (bf16_t*)(outp + O_PT); bf16_t* RH = (bf16_t*)(outp + O_RH); bf16_t* Gm = (bf16_t*)(outp + O_G); float* Y0 = (float*)(outp + O_Y0); float* gC = (float*)(outp + O_GC);
        const float* sin = (const float*)(F.ws + WS_SIN) + ((size_t)bh * TT + chunk * 64) * 384;
#ifndef S1_NO_CT
        { float gam[65]; gam[0] = 1.0f;
#pragma unroll
          for (int i = 0; i < 64; ++i) gam[i + 1] = sin[(size_t)i * 384 + 64 + lane];
#pragma unroll
          for (int i = 0; i < 64; ++i) gam[i + 1] *= gam[i];
#pragma unroll
          for (int blk = 0; blk < 8; ++blk) {
            float bt8[8], kt8[8], v8[8];
#pragma unroll
            for (int el = 0; el < 8; ++el) { const int i = blk * 8 + el; const float* p = sin + (size_t)i * 384;
                const float rr = p[lane], kk = p[128 + lane], ka = p[192 + lane], bb = p[256 + lane], vv = p[320 + lane];
                const float kap = gam[i] * ka; const float g = gam[i + 1]; const float inv = __builtin_amdgcn_rcpf(g); const float bt = bb * inv, kt = kk * inv, rt = rr * g;
                TCk[i * 64 + lane] = (bf16_t)f2bf(kap); TCb[i * 64 + lane] = (bf16_t)f2bf(bt); TCkt[i * 64 + lane] = (bf16_t)f2bf(kt); TCr[i * 64 + lane] = (bf16_t)f2bf(rt);
                bt8[el] = bt; kt8[el] = kt; v8[el] = vv; }
            *(bf16x8*)(CTb + lane * 64 + blk * 8) = pack8(bt8); *(bf16x8*)(CTk + lane * 64 + blk * 8) = pack8(kt8); *(bf16x8*)(CTv + lane * 64 + blk * 8) = pack8(v8);
            asm volatile("" ::: "memory");
          }
          gC[lane] = gam[64]; }
#endif
        STAGE_SYNC();
        f32x16 c00, c01, c10, c11;
        mm64_acc<false>(TCk, TCb, nullptr, nullptr, c00, c01, c10, c11, lane); { EpiMaskLds E{Ml}; mm64_epi(E, c00, c01, c10, c11, lane); }
        mm64_acc<false>(TCk, TCkt, nullptr, nullptr, c00, c01, c10, c11, lane); { EpiMaskBf<0> E{MAK}; mm64_epi(E, c00, c01, c10, c11, lane); }
        STAGE_SYNC();
        mm64_acc<false>(MAK, CTv, nullptr, nullptr, c00, c01, c10, c11, lane); { EpiF32 E{RHSF}; mm64_epi(E, c00, c01, c10, c11, lane); }
        STAGE_SYNC();
#ifndef S1_NO_SOLVE
#pragma unroll 1
        for (int pass = 0; pass < 2; ++pass) {
            if (pass & 1) {
#pragma unroll 8
                for (int i = 0; i < 64; ++i) Xl[i * 64 + lane] = RHSF[i * 64 + lane];
            } else {
#pragma unroll 8
                for (int i = 0; i < 64; ++i) Xl[i * 64 + lane] = bf2f(TCk[i * 64 + lane]);
            }
#pragma unroll 1
            for (int i0 = 0; i0 < 64; i0 += 4) {
                float a0 = Xl[i0 * 64 + lane], a1 = Xl[(i0 + 1) * 64 + lane], a2 = Xl[(i0 + 2) * 64 + lane], a3 = Xl[(i0 + 3) * 64 + lane];
#pragma unroll 2
                for (int j4 = 0; j4 < i0; j4 += 4) {
                    const float x0 = Xl[j4 * 64 + lane], x1 = Xl[(j4 + 1) * 64 + lane], x2 = Xl[(j4 + 2) * 64 + lane], x3 = Xl[(j4 + 3) * 64 + lane];
                    const f32x4 m0 = *(const LAS f32x4*)(Ml + i0 * 64 + j4), m1 = *(const LAS f32x4*)(Ml + (i0 + 1) * 64 + j4), m2 = *(const LAS f32x4*)(Ml + (i0 + 2) * 64 + j4), m3 = *(const LAS f32x4*)(Ml + (i0 + 3) * 64 + j4);
                    a0 -= m0.x * x0 + m0.y * x1 + m0.z * x2 + m0.w * x3; a1 -= m1.x * x0 + m1.y * x1 + m1.z * x2 + m1.w * x3;
                    a2 -= m2.x * x0 + m2.y * x1 + m2.z * x2 + m2.w * x3; a3 -= m3.x * x0 + m3.y * x1 + m3.z * x2 + m3.w * x3;
                }
                const f32x4 d1 = *(const LAS f32x4*)(Ml + (i0 + 1) * 64 + i0), d2 = *(const LAS f32x4*)(Ml + (i0 + 2) * 64 + i0), d3 = *(const LAS f32x4*)(Ml + (i0 + 3) * 64 + i0);
                a1 -= d1.x * a0; a2 -= d2.x * a0 + d2.y * a1; a3 -= d3.x * a0 + d3.y * a1 + d3.z * a2;
                Xl[i0 * 64 + lane] = a0; Xl[(i0 + 1) * 64 + lane] = a1; Xl[(i0 + 2) * 64 + lane] = a2; Xl[(i0 + 3) * 64 + lane] = a3;
            }
            bf16_t* dst = (pass & 1) ? CTU : CTKH; const float sgn = (pass & 1) ? -1.0f : 1.0f;
#pragma unroll 1
            for (int blk = 0; blk < 8; ++blk) { float o8[8];
#pragma unroll
                for (int el = 0; el < 8; ++el) o8[el] = sgn * Xl[(blk * 8 + el) * 64 + lane];
                *(bf16x8*)(dst + lane * 64 + blk * 8) = pack8(o8); }
        }
#endif
        mm64_acc<false>(TCr, TCb, nullptr, nullptr, c00, c01, c10, c11, lane); { EpiMaskBf<1> E{AAB}; mm64_epi(E, c00, c01, c10, c11, lane); }
        mm64_acc<false>(TCr, TCkt, nullptr, nullptr, c00, c01, c10, c11, lane); { EpiMaskBf<1> E{AAK}; mm64_epi(E, c00, c01, c10, c11, lane); }
        STAGE_SYNC();
        mm64_acc<false>(AAB, CTKH, nullptr, nullptr, c00, c01, c10, c11, lane); { EpiRhat E{TCr, RH}; mm64_epi(E, c00, c01, c10, c11, lane); }
        mm64_acc<true>(AAB, CTU, AAK, CTv, c00, c01, c10, c11, lane); { EpiF32 E{Y0}; mm64_epi(E, c00, c01, c10, c11, lane); }
        mm64_acc<false>(CTb, CTKH, nullptr, nullptr, c00, c01, c10, c11, lane); { EpiPT E{gC, PT}; mm64_epi(E, c00, c01, c10, c11, lane); }
        mm64_acc<true>(CTU, CTb, CTv, CTk, c00, c01, c10, c11, lane); { EpiGsc E{gC, Gm}; mm64_epi(E, c00, c01, c10, c11, lane); }
        STAGE_SYNC();
    }
}
__device__ __forceinline__ void ph_scan_s2(Frame& F) {
    PHASE_PIN(F);
    if (F.wave != 0 || blockIdx.x >= 32) return;
    const int lane = F.lane, r = lane & 31, hf = lane >> 5; const int bh = blockIdx.x >> 1, vt = blockIdx.x & 1, v = 32 * vt + r;
    bf16_t* SS = (bf16_t*)(F.ws + WS_Y);
    f32x16 acc0, acc1;
#pragma unroll
    for (int i = 0; i < 16; ++i) { acc0[i] = 0.f; acc1[i] = 0.f; }
    u32x2 pt[4][2][4][2]; u32x2 gin[2][2][4];
#define S2_LOADP(buf, chunk) do { const bf16_t* PT_ = (const bf16_t*)(F.ws + WS_PROJ + (size_t)(bh * 128 + (chunk)) * S1_OUT_STRIDE + O_PT); \
        _Pragma("unroll") for (int ni = 0; ni < 2; ++ni) { _Pragma("unroll") for (int s2 = 0; s2 < 4; ++s2) { pt[buf][ni][s2][0] = *(const u32x2*)(PT_ + (32 * ni + r) * 64 + 16 * s2 + 4 * hf); pt[buf][ni][s2][1] = *(const u32x2*)(PT_ + (32 * ni + r) * 64 + 16 * s2 + 8 + 4 * hf); } } } while (0)
#define S2_LOADG(buf, chunk) do { const bf16_t* G_ = (const bf16_t*)(F.ws + WS_PROJ + (size_t)(bh * 128 + (chunk)) * S1_OUT_STRIDE + O_G); \
        _Pragma("unroll") for (int ni = 0; ni < 2; ++ni) { _Pragma("unroll") for (int g = 0; g < 4; ++g) gin[buf][ni][g] = *(const u32x2*)(G_ + v * 64 + 32 * ni + 8 * g + 4 * hf); } } while (0)
#define S2_STEP(pb, gb, chunk) do { bf16_t* so_ = SS + ((size_t)(bh * 128 + (chunk)) * 64 + v) * 64 + 4 * hf; \
        _Pragma("unroll") for (int g = 0; g < 4; ++g) { *(u32x2*)(so_ + 8 * g) = pk4((f32x4){acc0[4 * g], acc0[4 * g + 1], acc0[4 * g + 2], acc0[4 * g + 3]}); *(u32x2*)(so_ + 32 + 8 * g) = pk4((f32x4){acc1[4 * g], acc1[4 * g + 1], acc1[4 * g + 2], acc1[4 * g + 3]}); } \
        bf16x8 sf[4]; { u32x4 w_; \
          w_.x = pk2(acc0[0], acc0[1]); w_.y = pk2(acc0[2], acc0[3]); w_.z = pk2(acc0[4], acc0[5]); w_.w = pk2(acc0[6], acc0[7]); sf[0] = __builtin_bit_cast(bf16x8, w_); \
          w_.x = pk2(acc0[8], acc0[9]); w_.y = pk2(acc0[10], acc0[11]); w_.z = pk2(acc0[12], acc0[13]); w_.w = pk2(acc0[14], acc0[15]); sf[1] = __builtin_bit_cast(bf16x8, w_); \
          w_.x = pk2(acc1[0], acc1[1]); w_.y = pk2(acc1[2], acc1[3]); w_.z = pk2(acc1[4], acc1[5]); w_.w = pk2(acc1[6], acc1[7]); sf[2] = __builtin_bit_cast(bf16x8, w_); \
          w_.x = pk2(acc1[8], acc1[9]); w_.y = pk2(acc1[10], acc1[11]); w_.z = pk2(acc1[12], acc1[13]); w_.w = pk2(acc1[14], acc1[15]); sf[3] = __builtin_bit_cast(bf16x8, w_); } \
        f32x16 n0_, n1_; \
        _Pragma("unroll") for (int q = 0; q < 16; ++q) { n0_[q] = 0.f; n1_[q] = 0.f; } \
        _Pragma("unroll") for (int s2 = 0; s2 < 4; ++s2) { u32x4 a_; a_.x = pt[pb][0][s2][0].x; a_.y = pt[pb][0][s2][0].y; a_.z = pt[pb][0][s2][1].x; a_.w = pt[pb][0][s2][1].y; n0_ = MFMA32(__builtin_bit_cast(bf16x8, a_), sf[s2], n0_); \
            a_.x = pt[pb][1][s2][0].x; a_.y = pt[pb][1][s2][0].y; a_.z = pt[pb][1][s2][1].x; a_.w = pt[pb][1][s2][1].y; n1_ = MFMA32(__builtin_bit_cast(bf16x8, a_), sf[s2], n1_); } \
        _Pragma("unroll") for (int g = 0; g < 4; ++g) { const u32x2 g0_ = gin[gb][0][g], g1_ = gin[gb][1][g]; \
            n0_[4 * g] += __uint_as_float(g0_.x << 16); n0_[4 * g + 1] += __uint_as_float(g0_.x & 0xffff0000u); n0_[4 * g + 2] += __uint_as_float(g0_.y << 16); n0_[4 * g + 3] += __uint_as_float(g0_.y & 0xffff0000u); \
            n1_[4 * g] += __uint_as_float(g1_.x << 16); n1_[4 * g + 1] += __uint_as_float(g1_.x & 0xffff0000u); n1_[4 * g + 2] += __uint_as_float(g1_.y << 16); n1_[4 * g + 3] += __uint_as_float(g1_.y & 0xffff0000u); } \
        acc0 = n0_; acc1 = n1_; } while (0)
    S2_LOADP(0, 0); S2_LOADP(1, 1); S2_LOADP(2, 2); S2_LOADG(0, 0);
    for (int chunk = 0; chunk < 128; chunk += 4) {
        S2_LOADP(3, chunk + 3); S2_LOADG(1, chunk + 1); S2_STEP(0, 0, chunk);
        if (chunk + 4 < 128) S2_LOADP(0, chunk + 4);
        S2_LOADG(0, chunk + 2); S2_STEP(1, 1, chunk + 1);
        if (chunk + 5 < 128) S2_LOADP(1, chunk + 5);
        S2_LOADG(1, chunk + 3); S2_STEP(2, 0, chunk + 2);
        if (chunk + 6 < 128) S2_LOADP(2, chunk + 6);
        if (chunk + 4 < 128) S2_LOADG(0, chunk + 4);
        S2_STEP(3, 1, chunk + 3);
    }
#undef S2_LOADP
#undef S2_LOADG
#undef S2_STEP
}
__device__ __forceinline__ void ph_scan_s3(Frame& F, int e) {
    PHASE_PIN(F);
    const int lane = F.lane, r = lane & 31, hf = lane >> 5;
    const float* ln_g = F.ka->in[17] + e * 512; const float* ln_b = F.ka->in[18] + e * 512;
    const float* GATE = (const float*)(F.ws + WS_GATE); const float* BON = (const float*)(F.ws + SM_BONUS); const float* SIN = (const float*)(F.ws + WS_SIN);
    bf16_t* YC = (bf16_t*)(F.ws + WS_YCAT); const bf16_t* SS = (const bf16_t*)(F.ws + WS_Y);
    for (int item = F.gw; item < 2048; item += F.ngw) {
        const int bh = item >> 7, chunk = item & 127, b = bh >> 3, hh = bh & 7;
        const unsigned char* outp = F.ws + WS_PROJ + (size_t)item * S1_OUT_STRIDE;
        const bf16_t* RH = (const bf16_t*)(outp + O_RH); const float* Y0 = (const float*)(outp + O_Y0);
        f32x16 c[2][2];
        mm64_acc<false>(RH, SS + (size_t)item * 4096, nullptr, nullptr, c[0][0], c[0][1], c[1][0], c[1][1], lane);
#pragma unroll
        for (int mi = 0; mi < 2; ++mi) {
            const int i = 32 * mi + r, t = chunk * 64 + i, m = b * TT + t;
            float s1 = 0.f;
#pragma unroll
            for (int ni = 0; ni < 2; ++ni)
#pragma unroll
                for (int g = 0; g < 4; ++g) { const f32x4 y0 = *(const f32x4*)(Y0 + i * 64 + 32 * ni + 8 * g + 4 * hf);
#pragma unroll
                    for (int q = 0; q < 4; ++q) { c[mi][ni][4 * g + q] += y0[q]; s1 += c[mi][ni][4 * g + q]; } }
            s1 += __shfl_xor(s1, 32); const float mean = s1 * (1.f / 64.f); float s2 = 0.f;
#pragma unroll
            for (int ni = 0; ni < 2; ++ni)
#pragma unroll
                for (int q = 0; q < 16; ++q) { const float d = c[mi][ni][q] - mean; c[mi][ni][q] = d; s2 += d * d; }
            s2 += __shfl_xor(s2, 32); const float rstd = rsqrtf(s2 * (1.f / 64.f) + GN_EPS); const float bon = BON[m * 8 + hh];
            const float* vrow = SIN + ((size_t)bh * TT + t) * 384 + 320;
#pragma unroll
            for (int ni = 0; ni < 2; ++ni)
#pragma unroll
                for (int g = 0; g < 4; ++g) { const int vv = 32 * ni + 8 * g + 4 * hf, ch = hh * 64 + vv;
                    const f32x4 lg = *(const f32x4*)(ln_g + ch), lb = *(const f32x4*)(ln_b + ch), v1 = *(const f32x4*)(vrow + vv), gt = *(const f32x4*)(GATE + (size_t)m * 512 + ch); f32x4 o;
#pragma unroll
                    for (int q = 0; q < 4; ++q) o[q] = (c[mi][ni][4 * g + q] * rstd * lg[q] + lb[q] + bon * v1[q]) * gt[q];
                    *(u32x2*)(YC + (size_t)m * 1024 + ch) = pk4(o); }
        }
    }
}

__device__ __forceinline__ size_t score_row_off(int b, int t) { const int j = t >> 7; return (size_t)b * SCORE_PER_BATCH + (size_t)16384 * (j * (j + 1) / 2) + (size_t)(t & 127) * (128 * (j + 1)); }
__device__ __forceinline__ void ph_idx_score(Frame& F) {
    PHASE_PIN(F);
    const int lane = F.lane, r = lane & 31, h = lane >> 5;
    const bf16_t* QI = (const bf16_t*)(F.ws + WS_QI); const bf16_t* KI = (const bf16_t*)(F.ws + WS_KI); const unsigned* SGN = (const unsigned*)(F.ws + SM_SGN);
    float* SC = (float*)(F.ws + WS_SCORE);
    if (F.wave < 4) return;
    for (int it = blockIdx.x * 4 + (F.wave - 4); it < 4352; it += gridDim.x * 4) {
        const int b = it / 2176; int i = it - b * 2176; i = 2175 - i;
        int a = 1; while (8 * a * (a + 1) <= i) ++a;
        const int rem = i - 8 * a * (a - 1), qt = 16 * (a - 1) + rem / a, g = rem % a;
        const int mq = b * TT + qt * 32 + r;
        bf16x8 qf[8][4];
#pragma unroll
        for (int hh = 0; hh < 8; ++hh)
#pragma unroll
            for (int ks = 0; ks < 4; ++ks) qf[hh][ks] = *(const bf16x8*)(QI + (size_t)mq * 512 + hh * 64 + ks * 16 + 8 * h);
        const unsigned sg = SGN[mq];
        float* srow = SC + score_row_off(b, qt * 32 + r);
        const int kt_end = (16 * g + 15 < qt) ? 16 * g + 15 : qt;
        for (int kt = 16 * g; kt <= kt_end; ++kt) {
            const bf16_t* kp = KI + (size_t)(b * TT + kt * 32 + r) * 64 + 8 * h;
            const bf16x8 kf0 = *(const bf16x8*)(kp), kf1 = *(const bf16x8*)(kp + 16), kf2 = *(const bf16x8*)(kp + 32), kf3 = *(const bf16x8*)(kp + 48);
            float sc[16];
#pragma unroll
            for (int q = 0; q < 16; ++q) sc[q] = 0.f;
#pragma unroll
            for (int hh = 0; hh < 8; ++hh) {
                f32x16 acc;
#pragma unroll
                for (int q = 0; q < 16; ++q) acc[q] = 0.f;
                acc = MFMA32(kf0, qf[hh][0], acc); acc = MFMA32(kf1, qf[hh][1], acc); acc = MFMA32(kf2, qf[hh][2], acc); acc = MFMA32(kf3, qf[hh][3], acc);
                const bool neg = (sg >> hh) & 1u;
#pragma unroll
                for (int q = 0; q < 16; ++q) { const float v = fmaxf(acc[q], 0.f); sc[q] = neg ? sc[q] - v : sc[q] + v; }
            }
#pragma unroll
            for (int g4 = 0; g4 < 4; ++g4) *(f32x4*)(srow + kt * 32 + 8 * g4 + 4 * h) = (f32x4){sc[4 * g4], sc[4 * g4 + 1], sc[4 * g4 + 2], sc[4 * g4 + 3]};
        }
    }
}
__device__ __forceinline__ unsigned block_excl_scan(unsigned v, LAS unsigned* scr, int tid, unsigned* total) {
    const int lane = tid & 63, w = tid >> 6; unsigned x = v;
#pragma unroll
    for (int o = 1; o < 64; o <<= 1) { const unsigned y = __shfl_up(x, o); if (lane >= o) x += y; }
    __syncthreads();
    if (lane == 63) scr[w] = x;
    __syncthreads();
    unsigned base = 0, tot = 0;
#pragma unroll
    for (int j = 0; j < 8; ++j) { const unsigned c = scr[j]; if (j < w) base += c; tot += c; }
    *total = tot;
    return base + x - v;
}
__device__ __forceinline__ void ph_idx_select(Frame& F) {
    PHASE_PIN(F);
    const int lane = F.lane;
    LAS unsigned* hist = (LAS unsigned*)(F.lds + F.wave * LDS_WSCR);
    LAS float* cval = (LAS float*)(hist + 2048); LAS int* cidx = (LAS int*)(cval + 1024);
    const float* SC = (const float*)(F.ws + WS_SCORE); int* SEL = (int*)(F.ws + WS_SEL);
    const unsigned long long lt_mask = (1ull << lane) - 1ull;
    if (F.wave == 0 && blockIdx.x < 32) return;
    const int nsel = F.ngw - 32, wsel = (blockIdx.x < 32) ? blockIdx.x * 7 + F.wave - 1 : 224 + (blockIdx.x - 32) * 8 + F.wave;
    for (int m = wsel; m < NT; m += nsel) {
        const int t = m & (TT - 1), b = m >> 13, n = t + 1; int* sel = SEL + (size_t)m * 256;
        if (n <= 256) {
#pragma unroll
            for (int i = 0; i < 4; ++i) sel[lane + 64 * i] = (lane + 64 * i < n) ? lane + 64 * i : -1;
            continue; }
        const float* srow = SC + score_row_off(b, t);
        const int nch = (n + 255) >> 8;
        float lo = INFINITY, hi = -INFINITY;
        { const f32x4 v = *(const f32x4*)(srow + 4 * lane);
#pragma unroll
          for (int i = 0; i < 4; ++i) { lo = fminf(lo, v[i]); hi = fmaxf(hi, v[i]); } }
#pragma unroll
        for (int o = 1; o < 64; o <<= 1) { lo = fminf(lo, __shfl_xor(lo, o)); hi = fmaxf(hi, __shfl_xor(hi, o)); }
        if (!(hi > lo)) { lo -= 1.0f; hi += 1.0f; }
        unsigned need = 256u, outpos = 0u;
        for (int level = 0; level < 8; ++level) {
            const bool l0 = (level == 0);
            if (!(hi > lo)) {
                for (int c = 0; c < nch && need > 0u; ++c) { const int idx0 = 256 * c + 4 * lane; f32x4 v = (f32x4){0.f, 0.f, 0.f, 0.f}; if (idx0 < n) v = *(const f32x4*)(srow + idx0);
                    bool f[4]; unsigned before = 0, mine = 0;
#pragma unroll
                    for (int i = 0; i < 4; ++i) { f[i] = (idx0 + i < n) && v[i] == lo; before += __popcll(__ballot(f[i]) & lt_mask); }
                    unsigned total = 0;
#pragma unroll
                    for (int i = 0; i < 4; ++i) total += __popcll(__ballot(f[i]));
#pragma unroll
                    for (int i = 0; i < 4; ++i) { if (f[i]) { const unsigned p = before + mine; if (p < need) sel[outpos + p] = idx0 + i; ++mine; } }
                    const unsigned took = total < need ? total : need; outpos += took; need -= took; }
                break;
            }
            const float scale = 2047.0f / (hi - lo);
#pragma unroll
            for (int i = 0; i < 8; ++i) *(LAS u32x4*)(hist + 4 * (lane + 64 * i)) = (u32x4){0u, 0u, 0u, 0u};
            LDS_WAIT(); asm volatile("" ::: "memory");
            for (int c0 = 0; c0 < nch; c0 += 4) {
                f32x4 vv[4];
#pragma unroll
                for (int u = 0; u < 4; ++u) { const int idx0 = 256 * (c0 + u) + 4 * lane; vv[u] = (f32x4){0.f, 0.f, 0.f, 0.f}; if (idx0 < n) vv[u] = *(const f32x4*)(srow + idx0); }
#pragma unroll
                for (int u = 0; u < 4; ++u) { const int idx0 = 256 * (c0 + u) + 4 * lane; const f32x4 v = vv[u];
#pragma unroll
                    for (int i = 0; i < 4; ++i) if (idx0 + i < n && (l0 || (v[i] >= lo && v[i] <= hi))) { int bq = (int)((v[i] - lo) * scale); bq = bq < 0 ? 0 : (bq > 2047 ? 2047 : bq);
                        __hip_atomic_fetch_add(&hist[bq], 1u, __ATOMIC_RELAXED, __HIP_MEMORY_SCOPE_WORKGROUP); } } }
            LDS_WAIT(); asm volatile("" ::: "memory");
            unsigned hv[32], L = 0;
#pragma unroll
            for (int i = 0; i < 8; ++i) { const u32x4 h4 = *(const LAS u32x4*)(hist + 2044 - 32 * lane - 4 * i); hv[4 * i] = h4.w; hv[4 * i + 1] = h4.z; hv[4 * i + 2] = h4.y; hv[4 * i + 3] = h4.x; L += h4.x + h4.y + h4.z + h4.w; }
            unsigned xs = L;
#pragma unroll
            for (int o = 1; o < 64; o <<= 1) { const unsigned y = __shfl_up(xs, o); if (lane >= o) xs += y; }
            unsigned run = xs - L; const bool finder = (run < need && need <= run + L);
            int fb = 0; unsigned fneed = 0, fcnt = 0;
#pragma unroll
            for (int i = 0; i < 32; ++i) { if (run < need && need <= run + hv[i]) { fb = 2047 - 32 * lane - i; fneed = need - run; fcnt = hv[i]; } run += hv[i]; }
            const int fl = __ffsll((long long)__ballot(finder)) - 1;
            const int bstar = __shfl(fb, fl); const unsigned need2 = __shfl(fneed, fl), cnum = __shfl(fcnt, fl);
            const bool listed = cnum <= 1024u;
            float lo2 = INFINITY, hi2 = -INFINITY; unsigned cpos = 0;
            for (int c0 = 0; c0 < nch; c0 += 4) {
              f32x4 vv[4];
#pragma unroll
              for (int u = 0; u < 4; ++u) { const int idx0 = 256 * (c0 + u) + 4 * lane; vv[u] = (f32x4){0.f, 0.f, 0.f, 0.f}; if (idx0 < n) vv[u] = *(const f32x4*)(srow + idx0); }
#pragma unroll
              for (int u = 0; u < 4; ++u) { const int idx0 = 256 * (c0 + u) + 4 * lane; const f32x4 v = vv[u];
                bool fg[4], fe[4]; unsigned bg = 0, be = 0, tg = 0, te = 0;
#pragma unroll
                for (int i = 0; i < 4; ++i) { const bool act = (idx0 + i < n) && (l0 || (v[i] >= lo && v[i] <= hi)); int bq = (int)((v[i] - lo) * scale); bq = bq < 0 ? 0 : (bq > 2047 ? 2047 : bq);
                    fg[i] = act && bq > bstar; fe[i] = act && bq == bstar;
                    const unsigned long long mg = __ballot(fg[i]), me = __ballot(fe[i]); bg += __popcll(mg & lt_mask); be += __popcll(me & lt_mask); tg += __popcll(mg); te += __popcll(me); }
                unsigned mg2 = 0, me2 = 0;
#pragma unroll
                for (int i = 0; i < 4; ++i) {
                    if (fg[i]) { sel[outpos + bg + mg2] = idx0 + i; ++mg2; }
                    if (fe[i]) { lo2 = fminf(lo2, v[i]); hi2 = fmaxf(hi2, v[i]); if (listed) { cval[cpos + be + me2] = v[i]; cidx[cpos + be + me2] = idx0 + i; } ++me2; } }
                outpos += tg; cpos += te; } }
            need = need2;
            if (listed) {
                LDS_WAIT(); asm volatile("" ::: "memory");
                for (unsigned i = lane; i < cnum; i += 64) { const float vi = cval[i]; const int ii = cidx[i]; unsigned rank = 0;
                    for (unsigned j = 0; j < cnum; ++j) { const float vj = cval[j]; rank += (vj > vi || (vj == vi && cidx[j] < ii)) ? 1u : 0u; }
                    if (rank < need) sel[outpos + rank] = ii; }
                LDS_WAIT(); asm volatile("" ::: "memory");
                break;
            }
#pragma unroll
            for (int o = 1; o < 64; o <<= 1) { lo2 = fminf(lo2, __shfl_xor(lo2, o)); hi2 = fmaxf(hi2, __shfl_xor(hi2, o)); }
            lo = lo2; hi = hi2;
        }
    }
}

#define MFMA16(a, b, c) __builtin_amdgcn_mfma_f32_16x16x32_bf16((a), (b), (c), 0, 0, 0)
__device__ __forceinline__ void ph_sparse(Frame& F, int e) {
    PHASE_PIN(F);
    const int lane = F.lane, hd = lane & 15, gq = lane >> 4; unsigned char* ws = F.ws;
    LAS unsigned char* Tl = F.lds + F.wave * LDS_WSCR;
    const bf16_t* QA = (const bf16_t*)(ws + WS_QA); bf16_t* CTXo = (bf16_t*)(ws + WS_XB);   const bf16_t* CN = (const bf16_t*)(ws + WS_CN); const int* SEL = (const int*)(ws + WS_SEL);
    for (int m = F.gw; m < NT; m += F.ngw) {
        const int t = m & (TT - 1), b = m >> 13; const int nvalid = (t + 1 < 256) ? t + 1 : 256;
        bf16x8 qf[4];
#pragma unroll
        for (int ks = 0; ks < 4; ++ks) { u32x4 z = (u32x4){0u, 0u, 0u, 0u}; if (hd < 8) z = *(const u32x4*)(QA + (size_t)m * 1024 + hd * 128 + 32 * ks + 8 * gq); qf[ks] = __builtin_bit_cast(bf16x8, z); }
        f32x4 ctx[8];
#pragma unroll
        for (int i = 0; i < 8; ++i) ctx[i] = (f32x4){0.f, 0.f, 0.f, 0.f};
        float mrun = -INFINITY, lsum = 0.f;
        const bf16_t* cbase = CN + (size_t)b * TT * 128;
#pragma unroll 1
        for (int c = 0; c < 4; ++c) {
            if (64 * c >= nvalid) break;
            int sjc = SEL[(size_t)m * 256 + 64 * c + lane]; if (sjc < 0) sjc = 0;
            bf16x8 pc[4][4];
#pragma unroll
            for (int kt = 0; kt < 4; ++kt) { const int s = __shfl(sjc, 16 * kt + hd); const bf16_t* row = cbase + (size_t)s * 128 + 8 * gq;
#pragma unroll
                for (int ks = 0; ks < 4; ++ks) pc[kt][ks] = *(const bf16x8*)(row + 32 * ks); }
            f32x4 d[4];
#pragma unroll
            for (int kt = 0; kt < 4; ++kt) { f32x4 a = (f32x4){0.f, 0.f, 0.f, 0.f};
#pragma unroll
                for (int ks = 0; ks < 4; ++ks) a = MFMA16(pc[kt][ks], qf[ks], a);
#pragma unroll
                for (int q = 0; q < 4; ++q) { const int kidx = 64 * c + 16 * kt + 4 * gq + q; d[kt][q] = (kidx < nvalid) ? a[q] * (0.125f * LOG2E) : -INFINITY; } }
            { LAS unsigned char* wb = Tl + (hd >> 2) * 1024 + (hd & 3) * 2 + gq * 64;
#pragma unroll
              for (int kt = 0; kt < 4; ++kt)
#pragma unroll
                for (int ks = 0; ks < 4; ++ks)
#pragma unroll
                    for (int el = 0; el < 8; ++el) *(LAS bf16_t*)(wb + 4 * kt * 1024 + (32 * ks + el) * 8) = (bf16_t)pc[kt][ks][el]; }
            float mx = fmaxf(fmaxf(fmaxf(d[0][0], d[0][1]), fmaxf(d[0][2], d[0][3])), fmaxf(fmaxf(d[1][0], d[1][1]), fmaxf(d[1][2], d[1][3])));
            mx = fmaxf(mx, fmaxf(fmaxf(fmaxf(d[2][0], d[2][1]), fmaxf(d[2][2], d[2][3])), fmaxf(fmaxf(d[3][0], d[3][1]), fmaxf(d[3][2], d[3][3]))));
            mx = fmaxf(mx, __shfl_xor(mx, 16)); mx = fmaxf(mx, __shfl_xor(mx, 32));
            const float mnew = fmaxf(mrun, mx); const float scale = __builtin_amdgcn_exp2f(mrun - mnew); mrun = mnew;
            float psum = 0.f;
#pragma unroll
            for (int kt = 0; kt < 4; ++kt)
#pragma unroll
                for (int q = 0; q < 4; ++q) { d[kt][q] = __builtin_amdgcn_exp2f(d[kt][q] - mnew); psum += d[kt][q]; }
            lsum = lsum * scale + psum;
#pragma unroll
            for (int i = 0; i < 8; ++i) ctx[i] *= scale;
#pragma unroll
            for (int u = 0; u < 2; ++u) {
                u32x4 pw; pw.x = pk2(d[2 * u][0], d[2 * u][1]); pw.y = pk2(d[2 * u][2], d[2 * u][3]); pw.z = pk2(d[2 * u + 1][0], d[2 * u + 1][1]); pw.w = pk2(d[2 * u + 1][2], d[2 * u + 1][3]);
                const bf16x8 pf = __builtin_bit_cast(bf16x8, pw);
#pragma unroll
                for (int mt = 0; mt < 8; ++mt) { const LAS unsigned char* rb = Tl + gq * 1024 + hd * 8;
                    const u32x2 lo = *(const LAS u32x2*)(rb + (8 * u) * 1024 + 16 * mt * 8);
                    const u32x2 hi = *(const LAS u32x2*)(rb + (8 * u + 4) * 1024 + 16 * mt * 8);
                    u32x4 aw; aw.x = lo.x; aw.y = lo.y; aw.z = hi.x; aw.w = hi.y;
                    ctx[mt] = MFMA16(__builtin_bit_cast(bf16x8, aw), pf, ctx[mt]); }
            }
        }
        lsum += __shfl_xor(lsum, 16); lsum += __shfl_xor(lsum, 32);
        const float inv = 1.0f / lsum;
        if (hd < 8) {
#pragma unroll
            for (int mt = 0; mt < 8; ++mt) { u32x2 w; w.x = pk2(ctx[mt][0] * inv, ctx[mt][1] * inv); w.y = pk2(ctx[mt][2] * inv, ctx[mt][3] * inv);
                *(u32x2*)(CTXo + (size_t)m * 1024 + hd * 128 + 16 * mt + 4 * gq) = w; }
        }
    }
}
__device__ __forceinline__ void ph_mix_finish(Frame& F, int e) {
    PHASE_PIN(F);
    const int lane = F.lane; unsigned char* ws = F.ws;
    bf16_t* YC = (bf16_t*)(ws + WS_YCAT);
    const float* ln_g = F.ka->in[17] + e * 512; const float* ln_b = F.ka->in[18] + e * 512;
    const float* Yr = (const float*)(ws + WS_Y); const float* GATE = (const float*)(ws + WS_GATE); const float* BON = (const float*)(ws + SM_BONUS); const float* SIN = (const float*)(ws + WS_SIN);
#if !CHUNKED
    for (int m = F.gw; m < NT; m += F.ngw) {
        const int t = m & (TT - 1), b = m >> 13;
#pragma unroll 1
        for (int hh = 0; hh < 8; ++hh) {
            const int ch = hh * 64 + lane; const float y = Yr[(size_t)m * 512 + ch];
            const float mean = wave_sum(y) * (1.f / 64.f); const float yc = y - mean; const float var = wave_sum(yc * yc) * (1.f / 64.f);
            const float v1 = SIN[((size_t)(b * 8 + hh) * TT + t) * 384 + 320 + lane];
            const float o = (yc * rsqrtf(var + GN_EPS) * ln_g[ch] + ln_b[ch] + BON[m * 8 + hh] * v1) * GATE[(size_t)m * 512 + ch];
            YC[(size_t)m * 1024 + ch] = (bf16_t)f2bf(o);
        }
    }
#endif
    { const bf16_t* CTX = (const bf16_t*)(ws + WS_XB); const bf16_t* WvT = (const bf16_t*)(ws + W_WVT) + (size_t)e * 512 * 128;
      for (int tI = F.gw; tI < (NT / 64) * 8; tI += F.ngw) {
          const int hh = tI & 7, mt = tI >> 3;
          EpiStoreBf16 E{YC + 512 + hh * 64, 1024, 0, 32};
          sg_tile(CTX + hh * 128, 1024, WvT + (size_t)(hh * 64) * 128, WvT + (size_t)(hh * 64 + 32) * 128, 128, 128, mt * 64, E, F.lane);
      } }
}

__device__ __forceinline__ void ph_stickbreak(Frame& F) {
    PHASE_PIN(F);
    const int lane = F.lane, r = lane & 31, hf = lane >> 5; unsigned char* ws = F.ws;
    const bf16_t* Q = (const bf16_t*)(ws + WS_PROJ); const bf16_t* Kb = Q + (size_t)NT * 1024; const bf16_t* Vb = Kb + (size_t)NT * 1024;
    bf16_t* YC = (bf16_t*)(ws + WS_YCAT);
    for (int it = F.gw; it < NB * 16 * 256; it += F.ngw) {
        const int qt = it & 255, hh = (it >> 8) & 15, b = it >> 12;
        const int mq = b * TT + qt * 32 + r;
        bf16x8 qf[4];
#pragma unroll
        for (int ks = 0; ks < 4; ++ks) qf[ks] = *(const bf16x8*)(Q + (size_t)mq * 1024 + hh * 64 + ks * 16 + 8 * hf);
        f32x16 o0, o1;
#pragma unroll
        for (int i = 0; i < 16; ++i) { o0[i] = 0.f; o1[i] = 0.f; }
        float P = 1.0f;
        for (int kt = qt; kt >= 0; --kt) {
            const bf16_t* kp = Kb + (size_t)(b * TT + kt * 32 + r) * 1024 + hh * 64 + 8 * hf;
            const bf16x8 kf0 = *(const bf16x8*)(kp), kf1 = *(const bf16x8*)(kp + 16), kf2 = *(const bf16x8*)(kp + 32), kf3 = *(const bf16x8*)(kp + 48);
            const bf16_t* vp = Vb + (size_t)(b * TT + kt * 32 + 4 * hf) * 1024 + hh * 64 + r;
            bf16x8 vf[2][2];
#pragma unroll
            for (int s2 = 0; s2 < 2; ++s2)
#pragma unroll
                for (int j = 0; j < 8; ++j) { const size_t ko = (size_t)(16 * s2 + 8 * (j >> 2) + (j & 3)) * 1024; vf[0][s2][j] = (short)vp[ko]; vf[1][s2][j] = (short)vp[ko + 32]; }
            f32x16 acc;
#pragma unroll
            for (int i = 0; i < 16; ++i) acc[i] = 0.f;
            acc = MFMA32(kf0, qf[0], acc); acc = MFMA32(kf1, qf[1], acc); acc = MFMA32(kf2, qf[2], acc); acc = MFMA32(kf3, qf[3], acc);
            float kp_[16], be[16];
            const bool diag = (kt == qt);
#pragma unroll
            for (int q = 0; q < 16; ++q) {
                const int key = 8 * (q >> 2) + 4 * hf + (q & 3);
                const float e = __builtin_amdgcn_exp2f(acc[q]); float keep = __builtin_amdgcn_rcpf(1.0f + e);
                if (diag && key >= r) keep = 1.0f;
                kp_[q] = keep; be[q] = 1.0f - keep;
            }
            float ls[16], tot[4], oth[4];
#pragma unroll
            for (int g = 0; g < 4; ++g) { ls[4 * g + 3] = 1.0f; ls[4 * g + 2] = kp_[4 * g + 3]; ls[4 * g + 1] = ls[4 * g + 2] * kp_[4 * g + 2]; ls[4 * g] = ls[4 * g + 1] * kp_[4 * g + 1]; tot[g] = ls[4 * g] * kp_[4 * g]; }
#pragma unroll
            for (int g = 0; g < 4; ++g) oth[g] = __shfl_xor(tot[g], 32);
            const float G0 = tot[0] * oth[0], G1 = tot[1] * oth[1], G2 = tot[2] * oth[2], G3 = tot[3] * oth[3];
            float E[4]; E[3] = 1.0f; E[2] = G3; E[1] = G3 * G2; E[0] = E[1] * G1;
            float w[16];
#pragma unroll
            for (int g = 0; g < 4; ++g) { const float mg = E[g] * (hf == 0 ? oth[g] : 1.0f) * P;
#pragma unroll
                for (int j = 0; j < 4; ++j) w[4 * g + j] = be[4 * g + j] * ls[4 * g + j] * mg; }
            P *= E[0] * G0;
            u32x4 w0, w1;
            w0.x = pk2(w[0], w[1]); w0.y = pk2(w[2], w[3]); w0.z = pk2(w[4], w[5]); w0.w = pk2(w[6], w[7]);
            w1.x = pk2(w[8], w[9]); w1.y = pk2(w[10], w[11]); w1.z = pk2(w[12], w[13]); w1.w = pk2(w[14], w[15]);
            const bf16x8 wf0 = __builtin_bit_cast(bf16x8, w0), wf1 = __builtin_bit_cast(bf16x8, w1);
            o0 = MFMA32(vf[0][0], wf0, o0); o0 = MFMA32(vf[0][1], wf1, o0);
            o1 = MFMA32(vf[1][0], wf0, o1); o1 = MFMA32(vf[1][1], wf1, o1);
            if (__ballot(P > 1e-30f) == 0ull) break;
        }
        bf16_t* op = YC + (size_t)mq * 1024 + hh * 64 + 4 * hf;
#pragma unroll
        for (int g = 0; g < 4; ++g) {
            u32x2 a; a.x = pk2(o0[4 * g], o0[4 * g + 1]); a.y = pk2(o0[4 * g + 2], o0[4 * g + 3]); *(u32x2*)(op + 8 * g) = a;
            u32x2 c; c.x = pk2(o1[4 * g], o1[4 * g + 1]); c.y = pk2(o1[4 * g + 2], o1[4 * g + 3]); *(u32x2*)(op + 32 + 8 * g) = c;
        }
    }
}

__device__ __forceinline__ void ph_moe_route(Frame& F, const Args& A, int l, bool claim) {
    PHASE_PIN(F);
    const int lane = F.lane; unsigned char* ws = F.ws;
    const float* X = (const float*)(ws + WS_X); bf16_t* XB = (bf16_t*)(ws + WS_XB);
    const float* g = F.ka->in[29] + l * DM; const float* Wg = F.ka->in[30] + (size_t)l * DM * 4; const float* We = F.ka->in[31] + (size_t)l * 4 * DM * 8;
    int* EIDX = (int*)(ws + SM_EIDX); float* GATEV = (float*)(ws + SM_GATE); int* SLOT = (int*)(ws + SM_SLOT);
    unsigned* cnt = (unsigned*)(ws + WS_CTL) + CW_CNT + 2048 * l;
    for (int m = F.gw; m < NT; m += F.ngw) {
        const f32x4* xr = (const f32x4*)(X + (size_t)m * DM) + lane; f32x4 v[4]; float s = 0.f;
#pragma unroll
        for (int j = 0; j < 4; ++j) { v[j] = xr[64 * j]; s += (v[j].x * v[j].x + v[j].y * v[j].y) + (v[j].z * v[j].z + v[j].w * v[j].w); }
        const float rstd = rsqrtf(wave_sum(s) * (1.f / DM) + RMS_EPS);
        u32x2* o8 = (u32x2*)(XB + (size_t)m * DM) + lane;
#pragma unroll
        for (int j = 0; j < 4; ++j) { u32x2 w; w.x = pk2(v[j].x * rstd, v[j].y * rstd); w.y = pk2(v[j].z * rstd, v[j].w * rstd); o8[64 * j] = w; }
#pragma unroll
        for (int j = 0; j < 4; ++j) { const f32x4 gg = *((const f32x4*)g + lane + 64 * j); v[j] = v[j] * gg * rstd; }
        float gl[4] = {0.f, 0.f, 0.f, 0.f};
#pragma unroll
        for (int j = 0; j < 4; ++j)
#pragma unroll
            for (int i = 0; i < 4; ++i) { const int k = 4 * (lane + 64 * j) + i; const f32x4 w = *(const f32x4*)(Wg + (size_t)k * 4); const float xv = v[j][i];
                gl[0] += xv * w.x; gl[1] += xv * w.y; gl[2] += xv * w.z; gl[3] += xv * w.w; }
#pragma unroll
        for (int q = 0; q < 4; ++q) gl[q] = wave_sum(gl[q]);
        int gs = 0; float gm = gl[0];
#pragma unroll
        for (int q = 1; q < 4; ++q) if (gl[q] > gm) { gm = gl[q]; gs = q; }
        float gden = 0.f;
#pragma unroll
        for (int q = 0; q < 4; ++q) gden += __expf(gl[q] - gm);
        const float g_gate = 1.0f / gden;
        const float* Wes = We + (size_t)gs * DM * 8;
        float el[8];
#pragma unroll
        for (int q = 0; q < 8; ++q) el[q] = 0.f;
#pragma unroll
        for (int j = 0; j < 4; ++j)
#pragma unroll
            for (int i = 0; i < 4; ++i) { const int k = 4 * (lane + 64 * j) + i; const f32x4 w0 = *(const f32x4*)(Wes + (size_t)k * 8), w1 = *(const f32x4*)(Wes + (size_t)k * 8 + 4); const float xv = v[j][i];
                el[0] += xv * w0.x; el[1] += xv * w0.y; el[2] += xv * w0.z; el[3] += xv * w0.w; el[4] += xv * w1.x; el[5] += xv * w1.y; el[6] += xv * w1.z; el[7] += xv * w1.w; }
#pragma unroll
        for (int q = 0; q < 8; ++q) el[q] = wave_sum(el[q]);
        int i1 = 0; float m1 = el[0];
#pragma unroll
        for (int q = 1; q < 8; ++q) if (el[q] > m1) { m1 = el[q]; i1 = q; }
        int i2 = -1; float m2 = -INFINITY;
#pragma unroll
        for (int q = 0; q < 8; ++q) if (q != i1 && el[q] > m2) { m2 = el[q]; i2 = q; }
        const float e2 = __expf(m2 - m1); const float ga = g_gate / (1.0f + e2), gb = g_gate * e2 / (1.0f + e2);
        if (lane == 0 && claim) {
            const int ea = gs * 8 + i1, eb = gs * 8 + i2;
            const unsigned sa = atomicAdd(&cnt[ea * 64], 1u), sb = atomicAdd(&cnt[eb * 64], 1u);
            EIDX[2 * m] = ea; EIDX[2 * m + 1] = eb; GATEV[2 * m] = ga; GATEV[2 * m + 1] = gb; SLOT[2 * m] = (int)sa; SLOT[2 * m + 1] = (int)sb;
        }
    }
}
__device__ __forceinline__ int moe_offsets(const unsigned* cnt, int lane, int* total, int* mycnt_pad) {
    const unsigned c = lane < 32 ? __hip_atomic_load(cnt + (lane & 31) * 64, __ATOMIC_RELAXED, __HIP_MEMORY_SCOPE_AGENT) : 0u; const int p = (int)((c + 255u) & ~255u);
    int x = p;
#pragma unroll
    for (int o = 1; o < 64; o <<= 1) { const int y = __shfl_up(x, o); if (lane >= o) x += y; }
    *total = __shfl(x, 63); *mycnt_pad = p;
    return x - p;
}
__device__ __forceinline__ void ph_moe_gather(Frame& F, int l) {
    PHASE_PIN(F);
    const int lane = F.lane; unsigned char* ws = F.ws;
    const unsigned* cnt = (const unsigned*)(ws + WS_CTL) + CW_CNT + 2048 * l; int total, pad; const int off = moe_offsets(cnt, lane, &total, &pad);
    const int* EIDX = (const int*)(ws + SM_EIDX); const int* SLOT = (const int*)(ws + SM_SLOT);
    const bf16_t* XB = (const bf16_t*)(ws + WS_XB); bf16_t* AM = (bf16_t*)(ws + WS_AMOE);
    for (int a = F.gw; a < NT * 2; a += F.ngw) {
        const int m = a >> 1, e = EIDX[a], row = __shfl(off, e) + SLOT[a];
        const u32x4* src = (const u32x4*)(XB + (size_t)m * DM); u32x4* dst = (u32x4*)(AM + (size_t)row * DM);
        dst[lane] = src[lane]; dst[lane + 64] = src[lane + 64];
    }
}
__device__ __forceinline__ int moe_build_tab(Frame& F, int l) {
    LAS int* tab = (LAS int*)(F.lds + LDS_MISC + 256); LAS int* ends = (LAS int*)(F.lds + LDS_MISC + 1024);
    const unsigned* cnt = (const unsigned*)(F.ws + WS_CTL) + CW_CNT + 2048 * l; int total, pad; const int off = moe_offsets(cnt, F.lane, &total, &pad);
    __syncthreads();
    if (F.tid < 32) ends[F.tid] = off + pad;
    __syncthreads();
    for (int rt = F.tid; rt < total / 256; rt += NTHR) { int e = 0; for (int q = 0; q < 32; ++q) e += (ends[q] <= rt * 256) ? 1 : 0; tab[rt] = e; }
    __syncthreads();
    return total;
}
__device__ __forceinline__ void ph_moe_gemm1(Frame& F, int l) {
    PHASE_PIN(F);
    const int total = moe_build_tab(F, l);
    pg8::Gemm g{(const pg8::bf16_t*)(F.ws + WS_AMOE), (const pg8::bf16_t*)(F.ws + WS_W13T), total, 32 * 1024, DM};
    pg8::MoeOrder S{(total / 256) * 4, (int)gridDim.x, (int)blockIdx.x, (const LAS int*)(F.lds + LDS_MISC + 256)};
    pg8::EpiGate E{(pg8::bf16_t*)(F.ws + WS_H)};
    pg8::gemm_phase<pg8::EpiGate, pg8::MoeOrder>(F.lds, g, S, E, nullptr, F.wave);
}
__device__ __forceinline__ void ph_moe_gemm2(Frame& F, int l) {
    PHASE_PIN(F);
    const int total = moe_build_tab(F, l);
    pg8::Gemm g{(const pg8::bf16_t*)(F.ws + WS_H), (const pg8::bf16_t*)(F.ws + WS_W2T), total, 32 * 1024, 512};
    pg8::MoeOrder S{(total / 256) * 4, (int)gridDim.x, (int)blockIdx.x, (const LAS int*)(F.lds + LDS_MISC + 256)};
    pg8::EpiMoeDown E{(pg8::bf16_t*)(F.ws + WS_YM)};
    pg8::gemm_phase<pg8::EpiMoeDown, pg8::MoeOrder>(F.lds, g, S, E, nullptr, F.wave);
}
__device__ __forceinline__ void ph_moe_combine(Frame& F, const Args& A, int l, bool wr) {
    PHASE_PIN(F);
    const int lane = F.lane; unsigned char* ws = F.ws;
    const unsigned* cnt = (const unsigned*)(ws + WS_CTL) + CW_CNT + 2048 * l; int total, pad; const int off = moe_offsets(cnt, lane, &total, &pad);
    const int* EIDX = (const int*)(ws + SM_EIDX); const int* SLOT = (const int*)(ws + SM_SLOT); const float* GATEV = (const float*)(ws + SM_GATE);
    float* X = (float*)(ws + WS_X); bf16_t* XB = (bf16_t*)(ws + WS_XB); const bf16_t* YM = (const bf16_t*)(ws + WS_YM);
    const float* fg = F.ka->in[35];
    for (int m = F.gw; m < NT; m += F.ngw) {
        const int ea = EIDX[2 * m], eb = EIDX[2 * m + 1]; const float ga = GATEV[2 * m], gb = GATEV[2 * m + 1];
        const int ra = __shfl(off, ea) + SLOT[2 * m], rb = __shfl(off, eb) + SLOT[2 * m + 1];
        f32x4* xr = (f32x4*)(X + (size_t)m * DM) + lane; const u32x2* ya = (const u32x2*)(YM + (size_t)ra * DM) + lane; const u32x2* yb = (const u32x2*)(YM + (size_t)rb * DM) + lane;
        f32x4 v[4]; float s = 0.f;
#pragma unroll
        for (int j = 0; j < 4; ++j) { v[j] = xr[64 * j]; const u32x2 a = ya[64 * j], bq = yb[64 * j];
            v[j].x += ga * __uint_as_float(a.x << 16) + gb * __uint_as_float(bq.x << 16); v[j].y += ga * __uint_as_float(a.x & 0xffff0000u) + gb * __uint_as_float(bq.x & 0xffff0000u);
            v[j].z += ga * __uint_as_float(a.y << 16) + gb * __uint_as_float(bq.y << 16); v[j].w += ga * __uint_as_float(a.y & 0xffff0000u) + gb * __uint_as_float(bq.y & 0xffff0000u);
            s += (v[j].x * v[j].x + v[j].y * v[j].y) + (v[j].z * v[j].z + v[j].w * v[j].w); }
        const float rstd = rsqrtf(wave_sum(s) * (1.f / DM) + RMS_EPS);
        if (l < 3) {
            u32x2* o8 = (u32x2*)(XB + (size_t)m * DM) + lane;
#pragma unroll
            for (int j = 0; j < 4; ++j) { if (wr) xr[64 * j] = v[j]; u32x2 w; w.x = pk2(v[j].x * rstd, v[j].y * rstd); w.y = pk2(v[j].z * rstd, v[j].w * rstd); o8[64 * j] = w; }
        } else {
            f32x4* orow = (f32x4*)(F.out + (size_t)m * DM) + lane;
#pragma unroll
            for (int j = 0; j < 4; ++j) { const f32x4 gg = *((const f32x4*)fg + lane + 64 * j); orow[64 * j] = v[j] * gg * rstd; }
        }
    }
}

__global__ void __launch_bounds__(NTHR, 2) fwd_kernel(Args args) {
    extern __shared__ __attribute__((aligned(16))) unsigned char lds_raw[];
    Frame F; F.lds = (LAS unsigned char*)lds_raw; F.tid = threadIdx.x; F.lane = F.tid & 63; F.wave = __builtin_amdgcn_readfirstlane(F.tid >> 6);
    F.gw = blockIdx.x * NWAVES + F.wave; F.ngw = gridDim.x * NWAVES; F.out = args.out; F.ws = args.ws; F.ka = (const __attribute__((address_space(4))) Args*)__builtin_amdgcn_kernarg_segment_ptr();
    volatile LAS unsigned* MISC = (volatile LAS unsigned*)(F.lds + LDS_MISC);
    if (F.tid < 64) MISC[F.tid] = 0u;
    __syncthreads();
    const int lo = args.ph_lo, hi = args.ph_hi;
    XcdBarrier bar; bar.bar = (unsigned*)(F.ws + WS_CTL) + CW_BAR; bar.x = 0; bar.st = MISC;
    if (hi - lo > 1) bar = xcd_barrier_post((unsigned*)(F.ws + WS_CTL) + CW_BAR, MISC, F.tid == 0);
#define IN(k) (lo <= (k) && (k) < hi)
#define DUP(k) for (int _rep = 0; _rep < ((DUP_PHASE == (k)) ? 2 : 1); ++_rep)
#define SEAM(k) do { if ((k) + 1 < hi) { PHASE_PIN(F); xcd_barrier(bar, F.tid == 0); if (DUP_PHASE == 99) xcd_barrier(bar, F.tid == 0); } } while (0)
    unsigned char* ws = F.ws;
    if (IN(0)) { DUP(0) ph_prologue(F, args); SEAM(0); }
    for (int l = 0; l < 4; ++l) {
        const int pb = 1 + 16 * l, e = l >> 1;
        const float* xsrc = (l == 0) ? args.in[0] : (const float*)(ws + WS_X);
        if ((l & 1) == 0) {
            if (IN(pb + 0)) { PHASE_PIN(F);
                pg8::Gemm g{(const pg8::bf16_t*)(F.ws + WS_XB), (const pg8::bf16_t*)(F.ws + W_WIN) + (size_t)e * NCOL * DM, NT, NCOL, DM}; pg8::StaticOrder S; S.init(NT, NCOL, (int)gridDim.x, (int)blockIdx.x);
                pg8::EpiBf16S E{(pg8::bf16_t*)(F.ws + WS_PROJ), NCOL, 0, 0};
                DUP(11) pg8::gemm_phase<pg8::EpiBf16S, pg8::StaticOrder>(F.lds, g, S, E, nullptr, F.wave);
                SEAM(pb + 0); }
            if (IN(pb + 1)) {
#ifndef NO_PREP
 ph_prep(F, args, e, 7); if (DUP_PHASE >= 20 && DUP_PHASE < 28) ph_prep(F, args, e, DUP_PHASE - 20);
#endif
 SEAM(pb + 1); }
            if (IN(pb + 2)) { ph_scan_s1(F); ph_idx_score(F); SEAM(pb + 2); }
            if (IN(pb + 3)) { ph_scan_s2(F); ph_idx_select(F); SEAM(pb + 3); }
            if (IN(pb + 4)) { ph_scan_s3(F, e); ph_sparse(F, e); SEAM(pb + 4); }
            if (IN(pb + 6)) { DUP(13) ph_mix_finish(F, e); SEAM(pb + 6); }
        } else {
            if (IN(pb + 0)) { PHASE_PIN(F);
                pg8::Gemm g{(const pg8::bf16_t*)(F.ws + WS_XB), (const pg8::bf16_t*)(F.ws + W_WQKV) + (size_t)e * 3072 * DM, NT, 3072, DM}; pg8::StaticOrder S; S.init(NT, 3072, (int)gridDim.x, (int)blockIdx.x);
                pg8::EpiBf16S E{(pg8::bf16_t*)(F.ws + WS_PROJ), 1024, 1024, (size_t)NT * 1024};
                DUP(12) pg8::gemm_phase<pg8::EpiBf16S, pg8::StaticOrder>(F.lds, g, S, E, nullptr, F.wave);
                SEAM(pb + 0); }
            if (IN(pb + 1)) {
#ifndef NO_SB
 DUP(6) ph_stickbreak(F);
#endif
 SEAM(pb + 1); }
        }
        if (IN(pb + 7)) { PHASE_PIN(F);
            pg8::Gemm g{(const pg8::bf16_t*)(F.ws + WS_YCAT), (const pg8::bf16_t*)(F.ws + ((l & 1) ? W_WOUTO : W_WOUTE)) + (size_t)e * DM * DM, NT, DM, DM}; pg8::StaticOrder S; S.init(NT, DM, (int)gridDim.x, (int)blockIdx.x);
            pg8::EpiResid E{xsrc, (float*)(F.ws + WS_X)};
            pg8::gemm_phase<pg8::EpiResid, pg8::StaticOrder>(F.lds, g, S, E, nullptr, F.wave);
            if (DUP_PHASE == 17 && l == 0) pg8::gemm_phase<pg8::EpiResid, pg8::StaticOrder>(F.lds, g, S, E, nullptr, F.wave);
            SEAM(pb + 7); }
        if (IN(pb + 8)) {
#ifndef NO_ROUTE
 if (!(args.flags & 1)) ph_moe_route(F, args, l, true); if (!(args.flags & 2)) moe_weight_prep(F, args, l);
#endif
 SEAM(pb + 8); }
        if (IN(pb + 9)) { DUP(8) ph_moe_gather(F, l); SEAM(pb + 9); }
        if (IN(pb + 10)) { DUP(9) ph_moe_gemm1(F, l); SEAM(pb + 10); }
        if (IN(pb + 11)) { DUP(10) ph_moe_gemm2(F, l); SEAM(pb + 11); }
        if (IN(pb + 12)) { if (DUP_PHASE == 18) ph_moe_combine(F, args, l, false); ph_moe_combine(F, args, l, true); SEAM(pb + 12); }
    }
#undef IN
#undef SEAM
}

extern "C" void kernel_launch(void* const* d_in, const int* in_sizes, int n_in, void* d_out, int out_size, void* d_ws, size_t ws_size, hipStream_t stream) {
    static int grid = 0;
    if (grid == 0) {
        if (n_in != 36 || out_size != NT * DM || ws_size < WS_END) { fprintf(stderr, "kernel_launch: unexpected problem (n_in %d out %d ws %zu)\n", n_in, out_size, ws_size); grid = -1; return; }
        int dev = 0, cus = 0, per_cu = 0;
        if (hipGetDevice(&dev) != hipSuccess || hipDeviceGetAttribute(&cus, hipDeviceAttributeMultiprocessorCount, dev) != hipSuccess) { grid = -1; return; }
        if (hipFuncSetAttribute((const void*)fwd_kernel, hipFuncAttributeMaxDynamicSharedMemorySize, LDS_BYTES) != hipSuccess) { grid = -1; return; }
        if (hipOccupancyMaxActiveBlocksPerMultiprocessor(&per_cu, (const void*)fwd_kernel, NTHR, LDS_BYTES) != hipSuccess || per_cu < 1) { fprintf(stderr, "kernel_launch: occupancy query says %d\n", per_cu); }
        (void)hipGetLastError();
        grid = cus;
    }
    if (grid < 0) return;
    (void)hipMemsetAsync((char*)d_ws + WS_CTL, 0, CTL_ZERO_BYTES, stream);
    Args a{};
    for (int i = 0; i < 36; ++i) a.in[i] = (const float*)d_in[i];
    a.out = (float*)d_out; a.ws = (unsigned char*)d_ws;
#if ONE_LAUNCH
    a.ph_lo = 0; a.ph_hi = 65;
    hipLaunchKernelGGL(fwd_kernel, dim3(grid), dim3(NTHR), LDS_BYTES, stream, a);
    if (DUP_PHASE >= 100 && DUP_PHASE < 400) { a.flags = DUP_PHASE / 100 - 1; a.ph_lo = DUP_PHASE % 100; a.ph_hi = a.ph_lo + 1; a.out = (float*)((char*)d_ws + WS_SIN); hipLaunchKernelGGL(fwd_kernel, dim3(grid), dim3(NTHR), LDS_BYTES, stream, a); }
#else
    for (int p = 0; p < 65; ++p) {
        const int l = (p - 1) >> 4, k = (p - 1) & 15;
        if (p > 0) { if (k > 12) continue; if ((l & 1) && k >= 2 && k <= 6) continue; if (!(l & 1) && k == 5) continue; }
        a.ph_lo = p; a.ph_hi = p + 1;
        hipLaunchKernelGGL(fwd_kernel, dim3(grid), dim3(NTHR), LDS_BYTES, stream, a);
    }
#endif
}
```

```cpp
#include <hip/hip_runtime.h>
#include <cstdio>
#include <cstdint>

#ifndef DUP_PHASE
#define DUP_PHASE -1
#endif
#ifndef CHUNKED
#define CHUNKED 1
#endif
#ifndef ONE_LAUNCH
#define ONE_LAUNCH 1
#endif

#define GAS __attribute__((address_space(1)))
#define LAS __attribute__((address_space(3)))
typedef unsigned short bf16_t;
typedef short bf16x8 __attribute__((ext_vector_type(8)));
typedef float f32x4 __attribute__((ext_vector_type(4)));
typedef float f32x2 __attribute__((ext_vector_type(2)));
typedef float f32x16 __attribute__((ext_vector_type(16)));
typedef unsigned u32x4 __attribute__((ext_vector_type(4)));
typedef unsigned u32x2 __attribute__((ext_vector_type(2)));

constexpr int NT = 16384, TT = 8192, DM = 1024, NB = 2;
constexpr int NCOL = 3584;
constexpr int C_R = 0, C_K = 512, C_V = 1024, C_QB = 1536, C_CKV = 2048, C_QI = 2176, C_KI = 2688, C_WI = 2752;
constexpr int C_PW = 2816, C_QW = 2880, C_PA = 2944, C_QA = 3008, C_PG = 3072, C_QG = 3200, C_PV = 3328, C_QV = 3360;
constexpr int NWAVES = 8, NTHR = 512;
constexpr float RMS_EPS = 1e-6f, GN_EPS = 64e-5f;
constexpr float LOG2E = 1.4426950408889634f;

constexpr size_t MiB = 1u << 20;
constexpr size_t WS_CTL = 0, CTL_ZERO_BYTES = 1 * MiB;
constexpr size_t WS_SMALL = 1 * MiB;
constexpr size_t SM_EIDX = WS_SMALL, SM_GATE = WS_SMALL + 128 * 1024, SM_SLOT = WS_SMALL + 256 * 1024, SM_BONUS = WS_SMALL + 512 * 1024, SM_SGN = WS_SMALL + 1024 * 1024, SM_QLIN = WS_SMALL + 2 * MiB;
constexpr size_t WS_W = 5 * MiB;
constexpr size_t W_WIN = WS_W, W_WOUTE = WS_W + 14 * MiB, W_WQKV = WS_W + 18 * MiB, W_WOUTO = WS_W + 30 * MiB, W_WKB = WS_W + 34 * MiB, W_WVT = W_WKB + 256 * 1024, W_L2 = W_WKB + 512 * 1024;
constexpr size_t WS_X = 45 * MiB, WS_XB = 109 * MiB, WS_PROJ = 141 * MiB, WS_SIN = 253 * MiB, WS_VF = 445 * MiB, WS_Y = 477 * MiB, WS_GATE = 509 * MiB, WS_YCAT = 541 * MiB;
constexpr size_t WS_CN = 573 * MiB, WS_KI = 577 * MiB, WS_QI = 579 * MiB, WS_QA = 595 * MiB, WS_SEL = 627 * MiB;
constexpr size_t WS_BIG = 645 * MiB;
constexpr size_t WS_SCORE = WS_BIG;
constexpr size_t WS_W13T = WS_BIG, WS_W2T = WS_BIG + 64 * MiB, WS_AMOE = WS_BIG + 96 * MiB, WS_H = WS_BIG + 176 * MiB, WS_YM = WS_BIG + 216 * MiB;
constexpr size_t WS_S1TMP = 905 * MiB;
constexpr size_t WS_END = 1017 * MiB;
constexpr size_t SCORE_PER_BATCH = (size_t)16384 * 2080;
static_assert(WS_SCORE + 2 * SCORE_PER_BATCH * 4 <= WS_END, "score map");
static_assert(WS_YM + (size_t)40960 * 1024 * 2 <= WS_END, "moe map");
constexpr int CW_BAR = 4096;
constexpr int CW_CNT = 16384;

constexpr int LDS_BYTES = 147456;
constexpr int LDS_WSCR = 16384;
constexpr int LDS_MISC = 131072;

__device__ __forceinline__ float bf2f(bf16_t b) { return __uint_as_float(((unsigned)b) << 16); }
typedef __bf16 bf16v2_t __attribute__((ext_vector_type(2)));
__device__ __forceinline__ unsigned pk2(float lo, float hi) { const f32x2 v = {lo, hi}; const bf16v2_t b = __builtin_convertvector(v, bf16v2_t); return __builtin_bit_cast(unsigned, b); }
__device__ __forceinline__ unsigned f2bf(float f) { return pk2(f, f) & 0xffffu; }
__device__ __forceinline__ float wave_sum(float v) {
#pragma unroll
    for (int o = 1; o < 64; o <<= 1) v += __shfl_xor(v, o);
    return v;
}
__device__ __forceinline__ float wave_max(float v) {
#pragma unroll
    for (int o = 1; o < 64; o <<= 1) v = fmaxf(v, __shfl_xor(v, o));
    return v;
}
__device__ __forceinline__ float sigmoidf_(float x) { return 1.0f / (1.0f + __expf(-x)); }
#define LDS_WAIT() asm volatile("s_waitcnt lgkmcnt(0)" ::: "memory")

#define XB_TMO      128
#define XB_XCNT(j)  (256  + 64 * (j))
#define XB_XSUB(j)  (1280 + 64 * (j))
#define XB_XGEN(j)  (2304 + 64 * (j))
#define XB_TOP      3328
#define XB_TOPGEN   3392
#define XCD_BAR_WORDS 3456
#define XB_SPIN_CAP (1u << 18)
__device__ __forceinline__ unsigned xb_ld(unsigned* p)              { return __hip_atomic_load(p, __ATOMIC_RELAXED, __HIP_MEMORY_SCOPE_AGENT); }
__device__ __forceinline__ unsigned xb_add(unsigned* p, unsigned v) { return __hip_atomic_fetch_add(p, v, __ATOMIC_RELAXED, __HIP_MEMORY_SCOPE_AGENT); }
__device__ __forceinline__ unsigned xb_xcc_id() { return (unsigned)__builtin_amdgcn_s_getreg((3 << 11) | 20) & 0xFu; }
#define XB_SPIN(cond, bar) do { unsigned _sp = 0; while (cond) { __builtin_amdgcn_s_sleep(1); \
    if ((++_sp & 255u) == 0u) { if (xb_ld(&(bar)[XB_TMO])) break; if (_sp > XB_SPIN_CAP) { atomicAdd(&(bar)[XB_TMO], 1u); break; } } } } while (0)
struct XcdBarrier { unsigned* bar; unsigned x; volatile LAS unsigned* st; };
__device__ __forceinline__ XcdBarrier xcd_barrier_post(unsigned* bar, volatile LAS unsigned* st, bool t0) {
    XcdBarrier b; b.bar = bar; b.x = xb_xcc_id(); b.st = st;
    if (t0) (void)xb_add(&bar[XB_XCNT(b.x)], 1u);
    return b;
}
__device__ __forceinline__ void xcd_barrier_complete(unsigned* bar, unsigned x, unsigned& nloc, unsigned& nx) {
    const unsigned G = gridDim.x * gridDim.y * gridDim.z;
    unsigned sum, cnt, mine, sp = 0u;
    for (;;) {
        sum = 0u; cnt = 0u; mine = 0u;
#pragma unroll
        for (unsigned j = 0; j < 16; ++j) { const unsigned c = xb_ld(&bar[XB_XCNT(j)]); sum += c; cnt += (c > 0u) ? 1u : 0u; mine = (j == x) ? c : mine; }
        if (sum == G) break;
        __builtin_amdgcn_s_sleep(1);
        if ((++sp & 255u) == 0u) { if (xb_ld(&bar[XB_TMO])) break; if (sp > XB_SPIN_CAP) { atomicAdd(&bar[XB_TMO], 1u); break; } }
    }
    nloc = mine > 0u ? mine : 1u; nx = cnt > 0u ? cnt : 1u;
}
__device__ __forceinline__ void xcd_barrier(const XcdBarrier& b, bool t0) {
    asm volatile("s_waitcnt vmcnt(0)" ::: "memory");
    __syncthreads();
    if (t0) {
        unsigned* bar = b.bar;
        __builtin_amdgcn_s_waitcnt(0);
        unsigned nloc = b.st[0], nx = b.st[1];
        if (nloc == 0u) { xcd_barrier_complete(bar, b.x, nloc, nx); b.st[0] = nloc; b.st[1] = nx; }
        const unsigned old = xb_add(&bar[XB_XSUB(b.x)], 1u);
        const unsigned gen = old / nloc;
        if (old + 1u == (gen + 1u) * nloc) {
            __builtin_amdgcn_fence(__ATOMIC_RELEASE, "agent");
            asm volatile("s_waitcnt vmcnt(0)" ::: "memory");
            const unsigned og = xb_add(&bar[XB_TOP], 1u);
            const unsigned tg = og / nx;
            if (og + 1u == (tg + 1u) * nx) xb_add(&bar[XB_TOPGEN], 1u);
            else XB_SPIN(xb_ld(&bar[XB_TOPGEN]) == tg, bar);
            __builtin_amdgcn_fence(__ATOMIC_ACQUIRE, "agent");
            xb_add(&bar[XB_XGEN(b.x)], 1u);
            asm volatile("s_waitcnt vmcnt(0)" ::: "memory");
        } else {
            XB_SPIN(xb_ld(&bar[XB_XGEN(b.x)]) == gen, bar);
            __builtin_amdgcn_fence(__ATOMIC_ACQUIRE, "agent");
            asm volatile("s_waitcnt vmcnt(0)" ::: "memory");
        }
    }
    __syncthreads();
}

struct Args { const float* in[36]; float* out; unsigned char* ws; int ph_lo, ph_hi, flags, pad; };
struct Frame {
    LAS unsigned char* lds; int tid, lane, wave, gw, ngw;
    float* out; unsigned char* ws; int flags;
    const __attribute__((address_space(4))) Args* ka;
};

#define PHASE_PIN(F) do { unsigned long long _z64; int _z32; asm volatile("s_mov_b64 %0, 0\n\ts_mov_b32 %1, 0" : "=s"(_z64), "=s"(_z32)); asm volatile("" : "+v"((F).lane)); \
    (F).ws += _z64; (F).out += _z64; (F).ka = (const __attribute__((address_space(4))) Args*)((const __attribute__((address_space(4))) char*)(F).ka + _z64); \
    (F).gw += _z32; (F).ngw += _z32; (F).wave += _z32; (F).tid = (F).wave * 64 + (F).lane; } while (0)
struct TrJob { const float* W; int K, ldw, col_off, ncols; bf16_t* WT; int ldt, row_off; const float* g; const float* mu; int mode; float cs; };
__device__ __forceinline__ void tr_item(const TrJob& J, int item, LAS float* scr, int lane) {
    const int nblk = (J.ncols + 31) / 32, kb = item / nblk, nb = item % nblk, k0 = 64 * kb, n0 = 32 * nb;
#pragma unroll 8
    for (int i = 0; i < 32; ++i) {
        const int kk = 2 * i + (lane >> 5), n = lane & 31, k = k0 + kk;
        float v = 0.f;
        if (k < J.K && n0 + n < J.ncols) {
            float s = J.cs;
            if (J.g) s *= J.g[k];
            if (J.mode == 1) s *= (1.0f - J.mu[k]); else if (J.mode == 2) s *= J.mu[k];
            v = J.W[(size_t)k * J.ldw + J.col_off + n0 + n] * s;
        }
        scr[kk * 33 + n] = v;
    }
    LDS_WAIT(); asm volatile("" ::: "memory");
    const int c = lane & 7;
#pragma unroll
    for (int j = 0; j < 4; ++j) {
        const int n = (lane >> 3) + 8 * j; const LAS float* s = scr + (8 * c) * 33 + n;
        u32x4 o; o.x = pk2(s[0 * 33], s[1 * 33]); o.y = pk2(s[2 * 33], s[3 * 33]); o.z = pk2(s[4 * 33], s[5 * 33]); o.w = pk2(s[6 * 33], s[7 * 33]);
        if (n0 + n < J.ncols && k0 + 8 * c < J.K) *(u32x4*)(J.WT + (size_t)(J.row_off + n0 + n) * J.ldt + k0 + 8 * c) = o;
    }
    LDS_WAIT(); asm volatile("" ::: "memory");
}
__device__ __forceinline__ void tr_job(Frame& F, const TrJob& J, int rot) {
    LAS float* scr = (LAS float*)(F.lds + F.wave * LDS_WSCR);
    const int nitems = ((J.K + 63) / 64) * ((J.ncols + 31) / 32);
    int start = F.gw - (rot % F.ngw); if (start < 0) start += F.ngw;
    for (int it = start; it < nitems; it += F.ngw) tr_item(J, it, scr, F.lane);
}
__device__ __forceinline__ void zero_rows(Frame& F, bf16_t* WT, int ld, int r0, int r1) {
    const size_t n16 = (size_t)(r1 - r0) * ld / 8; u32x4* p = (u32x4*)(WT + (size_t)r0 * ld);
    for (size_t i = (size_t)F.gw * 64 + F.lane; i < n16; i += (size_t)F.ngw * 64) p[i] = (u32x4){0u, 0u, 0u, 0u};
}
__device__ __forceinline__ void row_norm_to_bf16(const float* xrow, bf16_t* orow, int lane) {
    const f32x4* xr = (const f32x4*)xrow + lane; f32x4 v[4]; float s = 0.f;
#pragma unroll
    for (int j = 0; j < 4; ++j) { v[j] = xr[64 * j]; s += (v[j].x * v[j].x + v[j].y * v[j].y) + (v[j].z * v[j].z + v[j].w * v[j].w); }
    const float rstd = rsqrtf(wave_sum(s) * (1.f / DM) + RMS_EPS);
    u32x2* o8 = (u32x2*)orow + lane;
#pragma unroll
    for (int j = 0; j < 4; ++j) { u32x2 w; w.x = pk2(v[j].x * rstd, v[j].y * rstd); w.y = pk2(v[j].z * rstd, v[j].w * rstd); o8[64 * j] = w; }
}

__device__ __forceinline__ void ph_prologue(Frame& F, const Args& A) {
    PHASE_PIN(F);
    unsigned char* ws = F.ws; int rot = 0;
    for (int e = 0; e < 2; ++e) {
        bf16_t* WT = (bf16_t*)(ws + W_WIN) + (size_t)e * NCOL * DM;
        const float* g = F.ka->in[1] + e * DM; const float* mul = F.ka->in[5] + (size_t)e * 3 * DM;
        TrJob J{F.ka->in[2] + (size_t)e * DM * 2760, DM, 2760, 0, 2760, WT, DM, 0, g, nullptr, 0, 1.0f}; tr_job(F, J, rot); rot += 1392;
        zero_rows(F, WT, DM, 2760, C_PW);
        TrJob Jw1{F.ka->in[7] + (size_t)e * DM * 64, DM, 64, 0, 64, WT, DM, C_PW, g, mul, 1, 1.0f}; tr_job(F, Jw1, rot); rot += 32;
        TrJob Jw2{F.ka->in[7] + (size_t)e * DM * 64, DM, 64, 0, 64, WT, DM, C_QW, g, mul, 2, 1.0f}; tr_job(F, Jw2, rot); rot += 32;
        TrJob Ja1{F.ka->in[10] + (size_t)e * DM * 64, DM, 64, 0, 64, WT, DM, C_PA, g, mul + DM, 1, 1.0f}; tr_job(F, Ja1, rot); rot += 32;
        TrJob Ja2{F.ka->in[10] + (size_t)e * DM * 64, DM, 64, 0, 64, WT, DM, C_QA, g, mul + DM, 2, 1.0f}; tr_job(F, Ja2, rot); rot += 32;
        TrJob Jg1{F.ka->in[12] + (size_t)e * DM * 128, DM, 128, 0, 128, WT, DM, C_PG, g, mul + 2 * DM, 1, 1.0f}; tr_job(F, Jg1, rot); rot += 64;
        TrJob Jg2{F.ka->in[12] + (size_t)e * DM * 128, DM, 128, 0, 128, WT, DM, C_QG, g, mul + 2 * DM, 2, 1.0f}; tr_job(F, Jg2, rot); rot += 64;
        if (e == 1) {
            TrJob Jv1{F.ka->in[21], DM, 32, 0, 32, WT, DM, C_PV, g, F.ka->in[19], 1, 1.0f}; tr_job(F, Jv1, rot); rot += 16;
            TrJob Jv2{F.ka->in[21], DM, 32, 0, 32, WT, DM, C_QV, g, F.ka->in[19], 2, 1.0f}; tr_job(F, Jv2, rot); rot += 16;
            zero_rows(F, WT, DM, C_QV + 32, NCOL);
        } else zero_rows(F, WT, DM, C_PV, NCOL);
        TrJob Jo{F.ka->in[3] + (size_t)e * DM * DM, DM, DM, 0, DM, (bf16_t*)(ws + W_WOUTE) + (size_t)e * DM * DM, DM, 0, nullptr, nullptr, 0, 1.0f}; tr_job(F, Jo, rot); rot += 512;
        { bf16_t* L2W = (bf16_t*)(ws + W_L2) + (size_t)e * (288 * 512);
          TrJob Jl1{F.ka->in[8] + (size_t)e * 64 * 512, 64, 512, 0, 512, L2W, 64, 0, nullptr, nullptr, 0, 1.0f}; tr_job(F, Jl1, rot); rot += 16;
          TrJob Jl2{F.ka->in[11] + (size_t)e * 64 * 512, 64, 512, 0, 512, L2W + 64 * 512, 64, 0, nullptr, nullptr, 0, 1.0f}; tr_job(F, Jl2, rot); rot += 16;
          TrJob Jl3{F.ka->in[13] + (size_t)e * 128 * 512, 128, 512, 0, 512, L2W + 128 * 512, 128, 0, nullptr, nullptr, 0, 1.0f}; tr_job(F, Jl3, rot); rot += 32;
          if (e == 1) { TrJob Jl4{F.ka->in[22], 32, 512, 0, 512, L2W + 256 * 512, 32, 0, nullptr, nullptr, 0, 1.0f}; tr_job(F, Jl4, rot); rot += 16; } }
        { const float* Wkv = F.ka->in[24] + (size_t)e * 128 * 1024; bf16_t* WkB = (bf16_t*)(ws + W_WKB) + (size_t)e * 8 * 128 * 64;
          for (int i = F.gw * 64 + F.lane; i < 8 * 128 * 64; i += F.ngw * 64) { const int d = i & 63, r = (i >> 6) & 127, h = i >> 13; WkB[i] = (bf16_t)f2bf(Wkv[(size_t)r * 1024 + h * 64 + d]); } }
        TrJob Jv{F.ka->in[24] + (size_t)e * 128 * 1024, 128, 1024, 512, 512, (bf16_t*)(ws + W_WVT) + (size_t)e * 512 * 128, 128, 0, nullptr, nullptr, 0, 1.0f}; tr_job(F, Jv, rot); rot += 32;
    }
    for (int o = 0; o < 2; ++o) {
        const float* g = F.ka->in[26] + o * DM; bf16_t* WT = (bf16_t*)(ws + W_WQKV) + (size_t)o * 3072 * DM;
        TrJob Jq{F.ka->in[27] + (size_t)o * DM * 3072, DM, 3072, 0, 1024, WT, DM, 0, g, nullptr, 0, LOG2E * 0.125f}; tr_job(F, Jq, rot); rot += 512;
        TrJob Jk{F.ka->in[27] + (size_t)o * DM * 3072, DM, 3072, 1024, 2048, WT, DM, 1024, g, nullptr, 0, 1.0f}; tr_job(F, Jk, rot); rot += 1024;
        TrJob Jo{F.ka->in[28] + (size_t)o * DM * DM, DM, DM, 0, DM, (bf16_t*)(ws + W_WOUTO) + (size_t)o * DM * DM, DM, 0, nullptr, nullptr, 0, 1.0f}; tr_job(F, Jo, rot); rot += 512;
    }
    for (int m = F.gw; m < NT; m += F.ngw) row_norm_to_bf16(F.ka->in[0] + (size_t)m * DM, (bf16_t*)(ws + WS_XB) + (size_t)m * DM, F.lane);
}

struct MwJob { const float* src; const float* gk; bf16_t* dst; int ldw, ldt; };
__device__ __forceinline__ MwJob mw_job(int it, const float* w1, const float* w3, const float* w2, const float* g, bf16_t* W13T, bf16_t* W2T, int lane) {
    MwJob J;
    if (it < 16384) { const int job = it >> 6, item = it & 63, which = job & 1, j = (job >> 1) & 3, e = job >> 3, k0 = 64 * (item >> 2), n0 = 32 * (item & 3);
        J.src = (which ? w3 : w1) + (size_t)e * DM * 512 + (size_t)(k0 + (lane >> 3)) * 512 + 128 * j + n0 + 4 * (lane & 7); J.ldw = 512; J.gk = g + k0 + 8 * (lane & 7);
        J.dst = W13T + (size_t)(e * 1024 + 256 * j + 128 * which + n0 + (lane >> 3)) * DM + k0 + 8 * (lane & 7); J.ldt = DM; }
    else { const int it2 = it - 16384, e = it2 >> 8, item = it2 & 255, k0 = 64 * (item >> 5), n0 = 32 * (item & 31);
        J.src = w2 + (size_t)e * 512 * DM + (size_t)(k0 + (lane >> 3)) * DM + n0 + 4 * (lane & 7); J.ldw = DM; J.gk = nullptr;
        J.dst = W2T + (size_t)(e * 1024 + n0 + (lane >> 3)) * 512 + k0 + 8 * (lane & 7); J.ldt = 512; }
    return J;
}
__device__ __forceinline__ void mw_load(const MwJob& J, f32x4 (&v)[8], f32x4 (&gv)[2]) {
#pragma unroll
    for (int i = 0; i < 8; ++i) v[i] = __builtin_nontemporal_load((const f32x4*)(J.src + (size_t)(8 * i) * J.ldw));
    if (J.gk) { gv[0] = *(const f32x4*)(J.gk); gv[1] = *(const f32x4*)(J.gk + 4); } else { gv[0] = (f32x4){1.f, 1.f, 1.f, 1.f}; gv[1] = gv[0]; }
}
__device__ __forceinline__ void mw_finish(const MwJob& J, const f32x4 (&v)[8], const f32x4 (&gv)[2], LAS float* scr, int lane) {
#pragma unroll
    for (int i = 0; i < 8; ++i) { LAS float* sp = scr + (8 * i + (lane >> 3)) * 33 + 4 * (lane & 7); sp[0] = v[i].x; sp[1] = v[i].y; sp[2] = v[i].z; sp[3] = v[i].w; }
    LDS_WAIT(); asm volatile("" ::: "memory");
    const int c = lane & 7;
#pragma unroll
    for (int j = 0; j < 4; ++j) { const LAS float* sp = scr + (8 * c) * 33 + (lane >> 3) + 8 * j;
        u32x4 o; o.x = pk2(sp[0 * 33] * gv[0].x, sp[1 * 33] * gv[0].y); o.y = pk2(sp[2 * 33] * gv[0].z, sp[3 * 33] * gv[0].w); o.z = pk2(sp[4 * 33] * gv[1].x, sp[5 * 33] * gv[1].y); o.w = pk2(sp[6 * 33] * gv[1].z, sp[7 * 33] * gv[1].w);
        *(u32x4*)(J.dst + (size_t)(8 * j) * J.ldt) = o; }
    LDS_WAIT(); asm volatile("" ::: "memory");
}
__device__ __forceinline__ void moe_weight_prep(Frame& F, const Args& A, int l) {
    PHASE_PIN(F);
    LAS float* scr = (LAS float*)(F.lds + F.wave * LDS_WSCR); const int lane = F.lane;
    const float* g = F.ka->in[29] + l * DM;
    const float* w1 = F.ka->in[32] + (size_t)l * 32 * DM * 512; const float* w3 = F.ka->in[33] + (size_t)l * 32 * DM * 512; const float* w2 = F.ka->in[34] + (size_t)l * 32 * 512 * DM;
    bf16_t* W13T = (bf16_t*)(F.ws + WS_W13T); bf16_t* W2T = (bf16_t*)(F.ws + WS_W2T);
    f32x4 va[8], vb[8], ga[2], gb[2];
    int it = F.gw;
    if (it >= 24576) return;
    MwJob Ja = mw_job(it, w1, w3, w2, g, W13T, W2T, lane), Jb = Ja; mw_load(Ja, va, ga);
    for (;;) {
        const int itb = it + F.ngw; const bool hb = itb < 24576;
        if (hb) { Jb = mw_job(itb, w1, w3, w2, g, W13T, W2T, lane); mw_load(Jb, vb, gb); }
        mw_finish(Ja, va, ga, scr, lane);
        if (!hb) break;
        const int ita = itb + F.ngw; const bool ha = ita < 24576;
        if (ha) { Ja = mw_job(ita, w1, w3, w2, g, W13T, W2T, lane); mw_load(Ja, va, ga); }
        mw_finish(Jb, vb, gb, scr, lane);
        if (!ha) break;
        it = ita;
    }
}

#define MFMA32(a, b, c) __builtin_amdgcn_mfma_f32_32x32x16_bf16((a), (b), (c), 0, 0, 0)
template <class Epi>
__device__ __forceinline__ void sg_tile(const bf16_t* A, int lda, const bf16_t* B0, const bf16_t* B1, int ldb, int K, int m0, const Epi& epi, int lane) {
    const int r = lane & 31, h = lane >> 5;
    const bf16_t* a0 = A + (size_t)(m0 + r) * lda + 8 * h; const bf16_t* a1 = a0 + (size_t)32 * lda;
    const bf16_t* b0 = B0 + (size_t)r * ldb + 8 * h; const bf16_t* b1 = B1 + (size_t)r * ldb + 8 * h;
    f32x16 c00, c01, c10, c11;
#pragma unroll
    for (int i = 0; i < 16; ++i) { c00[i] = 0.f; c01[i] = 0.f; c10[i] = 0.f; c11[i] = 0.f; }
#pragma unroll 4
    for (int k = 0; k < K; k += 16) {
        const bf16x8 fa0 = *(const bf16x8*)(a0 + k), fa1 = *(const bf16x8*)(a1 + k), fb0 = *(const bf16x8*)(b0 + k), fb1 = *(const bf16x8*)(b1 + k);
        c00 = MFMA32(fb0, fa0, c00); c01 = MFMA32(fb1, fa0, c01); c10 = MFMA32(fb0, fa1, c10); c11 = MFMA32(fb1, fa1, c11);
    }
#pragma unroll
    for (int g = 0; g < 4; ++g) {
        const int j = 8 * g + 4 * h;
        epi.pair(m0 + r, j, (f32x4){c00[4 * g], c00[4 * g + 1], c00[4 * g + 2], c00[4 * g + 3]}, (f32x4){c01[4 * g], c01[4 * g + 1], c01[4 * g + 2], c01[4 * g + 3]});
        epi.pair(m0 + 32 + r, j, (f32x4){c10[4 * g], c10[4 * g + 1], c10[4 * g + 2], c10[4 * g + 3]}, (f32x4){c11[4 * g], c11[4 * g + 1], c11[4 * g + 2], c11[4 * g + 3]});
    }
}
struct EpiStoreBf16 {
    bf16_t* O; int ldo, n0, n1;
    __device__ __forceinline__ void pair(int row, int j, f32x4 v0, f32x4 v1) const {
        u32x2 w; w.x = pk2(v0.x, v0.y); w.y = pk2(v0.z, v0.w); *(u32x2*)(O + (size_t)row * ldo + n0 + j) = w;
        w.x = pk2(v1.x, v1.y); w.y = pk2(v1.z, v1.w); *(u32x2*)(O + (size_t)row * ldo + n1 + j) = w;
    }
};
struct EpiResidF32 {
    const float* S; float* X; int n0, n1;
    __device__ __forceinline__ void pair(int row, int j, f32x4 v0, f32x4 v1) const {
        const size_t o0 = (size_t)row * DM + n0 + j, o1 = (size_t)row * DM + n1 + j;
        *(f32x4*)(X + o0) = *(const f32x4*)(S + o0) + v0; *(f32x4*)(X + o1) = *(const f32x4*)(S + o1) + v1;
    }
};
struct EpiGated {
    bf16_t* H; int hc;
    __device__ __forceinline__ void pair(int row, int j, f32x4 a, f32x4 b) const {
        f32x4 o;
#pragma unroll
        for (int i = 0; i < 4; ++i) o[i] = a[i] * sigmoidf_(a[i]) * b[i];
        u32x2 w; w.x = pk2(o.x, o.y); w.y = pk2(o.z, o.w); *(u32x2*)(H + (size_t)row * 512 + hc + j) = w;
    }
};
__device__ __forceinline__ void sg_dense_bf16(Frame& F, const bf16_t* A, int lda, const bf16_t* Bt, int K, int M, int N, bf16_t* O, int ldo) {
    PHASE_PIN(F);
    const int nN = N / 64, ntile = (M / 64) * nN;
    for (int t = F.gw; t < ntile; t += F.ngw) {
        const int mt = t / nN, nt = t % nN; EpiStoreBf16 E{O, ldo, nt * 64, nt * 64 + 32};
        sg_tile(A, lda, Bt + (size_t)(nt * 64) * K, Bt + (size_t)(nt * 64 + 32) * K, K, K, mt * 64, E, F.lane);
    }
}
__device__ __forceinline__ void sg_dense_resid(Frame& F, const bf16_t* A, const bf16_t* Bt, const float* S, float* X) {
    PHASE_PIN(F);
    const int nN = DM / 64, ntile = (NT / 64) * nN;
    for (int t = F.gw; t < ntile; t += F.ngw) {
        const int mt = t / nN, nt = t % nN; EpiResidF32 E{S, X, nt * 64, nt * 64 + 32};
        sg_tile(A, DM, Bt + (size_t)(nt * 64) * DM, Bt + (size_t)(nt * 64 + 32) * DM, DM, DM, mt * 64, E, F.lane);
    }
}

namespace pg8 {
#define PG8_LAS __attribute__((address_space(3)))
typedef unsigned short bf16_t;
typedef short bf16x8 __attribute__((ext_vector_type(8)));
typedef float f32x4 __attribute__((ext_vector_type(4)));
typedef unsigned u32x4 __attribute__((ext_vector_type(4)));
constexpr int BM = 256, BK = 64, HALF = 128, HTB = HALF * BK * 2  , STAGE_BYTES = 8 * HTB, NXCD = 8, WGM = 8;

__host__ __device__ __forceinline__ int lds_byte(int r, int c) { const int st = (r >> 4) * 2 + (c >> 5), rr = r & 15, cc = c & 31, ob = rr * 64 + cc * 2; return st * 1024 + (ob ^ (((ob >> 9) & 1) << 5)); }
__host__ __device__ __forceinline__ void stage_rc(int b, int& R, int& C) { const int st = b / 1024, sb = b % 1024, swz = sb ^ (((sb >> 9) & 1) << 5); R = (st >> 1) * 16 + swz / 64; C = (st & 1) * 32 + (swz % 64) / 2; }
__host__ __device__ __forceinline__ int perm32(int rho) { const int n = rho >> 4, i = rho & 15; return 8 * (i >> 2) + 4 * n + (i & 3); }

struct Unit { int pm, pn; };
struct Gemm { const bf16_t* A; const bf16_t* Bt; int M, N, K; };

struct StaticOrder {
    int nM, nN, nwg, G, c;
    __host__ __device__ void init(int M, int N, int G_, int c_) { nM = M / BM; nN = N / BM; nwg = nM * nN; G = G_; c = c_; }
    __host__ __device__ bool next(int i, Unit& u) const {
        const long L = (long)i * G + c; if (L >= nwg) return false;
        int wgid = (int)L; { const int q = nwg / NXCD, r = nwg % NXCD, xcd = wgid % NXCD, off = wgid / NXCD; wgid = (xcd < r ? xcd * (q + 1) : r * (q + 1) + (xcd - r) * q) + off; }
        const int nig = WGM * nN, gid = wgid / nig, fm = gid * WGM, gsz = (nM - fm) < WGM ? (nM - fm) : WGM;
        u.pm = fm + ((wgid % nig) % gsz); u.pn = (wgid % nig) / gsz; return true;
    }
    __device__ __forceinline__ void a_ready(const Unit&) const {}
    __device__ __forceinline__ void done(const Unit&) const {}
};

__device__ __forceinline__ unsigned cvt_pk_bf16(float lo, float hi) { return ::pk2(lo, hi); }
struct EpiBf16S {
    static constexpr bool PERM = true, AFTER_DRAIN = false;
    bf16_t* O; int ldc; int split_cols; size_t split_stride;
    __device__ __forceinline__ void operator()(const f32x4 (&acc)[2][2][4][2], const Unit& u, int wr, int wc, int fr, int fq) const {
        const int row0 = u.pm * BM + wr * 64 + fr; int colt = u.pn * BM; bf16_t* base = O;
        if (split_cols) { const int t = colt / split_cols; base += (size_t)t * split_stride; colt -= t * split_cols; }
        const int col0 = colt + wc * 32 + 8 * fq;
#pragma unroll
        for (int ai = 0; ai < 2; ++ai)
#pragma unroll
            for (int m = 0; m < 4; ++m) { bf16_t* rowp = base + (size_t)(row0 + ai * HALF + m * 16) * ldc + col0;
#pragma unroll
                for (int bj = 0; bj < 2; ++bj) { const f32x4 v0 = acc[ai][bj][m][0], v1 = acc[ai][bj][m][1];
                    u32x4 w; w.x = cvt_pk_bf16(v0[0], v0[1]); w.y = cvt_pk_bf16(v0[2], v0[3]); w.z = cvt_pk_bf16(v1[0], v1[1]); w.w = cvt_pk_bf16(v1[2], v1[3]);
                    *(u32x4*)(rowp + bj * HALF) = w; } }
    }
};
struct EpiResid {
    static constexpr bool PERM = false, AFTER_DRAIN = false;
    const float* S; float* X;
    __device__ __forceinline__ void operator()(const f32x4 (&acc)[2][2][4][2], const Unit& u, int wr, int wc, int fr, int fq) const {
        const int row0 = u.pm * BM + wr * 64 + fr, col0 = u.pn * BM + wc * 32 + 4 * fq;
#pragma unroll
        for (int ai = 0; ai < 2; ++ai)
#pragma unroll
            for (int m = 0; m < 4; ++m) { const size_t off = (size_t)(row0 + ai * HALF + m * 16) * 1024 + col0;
#pragma unroll
                for (int bj = 0; bj < 2; ++bj)
#pragma unroll
                    for (int n = 0; n < 2; ++n) *(f32x4*)(X + off + bj * HALF + n * 16) = *(const f32x4*)(S + off + bj * HALF + n * 16) + acc[ai][bj][m][n]; }
    }
};
struct EpiGate {
    static constexpr bool PERM = true, AFTER_DRAIN = false;
    bf16_t* H;
    __device__ __forceinline__ void operator()(const f32x4 (&acc)[2][2][4][2], const Unit& u, int wr, int wc, int fr, int fq) const {
        const int row0 = u.pm * BM + wr * 64 + fr, col0 = (u.pn & 3) * 128 + wc * 32 + 8 * fq;
#pragma unroll
        for (int ai = 0; ai < 2; ++ai)
#pragma unroll
            for (int m = 0; m < 4; ++m) { float o[8];
#pragma unroll
                for (int n = 0; n < 2; ++n)
#pragma unroll
                    for (int i = 0; i < 4; ++i) { const float a = acc[ai][0][m][n][i], b = acc[ai][1][m][n][i]; o[4 * n + i] = a * b * __builtin_amdgcn_rcpf(1.0f + __builtin_amdgcn_exp2f(-1.4426950408889634f * a)); }
                u32x4 w; w.x = cvt_pk_bf16(o[0], o[1]); w.y = cvt_pk_bf16(o[2], o[3]); w.z = cvt_pk_bf16(o[4], o[5]); w.w = cvt_pk_bf16(o[6], o[7]);
                *(u32x4*)(H + (size_t)(row0 + ai * HALF + m * 16) * 512 + col0) = w; }
    }
};
struct EpiMoeDown {
    static constexpr bool PERM = true, AFTER_DRAIN = false;
    bf16_t* Y;
    __device__ __forceinline__ void operator()(const f32x4 (&acc)[2][2][4][2], const Unit& u, int wr, int wc, int fr, int fq) const {
        const int row0 = u.pm * BM + wr * 64 + fr, col0 = (u.pn & 3) * BM + wc * 32 + 8 * fq;
#pragma unroll
        for (int ai = 0; ai < 2; ++ai)
#pragma unroll
            for (int m = 0; m < 4; ++m) { bf16_t* rowp = Y + (size_t)(row0 + ai * HALF + m * 16) * 1024 + col0;
#pragma unroll
                for (int bj = 0; bj < 2; ++bj) { const f32x4 v0 = acc[ai][bj][m][0], v1 = acc[ai][bj][m][1];
                    u32x4 w; w.x = cvt_pk_bf16(v0[0], v0[1]); w.y = cvt_pk_bf16(v0[2], v0[3]); w.z = cvt_pk_bf16(v1[0], v1[1]); w.w = cvt_pk_bf16(v1[2], v1[3]);
                    *(u32x4*)(rowp + bj * HALF) = w; } }
    }
};
struct MoeOrder {
    int nunits, G, c; const PG8_LAS int* tab;
    __device__ __forceinline__ bool next(int i, Unit& u) const {
        const int L = i * G + c; if (L >= nunits) return false;
        const int rt = L >> 2; u.pm = rt; u.pn = __builtin_amdgcn_readfirstlane(tab[rt]) * 4 + (L & 3); return true;
    }
    __device__ __forceinline__ void a_ready(const Unit&) const {}
    __device__ __forceinline__ void done(const Unit&) const {}
};
template <class Epi, class Sched, bool STAMP = false>
__device__ __forceinline__ void gemm_phase(PG8_LAS unsigned char* lds, const Gemm g, const Sched& S, const Epi& E, unsigned long long* stamps, const int wid_in) {
    int ln_; asm volatile("v_mbcnt_lo_u32_b32 %0, -1, 0\n\tv_mbcnt_hi_u32_b32 %0, -1, %0" : "=v"(ln_)); const int tid = wid_in * 64 + ln_, wid = wid_in, lane = tid & 63, wr = wid >> 2, wc = wid & 3, fr = lane & 15, fq = lane >> 4;
    const int K = g.K, nt = K / BK;
    int ts_lo = 0, ts_hi = 0, nts = 0; const unsigned long long rt_entry = STAMP ? (unsigned long long)wall_clock64() : 0ull;
#define PG8_STAMP() do { if (STAMP && wid == 0 && nts < 64) { const unsigned long long _c = (unsigned long long)clock64(); \
        ts_lo = (lane == nts) ? (int)(unsigned)_c : ts_lo; ts_hi = (lane == nts) ? (int)(unsigned)(_c >> 32) : ts_hi; ++nts; } } while (0)
    PG8_STAMP();
    unsigned voffA[2], voffB[2];
#pragma unroll
    for (int i = 0; i < 2; ++i) { int R, C; stage_rc(tid * 16 + i * 8192, R, C); const int Rb = Epi::PERM ? ((R & ~31) + perm32(R & 31)) : R;
        voffA[i] = (unsigned)(R * K + C) * 2u; voffB[i] = (unsigned)(Rb * K + C) * 2u; }
    const size_t kstep = (size_t)(BK * 2);
    const size_t hstep = (size_t)HALF * K * 2;
    const size_t tstep = 2 * hstep;
    const unsigned ldsw = (unsigned)wid * 1024u;
    const int aoff = lds_byte(wr * 64 + fr, fq * 8), boff = lds_byte(wc * 32 + fr, fq * 8);
#define PG8_SA(b, h) (((b) * 2 + (h)) * HTB)
#define PG8_SB(b, h) ((4 + (b) * 2 + (h)) * HTB)
#define PG8_STAGE(bufoff, gbase, voff) do { _Pragma("unroll") for (int _i = 0; _i < 2; ++_i) \
        __builtin_amdgcn_global_load_lds((const unsigned*)((const char*)(gbase) + (voff)[_i]), (PG8_LAS unsigned*)(lds + (bufoff) + ldsw + _i * 8192), 16, 0, 0); } while (0)
#define PG8_LDA(dst, b, h) do { _Pragma("unroll") for (int m = 0; m < 4; ++m) _Pragma("unroll") for (int k = 0; k < 2; ++k) dst[m][k] = *(const PG8_LAS bf16x8*)(lds + PG8_SA(b, h) + aoff + m * 2048 + k * 1024); } while (0)
#define PG8_LDB(dst, b, h) do { _Pragma("unroll") for (int n = 0; n < 2; ++n) _Pragma("unroll") for (int k = 0; k < 2; ++k) dst[n][k] = *(const PG8_LAS bf16x8*)(lds + PG8_SB(b, h) + boff + n * 2048 + k * 1024); } while (0)
#define PG8_MMA(ai, bj, At, Bt) do { __builtin_amdgcn_s_setprio(1); _Pragma("unroll") for (int m = 0; m < 4; ++m) _Pragma("unroll") for (int n = 0; n < 2; ++n) _Pragma("unroll") for (int k = 0; k < 2; ++k) \
        acc[ai][bj][m][n] = __builtin_amdgcn_mfma_f32_16x16x32_bf16(Bt[n][k], At[m][k], acc[ai][bj][m][n], 0, 0, 0); __builtin_amdgcn_s_setprio(0); } while (0)
#define PG8_WAIT_V(n) asm volatile("s_waitcnt vmcnt(" #n ")" ::: "memory")
#define PG8_WAIT_L(n) asm volatile("s_waitcnt lgkmcnt(" #n ")" ::: "memory")
#define PG8_BAR __builtin_amdgcn_s_barrier()
#define PG8_SCHED __builtin_amdgcn_sched_barrier(0)
    Unit cur, nxt; int ui = 0;
    if (!S.next(0, cur)) return;
    f32x4 acc[2][2][4][2];
#pragma unroll
    for (int a = 0; a < 2; ++a)
#pragma unroll
        for (int b = 0; b < 2; ++b)
#pragma unroll
            for (int m = 0; m < 4; ++m)
#pragma unroll
                for (int n = 0; n < 2; ++n) acc[a][b][m][n] = (f32x4){0.f, 0.f, 0.f, 0.f};
    bf16x8 At[4][2], B0[2][2], B1[2][2];
    const char* cA = (const char*)g.A + (size_t)cur.pm * tstep; const char* cB = (const char*)g.Bt + (size_t)cur.pn * tstep;
    S.a_ready(cur);
    PG8_STAGE(PG8_SB(0, 0), cB, voffB); PG8_STAGE(PG8_SA(0, 0), cA, voffA); PG8_STAGE(PG8_SB(0, 1), cB + hstep, voffB); PG8_STAGE(PG8_SA(0, 1), cA + hstep, voffA);
    if (wr == 1) PG8_BAR;
    PG8_WAIT_V(4); PG8_BAR;
    PG8_STAGE(PG8_SB(1, 0), cB + kstep, voffB); PG8_STAGE(PG8_SA(1, 0), cA + kstep, voffA); PG8_STAGE(PG8_SB(1, 1), cB + hstep + kstep, voffB);
    PG8_WAIT_V(6); PG8_BAR;
    PG8_STAMP();
    for (;;) {
        const bool has_next = S.next(ui + 1, nxt);
        const char* nA = has_next ? (const char*)g.A + (size_t)nxt.pm * tstep : cA; const char* nB = has_next ? (const char*)g.Bt + (size_t)nxt.pn * tstep : cB;
        for (int t = 0; t < nt; t += 2) {
            const bool last = (t == nt - 2);
            const char* a1 = cA + (size_t)(t + 1) * kstep;
            const char* a2 = last ? nA : cA + (size_t)(t + 2) * kstep; const char* b2 = last ? nB : cB + (size_t)(t + 2) * kstep;
            const char* a3 = a2 + kstep; const char* b3 = b2 + kstep;
            if (last && has_next) S.a_ready(nxt);
            PG8_LDB(B0, 0, 0); PG8_SCHED; PG8_LDA(At, 0, 0); PG8_STAGE(PG8_SA(1, 1), a1 + hstep, voffA);
            PG8_WAIT_L(8); PG8_BAR; PG8_WAIT_L(0); PG8_MMA(0, 0, At, B0); PG8_BAR; PG8_SCHED;
            PG8_LDB(B1, 0, 1); PG8_STAGE(PG8_SB(0, 0), b2, voffB);
            PG8_BAR; PG8_WAIT_L(0); PG8_MMA(0, 1, At, B1); PG8_BAR;
            PG8_LDA(At, 0, 1); PG8_STAGE(PG8_SA(0, 0), a2, voffA);
            PG8_BAR; PG8_WAIT_L(0); PG8_MMA(1, 0, At, B0); PG8_BAR; PG8_SCHED;
            PG8_STAGE(PG8_SB(0, 1), b2 + hstep, voffB);
            PG8_WAIT_V(6); PG8_BAR; PG8_MMA(1, 1, At, B1); PG8_BAR;
            PG8_LDB(B0, 1, 0); PG8_SCHED; PG8_LDA(At, 1, 0); PG8_STAGE(PG8_SA(0, 1), a2 + hstep, voffA);
            PG8_WAIT_L(8); PG8_BAR; PG8_WAIT_L(0); PG8_MMA(0, 0, At, B0); PG8_BAR; PG8_SCHED;
            PG8_LDB(B1, 1, 1); PG8_STAGE(PG8_SB(1, 0), b3, voffB);
            PG8_BAR; PG8_WAIT_L(0); PG8_MMA(0, 1, At, B1); PG8_BAR;
            PG8_LDA(At, 1, 1); PG8_STAGE(PG8_SA(1, 0), a3, voffA);
            PG8_BAR; PG8_WAIT_L(0); PG8_MMA(1, 0, At, B0); PG8_BAR; PG8_SCHED;
            PG8_STAGE(PG8_SB(1, 1), b3 + hstep, voffB);
            PG8_WAIT_V(6); PG8_BAR; PG8_MMA(1, 1, At, B1); PG8_BAR;
        }
        PG8_STAMP();
        if constexpr (!Epi::AFTER_DRAIN) { E(acc, cur, wr, wc, fr, fq); S.done(cur); }
        PG8_STAMP();
        if (!has_next) break;
#pragma unroll
        for (int a = 0; a < 2; ++a)
#pragma unroll
            for (int b = 0; b < 2; ++b)
#pragma unroll
                for (int m = 0; m < 4; ++m)
#pragma unroll
                    for (int n = 0; n < 2; ++n) acc[a][b][m][n] = (f32x4){0.f, 0.f, 0.f, 0.f};
        cur = nxt; cA = nA; cB = nB; ++ui;
    }
    PG8_WAIT_V(0);
    if (wr == 0) PG8_BAR;
    PG8_BAR;
    if constexpr (Epi::AFTER_DRAIN) { E.fused(acc, cur, wr, wc, fr, fq, lds, wid, lane); S.done(cur); }
    PG8_STAMP();
    if (STAMP && wid == 0) { stamps[lane] = lane < nts ? (((unsigned long long)(unsigned)ts_hi << 32) | (unsigned)ts_lo) : 0ull;
        if (lane == 62) stamps[62] = rt_entry; if (lane == 63) stamps[63] = (unsigned long long)wall_clock64(); }
#undef PG8_STAMP
#undef PG8_SA
#undef PG8_SB
#undef PG8_STAGE
#undef PG8_LDA
#undef PG8_LDB
#undef PG8_MMA
#undef PG8_WAIT_V
#undef PG8_WAIT_L
#undef PG8_BAR
#undef PG8_SCHED
}
}

__device__ __forceinline__ f32x4 ld_bf4(const bf16_t* p) { const u32x2 w = *(const u32x2*)p; return (f32x4){__uint_as_float(w.x << 16), __uint_as_float(w.x & 0xffff0000u), __uint_as_float(w.y << 16), __uint_as_float(w.y & 0xffff0000u)}; }
__device__ __forceinline__ float fast_sigmoid(float x) { return __builtin_amdgcn_rcpf(1.0f + __builtin_amdgcn_exp2f(-LOG2E * x)); }
__device__ __forceinline__ float fast_tanh(float x) { return 1.0f - 2.0f * __builtin_amdgcn_rcpf(1.0f + __builtin_amdgcn_exp2f(2.0f * LOG2E * x)); }
__device__ __forceinline__ void ld_pq8(const bf16_t* p, const bf16_t* q, bool hp, float (&o)[8]) {
    const u32x4 a = *(const u32x4*)p; u32x4 b = (u32x4){0u, 0u, 0u, 0u}; if (hp) b = *(const u32x4*)q;
    o[0] = __uint_as_float(a.x << 16) + __uint_as_float(b.x << 16); o[1] = __uint_as_float(a.x & 0xffff0000u) + __uint_as_float(b.x & 0xffff0000u);
    o[2] = __uint_as_float(a.y << 16) + __uint_as_float(b.y << 16); o[3] = __uint_as_float(a.y & 0xffff0000u) + __uint_as_float(b.y & 0xffff0000u);
    o[4] = __uint_as_float(a.z << 16) + __uint_as_float(b.z << 16); o[5] = __uint_as_float(a.z & 0xffff0000u) + __uint_as_float(b.z & 0xffff0000u);
    o[6] = __uint_as_float(a.w << 16) + __uint_as_float(b.w << 16); o[7] = __uint_as_float(a.w & 0xffff0000u) + __uint_as_float(b.w & 0xffff0000u);
}
__device__ __forceinline__ bf16x8 pack8(const float (&o)[8]) { u32x4 w; w.x = pk2(o[0], o[1]); w.y = pk2(o[2], o[3]); w.z = pk2(o[4], o[5]); w.w = pk2(o[6], o[7]); return __builtin_bit_cast(bf16x8, w); }
__device__ __forceinline__ void ph_prep(Frame& F, const Args& A, int e, int parts) {
    PHASE_PIN(F);
    unsigned char* ws = F.ws; const int lane = F.lane;
    const bf16_t* proj = (const bf16_t*)(ws + WS_PROJ);
    const float* mu_rkv = F.ka->in[4] + (size_t)e * 3 * 512;
    const float* w0 = F.ka->in[6] + e * 512; const float* a0 = F.ka->in[9] + e * 512;
    const float* k_k = F.ka->in[14] + e * 512; const float* k_a = F.ka->in[15] + e * 512; const float* r_k = F.ka->in[16] + e * 512;
    const float* v0 = F.ka->in[20];
    const float* kvn = F.ka->in[23] + e * 128; const float* ikn = F.ka->in[25] + e * 64;
    float* SIN = (float*)(ws + WS_SIN); float* VF = (float*)(ws + WS_VF); float* GATE = (float*)(ws + WS_GATE); float* BON = (float*)(ws + SM_BONUS);
    unsigned* SGN = (unsigned*)(ws + SM_SGN);
    bf16_t* CN = (bf16_t*)(ws + WS_CN); bf16_t* KI = (bf16_t*)(ws + WS_KI); bf16_t* QI = (bf16_t*)(ws + WS_QI); bf16_t* QLIN = (bf16_t*)(ws + SM_QLIN);
    if (parts & 1)
    for (int m = F.gw; m < NT; m += F.ngw) {
        const bf16_t* pr = proj + (size_t)m * NCOL;
        const float c0 = bf2f(pr[C_CKV + lane]), c1 = bf2f(pr[C_CKV + 64 + lane]);
        const float rs = rsqrtf(wave_sum(c0 * c0 + c1 * c1) * (1.f / 128.f) + RMS_EPS);
        CN[(size_t)m * 128 + lane] = (bf16_t)f2bf(c0 * rs * kvn[lane]); CN[(size_t)m * 128 + 64 + lane] = (bf16_t)f2bf(c1 * rs * kvn[64 + lane]);
        const float ki = bf2f(pr[C_KI + lane]); const float rs2 = rsqrtf(wave_sum(ki * ki) * (1.f / 64.f) + RMS_EPS);
        KI[(size_t)m * 64 + lane] = (bf16_t)f2bf(ki * rs2 * ikn[lane]);
        unsigned sg = 0;
#pragma unroll
        for (int hh = 0; hh < 8; ++hh) { const float w = bf2f(pr[C_WI + hh]); if (w < 0.f) sg |= 1u << hh; const float qv = bf2f(pr[C_QI + hh * 64 + lane]);
            QI[(size_t)m * 512 + hh * 64 + lane] = (bf16_t)f2bf(fabsf(w) * qv); }
        if (lane == 0) SGN[m] = sg;
    }
    if (parts & 2) { const int r = lane & 31, hf = lane >> 5;
      const bf16_t* L2W = (const bf16_t*)(ws + W_L2) + (size_t)e * (288 * 512);
      const bf16_t* w2T = L2W; const bf16_t* a2T = L2W + 64 * 512; const bf16_t* g2T = L2W + 128 * 512; const bf16_t* v2T = L2W + 256 * 512;
      for (int it = F.gw; it < 512 * 2; it += F.ngw) {
        const int half = it & 1, tile = it >> 1, m = tile * 32 + r, t = m & (TT - 1), b = m >> 13; const bool hp = t > 0;
        const bf16_t* pr = proj + (size_t)m * NCOL; const bf16_t* pp = pr - NCOL;
        bf16x8 fw[4], fa[4], fg[8], fv[2];
#pragma unroll
        for (int ks = 0; ks < 4; ++ks) { float o[8]; ld_pq8(pr + C_PW + 16 * ks + 8 * hf, pp + C_QW + 16 * ks + 8 * hf, hp, o);
#pragma unroll
            for (int j = 0; j < 8; ++j) o[j] = fast_tanh(o[j]);
            fw[ks] = pack8(o);
            ld_pq8(pr + C_PA + 16 * ks + 8 * hf, pp + C_QA + 16 * ks + 8 * hf, hp, o); fa[ks] = pack8(o); }
#pragma unroll
        for (int ks = 0; ks < 8; ++ks) { float o[8]; ld_pq8(pr + C_PG + 16 * ks + 8 * hf, pp + C_QG + 16 * ks + 8 * hf, hp, o);
#pragma unroll
            for (int j = 0; j < 8; ++j) o[j] = fast_sigmoid(o[j]);
            fg[ks] = pack8(o); }
#pragma unroll
        for (int ks = 0; ks < 2; ++ks) { float o[8] = {0.f, 0.f, 0.f, 0.f, 0.f, 0.f, 0.f, 0.f}; if (e == 1) ld_pq8(pr + C_PV + 16 * ks + 8 * hf, pp + C_QV + 16 * ks + 8 * hf, hp, o); fv[ks] = pack8(o); }
#pragma unroll 1
        for (int hq = 0; hq < 4; ++hq) {
        const int hh = 4 * half + hq;
        float ss = 0.f, bon = 0.f;
        float* so = SIN + ((size_t)(b * 8 + hh) * TT + t) * 384;
#pragma unroll
        for (int sub = 0; sub < 2; ++sub)
#pragma unroll
            for (int g = 0; g < 4; ++g) { const int ch4 = hh * 64 + sub * 32 + 8 * g + 4 * hf;
                const f32x4 kk0 = ld_bf4(pr + C_K + ch4); f32x4 kp = (f32x4){0.f, 0.f, 0.f, 0.f}; if (hp) kp = ld_bf4(pp + C_K + ch4);
                const f32x4 mk = *(const f32x4*)(mu_rkv + 512 + ch4), kk4 = *(const f32x4*)(k_k + ch4);
#pragma unroll
                for (int j = 0; j < 4; ++j) { const float kx = (kk0[j] + (kp[j] - kk0[j]) * mk[j]) * kk4[j]; ss += kx * kx; } }
        ss += __shfl_xor(ss, 32);
        const float rn = rsqrtf(fmaxf(ss, 1e-12f));
#pragma unroll 1
        for (int sub = 0; sub < 2; ++sub) {
            const int cb = hh * 64 + sub * 32;
            f32x16 acc;
#pragma unroll
            for (int i = 0; i < 16; ++i) acc[i] = 0.f;
#pragma unroll
            for (int ks = 0; ks < 4; ++ks) acc = MFMA32(*(const bf16x8*)(w2T + (size_t)(cb + r) * 64 + 16 * ks + 8 * hf), fw[ks], acc);
#pragma unroll
            for (int g = 0; g < 4; ++g) { const int ch4 = cb + 8 * g + 4 * hf; const f32x4 b0 = *(const f32x4*)(w0 + ch4); f32x4 d;
#pragma unroll
                for (int j = 0; j < 4; ++j) d[j] = __builtin_amdgcn_exp2f(-0.6065306597126334f * LOG2E * fast_sigmoid(b0[j] + acc[4 * g + j]));
                *(f32x4*)(so + 64 + sub * 32 + 8 * g + 4 * hf) = d; }
            float icv[16];
#pragma unroll
            for (int i = 0; i < 16; ++i) acc[i] = 0.f;
#pragma unroll
            for (int ks = 0; ks < 4; ++ks) acc = MFMA32(*(const bf16x8*)(a2T + (size_t)(cb + r) * 64 + 16 * ks + 8 * hf), fa[ks], acc);
#pragma unroll
            for (int g = 0; g < 4; ++g) { const int ch4 = cb + 8 * g + 4 * hf; const f32x4 b0 = *(const f32x4*)(a0 + ch4);
#pragma unroll
                for (int j = 0; j < 4; ++j) icv[4 * g + j] = fast_sigmoid(b0[j] + acc[4 * g + j]); }
#pragma unroll
            for (int i = 0; i < 16; ++i) acc[i] = 0.f;
#pragma unroll
            for (int ks = 0; ks < 8; ++ks) acc = MFMA32(*(const bf16x8*)(g2T + (size_t)(cb + r) * 128 + 16 * ks + 8 * hf), fg[ks], acc);
#pragma unroll
            for (int g = 0; g < 4; ++g) *(f32x4*)(GATE + (size_t)m * 512 + cb + 8 * g + 4 * hf) = (f32x4){acc[4 * g], acc[4 * g + 1], acc[4 * g + 2], acc[4 * g + 3]};
            if (e == 1) {
#pragma unroll
                for (int i = 0; i < 16; ++i) acc[i] = 0.f;
#pragma unroll
                for (int ks = 0; ks < 2; ++ks) acc = MFMA32(*(const bf16x8*)(v2T + (size_t)(cb + r) * 32 + 16 * ks + 8 * hf), fv[ks], acc);
            }
#pragma unroll
            for (int g = 0; g < 4; ++g) {
                const int ch4 = cb + 8 * g + 4 * hf;
                const f32x4 rr = ld_bf4(pr + C_R + ch4), kk0 = ld_bf4(pr + C_K + ch4), vv = ld_bf4(pr + C_V + ch4);
                f32x4 rp = (f32x4){0.f, 0.f, 0.f, 0.f}, kp = rp, vp = rp;
                if (hp) { rp = ld_bf4(pp + C_R + ch4); kp = ld_bf4(pp + C_K + ch4); vp = ld_bf4(pp + C_V + ch4); }
                const f32x4 mr = *(const f32x4*)(mu_rkv + ch4), mk = *(const f32x4*)(mu_rkv + 512 + ch4), mv = *(const f32x4*)(mu_rkv + 1024 + ch4);
                const f32x4 kk4 = *(const f32x4*)(k_k + ch4), ka4 = *(const f32x4*)(k_a + ch4), rk4 = *(const f32x4*)(r_k + ch4);
                const f32x4 r1 = rr + (rp - rr) * mr, k1 = kk0 + (kp - kk0) * mk; f32x4 v1 = vv + (vp - vv) * mv;
                if (e == 1) { const f32x4 vb = *(const f32x4*)(v0 + ch4), vf = *(const f32x4*)(VF + (size_t)m * 512 + ch4);
#pragma unroll
                    for (int j = 0; j < 4; ++j) v1[j] = v1[j] + (vf[j] - v1[j]) * fast_sigmoid(vb[j] + acc[4 * g + j]); }
                else *(f32x4*)(VF + (size_t)m * 512 + ch4) = v1;
                f32x4 km, kn, bb;
#pragma unroll
                for (int j = 0; j < 4; ++j) { kn[j] = k1[j] * kk4[j] * rn; bb[j] = icv[4 * g + j] * kn[j];
                    km[j] = k1[j] * (1.0f + (icv[4 * g + j] - 1.0f) * ka4[j]); bon += r1[j] * km[j] * rk4[j]; }
                *(f32x4*)(so + sub * 32 + 8 * g + 4 * hf) = r1; *(f32x4*)(so + 128 + sub * 32 + 8 * g + 4 * hf) = km; *(f32x4*)(so + 320 + sub * 32 + 8 * g + 4 * hf) = v1;
                *(f32x4*)(so + 192 + sub * 32 + 8 * g + 4 * hf) = kn; *(f32x4*)(so + 256 + sub * 32 + 8 * g + 4 * hf) = bb;
                asm volatile("" ::: "memory");
            }
        }
        bon += __shfl_xor(bon, 32);
        if (hf == 0) BON[m * 8 + hh] = bon;
        }
      } }
    if (parts & 4) { bf16_t* QA = (bf16_t*)(ws + WS_QA); const bf16_t* WkB = (const bf16_t*)(ws + W_WKB) + (size_t)e * 8 * 128 * 64;
      const int ntile = (NT / 64) * 2 * 8;
      for (int tI = F.gw; tI < ntile; tI += F.ngw) {
          const int hh = tI & 7, nt = (tI >> 3) & 1, mt = tI >> 4;
          EpiStoreBf16 E{QA + hh * 128, 1024, nt * 64, nt * 64 + 32};
          sg_tile(proj + C_QB + hh * 64, NCOL, WkB + (size_t)hh * 128 * 64 + (size_t)(nt * 64) * 64, WkB + (size_t)hh * 128 * 64 + (size_t)(nt * 64 + 32) * 64, 64, 64, mt * 64, E, F.lane);
      } }
}

__device__ __forceinline__ float allred16(float x) {
    x += __builtin_bit_cast(float, __builtin_amdgcn_update_dpp(0, __builtin_bit_cast(int, x), 0x128, 0xf, 0xf, false));
    x += __builtin_bit_cast(float, __builtin_amdgcn_update_dpp(0, __builtin_bit_cast(int, x), 0x124, 0xf, 0xf, false));
    x += __builtin_bit_cast(float, __builtin_amdgcn_update_dpp(0, __builtin_bit_cast(int, x), 0x122, 0xf, 0xf, false));
    x += __builtin_bit_cast(float, __builtin_amdgcn_update_dpp(0, __builtin_bit_cast(int, x), 0x121, 0xf, 0xf, false));
    return x;
}
__device__ __forceinline__ void ph_scan(Frame& F) {
    PHASE_PIN(F);
    if (F.wave != 0) return;
    const int lane = F.lane, i = lane >> 4, kq = lane & 15;
    for (int task = blockIdx.x; task < 256; task += gridDim.x) {
        const int bh = task >> 4, rg = task & 15, row = 4 * rg + i, b = bh >> 3, hh = bh & 7;
        const float* sin = (const float*)(F.ws + WS_SIN) + (size_t)bh * TT * 384;
        float* Y = (float*)(F.ws + WS_Y) + (size_t)b * TT * 512 + hh * 64 + row;
        f32x4 R[8], W[8], K[8], KK[8], B[8]; float V[8];
#pragma unroll
        for (int j = 0; j < 8; ++j) { const float* p = sin + (size_t)j * 384; R[j] = *(const f32x4*)(p + 4 * kq); W[j] = *(const f32x4*)(p + 64 + 4 * kq); K[j] = *(const f32x4*)(p + 128 + 4 * kq);
            KK[j] = *(const f32x4*)(p + 192 + 4 * kq); B[j] = *(const f32x4*)(p + 256 + 4 * kq); V[j] = p[320 + row]; }
        float s0 = 0.f, s1 = 0.f, s2 = 0.f, s3 = 0.f;
        for (int t0 = 0; t0 < TT; t0 += 8) {
#pragma unroll
            for (int j = 0; j < 8; ++j) {
                float p = s0 * KK[j].x + s1 * KK[j].y + s2 * KK[j].z + s3 * KK[j].w; p = allred16(p);
                s0 = s0 * W[j].x - p * B[j].x + V[j] * K[j].x; s1 = s1 * W[j].y - p * B[j].y + V[j] * K[j].y;
                s2 = s2 * W[j].z - p * B[j].z + V[j] * K[j].z; s3 = s3 * W[j].w - p * B[j].w + V[j] * K[j].w;
                float y = s0 * R[j].x + s1 * R[j].y + s2 * R[j].z + s3 * R[j].w; y = allred16(y);
                if (kq == 0) Y[(size_t)(t0 + j) * 512] = y;
                if (t0 + j + 8 < TT) { const float* p2 = sin + (size_t)(t0 + j + 8) * 384; R[j] = *(const f32x4*)(p2 + 4 * kq); W[j] = *(const f32x4*)(p2 + 64 + 4 * kq); K[j] = *(const f32x4*)(p2 + 128 + 4 * kq);
                    KK[j] = *(const f32x4*)(p2 + 192 + 4 * kq); B[j] = *(const f32x4*)(p2 + 256 + 4 * kq); V[j] = p2[320 + row]; }
            }
        }
    }
}

constexpr size_t S1_TMP_STRIDE = 114688, S1_OUT_STRIDE = 50176;
constexpr int T_TCK = 0, T_TCB = 8192, T_TCKT = 16384, T_TCR = 24576, T_CTB = 32768, T_CTK = 40960, T_CTV = 49152, T_MAK = 57344, T_AAB = 65536, T_AAK = 73728, T_CTKH = 81920, T_CTU = 90112, T_RHSF = 98304;
constexpr int O_PT = 0, O_RH = 8192, O_G = 16384, O_Y0 = 32768, O_GC = 49152;
static_assert(WS_PROJ + 2048 * S1_OUT_STRIDE <= WS_SIN && WS_S1TMP + 1024 * S1_TMP_STRIDE <= WS_END, "scan map");
#define STAGE_SYNC() asm volatile("s_waitcnt vmcnt(0) lgkmcnt(0)" ::: "memory")
template <bool TWO>
__device__ __forceinline__ void mm64_acc(const bf16_t* A1, const bf16_t* B1, const bf16_t* A2, const bf16_t* B2, f32x16& c00, f32x16& c01, f32x16& c10, f32x16& c11, int lane) {
    const int r = lane & 31, h = lane >> 5; const int o = r * 64 + 8 * h;
#pragma unroll
    for (int i = 0; i < 16; ++i) { c00[i] = 0.f; c01[i] = 0.f; c10[i] = 0.f; c11[i] = 0.f; }
#pragma unroll
    for (int k = 0; k < 64; k += 16) {
        const bf16x8 fa0 = *(const bf16x8*)(A1 + o + k), fa1 = *(const bf16x8*)(A1 + o + 2048 + k), fb0 = *(const bf16x8*)(B1 + o + k), fb1 = *(const bf16x8*)(B1 + o + 2048 + k);
        c00 = MFMA32(fb0, fa0, c00); c01 = MFMA32(fb1, fa0, c01); c10 = MFMA32(fb0, fa1, c10); c11 = MFMA32(fb1, fa1, c11);
    }
    if (TWO) {
#pragma unroll
        for (int k = 0; k < 64; k += 16) {
            const bf16x8 fa0 = *(const bf16x8*)(A2 + o + k), fa1 = *(const bf16x8*)(A2 + o + 2048 + k), fb0 = *(const bf16x8*)(B2 + o + k), fb1 = *(const bf16x8*)(B2 + o + 2048 + k);
            c00 = MFMA32(fb0, fa0, c00); c01 = MFMA32(fb1, fa0, c01); c10 = MFMA32(fb0, fa1, c10); c11 = MFMA32(fb1, fa1, c11);
        }
    }
}
template <class Epi>
__device__ __forceinline__ void mm64_epi(const Epi& epi, const f32x16& c00, const f32x16& c01, const f32x16& c10, const f32x16& c11, int lane) {
    const int r = lane & 31, h = lane >> 5;
#pragma unroll
    for (int g = 0; g < 4; ++g) { const int j = 8 * g + 4 * h;
        epi.pair(r, j, (f32x4){c00[4 * g], c00[4 * g + 1], c00[4 * g + 2], c00[4 * g + 3]}, (f32x4){c01[4 * g], c01[4 * g + 1], c01[4 * g + 2], c01[4 * g + 3]});
        epi.pair(32 + r, j, (f32x4){c10[4 * g], c10[4 * g + 1], c10[4 * g + 2], c10[4 * g + 3]}, (f32x4){c11[4 * g], c11[4 * g + 1], c11[4 * g + 2], c11[4 * g + 3]}); }
}
__device__ __forceinline__ u32x2 pk4(f32x4 v) { u32x2 w; w.x = pk2(v.x, v.y); w.y = pk2(v.z, v.w); return w; }
struct EpiMaskLds { LAS float* M; __device__ __forceinline__ void pair(int row, int j, f32x4 v0, f32x4 v1) const {
    f32x4 a, b;
#pragma unroll
    for (int q = 0; q < 4; ++q) { a[q] = (j + q < row) ? v0[q] : 0.f; b[q] = (32 + j + q < row) ? v1[q] : 0.f; }
    *(LAS f32x4*)(M + row * 64 + j) = a; *(LAS f32x4*)(M + row * 64 + 32 + j) = b; } };
template <int INCL> struct EpiMaskBf { bf16_t* O; __device__ __forceinline__ void pair(int row, int j, f32x4 v0, f32x4 v1) const {
    f32x4 a, b;
#pragma unroll
    for (int q = 0; q < 4; ++q) { a[q] = (j + q < row + INCL) ? v0[q] : 0.f; b[q] = (32 + j + q < row + INCL) ? v1[q] : 0.f; }
    *(u32x2*)(O + row * 64 + j) = pk4(a); *(u32x2*)(O + row * 64 + 32 + j) = pk4(b); } };
struct EpiF32 { float* O; __device__ __forceinline__ void pair(int row, int j, f32x4 v0, f32x4 v1) const { *(f32x4*)(O + row * 64 + j) = v0; *(f32x4*)(O + row * 64 + 32 + j) = v1; } };
struct EpiRhat { const bf16_t* R; bf16_t* O; __device__ __forceinline__ void pair(int row, int j, f32x4 v0, f32x4 v1) const {
    *(u32x2*)(O + row * 64 + j) = pk4(ld_bf4(R + row * 64 + j) - v0); *(u32x2*)(O + row * 64 + 32 + j) = pk4(ld_bf4(R + row * 64 + 32 + j) - v1); } };
struct EpiPT { const float* gC; bf16_t* O; __device__ __forceinline__ void pair(int row, int j, f32x4 v0, f32x4 v1) const {
    const float gr = gC[row]; f32x4 a, b;
#pragma unroll
    for (int q = 0; q < 4; ++q) { a[q] = gr * (((j + q == row) ? 1.f : 0.f) - v0[q]); b[q] = gr * (((32 + j + q == row) ? 1.f : 0.f) - v1[q]); }
    *(u32x2*)(O + row * 64 + j) = pk4(a); *(u32x2*)(O + row * 64 + 32 + j) = pk4(b); } };
struct EpiGsc { const float* gC; bf16_t* O; __device__ __forceinline__ void pair(int row, int j, f32x4 v0, f32x4 v1) const {
    *(u32x2*)(O + row * 64 + j) = pk4(v0 * *(const f32x4*)(gC + j)); *(u32x2*)(O + row * 64 + 32 + j) = pk4(v1 * *(const f32x4*)(gC + 32 + j)); } };

__device__ __forceinline__ void ph_scan_s1(Frame& F) {
    PHASE_PIN(F);
    if (F.wave >= 4) return;
    LAS float* Ml = (LAS float*)(F.lds + F.wave * 32768); LAS float* Xl = Ml + 4096;
    const int lane0 = F.lane;
    for (int item = blockIdx.x * 4 + F.wave; item < 2048; item += gridDim.x * 4) {
        int lane = lane0; asm volatile("" : "+v"(lane));
        const int bh = item >> 7, chunk = item & 127;
        unsigned long long zt_; asm volatile("s_mov_b64 %0, 0" : "=s"(zt_));
        unsigned char* tmp = F.ws + WS_S1TMP + (size_t)(blockIdx.x * 4 + F.wave) * S1_TMP_STRIDE + zt_;
        __builtin_amdgcn_fence(__ATOMIC_ACQUIRE, "agent"); asm volatile("s_waitcnt vmcnt(0)" ::: "memory");
        unsigned char* outp = F.ws + WS_PROJ + (size_t)item * S1_OUT_STRIDE;
        bf16_t* TCk = (bf16_t*)(tmp + T_TCK); bf16_t* TCb = (bf16_t*)(tmp + T_TCB); bf16_t* TCkt = (bf16_t*)(tmp + T_TCKT); bf16_t* TCr = (bf16_t*)(tmp + T_TCR);
        bf16_t* CTb = (bf16_t*)(tmp + T_CTB); bf16_t* CTk = (bf16_t*)(tmp + T_CTK); bf16_t* CTv = (bf16_t*)(tmp + T_CTV);
        bf16_t* MAK = (bf16_t*)(tmp + T_MAK); bf16_t* AAB = (bf16_t*)(tmp + T_AAB); bf16_t* AAK = (bf16_t*)(tmp + T_AAK);
        bf16_t* CTKH = (bf16_t*)(tmp + T_CTKH); bf16_t* CTU = (bf16_t*)(tmp + T_CTU); float* RHSF = (float*)(tmp + T_RHSF);
        bf16_t* PT = (bf16_t*)(outp + O_PT); bf16_t* RH = (bf16_t*)(outp + O_RH); bf16_t* Gm = (bf16_t*)(outp + O_G); float* Y0 = (float*)(outp + O_Y0); float* gC = (float*)(outp + O_GC);
        const float* sin = (const float*)(F.ws + WS_SIN) + ((size_t)bh * TT + chunk * 64) * 384;
#ifndef S1_NO_CT
        { float gam[65]; gam[0] = 1.0f;
#pragma unroll
          for (int i = 0; i < 64; ++i) gam[i + 1] = sin[(size_t)i * 384 + 64 + lane];
#pragma unroll
          for (int i = 0; i < 64; ++i) gam[i + 1] *= gam[i];
#pragma unroll
          for (int blk = 0; blk < 8; ++blk) {
            float bt8[8], kt8[8], v8[8];
#pragma unroll
            for (int el = 0; el < 8; ++el) { const int i = blk * 8 + el; const float* p = sin + (size_t)i * 384;
                const float rr = p[lane], kk = p[128 + lane], ka = p[192 + lane], bb = p[256 + lane], vv = p[320 + lane];
                const float kap = gam[i] * ka; const float g = gam[i + 1]; const float inv = __builtin_amdgcn_rcpf(g); const float bt = bb * inv, kt = kk * inv, rt = rr * g;
                TCk[i * 64 + lane] = (bf16_t)f2bf(kap); TCb[i * 64 + lane] = (bf16_t)f2bf(bt); TCkt[i * 64 + lane] = (bf16_t)f2bf(kt); TCr[i * 64 + lane] = (bf16_t)f2bf(rt);
                bt8[el] = bt; kt8[el] = kt; v8[el] = vv; }
            *(bf16x8*)(CTb + lane * 64 + blk * 8) = pack8(bt8); *(bf16x8*)(CTk + lane * 64 + blk * 8) = pack8(kt8); *(bf16x8*)(CTv + lane * 64 + blk * 8) = pack8(v8);
            asm volatile("" ::: "memory");
          }
          gC[lane] = gam[64]; }
#endif
        STAGE_SYNC();
        f32x16 c00, c01, c10, c11;
        mm64_acc<false>(TCk, TCb, nullptr, nullptr, c00, c01, c10, c11, lane); { EpiMaskLds E{Ml}; mm64_epi(E, c00, c01, c10, c11, lane); }
        mm64_acc<false>(TCk, TCkt, nullptr, nullptr, c00, c01, c10, c11, lane); { EpiMaskBf<0> E{MAK}; mm64_epi(E, c00, c01, c10, c11, lane); }
        STAGE_SYNC();
        mm64_acc<false>(MAK, CTv, nullptr, nullptr, c00, c01, c10, c11, lane); { EpiF32 E{RHSF}; mm64_epi(E, c00, c01, c10, c11, lane); }
        STAGE_SYNC();
#ifndef S1_NO_SOLVE
#pragma unroll 1
        for (int pass = 0; pass < 2; ++pass) {
            if (pass & 1) {
#pragma unroll 8
                for (int i = 0; i < 64; ++i) Xl[i * 64 + lane] = RHSF[i * 64 + lane];
            } else {
#pragma unroll 8
                for (int i = 0; i < 64; ++i) Xl[i * 64 + lane] = bf2f(TCk[i * 64 + lane]);
            }
#pragma unroll 1
            for (int i0 = 0; i0 < 64; i0 += 4) {
                float a0 = Xl[i0 * 64 + lane], a1 = Xl[(i0 + 1) * 64 + lane], a2 = Xl[(i0 + 2) * 64 + lane], a3 = Xl[(i0 + 3) * 64 + lane];
#pragma unroll 2
                for (int j4 = 0; j4 < i0; j4 += 4) {
                    const float x0 = Xl[j4 * 64 + lane], x1 = Xl[(j4 + 1) * 64 + lane], x2 = Xl[(j4 + 2) * 64 + lane], x3 = Xl[(j4 + 3) * 64 + lane];
                    const f32x4 m0 = *(const LAS f32x4*)(Ml + i0 * 64 + j4), m1 = *(const LAS f32x4*)(Ml + (i0 + 1) * 64 + j4), m2 = *(const LAS f32x4*)(Ml + (i0 + 2) * 64 + j4), m3 = *(const LAS f32x4*)(Ml + (i0 + 3) * 64 + j4);
                    a0 -= m0.x * x0 + m0.y * x1 + m0.z * x2 + m0.w * x3; a1 -= m1.x * x0 + m1.y * x1 + m1.z * x2 + m1.w * x3;
                    a2 -= m2.x * x0 + m2.y * x1 + m2.z * x2 + m2.w * x3; a3 -= m3.x * x0 + m3.y * x1 + m3.z * x2 + m3.w * x3;
                }
                const f32x4 d1 = *(const LAS f32x4*)(Ml + (i0 + 1) * 64 + i0), d2 = *(const LAS f32x4*)(Ml + (i0 + 2) * 64 + i0), d3 = *(const LAS f32x4*)(Ml + (i0 + 3) * 64 + i0);
                a1 -= d1.x * a0; a2 -= d2.x * a0 + d2.y * a1; a3 -= d3.x * a0 + d3.y * a1 + d3.z * a2;
                Xl[i0 * 64 + lane] = a0; Xl[(i0 + 1) * 64 + lane] = a1; Xl[(i0 + 2) * 64 + lane] = a2; Xl[(i0 + 3) * 64 + lane] = a3;
            }
            bf16_t* dst = (pass & 1) ? CTU : CTKH; const float sgn = (pass & 1) ? -1.0f : 1.0f;
#pragma unroll 1
            for (int blk = 0; blk < 8; ++blk) { float o8[8];
#pragma unroll
                for (int el = 0; el < 8; ++el) o8[el] = sgn * Xl[(blk * 8 + el) * 64 + lane];
                *(bf16x8*)(dst + lane * 64 + blk * 8) = pack8(o8); }
        }
#endif
        mm64_acc<false>(TCr, TCb, nullptr, nullptr, c00, c01, c10, c11, lane); { EpiMaskBf<1> E{AAB}; mm64_epi(E, c00, c01, c10, c11, lane); }
        mm64_acc<false>(TCr, TCkt, nullptr, nullptr, c00, c01, c10, c11, lane); { EpiMaskBf<1> E{AAK}; mm64_epi(E, c00, c01, c10, c11, lane); }
        STAGE_SYNC();
        mm64_acc<false>(AAB, CTKH, nullptr, nullptr, c00, c01, c10, c11, lane); { EpiRhat E{TCr, RH}; mm64_epi(E, c00, c01, c10, c11, lane); }
        mm64_acc<true>(AAB, CTU, AAK, CTv, c00, c01, c10, c11, lane); { EpiF32 E{Y0}; mm64_epi(E, c00, c01, c10, c11, lane); }
        mm64_acc<false>(CTb, CTKH, nullptr, nullptr, c00, c01, c10, c11, lane); { EpiPT E{gC, PT}; mm64_epi(E, c00, c01, c10, c11, lane); }
        mm64_acc<true>(CTU, CTb, CTv, CTk, c00, c01, c10, c11, lane); { EpiGsc E{gC, Gm}; mm64_epi(E, c00, c01, c10, c11, lane); }
        STAGE_SYNC();
    }
}
__device__ __forceinline__ void ph_scan_s2(Frame& F) {
    PHASE_PIN(F);
    if (F.wave != 0 || blockIdx.x >= 32) return;
    const int lane = F.lane, r = lane & 31, hf = lane >> 5; const int bh = blockIdx.x >> 1, vt = blockIdx.x & 1, v = 32 * vt + r;
    bf16_t* SS = (bf16_t*)(F.ws + WS_Y);
    f32x16 acc0, acc1;
#pragma unroll
    for (int i = 0; i < 16; ++i) { acc0[i] = 0.f; acc1[i] = 0.f; }
    u32x2 pt[4][2][4][2]; u32x2 gin[2][2][4];
#define S2_LOADP(buf, chunk) do { const bf16_t* PT_ = (const bf16_t*)(F.ws + WS_PROJ + (size_t)(bh * 128 + (chunk)) * S1_OUT_STRIDE + O_PT); \
        _Pragma("unroll") for (int ni = 0; ni < 2; ++ni) { _Pragma("unroll") for (int s2 = 0; s2 < 4; ++s2) { pt[buf][ni][s2][0] = *(const u32x2*)(PT_ + (32 * ni + r) * 64 + 16 * s2 + 4 * hf); pt[buf][ni][s2][1] = *(const u32x2*)(PT_ + (32 * ni + r) * 64 + 16 * s2 + 8 + 4 * hf); } } } while (0)
#define S2_LOADG(buf, chunk) do { const bf16_t* G_ = (const bf16_t*)(F.ws + WS_PROJ + (size_t)(bh * 128 + (chunk)) * S1_OUT_STRIDE + O_G); \
        _Pragma("unroll") for (int ni = 0; ni < 2; ++ni) { _Pragma("unroll") for (int g = 0; g < 4; ++g) gin[buf][ni][g] = *(const u32x2*)(G_ + v * 64 + 32 * ni + 8 * g + 4 * hf); } } while (0)
#define S2_STEP(pb, gb, chunk) do { bf16_t* so_ = SS + ((size_t)(bh * 128 + (chunk)) * 64 + v) * 64 + 4 * hf; \
        _Pragma("unroll") for (int g = 0; g < 4; ++g) { *(u32x2*)(so_ + 8 * g) = pk4((f32x4){acc0[4 * g], acc0[4 * g + 1], acc0[4 * g + 2], acc0[4 * g + 3]}); *(u32x2*)(so_ + 32 + 8 * g) = pk4((f32x4){acc1[4 * g], acc1[4 * g + 1], acc1[4 * g + 2], acc1[4 * g + 3]}); } \
        bf16x8 sf[4]; { u32x4 w_; \
          w_.x = pk2(acc0[0], acc0[1]); w_.y = pk2(acc0[2], acc0[3]); w_.z = pk2(acc0[4], acc0[5]); w_.w = pk2(acc0[6], acc0[7]); sf[0] = __builtin_bit_cast(bf16x8, w_); \
          w_.x = pk2(acc0[8], acc0[9]); w_.y = pk2(acc0[10], acc0[11]); w_.z = pk2(acc0[12], acc0[13]); w_.w = pk2(acc0[14], acc0[15]); sf[1] = __builtin_bit_cast(bf16x8, w_); \
          w_.x = pk2(acc1[0], acc1[1]); w_.y = pk2(acc1[2], acc1[3]); w_.z = pk2(acc1[4], acc1[5]); w_.w = pk2(acc1[6], acc1[7]); sf[2] = __builtin_bit_cast(bf16x8, w_); \
          w_.x = pk2(acc1[8], acc1[9]); w_.y = pk2(acc1[10], acc1[11]); w_.z = pk2(acc1[12], acc1[13]); w_.w = pk2(acc1[14], acc1[15]); sf[3] = __builtin_bit_cast(bf16x8, w_); } \
        f32x16 n0_, n1_; \
        _Pragma("unroll") for (int q = 0; q < 16; ++q) { n0_[q] = 0.f; n1_[q] = 0.f; } \
        _Pragma("unroll") for (int s2 = 0; s2 < 4; ++s2) { u32x4 a_; a_.x = pt[pb][0][s2][0].x; a_.y = pt[pb][0][s2][0].y; a_.z = pt[pb][0][s2][1].x; a_.w = pt[pb][0][s2][1].y; n0_ = MFMA32(__builtin_bit_cast(bf16x8, a_), sf[s2], n0_); \
            a_.x = pt[pb][1][s2][0].x; a_.y = pt[pb][1][s2][0].y; a_.z = pt[pb][1][s2][1].x; a_.w = pt[pb][1][s2][1].y; n1_ = MFMA32(__builtin_bit_cast(bf16x8, a_), sf[s2], n1_); } \
        _Pragma("unroll") for (int g = 0; g < 4; ++g) { const u32x2 g0_ = gin[gb][0][g], g1_ = gin[gb][1][g]; \
            n0_[4 * g] += __uint_as_float(g0_.x << 16); n0_[4 * g + 1] += __uint_as_float(g0_.x & 0xffff0000u); n0_[4 * g + 2] += __uint_as_float(g0_.y << 16); n0_[4 * g + 3] += __uint_as_float(g0_.y & 0xffff0000u); \
            n1_[4 * g] += __uint_as_float(g1_.x << 16); n1_[4 * g + 1] += __uint_as_float(g1_.x & 0xffff0000u); n1_[4 * g + 2] += __uint_as_float(g1_.y << 16); n1_[4 * g + 3] += __uint_as_float(g1_.y & 0xffff0000u); } \
        acc0 = n0_; acc1 = n1_; } while (0)
    S2_LOADP(0, 0); S2_LOADP(1, 1); S2_LOADP(2, 2); S2_LOADG(0, 0);
    for (int chunk = 0; chunk < 128; chunk += 4) {
        S2_LOADP(3, chunk + 3); S2_LOADG(1, chunk + 1); S2_STEP(0, 0, chunk);
        if (chunk + 4 < 128) S2_LOADP(0, chunk + 4);
        S2_LOADG(0, chunk + 2); S2_STEP(1, 1, chunk + 1);
        if (chunk + 5 < 128) S2_LOADP(1, chunk + 5);
        S2_LOADG(1, chunk + 3); S2_STEP(2, 0, chunk + 2);
        if (chunk + 6 < 128) S2_LOADP(2, chunk + 6);
        if (chunk + 4 < 128) S2_LOADG(0, chunk + 4);
        S2_STEP(3, 1, chunk + 3);
    }
#undef S2_LOADP
#undef S2_LOADG
#undef S2_STEP
}
__device__ __forceinline__ void ph_scan_s3(Frame& F, int e) {
    PHASE_PIN(F);
    const int lane = F.lane, r = lane & 31, hf = lane >> 5;
    const float* ln_g = F.ka->in[17] + e * 512; const float* ln_b = F.ka->in[18] + e * 512;
    const float* GATE = (const float*)(F.ws + WS_GATE); const float* BON = (const float*)(F.ws + SM_BONUS); const float* SIN = (const float*)(F.ws + WS_SIN);
    bf16_t* YC = (bf16_t*)(F.ws + WS_YCAT); const bf16_t* SS = (const bf16_t*)(F.ws + WS_Y);
    for (int item = F.gw; item < 2048; item += F.ngw) {
        const int bh = item >> 7, chunk = item & 127, b = bh >> 3, hh = bh & 7;
        const unsigned char* outp = F.ws + WS_PROJ + (size_t)item * S1_OUT_STRIDE;
        const bf16_t* RH = (const bf16_t*)(outp + O_RH); const float* Y0 = (const float*)(outp + O_Y0);
        f32x16 c[2][2];
        mm64_acc<false>(RH, SS + (size_t)item * 4096, nullptr, nullptr, c[0][0], c[0][1], c[1][0], c[1][1], lane);
#pragma unroll
        for (int mi = 0; mi < 2; ++mi) {
            const int i = 32 * mi + r, t = chunk * 64 + i, m = b * TT + t;
            float s1 = 0.f;
#pragma unroll
            for (int ni = 0; ni < 2; ++ni)
#pragma unroll
                for (int g = 0; g < 4; ++g) { const f32x4 y0 = *(const f32x4*)(Y0 + i * 64 + 32 * ni + 8 * g + 4 * hf);
#pragma unroll
                    for (int q = 0; q < 4; ++q) { c[mi][ni][4 * g + q] += y0[q]; s1 += c[mi][ni][4 * g + q]; } }
            s1 += __shfl_xor(s1, 32); const float mean = s1 * (1.f / 64.f); float s2 = 0.f;
#pragma unroll
            for (int ni = 0; ni < 2; ++ni)
#pragma unroll
                for (int q = 0; q < 16; ++q) { const float d = c[mi][ni][q] - mean; c[mi][ni][q] = d; s2 += d * d; }
            s2 += __shfl_xor(s2, 32); const float rstd = rsqrtf(s2 * (1.f / 64.f) + GN_EPS); const float bon = BON[m * 8 + hh];
            const float* vrow = SIN + ((size_t)bh * TT + t) * 384 + 320;
#pragma unroll
            for (int ni = 0; ni < 2; ++ni)
#pragma unroll
                for (int g = 0; g < 4; ++g) { const int vv = 32 * ni + 8 * g + 4 * hf, ch = hh * 64 + vv;
                    const f32x4 lg = *(const f32x4*)(ln_g + ch), lb = *(const f32x4*)(ln_b + ch), v1 = *(const f32x4*)(vrow + vv), gt = *(const f32x4*)(GATE + (size_t)m * 512 + ch); f32x4 o;
#pragma unroll
                    for (int q = 0; q < 4; ++q) o[q] = (c[mi][ni][4 * g + q] * rstd * lg[q] + lb[q] + bon * v1[q]) * gt[q];
                    *(u32x2*)(YC + (size_t)m * 1024 + ch) = pk4(o); }
        }
    }
}

__device__ __forceinline__ size_t score_row_off(int b, int t) { const int j = t >> 7; return (size_t)b * SCORE_PER_BATCH + (size_t)16384 * (j * (j + 1) / 2) + (size_t)(t & 127) * (128 * (j + 1)); }
__device__ __forceinline__ void ph_idx_score(Frame& F) {
    PHASE_PIN(F);
    const int lane = F.lane, r = lane & 31, h = lane >> 5;
    const bf16_t* QI = (const bf16_t*)(F.ws + WS_QI); const bf16_t* KI = (const bf16_t*)(F.ws + WS_KI); const unsigned* SGN = (const unsigned*)(F.ws + SM_SGN);
    float* SC = (float*)(F.ws + WS_SCORE);
    if (F.wave < 4) return;
    for (int it = blockIdx.x * 4 + (F.wave - 4); it < 4352; it += gridDim.x * 4) {
        const int b = it / 2176; int i = it - b * 2176; i = 2175 - i;
        int a = 1; while (8 * a * (a + 1) <= i) ++a;
        const int rem = i - 8 * a * (a - 1), qt = 16 * (a - 1) + rem / a, g = rem % a;
        const int mq = b * TT + qt * 32 + r;
        bf16x8 qf[8][4];
#pragma unroll
        for (int hh = 0; hh < 8; ++hh)
#pragma unroll
            for (int ks = 0; ks < 4; ++ks) qf[hh][ks] = *(const bf16x8*)(QI + (size_t)mq * 512 + hh * 64 + ks * 16 + 8 * h);
        const unsigned sg = SGN[mq];
        float* srow = SC + score_row_off(b, qt * 32 + r);
        const int kt_end = (16 * g + 15 < qt) ? 16 * g + 15 : qt;
        for (int kt = 16 * g; kt <= kt_end; ++kt) {
            const bf16_t* kp = KI + (size_t)(b * TT + kt * 32 + r) * 64 + 8 * h;
            const bf16x8 kf0 = *(const bf16x8*)(kp), kf1 = *(const bf16x8*)(kp + 16), kf2 = *(const bf16x8*)(kp + 32), kf3 = *(const bf16x8*)(kp + 48);
            float sc[16];
#pragma unroll
            for (int q = 0; q < 16; ++q) sc[q] = 0.f;
#pragma unroll
            for (int hh = 0; hh < 8; ++hh) {
                f32x16 acc;
#pragma unroll
                for (int q = 0; q < 16; ++q) acc[q] = 0.f;
                acc = MFMA32(kf0, qf[hh][0], acc); acc = MFMA32(kf1, qf[hh][1], acc); acc = MFMA32(kf2, qf[hh][2], acc); acc = MFMA32(kf3, qf[hh][3], acc);
                const bool neg = (sg >> hh) & 1u;
#pragma unroll
                for (int q = 0; q < 16; ++q) { const float v = fmaxf(acc[q], 0.f); sc[q] = neg ? sc[q] - v : sc[q] + v; }
            }
#pragma unroll
            for (int g4 = 0; g4 < 4; ++g4) *(f32x4*)(srow + kt * 32 + 8 * g4 + 4 * h) = (f32x4){sc[4 * g4], sc[4 * g4 + 1], sc[4 * g4 + 2], sc[4 * g4 + 3]};
        }
    }
}
__device__ __forceinline__ unsigned block_excl_scan(unsigned v, LAS unsigned* scr, int tid, unsigned* total) {
    const int lane = tid & 63, w = tid >> 6; unsigned x = v;
#pragma unroll
    for (int o = 1; o < 64; o <<= 1) { const unsigned y = __shfl_up(x, o); if (lane >= o) x += y; }
    __syncthreads();
    if (lane == 63) scr[w] = x;
    __syncthreads();
    unsigned base = 0, tot = 0;
#pragma unroll
    for (int j = 0; j < 8; ++j) { const unsigned c = scr[j]; if (j < w) base += c; tot += c; }
    *total = tot;
    return base + x - v;
}
#define SEL_FIND(nd) do { unsigned L_ = 0; int fb_ = 0; unsigned fneed_ = 0, fcnt_ = 0; { unsigned hv_[32]; \
        _Pragma("unroll") for (int i_ = 0; i_ < 8; ++i_) { const u32x4 h4_ = *(const LAS u32x4*)(hist + 2044 - 32 * lane - 4 * i_); hv_[4 * i_] = h4_.w; hv_[4 * i_ + 1] = h4_.z; hv_[4 * i_ + 2] = h4_.y; hv_[4 * i_ + 3] = h4_.x; L_ += h4_.x + h4_.y + h4_.z + h4_.w; } \
        unsigned xs_ = L_; \
        _Pragma("unroll") for (int o_ = 1; o_ < 64; o_ <<= 1) { const unsigned y_ = __shfl_up(xs_, o_); if (lane >= o_) xs_ += y_; } \
        unsigned run_ = xs_ - L_; \
        _Pragma("unroll") for (int i_ = 0; i_ < 32; ++i_) { if (run_ < (nd) && (nd) <= run_ + hv_[i_]) { fb_ = 2047 - 32 * lane - i_; fneed_ = (nd) - run_; fcnt_ = hv_[i_]; } run_ += hv_[i_]; } } \
        const unsigned long long fm_ = __ballot(fcnt_ != 0u); found_ = fm_ != 0ull; const int fl_ = found_ ? __ffsll((long long)fm_) - 1 : 0; \
        bstar_ = __shfl(fb_, fl_); need2_ = __shfl(fneed_, fl_); cnum_ = __shfl(fcnt_, fl_); } while (0)
__device__ __forceinline__ void ph_idx_select(Frame& F) {
    PHASE_PIN(F);
    const int lane = F.lane;
    LAS unsigned* hist = (LAS unsigned*)(F.lds + F.wave * LDS_WSCR);
    LAS float* cval = (LAS float*)(hist + 2048); LAS int* cidx = (LAS int*)(cval + 1024);
    const float* SC = (const float*)(F.ws + WS_SCORE); int* SEL = (int*)(F.ws + WS_SEL);
    const unsigned long long lt_mask = (1ull << lane) - 1ull;
    if (F.wave == 0 && blockIdx.x < 32) return;
    const int nsel = F.ngw - 32, wsel = (blockIdx.x < 32) ? blockIdx.x * 7 + F.wave - 1 : 224 + (blockIdx.x - 32) * 8 + F.wave;
    for (int k = 0; k * nsel < NT; ++k) {
        const int j = k * nsel + ((k & 1) ? nsel - 1 - wsel : wsel); if (j >= NT) break;
        const int t = TT - 1 - (j >> 1), b = j & 1, m = b * TT + t, n = t + 1; int* sel = SEL + (size_t)m * 256;
        if (n <= 256) {
#pragma unroll
            for (int i = 0; i < 4; ++i) sel[lane + 64 * i] = (lane + 64 * i < n) ? lane + 64 * i : -1;
            continue; }
        const float* srow = SC + score_row_off(b, t);
        const int nch = (n + 255) >> 8;
        bool found_; int bstar_; unsigned need2_, cnum_;
        const f32x4 sv = *(const f32x4*)(srow + 4 * lane);
        float slo = fminf(fminf(sv.x, sv.y), fminf(sv.z, sv.w)), shi = fmaxf(fmaxf(sv.x, sv.y), fmaxf(sv.z, sv.w));
#pragma unroll
        for (int o = 1; o < 64; o <<= 1) { slo = fminf(slo, __shfl_xor(slo, o)); shi = fmaxf(shi, __shfl_xor(shi, o)); }
        if (!(shi > slo)) { slo -= 1.0f; shi += 1.0f; }
        float alo = -INFINITY, ahi = INFINITY, lo = slo, hi = shi;
        { const float xq = 65536.0f / (float)n; const float sk = 0.5f * (3.0f + sqrtf(9.0f + 4.0f * xq)); const unsigned kq = (unsigned)(sk * sk) + 2u;
          if (kq < 200u) {
            const float sscale = 2047.0f / (shi - slo);
#pragma unroll
            for (int i = 0; i < 8; ++i) *(LAS u32x4*)(hist + 4 * (lane + 64 * i)) = (u32x4){0u, 0u, 0u, 0u};
            LDS_WAIT(); asm volatile("" ::: "memory");
#pragma unroll
            for (int i = 0; i < 4; ++i) { int bq = (int)((sv[i] - slo) * sscale); bq = bq < 0 ? 0 : (bq > 2047 ? 2047 : bq); __hip_atomic_fetch_add(&hist[bq], 1u, __ATOMIC_RELAXED, __HIP_MEMORY_SCOPE_WORKGROUP); }
            LDS_WAIT(); asm volatile("" ::: "memory");
            SEL_FIND(kq);
            if (found_) { const float tau0 = slo + (float)bstar_ / sscale; if (shi > tau0) { alo = tau0; lo = tau0; } }
          } }
        unsigned need = 256u, outpos = 0u;
        for (int level = 0; level < 10; ++level) {
            if (!(hi > lo)) {
                for (int c = 0; c < nch && need > 0u; ++c) { const int idx0 = 256 * c + 4 * lane; f32x4 v = (f32x4){0.f, 0.f, 0.f, 0.f}; if (idx0 < n) v = *(const f32x4*)(srow + idx0);
                    bool f[4]; unsigned before = 0, mine = 0, total = 0;
#pragma unroll
                    for (int i = 0; i < 4; ++i) { f[i] = (idx0 + i < n) && v[i] >= alo && v[i] <= ahi; const unsigned long long mk = __ballot(f[i]); before += __popcll(mk & lt_mask); total += __popcll(mk); }
#pragma unroll
                    for (int i = 0; i < 4; ++i) { if (f[i]) { const unsigned p = before + mine; if (p < need) sel[outpos + p] = idx0 + i; ++mine; } }
                    const unsigned took = total < need ? total : need; outpos += took; need -= took; }
                break;
            }
            const float scale = 2047.0f / (hi - lo);
#pragma unroll
            for (int i = 0; i < 8; ++i) *(LAS u32x4*)(hist + 4 * (lane + 64 * i)) = (u32x4){0u, 0u, 0u, 0u};
            LDS_WAIT(); asm volatile("" ::: "memory");
            for (int c0 = 0; c0 < nch; c0 += 8) {
                f32x4 vv[8];
#pragma unroll
                for (int u = 0; u < 8; ++u) { const int idx0 = 256 * (c0 + u) + 4 * lane; vv[u] = (f32x4){0.f, 0.f, 0.f, 0.f}; if (idx0 < n) vv[u] = *(const f32x4*)(srow + idx0); }
#pragma unroll
                for (int u = 0; u < 8; ++u) { const int idx0 = 256 * (c0 + u) + 4 * lane; const f32x4 v = vv[u];
#pragma unroll
                    for (int i = 0; i < 4; ++i) if (idx0 + i < n && v[i] >= alo && v[i] <= ahi) { int bq = (int)((v[i] - lo) * scale); bq = bq < 0 ? 0 : (bq > 2047 ? 2047 : bq);
                        __hip_atomic_fetch_add(&hist[bq], 1u, __ATOMIC_RELAXED, __HIP_MEMORY_SCOPE_WORKGROUP); } } }
            LDS_WAIT(); asm volatile("" ::: "memory");
            SEL_FIND(need);
            if (!found_) { alo = -INFINITY; ahi = INFINITY; lo = slo; hi = shi; continue; }
            const int bstar = bstar_; const unsigned need2 = need2_, cnum = cnum_;
            const bool listed = cnum <= 1024u;
            float lo2 = INFINITY, hi2 = -INFINITY; unsigned cpos = 0;
            for (int c0 = 0; c0 < nch; c0 += 8) {
              f32x4 vv[8];
#pragma unroll
              for (int u = 0; u < 8; ++u) { const int idx0 = 256 * (c0 + u) + 4 * lane; vv[u] = (f32x4){0.f, 0.f, 0.f, 0.f}; if (idx0 < n) vv[u] = *(const f32x4*)(srow + idx0); }
#pragma unroll
              for (int u = 0; u < 8; ++u) { const int idx0 = 256 * (c0 + u) + 4 * lane; const f32x4 v = vv[u];
                bool fg[4], fe[4]; unsigned bg = 0, be = 0, tg = 0, te = 0;
#pragma unroll
                for (int i = 0; i < 4; ++i) { const bool act = (idx0 + i < n) && v[i] >= alo && v[i] <= ahi; int bq = (int)((v[i] - lo) * scale); bq = bq < 0 ? 0 : (bq > 2047 ? 2047 : bq);
                    fg[i] = act && bq > bstar; fe[i] = act && bq == bstar;
                    const unsigned long long mg = __ballot(fg[i]), me = __ballot(fe[i]); bg += __popcll(mg & lt_mask); be += __popcll(me & lt_mask); tg += __popcll(mg); te += __popcll(me); }
                unsigned mg2 = 0, me2 = 0;
#pragma unroll
                for (int i = 0; i < 4; ++i) {
                    if (fg[i]) { sel[outpos + bg + mg2] = idx0 + i; ++mg2; }
                    if (fe[i]) { lo2 = fminf(lo2, v[i]); hi2 = fmaxf(hi2, v[i]); if (listed) { cval[cpos + be + me2] = v[i]; cidx[cpos + be + me2] = idx0 + i; } ++me2; } }
                outpos += tg; cpos += te; } }
            need = need2;
            if (listed) {
                LDS_WAIT(); asm volatile("" ::: "memory");
                for (unsigned i = lane; i < cnum; i += 64) { const float vi = cval[i]; const int ii = cidx[i]; unsigned rank = 0;
                    for (unsigned jj = 0; jj < cnum; ++jj) { const float vj = cval[jj]; rank += (vj > vi || (vj == vi && cidx[jj] < ii)) ? 1u : 0u; }
                    if (rank < need) sel[outpos + rank] = ii; }
                LDS_WAIT(); asm volatile("" ::: "memory");
                break;
            }
#pragma unroll
            for (int o = 1; o < 64; o <<= 1) { lo2 = fminf(lo2, __shfl_xor(lo2, o)); hi2 = fmaxf(hi2, __shfl_xor(hi2, o)); }
            alo = lo2; ahi = hi2; lo = lo2; hi = hi2;
        }
    }
}

#define MFMA16(a, b, c) __builtin_amdgcn_mfma_f32_16x16x32_bf16((a), (b), (c), 0, 0, 0)
__device__ __forceinline__ void ph_sparse(Frame& F, int e) {
    PHASE_PIN(F);
    const int lane = F.lane, hd = lane & 15, gq = lane >> 4; unsigned char* ws = F.ws;
    LAS unsigned char* Tl = F.lds + F.wave * LDS_WSCR;
    const bf16_t* QA = (const bf16_t*)(ws + WS_QA); bf16_t* CTXo = (bf16_t*)(ws + WS_XB);   const bf16_t* CN = (const bf16_t*)(ws + WS_CN); const int* SEL = (const int*)(ws + WS_SEL);
    for (int m = F.gw; m < NT; m += F.ngw) {
        const int t = m & (TT - 1), b = m >> 13; const int nvalid = (t + 1 < 256) ? t + 1 : 256;
        bf16x8 qf[4];
#pragma unroll
        for (int ks = 0; ks < 4; ++ks) { u32x4 z = (u32x4){0u, 0u, 0u, 0u}; if (hd < 8) z = *(const u32x4*)(QA + (size_t)m * 1024 + hd * 128 + 32 * ks + 8 * gq); qf[ks] = __builtin_bit_cast(bf16x8, z); }
        f32x4 ctx[8];
#pragma unroll
        for (int i = 0; i < 8; ++i) ctx[i] = (f32x4){0.f, 0.f, 0.f, 0.f};
        float mrun = -INFINITY, lsum = 0.f;
        const bf16_t* cbase = CN + (size_t)b * TT * 128;
#pragma unroll 1
        for (int c = 0; c < 4; ++c) {
            if (64 * c >= nvalid) break;
            int sjc = SEL[(size_t)m * 256 + 64 * c + lane]; if (sjc < 0) sjc = 0;
            bf16x8 pc[4][4];
#pragma unroll
            for (int kt = 0; kt < 4; ++kt) { const int s = __shfl(sjc, 16 * kt + hd); const bf16_t* row = cbase + (size_t)s * 128 + 8 * gq;
#pragma unroll
                for (int ks = 0; ks < 4; ++ks) pc[kt][ks] = *(const bf16x8*)(row + 32 * ks); }
            f32x4 d[4];
#pragma unroll
            for (int kt = 0; kt < 4; ++kt) { f32x4 a = (f32x4){0.f, 0.f, 0.f, 0.f};
#pragma unroll
                for (int ks = 0; ks < 4; ++ks) a = MFMA16(pc[kt][ks], qf[ks], a);
#pragma unroll
                for (int q = 0; q < 4; ++q) { const int kidx = 64 * c + 16 * kt + 4 * gq + q; d[kt][q] = (kidx < nvalid) ? a[q] * (0.125f * LOG2E) : -INFINITY; } }
            { LAS unsigned char* wb = Tl + (hd >> 2) * 1024 + (hd & 3) * 2 + gq * 64;
#pragma unroll
              for (int kt = 0; kt < 4; ++kt)
#pragma unroll
                for (int ks = 0; ks < 4; ++ks)
#pragma unroll
                    for (int el = 0; el < 8; ++el) *(LAS bf16_t*)(wb + 4 * kt * 1024 + (32 * ks + el) * 8) = (bf16_t)pc[kt][ks][el]; }
            float mx = fmaxf(fmaxf(fmaxf(d[0][0], d[0][1]), fmaxf(d[0][2], d[0][3])), fmaxf(fmaxf(d[1][0], d[1][1]), fmaxf(d[1][2], d[1][3])));
            mx = fmaxf(mx, fmaxf(fmaxf(fmaxf(d[2][0], d[2][1]), fmaxf(d[2][2], d[2][3])), fmaxf(fmaxf(d[3][0], d[3][1]), fmaxf(d[3][2], d[3][3]))));
            mx = fmaxf(mx, __shfl_xor(mx, 16)); mx = fmaxf(mx, __shfl_xor(mx, 32));
            const float mnew = fmaxf(mrun, mx); const float scale = __builtin_amdgcn_exp2f(mrun - mnew); mrun = mnew;
            float psum = 0.f;
#pragma unroll
            for (int kt = 0; kt < 4; ++kt)
#pragma unroll
                for (int q = 0; q < 4; ++q) { d[kt][q] = __builtin_amdgcn_exp2f(d[kt][q] - mnew); psum += d[kt][q]; }
            lsum = lsum * scale + psum;
#pragma unroll
            for (int i = 0; i < 8; ++i) ctx[i] *= scale;
#pragma unroll
            for (int u = 0; u < 2; ++u) {
                u32x4 pw; pw.x = pk2(d[2 * u][0], d[2 * u][1]); pw.y = pk2(d[2 * u][2], d[2 * u][3]); pw.z = pk2(d[2 * u + 1][0], d[2 * u + 1][1]); pw.w = pk2(d[2 * u + 1][2], d[2 * u + 1][3]);
                const bf16x8 pf = __builtin_bit_cast(bf16x8, pw);
#pragma unroll
                for (int mt = 0; mt < 8; ++mt) { const LAS unsigned char* rb = Tl + gq * 1024 + hd * 8;
                    const u32x2 lo = *(const LAS u32x2*)(rb + (8 * u) * 1024 + 16 * mt * 8);
                    const u32x2 hi = *(const LAS u32x2*)(rb + (8 * u + 4) * 1024 + 16 * mt * 8);
                    u32x4 aw; aw.x = lo.x; aw.y = lo.y; aw.z = hi.x; aw.w = hi.y;
                    ctx[mt] = MFMA16(__builtin_bit_cast(bf16x8, aw), pf, ctx[mt]); }
            }
        }
        lsum += __shfl_xor(lsum, 16); lsum += __shfl_xor(lsum, 32);
        const float inv = 1.0f / lsum;
        if (hd < 8) {
#pragma unroll
            for (int mt = 0; mt < 8; ++mt) { u32x2 w; w.x = pk2(ctx[mt][0] * inv, ctx[mt][1] * inv); w.y = pk2(ctx[mt][2] * inv, ctx[mt][3] * inv);
                *(u32x2*)(CTXo + (size_t)m * 1024 + hd * 128 + 16 * mt + 4 * gq) = w; }
        }
    }
}
__device__ __forceinline__ void ph_mix_finish(Frame& F, int e) {
    PHASE_PIN(F);
    const int lane = F.lane; unsigned char* ws = F.ws;
    bf16_t* YC = (bf16_t*)(ws + WS_YCAT);
    const float* ln_g = F.ka->in[17] + e * 512; const float* ln_b = F.ka->in[18] + e * 512;
    const float* Yr = (const float*)(ws + WS_Y); const float* GATE = (const float*)(ws + WS_GATE); const float* BON = (const float*)(ws + SM_BONUS); const float* SIN = (const float*)(ws + WS_SIN);
#if !CHUNKED
    for (int m = F.gw; m < NT; m += F.ngw) {
        const int t = m & (TT - 1), b = m >> 13;
#pragma unroll 1
        for (int hh = 0; hh < 8; ++hh) {
            const int ch = hh * 64 + lane; const float y = Yr[(size_t)m * 512 + ch];
            const float mean = wave_sum(y) * (1.f / 64.f); const float yc = y - mean; const float var = wave_sum(yc * yc) * (1.f / 64.f);
            const float v1 = SIN[((size_t)(b * 8 + hh) * TT + t) * 384 + 320 + lane];
            const float o = (yc * rsqrtf(var + GN_EPS) * ln_g[ch] + ln_b[ch] + BON[m * 8 + hh] * v1) * GATE[(size_t)m * 512 + ch];
            YC[(size_t)m * 1024 + ch] = (bf16_t)f2bf(o);
        }
    }
#endif
    { const bf16_t* CTX = (const bf16_t*)(ws + WS_XB); const bf16_t* WvT = (const bf16_t*)(ws + W_WVT) + (size_t)e * 512 * 128;
      for (int tI = F.gw; tI < (NT / 64) * 8; tI += F.ngw) {
          const int hh = tI & 7, mt = tI >> 3;
          EpiStoreBf16 E{YC + 512 + hh * 64, 1024, 0, 32};
          sg_tile(CTX + hh * 128, 1024, WvT + (size_t)(hh * 64) * 128, WvT + (size_t)(hh * 64 + 32) * 128, 128, 128, mt * 64, E, F.lane);
      } }
}

__device__ __forceinline__ void ph_stickbreak(Frame& F) {
    PHASE_PIN(F);
    const int lane = F.lane, r = lane & 31, hf = lane >> 5; unsigned char* ws = F.ws;
    const bf16_t* Q = (const bf16_t*)(ws + WS_PROJ); const bf16_t* Kb = Q + (size_t)NT * 1024; const bf16_t* Vb = Kb + (size_t)NT * 1024;
    bf16_t* YC = (bf16_t*)(ws + WS_YCAT);
    for (int it = F.gw; it < NB * 16 * 256; it += F.ngw) {
        const int qt = it & 255, hh = (it >> 8) & 15, b = it >> 12;
        const int mq = b * TT + qt * 32 + r;
        bf16x8 qf[4];
#pragma unroll
        for (int ks = 0; ks < 4; ++ks) qf[ks] = *(const bf16x8*)(Q + (size_t)mq * 1024 + hh * 64 + ks * 16 + 8 * hf);
        f32x16 o0, o1;
#pragma unroll
        for (int i = 0; i < 16; ++i) { o0[i] = 0.f; o1[i] = 0.f; }
        float P = 1.0f;
        for (int kt = qt; kt >= 0; --kt) {
            const bf16_t* kp = Kb + (size_t)(b * TT + kt * 32 + r) * 1024 + hh * 64 + 8 * hf;
            const bf16x8 kf0 = *(const bf16x8*)(kp), kf1 = *(const bf16x8*)(kp + 16), kf2 = *(const bf16x8*)(kp + 32), kf3 = *(const bf16x8*)(kp + 48);
            const bf16_t* vp = Vb + (size_t)(b * TT + kt * 32 + 4 * hf) * 1024 + hh * 64 + r;
            bf16x8 vf[2][2];
#pragma unroll
            for (int s2 = 0; s2 < 2; ++s2)
#pragma unroll
                for (int j = 0; j < 8; ++j) { const size_t ko = (size_t)(16 * s2 + 8 * (j >> 2) + (j & 3)) * 1024; vf[0][s2][j] = (short)vp[ko]; vf[1][s2][j] = (short)vp[ko + 32]; }
            f32x16 acc;
#pragma unroll
            for (int i = 0; i < 16; ++i) acc[i] = 0.f;
            acc = MFMA32(kf0, qf[0], acc); acc = MFMA32(kf1, qf[1], acc); acc = MFMA32(kf2, qf[2], acc); acc = MFMA32(kf3, qf[3], acc);
            float kp_[16], be[16];
            const bool diag = (kt == qt);
#pragma unroll
            for (int q = 0; q < 16; ++q) {
                const int key = 8 * (q >> 2) + 4 * hf + (q & 3);
                const float e = __builtin_amdgcn_exp2f(acc[q]); float keep = __builtin_amdgcn_rcpf(1.0f + e);
                if (diag && key >= r) keep = 1.0f;
                kp_[q] = keep; be[q] = 1.0f - keep;
            }
            float ls[16], tot[4], oth[4];
#pragma unroll
            for (int g = 0; g < 4; ++g) { ls[4 * g + 3] = 1.0f; ls[4 * g + 2] = kp_[4 * g + 3]; ls[4 * g + 1] = ls[4 * g + 2] * kp_[4 * g + 2]; ls[4 * g] = ls[4 * g + 1] * kp_[4 * g + 1]; tot[g] = ls[4 * g] * kp_[4 * g]; }
#pragma unroll
            for (int g = 0; g < 4; ++g) oth[g] = __shfl_xor(tot[g], 32);
            const float G0 = tot[0] * oth[0], G1 = tot[1] * oth[1], G2 = tot[2] * oth[2], G3 = tot[3] * oth[3];
            float E[4]; E[3] = 1.0f; E[2] = G3; E[1] = G3 * G2; E[0] = E[1] * G1;
            float w[16];
#pragma unroll
            for (int g = 0; g < 4; ++g) { const float mg = E[g] * (hf == 0 ? oth[g] : 1.0f) * P;
#pragma unroll
                for (int j = 0; j < 4; ++j) w[4 * g + j] = be[4 * g + j] * ls[4 * g + j] * mg; }
            P *= E[0] * G0;
            u32x4 w0, w1;
            w0.x = pk2(w[0], w[1]); w0.y = pk2(w[2], w[3]); w0.z = pk2(w[4], w[5]); w0.w = pk2(w[6], w[7]);
            w1.x = pk2(w[8], w[9]); w1.y = pk2(w[10], w[11]); w1.z = pk2(w[12], w[13]); w1.w = pk2(w[14], w[15]);
            const bf16x8 wf0 = __builtin_bit_cast(bf16x8, w0), wf1 = __builtin_bit_cast(bf16x8, w1);
            o0 = MFMA32(vf[0][0], wf0, o0); o0 = MFMA32(vf[0][1], wf1, o0);
            o1 = MFMA32(vf[1][0], wf0, o1); o1 = MFMA32(vf[1][1], wf1, o1);
            if (__ballot(P > 1e-30f) == 0ull) break;
        }
        bf16_t* op = YC + (size_t)mq * 1024 + hh * 64 + 4 * hf;
#pragma unroll
        for (int g = 0; g < 4; ++g) {
            u32x2 a; a.x = pk2(o0[4 * g], o0[4 * g + 1]); a.y = pk2(o0[4 * g + 2], o0[4 * g + 3]); *(u32x2*)(op + 8 * g) = a;
            u32x2 c; c.x = pk2(o1[4 * g], o1[4 * g + 1]); c.y = pk2(o1[4 * g + 2], o1[4 * g + 3]); *(u32x2*)(op + 32 + 8 * g) = c;
        }
    }
}

__device__ __forceinline__ void ph_moe_route(Frame& F, const Args& A, int l, bool claim) {
    PHASE_PIN(F);
    const int lane = F.lane; unsigned char* ws = F.ws;
    const float* X = (const float*)(ws + WS_X); bf16_t* XB = (bf16_t*)(ws + WS_XB);
    const float* g = F.ka->in[29] + l * DM; const float* Wg = F.ka->in[30] + (size_t)l * DM * 4; const float* We = F.ka->in[31] + (size_t)l * 4 * DM * 8;
    int* EIDX = (int*)(ws + SM_EIDX); float* GATEV = (float*)(ws + SM_GATE); int* SLOT = (int*)(ws + SM_SLOT);
    unsigned* cnt = (unsigned*)(ws + WS_CTL) + CW_CNT + 2048 * l;
    for (int m = F.gw; m < NT; m += F.ngw) {
        const f32x4* xr = (const f32x4*)(X + (size_t)m * DM) + lane; f32x4 v[4]; float s = 0.f;
#pragma unroll
        for (int j = 0; j < 4; ++j) { v[j] = xr[64 * j]; s += (v[j].x * v[j].x + v[j].y * v[j].y) + (v[j].z * v[j].z + v[j].w * v[j].w); }
        const float rstd = rsqrtf(wave_sum(s) * (1.f / DM) + RMS_EPS);
        u32x2* o8 = (u32x2*)(XB + (size_t)m * DM) + lane;
#pragma unroll
        for (int j = 0; j < 4; ++j) { u32x2 w; w.x = pk2(v[j].x * rstd, v[j].y * rstd); w.y = pk2(v[j].z * rstd, v[j].w * rstd); o8[64 * j] = w; }
#pragma unroll
        for (int j = 0; j < 4; ++j) { const f32x4 gg = *((const f32x4*)g + lane + 64 * j); v[j] = v[j] * gg * rstd; }
        float gl[4] = {0.f, 0.f, 0.f, 0.f};
#pragma unroll
        for (int j = 0; j < 4; ++j)
#pragma unroll
            for (int i = 0; i < 4; ++i) { const int k = 4 * (lane + 64 * j) + i; const f32x4 w = *(const f32x4*)(Wg + (size_t)k * 4); const float xv = v[j][i];
                gl[0] += xv * w.x; gl[1] += xv * w.y; gl[2] += xv * w.z; gl[3] += xv * w.w; }
#pragma unroll
        for (int q = 0; q < 4; ++q) gl[q] = wave_sum(gl[q]);
        int gs = 0; float gm = gl[0];
#pragma unroll
        for (int q = 1; q < 4; ++q) if (gl[q] > gm) { gm = gl[q]; gs = q; }
        float gden = 0.f;
#pragma unroll
        for (int q = 0; q < 4; ++q) gden += __expf(gl[q] - gm);
        const float g_gate = 1.0f / gden;
        const float* Wes = We + (size_t)gs * DM * 8;
        float el[8];
#pragma unroll
        for (int q = 0; q < 8; ++q) el[q] = 0.f;
#pragma unroll
        for (int j = 0; j < 4; ++j)
#pragma unroll
            for (int i = 0; i < 4; ++i) { const int k = 4 * (lane + 64 * j) + i; const f32x4 w0 = *(const f32x4*)(Wes + (size_t)k * 8), w1 = *(const f32x4*)(Wes + (size_t)k * 8 + 4); const float xv = v[j][i];
                el[0] += xv * w0.x; el[1] += xv * w0.y; el[2] += xv * w0.z; el[3] += xv * w0.w; el[4] += xv * w1.x; el[5] += xv * w1.y; el[6] += xv * w1.z; el[7] += xv * w1.w; }
#pragma unroll
        for (int q = 0; q < 8; ++q) el[q] = wave_sum(el[q]);
        int i1 = 0; float m1 = el[0];
#pragma unroll
        for (int q = 1; q < 8; ++q) if (el[q] > m1) { m1 = el[q]; i1 = q; }
        int i2 = -1; float m2 = -INFINITY;
#pragma unroll
        for (int q = 0; q < 8; ++q) if (q != i1 && el[q] > m2) { m2 = el[q]; i2 = q; }
        const float e2 = __expf(m2 - m1); const float ga = g_gate / (1.0f + e2), gb = g_gate * e2 / (1.0f + e2);
        if (lane == 0 && claim) {
            const int ea = gs * 8 + i1, eb = gs * 8 + i2;
            const unsigned sa = atomicAdd(&cnt[ea * 64], 1u), sb = atomicAdd(&cnt[eb * 64], 1u);
            EIDX[2 * m] = ea; EIDX[2 * m + 1] = eb; GATEV[2 * m] = ga; GATEV[2 * m + 1] = gb; SLOT[2 * m] = (int)sa; SLOT[2 * m + 1] = (int)sb;
        }
    }
}
__device__ __forceinline__ int moe_offsets(const unsigned* cnt, int lane, int* total, int* mycnt_pad) {
    const unsigned c = lane < 32 ? __hip_atomic_load(cnt + (lane & 31) * 64, __ATOMIC_RELAXED, __HIP_MEMORY_SCOPE_AGENT) : 0u; const int p = (int)((c + 255u) & ~255u);
    int x = p;
#pragma unroll
    for (int o = 1; o < 64; o <<= 1) { const int y = __shfl_up(x, o); if (lane >= o) x += y; }
    *total = __shfl(x, 63); *mycnt_pad = p;
    return x - p;
}
__device__ __forceinline__ void ph_moe_gather(Frame& F, int l) {
    PHASE_PIN(F);
    const int lane = F.lane; unsigned char* ws = F.ws;
    const unsigned* cnt = (const unsigned*)(ws + WS_CTL) + CW_CNT + 2048 * l; int total, pad; const int off = moe_offsets(cnt, lane, &total, &pad);
    const int* EIDX = (const int*)(ws + SM_EIDX); const int* SLOT = (const int*)(ws + SM_SLOT);
    const bf16_t* XB = (const bf16_t*)(ws + WS_XB); bf16_t* AM = (bf16_t*)(ws + WS_AMOE);
    for (int a = F.gw; a < NT * 2; a += F.ngw) {
        const int m = a >> 1, e = EIDX[a], row = __shfl(off, e) + SLOT[a];
        const u32x4* src = (const u32x4*)(XB + (size_t)m * DM); u32x4* dst = (u32x4*)(AM + (size_t)row * DM);
        dst[lane] = src[lane]; dst[lane + 64] = src[lane + 64];
    }
}
__device__ __forceinline__ int moe_build_tab(Frame& F, int l) {
    LAS int* tab = (LAS int*)(F.lds + LDS_MISC + 256); LAS int* ends = (LAS int*)(F.lds + LDS_MISC + 1024);
    const unsigned* cnt = (const unsigned*)(F.ws + WS_CTL) + CW_CNT + 2048 * l; int total, pad; const int off = moe_offsets(cnt, F.lane, &total, &pad);
    __syncthreads();
    if (F.tid < 32) ends[F.tid] = off + pad;
    __syncthreads();
    for (int rt = F.tid; rt < total / 256; rt += NTHR) { int e = 0; for (int q = 0; q < 32; ++q) e += (ends[q] <= rt * 256) ? 1 : 0; tab[rt] = e; }
    __syncthreads();
    return total;
}
__device__ __forceinline__ void ph_moe_gemm1(Frame& F, int l) {
    PHASE_PIN(F);
    const int total = moe_build_tab(F, l);
    pg8::Gemm g{(const pg8::bf16_t*)(F.ws + WS_AMOE), (const pg8::bf16_t*)(F.ws + WS_W13T), total, 32 * 1024, DM};
    pg8::MoeOrder S{(total / 256) * 4, (int)gridDim.x, (int)blockIdx.x, (const LAS int*)(F.lds + LDS_MISC + 256)};
    pg8::EpiGate E{(pg8::bf16_t*)(F.ws + WS_H)};
    pg8::gemm_phase<pg8::EpiGate, pg8::MoeOrder>(F.lds, g, S, E, nullptr, F.wave);
}
__device__ __forceinline__ void ph_moe_gemm2(Frame& F, int l) {
    PHASE_PIN(F);
    const int total = moe_build_tab(F, l);
    pg8::Gemm g{(const pg8::bf16_t*)(F.ws + WS_H), (const pg8::bf16_t*)(F.ws + WS_W2T), total, 32 * 1024, 512};
    pg8::MoeOrder S{(total / 256) * 4, (int)gridDim.x, (int)blockIdx.x, (const LAS int*)(F.lds + LDS_MISC + 256)};
    pg8::EpiMoeDown E{(pg8::bf16_t*)(F.ws + WS_YM)};
    pg8::gemm_phase<pg8::EpiMoeDown, pg8::MoeOrder>(F.lds, g, S, E, nullptr, F.wave);
}
__device__ __forceinline__ void ph_moe_combine(Frame& F, const Args& A, int l, bool wr) {
    PHASE_PIN(F);
    const int lane = F.lane; unsigned char* ws = F.ws;
    const unsigned* cnt = (const unsigned*)(ws + WS_CTL) + CW_CNT + 2048 * l; int total, pad; const int off = moe_offsets(cnt, lane, &total, &pad);
    const int* EIDX = (const int*)(ws + SM_EIDX); const int* SLOT = (const int*)(ws + SM_SLOT); const float* GATEV = (const float*)(ws + SM_GATE);
    float* X = (float*)(ws + WS_X); bf16_t* XB = (bf16_t*)(ws + WS_XB); const bf16_t* YM = (const bf16_t*)(ws + WS_YM);
    const float* fg = F.ka->in[35];
    for (int m = F.gw; m < NT; m += F.ngw) {
        const int ea = EIDX[2 * m], eb = EIDX[2 * m + 1]; const float ga = GATEV[2 * m], gb = GATEV[2 * m + 1];
        const int ra = __shfl(off, ea) + SLOT[2 * m], rb = __shfl(off, eb) + SLOT[2 * m + 1];
        f32x4* xr = (f32x4*)(X + (size_t)m * DM) + lane; const u32x2* ya = (const u32x2*)(YM + (size_t)ra * DM) + lane; const u32x2* yb = (const u32x2*)(YM + (size_t)rb * DM) + lane;
        f32x4 v[4]; float s = 0.f;
#pragma unroll
        for (int j = 0; j < 4; ++j) { v[j] = xr[64 * j]; const u32x2 a = ya[64 * j], bq = yb[64 * j];
            v[j].x += ga * __uint_as_float(a.x << 16) + gb * __uint_as_float(bq.x << 16); v[j].y += ga * __uint_as_float(a.x & 0xffff0000u) + gb * __uint_as_float(bq.x & 0xffff0000u);
            v[j].z += ga * __uint_as_float(a.y << 16) + gb * __uint_as_float(bq.y << 16); v[j].w += ga * __uint_as_float(a.y & 0xffff0000u) + gb * __uint_as_float(bq.y & 0xffff0000u);
            s += (v[j].x * v[j].x + v[j].y * v[j].y) + (v[j].z * v[j].z + v[j].w * v[j].w); }
        const float rstd = rsqrtf(wave_sum(s) * (1.f / DM) + RMS_EPS);
        if (l < 3) {
            u32x2* o8 = (u32x2*)(XB + (size_t)m * DM) + lane;
#pragma unroll
            for (int j = 0; j < 4; ++j) { if (wr) xr[64 * j] = v[j]; u32x2 w; w.x = pk2(v[j].x * rstd, v[j].y * rstd); w.y = pk2(v[j].z * rstd, v[j].w * rstd); o8[64 * j] = w; }
        } else {
            f32x4* orow = (f32x4*)(F.out + (size_t)m * DM) + lane;
#pragma unroll
            for (int j = 0; j < 4; ++j) { const f32x4 gg = *((const f32x4*)fg + lane + 64 * j); orow[64 * j] = v[j] * gg * rstd; }
        }
    }
}

__global__ void __launch_bounds__(NTHR, 2) fwd_kernel(Args args) {
    extern __shared__ __attribute__((aligned(16))) unsigned char lds_raw[];
    Frame F; F.lds = (LAS unsigned char*)lds_raw; F.tid = threadIdx.x; F.lane = F.tid & 63; F.wave = __builtin_amdgcn_readfirstlane(F.tid >> 6);
    F.gw = blockIdx.x * NWAVES + F.wave; F.ngw = gridDim.x * NWAVES; F.out = args.out; F.ws = args.ws; F.flags = args.flags; F.ka = (const __attribute__((address_space(4))) Args*)__builtin_amdgcn_kernarg_segment_ptr();
    volatile LAS unsigned* MISC = (volatile LAS unsigned*)(F.lds + LDS_MISC);
    if (F.tid < 64) MISC[F.tid] = 0u;
    __syncthreads();
    const int lo = args.ph_lo, hi = args.ph_hi;
    XcdBarrier bar; bar.bar = (unsigned*)(F.ws + WS_CTL) + CW_BAR; bar.x = 0; bar.st = MISC;
    if (hi - lo > 1) bar = xcd_barrier_post((unsigned*)(F.ws + WS_CTL) + CW_BAR, MISC, F.tid == 0);
#define IN(k) (lo <= (k) && (k) < hi)
#define DUP(k) for (int _rep = 0; _rep < ((DUP_PHASE == (k)) ? 2 : 1); ++_rep)
#define SEAM(k) do { if ((k) + 1 < hi) { PHASE_PIN(F); xcd_barrier(bar, F.tid == 0); if (DUP_PHASE == 99) xcd_barrier(bar, F.tid == 0); } } while (0)
    unsigned char* ws = F.ws;
    if (IN(0)) { DUP(0) ph_prologue(F, args); SEAM(0); }
    for (int l = 0; l < 4; ++l) {
        const int pb = 1 + 16 * l, e = l >> 1;
        const float* xsrc = (l == 0) ? args.in[0] : (const float*)(ws + WS_X);
        if ((l & 1) == 0) {
            if (IN(pb + 0)) { PHASE_PIN(F);
                pg8::Gemm g{(const pg8::bf16_t*)(F.ws + WS_XB), (const pg8::bf16_t*)(F.ws + W_WIN) + (size_t)e * NCOL * DM, NT, NCOL, DM}; pg8::StaticOrder S; S.init(NT, NCOL, (int)gridDim.x, (int)blockIdx.x);
                pg8::EpiBf16S E{(pg8::bf16_t*)(F.ws + WS_PROJ), NCOL, 0, 0};
                DUP(11) pg8::gemm_phase<pg8::EpiBf16S, pg8::StaticOrder>(F.lds, g, S, E, nullptr, F.wave);
                SEAM(pb + 0); }
            if (IN(pb + 1)) {
#ifndef NO_PREP
 ph_prep(F, args, e, 7); if (DUP_PHASE >= 20 && DUP_PHASE < 28) ph_prep(F, args, e, DUP_PHASE - 20);
#endif
 SEAM(pb + 1); }
            if (IN(pb + 2)) { if (!(args.flags & 1)) ph_scan_s1(F); if (!(args.flags & 2)) ph_idx_score(F); SEAM(pb + 2); }
            if (IN(pb + 3)) { if (!(args.flags & 1)) ph_scan_s2(F); if (!(args.flags & 2)) ph_idx_select(F); SEAM(pb + 3); }
            if (IN(pb + 4)) { if (!(args.flags & 1)) ph_scan_s3(F, e); if (!(args.flags & 2)) ph_sparse(F, e); SEAM(pb + 4); }
            if (IN(pb + 6)) { DUP(13) ph_mix_finish(F, e); SEAM(pb + 6); }
        } else {
            if (IN(pb + 0)) { PHASE_PIN(F);
                pg8::Gemm g{(const pg8::bf16_t*)(F.ws + WS_XB), (const pg8::bf16_t*)(F.ws + W_WQKV) + (size_t)e * 3072 * DM, NT, 3072, DM}; pg8::StaticOrder S; S.init(NT, 3072, (int)gridDim.x, (int)blockIdx.x);
                pg8::EpiBf16S E{(pg8::bf16_t*)(F.ws + WS_PROJ), 1024, 1024, (size_t)NT * 1024};
                DUP(12) pg8::gemm_phase<pg8::EpiBf16S, pg8::StaticOrder>(F.lds, g, S, E, nullptr, F.wave);
                SEAM(pb + 0); }
            if (IN(pb + 1)) {
#ifndef NO_SB
 DUP(6) ph_stickbreak(F);
#endif
 SEAM(pb + 1); }
        }
        if (IN(pb + 7)) { PHASE_PIN(F);
            pg8::Gemm g{(const pg8::bf16_t*)(F.ws + WS_YCAT), (const pg8::bf16_t*)(F.ws + ((l & 1) ? W_WOUTO : W_WOUTE)) + (size_t)e * DM * DM, NT, DM, DM}; pg8::StaticOrder S; S.init(NT, DM, (int)gridDim.x, (int)blockIdx.x);
            pg8::EpiResid E{xsrc, (float*)(F.ws + WS_X)};
            pg8::gemm_phase<pg8::EpiResid, pg8::StaticOrder>(F.lds, g, S, E, nullptr, F.wave);
            if (DUP_PHASE == 17 && l == 0) pg8::gemm_phase<pg8::EpiResid, pg8::StaticOrder>(F.lds, g, S, E, nullptr, F.wave);
            SEAM(pb + 7); }
        if (IN(pb + 8)) {
#ifndef NO_ROUTE
 if (!(args.flags & 1)) ph_moe_route(F, args, l, true); if (!(args.flags & 2)) moe_weight_prep(F, args, l);
#endif
 SEAM(pb + 8); }
        if (IN(pb + 9)) { DUP(8) ph_moe_gather(F, l); SEAM(pb + 9); }
        if (IN(pb + 10)) { DUP(9) ph_moe_gemm1(F, l); SEAM(pb + 10); }
        if (IN(pb + 11)) { DUP(10) ph_moe_gemm2(F, l); SEAM(pb + 11); }
        if (IN(pb + 12)) { if (DUP_PHASE == 18) ph_moe_combine(F, args, l, false); ph_moe_combine(F, args, l, true); SEAM(pb + 12); }
    }
#undef IN
#undef SEAM
}

extern "C" void kernel_launch(void* const* d_in, const int* in_sizes, int n_in, void* d_out, int out_size, void* d_ws, size_t ws_size, hipStream_t stream) {
    static int grid = 0;
    if (grid == 0) {
        if (n_in != 36 || out_size != NT * DM || ws_size < WS_END) { fprintf(stderr, "kernel_launch: unexpected problem (n_in %d out %d ws %zu)\n", n_in, out_size, ws_size); grid = -1; return; }
        int dev = 0, cus = 0, per_cu = 0;
        if (hipGetDevice(&dev) != hipSuccess || hipDeviceGetAttribute(&cus, hipDeviceAttributeMultiprocessorCount, dev) != hipSuccess) { grid = -1; return; }
        if (hipFuncSetAttribute((const void*)fwd_kernel, hipFuncAttributeMaxDynamicSharedMemorySize, LDS_BYTES) != hipSuccess) { grid = -1; return; }
        if (hipOccupancyMaxActiveBlocksPerMultiprocessor(&per_cu, (const void*)fwd_kernel, NTHR, LDS_BYTES) != hipSuccess || per_cu < 1) { fprintf(stderr, "kernel_launch: occupancy query says %d\n", per_cu); }
        (void)hipGetLastError();
        grid = cus;
    }
    if (grid < 0) return;
    (void)hipMemsetAsync((char*)d_ws + WS_CTL, 0, CTL_ZERO_BYTES, stream);
    Args a{};
    for (int i = 0; i < 36; ++i) a.in[i] = (const float*)d_in[i];
    a.out = (float*)d_out; a.ws = (unsigned char*)d_ws;
#if ONE_LAUNCH
    a.ph_lo = 0; a.ph_hi = 65;
    hipLaunchKernelGGL(fwd_kernel, dim3(grid), dim3(NTHR), LDS_BYTES, stream, a);
    if (DUP_PHASE >= 100) { a.flags = DUP_PHASE / 100 - 1; a.ph_lo = DUP_PHASE % 100; a.ph_hi = a.ph_lo + 1; a.out = (float*)((char*)d_ws + WS_SIN); hipLaunchKernelGGL(fwd_kernel, dim3(grid), dim3(NTHR), LDS_BYTES, stream, a); }
#else
    for (int p = 0; p < 65; ++p) {
        const int l = (p - 1) >> 4, k = (p - 1) & 15;
        if (p > 0) { if (k > 12) continue; if ((l & 1) && k >= 2 && k <= 6) continue; if (!(l & 1) && k == 5) continue; }
        a.ph_lo = p; a.ph_hi = p + 1;
        hipLaunchKernelGGL(fwd_kernel, dim3(grid), dim3(NTHR), LDS_BYTES, stream, a);
    }
#endif
}
```
